# Optimizing an MI355X kernel written in HIP

```python
import math
import jax
import jax.numpy as jnp
from jax import lax
import numpy as np


D_MODEL = 1024
BATCH = 4
SEQ = 4096
DEPTH = 2

HEAD_DIM = 64
N_HEADS = D_MODEL // HEAD_DIM
D_MIX = N_HEADS * HEAD_DIM
H_FOX = 3 * N_HEADS // 8
H_GDN = 3 * N_HEADS // 8
H_GLA = N_HEADS - H_FOX - H_GDN
FOX_DIM = H_FOX * HEAD_DIM
GDN_DIM = H_GDN * HEAD_DIM
GLA_DK = HEAD_DIM // 2
GLA_DV = HEAD_DIM
GLA_K_DIM = H_GLA * GLA_DK
GLA_V_DIM = H_GLA * GLA_DV
GLA_RANK = 16
GLA_TAU = 16.0
CONV_K = 4
Q_BLOCK = 128
CHUNK = 64
N_GROUPS = 4
EXPERTS_PER_GROUP = 8
N_EXPERTS = N_GROUPS * EXPERTS_PER_GROUP
TOP_K = 2
D_EXPERT = D_MODEL // 2
MOE_BLOCK = 128
RMS_EPS = 1e-6
N_IN = 3 * FOX_DIM + H_FOX + 4 * GDN_DIM + 2 * H_GDN + 2 * GLA_K_DIM + 2 * GLA_V_DIM + GLA_RANK
F32 = jnp.float32

kernel_name = 'hybrid_fox_gdn_gla_hier_moe'


def rms_norm(x, gain):
    xf = x.astype(F32)
    y = xf * lax.rsqrt(jnp.mean(xf * xf, axis=-1, keepdims=True) + RMS_EPS)
    return (y * gain.astype(F32)).astype(x.dtype)


def l2_normalize(x):
    xf = x.astype(F32)
    return (xf * lax.rsqrt(jnp.sum(xf * xf, axis=-1, keepdims=True) + RMS_EPS)).astype(x.dtype)


def causal_depthwise_conv(x, w):
    c = x.shape[-1]
    return lax.conv_general_dilated(x, w[:, None, :].astype(x.dtype), window_strides=(1,),
                                    padding=[(CONV_K - 1, 0)],
                                    dimension_numbers=('NWC', 'WIO', 'NWC'),
                                    feature_group_count=c)


def split_columns(proj):
    sizes = [FOX_DIM, FOX_DIM, FOX_DIM, H_FOX,
             3 * GDN_DIM, GDN_DIM, H_GDN, H_GDN,
             GLA_K_DIM, GLA_K_DIM, GLA_V_DIM, GLA_V_DIM, GLA_RANK]
    idx = np.cumsum(sizes)[:-1].tolist()
    return jnp.split(proj, idx, axis=-1)


def fox_branch(q, k, v, f_logit, q_gain, k_gain, f_bias, o_gain):
    b, s, _ = q.shape
    q = rms_norm(q.reshape(b, s, H_FOX, HEAD_DIM), q_gain)
    k = rms_norm(k.reshape(b, s, H_FOX, HEAD_DIM), k_gain)
    v = v.reshape(b, s, H_FOX, HEAD_DIM)
    log_f = jax.nn.log_sigmoid(f_logit.astype(F32) + f_bias.astype(F32))
    cum = jnp.cumsum(log_f, axis=1).transpose(0, 2, 1)
    nq = s // Q_BLOCK
    q_blocks = q.reshape(b, nq, Q_BLOCK, H_FOX, HEAD_DIM).transpose(1, 0, 2, 3, 4)
    c_blocks = cum.reshape(b, H_FOX, nq, Q_BLOCK).transpose(2, 0, 1, 3)
    key_pos = jnp.arange(s)
    scale = HEAD_DIM ** -0.5

    def attend(args):
        q_i, c_i, blk = args
        logits = (jnp.einsum('bqhd,bkhd->bhqk', q_i, k).astype(F32) * scale
                  + (c_i[..., :, None] - cum[..., None, :]))
        query_pos = blk * Q_BLOCK + jnp.arange(Q_BLOCK)
        logits = jnp.where(key_pos[None, :] <= query_pos[:, None], logits, -jnp.inf)
        p = jax.nn.softmax(logits, axis=-1).astype(v.dtype)
        return jnp.einsum('bhqk,bkhd->bqhd', p, v)

    o = lax.map(attend, (q_blocks, c_blocks, jnp.arange(nq)))
    o = o.transpose(1, 0, 2, 3, 4).reshape(b, s, H_FOX, HEAD_DIM)
    return rms_norm(o, o_gain).reshape(b, s, FOX_DIM)


def gated_delta_rule(q, k, v, g, beta):
    b, s, h, dk = q.shape
    dv = v.shape[-1]
    n = s // CHUNK

    def chunks(t):
        return t.astype(F32).reshape(b, n, CHUNK, h, t.shape[-1]).transpose(0, 3, 1, 2, 4)

    qc, kc, vc = chunks(q), chunks(k), chunks(v)
    gc = g.reshape(b, n, CHUNK, h).transpose(0, 3, 1, 2)
    bc = beta.reshape(b, n, CHUNK, h).transpose(0, 3, 1, 2)
    decay = jnp.cumsum(gc, axis=-1)
    causal = jnp.tril(jnp.ones((CHUNK, CHUNK), bool))
    strict = jnp.tril(jnp.ones((CHUNK, CHUNK), bool), k=-1)
    diff = decay[..., :, None] - decay[..., None, :]
    gamma = jnp.where(causal, jnp.exp(jnp.where(causal, diff, 0.0)), 0.0)
    kb = kc * bc[..., None]
    a_strict = jnp.where(strict, jnp.einsum('bhnid,bhnjd->bhnij', kb, kc) * gamma, 0.0)
    lhs = a_strict + jnp.eye(CHUNK, dtype=F32)
    rhs = jnp.concatenate([vc * bc[..., None], kb * jnp.exp(decay)[..., None]], axis=-1)
    sol = lax.linalg.triangular_solve(lhs, rhs, left_side=True, lower=True)
    u, w = sol[..., :dv], sol[..., dv:]
    intra = jnp.einsum('bhnid,bhnjd->bhnij', qc, kc) * gamma
    q_dec = qc * jnp.exp(decay)[..., None]
    k_dec = kc * jnp.exp(decay[..., -1:] - decay)[..., None]
    last = jnp.exp(decay[..., -1])

    def step(state, xs):
        u_i, w_i, qd_i, kd_i, a_i, last_i = xs
        v_new = u_i - jnp.einsum('bhcd,bhde->bhce', w_i, state)
        o = jnp.einsum('bhcd,bhde->bhce', qd_i, state) + jnp.einsum('bhij,bhje->bhie', a_i, v_new)
        state = state * last_i[..., None, None] + jnp.einsum('bhcd,bhce->bhde', kd_i, v_new)
        return state, o

    xs = tuple(jnp.moveaxis(t, 2, 0) for t in (u, w, q_dec, k_dec, intra, last))
    _, o = lax.scan(step, jnp.zeros((b, h, dk, dv), F32), xs)
    return o.transpose(1, 0, 3, 2, 4).reshape(b, s, h, dv)


def gdn_branch(qkv, gate, a, beta_logit, conv_w, a_log, dt_bias, o_gain):
    b, s, _ = qkv.shape
    qkv = jax.nn.silu(causal_depthwise_conv(qkv, conv_w))
    q, k, v = jnp.split(qkv, 3, axis=-1)
    q = l2_normalize(q.reshape(b, s, H_GDN, HEAD_DIM)) * (HEAD_DIM ** -0.5)
    k = l2_normalize(k.reshape(b, s, H_GDN, HEAD_DIM))
    v = v.reshape(b, s, H_GDN, HEAD_DIM)
    g = -jnp.exp(a_log.astype(F32)) * jax.nn.softplus(a.astype(F32) + dt_bias.astype(F32))
    beta = jax.nn.sigmoid(beta_logit.astype(F32))
    o = gated_delta_rule(q, k, v, g, beta).astype(qkv.dtype)
    o = rms_norm(o, o_gain) * jax.nn.silu(gate.reshape(b, s, H_GDN, HEAD_DIM))
    return o.reshape(b, s, GDN_DIM)


def gla_chunked(q, k, v, log_a):
    b, s, h, dk = q.shape
    dv = v.shape[-1]
    n = s // CHUNK

    def chunks(t):
        return t.astype(F32).reshape(b, n, CHUNK, h, t.shape[-1]).transpose(1, 0, 3, 2, 4)

    qc, kc, vc = chunks(q), chunks(k), chunks(v)
    bcum = jnp.cumsum(chunks(log_a), axis=3)
    causal = jnp.tril(jnp.ones((CHUNK, CHUNK), bool))[..., None]

    def step(state, xs):
        q_i, k_i, v_i, b_i = xs
        diff = b_i[:, :, :, None, :] - b_i[:, :, None, :, :]
        dec = jnp.where(causal, jnp.exp(jnp.where(causal, diff, 0.0)), 0.0)
        scores = jnp.einsum('bhid,bhjd,bhijd->bhij', q_i, k_i, dec)
        o = (jnp.einsum('bhid,bhde->bhie', q_i * jnp.exp(b_i), state)
             + jnp.einsum('bhij,bhje->bhie', scores, v_i))
        b_last = b_i[:, :, -1:, :]
        state = (state * jnp.exp(b_last[:, :, 0, :, None])
                 + jnp.einsum('bhjd,bhje->bhde', k_i * jnp.exp(b_last - b_i), v_i))
        return state, o

    _, o = lax.scan(step, jnp.zeros((b, h, dk, dv), F32), (qc, kc, vc, bcum))
    return o.transpose(1, 0, 3, 2, 4).reshape(b, s, h, dv)


def gla_branch(q, k, v, r, a1, w_a2, b_a, o_gain):
    b, s, _ = q.shape
    q = q.reshape(b, s, H_GLA, GLA_DK) * (GLA_DK ** -0.5)
    k = k.reshape(b, s, H_GLA, GLA_DK)
    v = v.reshape(b, s, H_GLA, GLA_DV)
    log_a = jax.nn.log_sigmoid((a1 @ w_a2 + b_a).astype(F32)) / GLA_TAU
    log_a = log_a.reshape(b, s, H_GLA, GLA_DK)
    o = gla_chunked(q, k, v, log_a).astype(q.dtype)
    o = rms_norm(o, o_gain) * jax.nn.silu(r.reshape(b, s, H_GLA, GLA_DV))
    return o.reshape(b, s, GLA_V_DIM)


def token_mixer(h, w_in, fox_q_norm, fox_k_norm, fox_f_bias, fox_o_norm,
                gdn_conv, gdn_a_log, gdn_dt_bias, gdn_o_norm,
                gla_w_a2, gla_b_a, gla_o_norm, w_out):
    proj = h @ w_in
    (fq, fk, fv, ff, gqkv, ggate, ga, gb, lq, lk, lv, lr, la1) = split_columns(proj)
    o_fox = fox_branch(fq, fk, fv, ff, fox_q_norm, fox_k_norm, fox_f_bias, fox_o_norm)
    o_gdn = gdn_branch(gqkv, ggate, ga, gb, gdn_conv, gdn_a_log, gdn_dt_bias, gdn_o_norm)
    o_gla = gla_branch(lq, lk, lv, lr, la1, gla_w_a2, gla_b_a, gla_o_norm)
    return jnp.concatenate([o_fox, o_gdn, o_gla], axis=-1) @ w_out


def expert_dispatch(hf, expert_id, gate, w_g, w_u, w_d):
    n, d = hf.shape
    nk = n * TOP_K
    flat_e = expert_id.reshape(-1)
    flat_tok = jnp.repeat(jnp.arange(n, dtype=jnp.int32), TOP_K)
    flat_g = gate.reshape(-1).astype(hf.dtype)
    order = jnp.argsort(flat_e)
    e_sorted, tok_sorted, g_sorted = flat_e[order], flat_tok[order], flat_g[order]
    counts = jnp.bincount(flat_e, length=N_EXPERTS)
    starts = jnp.cumsum(counts) - counts
    padded = (counts + MOE_BLOCK - 1) // MOE_BLOCK * MOE_BLOCK
    pends = jnp.cumsum(padded)
    pstarts = pends - padded
    dest = pstarts[e_sorted] + (jnp.arange(nk) - starts[e_sorted])
    n_rows = -(-nk // MOE_BLOCK) * MOE_BLOCK + N_EXPERTS * MOE_BLOCK
    n_blocks = n_rows // MOE_BLOCK
    row_tok = jnp.full((n_rows,), n, jnp.int32).at[dest].set(tok_sorted)
    row_gate = jnp.zeros((n_rows,), hf.dtype).at[dest].set(g_sorted)
    block_e = jnp.minimum(jnp.searchsorted(pends, jnp.arange(n_blocks) * MOE_BLOCK, side='right'),
                          N_EXPERTS - 1)
    h_pad = jnp.concatenate([hf, jnp.zeros((1, d), hf.dtype)], axis=0)
    xb = h_pad[row_tok].reshape(n_blocks, MOE_BLOCK, d)

    def run_block(args):
        x_blk, e = args
        return (jax.nn.silu(x_blk @ w_g[e]) * (x_blk @ w_u[e])) @ w_d[e]

    yb = lax.map(run_block, (xb, block_e)).reshape(n_rows, d)
    y = jnp.zeros((n + 1, d), hf.dtype).at[row_tok].add(yb * row_gate[:, None])
    return y[:n]


def hierarchical_moe(h, w_rg, b_rg, w_re, b_re, w_g, w_u, w_d):
    b, s, d = h.shape
    n = b * s
    hf = h.reshape(n, d)
    group_prob = jax.nn.softmax((hf @ w_rg).astype(F32) + b_rg.astype(F32), axis=-1)
    group_p, group_idx = lax.top_k(group_prob, 1)
    expert_logits = ((hf @ w_re).astype(F32) + b_re.astype(F32)).reshape(n, N_GROUPS, EXPERTS_PER_GROUP)
    sel = jnp.broadcast_to(group_idx[:, :, None], (n, 1, EXPERTS_PER_GROUP))
    in_group = jnp.take_along_axis(expert_logits, sel, axis=1)[:, 0]
    top_p, top_idx = lax.top_k(jax.nn.softmax(in_group, axis=-1), TOP_K)
    gate = group_p * top_p / jnp.sum(top_p, axis=-1, keepdims=True)
    expert_id = group_idx * EXPERTS_PER_GROUP + top_idx
    return expert_dispatch(hf, expert_id, gate, w_g, w_u, w_d).reshape(b, s, d)


def setup_inputs(seed: int = 0) -> dict:
    key = jax.random.key(seed)
    ks = jax.random.split(key, 24)
    L = DEPTH

    def normal(k, shape, scale):
        return jax.random.normal(k, shape, F32) * scale

    def gain(k, shape):
        return 1.0 + 0.1 * jax.random.normal(k, shape, F32)

    dt = jnp.exp(jax.random.uniform(ks[9], (L, H_GDN), F32, math.log(1e-3), math.log(1e-1)))
    return {
        'x': normal(ks[0], (BATCH, SEQ, D_MODEL), 1.0),
        'attn_norm': gain(ks[1], (L, D_MODEL)),
        'w_in': normal(ks[2], (L, D_MODEL, N_IN), D_MODEL ** -0.5),
        'fox_q_norm': gain(ks[3], (L, HEAD_DIM)),
        'fox_k_norm': gain(ks[4], (L, HEAD_DIM)),
        'fox_f_bias': jax.random.uniform(ks[5], (L, H_FOX), F32, 1.0, 4.0),
        'fox_o_norm': gain(ks[6], (L, HEAD_DIM)),
        'gdn_conv': normal(ks[7], (L, CONV_K, 3 * GDN_DIM), CONV_K ** -0.5),
        'gdn_a_log': jnp.log(jax.random.uniform(ks[8], (L, H_GDN), F32, 1.0, 16.0)),
        'gdn_dt_bias': dt + jnp.log(-jnp.expm1(-dt)),
        'gdn_o_norm': gain(ks[10], (L, HEAD_DIM)),
        'gla_w_a2': normal(ks[11], (L, GLA_RANK, GLA_K_DIM), GLA_RANK ** -0.5),
        'gla_b_a': normal(ks[12], (L, GLA_K_DIM), 0.1),
        'gla_o_norm': gain(ks[13], (L, GLA_DV)),
        'w_out': normal(ks[14], (L, D_MIX, D_MODEL), D_MIX ** -0.5),
        'ffn_norm': gain(ks[15], (L, D_MODEL)),
        'w_router_group': normal(ks[16], (L, D_MODEL, N_GROUPS), D_MODEL ** -0.5),
        'b_router_group': normal(ks[17], (L, N_GROUPS), 0.01),
        'w_router_expert': normal(ks[18], (L, D_MODEL, N_EXPERTS), D_MODEL ** -0.5),
        'b_router_expert': normal(ks[19], (L, N_EXPERTS), 0.01),
        'w_expert_gate': normal(ks[20], (L, N_EXPERTS, D_MODEL, D_EXPERT), D_MODEL ** -0.5),
        'w_expert_up': normal(ks[21], (L, N_EXPERTS, D_MODEL, D_EXPERT), D_MODEL ** -0.5),
        'w_expert_down': normal(ks[22], (L, N_EXPERTS, D_EXPERT, D_MODEL), D_EXPERT ** -0.5),
    }


def reference(x, attn_norm, w_in, fox_q_norm, fox_k_norm, fox_f_bias, fox_o_norm,
              gdn_conv, gdn_a_log, gdn_dt_bias, gdn_o_norm,
              gla_w_a2, gla_b_a, gla_o_norm, w_out,
              ffn_norm, w_router_group, b_router_group, w_router_expert, b_router_expert,
              w_expert_gate, w_expert_up, w_expert_down):
    for layer in range(DEPTH):
        h = rms_norm(x, attn_norm[layer])
        x = x + token_mixer(h, w_in[layer], fox_q_norm[layer], fox_k_norm[layer],
                            fox_f_bias[layer], fox_o_norm[layer],
                            gdn_conv[layer], gdn_a_log[layer], gdn_dt_bias[layer], gdn_o_norm[layer],
                            gla_w_a2[layer], gla_b_a[layer], gla_o_norm[layer], w_out[layer])
        h = rms_norm(x, ffn_norm[layer])
        x = x + hierarchical_moe(h, w_router_group[layer], b_router_group[layer],
                                 w_router_expert[layer], b_router_expert[layer],
                                 w_expert_gate[layer], w_expert_up[layer], w_expert_down[layer])
    return x
```

```cpp
#include <hip/hip_runtime.h>
#include <cstdint>
#include <cstdio>

#define D_MODEL 1024
#define BATCH 4
#define SEQ 4096
#define NTOK (BATCH * SEQ)
#define H_FOX 6
#define H_GDN 6
#define H_GLA 4
#define N_IN 3490
#define N_EXP 32
#define D_EXP 512

#define C_FQ 0
#define C_FK 384
#define C_FV 768
#define C_FF 1152
#define C_GQ 1158
#define C_GK 1542
#define C_GV 1926
#define C_GG 2310
#define C_GA 2694
#define C_GB 2700
#define C_LQ 2706
#define C_LK 2834
#define C_LV 2962
#define C_LR 3218
#define C_LA 3474

__device__ __forceinline__ float sigmoidf_(float x) { return 1.f / (1.f + __expf(-x)); }
__device__ __forceinline__ float siluf_(float x) { return x / (1.f + __expf(-x)); }
__device__ __forceinline__ float softplusf_(float x) { return x > 20.f ? x : log1pf(__expf(x)); }
__device__ __forceinline__ float logsigmoidf_(float x) { return -softplusf_(-x); }

__device__ __forceinline__ float wave_sum(float v) {
#pragma unroll
    for (int o = 32; o > 0; o >>= 1) v += __shfl_xor(v, o, 64);
    return v;
}

__global__ void k_rmsnorm(const float* __restrict__ x, const float* __restrict__ gain, float* __restrict__ out, int rows) {
    int row = blockIdx.x * 4 + (threadIdx.x >> 6);
    int lane = threadIdx.x & 63;
    if (row >= rows) return;
    const float* xr = x + (size_t)row * D_MODEL;
    float v[16]; float ss = 0.f;
#pragma unroll
    for (int i = 0; i < 16; ++i) { v[i] = xr[lane + 64 * i]; ss += v[i] * v[i]; }
    ss = wave_sum(ss);
    float r = rsqrtf(ss / D_MODEL + 1e-6f);
#pragma unroll
    for (int i = 0; i < 16; ++i) out[(size_t)row * D_MODEL + lane + 64 * i] = v[i] * r * gain[lane + 64 * i];
}

__global__ void __launch_bounds__(256) k_gemm(const float* __restrict__ A, const float* __restrict__ B, float* C, const float* R, int M, int N, int K) {
    __shared__ float As[16][64 + 4];
    __shared__ float Bs[16][64 + 4];
    int tx = threadIdx.x & 15, ty = threadIdx.x >> 4;
    int m0 = blockIdx.y * 64, n0 = blockIdx.x * 64;
    float acc[4][4];
#pragma unroll
    for (int i = 0; i < 4; ++i)
#pragma unroll
        for (int j = 0; j < 4; ++j) acc[i][j] = 0.f;
    for (int k0 = 0; k0 < K; k0 += 16) {
        {
            int r = threadIdx.x >> 2, c = (threadIdx.x & 3) * 4;
            const float* ap = A + (size_t)(m0 + r) * K + k0 + c;
            float4 a4 = *(const float4*)ap;
            As[c + 0][r] = a4.x; As[c + 1][r] = a4.y; As[c + 2][r] = a4.z; As[c + 3][r] = a4.w;
        }
        {
            int r = threadIdx.x >> 4, c = (threadIdx.x & 15) * 4;
#pragma unroll
            for (int j = 0; j < 4; ++j) {
                int n = n0 + c + j;
                Bs[r][c + j] = (n < N) ? B[(size_t)(k0 + r) * N + n] : 0.f;
            }
        }
        __syncthreads();
#pragma unroll
        for (int kk = 0; kk < 16; ++kk) {
            float a[4], b[4];
#pragma unroll
            for (int i = 0; i < 4; ++i) a[i] = As[kk][ty * 4 + i];
#pragma unroll
            for (int j = 0; j < 4; ++j) b[j] = Bs[kk][tx * 4 + j];
#pragma unroll
            for (int i = 0; i < 4; ++i)
#pragma unroll
                for (int j = 0; j < 4; ++j) acc[i][j] += a[i] * b[j];
        }
        __syncthreads();
    }
#pragma unroll
    for (int i = 0; i < 4; ++i)
#pragma unroll
        for (int j = 0; j < 4; ++j) {
            int m = m0 + ty * 4 + i, n = n0 + tx * 4 + j;
            if (n < N) {
                float v = acc[i][j];
                if (R) v += R[(size_t)m * N + n];
                C[(size_t)m * N + n] = v;
            }
        }
}

__global__ void k_fox_qknorm(float* proj, const float* __restrict__ qg, const float* __restrict__ kg) {
    int gw = blockIdx.x * 4 + (threadIdx.x >> 6);
    int lane = threadIdx.x & 63;
    int which = gw % 2; int h = (gw / 2) % H_FOX; int t = gw / (2 * H_FOX);
    if (t >= NTOK) return;
    float* p = proj + (size_t)t * N_IN + (which ? C_FK : C_FQ) + h * 64;
    float v = p[lane];
    float ss = wave_sum(v * v);
    float r = rsqrtf(ss / 64.f + 1e-6f);
    p[lane] = v * r * (which ? kg[lane] : qg[lane]);
}
__global__ void k_fox_cumsum(const float* __restrict__ proj, const float* __restrict__ fbias, float* __restrict__ cum) {
    int id = blockIdx.x * blockDim.x + threadIdx.x;
    if (id >= BATCH * H_FOX) return;
    int b = id / H_FOX, h = id % H_FOX;
    float c = 0.f;
    for (int s = 0; s < SEQ; ++s) {
        float f = proj[(size_t)(b * SEQ + s) * N_IN + C_FF + h] + fbias[h];
        c += logsigmoidf_(f);
        cum[(size_t)id * SEQ + s] = c;
    }
}
__global__ void __launch_bounds__(64) k_fox_attn(const float* __restrict__ proj, const float* __restrict__ cum, const float* __restrict__ og, float* __restrict__ mix) {
    int bh = blockIdx.y; int b = bh / H_FOX, h = bh % H_FOX;
    int t = blockIdx.x * 64 + threadIdx.x;
    const float* qp = proj + (size_t)(b * SEQ + t) * N_IN + C_FQ + h * 64;
    float q[64], o[64];
#pragma unroll
    for (int d = 0; d < 64; ++d) { q[d] = qp[d] * 0.125f; o[d] = 0.f; }
    float ct = cum[(size_t)bh * SEQ + t];
    float m = -1e30f, l = 0.f;
    int smax = blockIdx.x * 64 + 63;
    for (int s = 0; s <= smax; ++s) {
        const float* kp = proj + (size_t)(b * SEQ + s) * N_IN + C_FK + h * 64;
        const float* vp = proj + (size_t)(b * SEQ + s) * N_IN + C_FV + h * 64;
        float dot = 0.f;
#pragma unroll
        for (int d = 0; d < 64; ++d) dot += q[d] * kp[d];
        float lg = dot + ct - cum[(size_t)bh * SEQ + s];
        if (s <= t) {
            float mn = fmaxf(m, lg);
            float a = __expf(m - mn), p = __expf(lg - mn);
            l = l * a + p;
#pragma unroll
            for (int d = 0; d < 64; ++d) o[d] = o[d] * a + p * vp[d];
            m = mn;
        }
    }
    float inv = 1.f / l; float ss = 0.f;
#pragma unroll
    for (int d = 0; d < 64; ++d) { o[d] *= inv; ss += o[d] * o[d]; }
    float r = rsqrtf(ss / 64.f + 1e-6f);
    float* mp = mix + (size_t)(b * SEQ + t) * D_MODEL + h * 64;
#pragma unroll
    for (int d = 0; d < 64; ++d) mp[d] = o[d] * r * og[d];
}

__global__ void k_gdn_prep(const float* __restrict__ proj, const float* __restrict__ convw, float* __restrict__ gq) {
    int gw = blockIdx.x * 4 + (threadIdx.x >> 6);
    int lane = threadIdx.x & 63;
    int grp = gw % 18; int t = gw / 18;
    if (t >= NTOK) return;
    int s = t % SEQ;
    int c = grp * 64 + lane;
    float acc = 0.f;
#pragma unroll
    for (int i = 0; i < 4; ++i) {
        int ss = s - 3 + i;
        if (ss >= 0) acc += convw[i * 1152 + c] * proj[(size_t)(t - 3 + i) * N_IN + C_GQ + c];
    }
    float v = siluf_(acc);
    int which = grp / 6;
    if (which < 2) {
        float ss2 = wave_sum(v * v);
        v *= rsqrtf(ss2 + 1e-6f);
        if (which == 0) v *= 0.125f;
    }
    gq[(size_t)t * 1152 + c] = v;
}
__global__ void __launch_bounds__(64) k_gdn_seq(const float* __restrict__ proj, const float* __restrict__ gq, const float* __restrict__ a_log, const float* __restrict__ dt_bias,
                                                const float* __restrict__ og, float* __restrict__ mix) {
    int bh = blockIdx.x; int b = bh / H_GDN, h = bh % H_GDN; int e = threadIdx.x;
    float S[64];
#pragma unroll
    for (int d = 0; d < 64; ++d) S[d] = 0.f;
    float A = -__expf(a_log[h]); float dtb = dt_bias[h];
    for (int s = 0; s < SEQ; ++s) {
        size_t t = (size_t)b * SEQ + s;
        const float* qp = gq + t * 1152 + h * 64;
        const float* kp = gq + t * 1152 + 384 + h * 64;
        float v = gq[t * 1152 + 768 + h * 64 + e];
        float g = A * softplusf_(proj[t * N_IN + C_GA + h] + dtb);
        float beta = sigmoidf_(proj[t * N_IN + C_GB + h]);
        float a = __expf(g);
        float kS = 0.f;
#pragma unroll
        for (int d = 0; d < 64; ++d) { S[d] *= a; kS += kp[d] * S[d]; }
        float vn = beta * (v - kS);
        float o = 0.f;
#pragma unroll
        for (int d = 0; d < 64; ++d) { S[d] += kp[d] * vn; o += qp[d] * S[d]; }
        float ss = wave_sum(o * o);
        float r = rsqrtf(ss / 64.f + 1e-6f);
        float gate = proj[t * N_IN + C_GG + h * 64 + e];
        mix[t * D_MODEL + 384 + h * 64 + e] = o * r * og[e] * siluf_(gate);
    }
}

__global__ void k_gla_loga(const float* __restrict__ proj, const float* __restrict__ wa2, const float* __restrict__ ba, float* __restrict__ la) {
    int id = blockIdx.x * blockDim.x + threadIdx.x;
    if (id >= NTOK * 128) return;
    int t = id / 128, j = id % 128;
    float acc = ba[j];
#pragma unroll
    for (int r = 0; r < 16; ++r) acc += proj[(size_t)t * N_IN + C_LA + r] * wa2[r * 128 + j];
    la[id] = logsigmoidf_(acc) * (1.f / 16.f);
}
__global__ void __launch_bounds__(64) k_gla_seq(const float* __restrict__ proj, const float* __restrict__ la, const float* __restrict__ og, float* __restrict__ mix) {
    int bh = blockIdx.x; int b = bh / H_GLA, h = bh % H_GLA; int e = threadIdx.x;
    float S[32];
#pragma unroll
    for (int d = 0; d < 32; ++d) S[d] = 0.f;
    const float qs = 0.17677669529663687f;
    for (int s = 0; s < SEQ; ++s) {
        size_t t = (size_t)b * SEQ + s;
        const float* qp = proj + t * N_IN + C_LQ + h * 32;
        const float* kp = proj + t * N_IN + C_LK + h * 32;
        const float* lp = la + t * 128 + h * 32;
        float v = proj[t * N_IN + C_LV + h * 64 + e];
        float o = 0.f;
#pragma unroll
        for (int d = 0; d < 32; ++d) { S[d] = S[d] * __expf(lp[d]) + kp[d] * v; o += qp[d] * qs * S[d]; }
        float ss = wave_sum(o * o);
        float r = rsqrtf(ss / 64.f + 1e-6f);
        float rr = proj[t * N_IN + C_LR + h * 64 + e];
        mix[t * D_MODEL + 768 + h * 64 + e] = o * r * og[e] * siluf_(rr);
    }
}

__global__ void k_router(const float* __restrict__ hn, const float* __restrict__ wrg, const float* __restrict__ brg, const float* __restrict__ wre, const float* __restrict__ bre,
                         int* __restrict__ eid, float* __restrict__ egate) {
    int t = blockIdx.x * 4 + (threadIdx.x >> 6);
    int lane = threadIdx.x & 63;
    if (t >= NTOK) return;
    const float* hp = hn + (size_t)t * D_MODEL;
    float lg[36];
#pragma unroll
    for (int j = 0; j < 36; ++j) lg[j] = 0.f;
    for (int i = 0; i < 16; ++i) {
        int k = lane + 64 * i; float hv = hp[k];
#pragma unroll
        for (int j = 0; j < 4; ++j) lg[j] += hv * wrg[k * 4 + j];
#pragma unroll
        for (int j = 0; j < 32; ++j) lg[4 + j] += hv * wre[k * 32 + j];
    }
#pragma unroll
    for (int j = 0; j < 36; ++j) lg[j] = wave_sum(lg[j]);
    if (lane == 0) {
        float gl[4]; float gm = -1e30f; int gi = 0;
#pragma unroll
        for (int j = 0; j < 4; ++j) { gl[j] = lg[j] + brg[j]; if (gl[j] > gm) { gm = gl[j]; gi = j; } }
        float gs = 0.f;
#pragma unroll
        for (int j = 0; j < 4; ++j) gs += __expf(gl[j] - gm);
        float gp = 1.f / gs;
        float el[8]; float em = -1e30f;
#pragma unroll
        for (int j = 0; j < 8; ++j) {
            float v = (gi == 0) ? lg[4 + j] : (gi == 1) ? lg[12 + j] : (gi == 2) ? lg[20 + j] : lg[28 + j];
            el[j] = v + bre[gi * 8 + j]; em = fmaxf(em, el[j]);
        }
        float es = 0.f;
#pragma unroll
        for (int j = 0; j < 8; ++j) { el[j] = __expf(el[j] - em); es += el[j]; }
        float v0 = -1.f, v1 = -1.f; int i0 = 0, i1 = 0;
#pragma unroll
        for (int j = 0; j < 8; ++j) {
            float v = el[j];
            if (v > v0) { v1 = v0; i1 = i0; v0 = v; i0 = j; }
            else if (v > v1) { v1 = v; i1 = j; }
        }
        float p0 = v0 / es, p1 = v1 / es;
        eid[t * 2] = gi * 8 + i0; eid[t * 2 + 1] = gi * 8 + i1;
        egate[t * 2] = gp * p0 / (p0 + p1); egate[t * 2 + 1] = gp * p1 / (p0 + p1);
    }
}
__global__ void __launch_bounds__(256) k_exp_hidden(const float* __restrict__ hn, const float* __restrict__ wg, const float* __restrict__ wu, const int* __restrict__ eid, float* __restrict__ H) {
    int tk = blockIdx.x; int t = tk >> 1;
    int e = eid[tk];
    __shared__ float hs[D_MODEL];
    for (int i = threadIdx.x; i < D_MODEL; i += 256) hs[i] = hn[(size_t)t * D_MODEL + i];
    __syncthreads();
    const float* wgp = wg + (size_t)e * D_MODEL * D_EXP;
    const float* wup = wu + (size_t)e * D_MODEL * D_EXP;
    for (int j = threadIdx.x; j < D_EXP; j += 256) {
        float g = 0.f, u = 0.f;
        for (int k = 0; k < D_MODEL; ++k) { float hv = hs[k]; g += hv * wgp[(size_t)k * D_EXP + j]; u += hv * wup[(size_t)k * D_EXP + j]; }
        H[(size_t)tk * D_EXP + j] = siluf_(g) * u;
    }
}
__global__ void __launch_bounds__(256) k_exp_down(const float* __restrict__ H, const float* __restrict__ wd, const int* __restrict__ eid, const float* __restrict__ egate, float* x) {
    int t = blockIdx.x;
    __shared__ float hs[2][D_EXP];
    for (int i = threadIdx.x; i < 2 * D_EXP; i += 256) hs[i / D_EXP][i % D_EXP] = H[(size_t)t * 2 * D_EXP + i];
    __syncthreads();
    int e0 = eid[t * 2], e1 = eid[t * 2 + 1]; float g0 = egate[t * 2], g1 = egate[t * 2 + 1];
    const float* w0 = wd + (size_t)e0 * D_EXP * D_MODEL;
    const float* w1 = wd + (size_t)e1 * D_EXP * D_MODEL;
    for (int c = threadIdx.x; c < D_MODEL; c += 256) {
        float a0 = 0.f, a1 = 0.f;
        for (int j = 0; j < D_EXP; ++j) { a0 += hs[0][j] * w0[(size_t)j * D_MODEL + c]; a1 += hs[1][j] * w1[(size_t)j * D_MODEL + c]; }
        x[(size_t)t * D_MODEL + c] += g0 * a0 + g1 * a1;
    }
}

extern "C" void kernel_launch(void* const* d_in, const int* in_sizes, int n_in,
                              void* d_out, int out_size, void* d_ws, size_t ws_size,
                              hipStream_t stream) {
    const float* x_in = (const float*)d_in[0];
    const float* attn_norm = (const float*)d_in[1];
    const float* w_in = (const float*)d_in[2];
    const float* fox_q_norm = (const float*)d_in[3];
    const float* fox_k_norm = (const float*)d_in[4];
    const float* fox_f_bias = (const float*)d_in[5];
    const float* fox_o_norm = (const float*)d_in[6];
    const float* gdn_conv = (const float*)d_in[7];
    const float* gdn_a_log = (const float*)d_in[8];
    const float* gdn_dt_bias = (const float*)d_in[9];
    const float* gdn_o_norm = (const float*)d_in[10];
    const float* gla_w_a2 = (const float*)d_in[11];
    const float* gla_b_a = (const float*)d_in[12];
    const float* gla_o_norm = (const float*)d_in[13];
    const float* w_out = (const float*)d_in[14];
    const float* ffn_norm = (const float*)d_in[15];
    const float* w_rg = (const float*)d_in[16];
    const float* b_rg = (const float*)d_in[17];
    const float* w_re = (const float*)d_in[18];
    const float* b_re = (const float*)d_in[19];
    const float* w_eg = (const float*)d_in[20];
    const float* w_eu = (const float*)d_in[21];
    const float* w_ed = (const float*)d_in[22];
    float* out = (float*)d_out;

    char* ws = (char*)d_ws;
    size_t off = 0;
    auto take = [&](size_t bytes) { char* p = ws + off; off += (bytes + 255) & ~(size_t)255; return p; };
    float* hn = (float*)take((size_t)NTOK * D_MODEL * 4);
    float* proj = (float*)take((size_t)NTOK * N_IN * 4);
    float* mix = (float*)take((size_t)NTOK * D_MODEL * 4);
    float* cum = (float*)take((size_t)BATCH * H_FOX * SEQ * 4);
    float* gq = (float*)take((size_t)NTOK * 1152 * 4);
    float* la = (float*)take((size_t)NTOK * 128 * 4);
    int* eid = (int*)take((size_t)NTOK * 2 * 4);
    float* egate = (float*)take((size_t)NTOK * 2 * 4);
    float* Hb = gq;
    if (off > ws_size) { fprintf(stderr, "ws too small: need %zu have %zu\n", off, ws_size); return; }

    for (int l = 0; l < 2; ++l) {
        const float* xin = (l == 0) ? x_in : out;
        k_rmsnorm<<<NTOK / 4, 256, 0, stream>>>(xin, attn_norm + l * D_MODEL, hn, NTOK);
        k_gemm<<<dim3((N_IN + 63) / 64, NTOK / 64), 256, 0, stream>>>(hn, w_in + (size_t)l * D_MODEL * N_IN, proj, nullptr, NTOK, N_IN, D_MODEL);
        k_fox_qknorm<<<NTOK * H_FOX * 2 / 4, 256, 0, stream>>>(proj, fox_q_norm + l * 64, fox_k_norm + l * 64);
        k_fox_cumsum<<<1, 64, 0, stream>>>(proj, fox_f_bias + l * H_FOX, cum);
        k_fox_attn<<<dim3(SEQ / 64, BATCH * H_FOX), 64, 0, stream>>>(proj, cum, fox_o_norm + l * 64, mix);
        k_gdn_prep<<<NTOK * 18 / 4, 256, 0, stream>>>(proj, gdn_conv + (size_t)l * 4 * 1152, gq);
        k_gdn_seq<<<BATCH * H_GDN, 64, 0, stream>>>(proj, gq, gdn_a_log + l * H_GDN, gdn_dt_bias + l * H_GDN, gdn_o_norm + l * 64, mix);
        k_gla_loga<<<NTOK * 128 / 256, 256, 0, stream>>>(proj, gla_w_a2 + (size_t)l * 16 * 128, gla_b_a + l * 128, la);
        k_gla_seq<<<BATCH * H_GLA, 64, 0, stream>>>(proj, la, gla_o_norm + l * 64, mix);
        k_gemm<<<dim3(D_MODEL / 64, NTOK / 64), 256, 0, stream>>>(mix, w_out + (size_t)l * D_MODEL * D_MODEL, out, xin, NTOK, D_MODEL, D_MODEL);
        k_rmsnorm<<<NTOK / 4, 256, 0, stream>>>(out, ffn_norm + l * D_MODEL, hn, NTOK);
        k_router<<<NTOK / 4, 256, 0, stream>>>(hn, w_rg + (size_t)l * D_MODEL * 4, b_rg + l * 4, w_re + (size_t)l * D_MODEL * 32, b_re + l * 32, eid, egate);
        k_exp_hidden<<<NTOK * 2, 256, 0, stream>>>(hn, w_eg + (size_t)l * N_EXP * D_MODEL * D_EXP, w_eu + (size_t)l * N_EXP * D_MODEL * D_EXP, eid, Hb);
        k_exp_down<<<NTOK, 256, 0, stream>>>(Hb, w_ed + (size_t)l * N_EXP * D_EXP * D_MODEL, eid, egate, out);
    }
}
```

```cpp
#include <hip/hip_runtime.h>
#include <hip/hip_cooperative_groups.h>
#include <cstdint>
#include <cstdio>
namespace cg = cooperative_groups;

#define D_MODEL 1024
#define BATCH 4
#define SEQ 4096
#define NTOK (BATCH * SEQ)
#define H_FOX 6
#define H_GDN 6
#define H_GLA 4
#define N_IN 3490
#define N_EXP 32
#define D_EXP 512
#define NPROJ 3456
#define NINP 3584

#define C_FF 1152
#define C_GQ 1158
#define C_GG 2310
#define C_GA 2694
#define C_GB 2700
#define C_LQ 2706
#define C_LA 3474
#define NC_FQ 0
#define NC_FK 384
#define NC_FV 768
#define NC_GQ 1152
#define NC_GK 1536
#define NC_GV 1920
#define NC_GG 2304
#define NC_LQ 2688
#define NC_LK 2816
#define NC_LV 2944
#define NC_LR 3200
#define AX_FF 0
#define AX_GA 6
#define AX_GB 12
#define AX_LA 18

#define NANMARK 1
#ifndef MIXSEL
#define MIXSEL 3
#endif
typedef unsigned short bf16_t;
typedef short bf16x8 __attribute__((ext_vector_type(8)));
typedef float f32x4 __attribute__((ext_vector_type(4)));
typedef unsigned u32x4 __attribute__((ext_vector_type(4)));

#define WS_CTL      0
#define CTL_BYTES   65536
#define WS_WIN      (WS_CTL + CTL_BYTES)
#define WS_WOUT     (WS_WIN + (size_t)2 * NINP * 1024 * 2)
#define WS_WGU      (WS_WOUT + (size_t)2 * 1024 * 1024 * 2)
#define WS_WD       (WS_WGU + (size_t)2 * 32 * 1024 * 1024 * 2)
#define WS_WR       (WS_WD + (size_t)2 * 32 * 1024 * 512 * 2)
#define WS_HN       (WS_WR + (size_t)2 * 64 * 1024 * 2)
#define WS_PROJ     (WS_HN + (size_t)NTOK * 1024 * 2)
#define WS_VTF      (WS_PROJ + (size_t)NTOK * NPROJ * 2)
#define WS_AUX      (WS_VTF + (size_t)BATCH * H_FOX * 64 * SEQ * 2)
#define WS_CUM      (WS_AUX + (size_t)NTOK * 64 * 4)
#define WS_MIX      (WS_CUM + (size_t)BATCH * H_FOX * SEQ * 4)
#define WS_ROWTOK   (WS_MIX + (size_t)NTOK * 1024 * 2)
#define WS_TSLOT    (WS_ROWTOK + (size_t)32 * NTOK * 4)
#define WS_TGATE    (WS_TSLOT + (size_t)NTOK * 2 * 4)
#define WS_SCR      (WS_TGATE + (size_t)NTOK * 2 * 4)
#define SCR_BYTES   ((size_t)100 * 1024 * 1024)
#define WS_END      (WS_SCR + SCR_BYTES)
#define HROWS       (2 * NTOK + 32 * 128)
#define WS_H        WS_PROJ
#define WS_Y        (WS_PROJ + (size_t)HROWS * 512 * 2)

#define NGDN_CH 1536
#define NGLA_CH 1024
#define SCR_GDN_MP   ((size_t)0)
#define SCR_GDN_NN   (SCR_GDN_MP + (size_t)NGDN_CH * 8192)
#define SCR_GDN_P    (SCR_GDN_NN + (size_t)NGDN_CH * 8192)
#define SCR_GDN_OL   (SCR_GDN_P  + (size_t)NGDN_CH * 8192)
#define SCR_GDN_SG   (SCR_GDN_OL + (size_t)NGDN_CH * 8192)
#define SCR_GDN_LAST (SCR_GDN_SG + (size_t)NGDN_CH * 8192)
#define SCR_GLA_OL   (SCR_GDN_LAST + (size_t)NGDN_CH * 4)
#define SCR_GLA_KV   (SCR_GLA_OL + (size_t)NGLA_CH * 8192)
#define SCR_GLA_QB   (SCR_GLA_KV + (size_t)NGLA_CH * 8192)
#define SCR_GLA_SG   (SCR_GLA_QB + (size_t)NGLA_CH * 4096)
#define SCR_GLA_DL   (SCR_GLA_SG + (size_t)NGLA_CH * 4096)
#define SCR_LVT      (SCR_GLA_DL + (size_t)NGLA_CH * 128)
#define SCR_USED     (SCR_LVT + (size_t)BATCH * H_GLA * 64 * SEQ * 2)
static_assert(SCR_USED <= SCR_BYTES, "scratch overflow");
#define CW_BAR      0
#define CW_CNT      4096
#define CW_Q        4224

struct Params {
    const float* in[23];
    float* out;
    char* ws;
};

__device__ __forceinline__ float sigmoidf_(float x) { return 1.f / (1.f + __expf(-x)); }
__device__ __forceinline__ float siluf_(float x) { return x / (1.f + __expf(-x)); }
__device__ __forceinline__ float softplusf_(float x) { return x > 20.f ? x : log1pf(__expf(x)); }
__device__ __forceinline__ float logsigmoidf_(float x) { return -softplusf_(-x); }
__device__ __forceinline__ float wave_sum(float v) {
#pragma unroll
    for (int o = 32; o > 0; o >>= 1) v += __shfl_xor(v, o, 64);
    return v;
}
__device__ __forceinline__ int ltid() { int t = threadIdx.x; asm volatile("" : "+v"(t)); return t; }
typedef __bf16 bf16x2_t __attribute__((ext_vector_type(2)));
typedef float f32x2_t __attribute__((ext_vector_type(2)));
__device__ __forceinline__ unsigned pk_bf16(float lo, float hi) { f32x2_t v = {lo, hi}; bf16x2_t r = __builtin_convertvector(v, bf16x2_t); return __builtin_bit_cast(unsigned, r); }
__device__ __forceinline__ float bf2f(bf16_t v) { return __uint_as_float((unsigned)v << 16); }
__device__ __forceinline__ float bflo(unsigned v) { return __uint_as_float(v << 16); }
__device__ __forceinline__ float bfhi(unsigned v) { return __uint_as_float(v & 0xffff0000u); }

#define XB_TMO      128
#define XB_XCNT(j)  (256  + 64 * (j))
#define XB_XSUB(j)  (1280 + 64 * (j))
#define XB_XGEN(j)  (2304 + 64 * (j))
#define XB_TOP      3328
#define XB_TOPGEN   3392
#define XCD_BAR_WORDS 3456
#define XB_SPIN_CAP (1u << 22)
#define LAS __attribute__((address_space(3)))
__device__ __forceinline__ unsigned xb_ld(unsigned* p)              { return __hip_atomic_load(p, __ATOMIC_RELAXED, __HIP_MEMORY_SCOPE_AGENT); }
__device__ __forceinline__ unsigned xb_add(unsigned* p, unsigned v) { return __hip_atomic_fetch_add(p, v, __ATOMIC_RELAXED, __HIP_MEMORY_SCOPE_AGENT); }
__device__ __forceinline__ unsigned xb_xcc_id() { return (unsigned)__builtin_amdgcn_s_getreg((3 << 11) | 20) & 0xFu; }
#define XB_SPIN(cond, bar) do { unsigned _sp = 0; while (cond) { __builtin_amdgcn_s_sleep(1); \
    if ((++_sp & 255u) == 0u) { if (xb_ld(&(bar)[XB_TMO])) break; if (_sp > XB_SPIN_CAP) { atomicAdd(&(bar)[XB_TMO], 1u); break; } } } } while (0)
struct XcdBarrier { unsigned* bar; unsigned x; volatile LAS unsigned* st; };
__device__ __forceinline__ XcdBarrier xcd_barrier_post(unsigned* bar, volatile LAS unsigned* st) {
    XcdBarrier b; b.bar = bar; b.x = xb_xcc_id(); b.st = st;
    if (threadIdx.x == 0) (void)xb_add(&bar[XB_XCNT(b.x)], 1u);
    return b;
}
__device__ __forceinline__ void xcd_barrier_complete(unsigned* bar, unsigned x, unsigned& nloc, unsigned& nx) {
    const unsigned G = gridDim.x * gridDim.y * gridDim.z;
    unsigned sum, cnt, mine, sp = 0u;
    for (;;) {
        sum = 0u; cnt = 0u; mine = 0u;
#pragma unroll
        for (unsigned j = 0; j < 16; ++j) { const unsigned c = xb_ld(&bar[XB_XCNT(j)]); sum += c; cnt += (c > 0u) ? 1u : 0u; mine = (j == x) ? c : mine; }
        if (sum == G) break;
        __builtin_amdgcn_s_sleep(1);
        if ((++sp & 255u) == 0u) { if (xb_ld(&bar[XB_TMO])) break; if (sp > XB_SPIN_CAP) { atomicAdd(&bar[XB_TMO], 1u); break; } }
    }
    nloc = mine > 0u ? mine : 1u; nx = cnt > 0u ? cnt : 1u;
}
__device__ __forceinline__ void xcd_barrier(const XcdBarrier& b) {
    asm volatile("s_waitcnt vmcnt(0)" ::: "memory");
    __syncthreads();
    if (threadIdx.x == 0) {
        unsigned* bar = b.bar;
        __builtin_amdgcn_s_waitcnt(0);
        unsigned nloc = b.st[0], nx = b.st[1];
        if (nloc == 0u) { xcd_barrier_complete(bar, b.x, nloc, nx); b.st[0] = nloc; b.st[1] = nx; }
        const unsigned old = xb_add(&bar[XB_XSUB(b.x)], 1u);
        const unsigned gen = old / nloc;
        if (old + 1u == (gen + 1u) * nloc) {
            __builtin_amdgcn_fence(__ATOMIC_RELEASE, "agent");
            asm volatile("s_waitcnt vmcnt(0)" ::: "memory");
            const unsigned og = xb_add(&bar[XB_TOP], 1u);
            const unsigned tg = og / nx;
            if (og + 1u == (tg + 1u) * nx) xb_add(&bar[XB_TOPGEN], 1u);
            else XB_SPIN(xb_ld(&bar[XB_TOPGEN]) == tg, bar);
            __builtin_amdgcn_fence(__ATOMIC_ACQUIRE, "agent");
            xb_add(&bar[XB_XGEN(b.x)], 1u);
            asm volatile("s_waitcnt vmcnt(0)" ::: "memory");
        } else {
            XB_SPIN(xb_ld(&bar[XB_XGEN(b.x)]) == gen, bar);
            __builtin_amdgcn_fence(__ATOMIC_ACQUIRE, "agent");
            asm volatile("s_waitcnt vmcnt(0)" ::: "memory");
        }
    }
    __syncthreads();
}

#define LDS_BYTES 57344
#define LROW 72

__device__ __forceinline__ int inproj_map(int n) {
    if (n < 1152) return n;
    if (n < 2304) return C_GQ + (n - 1152);
    if (n < 2688) return C_GG + (n - 2304);
    if (n < 3456) return C_LQ + (n - 2688);
    if (n < 3462) return C_FF + (n - 3456);
    if (n < 3468) return C_GA + (n - 3462);
    if (n < 3474) return C_GB + (n - 3468);
    if (n < 3490) return n;
    return -1;
}
__device__ __forceinline__ void conv_tile(const float* __restrict__ src, int ld, int col, bf16_t* __restrict__ dst_row, int k0) {
    float v[16];
    if (col >= 0) {
#pragma unroll
        for (int i = 0; i < 16; ++i) v[i] = src[(size_t)(k0 + i) * ld + col];
    } else {
#pragma unroll
        for (int i = 0; i < 16; ++i) v[i] = 0.f;
    }
    uint4 o0, o1;
    o0.x = pk_bf16(v[0], v[1]); o0.y = pk_bf16(v[2], v[3]); o0.z = pk_bf16(v[4], v[5]); o0.w = pk_bf16(v[6], v[7]);
    o1.x = pk_bf16(v[8], v[9]); o1.y = pk_bf16(v[10], v[11]); o1.z = pk_bf16(v[12], v[13]); o1.w = pk_bf16(v[14], v[15]);
    *(uint4*)(dst_row + k0) = o0;
    *(uint4*)(dst_row + k0 + 8) = o1;
}
#define P0_T_IN   (56 * 16)
#define P0_T_OUT  (16 * 16)
#define P0_T_GU   (32 * 16 * 16)
#define P0_T_D    (32 * 16 * 8)
#define P0_T_R    (16)
#define P0_T_LAYER (P0_T_IN + P0_T_OUT + P0_T_GU + P0_T_D + P0_T_R)
#define P0_T_NORM (NTOK / 4)
__device__ void phase0(const Params& p) {
    const int tid = ltid(), nl = tid & 63, kg = tid >> 6;
    const int total = 2 * P0_T_LAYER + P0_T_NORM;
    for (int it = blockIdx.x; it < total; it += gridDim.x) {
        if (it >= 2 * P0_T_LAYER) {
            int row = (it - 2 * P0_T_LAYER) * 4 + kg;
            const float* xr = p.in[0] + (size_t)row * D_MODEL + nl * 16;
            const float* gr = p.in[1] + nl * 16;
            float v[16]; float ss = 0.f;
#pragma unroll
            for (int i = 0; i < 4; ++i) { float4 t = *(const float4*)(xr + 4 * i); v[4 * i] = t.x; v[4 * i + 1] = t.y; v[4 * i + 2] = t.z; v[4 * i + 3] = t.w; }
#pragma unroll
            for (int i = 0; i < 16; ++i) ss += v[i] * v[i];
            ss = wave_sum(ss);
            float r = rsqrtf(ss / D_MODEL + 1e-6f);
#pragma unroll
            for (int i = 0; i < 16; ++i) v[i] = v[i] * r * gr[i];
            uint4 o0, o1;
            o0.x = pk_bf16(v[0], v[1]); o0.y = pk_bf16(v[2], v[3]); o0.z = pk_bf16(v[4], v[5]); o0.w = pk_bf16(v[6], v[7]);
            o1.x = pk_bf16(v[8], v[9]); o1.y = pk_bf16(v[10], v[11]); o1.z = pk_bf16(v[12], v[13]); o1.w = pk_bf16(v[14], v[15]);
            bf16_t* hr = (bf16_t*)(p.ws + WS_HN) + (size_t)row * D_MODEL + nl * 16;
            *(uint4*)hr = o0; *(uint4*)(hr + 8) = o1;
            continue;
        }
        int l = it / P0_T_LAYER, j = it % P0_T_LAYER;
        if (j < P0_T_IN) {
            int tn = j / 16, tk = j % 16; int n = tn * 64 + nl;
            conv_tile(p.in[2] + (size_t)l * 1024 * N_IN, N_IN, inproj_map(n), (bf16_t*)(p.ws + WS_WIN) + ((size_t)l * NINP + n) * 1024, tk * 64 + kg * 16);
            continue;
        }
        j -= P0_T_IN;
        if (j < P0_T_OUT) {
            int tn = j / 16, tk = j % 16; int n = tn * 64 + nl;
            conv_tile(p.in[14] + (size_t)l * 1024 * 1024, 1024, n, (bf16_t*)(p.ws + WS_WOUT) + ((size_t)l * 1024 + n) * 1024, tk * 64 + kg * 16);
            continue;
        }
        j -= P0_T_OUT;
        if (j < P0_T_GU) {
            int e = j / 256, r = j % 256; int tn = r / 16, tk = r % 16; int n = tn * 64 + nl;
            int t128 = n >> 7, wx = (n >> 6) & 1, half = (n >> 5) & 1, jj = n & 31;
            int hid = t128 * 64 + wx * 32 + jj;
            const float* src = (half ? p.in[21] : p.in[20]) + ((size_t)l * 32 + e) * 1024 * 512;
            conv_tile(src, 512, hid, (bf16_t*)(p.ws + WS_WGU) + (((size_t)l * 32 + e) * 1024 + n) * 1024, tk * 64 + kg * 16);
            continue;
        }
        j -= P0_T_GU;
        if (j < P0_T_D) {
            int e = j / 128, r = j % 128; int tn = r / 8, tk = r % 8; int n = tn * 64 + nl;
            const float* src = p.in[22] + ((size_t)l * 32 + e) * 512 * 1024;
            conv_tile(src, 1024, n, (bf16_t*)(p.ws + WS_WD) + (((size_t)l * 32 + e) * 1024 + n) * 512, tk * 64 + kg * 16);
            continue;
        }
        j -= P0_T_D;
        {
            int tk = j; int n = nl;
            const float* src; int ld, col;
            if (n < 4) { src = p.in[16] + (size_t)l * 1024 * 4; ld = 4; col = n; }
            else if (n < 36) { src = p.in[18] + (size_t)l * 1024 * 32; ld = 32; col = n - 4; }
            else { src = p.in[16]; ld = 4; col = -1; }
            conv_tile(src, ld, col, (bf16_t*)(p.ws + WS_WR) + ((size_t)l * 64 + n) * 1024, tk * 64 + kg * 16);
        }
    }
}

__device__ __forceinline__ void gemm_core(const bf16_t* const (&px)[4], const bf16_t* const (&py)[4], int K, bf16_t* lds, f32x4 (&acc)[4][4]) {
    const int tid = ltid(), lane = tid & 63, w = tid >> 6, wx = w >> 1, wy = w & 1;
    bf16_t* Xs = lds; bf16_t* Ys = lds + 128 * LROW;
#pragma unroll
    for (int a = 0; a < 4; ++a)
#pragma unroll
        for (int b = 0; b < 4; ++b) acc[a][b] = (f32x4){0.f, 0.f, 0.f, 0.f};
    u32x4 rx[4], ry[4];
#pragma unroll
    for (int i = 0; i < 4; ++i) { rx[i] = *(const u32x4*)(px[i]); ry[i] = *(const u32x4*)(py[i]); }
    const int fr = lane & 15, fg = lane >> 4;
    for (int k0 = 0; k0 < K; k0 += 64) {
        __syncthreads();
#pragma unroll
        for (int i = 0; i < 4; ++i) {
            int c = tid + 256 * i; int row = c >> 3, kc = c & 7;
            *(u32x4*)(Xs + row * LROW + kc * 8) = rx[i];
            *(u32x4*)(Ys + row * LROW + kc * 8) = ry[i];
        }
        __syncthreads();
        if (k0 + 64 < K) {
#pragma unroll
            for (int i = 0; i < 4; ++i) { rx[i] = *(const u32x4*)(px[i] + k0 + 64); ry[i] = *(const u32x4*)(py[i] + k0 + 64); }
        }
#pragma unroll
        for (int ks = 0; ks < 2; ++ks) {
            bf16x8 xa[4], yb[4];
#pragma unroll
            for (int m = 0; m < 4; ++m) xa[m] = *(const bf16x8*)(Xs + (wx * 64 + m * 16 + fr) * LROW + ks * 32 + fg * 8);
#pragma unroll
            for (int n = 0; n < 4; ++n) yb[n] = *(const bf16x8*)(Ys + (wy * 64 + n * 16 + fr) * LROW + ks * 32 + fg * 8);
#pragma unroll
            for (int m = 0; m < 4; ++m)
#pragma unroll
                for (int n = 0; n < 4; ++n) acc[m][n] = __builtin_amdgcn_mfma_f32_16x16x32_bf16(xa[m], yb[n], acc[m][n], 0, 0, 0);
        }
    }
}
__device__ __forceinline__ void store4_bf16(bf16_t* p, float a, float b, float c, float d) {
    uint2 o; o.x = pk_bf16(a, b); o.y = pk_bf16(c, d); *(uint2*)p = o;
}

__device__ __forceinline__ bool xcd_item(int round, int ntm, int ntn, int& tm, int& tn) {
    const int x = blockIdx.x & 7, loc = blockIdx.x >> 3, nloc = gridDim.x >> 3;
    const int tmx = ntm >> 3;
    const int j = round * nloc + loc;
    if (j >= tmx * ntn) return false;
    tn = j / tmx; tm = (j % tmx) * 8 + x;
    return true;
}

__device__ void phase_inproj(const Params& p, int l, bf16_t* lds) {
    const int tid = ltid(), lane = tid & 63, w = tid >> 6, wx = w >> 1, wy = w & 1, fr = lane & 15, fg = lane >> 4;
    const bf16_t* hn = (const bf16_t*)(p.ws + WS_HN);
    const bf16_t* wt = (const bf16_t*)(p.ws + WS_WIN) + (size_t)l * NINP * 1024;
    bf16_t* proj = (bf16_t*)(p.ws + WS_PROJ);
    bf16_t* vtf = (bf16_t*)(p.ws + WS_VTF);
    float* aux = (float*)(p.ws + WS_AUX);
    const float* qg = p.in[3] + l * 64; const float* kg = p.in[4] + l * 64;
    for (int round = 0;; ++round) {
        int tm, tn;
        if (!xcd_item(round, NTOK / 128, NINP / 128, tm, tn)) break;
        const bool vt = (tn >= 6 && tn < 9) || tn == 23 || tn == 24;
        const bf16_t* px[4]; const bf16_t* py[4];
#pragma unroll
        for (int i = 0; i < 4; ++i) {
            int c = tid + 256 * i; int row = c >> 3, kc = c & 7;
            const bf16_t* pw = wt + (size_t)(tn * 128 + row) * 1024 + kc * 8;
            const bf16_t* pt = hn + (size_t)(tm * 128 + row) * 1024 + kc * 8;
            px[i] = vt ? pt : pw; py[i] = vt ? pw : pt;
        }
        f32x4 acc[4][4];
        gemm_core(px, py, 1024, lds, acc);
        if (vt) {
#pragma unroll
            for (int n = 0; n < 4; ++n) {
                const bool fox = tn < 9;
                int ch = tn * 128 + wy * 64 + n * 16 + fr - (fox ? NC_FV : NC_LV); int h = ch >> 6, e = ch & 63;
                bf16_t* dst = fox ? vtf : (bf16_t*)(p.ws + WS_SCR + SCR_LVT); const int nh = fox ? H_FOX : H_GLA;
#pragma unroll
                for (int m = 0; m < 4; ++m) {
                    int t = tm * 128 + wx * 64 + m * 16 + 4 * fg; int b = t / SEQ, s = t % SEQ;
                    store4_bf16(dst + ((size_t)(b * nh + h) * 64 + e) * SEQ + s, acc[m][n][0], acc[m][n][1], acc[m][n][2], acc[m][n][3]);
                }
            }
        } else {
            const int c0 = tn * 128 + wx * 64;
            if (tn < 6) {
                const float* gn = (tn < 3) ? qg : kg; const float sc = (tn < 3) ? 0.125f : 1.f;
                float g[4][4];
#pragma unroll
                for (int m = 0; m < 4; ++m)
#pragma unroll
                    for (int r = 0; r < 4; ++r) g[m][r] = gn[m * 16 + 4 * fg + r] * sc;
#pragma unroll
                for (int n = 0; n < 4; ++n) {
                    float ss = 0.f;
#pragma unroll
                    for (int m = 0; m < 4; ++m)
#pragma unroll
                        for (int r = 0; r < 4; ++r) ss += acc[m][n][r] * acc[m][n][r];
                    ss += __shfl_xor(ss, 16, 64); ss += __shfl_xor(ss, 32, 64);
                    float rs = rsqrtf(ss * (1.f / 64.f) + 1e-6f);
                    int t = tm * 128 + wy * 64 + n * 16 + fr;
#pragma unroll
                    for (int m = 0; m < 4; ++m)
                        store4_bf16(proj + (size_t)t * NPROJ + c0 + m * 16 + 4 * fg, acc[m][n][0] * rs * g[m][0], acc[m][n][1] * rs * g[m][1], acc[m][n][2] * rs * g[m][2], acc[m][n][3] * rs * g[m][3]);
                }
            } else if (tn == 27) {
#pragma unroll
                for (int n = 0; n < 4; ++n) {
                    int t = tm * 128 + wy * 64 + n * 16 + fr;
#pragma unroll
                    for (int m = 0; m < 4; ++m) {
                        int c = wx * 64 + m * 16 + 4 * fg;
                        if (c < 64) *(float4*)(aux + (size_t)t * 64 + c) = make_float4(acc[m][n][0], acc[m][n][1], acc[m][n][2], acc[m][n][3]);
                    }
                }
            } else {
                const bool do_silu = (tn >= 18 && tn < 21) || (tn >= 25);
                const float sc = (tn == 21) ? 0.17677669529663687f : 1.f;
#pragma unroll
                for (int n = 0; n < 4; ++n) {
                    int t = tm * 128 + wy * 64 + n * 16 + fr;
#pragma unroll
                    for (int m = 0; m < 4; ++m) {
                        float v0 = acc[m][n][0] * sc, v1 = acc[m][n][1] * sc, v2 = acc[m][n][2] * sc, v3 = acc[m][n][3] * sc;
                        if (do_silu) { v0 = siluf_(v0); v1 = siluf_(v1); v2 = siluf_(v2); v3 = siluf_(v3); }
                        store4_bf16(proj + (size_t)t * NPROJ + c0 + m * 16 + 4 * fg, v0, v1, v2, v3);
                    }
                }
            }
        }
    }
}

__device__ void phase_outproj(const Params& p, int l, bf16_t* lds) {
    const int tid = ltid(), lane = tid & 63, w = tid >> 6, wx = w >> 1, wy = w & 1, fr = lane & 15, fg = lane >> 4;
    const bf16_t* mix = (const bf16_t*)(p.ws + WS_MIX);
    const bf16_t* wt = (const bf16_t*)(p.ws + WS_WOUT) + (size_t)l * 1024 * 1024;
    const float* xin = (l == 0) ? p.in[0] : p.out;
    float* xo = p.out;
    for (int round = 0;; ++round) {
        int tm, tn;
        if (!xcd_item(round, NTOK / 128, 8, tm, tn)) break;
        const bf16_t* px[4]; const bf16_t* py[4];
#pragma unroll
        for (int i = 0; i < 4; ++i) {
            int c = tid + 256 * i; int row = c >> 3, kc = c & 7;
            px[i] = wt + (size_t)(tn * 128 + row) * 1024 + kc * 8;
            py[i] = mix + (size_t)(tm * 128 + row) * 1024 + kc * 8;
        }
        f32x4 acc[4][4];
        gemm_core(px, py, 1024, lds, acc);
#pragma unroll
        for (int n = 0; n < 4; ++n) {
            int t = tm * 128 + wy * 64 + n * 16 + fr;
#pragma unroll
            for (int m = 0; m < 4; ++m) {
                int c = tn * 128 + wx * 64 + m * 16 + 4 * fg;
                float4 xv = *(const float4*)(xin + (size_t)t * 1024 + c);
                xv.x += acc[m][n][0]; xv.y += acc[m][n][1]; xv.z += acc[m][n][2]; xv.w += acc[m][n][3];
                *(float4*)(xo + (size_t)t * 1024 + c) = xv;
            }
        }
    }
}

__device__ void phase_route(const Params& p, int l, bf16_t* lds) {
    const int tid = ltid(), lane = tid & 63, w = tid >> 6, fr = lane & 15, fg = lane >> 4;
    const float* x1 = p.out;
    const float* gain = p.in[15] + l * 1024;
    bf16_t* hn = (bf16_t*)(p.ws + WS_HN);
    const bf16_t* wr = (const bf16_t*)(p.ws + WS_WR) + (size_t)l * 64 * 1024;
    const float* brg = p.in[17] + l * 4; const float* bre = p.in[19] + l * 32;
    unsigned* cnt = (unsigned*)(p.ws + WS_CTL) + CW_CNT + l * 32;
    int* rowtok = (int*)(p.ws + WS_ROWTOK);
    int* tslot = (int*)(p.ws + WS_TSLOT);
    float* tgate = (float*)(p.ws + WS_TGATE);
    const int HL = 1032;
    float* red = (float*)(lds + 16 * HL);
    for (int it = blockIdx.x; it < NTOK / 16; it += gridDim.x) {
        __syncthreads();
#pragma unroll
        for (int rr = 0; rr < 4; ++rr) {
            int lr = w * 4 + rr; int t = it * 16 + lr;
            const float* xr = x1 + (size_t)t * 1024 + lane * 16;
            float v[16]; float ss = 0.f;
#pragma unroll
            for (int i = 0; i < 4; ++i) { float4 q = *(const float4*)(xr + 4 * i); v[4 * i] = q.x; v[4 * i + 1] = q.y; v[4 * i + 2] = q.z; v[4 * i + 3] = q.w; }
#pragma unroll
            for (int i = 0; i < 16; ++i) ss += v[i] * v[i];
            ss = wave_sum(ss);
            float r = rsqrtf(ss / D_MODEL + 1e-6f);
#pragma unroll
            for (int i = 0; i < 16; ++i) v[i] = v[i] * r * gain[lane * 16 + i];
            uint4 o0, o1;
            o0.x = pk_bf16(v[0], v[1]); o0.y = pk_bf16(v[2], v[3]); o0.z = pk_bf16(v[4], v[5]); o0.w = pk_bf16(v[6], v[7]);
            o1.x = pk_bf16(v[8], v[9]); o1.y = pk_bf16(v[10], v[11]); o1.z = pk_bf16(v[12], v[13]); o1.w = pk_bf16(v[14], v[15]);
            bf16_t* hr = hn + (size_t)t * 1024 + lane * 16;
            *(uint4*)hr = o0; *(uint4*)(hr + 8) = o1;
            *(uint4*)(lds + lr * HL + lane * 16) = o0; *(uint4*)(lds + lr * HL + lane * 16 + 8) = o1;
        }
        __syncthreads();
        f32x4 acc[3];
#pragma unroll
        for (int n = 0; n < 3; ++n) acc[n] = (f32x4){0.f, 0.f, 0.f, 0.f};
#pragma unroll
        for (int ks = 0; ks < 8; ++ks) {
            int k = w * 256 + ks * 32 + fg * 8;
            bf16x8 a = *(const bf16x8*)(lds + fr * HL + k);
#pragma unroll
            for (int n = 0; n < 3; ++n) {
                bf16x8 b = *(const bf16x8*)(wr + (size_t)(n * 16 + fr) * 1024 + k);
                acc[n] = __builtin_amdgcn_mfma_f32_16x16x32_bf16(a, b, acc[n], 0, 0, 0);
            }
        }
#pragma unroll
        for (int n = 0; n < 3; ++n) *(f32x4*)(red + ((w * 3 + n) * 64 + lane) * 4) = acc[n];
        __syncthreads();
        if (tid < 16) {
            float lg[36];
#pragma unroll
            for (int j = 0; j < 36; ++j) {
                int n = j >> 4, f = j & 15; int ln = (tid >> 2) * 16 + f; float s = 0.f;
#pragma unroll
                for (int ww = 0; ww < 4; ++ww) s += red[((ww * 3 + n) * 64 + ln) * 4 + (tid & 3)];
                lg[j] = s;
            }
            float gl[4]; float gm = -1e30f; int gi = 0;
#pragma unroll
            for (int j = 0; j < 4; ++j) { gl[j] = lg[j] + brg[j]; if (gl[j] > gm) { gm = gl[j]; gi = j; } }
            float gs = 0.f;
#pragma unroll
            for (int j = 0; j < 4; ++j) gs += __expf(gl[j] - gm);
            float gp = 1.f / gs;
            float el[8]; float em = -1e30f;
#pragma unroll
            for (int j = 0; j < 8; ++j) {
                float v = (gi == 0) ? lg[4 + j] : (gi == 1) ? lg[12 + j] : (gi == 2) ? lg[20 + j] : lg[28 + j];
                el[j] = v + bre[gi * 8 + j]; em = fmaxf(em, el[j]);
            }
#pragma unroll
            for (int j = 0; j < 8; ++j) el[j] = __expf(el[j] - em);
            float v0 = -1.f, v1 = -1.f; int i0 = 0, i1 = 0;
#pragma unroll
            for (int j = 0; j < 8; ++j) {
                float v = el[j];
                if (v > v0) { v1 = v0; i1 = i0; v0 = v; i0 = j; }
                else if (v > v1) { v1 = v; i1 = j; }
            }
            int t = it * 16 + tid;
            int e0 = gi * 8 + i0, e1 = gi * 8 + i1;
            unsigned s0 = atomicAdd(&cnt[e0], 1u), s1 = atomicAdd(&cnt[e1], 1u);
            rowtok[(size_t)e0 * NTOK + s0] = t; rowtok[(size_t)e1 * NTOK + s1] = t;
            tslot[t * 2] = (e0 << 16) | (int)s0; tslot[t * 2 + 1] = (e1 << 16) | (int)s1;
            tgate[t * 2] = gp * v0 / (v0 + v1); tgate[t * 2 + 1] = gp * v1 / (v0 + v1);
        }
    }
}

__device__ __forceinline__ void moe_tables(const unsigned* cnt, int* tab) {
    if (threadIdx.x == 0) {
        int a = 0;
        for (int e = 0; e < 32; ++e) { tab[e] = a; tab[40 + e] = a * 128; a += ((int)cnt[e] + 127) >> 7; }
        tab[32] = a; tab[72] = a * 128;
    }
    __syncthreads();
}
template <int MODE>
__device__ void phase_expert(const Params& p, int l, bf16_t* lds) {
    const int tid = ltid(), lane = tid & 63, w = tid >> 6, wx = w >> 1, wy = w & 1, fr = lane & 15, fg = lane >> 4;
    const unsigned* cnt = (const unsigned*)(p.ws + WS_CTL) + CW_CNT + l * 32;
    int* tab = (int*)(lds + 2 * 128 * LROW);
    moe_tables(cnt, tab);
    const int* rowtok = (const int*)(p.ws + WS_ROWTOK);
    const bf16_t* hn = (const bf16_t*)(p.ws + WS_HN);
    bf16_t* Hb = (bf16_t*)(p.ws + WS_H);
    bf16_t* Yb = (bf16_t*)(p.ws + WS_Y);
    const int x = blockIdx.x & 7, loc = blockIdx.x >> 3, nloc = gridDim.x >> 3;
    for (int j = loc;; j += nloc) {
        int e = -1, rt = 0, tn = 0; int jj = j;
#pragma unroll
        for (int q = 0; q < 4; ++q) {
            int ee = q * 8 + x; int nrt = tab[ee + 1] - tab[ee];
            if (e < 0) { if (jj < nrt * 8) { e = ee; tn = jj / nrt; rt = jj % nrt; } else jj -= nrt * 8; }
        }
        if (e < 0) break;
        const int c_e = (int)cnt[e]; const int hrow0 = tab[40 + e] + rt * 128;
        const bf16_t* px[4]; const bf16_t* py[4];
#pragma unroll
        for (int i = 0; i < 4; ++i) {
            int c = tid + 256 * i; int row = c >> 3, kc = c & 7;
            if (MODE == 0) {
                px[i] = (const bf16_t*)(p.ws + WS_WGU) + (((size_t)l * 32 + e) * 1024 + tn * 128 + row) * 1024 + kc * 8;
                int s = rt * 128 + row; int t = (s < c_e) ? rowtok[(size_t)e * NTOK + s] : 0;
                py[i] = hn + (size_t)t * 1024 + kc * 8;
            } else {
                px[i] = (const bf16_t*)(p.ws + WS_WD) + (((size_t)l * 32 + e) * 1024 + tn * 128 + row) * 512 + kc * 8;
                py[i] = Hb + (size_t)(hrow0 + row) * 512 + kc * 8;
            }
        }
        f32x4 acc[4][4];
        gemm_core(px, py, MODE == 0 ? 1024 : 512, lds, acc);
        if (MODE == 0) {
#pragma unroll
            for (int n = 0; n < 4; ++n) {
                int hr = hrow0 + wy * 64 + n * 16 + fr;
#pragma unroll
                for (int m = 0; m < 2; ++m) {
                    int hc = tn * 64 + wx * 32 + m * 16 + 4 * fg;
                    store4_bf16(Hb + (size_t)hr * 512 + hc, siluf_(acc[m][n][0]) * acc[m + 2][n][0], siluf_(acc[m][n][1]) * acc[m + 2][n][1],
                                siluf_(acc[m][n][2]) * acc[m + 2][n][2], siluf_(acc[m][n][3]) * acc[m + 2][n][3]);
                }
            }
        } else {
#pragma unroll
            for (int n = 0; n < 4; ++n) {
                int hr = hrow0 + wy * 64 + n * 16 + fr;
#pragma unroll
                for (int m = 0; m < 4; ++m) {
                    int c = tn * 128 + wx * 64 + m * 16 + 4 * fg;
                    store4_bf16(Yb + (size_t)hr * 1024 + c, acc[m][n][0], acc[m][n][1], acc[m][n][2], acc[m][n][3]);
                }
            }
        }
    }
}

__device__ void phase_combine(const Params& p, int l) {
    const int tid = ltid(), lane = tid & 63, w = tid >> 6;
    const unsigned* cnt = (const unsigned*)(p.ws + WS_CTL) + CW_CNT + l * 32;
    int c = (lane < 32) ? (((int)cnt[lane] + 127) >> 7) * 128 : 0;
    int incl = c;
#pragma unroll
    for (int o = 1; o < 32; o <<= 1) { int v = __shfl_up(incl, o, 64); if (lane >= o) incl += v; }
    int hoff = incl - c;
    const int* tslot = (const int*)(p.ws + WS_TSLOT);
    const float* tgate = (const float*)(p.ws + WS_TGATE);
    const bf16_t* Yb = (const bf16_t*)(p.ws + WS_Y);
    bf16_t* hn = (bf16_t*)(p.ws + WS_HN);
    float* x = p.out;
    const float* gain = (l == 0) ? p.in[1] + 1024 : nullptr;
    for (int it = blockIdx.x; it < NTOK / 4; it += gridDim.x) {
        int t = it * 4 + w;
        int ts0 = tslot[t * 2], ts1 = tslot[t * 2 + 1];
        float g0 = tgate[t * 2], g1 = tgate[t * 2 + 1];
        int r0 = __shfl(hoff, ts0 >> 16, 64) + (ts0 & 0xffff);
        int r1 = __shfl(hoff, ts1 >> 16, 64) + (ts1 & 0xffff);
        float* xr = x + (size_t)t * 1024 + lane * 16;
        const bf16_t* y0 = Yb + (size_t)r0 * 1024 + lane * 16;
        const bf16_t* y1 = Yb + (size_t)r1 * 1024 + lane * 16;
        float v[16];
#pragma unroll
        for (int i = 0; i < 4; ++i) { float4 q = *(const float4*)(xr + 4 * i); v[4 * i] = q.x; v[4 * i + 1] = q.y; v[4 * i + 2] = q.z; v[4 * i + 3] = q.w; }
        uint4 a0 = *(const uint4*)y0, a1 = *(const uint4*)(y0 + 8), b0 = *(const uint4*)y1, b1 = *(const uint4*)(y1 + 8);
        unsigned ya[8] = {a0.x, a0.y, a0.z, a0.w, a1.x, a1.y, a1.z, a1.w};
        unsigned yb[8] = {b0.x, b0.y, b0.z, b0.w, b1.x, b1.y, b1.z, b1.w};
#pragma unroll
        for (int i = 0; i < 8; ++i) {
            v[2 * i] += g0 * bflo(ya[i]) + g1 * bflo(yb[i]);
            v[2 * i + 1] += g0 * bfhi(ya[i]) + g1 * bfhi(yb[i]);
        }
#ifdef NANMARK
#pragma unroll
        for (int i = 0; i < 16; ++i) if (!(fabsf(v[i]) < 1e30f)) v[i] = 1000.f;
#endif
#pragma unroll
        for (int i = 0; i < 4; ++i) *(float4*)(xr + 4 * i) = make_float4(v[4 * i], v[4 * i + 1], v[4 * i + 2], v[4 * i + 3]);
        if (gain) {
            float ss = 0.f;
#pragma unroll
            for (int i = 0; i < 16; ++i) ss += v[i] * v[i];
            ss = wave_sum(ss);
            float r = rsqrtf(ss / D_MODEL + 1e-6f);
#pragma unroll
            for (int i = 0; i < 16; ++i) v[i] = v[i] * r * gain[lane * 16 + i];
            uint4 o0, o1;
            o0.x = pk_bf16(v[0], v[1]); o0.y = pk_bf16(v[2], v[3]); o0.z = pk_bf16(v[4], v[5]); o0.w = pk_bf16(v[6], v[7]);
            o1.x = pk_bf16(v[8], v[9]); o1.y = pk_bf16(v[10], v[11]); o1.z = pk_bf16(v[12], v[13]); o1.w = pk_bf16(v[14], v[15]);
            bf16_t* hr = hn + (size_t)t * 1024 + lane * 16;
            *(uint4*)hr = o0; *(uint4*)(hr + 8) = o1;
        }
    }
}


__device__ __forceinline__ void mm_row(const bf16_t* RA, const bf16_t* RB, int mw, int fr, int fg, f32x4 (&acc)[4]) {
#pragma unroll
    for (int ks = 0; ks < 2; ++ks) {
        bf16x8 a = *(const bf16x8*)(RA + (16 * mw + fr) * LROW + ks * 32 + fg * 8);
#pragma unroll
        for (int nt = 0; nt < 4; ++nt) {
            bf16x8 b = *(const bf16x8*)(RB + (16 * nt + fr) * LROW + ks * 32 + fg * 8);
            acc[nt] = __builtin_amdgcn_mfma_f32_16x16x32_bf16(a, b, acc[nt], 0, 0, 0);
        }
    }
}
__device__ __forceinline__ void mm_col(const bf16_t* RA, const bf16_t* RB, int nw, int fr, int fg, f32x4 (&acc)[4]) {
#pragma unroll
    for (int ks = 0; ks < 2; ++ks) {
        bf16x8 b = *(const bf16x8*)(RB + (16 * nw + fr) * LROW + ks * 32 + fg * 8);
#pragma unroll
        for (int mt = 0; mt < 4; ++mt) {
            bf16x8 a = *(const bf16x8*)(RA + (16 * mt + fr) * LROW + ks * 32 + fg * 8);
            acc[mt] = __builtin_amdgcn_mfma_f32_16x16x32_bf16(a, b, acc[mt], 0, 0, 0);
        }
    }
}
__device__ __forceinline__ void zero4(f32x4 (&a)[4]) {
#pragma unroll
    for (int i = 0; i < 4; ++i) a[i] = (f32x4){0.f, 0.f, 0.f, 0.f};
}
__device__ __forceinline__ void st4_lds(bf16_t* p, float a, float b, float c, float d) { uint2 o; o.x = pk_bf16(a, b); o.y = pk_bf16(c, d); *(uint2*)p = o; }
__device__ __forceinline__ bf16_t f2bf(float v) { return (bf16_t)(pk_bf16(v, 0.f) & 0xffffu); }

__device__ void gdn_prep_item(const Params& p, int l, int cid, unsigned char* lds_raw) {
    const int tid = ltid(), lane = tid & 63, w = tid >> 6, fr = lane & 15, fg = lane >> 4;
    const int bh = cid >> 6, n = cid & 63, b = bh / H_GDN, h = bh % H_GDN;
    const int t0 = b * SEQ + n * 64;
    bf16_t* L0 = (bf16_t*)lds_raw; bf16_t* L1 = L0 + 64 * LROW; bf16_t* L2 = L1 + 64 * LROW; bf16_t* L3 = L2 + 64 * LROW; bf16_t* L4 = L3 + 64 * LROW; bf16_t* L5 = L4 + 64 * LROW;
    float* dec = (float*)(L5 + 64 * LROW); float* beta = dec + 64;
    const bf16_t* proj = (const bf16_t*)(p.ws + WS_PROJ);
    const float* aux = (const float*)(p.ws + WS_AUX);
    const float* convw = p.in[7] + (size_t)l * 4 * 1152;
    __syncthreads();
    const int i = tid >> 2, c0 = (tid & 3) * 16;
    float qv[16], kv[16], vv[16];
#pragma unroll
    for (int which = 0; which < 3; ++which) {
        float acc[16];
#pragma unroll
        for (int c = 0; c < 16; ++c) acc[c] = 0.f;
#pragma unroll
        for (int tap = 0; tap < 4; ++tap) {
            const int row = i - 3 + tap;
            if (n * 64 + row >= 0) {
                const bf16_t* xp = proj + (size_t)(t0 + row) * NPROJ + NC_GQ + which * 384 + h * 64 + c0;
                u32x4 x0 = *(const u32x4*)xp, x1 = *(const u32x4*)(xp + 8);
                const float* wp = convw + tap * 1152 + which * 384 + h * 64 + c0;
                unsigned xs[8] = {x0[0], x0[1], x0[2], x0[3], x1[0], x1[1], x1[2], x1[3]};
#pragma unroll
                for (int c = 0; c < 8; ++c) { acc[2 * c] += wp[2 * c] * bflo(xs[c]); acc[2 * c + 1] += wp[2 * c + 1] * bfhi(xs[c]); }
            }
        }
        float ss = 0.f;
#pragma unroll
        for (int c = 0; c < 16; ++c) { acc[c] = siluf_(acc[c]); ss += acc[c] * acc[c]; }
        if (which < 2) {
            ss += __shfl_xor(ss, 1, 64); ss += __shfl_xor(ss, 2, 64);
            const float sc = rsqrtf(ss + 1e-6f) * (which == 0 ? 0.125f : 1.f);
#pragma unroll
            for (int c = 0; c < 16; ++c) acc[c] *= sc;
        }
#pragma unroll
        for (int c = 0; c < 16; ++c) { if (which == 0) qv[c] = acc[c]; else if (which == 1) kv[c] = acc[c]; else vv[c] = acc[c]; }
    }
#pragma unroll
    for (int c = 0; c < 16; c += 4) { st4_lds(L2 + i * LROW + c0 + c, kv[c], kv[c + 1], kv[c + 2], kv[c + 3]); st4_lds(L3 + i * LROW + c0 + c, qv[c], qv[c + 1], qv[c + 2], qv[c + 3]); }
    if (w == 0) {
        const float a = aux[(size_t)(t0 + lane) * 64 + AX_GA + h], bl = aux[(size_t)(t0 + lane) * 64 + AX_GB + h];
        const float g = -__expf(p.in[8][l * H_GDN + h]) * softplusf_(a + p.in[9][l * H_GDN + h]);
        float inc = g;
#pragma unroll
        for (int o = 1; o < 64; o <<= 1) { float t = __shfl_up(inc, o, 64); if (lane >= o) inc += t; }
        dec[lane] = inc; beta[lane] = sigmoidf_(bl);
    }
    __syncthreads();
    {
        f32x4 g4[4]; zero4(g4);
        mm_row(L2, L2, w, fr, fg, g4);
#pragma unroll
        for (int nt = 0; nt < 4; ++nt) {
            const int kap = 16 * nt + fr; const float dk_ = dec[kap], bk_ = beta[kap];
            float nT[4], nN[4], tt[4];
#pragma unroll
            for (int r = 0; r < 4; ++r) {
                const int rho = 16 * w + 4 * fg + r; const float dr_ = dec[rho], br_ = beta[rho];
                const float G = g4[nt][r];
                nT[r] = (kap < rho) ? br_ * G * __expf(dr_ - dk_) : 0.f;
                nN[r] = (rho < kap) ? bk_ * G * __expf(dk_ - dr_) : 0.f;
                tt[r] = ((kap == rho) ? 1.f : 0.f) - nN[r];
            }
            st4_lds(L1 + kap * LROW + 16 * w + 4 * fg, nT[0], nT[1], nT[2], nT[3]);
            st4_lds(L0 + kap * LROW + 16 * w + 4 * fg, nN[0], nN[1], nN[2], nN[3]);
            st4_lds(L4 + kap * LROW + 16 * w + 4 * fg, tt[0], tt[1], tt[2], tt[3]);
        }
        f32x4 a4[4]; zero4(a4);
        mm_row(L2, L3, w, fr, fg, a4);
#pragma unroll
        for (int nt = 0; nt < 4; ++nt) {
            const int ii = 16 * nt + fr; const float di_ = dec[ii];
            float v4[4];
#pragma unroll
            for (int r = 0; r < 4; ++r) { const int j = 16 * w + 4 * fg + r; v4[r] = (j <= ii) ? a4[nt][r] * __expf(di_ - dec[j]) : 0.f; }
            st4_lds(L5 + ii * LROW + 16 * w + 4 * fg, v4[0], v4[1], v4[2], v4[3]);
        }
    }
    __syncthreads();
#pragma unroll
    for (int lev = 1; lev <= 5; ++lev) {
        const bf16_t* XA = (lev & 1) ? L0 : L2; const bf16_t* XAt = (lev & 1) ? L1 : L3;
        bf16_t* XB = (lev & 1) ? L2 : L0; bf16_t* XBt = (lev & 1) ? L3 : L1;
        {
            f32x4 x4[4]; zero4(x4);
            mm_row(XA, XAt, w, fr, fg, x4);
#pragma unroll
            for (int nt = 0; nt < 4; ++nt) {
                const int c = 16 * nt + fr;
                st4_lds(XBt + c * LROW + 16 * w + 4 * fg, x4[nt][0], x4[nt][1], x4[nt][2], x4[nt][3]);
                if (lev < 5) {
#pragma unroll
                    for (int r = 0; r < 4; ++r) XB[(16 * w + 4 * fg + r) * LROW + c] = f2bf(x4[nt][r]);
                }
            }
        }
        __syncthreads();
        {
            f32x4 t4[4];
#pragma unroll
            for (int mt = 0; mt < 4; ++mt) {
                uint2 u = *(const uint2*)(L4 + (16 * w + fr) * LROW + 16 * mt + 4 * fg);
                t4[mt] = (f32x4){bflo(u.x), bfhi(u.x), bflo(u.y), bfhi(u.y)};
            }
            mm_col(XBt, L4, w, fr, fg, t4);
#pragma unroll
            for (int mt = 0; mt < 4; ++mt) st4_lds(L4 + (16 * w + fr) * LROW + 16 * mt + 4 * fg, t4[mt][0], t4[mt][1], t4[mt][2], t4[mt][3]);
        }
    }
    {
        const float dj = dec[i], bj = beta[i], dlast = dec[63];
        const float s1 = bj * __expf(dj), s2 = bj, s3 = __expf(dlast - dj);
#pragma unroll
        for (int c = 0; c < 16; ++c) {
            L0[(c0 + c) * LROW + i] = f2bf(kv[c] * s1);
            L1[(c0 + c) * LROW + i] = f2bf(vv[c] * s2);
            L2[(c0 + c) * LROW + i] = f2bf(kv[c] * s3);
        }
    }
    __syncthreads();
    {
        f32x4 w4[4], u4[4]; zero4(w4); zero4(u4);
        mm_row(L4, L0, w, fr, fg, w4);
        mm_row(L4, L1, w, fr, fg, u4);
        __syncthreads();
#pragma unroll
        for (int nt = 0; nt < 4; ++nt) {
            st4_lds(L0 + (16 * nt + fr) * LROW + 16 * w + 4 * fg, w4[nt][0], w4[nt][1], w4[nt][2], w4[nt][3]);
            st4_lds(L1 + (16 * nt + fr) * LROW + 16 * w + 4 * fg, u4[nt][0], u4[nt][1], u4[nt][2], u4[nt][3]);
        }
        const float ed = __expf(dec[i]);
#pragma unroll
        for (int c = 0; c < 16; c += 4) st4_lds(L3 + i * LROW + c0 + c, qv[c] * ed, qv[c + 1] * ed, qv[c + 2] * ed, qv[c + 3] * ed);
    }
    __syncthreads();
    char* scr = p.ws + WS_SCR;
    {
        f32x4 m4[4]; zero4(m4);
        mm_row(L0, L2, w, fr, fg, m4);
        bf16_t* MP = (bf16_t*)(scr + SCR_GDN_MP) + (size_t)cid * 4096;
#pragma unroll
        for (int nt = 0; nt < 4; ++nt) store4_bf16(MP + (16 * nt + fr) * 64 + 16 * w + 4 * fg, -m4[nt][0], -m4[nt][1], -m4[nt][2], -m4[nt][3]);
        f32x4 n4[4]; zero4(n4);
        mm_row(L2, L1, w, fr, fg, n4);
        bf16_t* NN = (bf16_t*)(scr + SCR_GDN_NN) + (size_t)cid * 4096;
#pragma unroll
        for (int nt = 0; nt < 4; ++nt) store4_bf16(NN + ((w * 4 + nt) * 64 + lane) * 4, n4[nt][0], n4[nt][1], n4[nt][2], n4[nt][3]);
        f32x4 p4[4]; zero4(p4);
        mm_row(L0, L5, w, fr, fg, p4);
        bf16_t* PG = (bf16_t*)(scr + SCR_GDN_P) + (size_t)cid * 4096;
#pragma unroll
        for (int nt = 0; nt < 4; ++nt) {
            uint2 u = *(const uint2*)(L3 + (16 * nt + fr) * LROW + 16 * w + 4 * fg);
            store4_bf16(PG + (16 * nt + fr) * 64 + 16 * w + 4 * fg, bflo(u.x) - p4[nt][0], bfhi(u.x) - p4[nt][1], bflo(u.y) - p4[nt][2], bfhi(u.y) - p4[nt][3]);
        }
        f32x4 o4[4]; zero4(o4);
        mm_row(L1, L5, w, fr, fg, o4);
        bf16_t* OL = (bf16_t*)(scr + SCR_GDN_OL) + (size_t)cid * 4096;
#pragma unroll
        for (int nt = 0; nt < 4; ++nt) store4_bf16(OL + (16 * nt + fr) * 64 + 16 * w + 4 * fg, o4[nt][0], o4[nt][1], o4[nt][2], o4[nt][3]);
        if (tid == 0) ((float*)(scr + SCR_GDN_LAST))[cid] = __expf(dec[63]);
    }
}

__device__ void gdn_scan_item(const Params& p, int bh, unsigned char* lds_raw) {
    const int tid = ltid(), lane = tid & 63, w = tid >> 6, fr = lane & 15, fg = lane >> 4;
    char* scr = p.ws + WS_SCR;
    const bf16_t* MP = (const bf16_t*)(scr + SCR_GDN_MP) + (size_t)bh * 64 * 4096;
    const bf16_t* NN = (const bf16_t*)(scr + SCR_GDN_NN) + (size_t)bh * 64 * 4096;
    const float* LAST = (const float*)(scr + SCR_GDN_LAST) + bh * 64;
    bf16_t* SG = (bf16_t*)(scr + SCR_GDN_SG) + (size_t)bh * 64 * 4096;
    f32x4 S[4]; zero4(S);
    bf16x8 a0 = *(const bf16x8*)(MP + (16 * w + fr) * 64 + fg * 8), a1 = *(const bf16x8*)(MP + (16 * w + fr) * 64 + 32 + fg * 8);
    uint2 nn[4];
#pragma unroll
    for (int nt = 0; nt < 4; ++nt) nn[nt] = *(const uint2*)(NN + ((w * 4 + nt) * 64 + lane) * 4);
    float last = LAST[0];
    __syncthreads();
    for (int n = 0; n < 64; ++n) {
        bf16_t* buf = (bf16_t*)lds_raw + (n & 1) * 64 * LROW;
#pragma unroll
        for (int nt = 0; nt < 4; ++nt) {
            uint2 o; o.x = pk_bf16(S[nt][0], S[nt][1]); o.y = pk_bf16(S[nt][2], S[nt][3]);
            *(uint2*)(buf + (16 * nt + fr) * LROW + 16 * w + 4 * fg) = o;
            *(uint2*)(SG + (size_t)n * 4096 + (16 * nt + fr) * 64 + 16 * w + 4 * fg) = o;
        }
        bf16x8 b0 = a0, b1 = a1; uint2 nn2[4]; float last2 = last;
#pragma unroll
        for (int nt = 0; nt < 4; ++nt) nn2[nt] = nn[nt];
        if (n + 1 < 64) {
            const bf16_t* MPn = MP + (size_t)(n + 1) * 4096;
            b0 = *(const bf16x8*)(MPn + (16 * w + fr) * 64 + fg * 8); b1 = *(const bf16x8*)(MPn + (16 * w + fr) * 64 + 32 + fg * 8);
#pragma unroll
            for (int nt = 0; nt < 4; ++nt) nn2[nt] = *(const uint2*)(NN + (size_t)(n + 1) * 4096 + ((w * 4 + nt) * 64 + lane) * 4);
            last2 = LAST[n + 1];
        }
        __syncthreads();
#pragma unroll
        for (int nt = 0; nt < 4; ++nt) {
            S[nt][0] = last * S[nt][0] + bflo(nn[nt].x); S[nt][1] = last * S[nt][1] + bfhi(nn[nt].x);
            S[nt][2] = last * S[nt][2] + bflo(nn[nt].y); S[nt][3] = last * S[nt][3] + bfhi(nn[nt].y);
        }
#pragma unroll
        for (int nt = 0; nt < 4; ++nt) {
            bf16x8 s0 = *(const bf16x8*)(buf + (16 * nt + fr) * LROW + fg * 8), s1 = *(const bf16x8*)(buf + (16 * nt + fr) * LROW + 32 + fg * 8);
            S[nt] = __builtin_amdgcn_mfma_f32_16x16x32_bf16(a0, s0, S[nt], 0, 0, 0);
            S[nt] = __builtin_amdgcn_mfma_f32_16x16x32_bf16(a1, s1, S[nt], 0, 0, 0);
        }
        a0 = b0; a1 = b1; last = last2;
#pragma unroll
        for (int nt = 0; nt < 4; ++nt) nn[nt] = nn2[nt];
    }
}

__device__ void gdn_out_item(const Params& p, int l, int cid) {
    const int tid = ltid(), lane = tid & 63, w = tid >> 6, fr = lane & 15, fg = lane >> 4;
    const int bh = cid >> 6, n = cid & 63, b = bh / H_GDN, h = bh % H_GDN;
    char* scr = p.ws + WS_SCR;
    const bf16_t* SG = (const bf16_t*)(scr + SCR_GDN_SG) + (size_t)cid * 4096;
    const bf16_t* PG = (const bf16_t*)(scr + SCR_GDN_P) + (size_t)cid * 4096;
    const bf16_t* OL = (const bf16_t*)(scr + SCR_GDN_OL) + (size_t)cid * 4096;
    const int i = 16 * w + fr; const int t = b * SEQ + n * 64 + i;
    f32x4 acc[4];
#pragma unroll
    for (int mt = 0; mt < 4; ++mt) { uint2 u = *(const uint2*)(OL + i * 64 + 16 * mt + 4 * fg); acc[mt] = (f32x4){bflo(u.x), bfhi(u.x), bflo(u.y), bfhi(u.y)}; }
#pragma unroll
    for (int ks = 0; ks < 2; ++ks) {
        bf16x8 bq = *(const bf16x8*)(PG + i * 64 + ks * 32 + fg * 8);
#pragma unroll
        for (int mt = 0; mt < 4; ++mt) {
            bf16x8 a = *(const bf16x8*)(SG + (16 * mt + fr) * 64 + ks * 32 + fg * 8);
            acc[mt] = __builtin_amdgcn_mfma_f32_16x16x32_bf16(a, bq, acc[mt], 0, 0, 0);
        }
    }
    float ss = 0.f;
#pragma unroll
    for (int mt = 0; mt < 4; ++mt)
#pragma unroll
        for (int r = 0; r < 4; ++r) ss += acc[mt][r] * acc[mt][r];
    ss += __shfl_xor(ss, 16, 64); ss += __shfl_xor(ss, 32, 64);
    const float rstd = rsqrtf(ss * (1.f / 64.f) + 1e-6f);
    const float* og = p.in[10] + l * 64;
    const bf16_t* gp = (const bf16_t*)(p.ws + WS_PROJ) + (size_t)t * NPROJ + NC_GG + h * 64;
    bf16_t* mp = (bf16_t*)(p.ws + WS_MIX) + (size_t)t * D_MODEL + 384 + h * 64;
#pragma unroll
    for (int mt = 0; mt < 4; ++mt) {
        const int e0 = 16 * mt + 4 * fg;
        uint2 gu = *(const uint2*)(gp + e0); f32x4 g4 = *(const f32x4*)(og + e0);
        store4_bf16(mp + e0, acc[mt][0] * rstd * g4[0] * bflo(gu.x), acc[mt][1] * rstd * g4[1] * bfhi(gu.x), acc[mt][2] * rstd * g4[2] * bflo(gu.y), acc[mt][3] * rstd * g4[3] * bfhi(gu.y));
    }
}

#define GQROW 40
__device__ void gla_prep_item(const Params& p, int l, int cid, unsigned char* lds_raw) {
    const int tid = ltid(), lane = tid & 63, w = tid >> 6, fr = lane & 15, fg = lane >> 4;
    const int bh = cid >> 6, n = cid & 63, b = bh / H_GLA, h = bh % H_GLA;
    const int t0 = b * SEQ + n * 64;
    float* Bf = (float*)lds_raw;
    bf16_t* Qt = (bf16_t*)(lds_raw + 8448);
    bf16_t* Kt = Qt + 64 * GQROW;
    bf16_t* KLt = Kt + 64 * GQROW;
    bf16_t* Vt = KLt + 32 * LROW;
    const bf16_t* proj = (const bf16_t*)(p.ws + WS_PROJ);
    const float* aux = (const float*)(p.ws + WS_AUX);
    char* scr = p.ws + WS_SCR;
    __syncthreads();
    const int i = tid >> 2, d0 = (tid & 3) * 8;
    {
        const float* wa = p.in[11] + (size_t)l * 16 * 128 + h * 32 + d0;
        const float* ba = p.in[12] + l * 128 + h * 32 + d0;
        float acc[8];
#pragma unroll
        for (int j = 0; j < 8; ++j) acc[j] = ba[j];
#pragma unroll
        for (int r = 0; r < 16; ++r) {
            const float a1 = aux[(size_t)(t0 + i) * 64 + AX_LA + r];
#pragma unroll
            for (int j = 0; j < 8; ++j) acc[j] += a1 * wa[r * 128 + j];
        }
#pragma unroll
        for (int j = 0; j < 8; ++j) Bf[i * 33 + d0 + j] = logsigmoidf_(acc[j]) * (1.f / 16.f);
    }
    {
        const bf16_t* lvt = (const bf16_t*)(scr + SCR_LVT) + (size_t)bh * 64 * SEQ + n * 64;
#pragma unroll
        for (int ii = 0; ii < 2; ++ii) { int c = tid + 256 * ii; int row = c >> 3, kc = c & 7; *(u32x4*)(Vt + row * LROW + kc * 8) = *(const u32x4*)(lvt + (size_t)row * SEQ + kc * 8); }
    }
    __syncthreads();
#pragma unroll
    for (int c = 0; c < 8; ++c) {
        const int d = 8 * w + c;
        float inc = Bf[lane * 33 + d];
#pragma unroll
        for (int o = 1; o < 64; o <<= 1) { float t = __shfl_up(inc, o, 64); if (lane >= o) inc += t; }
        Bf[lane * 33 + d] = inc;
    }
    __syncthreads();
    {
        const bf16_t* qp = proj + (size_t)(t0 + i) * NPROJ + NC_LQ + h * 32 + d0;
        const bf16_t* kp = proj + (size_t)(t0 + i) * NPROJ + NC_LK + h * 32 + d0;
        u32x4 qu = *(const u32x4*)qp, ku = *(const u32x4*)kp;
        float qf[8] = {bflo(qu[0]), bfhi(qu[0]), bflo(qu[1]), bfhi(qu[1]), bflo(qu[2]), bfhi(qu[2]), bflo(qu[3]), bfhi(qu[3])};
        float kf[8] = {bflo(ku[0]), bfhi(ku[0]), bflo(ku[1]), bfhi(ku[1]), bflo(ku[2]), bfhi(ku[2]), bflo(ku[3]), bfhi(ku[3])};
        float qt[8], kt[8], qb[8];
#pragma unroll
        for (int j = 0; j < 8; ++j) {
            const float bi = Bf[i * 33 + d0 + j], bm = Bf[31 * 33 + d0 + j], bl = Bf[63 * 33 + d0 + j];
            qt[j] = qf[j] * __expf(bi - bm); kt[j] = kf[j] * __expf(bm - bi); qb[j] = qf[j] * __expf(bi);
            KLt[(d0 + j) * LROW + i] = f2bf(kf[j] * __expf(bl - bi));
            if (i == 63) ((float*)(scr + SCR_GLA_DL))[cid * 32 + d0 + j] = __expf(bl);
        }
        u32x4 o; o[0] = pk_bf16(qt[0], qt[1]); o[1] = pk_bf16(qt[2], qt[3]); o[2] = pk_bf16(qt[4], qt[5]); o[3] = pk_bf16(qt[6], qt[7]);
        *(u32x4*)(Qt + i * GQROW + d0) = o;
        o[0] = pk_bf16(kt[0], kt[1]); o[1] = pk_bf16(kt[2], kt[3]); o[2] = pk_bf16(kt[4], kt[5]); o[3] = pk_bf16(kt[6], kt[7]);
        *(u32x4*)(Kt + i * GQROW + d0) = o;
        o[0] = pk_bf16(qb[0], qb[1]); o[1] = pk_bf16(qb[2], qb[3]); o[2] = pk_bf16(qb[4], qb[5]); o[3] = pk_bf16(qb[6], qb[7]);
        *(u32x4*)((bf16_t*)(scr + SCR_GLA_QB) + (size_t)cid * 2048 + i * 32 + d0) = o;
    }
    __syncthreads();
    f32x4 sc[4];
    {
        bf16x8 bq = *(const bf16x8*)(Qt + (16 * w + fr) * GQROW + fg * 8);
#pragma unroll
        for (int mt = 0; mt < 4; ++mt) {
            bf16x8 a = *(const bf16x8*)(Kt + (16 * mt + fr) * GQROW + fg * 8);
            sc[mt] = __builtin_amdgcn_mfma_f32_16x16x32_bf16(a, bq, (f32x4){0.f, 0.f, 0.f, 0.f}, 0, 0, 0);
        }
        const int ii = 16 * w + fr;
#pragma unroll
        for (int mt = 0; mt < 4; ++mt)
#pragma unroll
            for (int r = 0; r < 4; ++r) { const int j = 16 * mt + 4 * fg + r; if (j > ii) sc[mt][r] = 0.f; }
    }
    {
        f32x4 o4[4]; zero4(o4);
#pragma unroll
        for (int kk = 0; kk < 2; ++kk) {
            u32x4 pb = {pk_bf16(sc[2 * kk][0], sc[2 * kk][1]), pk_bf16(sc[2 * kk][2], sc[2 * kk][3]), pk_bf16(sc[2 * kk + 1][0], sc[2 * kk + 1][1]), pk_bf16(sc[2 * kk + 1][2], sc[2 * kk + 1][3])};
#pragma unroll
            for (int mt = 0; mt < 4; ++mt) {
                uint2 v0 = *(const uint2*)(Vt + (16 * mt + fr) * LROW + 32 * kk + 4 * fg), v1 = *(const uint2*)(Vt + (16 * mt + fr) * LROW + 32 * kk + 16 + 4 * fg);
                u32x4 va = {v0.x, v0.y, v1.x, v1.y};
                o4[mt] = __builtin_amdgcn_mfma_f32_16x16x32_bf16(__builtin_bit_cast(bf16x8, va), __builtin_bit_cast(bf16x8, pb), o4[mt], 0, 0, 0);
            }
        }
        bf16_t* OL = (bf16_t*)(scr + SCR_GLA_OL) + (size_t)cid * 4096;
#pragma unroll
        for (int mt = 0; mt < 4; ++mt) store4_bf16(OL + (16 * w + fr) * 64 + 16 * mt + 4 * fg, o4[mt][0], o4[mt][1], o4[mt][2], o4[mt][3]);
    }
    {
        f32x4 k4[2] = {(f32x4){0.f, 0.f, 0.f, 0.f}, (f32x4){0.f, 0.f, 0.f, 0.f}};
#pragma unroll
        for (int ks = 0; ks < 2; ++ks) {
            bf16x8 bv = *(const bf16x8*)(Vt + (16 * w + fr) * LROW + ks * 32 + fg * 8);
#pragma unroll
            for (int mt = 0; mt < 2; ++mt) {
                bf16x8 a = *(const bf16x8*)(KLt + (16 * mt + fr) * LROW + ks * 32 + fg * 8);
                k4[mt] = __builtin_amdgcn_mfma_f32_16x16x32_bf16(a, bv, k4[mt], 0, 0, 0);
            }
        }
        float* KV = (float*)(scr + SCR_GLA_KV) + (size_t)cid * 2048;
#pragma unroll
        for (int mt = 0; mt < 2; ++mt) *(f32x4*)(KV + (16 * w + fr) * 32 + 16 * mt + 4 * fg) = k4[mt];
    }
}
__device__ void gla_scan_item(const Params& p, int g) {
    const int tid = ltid();
    const int bh = g >> 3, idx = (g & 7) * 256 + tid, d = idx & 31;
    char* scr = p.ws + WS_SCR;
    const float* __restrict__ KV = (const float*)(scr + SCR_GLA_KV) + (size_t)bh * 64 * 2048 + idx;
    const float* __restrict__ DL = (const float*)(scr + SCR_GLA_DL) + bh * 64 * 32 + d;
    bf16_t* __restrict__ SG = (bf16_t*)(scr + SCR_GLA_SG) + (size_t)bh * 64 * 2048 + idx;
    float S = 0.f;
    for (int n0 = 0; n0 < 64; n0 += 8) {
        float kv[8], dl[8];
#pragma unroll
        for (int u = 0; u < 8; ++u) { kv[u] = KV[(size_t)(n0 + u) * 2048]; dl[u] = DL[(n0 + u) * 32]; }
#pragma unroll
        for (int u = 0; u < 8; ++u) { SG[(size_t)(n0 + u) * 2048] = f2bf(S); S = dl[u] * S + kv[u]; }
    }
}
__device__ void gla_out_item(const Params& p, int l, int cid) {
    const int tid = ltid(), lane = tid & 63, w = tid >> 6, fr = lane & 15, fg = lane >> 4;
    const int bh = cid >> 6, n = cid & 63, b = bh / H_GLA, h = bh % H_GLA;
    char* scr = p.ws + WS_SCR;
    const bf16_t* SG = (const bf16_t*)(scr + SCR_GLA_SG) + (size_t)cid * 2048;
    const bf16_t* QB = (const bf16_t*)(scr + SCR_GLA_QB) + (size_t)cid * 2048;
    const bf16_t* OL = (const bf16_t*)(scr + SCR_GLA_OL) + (size_t)cid * 4096;
    const int i = 16 * w + fr; const int t = b * SEQ + n * 64 + i;
    f32x4 acc[4];
#pragma unroll
    for (int mt = 0; mt < 4; ++mt) { uint2 u = *(const uint2*)(OL + i * 64 + 16 * mt + 4 * fg); acc[mt] = (f32x4){bflo(u.x), bfhi(u.x), bflo(u.y), bfhi(u.y)}; }
    bf16x8 bq = *(const bf16x8*)(QB + i * 32 + fg * 8);
#pragma unroll
    for (int mt = 0; mt < 4; ++mt) {
        bf16x8 a = *(const bf16x8*)(SG + (16 * mt + fr) * 32 + fg * 8);
        acc[mt] = __builtin_amdgcn_mfma_f32_16x16x32_bf16(a, bq, acc[mt], 0, 0, 0);
    }
    float ss = 0.f;
#pragma unroll
    for (int mt = 0; mt < 4; ++mt)
#pragma unroll
        for (int r = 0; r < 4; ++r) ss += acc[mt][r] * acc[mt][r];
    ss += __shfl_xor(ss, 16, 64); ss += __shfl_xor(ss, 32, 64);
    const float rstd = rsqrtf(ss * (1.f / 64.f) + 1e-6f);
    const float* og = p.in[13] + l * 64;
    const bf16_t* rp = (const bf16_t*)(p.ws + WS_PROJ) + (size_t)t * NPROJ + NC_LR + h * 64;
    bf16_t* mp = (bf16_t*)(p.ws + WS_MIX) + (size_t)t * D_MODEL + 768 + h * 64;
#pragma unroll
    for (int mt = 0; mt < 4; ++mt) {
        const int e0 = 16 * mt + 4 * fg;
        uint2 gu = *(const uint2*)(rp + e0); f32x4 g4 = *(const f32x4*)(og + e0);
        store4_bf16(mp + e0, acc[mt][0] * rstd * g4[0] * bflo(gu.x), acc[mt][1] * rstd * g4[1] * bfhi(gu.x), acc[mt][2] * rstd * g4[2] * bflo(gu.y), acc[mt][3] * rstd * g4[3] * bfhi(gu.y));
    }
}
__device__ void phase_mixout(const Params& p, int l) {
    for (int it = blockIdx.x; it < NGDN_CH + NGLA_CH; it += gridDim.x) {
        if (it < NGDN_CH) { if (MIXSEL & 1) gdn_out_item(p, l, it); } else { if (MIXSEL & 2) gla_out_item(p, l, it - NGDN_CH); }
    }
}

__device__ void fox_cumsum_item(const Params& p, int l, int bh, float* ldsf) {
    const int tid = ltid(), lane = tid & 63, w = tid >> 6;
    const int b = bh / H_FOX, h = bh % H_FOX;
    const float* aux = (const float*)(p.ws + WS_AUX);
    float* cum = (float*)(p.ws + WS_CUM) + (size_t)bh * SEQ;
    const float fb = p.in[5][l * H_FOX + h];
    float v[16]; float s = 0.f;
#pragma unroll
    for (int i = 0; i < 16; ++i) { v[i] = logsigmoidf_(aux[(size_t)(b * SEQ + tid * 16 + i) * 64 + AX_FF + h] + fb); s += v[i]; }
    float inc = s;
#pragma unroll
    for (int o = 1; o < 64; o <<= 1) { float t = __shfl_up(inc, o, 64); if (lane >= o) inc += t; }
    __syncthreads();
    if (lane == 63) ldsf[w] = inc;
    __syncthreads();
    float base = inc - s;
    for (int ww = 0; ww < w; ++ww) base += ldsf[ww];
    float c = base;
#pragma unroll
    for (int i = 0; i < 16; ++i) { c += v[i]; cum[tid * 16 + i] = c; }
}
__device__ void phase_prep(const Params& p, int l, unsigned char* lds_raw) {
    const int n0 = BATCH * H_FOX, n1 = n0 + ((MIXSEL & 1) ? NGDN_CH : 0), n2 = n1 + ((MIXSEL & 2) ? NGLA_CH : 0);
    for (int it = blockIdx.x; it < n2; it += gridDim.x) {
        if (it < n0) { __syncthreads(); fox_cumsum_item(p, l, it, (float*)lds_raw); }
        else if (it < n1) gdn_prep_item(p, l, it - n0, lds_raw);
        else gla_prep_item(p, l, it - n1, lds_raw);
    }
}

typedef float f32x16 __attribute__((ext_vector_type(16)));
#define ATT_BUF 18688
__device__ void fox_attn_item(const Params& p, int l, int bh, int qt, unsigned char* lds_raw) {
    const int tid = ltid(), lane = tid & 63, w = tid >> 6, r = lane & 31, h = lane >> 5;
    const int b = bh / H_FOX, hh = bh % H_FOX;
    const bf16_t* proj = (const bf16_t*)(p.ws + WS_PROJ);
    const bf16_t* kbase = proj + (size_t)b * SEQ * NPROJ + NC_FK + hh * 64;
    const bf16_t* vbase = (const bf16_t*)(p.ws + WS_VTF) + (size_t)bh * 64 * SEQ;
    const float* cum = (const float*)(p.ws + WS_CUM) + (size_t)bh * SEQ;
    const int qlo = qt * 128 + w * 32, q = qlo + r;
    bf16x8 qf[4];
    {
        const bf16_t* qrow = proj + (size_t)(b * SEQ + q) * NPROJ + NC_FQ + hh * 64;
#pragma unroll
        for (int kk = 0; kk < 4; ++kk) qf[kk] = *(const bf16x8*)(qrow + kk * 16 + h * 8);
    }
    const float cq = cum[q];
    f32x16 o0, o1;
#pragma unroll
    for (int i = 0; i < 16; ++i) { o0[i] = 0.f; o1[i] = 0.f; }
    float m = -1e30f, lsum = 0.f;
    const int ntiles = 2 * qt + 2;
    const int crow = tid >> 3, ckc = tid & 7;
    u32x4 kr0, kr1, vr0, vr1; float cr = 0.f;
    auto gload = [&](int j) {
        const int s0 = j * 64;
        kr0 = *(const u32x4*)(kbase + (size_t)(s0 + crow) * NPROJ + ckc * 8);
        kr1 = *(const u32x4*)(kbase + (size_t)(s0 + crow + 32) * NPROJ + ckc * 8);
        vr0 = *(const u32x4*)(vbase + (size_t)crow * SEQ + s0 + ckc * 8);
        vr1 = *(const u32x4*)(vbase + (size_t)(crow + 32) * SEQ + s0 + ckc * 8);
        if (tid < 64) cr = cum[s0 + tid];
    };
    auto lstore = [&](int buf) {
        bf16_t* Ks = (bf16_t*)(lds_raw + buf * ATT_BUF); bf16_t* Vs = Ks + 64 * LROW; float* cs = (float*)(Vs + 64 * LROW);
        *(u32x4*)(Ks + crow * LROW + ckc * 8) = kr0; *(u32x4*)(Ks + (crow + 32) * LROW + ckc * 8) = kr1;
        *(u32x4*)(Vs + crow * LROW + ckc * 8) = vr0; *(u32x4*)(Vs + (crow + 32) * LROW + ckc * 8) = vr1;
        if (tid < 64) cs[tid] = cr;
    };
    __syncthreads();
    gload(0); lstore(0);
    __syncthreads();
    for (int j = 0; j < ntiles; ++j) {
        if (j + 1 < ntiles) gload(j + 1);
        const int s0 = j * 64;
        if (s0 <= qlo + 31) {
            const bf16_t* Ks = (const bf16_t*)(lds_raw + (j & 1) * ATT_BUF); const bf16_t* Vs = Ks + 64 * LROW; const float* cs = (const float*)(Vs + 64 * LROW);
            f32x16 st0, st1;
#pragma unroll
            for (int i = 0; i < 16; ++i) { st0[i] = 0.f; st1[i] = 0.f; }
#pragma unroll
            for (int kk = 0; kk < 4; ++kk) {
                bf16x8 a0 = *(const bf16x8*)(Ks + r * LROW + kk * 16 + h * 8);
                bf16x8 a1 = *(const bf16x8*)(Ks + (32 + r) * LROW + kk * 16 + h * 8);
                st0 = __builtin_amdgcn_mfma_f32_32x32x16_bf16(a0, qf[kk], st0, 0, 0, 0);
                st1 = __builtin_amdgcn_mfma_f32_32x32x16_bf16(a1, qf[kk], st1, 0, 0, 0);
            }
            const bool need_mask = (s0 + 63 > qlo);
            float mx = -1e30f;
#pragma unroll
            for (int g = 0; g < 4; ++g) {
                f32x4 c0 = *(const f32x4*)(cs + 8 * g + 4 * h);
                f32x4 c1 = *(const f32x4*)(cs + 32 + 8 * g + 4 * h);
#pragma unroll
                for (int e = 0; e < 4; ++e) {
                    int i = 4 * g + e;
                    float v0 = st0[i] + (cq - c0[e]), v1 = st1[i] + (cq - c1[e]);
                    if (need_mask) {
                        int key = s0 + 8 * g + 4 * h + e;
                        if (key > q) v0 = -1e30f;
                        if (key + 32 > q) v1 = -1e30f;
                    }
                    st0[i] = v0; st1[i] = v1;
                    mx = fmaxf(mx, fmaxf(v0, v1));
                }
            }
            mx = fmaxf(mx, __shfl_xor(mx, 32, 64));
            const float mnew = fmaxf(m, mx);
            const float alpha = __expf(m - mnew);
            float rs = 0.f;
#pragma unroll
            for (int i = 0; i < 16; ++i) { st0[i] = __expf(st0[i] - mnew); st1[i] = __expf(st1[i] - mnew); rs += st0[i] + st1[i]; }
            lsum = lsum * alpha + rs; m = mnew;
#pragma unroll
            for (int i = 0; i < 16; ++i) { o0[i] *= alpha; o1[i] *= alpha; }
            bf16x8 pf[2][2];
#pragma unroll
            for (int s = 0; s < 2; ++s) {
                u32x4 t0 = {pk_bf16(st0[8 * s], st0[8 * s + 1]), pk_bf16(st0[8 * s + 2], st0[8 * s + 3]), pk_bf16(st0[8 * s + 4], st0[8 * s + 5]), pk_bf16(st0[8 * s + 6], st0[8 * s + 7])};
                u32x4 t1 = {pk_bf16(st1[8 * s], st1[8 * s + 1]), pk_bf16(st1[8 * s + 2], st1[8 * s + 3]), pk_bf16(st1[8 * s + 4], st1[8 * s + 5]), pk_bf16(st1[8 * s + 6], st1[8 * s + 7])};
                pf[0][s] = __builtin_bit_cast(bf16x8, t0); pf[1][s] = __builtin_bit_cast(bf16x8, t1);
            }
#pragma unroll
            for (int mt = 0; mt < 2; ++mt)
#pragma unroll
                for (int s = 0; s < 2; ++s) {
                    const int ko = 32 * mt + 16 * s + 4 * h;
                    uint2 a00 = *(const uint2*)(Vs + r * LROW + ko), a01 = *(const uint2*)(Vs + r * LROW + ko + 8);
                    uint2 a10 = *(const uint2*)(Vs + (32 + r) * LROW + ko), a11 = *(const uint2*)(Vs + (32 + r) * LROW + ko + 8);
                    u32x4 u0 = {a00.x, a00.y, a01.x, a01.y}; u32x4 u1 = {a10.x, a10.y, a11.x, a11.y};
                    o0 = __builtin_amdgcn_mfma_f32_32x32x16_bf16(__builtin_bit_cast(bf16x8, u0), pf[mt][s], o0, 0, 0, 0);
                    o1 = __builtin_amdgcn_mfma_f32_32x32x16_bf16(__builtin_bit_cast(bf16x8, u1), pf[mt][s], o1, 0, 0, 0);
                }
        }
        if (j + 1 < ntiles) lstore((j + 1) & 1);
        __syncthreads();
    }
    lsum += __shfl_xor(lsum, 32, 64);
    const float inv = 1.f / lsum;
    float ss = 0.f;
#pragma unroll
    for (int i = 0; i < 16; ++i) { o0[i] *= inv; o1[i] *= inv; ss += o0[i] * o0[i] + o1[i] * o1[i]; }
    ss += __shfl_xor(ss, 32, 64);
    const float rstd = rsqrtf(ss * (1.f / 64.f) + 1e-6f);
    const float* og = p.in[6] + l * 64;
    bf16_t* mrow = (bf16_t*)(p.ws + WS_MIX) + (size_t)(b * SEQ + q) * D_MODEL + hh * 64;
#pragma unroll
    for (int g = 0; g < 4; ++g) {
        const int e0 = 8 * g + 4 * h;
        f32x4 g0 = *(const f32x4*)(og + e0), g1 = *(const f32x4*)(og + 32 + e0);
        store4_bf16(mrow + e0, o0[4 * g] * rstd * g0[0], o0[4 * g + 1] * rstd * g0[1], o0[4 * g + 2] * rstd * g0[2], o0[4 * g + 3] * rstd * g0[3]);
        store4_bf16(mrow + 32 + e0, o1[4 * g] * rstd * g1[0], o1[4 * g + 1] * rstd * g1[1], o1[4 * g + 2] * rstd * g1[2], o1[4 * g + 3] * rstd * g1[3]);
    }
}
#define ATT_ITEMS (BATCH * H_FOX * (SEQ / 128))
__device__ void phase_scan_attn(const Params& p, int l, unsigned char* lds_raw) {
    unsigned* qctr = (unsigned*)(p.ws + WS_CTL) + CW_Q + l;
    volatile int* slot = (volatile int*)(lds_raw + 2 * ATT_BUF);
    for (;;) {
        __syncthreads();
        if (threadIdx.x == 0) *slot = (int)atomicAdd(qctr, 1u);
        __syncthreads();
        int it = *slot;
        const int ns0 = (MIXSEL & 1) ? BATCH * H_GDN : 0, ns1 = ns0 + ((MIXSEL & 2) ? 128 : 0);
        if (it >= ns1 + ATT_ITEMS) break;
        if (it < ns0) { gdn_scan_item(p, it, lds_raw); continue; }
        if (it < ns1) { gla_scan_item(p, it - ns0); continue; }
        it -= ns1;
        const int qt = (SEQ / 128 - 1) - it / (BATCH * H_FOX), bh = it % (BATCH * H_FOX);
        fox_attn_item(p, l, bh, qt, lds_raw);
    }
}

#define NPHASE 19
__global__ void __launch_bounds__(256, 2) mk(Params p, int lo, int hi, int use_bar) {
    __shared__ __attribute__((aligned(16))) unsigned char lds_raw[LDS_BYTES];
    bf16_t* lds = (bf16_t*)lds_raw;
    volatile LAS unsigned* st = (volatile LAS unsigned*)(lds_raw + LDS_BYTES - 16);
    XcdBarrier bar; bar.bar = (unsigned*)(p.ws + WS_CTL) + CW_BAR; bar.x = 0; bar.st = st;
    if (use_bar) {
        if (threadIdx.x == 0) { st[0] = 0u; st[1] = 0u; }
        __syncthreads();
        bar = xcd_barrier_post((unsigned*)(p.ws + WS_CTL) + CW_BAR, st);
    }
    for (int ph = lo; ph < hi; ++ph) {
#ifndef PSEL
#define PSEL 0xffff
#endif
        int phv = ph; asm volatile("" : "+s"(phv));
        Params q = p; asm volatile("" : "+s"(q.ws)); asm volatile("" : "+s"(q.out));
        if (phv == 0) { if (PSEL & 1) phase0(q); }
        else {
            int l = (phv - 1) / 9, s = (phv - 1) % 9;
            if (s == 0) { if (PSEL & 2) phase_inproj(q, l, lds); }
            else if (s == 1) { if (PSEL & 128) phase_prep(q, l, lds_raw); }
            else if (s == 2) { if (PSEL & 256) phase_scan_attn(q, l, lds_raw); }
            else if (s == 3) { if (PSEL & 512) phase_mixout(q, l); }
            else if (s == 4) { if (PSEL & 4) phase_outproj(q, l, lds); }
            else if (s == 5) { if (PSEL & 8) phase_route(q, l, lds); }
            else if (s == 6) { if (PSEL & 16) phase_expert<0>(q, l, lds); }
            else if (s == 7) { if (PSEL & 32) phase_expert<1>(q, l, lds); }
            else if (s == 8) { if (PSEL & 64) phase_combine(q, l); }
        }
        if (ph + 1 < hi) {
            if (use_bar == 2 && ph == lo) { cg::this_grid().sync(); }
            else xcd_barrier(bar);
        }
    }
}

__global__ void k_fox_cumsum(const float* __restrict__ aux, const float* __restrict__ fbias, float* __restrict__ cum) {
    int id = blockIdx.x * blockDim.x + threadIdx.x;
    if (id >= BATCH * H_FOX) return;
    int b = id / H_FOX, h = id % H_FOX;
    float c = 0.f;
    for (int s = 0; s < SEQ; ++s) {
        float f = aux[(size_t)(b * SEQ + s) * 64 + AX_FF + h] + fbias[h];
        c += logsigmoidf_(f);
        cum[(size_t)id * SEQ + s] = c;
    }
}
__global__ void __launch_bounds__(64) k_fox_attn(const bf16_t* __restrict__ proj, const bf16_t* __restrict__ vtf, const float* __restrict__ cum, const float* __restrict__ og, bf16_t* __restrict__ mix) {
    int bh = blockIdx.y; int b = bh / H_FOX, h = bh % H_FOX;
    int t = blockIdx.x * 64 + threadIdx.x;
    const bf16_t* qp = proj + (size_t)(b * SEQ + t) * NPROJ + NC_FQ + h * 64;
    float q[64], o[64];
#pragma unroll
    for (int d = 0; d < 64; ++d) { q[d] = bf2f(qp[d]); o[d] = 0.f; }
    float ct = cum[(size_t)bh * SEQ + t];
    float m = -1e30f, l = 0.f;
    int smax = blockIdx.x * 64 + 63;
    for (int s = 0; s <= smax; ++s) {
        const bf16_t* kp = proj + (size_t)(b * SEQ + s) * NPROJ + NC_FK + h * 64;
        const bf16_t* vp = vtf + (size_t)bh * 64 * SEQ + s;
        float dot = 0.f;
#pragma unroll
        for (int d = 0; d < 64; ++d) dot += q[d] * bf2f(kp[d]);
        float lg = dot + ct - cum[(size_t)bh * SEQ + s];
        if (s <= t) {
            float mn = fmaxf(m, lg);
            float a = __expf(m - mn), pp = __expf(lg - mn);
            l = l * a + pp;
#pragma unroll
            for (int d = 0; d < 64; ++d) o[d] = o[d] * a + pp * bf2f(vp[(size_t)d * SEQ]);
            m = mn;
        }
    }
    float inv = 1.f / l; float ss = 0.f;
#pragma unroll
    for (int d = 0; d < 64; ++d) { o[d] *= inv; ss += o[d] * o[d]; }
    float r = rsqrtf(ss / 64.f + 1e-6f);
    bf16_t* mp = mix + (size_t)(b * SEQ + t) * D_MODEL + h * 64;
#pragma unroll
    for (int d = 0; d < 64; d += 2) *(unsigned*)(mp + d) = pk_bf16(o[d] * r * og[d], o[d + 1] * r * og[d + 1]);
}
__global__ void k_gdn_prep(const bf16_t* __restrict__ proj, const float* __restrict__ convw, float* __restrict__ gq) {
    int gw = blockIdx.x * 4 + (threadIdx.x >> 6);
    int lane = threadIdx.x & 63;
    int grp = gw % 18; int t = gw / 18;
    if (t >= NTOK) return;
    int s = t % SEQ;
    int c = grp * 64 + lane;
    float acc = 0.f;
#pragma unroll
    for (int i = 0; i < 4; ++i) {
        int ss = s - 3 + i;
        if (ss >= 0) acc += convw[i * 1152 + c] * bf2f(proj[(size_t)(t - 3 + i) * NPROJ + NC_GQ + c]);
    }
    float v = siluf_(acc);
    int which = grp / 6;
    if (which < 2) {
        float ss2 = wave_sum(v * v);
        v *= rsqrtf(ss2 + 1e-6f);
        if (which == 0) v *= 0.125f;
    }
    gq[(size_t)t * 1152 + c] = v;
}
__global__ void __launch_bounds__(64) k_gdn_seq(const bf16_t* __restrict__ proj, const float* __restrict__ aux, const float* __restrict__ gq, const float* __restrict__ a_log, const float* __restrict__ dt_bias,
                                                const float* __restrict__ og, bf16_t* __restrict__ mix) {
    int bh = blockIdx.x; int b = bh / H_GDN, h = bh % H_GDN; int e = threadIdx.x;
    float S[64];
#pragma unroll
    for (int d = 0; d < 64; ++d) S[d] = 0.f;
    float A = -__expf(a_log[h]); float dtb = dt_bias[h];
    for (int s = 0; s < SEQ; ++s) {
        size_t t = (size_t)b * SEQ + s;
        const float* qp = gq + t * 1152 + h * 64;
        const float* kp = gq + t * 1152 + 384 + h * 64;
        float v = gq[t * 1152 + 768 + h * 64 + e];
        float g = A * softplusf_(aux[t * 64 + AX_GA + h] + dtb);
        float beta = sigmoidf_(aux[t * 64 + AX_GB + h]);
        float a = __expf(g);
        float kS = 0.f;
#pragma unroll
        for (int d = 0; d < 64; ++d) { S[d] *= a; kS += kp[d] * S[d]; }
        float vn = beta * (v - kS);
        float o = 0.f;
#pragma unroll
        for (int d = 0; d < 64; ++d) { S[d] += kp[d] * vn; o += qp[d] * S[d]; }
        float ss = wave_sum(o * o);
        float r = rsqrtf(ss / 64.f + 1e-6f);
        float gate = bf2f(proj[t * NPROJ + NC_GG + h * 64 + e]);
        float ov = o * r * og[e] * gate;
        float on = __shfl_down(ov, 1, 64);
        if ((e & 1) == 0) *(unsigned*)(mix + t * D_MODEL + 384 + h * 64 + e) = pk_bf16(ov, on);
    }
}
__global__ void k_gla_loga(const float* __restrict__ aux, const float* __restrict__ wa2, const float* __restrict__ ba, float* __restrict__ la) {
    int id = blockIdx.x * blockDim.x + threadIdx.x;
    if (id >= NTOK * 128) return;
    int t = id / 128, j = id % 128;
    float acc = ba[j];
#pragma unroll
    for (int r = 0; r < 16; ++r) acc += aux[(size_t)t * 64 + AX_LA + r] * wa2[r * 128 + j];
    la[id] = logsigmoidf_(acc) * (1.f / 16.f);
}
__global__ void __launch_bounds__(64) k_gla_seq(const bf16_t* __restrict__ proj, const bf16_t* __restrict__ lvt, const float* __restrict__ la, const float* __restrict__ og, bf16_t* __restrict__ mix) {
    int bh = blockIdx.x; int b = bh / H_GLA, h = bh % H_GLA; int e = threadIdx.x;
    float S[32];
#pragma unroll
    for (int d = 0; d < 32; ++d) S[d] = 0.f;
    for (int s = 0; s < SEQ; ++s) {
        size_t t = (size_t)b * SEQ + s;
        const bf16_t* qp = proj + t * NPROJ + NC_LQ + h * 32;
        const bf16_t* kp = proj + t * NPROJ + NC_LK + h * 32;
        const float* lp = la + t * 128 + h * 32;
        float v = bf2f(lvt[((size_t)bh * 64 + e) * SEQ + s]);
        float o = 0.f;
#pragma unroll
        for (int d = 0; d < 32; ++d) { S[d] = S[d] * __expf(lp[d]) + bf2f(kp[d]) * v; o += bf2f(qp[d]) * S[d]; }
        float ss = wave_sum(o * o);
        float r = rsqrtf(ss / 64.f + 1e-6f);
        float rr = bf2f(proj[t * NPROJ + NC_LR + h * 64 + e]);
        float ov = o * r * og[e] * rr;
        float on = __shfl_down(ov, 1, 64);
        if ((e & 1) == 0) *(unsigned*)(mix + t * D_MODEL + 768 + h * 64 + e) = pk_bf16(ov, on);
    }
}

extern "C" void kernel_launch(void* const* d_in, const int* in_sizes, int n_in,
                              void* d_out, int out_size, void* d_ws, size_t ws_size,
                              hipStream_t stream) {
    static int grid = 0;
    if (grid == 0) {
        if (ws_size < WS_END) { fprintf(stderr, "ws too small: need %zu have %zu\n", (size_t)WS_END, ws_size); grid = -1; return; }
        int dev = 0, cus = 0, per_cu = 0;
        hipGetDevice(&dev);
        hipDeviceGetAttribute(&cus, hipDeviceAttributeMultiprocessorCount, dev);
        hipOccupancyMaxActiveBlocksPerMultiprocessor(&per_cu, mk, 256, 0);
        if (per_cu > 2) per_cu = 2;
        if (per_cu < 1) { fprintf(stderr, "occupancy query failed\n"); grid = -1; return; }
        grid = cus * per_cu;
        grid -= grid % 8;
    }
    if (grid < 0) return;
    Params p{};
    for (int i = 0; i < 23; ++i) p.in[i] = (const float*)d_in[i];
    p.out = (float*)d_out; p.ws = (char*)d_ws;
    hipMemsetAsync((char*)d_ws + WS_CTL, 0, CTL_BYTES, stream);
#ifdef POISON_GLA
    hipMemsetAsync((char*)d_ws + WS_SCR + SCR_GLA_OL, 0xFF, SCR_LVT - SCR_GLA_OL, stream);
#endif

    char* ws = (char*)d_ws;
    const bf16_t* proj = (const bf16_t*)(ws + WS_PROJ);
    const bf16_t* vtf = (const bf16_t*)(ws + WS_VTF);
    const float* aux = (const float*)(ws + WS_AUX);
    float* cum = (float*)(ws + WS_CUM);
    bf16_t* mix = (bf16_t*)(ws + WS_MIX);
    float* gq = (float*)(ws + WS_SCR);
    float* la = (float*)(ws + WS_H);
    la = (float*)(ws + WS_SCR + (size_t)76 * 1024 * 1024);

    auto run = [&](int lo, int hi) {
        int ub = 0;
        mk<<<grid, 256, 0, stream>>>(p, lo, hi, ub);
    };
    for (int ph = 0; ph <= 1; ++ph) run(ph, ph + 1);
    for (int l = 0; l < 2; ++l) {
        if (l == 1) run(10, 11);
        if (!(MIXSEL & 1)) {
            k_gdn_prep<<<NTOK * 18 / 4, 256, 0, stream>>>(proj, p.in[7] + (size_t)l * 4 * 1152, gq);
            k_gdn_seq<<<BATCH * H_GDN, 64, 0, stream>>>(proj, aux, gq, p.in[8] + l * H_GDN, p.in[9] + l * H_GDN, p.in[10] + l * 64, mix);
        }
        if (!(MIXSEL & 2)) {
            k_gla_loga<<<NTOK * 128 / 256, 256, 0, stream>>>(aux, p.in[11] + (size_t)l * 16 * 128, p.in[12] + l * 128, la);
            k_gla_seq<<<BATCH * H_GLA, 64, 0, stream>>>(proj, (const bf16_t*)(ws + WS_SCR + SCR_LVT), la, p.in[13] + l * 64, mix);
        }
        for (int s = 1; s <= 3; ++s) run(1 + 9 * l + s, 1 + 9 * l + s + 1);
#ifdef GLA_NAIVE_AFTER
        k_gla_loga<<<NTOK * 128 / 256, 256, 0, stream>>>(aux, p.in[11] + (size_t)l * 16 * 128, p.in[12] + l * 128, (float*)(ws + WS_SCR));
        k_gla_seq<<<BATCH * H_GLA, 64, 0, stream>>>(proj, (const bf16_t*)(ws + WS_SCR + SCR_LVT), (float*)(ws + WS_SCR), p.in[13] + l * 64, mix);
#endif
        for (int s = 4; s <= 8; ++s) run(1 + 9 * l + s, 1 + 9 * l + s + 1);
    }
}
```

```cpp
#include <hip/hip_runtime.h>
#include <hip/hip_cooperative_groups.h>
#include <cstdint>
#include <cstdio>
namespace cg = cooperative_groups;

#define D_MODEL 1024
#define BATCH 4
#define SEQ 4096
#define NTOK (BATCH * SEQ)
#define H_FOX 6
#define H_GDN 6
#define H_GLA 4
#define N_IN 3490
#define N_EXP 32
#define D_EXP 512
#define NPROJ 3456
#define NINP 3584

#define C_FF 1152
#define C_GQ 1158
#define C_GG 2310
#define C_GA 2694
#define C_GB 2700
#define C_LQ 2706
#define C_LA 3474
#define NC_FQ 0
#define NC_FK 384
#define NC_FV 768
#define NC_GQ 1152
#define NC_GK 1536
#define NC_GV 1920
#define NC_GG 2304
#define NC_LQ 2688
#define NC_LK 2816
#define NC_LV 2944
#define NC_LR 3200
#define AX_FF 0
#define AX_GA 6
#define AX_GB 12
#define AX_LA 18

#ifndef MIXSEL
#define MIXSEL 3
#endif
typedef unsigned short bf16_t;
typedef short bf16x8 __attribute__((ext_vector_type(8)));
typedef float f32x4 __attribute__((ext_vector_type(4)));
typedef unsigned u32x4 __attribute__((ext_vector_type(4)));

#define WS_CTL      0
#define CTL_BYTES   65536
#define WS_WIN      (WS_CTL + CTL_BYTES)
#define WS_WOUT     (WS_WIN + (size_t)2 * NINP * 1024 * 2)
#define WS_WGU      (WS_WOUT + (size_t)2 * 1024 * 1024 * 2)
#define WS_WD       (WS_WGU + (size_t)2 * 32 * 1024 * 1024 * 2)
#define WS_WR       (WS_WD + (size_t)2 * 32 * 1024 * 512 * 2)
#define WS_HN       (WS_WR + (size_t)2 * 64 * 1024 * 2)
#define WS_PROJ     (WS_HN + (size_t)NTOK * 1024 * 2)
#define WS_VTF      (WS_PROJ + (size_t)NTOK * NPROJ * 2)
#define WS_AUX      (WS_VTF + (size_t)BATCH * H_FOX * 64 * SEQ * 2)
#define WS_CUM      (WS_AUX + (size_t)NTOK * 64 * 4)
#define WS_MIX      (WS_CUM + (size_t)BATCH * H_FOX * SEQ * 4)
#define WS_ROWTOK   (WS_MIX + (size_t)NTOK * 1024 * 2)
#define WS_TSLOT    (WS_ROWTOK + (size_t)32 * NTOK * 4)
#define WS_TGATE    (WS_TSLOT + (size_t)NTOK * 2 * 4)
#define WS_SCR      (WS_TGATE + (size_t)NTOK * 2 * 4)
#define SCR_BYTES   ((size_t)100 * 1024 * 1024)
#define WS_END      (WS_SCR + SCR_BYTES)
#define HROWS       (2 * NTOK + 32 * 128)
#define WS_H        WS_PROJ
#define WS_Y        (WS_PROJ + (size_t)HROWS * 512 * 2)

#define NGDN_CH 1536
#define NGLA_CH 1024
#define SCR_GDN_MP   ((size_t)0)
#define SCR_GDN_NN   (SCR_GDN_MP + (size_t)NGDN_CH * 8192)
#define SCR_GDN_P    (SCR_GDN_NN + (size_t)NGDN_CH * 8192)
#define SCR_GDN_OL   (SCR_GDN_P  + (size_t)NGDN_CH * 8192)
#define SCR_GDN_SG   (SCR_GDN_OL + (size_t)NGDN_CH * 8192)
#define SCR_GDN_LAST (SCR_GDN_SG + (size_t)NGDN_CH * 8192)
#define SCR_GLA_OL   (SCR_GDN_LAST + (size_t)NGDN_CH * 4)
#define SCR_GLA_KV   (SCR_GLA_OL + (size_t)NGLA_CH * 8192)
#define SCR_GLA_QB   (SCR_GLA_KV + (size_t)NGLA_CH * 8192)
#define SCR_GLA_SG   (SCR_GLA_QB + (size_t)NGLA_CH * 4096)
#define SCR_GLA_DL   (SCR_GLA_SG + (size_t)NGLA_CH * 4096)
#define SCR_LVT      (SCR_GLA_DL + (size_t)NGLA_CH * 128)
#define SCR_USED     (SCR_LVT + (size_t)BATCH * H_GLA * 64 * SEQ * 2)
static_assert(SCR_USED <= SCR_BYTES, "scratch overflow");
#define CW_BAR      0
#define CW_CNT      4096
#define CW_Q        4224

struct Params {
    const float* in[23];
    float* out;
    char* ws;
};

__device__ __forceinline__ float sigmoidf_(float x) { return 1.f / (1.f + __expf(-x)); }
__device__ __forceinline__ float siluf_(float x) { return x / (1.f + __expf(-x)); }
__device__ __forceinline__ float softplusf_(float x) { return x > 20.f ? x : log1pf(__expf(x)); }
__device__ __forceinline__ float logsigmoidf_(float x) { return -softplusf_(-x); }
__device__ __forceinline__ float wave_sum(float v) {
#pragma unroll
    for (int o = 32; o > 0; o >>= 1) v += __shfl_xor(v, o, 64);
    return v;
}
__device__ __forceinline__ int ltid() { int t = threadIdx.x; asm volatile("" : "+v"(t)); return t; }
typedef __bf16 bf16x2_t __attribute__((ext_vector_type(2)));
typedef float f32x2_t __attribute__((ext_vector_type(2)));
__device__ __forceinline__ unsigned pk_bf16(float lo, float hi) { f32x2_t v = {lo, hi}; bf16x2_t r = __builtin_convertvector(v, bf16x2_t); return __builtin_bit_cast(unsigned, r); }
__device__ __forceinline__ unsigned ld_u32_agent(const unsigned* p) { return __hip_atomic_load(p, __ATOMIC_RELAXED, __HIP_MEMORY_SCOPE_AGENT); }
__device__ __forceinline__ float ld_f32_agent(const float* p) { return __uint_as_float(__hip_atomic_load((const unsigned*)p, __ATOMIC_RELAXED, __HIP_MEMORY_SCOPE_AGENT)); }
__device__ __forceinline__ float bf2f(bf16_t v) { return __uint_as_float((unsigned)v << 16); }
__device__ __forceinline__ float bflo(unsigned v) { return __uint_as_float(v << 16); }
__device__ __forceinline__ float bfhi(unsigned v) { return __uint_as_float(v & 0xffff0000u); }

#define XB_TMO      128
#define XB_XCNT(j)  (256  + 64 * (j))
#define XB_XSUB(j)  (1280 + 64 * (j))
#define XB_XGEN(j)  (2304 + 64 * (j))
#define XB_TOP      3328
#define XB_TOPGEN   3392
#define XCD_BAR_WORDS 3456
#define XB_SPIN_CAP (1u << 22)
#define LAS __attribute__((address_space(3)))
__device__ __forceinline__ unsigned xb_ld(unsigned* p)              { return __hip_atomic_load(p, __ATOMIC_RELAXED, __HIP_MEMORY_SCOPE_AGENT); }
__device__ __forceinline__ unsigned xb_add(unsigned* p, unsigned v) { return __hip_atomic_fetch_add(p, v, __ATOMIC_RELAXED, __HIP_MEMORY_SCOPE_AGENT); }
__device__ __forceinline__ unsigned xb_xcc_id() { return (unsigned)__builtin_amdgcn_s_getreg((3 << 11) | 20) & 0xFu; }
#define XB_SPIN(cond, bar) do { unsigned _sp = 0; while (cond) { __builtin_amdgcn_s_sleep(1); \
    if ((++_sp & 255u) == 0u) { if (xb_ld(&(bar)[XB_TMO])) break; if (_sp > XB_SPIN_CAP) { atomicAdd(&(bar)[XB_TMO], 1u); break; } } } } while (0)
struct XcdBarrier { unsigned* bar; unsigned x; volatile LAS unsigned* st; };
__device__ __forceinline__ XcdBarrier xcd_barrier_post(unsigned* bar, volatile LAS unsigned* st) {
    XcdBarrier b; b.bar = bar; b.x = xb_xcc_id(); b.st = st;
    if (threadIdx.x == 0) (void)xb_add(&bar[XB_XCNT(b.x)], 1u);
    return b;
}
__device__ __forceinline__ void xcd_barrier_complete(unsigned* bar, unsigned x, unsigned& nloc, unsigned& nx) {
    const unsigned G = gridDim.x * gridDim.y * gridDim.z;
    unsigned sum, cnt, mine, sp = 0u;
    for (;;) {
        sum = 0u; cnt = 0u; mine = 0u;
#pragma unroll
        for (unsigned j = 0; j < 16; ++j) { const unsigned c = xb_ld(&bar[XB_XCNT(j)]); sum += c; cnt += (c > 0u) ? 1u : 0u; mine = (j == x) ? c : mine; }
        if (sum == G) break;
        __builtin_amdgcn_s_sleep(1);
        if ((++sp & 255u) == 0u) { if (xb_ld(&bar[XB_TMO])) break; if (sp > XB_SPIN_CAP) { atomicAdd(&bar[XB_TMO], 1u); break; } }
    }
    nloc = mine > 0u ? mine : 1u; nx = cnt > 0u ? cnt : 1u;
}
__device__ __forceinline__ void xcd_barrier(const XcdBarrier& b) {
    asm volatile("s_waitcnt vmcnt(0)" ::: "memory");
    __syncthreads();
    if (threadIdx.x == 0) {
        unsigned* bar = b.bar;
        __builtin_amdgcn_s_waitcnt(0);
        unsigned nloc = b.st[0], nx = b.st[1];
        if (nloc == 0u) { xcd_barrier_complete(bar, b.x, nloc, nx); b.st[0] = nloc; b.st[1] = nx; }
        const unsigned old = xb_add(&bar[XB_XSUB(b.x)], 1u);
        const unsigned gen = old / nloc;
        if (old + 1u == (gen + 1u) * nloc) {
            __builtin_amdgcn_fence(__ATOMIC_RELEASE, "agent");
            asm volatile("s_waitcnt vmcnt(0)" ::: "memory");
            const unsigned og = xb_add(&bar[XB_TOP], 1u);
            const unsigned tg = og / nx;
            if (og + 1u == (tg + 1u) * nx) xb_add(&bar[XB_TOPGEN], 1u);
            else XB_SPIN(xb_ld(&bar[XB_TOPGEN]) == tg, bar);
            __builtin_amdgcn_fence(__ATOMIC_ACQUIRE, "agent");
            xb_add(&bar[XB_XGEN(b.x)], 1u);
            asm volatile("s_waitcnt vmcnt(0)" ::: "memory");
        } else {
            XB_SPIN(xb_ld(&bar[XB_XGEN(b.x)]) == gen, bar);
            __builtin_amdgcn_fence(__ATOMIC_ACQUIRE, "agent");
            asm volatile("s_waitcnt vmcnt(0)" ::: "memory");
        }
    }
    __syncthreads();
}

#define LDS_BYTES 57344
#define LROW 72

__device__ __forceinline__ int inproj_map(int n) {
    if (n < 1152) return n;
    if (n < 2304) return C_GQ + (n - 1152);
    if (n < 2688) return C_GG + (n - 2304);
    if (n < 3456) return C_LQ + (n - 2688);
    if (n < 3462) return C_FF + (n - 3456);
    if (n < 3468) return C_GA + (n - 3462);
    if (n < 3474) return C_GB + (n - 3468);
    if (n < 3490) return n;
    return -1;
}
__device__ __forceinline__ void conv_tile(const float* __restrict__ src, int ld, int col, bf16_t* __restrict__ dst_row, int k0) {
    float v[16];
    if (col >= 0) {
#pragma unroll
        for (int i = 0; i < 16; ++i) v[i] = src[(size_t)(k0 + i) * ld + col];
    } else {
#pragma unroll
        for (int i = 0; i < 16; ++i) v[i] = 0.f;
    }
    uint4 o0, o1;
    o0.x = pk_bf16(v[0], v[1]); o0.y = pk_bf16(v[2], v[3]); o0.z = pk_bf16(v[4], v[5]); o0.w = pk_bf16(v[6], v[7]);
    o1.x = pk_bf16(v[8], v[9]); o1.y = pk_bf16(v[10], v[11]); o1.z = pk_bf16(v[12], v[13]); o1.w = pk_bf16(v[14], v[15]);
    *(uint4*)(dst_row + k0) = o0;
    *(uint4*)(dst_row + k0 + 8) = o1;
}
#define P0_T_IN   (56 * 16)
#define P0_T_OUT  (16 * 16)
#define P0_T_GU   (32 * 16 * 16)
#define P0_T_D    (32 * 16 * 8)
#define P0_T_R    (16)
#define P0_T_LAYER (P0_T_IN + P0_T_OUT + P0_T_GU + P0_T_D + P0_T_R)
#define P0_T_NORM (NTOK / 4)
__device__ void phase0(const Params& p) {
    const int tid = ltid(), nl = tid & 63, kg = tid >> 6;
    const int total = 2 * P0_T_LAYER + P0_T_NORM;
    for (int it = blockIdx.x; it < total; it += gridDim.x) {
        if (it >= 2 * P0_T_LAYER) {
            int row = (it - 2 * P0_T_LAYER) * 4 + kg;
            const float* xr = p.in[0] + (size_t)row * D_MODEL + nl * 16;
            const float* gr = p.in[1] + nl * 16;
            float v[16]; float ss = 0.f;
#pragma unroll
            for (int i = 0; i < 4; ++i) { float4 t = *(const float4*)(xr + 4 * i); v[4 * i] = t.x; v[4 * i + 1] = t.y; v[4 * i + 2] = t.z; v[4 * i + 3] = t.w; }
#pragma unroll
            for (int i = 0; i < 16; ++i) ss += v[i] * v[i];
            ss = wave_sum(ss);
            float r = rsqrtf(ss / D_MODEL + 1e-6f);
#pragma unroll
            for (int i = 0; i < 16; ++i) v[i] = v[i] * r * gr[i];
            uint4 o0, o1;
            o0.x = pk_bf16(v[0], v[1]); o0.y = pk_bf16(v[2], v[3]); o0.z = pk_bf16(v[4], v[5]); o0.w = pk_bf16(v[6], v[7]);
            o1.x = pk_bf16(v[8], v[9]); o1.y = pk_bf16(v[10], v[11]); o1.z = pk_bf16(v[12], v[13]); o1.w = pk_bf16(v[14], v[15]);
            bf16_t* hr = (bf16_t*)(p.ws + WS_HN) + (size_t)row * D_MODEL + nl * 16;
            *(uint4*)hr = o0; *(uint4*)(hr + 8) = o1;
            continue;
        }
        int l = it / P0_T_LAYER, j = it % P0_T_LAYER;
        if (j < P0_T_IN) {
            int tn = j / 16, tk = j % 16; int n = tn * 64 + nl;
            conv_tile(p.in[2] + (size_t)l * 1024 * N_IN, N_IN, inproj_map(n), (bf16_t*)(p.ws + WS_WIN) + ((size_t)l * NINP + n) * 1024, tk * 64 + kg * 16);
            continue;
        }
        j -= P0_T_IN;
        if (j < P0_T_OUT) {
            int tn = j / 16, tk = j % 16; int n = tn * 64 + nl;
            conv_tile(p.in[14] + (size_t)l * 1024 * 1024, 1024, n, (bf16_t*)(p.ws + WS_WOUT) + ((size_t)l * 1024 + n) * 1024, tk * 64 + kg * 16);
            continue;
        }
        j -= P0_T_OUT;
        if (j < P0_T_GU) {
            int e = j / 256, r = j % 256; int tn = r / 16, tk = r % 16; int n = tn * 64 + nl;
            int t128 = n >> 7, wx = (n >> 6) & 1, half = (n >> 5) & 1, jj = n & 31;
            int hid = t128 * 64 + wx * 32 + jj;
            const float* src = (half ? p.in[21] : p.in[20]) + ((size_t)l * 32 + e) * 1024 * 512;
            conv_tile(src, 512, hid, (bf16_t*)(p.ws + WS_WGU) + (((size_t)l * 32 + e) * 1024 + n) * 1024, tk * 64 + kg * 16);
            continue;
        }
        j -= P0_T_GU;
        if (j < P0_T_D) {
            int e = j / 128, r = j % 128; int tn = r / 8, tk = r % 8; int n = tn * 64 + nl;
            const float* src = p.in[22] + ((size_t)l * 32 + e) * 512 * 1024;
            conv_tile(src, 1024, n, (bf16_t*)(p.ws + WS_WD) + (((size_t)l * 32 + e) * 1024 + n) * 512, tk * 64 + kg * 16);
            continue;
        }
        j -= P0_T_D;
        {
            int tk = j; int n = nl;
            const float* src; int ld, col;
            if (n < 4) { src = p.in[16] + (size_t)l * 1024 * 4; ld = 4; col = n; }
            else if (n < 36) { src = p.in[18] + (size_t)l * 1024 * 32; ld = 32; col = n - 4; }
            else { src = p.in[16]; ld = 4; col = -1; }
            conv_tile(src, ld, col, (bf16_t*)(p.ws + WS_WR) + ((size_t)l * 64 + n) * 1024, tk * 64 + kg * 16);
        }
    }
}

__device__ __forceinline__ void gemm_core(const bf16_t* const (&px)[4], const bf16_t* const (&py)[4], int K, bf16_t* lds, f32x4 (&acc)[4][4]) {
    const int tid = ltid(), lane = tid & 63, w = tid >> 6, wx = w >> 1, wy = w & 1;
    bf16_t* Xs = lds; bf16_t* Ys = lds + 128 * LROW;
#pragma unroll
    for (int a = 0; a < 4; ++a)
#pragma unroll
        for (int b = 0; b < 4; ++b) acc[a][b] = (f32x4){0.f, 0.f, 0.f, 0.f};
    u32x4 rx[4], ry[4];
#pragma unroll
    for (int i = 0; i < 4; ++i) { rx[i] = *(const u32x4*)(px[i]); ry[i] = *(const u32x4*)(py[i]); }
    const int fr = lane & 15, fg = lane >> 4;
    for (int k0 = 0; k0 < K; k0 += 64) {
        __syncthreads();
#pragma unroll
        for (int i = 0; i < 4; ++i) {
            int c = tid + 256 * i; int row = c >> 3, kc = c & 7;
            *(u32x4*)(Xs + row * LROW + kc * 8) = rx[i];
            *(u32x4*)(Ys + row * LROW + kc * 8) = ry[i];
        }
        __syncthreads();
        if (k0 + 64 < K) {
#pragma unroll
            for (int i = 0; i < 4; ++i) { rx[i] = *(const u32x4*)(px[i] + k0 + 64); ry[i] = *(const u32x4*)(py[i] + k0 + 64); }
        }
#pragma unroll
        for (int ks = 0; ks < 2; ++ks) {
            bf16x8 xa[4], yb[4];
#pragma unroll
            for (int m = 0; m < 4; ++m) xa[m] = *(const bf16x8*)(Xs + (wx * 64 + m * 16 + fr) * LROW + ks * 32 + fg * 8);
#pragma unroll
            for (int n = 0; n < 4; ++n) yb[n] = *(const bf16x8*)(Ys + (wy * 64 + n * 16 + fr) * LROW + ks * 32 + fg * 8);
#pragma unroll
            for (int m = 0; m < 4; ++m)
#pragma unroll
                for (int n = 0; n < 4; ++n) acc[m][n] = __builtin_amdgcn_mfma_f32_16x16x32_bf16(xa[m], yb[n], acc[m][n], 0, 0, 0);
        }
    }
}
__device__ __forceinline__ void store4_bf16(bf16_t* p, float a, float b, float c, float d) {
    uint2 o; o.x = pk_bf16(a, b); o.y = pk_bf16(c, d); *(uint2*)p = o;
}

__device__ __forceinline__ bool xcd_item(int round, int ntm, int ntn, int& tm, int& tn) {
    const int x = blockIdx.x & 7, loc = blockIdx.x >> 3, nloc = gridDim.x >> 3;
    const int tmx = ntm >> 3;
    const int j = round * nloc + loc;
    if (j >= tmx * ntn) return false;
    tn = j / tmx; tm = (j % tmx) * 8 + x;
    return true;
}

__device__ void phase_inproj(const Params& p, int l, bf16_t* lds) {
    const int tid = ltid(), lane = tid & 63, w = tid >> 6, wx = w >> 1, wy = w & 1, fr = lane & 15, fg = lane >> 4;
    const bf16_t* hn = (const bf16_t*)(p.ws + WS_HN);
    const bf16_t* wt = (const bf16_t*)(p.ws + WS_WIN) + (size_t)l * NINP * 1024;
    bf16_t* proj = (bf16_t*)(p.ws + WS_PROJ);
    bf16_t* vtf = (bf16_t*)(p.ws + WS_VTF);
    float* aux = (float*)(p.ws + WS_AUX);
    const float* qg = p.in[3] + l * 64; const float* kg = p.in[4] + l * 64;
    for (int round = 0;; ++round) {
        int tm, tn;
        if (!xcd_item(round, NTOK / 128, NINP / 128, tm, tn)) break;
        const bool vt = (tn >= 6 && tn < 9) || tn == 23 || tn == 24;
        const bf16_t* px[4]; const bf16_t* py[4];
#pragma unroll
        for (int i = 0; i < 4; ++i) {
            int c = tid + 256 * i; int row = c >> 3, kc = c & 7;
            const bf16_t* pw = wt + (size_t)(tn * 128 + row) * 1024 + kc * 8;
            const bf16_t* pt = hn + (size_t)(tm * 128 + row) * 1024 + kc * 8;
            px[i] = vt ? pt : pw; py[i] = vt ? pw : pt;
        }
        f32x4 acc[4][4];
        gemm_core(px, py, 1024, lds, acc);
        if (vt) {
#pragma unroll
            for (int n = 0; n < 4; ++n) {
                const bool fox = tn < 9;
                int ch = tn * 128 + wy * 64 + n * 16 + fr - (fox ? NC_FV : NC_LV); int h = ch >> 6, e = ch & 63;
                bf16_t* dst = fox ? vtf : (bf16_t*)(p.ws + WS_SCR + SCR_LVT); const int nh = fox ? H_FOX : H_GLA;
#pragma unroll
                for (int m = 0; m < 4; ++m) {
                    int t = tm * 128 + wx * 64 + m * 16 + 4 * fg; int b = t / SEQ, s = t % SEQ;
                    store4_bf16(dst + ((size_t)(b * nh + h) * 64 + e) * SEQ + s, acc[m][n][0], acc[m][n][1], acc[m][n][2], acc[m][n][3]);
                }
            }
        } else {
            const int c0 = tn * 128 + wx * 64;
            if (tn < 6) {
                const float* gn = (tn < 3) ? qg : kg; const float sc = (tn < 3) ? 0.125f : 1.f;
                float g[4][4];
#pragma unroll
                for (int m = 0; m < 4; ++m)
#pragma unroll
                    for (int r = 0; r < 4; ++r) g[m][r] = gn[m * 16 + 4 * fg + r] * sc;
#pragma unroll
                for (int n = 0; n < 4; ++n) {
                    float ss = 0.f;
#pragma unroll
                    for (int m = 0; m < 4; ++m)
#pragma unroll
                        for (int r = 0; r < 4; ++r) ss += acc[m][n][r] * acc[m][n][r];
                    ss += __shfl_xor(ss, 16, 64); ss += __shfl_xor(ss, 32, 64);
                    float rs = rsqrtf(ss * (1.f / 64.f) + 1e-6f);
                    int t = tm * 128 + wy * 64 + n * 16 + fr;
#pragma unroll
                    for (int m = 0; m < 4; ++m)
                        store4_bf16(proj + (size_t)t * NPROJ + c0 + m * 16 + 4 * fg, acc[m][n][0] * rs * g[m][0], acc[m][n][1] * rs * g[m][1], acc[m][n][2] * rs * g[m][2], acc[m][n][3] * rs * g[m][3]);
                }
            } else if (tn == 27) {
#pragma unroll
                for (int n = 0; n < 4; ++n) {
                    int t = tm * 128 + wy * 64 + n * 16 + fr;
#pragma unroll
                    for (int m = 0; m < 4; ++m) {
                        int c = wx * 64 + m * 16 + 4 * fg;
                        if (c < 64) *(float4*)(aux + (size_t)t * 64 + c) = make_float4(acc[m][n][0], acc[m][n][1], acc[m][n][2], acc[m][n][3]);
                    }
                }
            } else {
                const bool do_silu = (tn >= 18 && tn < 21) || (tn >= 25);
                const float sc = (tn == 21) ? 0.17677669529663687f : 1.f;
#pragma unroll
                for (int n = 0; n < 4; ++n) {
                    int t = tm * 128 + wy * 64 + n * 16 + fr;
#pragma unroll
                    for (int m = 0; m < 4; ++m) {
                        float v0 = acc[m][n][0] * sc, v1 = acc[m][n][1] * sc, v2 = acc[m][n][2] * sc, v3 = acc[m][n][3] * sc;
                        if (do_silu) { v0 = siluf_(v0); v1 = siluf_(v1); v2 = siluf_(v2); v3 = siluf_(v3); }
                        store4_bf16(proj + (size_t)t * NPROJ + c0 + m * 16 + 4 * fg, v0, v1, v2, v3);
                    }
                }
            }
        }
    }
}

__device__ void phase_outproj(const Params& p, int l, bf16_t* lds) {
    const int tid = ltid(), lane = tid & 63, w = tid >> 6, wx = w >> 1, wy = w & 1, fr = lane & 15, fg = lane >> 4;
    const bf16_t* mix = (const bf16_t*)(p.ws + WS_MIX);
    const bf16_t* wt = (const bf16_t*)(p.ws + WS_WOUT) + (size_t)l * 1024 * 1024;
    const float* xin = (l == 0) ? p.in[0] : p.out;
    float* xo = p.out;
    for (int round = 0;; ++round) {
        int tm, tn;
        if (!xcd_item(round, NTOK / 128, 8, tm, tn)) break;
        const bf16_t* px[4]; const bf16_t* py[4];
#pragma unroll
        for (int i = 0; i < 4; ++i) {
            int c = tid + 256 * i; int row = c >> 3, kc = c & 7;
            px[i] = wt + (size_t)(tn * 128 + row) * 1024 + kc * 8;
            py[i] = mix + (size_t)(tm * 128 + row) * 1024 + kc * 8;
        }
        f32x4 acc[4][4];
        gemm_core(px, py, 1024, lds, acc);
#pragma unroll
        for (int n = 0; n < 4; ++n) {
            int t = tm * 128 + wy * 64 + n * 16 + fr;
#pragma unroll
            for (int m = 0; m < 4; ++m) {
                int c = tn * 128 + wx * 64 + m * 16 + 4 * fg;
                float4 xv = *(const float4*)(xin + (size_t)t * 1024 + c);
                xv.x += acc[m][n][0]; xv.y += acc[m][n][1]; xv.z += acc[m][n][2]; xv.w += acc[m][n][3];
                *(float4*)(xo + (size_t)t * 1024 + c) = xv;
            }
        }
    }
}

__device__ void phase_route(const Params& p, int l, bf16_t* lds) {
    const int tid = ltid(), lane = tid & 63, w = tid >> 6, fr = lane & 15, fg = lane >> 4;
    const float* x1 = p.out;
    const float* gain = p.in[15] + l * 1024;
    bf16_t* hn = (bf16_t*)(p.ws + WS_HN);
    const bf16_t* wr = (const bf16_t*)(p.ws + WS_WR) + (size_t)l * 64 * 1024;
    const float* brg = p.in[17] + l * 4; const float* bre = p.in[19] + l * 32;
    unsigned* cnt = (unsigned*)(p.ws + WS_CTL) + CW_CNT + l * 32;
    int* rowtok = (int*)(p.ws + WS_ROWTOK);
    int* tslot = (int*)(p.ws + WS_TSLOT);
    float* tgate = (float*)(p.ws + WS_TGATE);
    const int HL = 1032;
    float* red = (float*)(lds + 16 * HL);
    for (int it = blockIdx.x; it < NTOK / 16; it += gridDim.x) {
        __syncthreads();
#pragma unroll
        for (int rr = 0; rr < 4; ++rr) {
            int lr = w * 4 + rr; int t = it * 16 + lr;
            const float* xr = x1 + (size_t)t * 1024 + lane * 16;
            float v[16]; float ss = 0.f;
#pragma unroll
            for (int i = 0; i < 4; ++i) { float4 q = *(const float4*)(xr + 4 * i); v[4 * i] = q.x; v[4 * i + 1] = q.y; v[4 * i + 2] = q.z; v[4 * i + 3] = q.w; }
#pragma unroll
            for (int i = 0; i < 16; ++i) ss += v[i] * v[i];
            ss = wave_sum(ss);
            float r = rsqrtf(ss / D_MODEL + 1e-6f);
#pragma unroll
            for (int i = 0; i < 16; ++i) v[i] = v[i] * r * gain[lane * 16 + i];
            uint4 o0, o1;
            o0.x = pk_bf16(v[0], v[1]); o0.y = pk_bf16(v[2], v[3]); o0.z = pk_bf16(v[4], v[5]); o0.w = pk_bf16(v[6], v[7]);
            o1.x = pk_bf16(v[8], v[9]); o1.y = pk_bf16(v[10], v[11]); o1.z = pk_bf16(v[12], v[13]); o1.w = pk_bf16(v[14], v[15]);
            bf16_t* hr = hn + (size_t)t * 1024 + lane * 16;
            *(uint4*)hr = o0; *(uint4*)(hr + 8) = o1;
            *(uint4*)(lds + lr * HL + lane * 16) = o0; *(uint4*)(lds + lr * HL + lane * 16 + 8) = o1;
        }
        __syncthreads();
        f32x4 acc[3];
#pragma unroll
        for (int n = 0; n < 3; ++n) acc[n] = (f32x4){0.f, 0.f, 0.f, 0.f};
#pragma unroll
        for (int ks = 0; ks < 8; ++ks) {
            int k = w * 256 + ks * 32 + fg * 8;
            bf16x8 a = *(const bf16x8*)(lds + fr * HL + k);
#pragma unroll
            for (int n = 0; n < 3; ++n) {
                bf16x8 b = *(const bf16x8*)(wr + (size_t)(n * 16 + fr) * 1024 + k);
                acc[n] = __builtin_amdgcn_mfma_f32_16x16x32_bf16(a, b, acc[n], 0, 0, 0);
            }
        }
#pragma unroll
        for (int n = 0; n < 3; ++n) *(f32x4*)(red + ((w * 3 + n) * 64 + lane) * 4) = acc[n];
        __syncthreads();
        if (tid < 16) {
            float lg[36];
#pragma unroll
            for (int j = 0; j < 36; ++j) {
                int n = j >> 4, f = j & 15; int ln = (tid >> 2) * 16 + f; float s = 0.f;
#pragma unroll
                for (int ww = 0; ww < 4; ++ww) s += red[((ww * 3 + n) * 64 + ln) * 4 + (tid & 3)];
                lg[j] = s;
            }
            float gl[4]; float gm = -1e30f; int gi = 0;
#pragma unroll
            for (int j = 0; j < 4; ++j) { gl[j] = lg[j] + brg[j]; if (gl[j] > gm) { gm = gl[j]; gi = j; } }
            float gs = 0.f;
#pragma unroll
            for (int j = 0; j < 4; ++j) gs += __expf(gl[j] - gm);
            float gp = 1.f / gs;
            float el[8]; float em = -1e30f;
#pragma unroll
            for (int j = 0; j < 8; ++j) {
                float v = (gi == 0) ? lg[4 + j] : (gi == 1) ? lg[12 + j] : (gi == 2) ? lg[20 + j] : lg[28 + j];
                el[j] = v + bre[gi * 8 + j]; em = fmaxf(em, el[j]);
            }
#pragma unroll
            for (int j = 0; j < 8; ++j) el[j] = __expf(el[j] - em);
            float v0 = -1.f, v1 = -1.f; int i0 = 0, i1 = 0;
#pragma unroll
            for (int j = 0; j < 8; ++j) {
                float v = el[j];
                if (v > v0) { v1 = v0; i1 = i0; v0 = v; i0 = j; }
                else if (v > v1) { v1 = v; i1 = j; }
            }
            int t = it * 16 + tid;
            int e0 = gi * 8 + i0, e1 = gi * 8 + i1;
            unsigned s0 = atomicAdd(&cnt[e0], 1u), s1 = atomicAdd(&cnt[e1], 1u);
            rowtok[(size_t)e0 * NTOK + s0] = t; rowtok[(size_t)e1 * NTOK + s1] = t;
            tslot[t * 2] = (e0 << 16) | (int)s0; tslot[t * 2 + 1] = (e1 << 16) | (int)s1;
            tgate[t * 2] = gp * v0 / (v0 + v1); tgate[t * 2 + 1] = gp * v1 / (v0 + v1);
        }
    }
}

__device__ __forceinline__ void moe_tables(const unsigned* cnt, int* tab) {
    if (threadIdx.x == 0) {
        int a = 0;
        for (int e = 0; e < 32; ++e) { tab[e] = a; tab[40 + e] = a * 128; a += ((int)ld_u32_agent(cnt + e) + 127) >> 7; }
        tab[32] = a; tab[72] = a * 128;
    }
    __syncthreads();
}
template <int MODE>
__device__ void phase_expert(const Params& p, int l, bf16_t* lds) {
    const int tid = ltid(), lane = tid & 63, w = tid >> 6, wx = w >> 1, wy = w & 1, fr = lane & 15, fg = lane >> 4;
    const unsigned* cnt = (const unsigned*)(p.ws + WS_CTL) + CW_CNT + l * 32;
    int* tab = (int*)(lds + 2 * 128 * LROW);
    moe_tables(cnt, tab);
    const int* rowtok = (const int*)(p.ws + WS_ROWTOK);
    const bf16_t* hn = (const bf16_t*)(p.ws + WS_HN);
    bf16_t* Hb = (bf16_t*)(p.ws + WS_H);
    bf16_t* Yb = (bf16_t*)(p.ws + WS_Y);
    const int x = blockIdx.x & 7, loc = blockIdx.x >> 3, nloc = gridDim.x >> 3;
    for (int j = loc;; j += nloc) {
        int e = -1, rt = 0, tn = 0; int jj = j;
#pragma unroll
        for (int q = 0; q < 4; ++q) {
            int ee = q * 8 + x; int nrt = tab[ee + 1] - tab[ee];
            if (e < 0) { if (jj < nrt * 8) { e = ee; tn = jj / nrt; rt = jj % nrt; } else jj -= nrt * 8; }
        }
        if (e < 0) break;
        const int c_e = (int)ld_u32_agent(cnt + e); const int hrow0 = tab[40 + e] + rt * 128;
        const bf16_t* px[4]; const bf16_t* py[4];
#pragma unroll
        for (int i = 0; i < 4; ++i) {
            int c = tid + 256 * i; int row = c >> 3, kc = c & 7;
            if (MODE == 0) {
                px[i] = (const bf16_t*)(p.ws + WS_WGU) + (((size_t)l * 32 + e) * 1024 + tn * 128 + row) * 1024 + kc * 8;
                int s = rt * 128 + row; int t = (s < c_e) ? rowtok[(size_t)e * NTOK + s] : 0;
                py[i] = hn + (size_t)t * 1024 + kc * 8;
            } else {
                px[i] = (const bf16_t*)(p.ws + WS_WD) + (((size_t)l * 32 + e) * 1024 + tn * 128 + row) * 512 + kc * 8;
                py[i] = Hb + (size_t)(hrow0 + row) * 512 + kc * 8;
            }
        }
        f32x4 acc[4][4];
        gemm_core(px, py, MODE == 0 ? 1024 : 512, lds, acc);
        if (MODE == 0) {
#pragma unroll
            for (int n = 0; n < 4; ++n) {
                int hr = hrow0 + wy * 64 + n * 16 + fr;
#pragma unroll
                for (int m = 0; m < 2; ++m) {
                    int hc = tn * 64 + wx * 32 + m * 16 + 4 * fg;
                    store4_bf16(Hb + (size_t)hr * 512 + hc, siluf_(acc[m][n][0]) * acc[m + 2][n][0], siluf_(acc[m][n][1]) * acc[m + 2][n][1],
                                siluf_(acc[m][n][2]) * acc[m + 2][n][2], siluf_(acc[m][n][3]) * acc[m + 2][n][3]);
                }
            }
        } else {
#pragma unroll
            for (int n = 0; n < 4; ++n) {
                int hr = hrow0 + wy * 64 + n * 16 + fr;
#pragma unroll
                for (int m = 0; m < 4; ++m) {
                    int c = tn * 128 + wx * 64 + m * 16 + 4 * fg;
                    store4_bf16(Yb + (size_t)hr * 1024 + c, acc[m][n][0], acc[m][n][1], acc[m][n][2], acc[m][n][3]);
                }
            }
        }
    }
}

__device__ void phase_combine(const Params& p, int l) {
    const int tid = ltid(), lane = tid & 63, w = tid >> 6;
    const unsigned* cnt = (const unsigned*)(p.ws + WS_CTL) + CW_CNT + l * 32;
    int c = (lane < 32) ? (((int)ld_u32_agent(cnt + (lane & 31)) + 127) >> 7) * 128 : 0;
    int incl = c;
#pragma unroll
    for (int o = 1; o < 32; o <<= 1) { int v = __shfl_up(incl, o, 64); if (lane >= o) incl += v; }
    int hoff = incl - c;
    const int* tslot = (const int*)(p.ws + WS_TSLOT);
    const float* tgate = (const float*)(p.ws + WS_TGATE);
    const bf16_t* Yb = (const bf16_t*)(p.ws + WS_Y);
    bf16_t* hn = (bf16_t*)(p.ws + WS_HN);
    float* x = p.out;
    const float* gain = (l == 0) ? p.in[1] + 1024 : nullptr;
    for (int it = blockIdx.x; it < NTOK / 4; it += gridDim.x) {
        int t = it * 4 + w;
        int ts0 = tslot[t * 2], ts1 = tslot[t * 2 + 1];
        float g0 = tgate[t * 2], g1 = tgate[t * 2 + 1];
        int r0 = __shfl(hoff, ts0 >> 16, 64) + (ts0 & 0xffff);
        int r1 = __shfl(hoff, ts1 >> 16, 64) + (ts1 & 0xffff);
        float* xr = x + (size_t)t * 1024 + lane * 16;
        const bf16_t* y0 = Yb + (size_t)r0 * 1024 + lane * 16;
        const bf16_t* y1 = Yb + (size_t)r1 * 1024 + lane * 16;
        float v[16];
#pragma unroll
        for (int i = 0; i < 4; ++i) { float4 q = *(const float4*)(xr + 4 * i); v[4 * i] = q.x; v[4 * i + 1] = q.y; v[4 * i + 2] = q.z; v[4 * i + 3] = q.w; }
        uint4 a0 = *(const uint4*)y0, a1 = *(const uint4*)(y0 + 8), b0 = *(const uint4*)y1, b1 = *(const uint4*)(y1 + 8);
        unsigned ya[8] = {a0.x, a0.y, a0.z, a0.w, a1.x, a1.y, a1.z, a1.w};
        unsigned yb[8] = {b0.x, b0.y, b0.z, b0.w, b1.x, b1.y, b1.z, b1.w};
#pragma unroll
        for (int i = 0; i < 8; ++i) {
            v[2 * i] += g0 * bflo(ya[i]) + g1 * bflo(yb[i]);
            v[2 * i + 1] += g0 * bfhi(ya[i]) + g1 * bfhi(yb[i]);
        }
#ifdef NANMARK
#pragma unroll
        for (int i = 0; i < 16; ++i) if (!(fabsf(v[i]) < 1e30f)) v[i] = 1000.f;
#endif
#pragma unroll
        for (int i = 0; i < 4; ++i) *(float4*)(xr + 4 * i) = make_float4(v[4 * i], v[4 * i + 1], v[4 * i + 2], v[4 * i + 3]);
        if (gain) {
            float ss = 0.f;
#pragma unroll
            for (int i = 0; i < 16; ++i) ss += v[i] * v[i];
            ss = wave_sum(ss);
            float r = rsqrtf(ss / D_MODEL + 1e-6f);
#pragma unroll
            for (int i = 0; i < 16; ++i) v[i] = v[i] * r * gain[lane * 16 + i];
            uint4 o0, o1;
            o0.x = pk_bf16(v[0], v[1]); o0.y = pk_bf16(v[2], v[3]); o0.z = pk_bf16(v[4], v[5]); o0.w = pk_bf16(v[6], v[7]);
            o1.x = pk_bf16(v[8], v[9]); o1.y = pk_bf16(v[10], v[11]); o1.z = pk_bf16(v[12], v[13]); o1.w = pk_bf16(v[14], v[15]);
            bf16_t* hr = hn + (size_t)t * 1024 + lane * 16;
            *(uint4*)hr = o0; *(uint4*)(hr + 8) = o1;
        }
    }
}


__device__ __forceinline__ void mm_row(const bf16_t* RA, const bf16_t* RB, int mw, int fr, int fg, f32x4 (&acc)[4]) {
#pragma unroll
    for (int ks = 0; ks < 2; ++ks) {
        bf16x8 a = *(const bf16x8*)(RA + (16 * mw + fr) * LROW + ks * 32 + fg * 8);
#pragma unroll
        for (int nt = 0; nt < 4; ++nt) {
            bf16x8 b = *(const bf16x8*)(RB + (16 * nt + fr) * LROW + ks * 32 + fg * 8);
            acc[nt] = __builtin_amdgcn_mfma_f32_16x16x32_bf16(a, b, acc[nt], 0, 0, 0);
        }
    }
}
__device__ __forceinline__ void mm_col(const bf16_t* RA, const bf16_t* RB, int nw, int fr, int fg, f32x4 (&acc)[4]) {
#pragma unroll
    for (int ks = 0; ks < 2; ++ks) {
        bf16x8 b = *(const bf16x8*)(RB + (16 * nw + fr) * LROW + ks * 32 + fg * 8);
#pragma unroll
        for (int mt = 0; mt < 4; ++mt) {
            bf16x8 a = *(const bf16x8*)(RA + (16 * mt + fr) * LROW + ks * 32 + fg * 8);
            acc[mt] = __builtin_amdgcn_mfma_f32_16x16x32_bf16(a, b, acc[mt], 0, 0, 0);
        }
    }
}
__device__ __forceinline__ void zero4(f32x4 (&a)[4]) {
#pragma unroll
    for (int i = 0; i < 4; ++i) a[i] = (f32x4){0.f, 0.f, 0.f, 0.f};
}
__device__ __forceinline__ void st4_lds(bf16_t* p, float a, float b, float c, float d) { uint2 o; o.x = pk_bf16(a, b); o.y = pk_bf16(c, d); *(uint2*)p = o; }
__device__ __forceinline__ bf16_t f2bf(float v) { return (bf16_t)(pk_bf16(v, 0.f) & 0xffffu); }

__device__ void gdn_prep_item(const Params& p, int l, int cid, unsigned char* lds_raw) {
    const int tid = ltid(), lane = tid & 63, w = tid >> 6, fr = lane & 15, fg = lane >> 4;
    const int bh = cid >> 6, n = cid & 63, b = bh / H_GDN, h = bh % H_GDN;
    const int t0 = b * SEQ + n * 64;
    bf16_t* L0 = (bf16_t*)lds_raw; bf16_t* L1 = L0 + 64 * LROW; bf16_t* L2 = L1 + 64 * LROW; bf16_t* L3 = L2 + 64 * LROW; bf16_t* L4 = L3 + 64 * LROW; bf16_t* L5 = L4 + 64 * LROW;
    float* dec = (float*)(L5 + 64 * LROW); float* beta = dec + 64;
    const bf16_t* proj = (const bf16_t*)(p.ws + WS_PROJ);
    const float* aux = (const float*)(p.ws + WS_AUX);
    const float* convw = p.in[7] + (size_t)l * 4 * 1152;
    __syncthreads();
    const int i = tid >> 2, c0 = (tid & 3) * 16;
    float qv[16], kv[16], vv[16];
#pragma unroll
    for (int which = 0; which < 3; ++which) {
        float acc[16];
#pragma unroll
        for (int c = 0; c < 16; ++c) acc[c] = 0.f;
#pragma unroll
        for (int tap = 0; tap < 4; ++tap) {
            const int row = i - 3 + tap;
            if (n * 64 + row >= 0) {
                const bf16_t* xp = proj + (size_t)(t0 + row) * NPROJ + NC_GQ + which * 384 + h * 64 + c0;
                u32x4 x0 = *(const u32x4*)xp, x1 = *(const u32x4*)(xp + 8);
                const float* wp = convw + tap * 1152 + which * 384 + h * 64 + c0;
                unsigned xs[8] = {x0[0], x0[1], x0[2], x0[3], x1[0], x1[1], x1[2], x1[3]};
#pragma unroll
                for (int c = 0; c < 8; ++c) { acc[2 * c] += wp[2 * c] * bflo(xs[c]); acc[2 * c + 1] += wp[2 * c + 1] * bfhi(xs[c]); }
            }
        }
        float ss = 0.f;
#pragma unroll
        for (int c = 0; c < 16; ++c) { acc[c] = siluf_(acc[c]); ss += acc[c] * acc[c]; }
        if (which < 2) {
            ss += __shfl_xor(ss, 1, 64); ss += __shfl_xor(ss, 2, 64);
            const float sc = rsqrtf(ss + 1e-6f) * (which == 0 ? 0.125f : 1.f);
#pragma unroll
            for (int c = 0; c < 16; ++c) acc[c] *= sc;
        }
#pragma unroll
        for (int c = 0; c < 16; ++c) { if (which == 0) qv[c] = acc[c]; else if (which == 1) kv[c] = acc[c]; else vv[c] = acc[c]; }
    }
#pragma unroll
    for (int c = 0; c < 16; c += 4) { st4_lds(L2 + i * LROW + c0 + c, kv[c], kv[c + 1], kv[c + 2], kv[c + 3]); st4_lds(L3 + i * LROW + c0 + c, qv[c], qv[c + 1], qv[c + 2], qv[c + 3]); }
    if (w == 0) {
        const float a = aux[(size_t)(t0 + lane) * 64 + AX_GA + h], bl = aux[(size_t)(t0 + lane) * 64 + AX_GB + h];
        const float g = -__expf(p.in[8][l * H_GDN + h]) * softplusf_(a + p.in[9][l * H_GDN + h]);
        float inc = g;
#pragma unroll
        for (int o = 1; o < 64; o <<= 1) { float t = __shfl_up(inc, o, 64); if (lane >= o) inc += t; }
        dec[lane] = inc; beta[lane] = sigmoidf_(bl);
    }
    __syncthreads();
    {
        f32x4 g4[4]; zero4(g4);
        mm_row(L2, L2, w, fr, fg, g4);
#pragma unroll
        for (int nt = 0; nt < 4; ++nt) {
            const int kap = 16 * nt + fr; const float dk_ = dec[kap], bk_ = beta[kap];
            float nT[4], nN[4], tt[4];
#pragma unroll
            for (int r = 0; r < 4; ++r) {
                const int rho = 16 * w + 4 * fg + r; const float dr_ = dec[rho], br_ = beta[rho];
                const float G = g4[nt][r];
                nT[r] = (kap < rho) ? br_ * G * __expf(dr_ - dk_) : 0.f;
                nN[r] = (rho < kap) ? bk_ * G * __expf(dk_ - dr_) : 0.f;
                tt[r] = ((kap == rho) ? 1.f : 0.f) - nN[r];
            }
            st4_lds(L1 + kap * LROW + 16 * w + 4 * fg, nT[0], nT[1], nT[2], nT[3]);
            st4_lds(L0 + kap * LROW + 16 * w + 4 * fg, nN[0], nN[1], nN[2], nN[3]);
            st4_lds(L4 + kap * LROW + 16 * w + 4 * fg, tt[0], tt[1], tt[2], tt[3]);
        }
        f32x4 a4[4]; zero4(a4);
        mm_row(L2, L3, w, fr, fg, a4);
#pragma unroll
        for (int nt = 0; nt < 4; ++nt) {
            const int ii = 16 * nt + fr; const float di_ = dec[ii];
            float v4[4];
#pragma unroll
            for (int r = 0; r < 4; ++r) { const int j = 16 * w + 4 * fg + r; v4[r] = (j <= ii) ? a4[nt][r] * __expf(di_ - dec[j]) : 0.f; }
            st4_lds(L5 + ii * LROW + 16 * w + 4 * fg, v4[0], v4[1], v4[2], v4[3]);
        }
    }
    __syncthreads();
#pragma unroll
    for (int lev = 1; lev <= 5; ++lev) {
        const bf16_t* XA = (lev & 1) ? L0 : L2; const bf16_t* XAt = (lev & 1) ? L1 : L3;
        bf16_t* XB = (lev & 1) ? L2 : L0; bf16_t* XBt = (lev & 1) ? L3 : L1;
        {
            f32x4 x4[4]; zero4(x4);
            mm_row(XA, XAt, w, fr, fg, x4);
#pragma unroll
            for (int nt = 0; nt < 4; ++nt) {
                const int c = 16 * nt + fr;
                st4_lds(XBt + c * LROW + 16 * w + 4 * fg, x4[nt][0], x4[nt][1], x4[nt][2], x4[nt][3]);
                if (lev < 5) {
#pragma unroll
                    for (int r = 0; r < 4; ++r) XB[(16 * w + 4 * fg + r) * LROW + c] = f2bf(x4[nt][r]);
                }
            }
        }
        __syncthreads();
        {
            f32x4 t4[4];
#pragma unroll
            for (int mt = 0; mt < 4; ++mt) {
                uint2 u = *(const uint2*)(L4 + (16 * w + fr) * LROW + 16 * mt + 4 * fg);
                t4[mt] = (f32x4){bflo(u.x), bfhi(u.x), bflo(u.y), bfhi(u.y)};
            }
            mm_col(XBt, L4, w, fr, fg, t4);
#pragma unroll
            for (int mt = 0; mt < 4; ++mt) st4_lds(L4 + (16 * w + fr) * LROW + 16 * mt + 4 * fg, t4[mt][0], t4[mt][1], t4[mt][2], t4[mt][3]);
        }
    }
    {
        const float dj = dec[i], bj = beta[i], dlast = dec[63];
        const float s1 = bj * __expf(dj), s2 = bj, s3 = __expf(dlast - dj);
#pragma unroll
        for (int c = 0; c < 16; ++c) {
            L0[(c0 + c) * LROW + i] = f2bf(kv[c] * s1);
            L1[(c0 + c) * LROW + i] = f2bf(vv[c] * s2);
            L2[(c0 + c) * LROW + i] = f2bf(kv[c] * s3);
        }
    }
    __syncthreads();
    {
        f32x4 w4[4], u4[4]; zero4(w4); zero4(u4);
        mm_row(L4, L0, w, fr, fg, w4);
        mm_row(L4, L1, w, fr, fg, u4);
        __syncthreads();
#pragma unroll
        for (int nt = 0; nt < 4; ++nt) {
            st4_lds(L0 + (16 * nt + fr) * LROW + 16 * w + 4 * fg, w4[nt][0], w4[nt][1], w4[nt][2], w4[nt][3]);
            st4_lds(L1 + (16 * nt + fr) * LROW + 16 * w + 4 * fg, u4[nt][0], u4[nt][1], u4[nt][2], u4[nt][3]);
        }
        const float ed = __expf(dec[i]);
#pragma unroll
        for (int c = 0; c < 16; c += 4) st4_lds(L3 + i * LROW + c0 + c, qv[c] * ed, qv[c + 1] * ed, qv[c + 2] * ed, qv[c + 3] * ed);
    }
    __syncthreads();
    char* scr = p.ws + WS_SCR;
    {
        f32x4 m4[4]; zero4(m4);
        mm_row(L0, L2, w, fr, fg, m4);
        bf16_t* MP = (bf16_t*)(scr + SCR_GDN_MP) + (size_t)cid * 4096;
#pragma unroll
        for (int nt = 0; nt < 4; ++nt) store4_bf16(MP + (16 * nt + fr) * 64 + 16 * w + 4 * fg, -m4[nt][0], -m4[nt][1], -m4[nt][2], -m4[nt][3]);
        f32x4 n4[4]; zero4(n4);
        mm_row(L2, L1, w, fr, fg, n4);
        bf16_t* NN = (bf16_t*)(scr + SCR_GDN_NN) + (size_t)cid * 4096;
#pragma unroll
        for (int nt = 0; nt < 4; ++nt) store4_bf16(NN + ((w * 4 + nt) * 64 + lane) * 4, n4[nt][0], n4[nt][1], n4[nt][2], n4[nt][3]);
        f32x4 p4[4]; zero4(p4);
        mm_row(L0, L5, w, fr, fg, p4);
        bf16_t* PG = (bf16_t*)(scr + SCR_GDN_P) + (size_t)cid * 4096;
#pragma unroll
        for (int nt = 0; nt < 4; ++nt) {
            uint2 u = *(const uint2*)(L3 + (16 * nt + fr) * LROW + 16 * w + 4 * fg);
            store4_bf16(PG + (16 * nt + fr) * 64 + 16 * w + 4 * fg, bflo(u.x) - p4[nt][0], bfhi(u.x) - p4[nt][1], bflo(u.y) - p4[nt][2], bfhi(u.y) - p4[nt][3]);
        }
        f32x4 o4[4]; zero4(o4);
        mm_row(L1, L5, w, fr, fg, o4);
        bf16_t* OL = (bf16_t*)(scr + SCR_GDN_OL) + (size_t)cid * 4096;
#pragma unroll
        for (int nt = 0; nt < 4; ++nt) store4_bf16(OL + (16 * nt + fr) * 64 + 16 * w + 4 * fg, o4[nt][0], o4[nt][1], o4[nt][2], o4[nt][3]);
        if (tid == 0) ((float*)(scr + SCR_GDN_LAST))[cid] = __expf(dec[63]);
    }
}

__device__ void gdn_scan_item(const Params& p, int bh, unsigned char* lds_raw) {
    const int tid = ltid(), lane = tid & 63, w = tid >> 6, fr = lane & 15, fg = lane >> 4;
    char* scr = p.ws + WS_SCR;
    const bf16_t* MP = (const bf16_t*)(scr + SCR_GDN_MP) + (size_t)bh * 64 * 4096;
    const bf16_t* NN = (const bf16_t*)(scr + SCR_GDN_NN) + (size_t)bh * 64 * 4096;
    const float* LAST = (const float*)(scr + SCR_GDN_LAST) + bh * 64;
    bf16_t* SG = (bf16_t*)(scr + SCR_GDN_SG) + (size_t)bh * 64 * 4096;
    f32x4 S[4]; zero4(S);
    bf16x8 a0 = *(const bf16x8*)(MP + (16 * w + fr) * 64 + fg * 8), a1 = *(const bf16x8*)(MP + (16 * w + fr) * 64 + 32 + fg * 8);
    uint2 nn[4];
#pragma unroll
    for (int nt = 0; nt < 4; ++nt) nn[nt] = *(const uint2*)(NN + ((w * 4 + nt) * 64 + lane) * 4);
    float last = ld_f32_agent(LAST);
    __syncthreads();
    for (int n = 0; n < 64; ++n) {
        bf16_t* buf = (bf16_t*)lds_raw + (n & 1) * 64 * LROW;
#pragma unroll
        for (int nt = 0; nt < 4; ++nt) {
            uint2 o; o.x = pk_bf16(S[nt][0], S[nt][1]); o.y = pk_bf16(S[nt][2], S[nt][3]);
            *(uint2*)(buf + (16 * nt + fr) * LROW + 16 * w + 4 * fg) = o;
            *(uint2*)(SG + (size_t)n * 4096 + (16 * nt + fr) * 64 + 16 * w + 4 * fg) = o;
        }
        bf16x8 b0 = a0, b1 = a1; uint2 nn2[4]; float last2 = last;
#pragma unroll
        for (int nt = 0; nt < 4; ++nt) nn2[nt] = nn[nt];
        if (n + 1 < 64) {
            const bf16_t* MPn = MP + (size_t)(n + 1) * 4096;
            b0 = *(const bf16x8*)(MPn + (16 * w + fr) * 64 + fg * 8); b1 = *(const bf16x8*)(MPn + (16 * w + fr) * 64 + 32 + fg * 8);
#pragma unroll
            for (int nt = 0; nt < 4; ++nt) nn2[nt] = *(const uint2*)(NN + (size_t)(n + 1) * 4096 + ((w * 4 + nt) * 64 + lane) * 4);
            last2 = ld_f32_agent(LAST + n + 1);
        }
        __syncthreads();
#pragma unroll
        for (int nt = 0; nt < 4; ++nt) {
            S[nt][0] = last * S[nt][0] + bflo(nn[nt].x); S[nt][1] = last * S[nt][1] + bfhi(nn[nt].x);
            S[nt][2] = last * S[nt][2] + bflo(nn[nt].y); S[nt][3] = last * S[nt][3] + bfhi(nn[nt].y);
        }
#pragma unroll
        for (int nt = 0; nt < 4; ++nt) {
            bf16x8 s0 = *(const bf16x8*)(buf + (16 * nt + fr) * LROW + fg * 8), s1 = *(const bf16x8*)(buf + (16 * nt + fr) * LROW + 32 + fg * 8);
            S[nt] = __builtin_amdgcn_mfma_f32_16x16x32_bf16(a0, s0, S[nt], 0, 0, 0);
            S[nt] = __builtin_amdgcn_mfma_f32_16x16x32_bf16(a1, s1, S[nt], 0, 0, 0);
        }
        a0 = b0; a1 = b1; last = last2;
#pragma unroll
        for (int nt = 0; nt < 4; ++nt) nn[nt] = nn2[nt];
    }
}

__device__ void gdn_out_item(const Params& p, int l, int cid) {
    const int tid = ltid(), lane = tid & 63, w = tid >> 6, fr = lane & 15, fg = lane >> 4;
    const int bh = cid >> 6, n = cid & 63, b = bh / H_GDN, h = bh % H_GDN;
    char* scr = p.ws + WS_SCR;
    const bf16_t* SG = (const bf16_t*)(scr + SCR_GDN_SG) + (size_t)cid * 4096;
    const bf16_t* PG = (const bf16_t*)(scr + SCR_GDN_P) + (size_t)cid * 4096;
    const bf16_t* OL = (const bf16_t*)(scr + SCR_GDN_OL) + (size_t)cid * 4096;
    const int i = 16 * w + fr; const int t = b * SEQ + n * 64 + i;
    f32x4 acc[4];
#pragma unroll
    for (int mt = 0; mt < 4; ++mt) { uint2 u = *(const uint2*)(OL + i * 64 + 16 * mt + 4 * fg); acc[mt] = (f32x4){bflo(u.x), bfhi(u.x), bflo(u.y), bfhi(u.y)}; }
#pragma unroll
    for (int ks = 0; ks < 2; ++ks) {
        bf16x8 bq = *(const bf16x8*)(PG + i * 64 + ks * 32 + fg * 8);
#pragma unroll
        for (int mt = 0; mt < 4; ++mt) {
            bf16x8 a = *(const bf16x8*)(SG + (16 * mt + fr) * 64 + ks * 32 + fg * 8);
            acc[mt] = __builtin_amdgcn_mfma_f32_16x16x32_bf16(a, bq, acc[mt], 0, 0, 0);
        }
    }
    float ss = 0.f;
#pragma unroll
    for (int mt = 0; mt < 4; ++mt)
#pragma unroll
        for (int r = 0; r < 4; ++r) ss += acc[mt][r] * acc[mt][r];
    ss += __shfl_xor(ss, 16, 64); ss += __shfl_xor(ss, 32, 64);
    const float rstd = rsqrtf(ss * (1.f / 64.f) + 1e-6f);
    const float* og = p.in[10] + l * 64;
    const bf16_t* gp = (const bf16_t*)(p.ws + WS_PROJ) + (size_t)t * NPROJ + NC_GG + h * 64;
    bf16_t* mp = (bf16_t*)(p.ws + WS_MIX) + (size_t)t * D_MODEL + 384 + h * 64;
#pragma unroll
    for (int mt = 0; mt < 4; ++mt) {
        const int e0 = 16 * mt + 4 * fg;
        uint2 gu = *(const uint2*)(gp + e0); f32x4 g4 = *(const f32x4*)(og + e0);
        store4_bf16(mp + e0, acc[mt][0] * rstd * g4[0] * bflo(gu.x), acc[mt][1] * rstd * g4[1] * bfhi(gu.x), acc[mt][2] * rstd * g4[2] * bflo(gu.y), acc[mt][3] * rstd * g4[3] * bfhi(gu.y));
    }
}

#define GQROW 40
__device__ void gla_prep_item(const Params& p, int l, int cid, unsigned char* lds_raw) {
    const int tid = ltid(), lane = tid & 63, w = tid >> 6, fr = lane & 15, fg = lane >> 4;
    const int bh = cid >> 6, n = cid & 63, b = bh / H_GLA, h = bh % H_GLA;
    const int t0 = b * SEQ + n * 64;
    float* Bf = (float*)lds_raw;
    bf16_t* Qt = (bf16_t*)(lds_raw + 8448);
    bf16_t* Kt = Qt + 64 * GQROW;
    bf16_t* KLt = Kt + 64 * GQROW;
    bf16_t* Vt = KLt + 32 * LROW;
    const bf16_t* proj = (const bf16_t*)(p.ws + WS_PROJ);
    const float* aux = (const float*)(p.ws + WS_AUX);
    char* scr = p.ws + WS_SCR;
    __syncthreads();
    const int i = tid >> 2, d0 = (tid & 3) * 8;
    {
        const float* wa = p.in[11] + (size_t)l * 16 * 128 + h * 32 + d0;
        const float* ba = p.in[12] + l * 128 + h * 32 + d0;
        float acc[8];
#pragma unroll
        for (int j = 0; j < 8; ++j) acc[j] = ba[j];
#pragma unroll
        for (int r = 0; r < 16; ++r) {
            const float a1 = aux[(size_t)(t0 + i) * 64 + AX_LA + r];
#pragma unroll
            for (int j = 0; j < 8; ++j) acc[j] += a1 * wa[r * 128 + j];
        }
#pragma unroll
        for (int j = 0; j < 8; ++j) Bf[i * 33 + d0 + j] = logsigmoidf_(acc[j]) * (1.f / 16.f);
    }
    {
        const bf16_t* lvt = (const bf16_t*)(scr + SCR_LVT) + (size_t)bh * 64 * SEQ + n * 64;
#pragma unroll
        for (int ii = 0; ii < 2; ++ii) { int c = tid + 256 * ii; int row = c >> 3, kc = c & 7; *(u32x4*)(Vt + row * LROW + kc * 8) = *(const u32x4*)(lvt + (size_t)row * SEQ + kc * 8); }
    }
    __syncthreads();
#pragma unroll
    for (int c = 0; c < 8; ++c) {
        const int d = 8 * w + c;
        float inc = Bf[lane * 33 + d];
#pragma unroll
        for (int o = 1; o < 64; o <<= 1) { float t = __shfl_up(inc, o, 64); if (lane >= o) inc += t; }
        Bf[lane * 33 + d] = inc;
    }
    __syncthreads();
    {
        const bf16_t* qp = proj + (size_t)(t0 + i) * NPROJ + NC_LQ + h * 32 + d0;
        const bf16_t* kp = proj + (size_t)(t0 + i) * NPROJ + NC_LK + h * 32 + d0;
        u32x4 qu = *(const u32x4*)qp, ku = *(const u32x4*)kp;
        float qf[8] = {bflo(qu[0]), bfhi(qu[0]), bflo(qu[1]), bfhi(qu[1]), bflo(qu[2]), bfhi(qu[2]), bflo(qu[3]), bfhi(qu[3])};
        float kf[8] = {bflo(ku[0]), bfhi(ku[0]), bflo(ku[1]), bfhi(ku[1]), bflo(ku[2]), bfhi(ku[2]), bflo(ku[3]), bfhi(ku[3])};
        float qt[8], kt[8], qb[8];
#pragma unroll
        for (int j = 0; j < 8; ++j) {
            const float bi = Bf[i * 33 + d0 + j], bm = Bf[31 * 33 + d0 + j], bl = Bf[63 * 33 + d0 + j];
            qt[j] = qf[j] * __expf(bi - bm); kt[j] = kf[j] * __expf(bm - bi); qb[j] = qf[j] * __expf(bi);
            KLt[(d0 + j) * LROW + i] = f2bf(kf[j] * __expf(bl - bi));
            if (i == 63) ((float*)(scr + SCR_GLA_DL))[cid * 32 + d0 + j] = __expf(bl);
        }
        u32x4 o; o[0] = pk_bf16(qt[0], qt[1]); o[1] = pk_bf16(qt[2], qt[3]); o[2] = pk_bf16(qt[4], qt[5]); o[3] = pk_bf16(qt[6], qt[7]);
        *(u32x4*)(Qt + i * GQROW + d0) = o;
        o[0] = pk_bf16(kt[0], kt[1]); o[1] = pk_bf16(kt[2], kt[3]); o[2] = pk_bf16(kt[4], kt[5]); o[3] = pk_bf16(kt[6], kt[7]);
        *(u32x4*)(Kt + i * GQROW + d0) = o;
        o[0] = pk_bf16(qb[0], qb[1]); o[1] = pk_bf16(qb[2], qb[3]); o[2] = pk_bf16(qb[4], qb[5]); o[3] = pk_bf16(qb[6], qb[7]);
        *(u32x4*)((bf16_t*)(scr + SCR_GLA_QB) + (size_t)cid * 2048 + i * 32 + d0) = o;
    }
    __syncthreads();
    f32x4 sc[4];
    {
        bf16x8 bq = *(const bf16x8*)(Qt + (16 * w + fr) * GQROW + fg * 8);
#pragma unroll
        for (int mt = 0; mt < 4; ++mt) {
            bf16x8 a = *(const bf16x8*)(Kt + (16 * mt + fr) * GQROW + fg * 8);
            sc[mt] = __builtin_amdgcn_mfma_f32_16x16x32_bf16(a, bq, (f32x4){0.f, 0.f, 0.f, 0.f}, 0, 0, 0);
        }
        const int ii = 16 * w + fr;
#pragma unroll
        for (int mt = 0; mt < 4; ++mt)
#pragma unroll
            for (int r = 0; r < 4; ++r) { const int j = 16 * mt + 4 * fg + r; if (j > ii) sc[mt][r] = 0.f; }
    }
    {
        f32x4 o4[4]; zero4(o4);
#pragma unroll
        for (int kk = 0; kk < 2; ++kk) {
            u32x4 pb = {pk_bf16(sc[2 * kk][0], sc[2 * kk][1]), pk_bf16(sc[2 * kk][2], sc[2 * kk][3]), pk_bf16(sc[2 * kk + 1][0], sc[2 * kk + 1][1]), pk_bf16(sc[2 * kk + 1][2], sc[2 * kk + 1][3])};
#pragma unroll
            for (int mt = 0; mt < 4; ++mt) {
                uint2 v0 = *(const uint2*)(Vt + (16 * mt + fr) * LROW + 32 * kk + 4 * fg), v1 = *(const uint2*)(Vt + (16 * mt + fr) * LROW + 32 * kk + 16 + 4 * fg);
                u32x4 va = {v0.x, v0.y, v1.x, v1.y};
                o4[mt] = __builtin_amdgcn_mfma_f32_16x16x32_bf16(__builtin_bit_cast(bf16x8, va), __builtin_bit_cast(bf16x8, pb), o4[mt], 0, 0, 0);
            }
        }
        bf16_t* OL = (bf16_t*)(scr + SCR_GLA_OL) + (size_t)cid * 4096;
#pragma unroll
        for (int mt = 0; mt < 4; ++mt) store4_bf16(OL + (16 * w + fr) * 64 + 16 * mt + 4 * fg, o4[mt][0], o4[mt][1], o4[mt][2], o4[mt][3]);
    }
    {
        f32x4 k4[2] = {(f32x4){0.f, 0.f, 0.f, 0.f}, (f32x4){0.f, 0.f, 0.f, 0.f}};
#pragma unroll
        for (int ks = 0; ks < 2; ++ks) {
            bf16x8 bv = *(const bf16x8*)(Vt + (16 * w + fr) * LROW + ks * 32 + fg * 8);
#pragma unroll
            for (int mt = 0; mt < 2; ++mt) {
                bf16x8 a = *(const bf16x8*)(KLt + (16 * mt + fr) * LROW + ks * 32 + fg * 8);
                k4[mt] = __builtin_amdgcn_mfma_f32_16x16x32_bf16(a, bv, k4[mt], 0, 0, 0);
            }
        }
        float* KV = (float*)(scr + SCR_GLA_KV) + (size_t)cid * 2048;
#pragma unroll
        for (int mt = 0; mt < 2; ++mt) *(f32x4*)(KV + (16 * w + fr) * 32 + 16 * mt + 4 * fg) = k4[mt];
    }
}
__device__ void gla_scan_item(const Params& p, int g) {
    const int tid = ltid();
    const int bh = g >> 3, idx = (g & 7) * 256 + tid, d = idx & 31;
    char* scr = p.ws + WS_SCR;
    const float* __restrict__ KV = (const float*)(scr + SCR_GLA_KV) + (size_t)bh * 64 * 2048 + idx;
    const float* __restrict__ DL = (const float*)(scr + SCR_GLA_DL) + bh * 64 * 32 + d;
    bf16_t* __restrict__ SG = (bf16_t*)(scr + SCR_GLA_SG) + (size_t)bh * 64 * 2048 + idx;
    float S = 0.f;
    for (int n0 = 0; n0 < 64; n0 += 8) {
        float kv[8], dl[8];
#pragma unroll
        for (int u = 0; u < 8; ++u) { kv[u] = KV[(size_t)(n0 + u) * 2048]; dl[u] = DL[(n0 + u) * 32]; }
#pragma unroll
        for (int u = 0; u < 8; ++u) { SG[(size_t)(n0 + u) * 2048] = f2bf(S); S = dl[u] * S + kv[u]; }
    }
}
__device__ void gla_out_item(const Params& p, int l, int cid) {
    const int tid = ltid(), lane = tid & 63, w = tid >> 6, fr = lane & 15, fg = lane >> 4;
    const int bh = cid >> 6, n = cid & 63, b = bh / H_GLA, h = bh % H_GLA;
    char* scr = p.ws + WS_SCR;
    const bf16_t* SG = (const bf16_t*)(scr + SCR_GLA_SG) + (size_t)cid * 2048;
    const bf16_t* QB = (const bf16_t*)(scr + SCR_GLA_QB) + (size_t)cid * 2048;
    const bf16_t* OL = (const bf16_t*)(scr + SCR_GLA_OL) + (size_t)cid * 4096;
    const int i = 16 * w + fr; const int t = b * SEQ + n * 64 + i;
    f32x4 acc[4];
#pragma unroll
    for (int mt = 0; mt < 4; ++mt) { uint2 u = *(const uint2*)(OL + i * 64 + 16 * mt + 4 * fg); acc[mt] = (f32x4){bflo(u.x), bfhi(u.x), bflo(u.y), bfhi(u.y)}; }
    bf16x8 bq = *(const bf16x8*)(QB + i * 32 + fg * 8);
#pragma unroll
    for (int mt = 0; mt < 4; ++mt) {
        bf16x8 a = *(const bf16x8*)(SG + (16 * mt + fr) * 32 + fg * 8);
        acc[mt] = __builtin_amdgcn_mfma_f32_16x16x32_bf16(a, bq, acc[mt], 0, 0, 0);
    }
    float ss = 0.f;
#pragma unroll
    for (int mt = 0; mt < 4; ++mt)
#pragma unroll
        for (int r = 0; r < 4; ++r) ss += acc[mt][r] * acc[mt][r];
    ss += __shfl_xor(ss, 16, 64); ss += __shfl_xor(ss, 32, 64);
    const float rstd = rsqrtf(ss * (1.f / 64.f) + 1e-6f);
    const float* og = p.in[13] + l * 64;
    const bf16_t* rp = (const bf16_t*)(p.ws + WS_PROJ) + (size_t)t * NPROJ + NC_LR + h * 64;
    bf16_t* mp = (bf16_t*)(p.ws + WS_MIX) + (size_t)t * D_MODEL + 768 + h * 64;
#pragma unroll
    for (int mt = 0; mt < 4; ++mt) {
        const int e0 = 16 * mt + 4 * fg;
        uint2 gu = *(const uint2*)(rp + e0); f32x4 g4 = *(const f32x4*)(og + e0);
        store4_bf16(mp + e0, acc[mt][0] * rstd * g4[0] * bflo(gu.x), acc[mt][1] * rstd * g4[1] * bfhi(gu.x), acc[mt][2] * rstd * g4[2] * bflo(gu.y), acc[mt][3] * rstd * g4[3] * bfhi(gu.y));
    }
}
__device__ void phase_mixout(const Params& p, int l) {
    for (int it = blockIdx.x; it < NGDN_CH + NGLA_CH; it += gridDim.x) {
        if (it < NGDN_CH) { if (MIXSEL & 1) gdn_out_item(p, l, it); } else { if (MIXSEL & 2) gla_out_item(p, l, it - NGDN_CH); }
    }
}

__device__ void fox_cumsum_item(const Params& p, int l, int bh, float* ldsf) {
    const int tid = ltid(), lane = tid & 63, w = tid >> 6;
    const int b = bh / H_FOX, h = bh % H_FOX;
    const float* aux = (const float*)(p.ws + WS_AUX);
    float* cum = (float*)(p.ws + WS_CUM) + (size_t)bh * SEQ;
    const float fb = p.in[5][l * H_FOX + h];
    float v[16]; float s = 0.f;
#pragma unroll
    for (int i = 0; i < 16; ++i) { v[i] = logsigmoidf_(aux[(size_t)(b * SEQ + tid * 16 + i) * 64 + AX_FF + h] + fb); s += v[i]; }
    float inc = s;
#pragma unroll
    for (int o = 1; o < 64; o <<= 1) { float t = __shfl_up(inc, o, 64); if (lane >= o) inc += t; }
    __syncthreads();
    if (lane == 63) ldsf[w] = inc;
    __syncthreads();
    float base = inc - s;
    for (int ww = 0; ww < w; ++ww) base += ldsf[ww];
    float c = base;
#pragma unroll
    for (int i = 0; i < 16; ++i) { c += v[i]; cum[tid * 16 + i] = c; }
}
__device__ void phase_prep(const Params& p, int l, unsigned char* lds_raw) {
    const int n0 = BATCH * H_FOX, n1 = n0 + ((MIXSEL & 1) ? NGDN_CH : 0), n2 = n1 + ((MIXSEL & 2) ? NGLA_CH : 0);
    for (int it = blockIdx.x; it < n2; it += gridDim.x) {
        if (it < n0) { __syncthreads(); fox_cumsum_item(p, l, it, (float*)lds_raw); }
        else if (it < n1) gdn_prep_item(p, l, it - n0, lds_raw);
        else gla_prep_item(p, l, it - n1, lds_raw);
    }
}

typedef float f32x16 __attribute__((ext_vector_type(16)));
#define ATT_BUF 18688
__device__ void fox_attn_item(const Params& p, int l, int bh, int qt, unsigned char* lds_raw) {
    const int tid = ltid(), lane = tid & 63, w = tid >> 6, r = lane & 31, h = lane >> 5;
    const int b = bh / H_FOX, hh = bh % H_FOX;
    const bf16_t* proj = (const bf16_t*)(p.ws + WS_PROJ);
    const bf16_t* kbase = proj + (size_t)b * SEQ * NPROJ + NC_FK + hh * 64;
    const bf16_t* vbase = (const bf16_t*)(p.ws + WS_VTF) + (size_t)bh * 64 * SEQ;
    const float* cum = (const float*)(p.ws + WS_CUM) + (size_t)bh * SEQ;
    const int qlo = qt * 128 + w * 32, q = qlo + r;
    bf16x8 qf[4];
    {
        const bf16_t* qrow = proj + (size_t)(b * SEQ + q) * NPROJ + NC_FQ + hh * 64;
#pragma unroll
        for (int kk = 0; kk < 4; ++kk) qf[kk] = *(const bf16x8*)(qrow + kk * 16 + h * 8);
    }
    const float cq = cum[q];
    f32x16 o0, o1;
#pragma unroll
    for (int i = 0; i < 16; ++i) { o0[i] = 0.f; o1[i] = 0.f; }
    float m = -1e30f, lsum = 0.f;
    const int ntiles = 2 * qt + 2;
    const int crow = tid >> 3, ckc = tid & 7;
    u32x4 kr0, kr1, vr0, vr1; float cr = 0.f;
    auto gload = [&](int j) {
        const int s0 = j * 64;
        kr0 = *(const u32x4*)(kbase + (size_t)(s0 + crow) * NPROJ + ckc * 8);
        kr1 = *(const u32x4*)(kbase + (size_t)(s0 + crow + 32) * NPROJ + ckc * 8);
        vr0 = *(const u32x4*)(vbase + (size_t)crow * SEQ + s0 + ckc * 8);
        vr1 = *(const u32x4*)(vbase + (size_t)(crow + 32) * SEQ + s0 + ckc * 8);
        if (tid < 64) cr = cum[s0 + tid];
    };
    auto lstore = [&](int buf) {
        bf16_t* Ks = (bf16_t*)(lds_raw + buf * ATT_BUF); bf16_t* Vs = Ks + 64 * LROW; float* cs = (float*)(Vs + 64 * LROW);
        *(u32x4*)(Ks + crow * LROW + ckc * 8) = kr0; *(u32x4*)(Ks + (crow + 32) * LROW + ckc * 8) = kr1;
        *(u32x4*)(Vs + crow * LROW + ckc * 8) = vr0; *(u32x4*)(Vs + (crow + 32) * LROW + ckc * 8) = vr1;
        if (tid < 64) cs[tid] = cr;
    };
    __syncthreads();
    gload(0); lstore(0);
    __syncthreads();
    for (int j = 0; j < ntiles; ++j) {
        if (j + 1 < ntiles) gload(j + 1);
        const int s0 = j * 64;
        if (s0 <= qlo + 31) {
            const bf16_t* Ks = (const bf16_t*)(lds_raw + (j & 1) * ATT_BUF); const bf16_t* Vs = Ks + 64 * LROW; const float* cs = (const float*)(Vs + 64 * LROW);
            f32x16 st0, st1;
#pragma unroll
            for (int i = 0; i < 16; ++i) { st0[i] = 0.f; st1[i] = 0.f; }
#pragma unroll
            for (int kk = 0; kk < 4; ++kk) {
                bf16x8 a0 = *(const bf16x8*)(Ks + r * LROW + kk * 16 + h * 8);
                bf16x8 a1 = *(const bf16x8*)(Ks + (32 + r) * LROW + kk * 16 + h * 8);
                st0 = __builtin_amdgcn_mfma_f32_32x32x16_bf16(a0, qf[kk], st0, 0, 0, 0);
                st1 = __builtin_amdgcn_mfma_f32_32x32x16_bf16(a1, qf[kk], st1, 0, 0, 0);
            }
            const bool need_mask = (s0 + 63 > qlo);
            float mx = -1e30f;
#pragma unroll
            for (int g = 0; g < 4; ++g) {
                f32x4 c0 = *(const f32x4*)(cs + 8 * g + 4 * h);
                f32x4 c1 = *(const f32x4*)(cs + 32 + 8 * g + 4 * h);
#pragma unroll
                for (int e = 0; e < 4; ++e) {
                    int i = 4 * g + e;
                    float v0 = st0[i] + (cq - c0[e]), v1 = st1[i] + (cq - c1[e]);
                    if (need_mask) {
                        int key = s0 + 8 * g + 4 * h + e;
                        if (key > q) v0 = -1e30f;
                        if (key + 32 > q) v1 = -1e30f;
                    }
                    st0[i] = v0; st1[i] = v1;
                    mx = fmaxf(mx, fmaxf(v0, v1));
                }
            }
            mx = fmaxf(mx, __shfl_xor(mx, 32, 64));
            const float mnew = fmaxf(m, mx);
            const float alpha = __expf(m - mnew);
            float rs = 0.f;
#pragma unroll
            for (int i = 0; i < 16; ++i) { st0[i] = __expf(st0[i] - mnew); st1[i] = __expf(st1[i] - mnew); rs += st0[i] + st1[i]; }
            lsum = lsum * alpha + rs; m = mnew;
#pragma unroll
            for (int i = 0; i < 16; ++i) { o0[i] *= alpha; o1[i] *= alpha; }
            bf16x8 pf[2][2];
#pragma unroll
            for (int s = 0; s < 2; ++s) {
                u32x4 t0 = {pk_bf16(st0[8 * s], st0[8 * s + 1]), pk_bf16(st0[8 * s + 2], st0[8 * s + 3]), pk_bf16(st0[8 * s + 4], st0[8 * s + 5]), pk_bf16(st0[8 * s + 6], st0[8 * s + 7])};
                u32x4 t1 = {pk_bf16(st1[8 * s], st1[8 * s + 1]), pk_bf16(st1[8 * s + 2], st1[8 * s + 3]), pk_bf16(st1[8 * s + 4], st1[8 * s + 5]), pk_bf16(st1[8 * s + 6], st1[8 * s + 7])};
                pf[0][s] = __builtin_bit_cast(bf16x8, t0); pf[1][s] = __builtin_bit_cast(bf16x8, t1);
            }
#pragma unroll
            for (int mt = 0; mt < 2; ++mt)
#pragma unroll
                for (int s = 0; s < 2; ++s) {
                    const int ko = 32 * mt + 16 * s + 4 * h;
                    uint2 a00 = *(const uint2*)(Vs + r * LROW + ko), a01 = *(const uint2*)(Vs + r * LROW + ko + 8);
                    uint2 a10 = *(const uint2*)(Vs + (32 + r) * LROW + ko), a11 = *(const uint2*)(Vs + (32 + r) * LROW + ko + 8);
                    u32x4 u0 = {a00.x, a00.y, a01.x, a01.y}; u32x4 u1 = {a10.x, a10.y, a11.x, a11.y};
                    o0 = __builtin_amdgcn_mfma_f32_32x32x16_bf16(__builtin_bit_cast(bf16x8, u0), pf[mt][s], o0, 0, 0, 0);
                    o1 = __builtin_amdgcn_mfma_f32_32x32x16_bf16(__builtin_bit_cast(bf16x8, u1), pf[mt][s], o1, 0, 0, 0);
                }
        }
        if (j + 1 < ntiles) lstore((j + 1) & 1);
        __syncthreads();
    }
    lsum += __shfl_xor(lsum, 32, 64);
    const float inv = 1.f / lsum;
    float ss = 0.f;
#pragma unroll
    for (int i = 0; i < 16; ++i) { o0[i] *= inv; o1[i] *= inv; ss += o0[i] * o0[i] + o1[i] * o1[i]; }
    ss += __shfl_xor(ss, 32, 64);
    const float rstd = rsqrtf(ss * (1.f / 64.f) + 1e-6f);
    const float* og = p.in[6] + l * 64;
    bf16_t* mrow = (bf16_t*)(p.ws + WS_MIX) + (size_t)(b * SEQ + q) * D_MODEL + hh * 64;
#pragma unroll
    for (int g = 0; g < 4; ++g) {
        const int e0 = 8 * g + 4 * h;
        f32x4 g0 = *(const f32x4*)(og + e0), g1 = *(const f32x4*)(og + 32 + e0);
        store4_bf16(mrow + e0, o0[4 * g] * rstd * g0[0], o0[4 * g + 1] * rstd * g0[1], o0[4 * g + 2] * rstd * g0[2], o0[4 * g + 3] * rstd * g0[3]);
        store4_bf16(mrow + 32 + e0, o1[4 * g] * rstd * g1[0], o1[4 * g + 1] * rstd * g1[1], o1[4 * g + 2] * rstd * g1[2], o1[4 * g + 3] * rstd * g1[3]);
    }
}
#define ATT_ITEMS (BATCH * H_FOX * (SEQ / 128))
__device__ void phase_scan_attn(const Params& p, int l, unsigned char* lds_raw) {
    unsigned* qctr = (unsigned*)(p.ws + WS_CTL) + CW_Q + l;
    volatile int* slot = (volatile int*)(lds_raw + 2 * ATT_BUF);
    for (;;) {
        __syncthreads();
        if (threadIdx.x == 0) *slot = (int)atomicAdd(qctr, 1u);
        __syncthreads();
        int it = *slot;
        const int ns0 = (MIXSEL & 1) ? BATCH * H_GDN : 0, ns1 = ns0 + ((MIXSEL & 2) ? 128 : 0);
        if (it >= ns1 + ATT_ITEMS) break;
        if (it < ns0) { gdn_scan_item(p, it, lds_raw); continue; }
        if (it < ns1) { gla_scan_item(p, it - ns0); continue; }
        it -= ns1;
        const int qt = (SEQ / 128 - 1) - it / (BATCH * H_FOX), bh = it % (BATCH * H_FOX);
        fox_attn_item(p, l, bh, qt, lds_raw);
    }
}

#define NPHASE 19
__global__ void __launch_bounds__(256, 2) mk(Params p, int lo, int hi, int use_bar) {
    __shared__ __attribute__((aligned(16))) unsigned char lds_raw[LDS_BYTES];
    bf16_t* lds = (bf16_t*)lds_raw;
    volatile LAS unsigned* st = (volatile LAS unsigned*)(lds_raw + LDS_BYTES - 16);
    XcdBarrier bar; bar.bar = (unsigned*)(p.ws + WS_CTL) + CW_BAR; bar.x = 0; bar.st = st;
    if (use_bar) {
        if (threadIdx.x == 0) { st[0] = 0u; st[1] = 0u; }
        __syncthreads();
        bar = xcd_barrier_post((unsigned*)(p.ws + WS_CTL) + CW_BAR, st);
    }
    for (int ph = lo; ph < hi; ++ph) {
#ifndef PSEL
#define PSEL 0xffff
#endif
        int phv = ph; asm volatile("" : "+s"(phv));
        Params q = p; asm volatile("" : "+s"(q.ws)); asm volatile("" : "+s"(q.out));
        if (phv == 0) { if (PSEL & 1) phase0(q); }
        else {
            int l = (phv - 1) / 9, s = (phv - 1) % 9;
            if (s == 0) { if (PSEL & 2) phase_inproj(q, l, lds); }
            else if (s == 1) { if (PSEL & 128) phase_prep(q, l, lds_raw); }
            else if (s == 2) { if (PSEL & 256) phase_scan_attn(q, l, lds_raw); }
            else if (s == 3) { if (PSEL & 512) phase_mixout(q, l); }
            else if (s == 4) { if (PSEL & 4) phase_outproj(q, l, lds); }
            else if (s == 5) { if (PSEL & 8) phase_route(q, l, lds); }
            else if (s == 6) { if (PSEL & 16) phase_expert<0>(q, l, lds); }
            else if (s == 7) { if (PSEL & 32) phase_expert<1>(q, l, lds); }
            else if (s == 8) { if (PSEL & 64) phase_combine(q, l); }
        }
        if (ph + 1 < hi) {
            if (use_bar == 2 && ph == lo) { cg::this_grid().sync(); }
            else xcd_barrier(bar);
        }
    }
}

extern "C" void kernel_launch(void* const* d_in, const int* in_sizes, int n_in,
                              void* d_out, int out_size, void* d_ws, size_t ws_size,
                              hipStream_t stream) {
    static int grid = 0;
    if (grid == 0) {
        if (ws_size < WS_END) { fprintf(stderr, "ws too small: need %zu have %zu\n", (size_t)WS_END, ws_size); grid = -1; return; }
        int dev = 0, cus = 0, per_cu = 0;
        hipGetDevice(&dev);
        hipDeviceGetAttribute(&cus, hipDeviceAttributeMultiprocessorCount, dev);
        hipOccupancyMaxActiveBlocksPerMultiprocessor(&per_cu, mk, 256, 0);
        if (per_cu > 2) per_cu = 2;
        if (per_cu < 1) { fprintf(stderr, "occupancy query failed\n"); grid = -1; return; }
        grid = cus * per_cu;
        grid -= grid % 8;
    }
    if (grid < 0) return;
    Params p{};
    for (int i = 0; i < 23; ++i) p.in[i] = (const float*)d_in[i];
    p.out = (float*)d_out; p.ws = (char*)d_ws;
    hipMemsetAsync((char*)d_ws + WS_CTL, 0, CTL_BYTES, stream);
#ifdef POISON_GLA
    hipMemsetAsync((char*)d_ws + WS_SCR + SCR_GLA_OL, 0xFF, SCR_LVT - SCR_GLA_OL, stream);
#endif

#ifdef MULTI_LAUNCH
    for (int ph = 0; ph < NPHASE; ++ph) mk<<<grid, 256, 0, stream>>>(p, ph, ph + 1, 0);
#else
    int lo = 0, hi = NPHASE, ub = 2;
    void* args[] = {&p, &lo, &hi, &ub};
    hipError_t e = hipLaunchCooperativeKernel((void*)mk, dim3(grid), dim3(256), args, 0, stream);
    if (e != hipSuccess) fprintf(stderr, "cooperative launch failed: %s (grid %d)\n", hipGetErrorString(e), grid);
#endif
}
```

```cpp
#include <hip/hip_runtime.h>
#include <hip/hip_cooperative_groups.h>
#include <cstdint>
#include <cstdio>
namespace cg = cooperative_groups;

#define D_MODEL 1024
#define BATCH 4
#define SEQ 4096
#define NTOK (BATCH * SEQ)
#define H_FOX 6
#define H_GDN 6
#define H_GLA 4
#define N_IN 3490
#define N_EXP 32
#define D_EXP 512
#define NPROJ 3456
#define NINP 3584

#define C_FF 1152
#define C_GQ 1158
#define C_GG 2310
#define C_GA 2694
#define C_GB 2700
#define C_LQ 2706
#define C_LA 3474
#define NC_FQ 0
#define NC_FK 384
#define NC_FV 768
#define NC_GQ 1152
#define NC_GK 1536
#define NC_GV 1920
#define NC_GG 2304
#define NC_LQ 2688
#define NC_LK 2816
#define NC_LV 2944
#define NC_LR 3200
#define AX_FF 0
#define AX_GA 6
#define AX_GB 12
#define AX_LA 18

#ifndef MIXSEL
#define MIXSEL 3
#endif
typedef unsigned short bf16_t;
typedef short bf16x8 __attribute__((ext_vector_type(8)));
typedef float f32x4 __attribute__((ext_vector_type(4)));
typedef unsigned u32x4 __attribute__((ext_vector_type(4)));

#define WS_CTL      0
#define CTL_BYTES   65536
#define WS_WIN      (WS_CTL + CTL_BYTES)
#define WS_WOUT     (WS_WIN + (size_t)2 * NINP * 1024 * 2)
#define WS_WGU      (WS_WOUT + (size_t)2 * 1024 * 1024 * 2)
#define WS_WD       (WS_WGU + (size_t)2 * 32 * 1024 * 1024 * 2)
#define WS_WR       (WS_WD + (size_t)2 * 32 * 1024 * 512 * 2)
#define WS_HN       (WS_WR + (size_t)2 * 64 * 1024 * 2)
#define WS_PROJ     (WS_HN + (size_t)NTOK * 1024 * 2)
#define WS_VTF      (WS_PROJ + (size_t)NTOK * NPROJ * 2)
#define WS_AUX      (WS_VTF + (size_t)BATCH * H_FOX * 64 * SEQ * 2)
#define WS_CUM      (WS_AUX + (size_t)NTOK * 64 * 4)
#define WS_MIX      (WS_CUM + (size_t)BATCH * H_FOX * SEQ * 4)
#define WS_ROWTOK   (WS_MIX + (size_t)NTOK * 1024 * 2)
#define WS_TSLOT    (WS_ROWTOK + (size_t)32 * NTOK * 4)
#define WS_TGATE    (WS_TSLOT + (size_t)NTOK * 2 * 4)
#define WS_SCR      (WS_TGATE + (size_t)NTOK * 2 * 4)
#define SCR_BYTES   ((size_t)100 * 1024 * 1024)
#define WS_END      (WS_SCR + SCR_BYTES)
#define HROWS       (2 * NTOK + 32 * 128)
#define WS_H        WS_PROJ
#define WS_Y        (WS_PROJ + (size_t)HROWS * 512 * 2)

#define NGDN_CH 1536
#define NGLA_CH 1024
#define SCR_GDN_MP   ((size_t)0)
#define SCR_GDN_NN   (SCR_GDN_MP + (size_t)NGDN_CH * 8192)
#define SCR_GDN_P    (SCR_GDN_NN + (size_t)NGDN_CH * 8192)
#define SCR_GDN_OL   (SCR_GDN_P  + (size_t)NGDN_CH * 8192)
#define SCR_GDN_SG   (SCR_GDN_OL + (size_t)NGDN_CH * 8192)
#define SCR_GDN_LAST (SCR_GDN_SG + (size_t)NGDN_CH * 8192)
#define SCR_GLA_OL   (SCR_GDN_LAST + (size_t)NGDN_CH * 4)
#define SCR_GLA_KV   (SCR_GLA_OL + (size_t)NGLA_CH * 8192)
#define SCR_GLA_QB   (SCR_GLA_KV + (size_t)NGLA_CH * 8192)
#define SCR_GLA_SG   (SCR_GLA_QB + (size_t)NGLA_CH * 4096)
#define SCR_GLA_DL   (SCR_GLA_SG + (size_t)NGLA_CH * 4096)
#define SCR_LVT      (SCR_GLA_DL + (size_t)NGLA_CH * 128)
#define SCR_USED     (SCR_LVT + (size_t)BATCH * H_GLA * 64 * SEQ * 2)
static_assert(SCR_USED <= SCR_BYTES, "scratch overflow");
#define CW_BAR      0
#define CW_CNT      4096
#define CW_Q        4224

struct Params {
    const float* in[23];
    float* out;
    char* ws;
};

__device__ __forceinline__ float sigmoidf_(float x) { return 1.f / (1.f + __expf(-x)); }
__device__ __forceinline__ float siluf_(float x) { return x / (1.f + __expf(-x)); }
__device__ __forceinline__ float softplusf_(float x) { return x > 20.f ? x : log1pf(__expf(x)); }
__device__ __forceinline__ float logsigmoidf_(float x) { return -softplusf_(-x); }
__device__ __forceinline__ float wave_sum(float v) {
#pragma unroll
    for (int o = 32; o > 0; o >>= 1) v += __shfl_xor(v, o, 64);
    return v;
}
__device__ __forceinline__ int ltid() { int t = threadIdx.x; asm volatile("" : "+v"(t)); return t; }
typedef __bf16 bf16x2_t __attribute__((ext_vector_type(2)));
typedef float f32x2_t __attribute__((ext_vector_type(2)));
__device__ __forceinline__ unsigned pk_bf16(float lo, float hi) { f32x2_t v = {lo, hi}; bf16x2_t r = __builtin_convertvector(v, bf16x2_t); return __builtin_bit_cast(unsigned, r); }
__device__ __forceinline__ unsigned ld_u32_agent(const unsigned* p) { return __hip_atomic_load(p, __ATOMIC_RELAXED, __HIP_MEMORY_SCOPE_AGENT); }
__device__ __forceinline__ float ld_f32_agent(const float* p) { return __uint_as_float(__hip_atomic_load((const unsigned*)p, __ATOMIC_RELAXED, __HIP_MEMORY_SCOPE_AGENT)); }
__device__ __forceinline__ float bf2f(bf16_t v) { return __uint_as_float((unsigned)v << 16); }
__device__ __forceinline__ float bflo(unsigned v) { return __uint_as_float(v << 16); }
__device__ __forceinline__ float bfhi(unsigned v) { return __uint_as_float(v & 0xffff0000u); }

#define XB_TMO      128
#define XB_XCNT(j)  (256  + 64 * (j))
#define XB_XSUB(j)  (1280 + 64 * (j))
#define XB_XGEN(j)  (2304 + 64 * (j))
#define XB_TOP      3328
#define XB_TOPGEN   3392
#define XCD_BAR_WORDS 3456
#define XB_SPIN_CAP (1u << 22)
#define LAS __attribute__((address_space(3)))
__device__ __forceinline__ unsigned xb_ld(unsigned* p)              { return __hip_atomic_load(p, __ATOMIC_RELAXED, __HIP_MEMORY_SCOPE_AGENT); }
__device__ __forceinline__ unsigned xb_add(unsigned* p, unsigned v) { return __hip_atomic_fetch_add(p, v, __ATOMIC_RELAXED, __HIP_MEMORY_SCOPE_AGENT); }
__device__ __forceinline__ unsigned xb_xcc_id() { return (unsigned)__builtin_amdgcn_s_getreg((3 << 11) | 20) & 0xFu; }
#define XB_SPIN(cond, bar) do { unsigned _sp = 0; while (cond) { __builtin_amdgcn_s_sleep(1); \
    if ((++_sp & 255u) == 0u) { if (xb_ld(&(bar)[XB_TMO])) break; if (_sp > XB_SPIN_CAP) { atomicAdd(&(bar)[XB_TMO], 1u); break; } } } } while (0)
struct XcdBarrier { unsigned* bar; unsigned x; volatile LAS unsigned* st; };
__device__ __forceinline__ XcdBarrier xcd_barrier_post(unsigned* bar, volatile LAS unsigned* st) {
    XcdBarrier b; b.bar = bar; b.x = xb_xcc_id(); b.st = st;
    if (threadIdx.x == 0) (void)xb_add(&bar[XB_XCNT(b.x)], 1u);
    return b;
}
__device__ __forceinline__ void xcd_barrier_complete(unsigned* bar, unsigned x, unsigned& nloc, unsigned& nx) {
    const unsigned G = gridDim.x * gridDim.y * gridDim.z;
    unsigned sum, cnt, mine, sp = 0u;
    for (;;) {
        sum = 0u; cnt = 0u; mine = 0u;
#pragma unroll
        for (unsigned j = 0; j < 16; ++j) { const unsigned c = xb_ld(&bar[XB_XCNT(j)]); sum += c; cnt += (c > 0u) ? 1u : 0u; mine = (j == x) ? c : mine; }
        if (sum == G) break;
        __builtin_amdgcn_s_sleep(1);
        if ((++sp & 255u) == 0u) { if (xb_ld(&bar[XB_TMO])) break; if (sp > XB_SPIN_CAP) { atomicAdd(&bar[XB_TMO], 1u); break; } }
    }
    nloc = mine > 0u ? mine : 1u; nx = cnt > 0u ? cnt : 1u;
}
__device__ __forceinline__ void xcd_barrier(const XcdBarrier& b) {
    asm volatile("s_waitcnt vmcnt(0)" ::: "memory");
    __syncthreads();
    if (threadIdx.x == 0) {
        unsigned* bar = b.bar;
        __builtin_amdgcn_s_waitcnt(0);
        unsigned nloc = b.st[0], nx = b.st[1];
        if (nloc == 0u) { xcd_barrier_complete(bar, b.x, nloc, nx); b.st[0] = nloc; b.st[1] = nx; }
        const unsigned old = xb_add(&bar[XB_XSUB(b.x)], 1u);
        const unsigned gen = old / nloc;
        if (old + 1u == (gen + 1u) * nloc) {
            __builtin_amdgcn_fence(__ATOMIC_RELEASE, "agent");
            asm volatile("s_waitcnt vmcnt(0)" ::: "memory");
            const unsigned og = xb_add(&bar[XB_TOP], 1u);
            const unsigned tg = og / nx;
            if (og + 1u == (tg + 1u) * nx) xb_add(&bar[XB_TOPGEN], 1u);
            else XB_SPIN(xb_ld(&bar[XB_TOPGEN]) == tg, bar);
            __builtin_amdgcn_fence(__ATOMIC_ACQUIRE, "agent");
            xb_add(&bar[XB_XGEN(b.x)], 1u);
            asm volatile("s_waitcnt vmcnt(0)" ::: "memory");
        } else {
            XB_SPIN(xb_ld(&bar[XB_XGEN(b.x)]) == gen, bar);
            __builtin_amdgcn_fence(__ATOMIC_ACQUIRE, "agent");
            asm volatile("s_waitcnt vmcnt(0)" ::: "memory");
        }
    }
    __syncthreads();
}

#define LDS_BYTES 66560
#define LROW 72

__device__ __forceinline__ int inproj_map(int n) {
    if (n < 1152) return n;
    if (n < 2304) return C_GQ + (n - 1152);
    if (n < 2688) return C_GG + (n - 2304);
    if (n < 3456) return C_LQ + (n - 2688);
    if (n < 3462) return C_FF + (n - 3456);
    if (n < 3468) return C_GA + (n - 3462);
    if (n < 3474) return C_GB + (n - 3468);
    if (n < 3490) return n;
    return -1;
}
__device__ __forceinline__ void conv_tile(const float* __restrict__ src, int ld, int col, bf16_t* __restrict__ dst_row, int k0) {
    float v[16];
    if (col >= 0) {
#pragma unroll
        for (int i = 0; i < 16; ++i) v[i] = src[(size_t)(k0 + i) * ld + col];
    } else {
#pragma unroll
        for (int i = 0; i < 16; ++i) v[i] = 0.f;
    }
    uint4 o0, o1;
    o0.x = pk_bf16(v[0], v[1]); o0.y = pk_bf16(v[2], v[3]); o0.z = pk_bf16(v[4], v[5]); o0.w = pk_bf16(v[6], v[7]);
    o1.x = pk_bf16(v[8], v[9]); o1.y = pk_bf16(v[10], v[11]); o1.z = pk_bf16(v[12], v[13]); o1.w = pk_bf16(v[14], v[15]);
    *(uint4*)(dst_row + k0) = o0;
    *(uint4*)(dst_row + k0 + 8) = o1;
}
#define P0_T_IN   (56 * 16)
#define P0_T_OUT  (16 * 16)
#define P0_T_GU   (32 * 16 * 16)
#define P0_T_D    (32 * 16 * 8)
#define P0_T_R    (16)
#define P0_T_LAYER (P0_T_IN + P0_T_OUT + P0_T_GU + P0_T_D + P0_T_R)
#define P0_T_NORM (NTOK / 4)
__device__ __forceinline__ void conv_job(const Params& p, int l, int j, int tid) {
    const int nl = tid & 63, kg = tid >> 6;
    if (j < P0_T_IN) {
        int tn = j / 16, tk = j % 16; int n = tn * 64 + nl;
        conv_tile(p.in[2] + (size_t)l * 1024 * N_IN, N_IN, inproj_map(n), (bf16_t*)(p.ws + WS_WIN) + ((size_t)l * NINP + n) * 1024, tk * 64 + kg * 16);
        return;
    }
    j -= P0_T_IN;
    if (j < P0_T_OUT) {
        int tn = j / 16, tk = j % 16; int n = tn * 64 + nl;
        conv_tile(p.in[14] + (size_t)l * 1024 * 1024, 1024, n, (bf16_t*)(p.ws + WS_WOUT) + ((size_t)l * 1024 + n) * 1024, tk * 64 + kg * 16);
        return;
    }
    j -= P0_T_OUT;
    if (j < P0_T_GU) {
        int e = j / 256, r = j % 256; int tn = r / 16, tk = r % 16; int n = tn * 64 + nl;
        int t128 = n >> 7, wx = (n >> 6) & 1, half = (n >> 5) & 1, jj = n & 31;
        int hid = t128 * 64 + wx * 32 + jj;
        const float* src = (half ? p.in[21] : p.in[20]) + ((size_t)l * 32 + e) * 1024 * 512;
        conv_tile(src, 512, hid, (bf16_t*)(p.ws + WS_WGU) + (((size_t)l * 32 + e) * 1024 + n) * 1024, tk * 64 + kg * 16);
        return;
    }
    j -= P0_T_GU;
    if (j < P0_T_D) {
        int e = j / 128, r = j % 128; int tn = r / 8, tk = r % 8; int n = tn * 64 + nl;
        const float* src = p.in[22] + ((size_t)l * 32 + e) * 512 * 1024;
        conv_tile(src, 1024, n, (bf16_t*)(p.ws + WS_WD) + (((size_t)l * 32 + e) * 1024 + n) * 512, tk * 64 + kg * 16);
        return;
    }
    j -= P0_T_D;
    {
        int tk = j; int n = nl;
        const float* src; int ld, col;
        if (n < 4) { src = p.in[16] + (size_t)l * 1024 * 4; ld = 4; col = n; }
        else if (n < 36) { src = p.in[18] + (size_t)l * 1024 * 32; ld = 32; col = n - 4; }
        else { src = p.in[16]; ld = 4; col = -1; }
        conv_tile(src, ld, col, (bf16_t*)(p.ws + WS_WR) + ((size_t)l * 64 + n) * 1024, tk * 64 + kg * 16);
    }
}
#define CONV_REST (P0_T_LAYER - P0_T_IN)
__device__ __forceinline__ void conv_fold(const Params& p, int l, int idx, int tid) {
    if (idx < CONV_REST) conv_job(p, l, P0_T_IN + idx, tid);
    else if (l == 0 && idx < CONV_REST + P0_T_IN) conv_job(p, 1, idx - CONV_REST, tid);
}
__device__ void phase0(const Params& p) {
    const int tid = ltid(), nl = tid & 63, kg = tid >> 6;
    const int total = P0_T_IN + P0_T_NORM;
    for (int it = blockIdx.x; it < total; it += gridDim.x) {
        if (it >= P0_T_IN) {
            int row = (it - P0_T_IN) * 4 + kg;
            const float* xr = p.in[0] + (size_t)row * D_MODEL + nl * 16;
            const float* gr = p.in[1] + nl * 16;
            float v[16]; float ss = 0.f;
#pragma unroll
            for (int i = 0; i < 4; ++i) { float4 t = *(const float4*)(xr + 4 * i); v[4 * i] = t.x; v[4 * i + 1] = t.y; v[4 * i + 2] = t.z; v[4 * i + 3] = t.w; }
#pragma unroll
            for (int i = 0; i < 16; ++i) ss += v[i] * v[i];
            ss = wave_sum(ss);
            float r = rsqrtf(ss / D_MODEL + 1e-6f);
#pragma unroll
            for (int i = 0; i < 16; ++i) v[i] = v[i] * r * gr[i];
            uint4 o0, o1;
            o0.x = pk_bf16(v[0], v[1]); o0.y = pk_bf16(v[2], v[3]); o0.z = pk_bf16(v[4], v[5]); o0.w = pk_bf16(v[6], v[7]);
            o1.x = pk_bf16(v[8], v[9]); o1.y = pk_bf16(v[10], v[11]); o1.z = pk_bf16(v[12], v[13]); o1.w = pk_bf16(v[14], v[15]);
            bf16_t* hr = (bf16_t*)(p.ws + WS_HN) + (size_t)row * D_MODEL + nl * 16;
            *(uint4*)hr = o0; *(uint4*)(hr + 8) = o1;
            continue;
        }
        conv_job(p, 0, it, tid);
    }
}

#define GSTAGE 8192
#define RAW_BARRIER() do { asm volatile("s_waitcnt lgkmcnt(0)" ::: "memory"); __builtin_amdgcn_s_barrier(); } while (0)
__device__ __forceinline__ int gswz(int row) { return (0x1320 >> (((row >> 2) & 3) * 4)) & 3; }
__device__ __forceinline__ void gemm_issue(const bf16_t* const (&px)[2], const bf16_t* const (&py)[2], int k0, bf16_t* stage, int w) {
    __builtin_amdgcn_global_load_lds((const unsigned*)(px[0] + k0), (unsigned*)(stage + (w * 16) * 32), 16, 0, 0);
    __builtin_amdgcn_global_load_lds((const unsigned*)(px[1] + k0), (unsigned*)(stage + (64 + w * 16) * 32), 16, 0, 0);
    __builtin_amdgcn_global_load_lds((const unsigned*)(py[0] + k0), (unsigned*)(stage + 4096 + (w * 16) * 32), 16, 0, 0);
    __builtin_amdgcn_global_load_lds((const unsigned*)(py[1] + k0), (unsigned*)(stage + 4096 + (64 + w * 16) * 32), 16, 0, 0);
}
__device__ __forceinline__ void gemm_compute(const bf16_t* stage, int wx, int wy, int fr, int fg, f32x4 (&acc)[4][4]) {
    const int co = (fg ^ gswz(fr)) * 8;
    bf16x8 xa[4], yb[4];
#pragma unroll
    for (int m = 0; m < 4; ++m) xa[m] = *(const bf16x8*)(stage + (wx * 64 + m * 16 + fr) * 32 + co);
#pragma unroll
    for (int n = 0; n < 4; ++n) yb[n] = *(const bf16x8*)(stage + 4096 + (wy * 64 + n * 16 + fr) * 32 + co);
#pragma unroll
    for (int m = 0; m < 4; ++m)
#pragma unroll
        for (int n = 0; n < 4; ++n) acc[m][n] = __builtin_amdgcn_mfma_f32_16x16x32_bf16(xa[m], yb[n], acc[m][n], 0, 0, 0);
}
template <class FX, class FY>
__device__ __forceinline__ void gemm_core(FX rowx, FY rowy, int K, bf16_t* lds, f32x4 (&acc)[4][4], int gvar = 0) {
    const int tid = ltid(), lane = tid & 63, w = __builtin_amdgcn_readfirstlane(tid >> 6), wx = w >> 1, wy = w & 1, fr = lane & 15, fg = lane >> 4;
#pragma unroll
    for (int a = 0; a < 4; ++a)
#pragma unroll
        for (int b = 0; b < 4; ++b) acc[a][b] = (f32x4){0.f, 0.f, 0.f, 0.f};
    const bf16_t* px[2]; const bf16_t* py[2];
    {
        const int r0 = w * 16 + (lane >> 2), pc = lane & 3;
        const int lc0 = (pc ^ gswz(r0)) * 8;
        px[0] = rowx(r0) + lc0; px[1] = rowx(r0 + 64) + lc0;
        py[0] = rowy(r0) + lc0; py[1] = rowy(r0 + 64) + lc0;
    }
    const int nt = K >> 5;
    RAW_BARRIER();
    if (gvar != 3) {
    gemm_issue(px, py, 0, lds, w);
    gemm_issue(px, py, 32, lds + GSTAGE, w);
    gemm_issue(px, py, 64, lds + 2 * GSTAGE, w);
    }
    for (int j = 0; j < nt; ++j) {
        if (j + 2 < nt) asm volatile("s_waitcnt vmcnt(8)" ::: "memory");
        else if (j + 1 < nt) asm volatile("s_waitcnt vmcnt(4)" ::: "memory");
        else asm volatile("s_waitcnt vmcnt(0)" ::: "memory");
        RAW_BARRIER();
        if (j + 3 < nt && gvar != 3) gemm_issue(px, py, (j + 3) * 32, lds + ((j + 3) & 3) * GSTAGE, w);
        if (gvar != 2) gemm_compute(lds + (j & 3) * GSTAGE, wx, wy, fr, fg, acc);
    }
}
__device__ __forceinline__ void store4_bf16(bf16_t* p, float a, float b, float c, float d) {
    uint2 o; o.x = pk_bf16(a, b); o.y = pk_bf16(c, d); *(uint2*)p = o;
}

__device__ __forceinline__ bool xcd_item(int round, int ntm, int ntn, int& tm, int& tn) {
    const int x = blockIdx.x & 7, loc = blockIdx.x >> 3, nloc = gridDim.x >> 3;
    const int tmx = ntm >> 3;
    const int j = round * nloc + loc;
    if (j >= tmx * ntn) return false;
    tn = j / tmx; tm = (j % tmx) * 8 + x;
    return true;
}

__device__ void phase_inproj(const Params& p, int l, bf16_t* lds, int gvar = 0) {
    const int tid = ltid(), lane = tid & 63, w = tid >> 6, wx = w >> 1, wy = w & 1, fr = lane & 15, fg = lane >> 4;
    const bf16_t* hn = (const bf16_t*)(p.ws + WS_HN);
    const bf16_t* wt = (const bf16_t*)(p.ws + WS_WIN) + (size_t)l * NINP * 1024;
    bf16_t* proj = (bf16_t*)(p.ws + WS_PROJ);
    bf16_t* vtf = (bf16_t*)(p.ws + WS_VTF);
    float* aux = (float*)(p.ws + WS_AUX);
    const float* qg = p.in[3] + l * 64; const float* kg = p.in[4] + l * 64;
    for (int round = 0;; ++round) {
        int tm, tn;
        if (!xcd_item(round, NTOK / 128, NINP / 128, tm, tn)) break;
        const bool vt = (tn >= 6 && tn < 9) || tn == 23 || tn == 24;
        f32x4 acc[4][4];
        {
            const bf16_t* wbase = wt + (size_t)(tn * 128) * 1024; const bf16_t* tbase = hn + (size_t)(tm * 128) * 1024;
            auto rw = [&](int r) { return wbase + (size_t)r * 1024; };
            auto rt_ = [&](int r) { return tbase + (size_t)r * 1024; };
            if (vt) gemm_core(rt_, rw, 1024, lds, acc, gvar); else gemm_core(rw, rt_, 1024, lds, acc, gvar);
        }
        if (gvar == 0) {
#pragma unroll 1
            for (int c = 0; c < 4; ++c) conv_fold(p, l, (round * 4 + c) * (int)gridDim.x + (int)blockIdx.x, tid);
        }
        if (gvar != 0 && acc[0][0][0] != 123456.789f) continue;
        if (vt) {
#pragma unroll
            for (int n = 0; n < 4; ++n) {
                const bool fox = tn < 9;
                int ch = tn * 128 + wy * 64 + n * 16 + fr - (fox ? NC_FV : NC_LV); int h = ch >> 6, e = ch & 63;
                bf16_t* dst = fox ? vtf : (bf16_t*)(p.ws + WS_SCR + SCR_LVT); const int nh = fox ? H_FOX : H_GLA;
#pragma unroll
                for (int m = 0; m < 4; ++m) {
                    int t = tm * 128 + wx * 64 + m * 16 + 4 * fg; int b = t / SEQ, s = t % SEQ;
                    store4_bf16(dst + ((size_t)(b * nh + h) * 64 + e) * SEQ + s, acc[m][n][0], acc[m][n][1], acc[m][n][2], acc[m][n][3]);
                }
            }
        } else {
            const int c0 = tn * 128 + wx * 64;
            if (tn < 6) {
                const float* gn = (tn < 3) ? qg : kg; const float sc = (tn < 3) ? 0.125f : 1.f;
                float g[4][4];
#pragma unroll
                for (int m = 0; m < 4; ++m)
#pragma unroll
                    for (int r = 0; r < 4; ++r) g[m][r] = gn[m * 16 + 4 * fg + r] * sc;
#pragma unroll
                for (int n = 0; n < 4; ++n) {
                    float ss = 0.f;
#pragma unroll
                    for (int m = 0; m < 4; ++m)
#pragma unroll
                        for (int r = 0; r < 4; ++r) ss += acc[m][n][r] * acc[m][n][r];
                    ss += __shfl_xor(ss, 16, 64); ss += __shfl_xor(ss, 32, 64);
                    float rs = rsqrtf(ss * (1.f / 64.f) + 1e-6f);
                    int t = tm * 128 + wy * 64 + n * 16 + fr;
#pragma unroll
                    for (int m = 0; m < 4; ++m)
                        store4_bf16(proj + (size_t)t * NPROJ + c0 + m * 16 + 4 * fg, acc[m][n][0] * rs * g[m][0], acc[m][n][1] * rs * g[m][1], acc[m][n][2] * rs * g[m][2], acc[m][n][3] * rs * g[m][3]);
                }
            } else if (tn == 27) {
#pragma unroll
                for (int n = 0; n < 4; ++n) {
                    int t = tm * 128 + wy * 64 + n * 16 + fr;
#pragma unroll
                    for (int m = 0; m < 4; ++m) {
                        int c = wx * 64 + m * 16 + 4 * fg;
                        if (c < 64) *(float4*)(aux + (size_t)t * 64 + c) = make_float4(acc[m][n][0], acc[m][n][1], acc[m][n][2], acc[m][n][3]);
                    }
                }
            } else {
                const bool do_silu = (tn >= 18 && tn < 21) || (tn >= 25);
                const float sc = (tn == 21) ? 0.17677669529663687f : 1.f;
#pragma unroll
                for (int n = 0; n < 4; ++n) {
                    int t = tm * 128 + wy * 64 + n * 16 + fr;
#pragma unroll
                    for (int m = 0; m < 4; ++m) {
                        float v0 = acc[m][n][0] * sc, v1 = acc[m][n][1] * sc, v2 = acc[m][n][2] * sc, v3 = acc[m][n][3] * sc;
                        if (do_silu) { v0 = siluf_(v0); v1 = siluf_(v1); v2 = siluf_(v2); v3 = siluf_(v3); }
                        store4_bf16(proj + (size_t)t * NPROJ + c0 + m * 16 + 4 * fg, v0, v1, v2, v3);
                    }
                }
            }
        }
    }
}

__device__ void phase_outproj(const Params& p, int l, bf16_t* lds) {
    const int tid = ltid(), lane = tid & 63, w = tid >> 6, wx = w >> 1, wy = w & 1, fr = lane & 15, fg = lane >> 4;
    const bf16_t* mix = (const bf16_t*)(p.ws + WS_MIX);
    const bf16_t* wt = (const bf16_t*)(p.ws + WS_WOUT) + (size_t)l * 1024 * 1024;
    const float* xin = (l == 0) ? p.in[0] : p.out;
    float* xo = p.out;
    for (int round = 0;; ++round) {
        int tm, tn;
        if (!xcd_item(round, NTOK / 128, 8, tm, tn)) break;
        f32x4 acc[4][4];
        {
            const bf16_t* wbase = wt + (size_t)(tn * 128) * 1024; const bf16_t* tbase = mix + (size_t)(tm * 128) * 1024;
            auto rw = [&](int r) { return wbase + (size_t)r * 1024; };
            auto rt_ = [&](int r) { return tbase + (size_t)r * 1024; };
            gemm_core(rw, rt_, 1024, lds, acc);
        }
#pragma unroll
        for (int n = 0; n < 4; ++n) {
            int t = tm * 128 + wy * 64 + n * 16 + fr;
#pragma unroll
            for (int m = 0; m < 4; ++m) {
                int c = tn * 128 + wx * 64 + m * 16 + 4 * fg;
                float4 xv = *(const float4*)(xin + (size_t)t * 1024 + c);
                xv.x += acc[m][n][0]; xv.y += acc[m][n][1]; xv.z += acc[m][n][2]; xv.w += acc[m][n][3];
                *(float4*)(xo + (size_t)t * 1024 + c) = xv;
            }
        }
    }
}

__device__ void phase_route(const Params& p, int l, bf16_t* lds) {
    const int tid = ltid(), lane = tid & 63, w = tid >> 6, fr = lane & 15, fg = lane >> 4;
    const float* x1 = p.out;
    const float* gain = p.in[15] + l * 1024;
    bf16_t* hn = (bf16_t*)(p.ws + WS_HN);
    const bf16_t* wr = (const bf16_t*)(p.ws + WS_WR) + (size_t)l * 64 * 1024;
    const float* brg = p.in[17] + l * 4; const float* bre = p.in[19] + l * 32;
    unsigned* cnt = (unsigned*)(p.ws + WS_CTL) + CW_CNT + l * 32;
    int* rowtok = (int*)(p.ws + WS_ROWTOK);
    int* tslot = (int*)(p.ws + WS_TSLOT);
    float* tgate = (float*)(p.ws + WS_TGATE);
    const int HL = 1032;
    float* red = (float*)(lds + 16 * HL);
    for (int it = blockIdx.x; it < NTOK / 16; it += gridDim.x) {
        __syncthreads();
#pragma unroll
        for (int rr = 0; rr < 4; ++rr) {
            int lr = w * 4 + rr; int t = it * 16 + lr;
            const float* xr = x1 + (size_t)t * 1024 + lane * 16;
            float v[16]; float ss = 0.f;
#pragma unroll
            for (int i = 0; i < 4; ++i) { float4 q = *(const float4*)(xr + 4 * i); v[4 * i] = q.x; v[4 * i + 1] = q.y; v[4 * i + 2] = q.z; v[4 * i + 3] = q.w; }
#pragma unroll
            for (int i = 0; i < 16; ++i) ss += v[i] * v[i];
            ss = wave_sum(ss);
            float r = rsqrtf(ss / D_MODEL + 1e-6f);
#pragma unroll
            for (int i = 0; i < 16; ++i) v[i] = v[i] * r * gain[lane * 16 + i];
            uint4 o0, o1;
            o0.x = pk_bf16(v[0], v[1]); o0.y = pk_bf16(v[2], v[3]); o0.z = pk_bf16(v[4], v[5]); o0.w = pk_bf16(v[6], v[7]);
            o1.x = pk_bf16(v[8], v[9]); o1.y = pk_bf16(v[10], v[11]); o1.z = pk_bf16(v[12], v[13]); o1.w = pk_bf16(v[14], v[15]);
            bf16_t* hr = hn + (size_t)t * 1024 + lane * 16;
            *(uint4*)hr = o0; *(uint4*)(hr + 8) = o1;
            *(uint4*)(lds + lr * HL + lane * 16) = o0; *(uint4*)(lds + lr * HL + lane * 16 + 8) = o1;
        }
        __syncthreads();
        f32x4 acc[3];
#pragma unroll
        for (int n = 0; n < 3; ++n) acc[n] = (f32x4){0.f, 0.f, 0.f, 0.f};
#pragma unroll
        for (int ks = 0; ks < 8; ++ks) {
            int k = w * 256 + ks * 32 + fg * 8;
            bf16x8 a = *(const bf16x8*)(lds + fr * HL + k);
#pragma unroll
            for (int n = 0; n < 3; ++n) {
                bf16x8 b = *(const bf16x8*)(wr + (size_t)(n * 16 + fr) * 1024 + k);
                acc[n] = __builtin_amdgcn_mfma_f32_16x16x32_bf16(a, b, acc[n], 0, 0, 0);
            }
        }
#pragma unroll
        for (int n = 0; n < 3; ++n) *(f32x4*)(red + ((w * 3 + n) * 64 + lane) * 4) = acc[n];
        __syncthreads();
        if (tid < 16) {
            float lg[36];
#pragma unroll
            for (int j = 0; j < 36; ++j) {
                int n = j >> 4, f = j & 15; int ln = (tid >> 2) * 16 + f; float s = 0.f;
#pragma unroll
                for (int ww = 0; ww < 4; ++ww) s += red[((ww * 3 + n) * 64 + ln) * 4 + (tid & 3)];
                lg[j] = s;
            }
            float gl[4]; float gm = -1e30f; int gi = 0;
#pragma unroll
            for (int j = 0; j < 4; ++j) { gl[j] = lg[j] + brg[j]; if (gl[j] > gm) { gm = gl[j]; gi = j; } }
            float gs = 0.f;
#pragma unroll
            for (int j = 0; j < 4; ++j) gs += __expf(gl[j] - gm);
            float gp = 1.f / gs;
            float el[8]; float em = -1e30f;
#pragma unroll
            for (int j = 0; j < 8; ++j) {
                float v = (gi == 0) ? lg[4 + j] : (gi == 1) ? lg[12 + j] : (gi == 2) ? lg[20 + j] : lg[28 + j];
                el[j] = v + bre[gi * 8 + j]; em = fmaxf(em, el[j]);
            }
#pragma unroll
            for (int j = 0; j < 8; ++j) el[j] = __expf(el[j] - em);
            float v0 = -1.f, v1 = -1.f; int i0 = 0, i1 = 0;
#pragma unroll
            for (int j = 0; j < 8; ++j) {
                float v = el[j];
                if (v > v0) { v1 = v0; i1 = i0; v0 = v; i0 = j; }
                else if (v > v1) { v1 = v; i1 = j; }
            }
            int t = it * 16 + tid;
            int e0 = gi * 8 + i0, e1 = gi * 8 + i1;
            unsigned s0 = atomicAdd(&cnt[e0], 1u), s1 = atomicAdd(&cnt[e1], 1u);
            rowtok[(size_t)e0 * NTOK + s0] = t; rowtok[(size_t)e1 * NTOK + s1] = t;
            tslot[t * 2] = (e0 << 16) | (int)s0; tslot[t * 2 + 1] = (e1 << 16) | (int)s1;
            tgate[t * 2] = gp * v0 / (v0 + v1); tgate[t * 2 + 1] = gp * v1 / (v0 + v1);
        }
    }
}

__device__ __forceinline__ void moe_tables(const unsigned* cnt, int* tab) {
    if (threadIdx.x == 0) {
        int a = 0;
        for (int e = 0; e < 32; ++e) { tab[e] = a; tab[40 + e] = a * 128; a += ((int)ld_u32_agent(cnt + e) + 127) >> 7; }
        tab[32] = a; tab[72] = a * 128;
    }
    __syncthreads();
}
template <int MODE>
__device__ void phase_expert(const Params& p, int l, bf16_t* lds) {
    const int tid = ltid(), lane = tid & 63, w = tid >> 6, wx = w >> 1, wy = w & 1, fr = lane & 15, fg = lane >> 4;
    const unsigned* cnt = (const unsigned*)(p.ws + WS_CTL) + CW_CNT + l * 32;
    int* tab = (int*)(lds + 4 * GSTAGE);
    moe_tables(cnt, tab);
    const int* rowtok = (const int*)(p.ws + WS_ROWTOK);
    const bf16_t* hn = (const bf16_t*)(p.ws + WS_HN);
    bf16_t* Hb = (bf16_t*)(p.ws + WS_H);
    bf16_t* Yb = (bf16_t*)(p.ws + WS_Y);
    const int x = blockIdx.x & 7, loc = blockIdx.x >> 3, nloc = gridDim.x >> 3;
    for (int j = loc;; j += nloc) {
        int e = -1, rt = 0, tn = 0; int jj = j;
#pragma unroll
        for (int q = 0; q < 4; ++q) {
            int ee = q * 8 + x; int nrt = tab[ee + 1] - tab[ee];
            if (e < 0) { if (jj < nrt * 8) { e = ee; tn = jj / nrt; rt = jj % nrt; } else jj -= nrt * 8; }
        }
        if (e < 0) break;
        const int c_e = (int)ld_u32_agent(cnt + e); const int hrow0 = tab[40 + e] + rt * 128;
        f32x4 acc[4][4];
        if (MODE == 0) {
            const bf16_t* wbase = (const bf16_t*)(p.ws + WS_WGU) + (((size_t)l * 32 + e) * 1024 + tn * 128) * 1024;
            const int* rtk = rowtok + (size_t)e * NTOK + rt * 128; const int nval = c_e - rt * 128;
            auto rw = [&](int r) { return wbase + (size_t)r * 1024; };
            auto rt_ = [&](int r) { int t = (r < nval) ? rtk[r] : 0; return hn + (size_t)t * 1024; };
            gemm_core(rw, rt_, 1024, lds, acc);
        } else {
            const bf16_t* wbase = (const bf16_t*)(p.ws + WS_WD) + (((size_t)l * 32 + e) * 1024 + tn * 128) * 512;
            const bf16_t* hbase = Hb + (size_t)hrow0 * 512;
            auto rw = [&](int r) { return wbase + (size_t)r * 512; };
            auto rt_ = [&](int r) { return hbase + (size_t)r * 512; };
            gemm_core(rw, rt_, 512, lds, acc);
        }
        if (MODE == 0) {
#pragma unroll
            for (int n = 0; n < 4; ++n) {
                int hr = hrow0 + wy * 64 + n * 16 + fr;
#pragma unroll
                for (int m = 0; m < 2; ++m) {
                    int hc = tn * 64 + wx * 32 + m * 16 + 4 * fg;
                    store4_bf16(Hb + (size_t)hr * 512 + hc, siluf_(acc[m][n][0]) * acc[m + 2][n][0], siluf_(acc[m][n][1]) * acc[m + 2][n][1],
                                siluf_(acc[m][n][2]) * acc[m + 2][n][2], siluf_(acc[m][n][3]) * acc[m + 2][n][3]);
                }
            }
        } else {
#pragma unroll
            for (int n = 0; n < 4; ++n) {
                int hr = hrow0 + wy * 64 + n * 16 + fr;
#pragma unroll
                for (int m = 0; m < 4; ++m) {
                    int c = tn * 128 + wx * 64 + m * 16 + 4 * fg;
                    store4_bf16(Yb + (size_t)hr * 1024 + c, acc[m][n][0], acc[m][n][1], acc[m][n][2], acc[m][n][3]);
                }
            }
        }
    }
}

__device__ void phase_combine(const Params& p, int l) {
    const int tid = ltid(), lane = tid & 63, w = tid >> 6;
    const unsigned* cnt = (const unsigned*)(p.ws + WS_CTL) + CW_CNT + l * 32;
    int c = (lane < 32) ? (((int)ld_u32_agent(cnt + (lane & 31)) + 127) >> 7) * 128 : 0;
    int incl = c;
#pragma unroll
    for (int o = 1; o < 32; o <<= 1) { int v = __shfl_up(incl, o, 64); if (lane >= o) incl += v; }
    int hoff = incl - c;
    const int* tslot = (const int*)(p.ws + WS_TSLOT);
    const float* tgate = (const float*)(p.ws + WS_TGATE);
    const bf16_t* Yb = (const bf16_t*)(p.ws + WS_Y);
    bf16_t* hn = (bf16_t*)(p.ws + WS_HN);
    float* x = p.out;
    const float* gain = (l == 0) ? p.in[1] + 1024 : nullptr;
    for (int it = blockIdx.x; it < NTOK / 4; it += gridDim.x) {
        int t = it * 4 + w;
        int ts0 = tslot[t * 2], ts1 = tslot[t * 2 + 1];
        float g0 = tgate[t * 2], g1 = tgate[t * 2 + 1];
        int r0 = __shfl(hoff, ts0 >> 16, 64) + (ts0 & 0xffff);
        int r1 = __shfl(hoff, ts1 >> 16, 64) + (ts1 & 0xffff);
        float* xr = x + (size_t)t * 1024 + lane * 16;
        const bf16_t* y0 = Yb + (size_t)r0 * 1024 + lane * 16;
        const bf16_t* y1 = Yb + (size_t)r1 * 1024 + lane * 16;
        float v[16];
#pragma unroll
        for (int i = 0; i < 4; ++i) { float4 q = *(const float4*)(xr + 4 * i); v[4 * i] = q.x; v[4 * i + 1] = q.y; v[4 * i + 2] = q.z; v[4 * i + 3] = q.w; }
        uint4 a0 = *(const uint4*)y0, a1 = *(const uint4*)(y0 + 8), b0 = *(const uint4*)y1, b1 = *(const uint4*)(y1 + 8);
        unsigned ya[8] = {a0.x, a0.y, a0.z, a0.w, a1.x, a1.y, a1.z, a1.w};
        unsigned yb[8] = {b0.x, b0.y, b0.z, b0.w, b1.x, b1.y, b1.z, b1.w};
#pragma unroll
        for (int i = 0; i < 8; ++i) {
            v[2 * i] += g0 * bflo(ya[i]) + g1 * bflo(yb[i]);
            v[2 * i + 1] += g0 * bfhi(ya[i]) + g1 * bfhi(yb[i]);
        }
#ifdef NANMARK
#pragma unroll
        for (int i = 0; i < 16; ++i) if (!(fabsf(v[i]) < 1e30f)) v[i] = 1000.f;
#endif
#pragma unroll
        for (int i = 0; i < 4; ++i) *(float4*)(xr + 4 * i) = make_float4(v[4 * i], v[4 * i + 1], v[4 * i + 2], v[4 * i + 3]);
        if (gain) {
            float ss = 0.f;
#pragma unroll
            for (int i = 0; i < 16; ++i) ss += v[i] * v[i];
            ss = wave_sum(ss);
            float r = rsqrtf(ss / D_MODEL + 1e-6f);
#pragma unroll
            for (int i = 0; i < 16; ++i) v[i] = v[i] * r * gain[lane * 16 + i];
            uint4 o0, o1;
            o0.x = pk_bf16(v[0], v[1]); o0.y = pk_bf16(v[2], v[3]); o0.z = pk_bf16(v[4], v[5]); o0.w = pk_bf16(v[6], v[7]);
            o1.x = pk_bf16(v[8], v[9]); o1.y = pk_bf16(v[10], v[11]); o1.z = pk_bf16(v[12], v[13]); o1.w = pk_bf16(v[14], v[15]);
            bf16_t* hr = hn + (size_t)t * 1024 + lane * 16;
            *(uint4*)hr = o0; *(uint4*)(hr + 8) = o1;
        }
    }
}


__device__ __forceinline__ void mm_row(const bf16_t* RA, const bf16_t* RB, int mw, int fr, int fg, f32x4 (&acc)[4]) {
#pragma unroll
    for (int ks = 0; ks < 2; ++ks) {
        bf16x8 a = *(const bf16x8*)(RA + (16 * mw + fr) * LROW + ks * 32 + fg * 8);
#pragma unroll
        for (int nt = 0; nt < 4; ++nt) {
            bf16x8 b = *(const bf16x8*)(RB + (16 * nt + fr) * LROW + ks * 32 + fg * 8);
            acc[nt] = __builtin_amdgcn_mfma_f32_16x16x32_bf16(a, b, acc[nt], 0, 0, 0);
        }
    }
}
__device__ __forceinline__ void mm_col(const bf16_t* RA, const bf16_t* RB, int nw, int fr, int fg, f32x4 (&acc)[4]) {
#pragma unroll
    for (int ks = 0; ks < 2; ++ks) {
        bf16x8 b = *(const bf16x8*)(RB + (16 * nw + fr) * LROW + ks * 32 + fg * 8);
#pragma unroll
        for (int mt = 0; mt < 4; ++mt) {
            bf16x8 a = *(const bf16x8*)(RA + (16 * mt + fr) * LROW + ks * 32 + fg * 8);
            acc[mt] = __builtin_amdgcn_mfma_f32_16x16x32_bf16(a, b, acc[mt], 0, 0, 0);
        }
    }
}
__device__ __forceinline__ void zero4(f32x4 (&a)[4]) {
#pragma unroll
    for (int i = 0; i < 4; ++i) a[i] = (f32x4){0.f, 0.f, 0.f, 0.f};
}
__device__ __forceinline__ void st4_lds(bf16_t* p, float a, float b, float c, float d) { uint2 o; o.x = pk_bf16(a, b); o.y = pk_bf16(c, d); *(uint2*)p = o; }
__device__ __forceinline__ bf16_t f2bf(float v) { return (bf16_t)(pk_bf16(v, 0.f) & 0xffffu); }

__device__ void gdn_prep_item(const Params& p, int l, int cid, unsigned char* lds_raw) {
    const int tid = ltid(), lane = tid & 63, w = tid >> 6, fr = lane & 15, fg = lane >> 4;
    const int bh = cid >> 6, n = cid & 63, b = bh / H_GDN, h = bh % H_GDN;
    const int t0 = b * SEQ + n * 64;
    bf16_t* L0 = (bf16_t*)lds_raw; bf16_t* L1 = L0 + 64 * LROW; bf16_t* L2 = L1 + 64 * LROW; bf16_t* L3 = L2 + 64 * LROW; bf16_t* L4 = L3 + 64 * LROW; bf16_t* L5 = L4 + 64 * LROW;
    float* dec = (float*)(L5 + 64 * LROW); float* beta = dec + 64;
    const bf16_t* proj = (const bf16_t*)(p.ws + WS_PROJ);
    const float* aux = (const float*)(p.ws + WS_AUX);
    const float* convw = p.in[7] + (size_t)l * 4 * 1152;
    __syncthreads();
    const int i = tid >> 2, c0 = (tid & 3) * 16;
    float qv[16], kv[16], vv[16];
#pragma unroll
    for (int which = 0; which < 3; ++which) {
        float acc[16];
#pragma unroll
        for (int c = 0; c < 16; ++c) acc[c] = 0.f;
#pragma unroll
        for (int tap = 0; tap < 4; ++tap) {
            const int row = i - 3 + tap;
            if (n * 64 + row >= 0) {
                const bf16_t* xp = proj + (size_t)(t0 + row) * NPROJ + NC_GQ + which * 384 + h * 64 + c0;
                u32x4 x0 = *(const u32x4*)xp, x1 = *(const u32x4*)(xp + 8);
                const float* wp = convw + tap * 1152 + which * 384 + h * 64 + c0;
                f32x4 w0 = *(const f32x4*)wp, w1 = *(const f32x4*)(wp + 4), w2 = *(const f32x4*)(wp + 8), w3 = *(const f32x4*)(wp + 12);
                float wv[16] = {w0[0], w0[1], w0[2], w0[3], w1[0], w1[1], w1[2], w1[3], w2[0], w2[1], w2[2], w2[3], w3[0], w3[1], w3[2], w3[3]};
                unsigned xs[8] = {x0[0], x0[1], x0[2], x0[3], x1[0], x1[1], x1[2], x1[3]};
#pragma unroll
                for (int c = 0; c < 8; ++c) { acc[2 * c] += wv[2 * c] * bflo(xs[c]); acc[2 * c + 1] += wv[2 * c + 1] * bfhi(xs[c]); }
            }
        }
        float ss = 0.f;
#pragma unroll
        for (int c = 0; c < 16; ++c) { acc[c] = siluf_(acc[c]); ss += acc[c] * acc[c]; }
        if (which < 2) {
            ss += __shfl_xor(ss, 1, 64); ss += __shfl_xor(ss, 2, 64);
            const float sc = rsqrtf(ss + 1e-6f) * (which == 0 ? 0.125f : 1.f);
#pragma unroll
            for (int c = 0; c < 16; ++c) acc[c] *= sc;
        }
#pragma unroll
        for (int c = 0; c < 16; ++c) { if (which == 0) qv[c] = acc[c]; else if (which == 1) kv[c] = acc[c]; else vv[c] = acc[c]; }
    }
#pragma unroll
    for (int c = 0; c < 16; c += 4) { st4_lds(L2 + i * LROW + c0 + c, kv[c], kv[c + 1], kv[c + 2], kv[c + 3]); st4_lds(L3 + i * LROW + c0 + c, qv[c], qv[c + 1], qv[c + 2], qv[c + 3]); }
    if (w == 0) {
        const float a = aux[(size_t)(t0 + lane) * 64 + AX_GA + h], bl = aux[(size_t)(t0 + lane) * 64 + AX_GB + h];
        const float g = -__expf(p.in[8][l * H_GDN + h]) * softplusf_(a + p.in[9][l * H_GDN + h]);
        float inc = g;
#pragma unroll
        for (int o = 1; o < 64; o <<= 1) { float t = __shfl_up(inc, o, 64); if (lane >= o) inc += t; }
        dec[lane] = inc; beta[lane] = sigmoidf_(bl);
    }
    __syncthreads();
    {
        f32x4 g4[4]; zero4(g4);
        mm_row(L2, L2, w, fr, fg, g4);
#pragma unroll
        for (int nt = 0; nt < 4; ++nt) {
            const int kap = 16 * nt + fr; const float dk_ = dec[kap], bk_ = beta[kap];
            float nT[4], nN[4], tt[4];
#pragma unroll
            for (int r = 0; r < 4; ++r) {
                const int rho = 16 * w + 4 * fg + r; const float dr_ = dec[rho], br_ = beta[rho];
                const float G = g4[nt][r];
                nT[r] = (kap < rho) ? br_ * G * __expf(dr_ - dk_) : 0.f;
                nN[r] = (rho < kap) ? bk_ * G * __expf(dk_ - dr_) : 0.f;
                tt[r] = ((kap == rho) ? 1.f : 0.f) - nN[r];
            }
            st4_lds(L1 + kap * LROW + 16 * w + 4 * fg, nT[0], nT[1], nT[2], nT[3]);
            st4_lds(L0 + kap * LROW + 16 * w + 4 * fg, nN[0], nN[1], nN[2], nN[3]);
            st4_lds(L4 + kap * LROW + 16 * w + 4 * fg, tt[0], tt[1], tt[2], tt[3]);
        }
        f32x4 a4[4]; zero4(a4);
        mm_row(L2, L3, w, fr, fg, a4);
#pragma unroll
        for (int nt = 0; nt < 4; ++nt) {
            const int ii = 16 * nt + fr; const float di_ = dec[ii];
            float v4[4];
#pragma unroll
            for (int r = 0; r < 4; ++r) { const int j = 16 * w + 4 * fg + r; v4[r] = (j <= ii) ? a4[nt][r] * __expf(di_ - dec[j]) : 0.f; }
            st4_lds(L5 + ii * LROW + 16 * w + 4 * fg, v4[0], v4[1], v4[2], v4[3]);
        }
    }
    __syncthreads();
#pragma unroll
    for (int lev = 1; lev <= 5; ++lev) {
        const bf16_t* XA = (lev & 1) ? L0 : L2; const bf16_t* XAt = (lev & 1) ? L1 : L3;
        bf16_t* XB = (lev & 1) ? L2 : L0; bf16_t* XBt = (lev & 1) ? L3 : L1;
        {
            f32x4 x4[4]; zero4(x4);
            mm_row(XA, XAt, w, fr, fg, x4);
#pragma unroll
            for (int nt = 0; nt < 4; ++nt) {
                const int c = 16 * nt + fr;
                st4_lds(XBt + c * LROW + 16 * w + 4 * fg, x4[nt][0], x4[nt][1], x4[nt][2], x4[nt][3]);
                if (lev < 5) {
#pragma unroll
                    for (int r = 0; r < 4; ++r) XB[(16 * w + 4 * fg + r) * LROW + c] = f2bf(x4[nt][r]);
                }
            }
        }
        __syncthreads();
        {
            f32x4 t4[4];
#pragma unroll
            for (int mt = 0; mt < 4; ++mt) {
                uint2 u = *(const uint2*)(L4 + (16 * w + fr) * LROW + 16 * mt + 4 * fg);
                t4[mt] = (f32x4){bflo(u.x), bfhi(u.x), bflo(u.y), bfhi(u.y)};
            }
            mm_col(XBt, L4, w, fr, fg, t4);
#pragma unroll
            for (int mt = 0; mt < 4; ++mt) st4_lds(L4 + (16 * w + fr) * LROW + 16 * mt + 4 * fg, t4[mt][0], t4[mt][1], t4[mt][2], t4[mt][3]);
        }
    }
    {
        const float dj = dec[i], bj = beta[i], dlast = dec[63];
        const float s1 = bj * __expf(dj), s2 = bj, s3 = __expf(dlast - dj);
#pragma unroll
        for (int c = 0; c < 16; ++c) {
            L0[(c0 + c) * LROW + i] = f2bf(kv[c] * s1);
            L1[(c0 + c) * LROW + i] = f2bf(vv[c] * s2);
            L2[(c0 + c) * LROW + i] = f2bf(kv[c] * s3);
        }
    }
    __syncthreads();
    {
        f32x4 w4[4], u4[4]; zero4(w4); zero4(u4);
        mm_row(L4, L0, w, fr, fg, w4);
        mm_row(L4, L1, w, fr, fg, u4);
        __syncthreads();
#pragma unroll
        for (int nt = 0; nt < 4; ++nt) {
            st4_lds(L0 + (16 * nt + fr) * LROW + 16 * w + 4 * fg, w4[nt][0], w4[nt][1], w4[nt][2], w4[nt][3]);
            st4_lds(L1 + (16 * nt + fr) * LROW + 16 * w + 4 * fg, u4[nt][0], u4[nt][1], u4[nt][2], u4[nt][3]);
        }
        const float ed = __expf(dec[i]);
#pragma unroll
        for (int c = 0; c < 16; c += 4) st4_lds(L3 + i * LROW + c0 + c, qv[c] * ed, qv[c + 1] * ed, qv[c + 2] * ed, qv[c + 3] * ed);
    }
    __syncthreads();
    char* scr = p.ws + WS_SCR;
    {
        f32x4 m4[4]; zero4(m4);
        mm_row(L0, L2, w, fr, fg, m4);
        bf16_t* MP = (bf16_t*)(scr + SCR_GDN_MP) + (size_t)cid * 4096;
#pragma unroll
        for (int nt = 0; nt < 4; ++nt) store4_bf16(MP + (16 * nt + fr) * 64 + 16 * w + 4 * fg, -m4[nt][0], -m4[nt][1], -m4[nt][2], -m4[nt][3]);
        f32x4 n4[4]; zero4(n4);
        mm_row(L2, L1, w, fr, fg, n4);
        bf16_t* NN = (bf16_t*)(scr + SCR_GDN_NN) + (size_t)cid * 4096;
#pragma unroll
        for (int nt = 0; nt < 4; ++nt) store4_bf16(NN + ((w * 4 + nt) * 64 + lane) * 4, n4[nt][0], n4[nt][1], n4[nt][2], n4[nt][3]);
        f32x4 p4[4]; zero4(p4);
        mm_row(L0, L5, w, fr, fg, p4);
        bf16_t* PG = (bf16_t*)(scr + SCR_GDN_P) + (size_t)cid * 4096;
#pragma unroll
        for (int nt = 0; nt < 4; ++nt) {
            uint2 u = *(const uint2*)(L3 + (16 * nt + fr) * LROW + 16 * w + 4 * fg);
            store4_bf16(PG + (16 * nt + fr) * 64 + 16 * w + 4 * fg, bflo(u.x) - p4[nt][0], bfhi(u.x) - p4[nt][1], bflo(u.y) - p4[nt][2], bfhi(u.y) - p4[nt][3]);
        }
        f32x4 o4[4]; zero4(o4);
        mm_row(L1, L5, w, fr, fg, o4);
        bf16_t* OL = (bf16_t*)(scr + SCR_GDN_OL) + (size_t)cid * 4096;
#pragma unroll
        for (int nt = 0; nt < 4; ++nt) store4_bf16(OL + (16 * nt + fr) * 64 + 16 * w + 4 * fg, o4[nt][0], o4[nt][1], o4[nt][2], o4[nt][3]);
        if (tid == 0) ((float*)(scr + SCR_GDN_LAST))[cid] = __expf(dec[63]);
    }
}

struct ScanOp { bf16x8 a0, a1; uint2 nn[4]; float last; };
__device__ void gdn_scan_item(const Params& p, int bh, unsigned char* lds_raw) {
    const int tid = ltid(), lane = tid & 63, w = tid >> 6, fr = lane & 15, fg = lane >> 4;
    char* scr = p.ws + WS_SCR;
    const bf16_t* MP = (const bf16_t*)(scr + SCR_GDN_MP) + (size_t)bh * 64 * 4096;
    const bf16_t* NN = (const bf16_t*)(scr + SCR_GDN_NN) + (size_t)bh * 64 * 4096;
    const float* LAST = (const float*)(scr + SCR_GDN_LAST) + bh * 64;
    bf16_t* SG = (bf16_t*)(scr + SCR_GDN_SG) + (size_t)bh * 64 * 4096;
    f32x4 S[4]; zero4(S);
    ScanOp o0, o1, o2, o3;
#define SCAN_LOAD(op, n_) do { const bf16_t* MPn = MP + (size_t)(n_) * 4096; \
        op.a0 = *(const bf16x8*)(MPn + (16 * w + fr) * 64 + fg * 8); op.a1 = *(const bf16x8*)(MPn + (16 * w + fr) * 64 + 32 + fg * 8); \
        _Pragma("unroll") for (int nt = 0; nt < 4; ++nt) op.nn[nt] = *(const uint2*)(NN + (size_t)(n_) * 4096 + ((w * 4 + nt) * 64 + lane) * 4); \
        op.last = ld_f32_agent(LAST + (n_)); } while (0)
#define SCAN_STEP(op, n_) do { \
        bf16_t* buf = (bf16_t*)lds_raw + ((n_) & 1) * 64 * LROW; \
        _Pragma("unroll") for (int nt = 0; nt < 4; ++nt) { \
            uint2 o; o.x = pk_bf16(S[nt][0], S[nt][1]); o.y = pk_bf16(S[nt][2], S[nt][3]); \
            *(uint2*)(buf + (16 * nt + fr) * LROW + 16 * w + 4 * fg) = o; \
            *(uint2*)(SG + (size_t)(n_) * 4096 + (16 * nt + fr) * 64 + 16 * w + 4 * fg) = o; } \
        __syncthreads(); \
        _Pragma("unroll") for (int nt = 0; nt < 4; ++nt) { \
            S[nt][0] = op.last * S[nt][0] + bflo(op.nn[nt].x); S[nt][1] = op.last * S[nt][1] + bfhi(op.nn[nt].x); \
            S[nt][2] = op.last * S[nt][2] + bflo(op.nn[nt].y); S[nt][3] = op.last * S[nt][3] + bfhi(op.nn[nt].y); } \
        _Pragma("unroll") for (int nt = 0; nt < 4; ++nt) { \
            bf16x8 s0 = *(const bf16x8*)(buf + (16 * nt + fr) * LROW + fg * 8), s1 = *(const bf16x8*)(buf + (16 * nt + fr) * LROW + 32 + fg * 8); \
            S[nt] = __builtin_amdgcn_mfma_f32_16x16x32_bf16(op.a0, s0, S[nt], 0, 0, 0); \
            S[nt] = __builtin_amdgcn_mfma_f32_16x16x32_bf16(op.a1, s1, S[nt], 0, 0, 0); } \
        if ((n_) + 4 < 64) SCAN_LOAD(op, (n_) + 4); } while (0)
    SCAN_LOAD(o0, 0); SCAN_LOAD(o1, 1); SCAN_LOAD(o2, 2); SCAN_LOAD(o3, 3);
    __syncthreads();
    for (int n = 0; n < 64; n += 4) { SCAN_STEP(o0, n); SCAN_STEP(o1, n + 1); SCAN_STEP(o2, n + 2); SCAN_STEP(o3, n + 3); }
#undef SCAN_LOAD
#undef SCAN_STEP
}

__device__ void gdn_out_item(const Params& p, int l, int cid) {
    const int tid = ltid(), lane = tid & 63, w = tid >> 6, fr = lane & 15, fg = lane >> 4;
    const int bh = cid >> 6, n = cid & 63, b = bh / H_GDN, h = bh % H_GDN;
    char* scr = p.ws + WS_SCR;
    const bf16_t* SG = (const bf16_t*)(scr + SCR_GDN_SG) + (size_t)cid * 4096;
    const bf16_t* PG = (const bf16_t*)(scr + SCR_GDN_P) + (size_t)cid * 4096;
    const bf16_t* OL = (const bf16_t*)(scr + SCR_GDN_OL) + (size_t)cid * 4096;
    const int i = 16 * w + fr; const int t = b * SEQ + n * 64 + i;
    f32x4 acc[4];
#pragma unroll
    for (int mt = 0; mt < 4; ++mt) { uint2 u = *(const uint2*)(OL + i * 64 + 16 * mt + 4 * fg); acc[mt] = (f32x4){bflo(u.x), bfhi(u.x), bflo(u.y), bfhi(u.y)}; }
#pragma unroll
    for (int ks = 0; ks < 2; ++ks) {
        bf16x8 bq = *(const bf16x8*)(PG + i * 64 + ks * 32 + fg * 8);
#pragma unroll
        for (int mt = 0; mt < 4; ++mt) {
            bf16x8 a = *(const bf16x8*)(SG + (16 * mt + fr) * 64 + ks * 32 + fg * 8);
            acc[mt] = __builtin_amdgcn_mfma_f32_16x16x32_bf16(a, bq, acc[mt], 0, 0, 0);
        }
    }
    float ss = 0.f;
#pragma unroll
    for (int mt = 0; mt < 4; ++mt)
#pragma unroll
        for (int r = 0; r < 4; ++r) ss += acc[mt][r] * acc[mt][r];
    ss += __shfl_xor(ss, 16, 64); ss += __shfl_xor(ss, 32, 64);
    const float rstd = rsqrtf(ss * (1.f / 64.f) + 1e-6f);
    const float* og = p.in[10] + l * 64;
    const bf16_t* gp = (const bf16_t*)(p.ws + WS_PROJ) + (size_t)t * NPROJ + NC_GG + h * 64;
    bf16_t* mp = (bf16_t*)(p.ws + WS_MIX) + (size_t)t * D_MODEL + 384 + h * 64;
#pragma unroll
    for (int mt = 0; mt < 4; ++mt) {
        const int e0 = 16 * mt + 4 * fg;
        uint2 gu = *(const uint2*)(gp + e0); f32x4 g4 = *(const f32x4*)(og + e0);
        store4_bf16(mp + e0, acc[mt][0] * rstd * g4[0] * bflo(gu.x), acc[mt][1] * rstd * g4[1] * bfhi(gu.x), acc[mt][2] * rstd * g4[2] * bflo(gu.y), acc[mt][3] * rstd * g4[3] * bfhi(gu.y));
    }
}

#define GQROW 40
__device__ void gla_prep_item(const Params& p, int l, int cid, unsigned char* lds_raw) {
    const int tid = ltid(), lane = tid & 63, w = tid >> 6, fr = lane & 15, fg = lane >> 4;
    const int bh = cid >> 6, n = cid & 63, b = bh / H_GLA, h = bh % H_GLA;
    const int t0 = b * SEQ + n * 64;
    float* Bf = (float*)lds_raw;
    bf16_t* Qt = (bf16_t*)(lds_raw + 8448);
    bf16_t* Kt = Qt + 64 * GQROW;
    bf16_t* KLt = Kt + 64 * GQROW;
    bf16_t* Vt = KLt + 32 * LROW;
    const bf16_t* proj = (const bf16_t*)(p.ws + WS_PROJ);
    const float* aux = (const float*)(p.ws + WS_AUX);
    char* scr = p.ws + WS_SCR;
    __syncthreads();
    const int i = tid >> 2, d0 = (tid & 3) * 8;
    {
        const float* wa = p.in[11] + (size_t)l * 16 * 128 + h * 32 + d0;
        const float* ba = p.in[12] + l * 128 + h * 32 + d0;
        float acc[8];
#pragma unroll
        for (int j = 0; j < 8; ++j) acc[j] = ba[j];
        float a1v[16];
#pragma unroll
        for (int r = 0; r < 16; r += 2) { float2 t2 = *(const float2*)(aux + (size_t)(t0 + i) * 64 + AX_LA + r); a1v[r] = t2.x; a1v[r + 1] = t2.y; }
#pragma unroll
        for (int r = 0; r < 16; ++r) {
            f32x4 wA = *(const f32x4*)(wa + r * 128), wB = *(const f32x4*)(wa + r * 128 + 4);
#pragma unroll
            for (int j = 0; j < 4; ++j) { acc[j] += a1v[r] * wA[j]; acc[4 + j] += a1v[r] * wB[j]; }
        }
#pragma unroll
        for (int j = 0; j < 8; ++j) Bf[i * 33 + d0 + j] = logsigmoidf_(acc[j]) * (1.f / 16.f);
    }
    {
        const bf16_t* lvt = (const bf16_t*)(scr + SCR_LVT) + (size_t)bh * 64 * SEQ + n * 64;
#pragma unroll
        for (int ii = 0; ii < 2; ++ii) { int c = tid + 256 * ii; int row = c >> 3, kc = c & 7; *(u32x4*)(Vt + row * LROW + kc * 8) = *(const u32x4*)(lvt + (size_t)row * SEQ + kc * 8); }
    }
    __syncthreads();
#pragma unroll
    for (int c = 0; c < 8; ++c) {
        const int d = 8 * w + c;
        float inc = Bf[lane * 33 + d];
#pragma unroll
        for (int o = 1; o < 64; o <<= 1) { float t = __shfl_up(inc, o, 64); if (lane >= o) inc += t; }
        Bf[lane * 33 + d] = inc;
    }
    __syncthreads();
    {
        const bf16_t* qp = proj + (size_t)(t0 + i) * NPROJ + NC_LQ + h * 32 + d0;
        const bf16_t* kp = proj + (size_t)(t0 + i) * NPROJ + NC_LK + h * 32 + d0;
        u32x4 qu = *(const u32x4*)qp, ku = *(const u32x4*)kp;
        float qf[8] = {bflo(qu[0]), bfhi(qu[0]), bflo(qu[1]), bfhi(qu[1]), bflo(qu[2]), bfhi(qu[2]), bflo(qu[3]), bfhi(qu[3])};
        float kf[8] = {bflo(ku[0]), bfhi(ku[0]), bflo(ku[1]), bfhi(ku[1]), bflo(ku[2]), bfhi(ku[2]), bflo(ku[3]), bfhi(ku[3])};
        float qt[8], kt[8], qb[8];
#pragma unroll
        for (int j = 0; j < 8; ++j) {
            const float bi = Bf[i * 33 + d0 + j], bm = Bf[31 * 33 + d0 + j], bl = Bf[63 * 33 + d0 + j];
            qt[j] = qf[j] * __expf(bi - bm); kt[j] = kf[j] * __expf(bm - bi); qb[j] = qf[j] * __expf(bi);
            KLt[(d0 + j) * LROW + i] = f2bf(kf[j] * __expf(bl - bi));
            if (i == 63) ((float*)(scr + SCR_GLA_DL))[cid * 32 + d0 + j] = __expf(bl);
        }
        u32x4 o; o[0] = pk_bf16(qt[0], qt[1]); o[1] = pk_bf16(qt[2], qt[3]); o[2] = pk_bf16(qt[4], qt[5]); o[3] = pk_bf16(qt[6], qt[7]);
        *(u32x4*)(Qt + i * GQROW + d0) = o;
        o[0] = pk_bf16(kt[0], kt[1]); o[1] = pk_bf16(kt[2], kt[3]); o[2] = pk_bf16(kt[4], kt[5]); o[3] = pk_bf16(kt[6], kt[7]);
        *(u32x4*)(Kt + i * GQROW + d0) = o;
        o[0] = pk_bf16(qb[0], qb[1]); o[1] = pk_bf16(qb[2], qb[3]); o[2] = pk_bf16(qb[4], qb[5]); o[3] = pk_bf16(qb[6], qb[7]);
        *(u32x4*)((bf16_t*)(scr + SCR_GLA_QB) + (size_t)cid * 2048 + i * 32 + d0) = o;
    }
    __syncthreads();
    f32x4 sc[4];
    {
        bf16x8 bq = *(const bf16x8*)(Qt + (16 * w + fr) * GQROW + fg * 8);
#pragma unroll
        for (int mt = 0; mt < 4; ++mt) {
            bf16x8 a = *(const bf16x8*)(Kt + (16 * mt + fr) * GQROW + fg * 8);
            sc[mt] = __builtin_amdgcn_mfma_f32_16x16x32_bf16(a, bq, (f32x4){0.f, 0.f, 0.f, 0.f}, 0, 0, 0);
        }
        const int ii = 16 * w + fr;
#pragma unroll
        for (int mt = 0; mt < 4; ++mt)
#pragma unroll
            for (int r = 0; r < 4; ++r) { const int j = 16 * mt + 4 * fg + r; if (j > ii) sc[mt][r] = 0.f; }
    }
    {
        f32x4 o4[4]; zero4(o4);
#pragma unroll
        for (int kk = 0; kk < 2; ++kk) {
            u32x4 pb = {pk_bf16(sc[2 * kk][0], sc[2 * kk][1]), pk_bf16(sc[2 * kk][2], sc[2 * kk][3]), pk_bf16(sc[2 * kk + 1][0], sc[2 * kk + 1][1]), pk_bf16(sc[2 * kk + 1][2], sc[2 * kk + 1][3])};
#pragma unroll
            for (int mt = 0; mt < 4; ++mt) {
                uint2 v0 = *(const uint2*)(Vt + (16 * mt + fr) * LROW + 32 * kk + 4 * fg), v1 = *(const uint2*)(Vt + (16 * mt + fr) * LROW + 32 * kk + 16 + 4 * fg);
                u32x4 va = {v0.x, v0.y, v1.x, v1.y};
                o4[mt] = __builtin_amdgcn_mfma_f32_16x16x32_bf16(__builtin_bit_cast(bf16x8, va), __builtin_bit_cast(bf16x8, pb), o4[mt], 0, 0, 0);
            }
        }
        bf16_t* OL = (bf16_t*)(scr + SCR_GLA_OL) + (size_t)cid * 4096;
#pragma unroll
        for (int mt = 0; mt < 4; ++mt) store4_bf16(OL + (16 * w + fr) * 64 + 16 * mt + 4 * fg, o4[mt][0], o4[mt][1], o4[mt][2], o4[mt][3]);
    }
    {
        f32x4 k4[2] = {(f32x4){0.f, 0.f, 0.f, 0.f}, (f32x4){0.f, 0.f, 0.f, 0.f}};
#pragma unroll
        for (int ks = 0; ks < 2; ++ks) {
            bf16x8 bv = *(const bf16x8*)(Vt + (16 * w + fr) * LROW + ks * 32 + fg * 8);
#pragma unroll
            for (int mt = 0; mt < 2; ++mt) {
                bf16x8 a = *(const bf16x8*)(KLt + (16 * mt + fr) * LROW + ks * 32 + fg * 8);
                k4[mt] = __builtin_amdgcn_mfma_f32_16x16x32_bf16(a, bv, k4[mt], 0, 0, 0);
            }
        }
        float* KV = (float*)(scr + SCR_GLA_KV) + (size_t)cid * 2048;
#pragma unroll
        for (int mt = 0; mt < 2; ++mt) *(f32x4*)(KV + (16 * w + fr) * 32 + 16 * mt + 4 * fg) = k4[mt];
    }
}
__device__ void gla_scan_item(const Params& p, int g) {
    const int tid = ltid();
    const int bh = g >> 3, idx = (g & 7) * 256 + tid, d = idx & 31;
    char* scr = p.ws + WS_SCR;
    const float* __restrict__ KV = (const float*)(scr + SCR_GLA_KV) + (size_t)bh * 64 * 2048 + idx;
    const float* __restrict__ DL = (const float*)(scr + SCR_GLA_DL) + bh * 64 * 32 + d;
    bf16_t* __restrict__ SG = (bf16_t*)(scr + SCR_GLA_SG) + (size_t)bh * 64 * 2048 + idx;
    float S = 0.f;
    for (int n0 = 0; n0 < 64; n0 += 8) {
        float kv[8], dl[8];
#pragma unroll
        for (int u = 0; u < 8; ++u) { kv[u] = KV[(size_t)(n0 + u) * 2048]; dl[u] = DL[(n0 + u) * 32]; }
#pragma unroll
        for (int u = 0; u < 8; ++u) { SG[(size_t)(n0 + u) * 2048] = f2bf(S); S = dl[u] * S + kv[u]; }
    }
}
__device__ void gla_out_item(const Params& p, int l, int cid) {
    const int tid = ltid(), lane = tid & 63, w = tid >> 6, fr = lane & 15, fg = lane >> 4;
    const int bh = cid >> 6, n = cid & 63, b = bh / H_GLA, h = bh % H_GLA;
    char* scr = p.ws + WS_SCR;
    const bf16_t* SG = (const bf16_t*)(scr + SCR_GLA_SG) + (size_t)cid * 2048;
    const bf16_t* QB = (const bf16_t*)(scr + SCR_GLA_QB) + (size_t)cid * 2048;
    const bf16_t* OL = (const bf16_t*)(scr + SCR_GLA_OL) + (size_t)cid * 4096;
    const int i = 16 * w + fr; const int t = b * SEQ + n * 64 + i;
    f32x4 acc[4];
#pragma unroll
    for (int mt = 0; mt < 4; ++mt) { uint2 u = *(const uint2*)(OL + i * 64 + 16 * mt + 4 * fg); acc[mt] = (f32x4){bflo(u.x), bfhi(u.x), bflo(u.y), bfhi(u.y)}; }
    bf16x8 bq = *(const bf16x8*)(QB + i * 32 + fg * 8);
#pragma unroll
    for (int mt = 0; mt < 4; ++mt) {
        bf16x8 a = *(const bf16x8*)(SG + (16 * mt + fr) * 32 + fg * 8);
        acc[mt] = __builtin_amdgcn_mfma_f32_16x16x32_bf16(a, bq, acc[mt], 0, 0, 0);
    }
    float ss = 0.f;
#pragma unroll
    for (int mt = 0; mt < 4; ++mt)
#pragma unroll
        for (int r = 0; r < 4; ++r) ss += acc[mt][r] * acc[mt][r];
    ss += __shfl_xor(ss, 16, 64); ss += __shfl_xor(ss, 32, 64);
    const float rstd = rsqrtf(ss * (1.f / 64.f) + 1e-6f);
    const float* og = p.in[13] + l * 64;
    const bf16_t* rp = (const bf16_t*)(p.ws + WS_PROJ) + (size_t)t * NPROJ + NC_LR + h * 64;
    bf16_t* mp = (bf16_t*)(p.ws + WS_MIX) + (size_t)t * D_MODEL + 768 + h * 64;
#pragma unroll
    for (int mt = 0; mt < 4; ++mt) {
        const int e0 = 16 * mt + 4 * fg;
        uint2 gu = *(const uint2*)(rp + e0); f32x4 g4 = *(const f32x4*)(og + e0);
        store4_bf16(mp + e0, acc[mt][0] * rstd * g4[0] * bflo(gu.x), acc[mt][1] * rstd * g4[1] * bfhi(gu.x), acc[mt][2] * rstd * g4[2] * bflo(gu.y), acc[mt][3] * rstd * g4[3] * bfhi(gu.y));
    }
}
__device__ void phase_mixout(const Params& p, int l) {
    for (int it = blockIdx.x; it < NGDN_CH + NGLA_CH; it += gridDim.x) {
        if (it < NGDN_CH) { if (MIXSEL & 1) gdn_out_item(p, l, it); } else { if (MIXSEL & 2) gla_out_item(p, l, it - NGDN_CH); }
    }
}

__device__ void fox_cumsum_item(const Params& p, int l, int bh, float* ldsf) {
    const int tid = ltid(), lane = tid & 63, w = tid >> 6;
    const int b = bh / H_FOX, h = bh % H_FOX;
    const float* aux = (const float*)(p.ws + WS_AUX);
    float* cum = (float*)(p.ws + WS_CUM) + (size_t)bh * SEQ;
    const float fb = p.in[5][l * H_FOX + h];
    float v[16]; float s = 0.f;
#pragma unroll
    for (int i = 0; i < 16; ++i) { v[i] = logsigmoidf_(aux[(size_t)(b * SEQ + tid * 16 + i) * 64 + AX_FF + h] + fb); s += v[i]; }
    float inc = s;
#pragma unroll
    for (int o = 1; o < 64; o <<= 1) { float t = __shfl_up(inc, o, 64); if (lane >= o) inc += t; }
    __syncthreads();
    if (lane == 63) ldsf[w] = inc;
    __syncthreads();
    float base = inc - s;
    for (int ww = 0; ww < w; ++ww) base += ldsf[ww];
    float c = base;
#pragma unroll
    for (int i = 0; i < 16; ++i) { c += v[i]; cum[tid * 16 + i] = c; }
}
__device__ void phase_prep(const Params& p, int l, unsigned char* lds_raw) {
    const int n0 = BATCH * H_FOX, n1 = n0 + ((MIXSEL & 1) ? NGDN_CH : 0), n2 = n1 + ((MIXSEL & 2) ? NGLA_CH : 0);
    for (int it = blockIdx.x; it < n2; it += gridDim.x) {
        if (it < n0) { __syncthreads(); fox_cumsum_item(p, l, it, (float*)lds_raw); }
        else if (it < n1) gdn_prep_item(p, l, it - n0, lds_raw);
        else gla_prep_item(p, l, it - n1, lds_raw);
    }
}

typedef float f32x16 __attribute__((ext_vector_type(16)));
#define ATT_BUF 18688
__device__ void fox_attn_item(const Params& p, int l, int bh, int qt, unsigned char* lds_raw) {
    const int tid = ltid(), lane = tid & 63, w = tid >> 6, r = lane & 31, h = lane >> 5;
    const int b = bh / H_FOX, hh = bh % H_FOX;
    const bf16_t* proj = (const bf16_t*)(p.ws + WS_PROJ);
    const bf16_t* kbase = proj + (size_t)b * SEQ * NPROJ + NC_FK + hh * 64;
    const bf16_t* vbase = (const bf16_t*)(p.ws + WS_VTF) + (size_t)bh * 64 * SEQ;
    const float* cum = (const float*)(p.ws + WS_CUM) + (size_t)bh * SEQ;
    const int qlo = qt * 128 + w * 32, q = qlo + r;
    bf16x8 qf[4];
    {
        const bf16_t* qrow = proj + (size_t)(b * SEQ + q) * NPROJ + NC_FQ + hh * 64;
#pragma unroll
        for (int kk = 0; kk < 4; ++kk) qf[kk] = *(const bf16x8*)(qrow + kk * 16 + h * 8);
    }
    const float cq = cum[q];
    f32x16 o0, o1;
#pragma unroll
    for (int i = 0; i < 16; ++i) { o0[i] = 0.f; o1[i] = 0.f; }
    float m = -1e30f, lsum = 0.f;
    const int ntiles = 2 * qt + 2;
    const int crow = tid >> 3, ckc = tid & 7;
    u32x4 kr0, kr1, vr0, vr1; float cr = 0.f;
    auto gload = [&](int j) {
        const int s0 = j * 64;
        kr0 = *(const u32x4*)(kbase + (size_t)(s0 + crow) * NPROJ + ckc * 8);
        kr1 = *(const u32x4*)(kbase + (size_t)(s0 + crow + 32) * NPROJ + ckc * 8);
        vr0 = *(const u32x4*)(vbase + (size_t)crow * SEQ + s0 + ckc * 8);
        vr1 = *(const u32x4*)(vbase + (size_t)(crow + 32) * SEQ + s0 + ckc * 8);
        if (tid < 64) cr = cum[s0 + tid];
    };
    auto lstore = [&](int buf) {
        bf16_t* Ks = (bf16_t*)(lds_raw + buf * ATT_BUF); bf16_t* Vs = Ks + 64 * LROW; float* cs = (float*)(Vs + 64 * LROW);
        *(u32x4*)(Ks + crow * LROW + ckc * 8) = kr0; *(u32x4*)(Ks + (crow + 32) * LROW + ckc * 8) = kr1;
        *(u32x4*)(Vs + crow * LROW + ckc * 8) = vr0; *(u32x4*)(Vs + (crow + 32) * LROW + ckc * 8) = vr1;
        if (tid < 64) cs[tid] = cr;
    };
    __syncthreads();
    gload(0); lstore(0);
    __syncthreads();
    for (int j = 0; j < ntiles; ++j) {
        if (j + 1 < ntiles) gload(j + 1);
        const int s0 = j * 64;
        if (s0 <= qlo + 31) {
            const bf16_t* Ks = (const bf16_t*)(lds_raw + (j & 1) * ATT_BUF); const bf16_t* Vs = Ks + 64 * LROW; const float* cs = (const float*)(Vs + 64 * LROW);
            f32x16 st0, st1;
#pragma unroll
            for (int i = 0; i < 16; ++i) { st0[i] = 0.f; st1[i] = 0.f; }
#pragma unroll
            for (int kk = 0; kk < 4; ++kk) {
                bf16x8 a0 = *(const bf16x8*)(Ks + r * LROW + kk * 16 + h * 8);
                bf16x8 a1 = *(const bf16x8*)(Ks + (32 + r) * LROW + kk * 16 + h * 8);
                st0 = __builtin_amdgcn_mfma_f32_32x32x16_bf16(a0, qf[kk], st0, 0, 0, 0);
                st1 = __builtin_amdgcn_mfma_f32_32x32x16_bf16(a1, qf[kk], st1, 0, 0, 0);
            }
            const bool need_mask = (s0 + 63 > qlo);
            float mx = -1e30f;
#pragma unroll
            for (int g = 0; g < 4; ++g) {
                f32x4 c0 = *(const f32x4*)(cs + 8 * g + 4 * h);
                f32x4 c1 = *(const f32x4*)(cs + 32 + 8 * g + 4 * h);
#pragma unroll
                for (int e = 0; e < 4; ++e) {
                    int i = 4 * g + e;
                    float v0 = st0[i] + (cq - c0[e]), v1 = st1[i] + (cq - c1[e]);
                    if (need_mask) {
                        int key = s0 + 8 * g + 4 * h + e;
                        if (key > q) v0 = -1e30f;
                        if (key + 32 > q) v1 = -1e30f;
                    }
                    st0[i] = v0; st1[i] = v1;
                    mx = fmaxf(mx, fmaxf(v0, v1));
                }
            }
            mx = fmaxf(mx, __shfl_xor(mx, 32, 64));
            const float mnew = fmaxf(m, mx);
            const float alpha = __expf(m - mnew);
            float rs = 0.f;
#pragma unroll
            for (int i = 0; i < 16; ++i) { st0[i] = __expf(st0[i] - mnew); st1[i] = __expf(st1[i] - mnew); rs += st0[i] + st1[i]; }
            lsum = lsum * alpha + rs; m = mnew;
#pragma unroll
            for (int i = 0; i < 16; ++i) { o0[i] *= alpha; o1[i] *= alpha; }
            bf16x8 pf[2][2];
#pragma unroll
            for (int s = 0; s < 2; ++s) {
                u32x4 t0 = {pk_bf16(st0[8 * s], st0[8 * s + 1]), pk_bf16(st0[8 * s + 2], st0[8 * s + 3]), pk_bf16(st0[8 * s + 4], st0[8 * s + 5]), pk_bf16(st0[8 * s + 6], st0[8 * s + 7])};
                u32x4 t1 = {pk_bf16(st1[8 * s], st1[8 * s + 1]), pk_bf16(st1[8 * s + 2], st1[8 * s + 3]), pk_bf16(st1[8 * s + 4], st1[8 * s + 5]), pk_bf16(st1[8 * s + 6], st1[8 * s + 7])};
                pf[0][s] = __builtin_bit_cast(bf16x8, t0); pf[1][s] = __builtin_bit_cast(bf16x8, t1);
            }
#pragma unroll
            for (int mt = 0; mt < 2; ++mt)
#pragma unroll
                for (int s = 0; s < 2; ++s) {
                    const int ko = 32 * mt + 16 * s + 4 * h;
                    uint2 a00 = *(const uint2*)(Vs + r * LROW + ko), a01 = *(const uint2*)(Vs + r * LROW + ko + 8);
                    uint2 a10 = *(const uint2*)(Vs + (32 + r) * LROW + ko), a11 = *(const uint2*)(Vs + (32 + r) * LROW + ko + 8);
                    u32x4 u0 = {a00.x, a00.y, a01.x, a01.y}; u32x4 u1 = {a10.x, a10.y, a11.x, a11.y};
                    o0 = __builtin_amdgcn_mfma_f32_32x32x16_bf16(__builtin_bit_cast(bf16x8, u0), pf[mt][s], o0, 0, 0, 0);
                    o1 = __builtin_amdgcn_mfma_f32_32x32x16_bf16(__builtin_bit_cast(bf16x8, u1), pf[mt][s], o1, 0, 0, 0);
                }
        }
        if (j + 1 < ntiles) lstore((j + 1) & 1);
        __syncthreads();
    }
    lsum += __shfl_xor(lsum, 32, 64);
    const float inv = 1.f / lsum;
    float ss = 0.f;
#pragma unroll
    for (int i = 0; i < 16; ++i) { o0[i] *= inv; o1[i] *= inv; ss += o0[i] * o0[i] + o1[i] * o1[i]; }
    ss += __shfl_xor(ss, 32, 64);
    const float rstd = rsqrtf(ss * (1.f / 64.f) + 1e-6f);
    const float* og = p.in[6] + l * 64;
    bf16_t* mrow = (bf16_t*)(p.ws + WS_MIX) + (size_t)(b * SEQ + q) * D_MODEL + hh * 64;
#pragma unroll
    for (int g = 0; g < 4; ++g) {
        const int e0 = 8 * g + 4 * h;
        f32x4 g0 = *(const f32x4*)(og + e0), g1 = *(const f32x4*)(og + 32 + e0);
        store4_bf16(mrow + e0, o0[4 * g] * rstd * g0[0], o0[4 * g + 1] * rstd * g0[1], o0[4 * g + 2] * rstd * g0[2], o0[4 * g + 3] * rstd * g0[3]);
        store4_bf16(mrow + 32 + e0, o1[4 * g] * rstd * g1[0], o1[4 * g + 1] * rstd * g1[1], o1[4 * g + 2] * rstd * g1[2], o1[4 * g + 3] * rstd * g1[3]);
    }
}
#define ATT_ITEMS (BATCH * H_FOX * (SEQ / 128))
__device__ void phase_scan_attn(const Params& p, int l, unsigned char* lds_raw, int rep = 0) {
    unsigned* qctr = (unsigned*)(p.ws + WS_CTL) + CW_Q + l + 2 * rep;
    volatile int* slot = (volatile int*)(lds_raw + 2 * ATT_BUF);
    for (;;) {
        __syncthreads();
        if (threadIdx.x == 0) *slot = (int)atomicAdd(qctr, 1u);
        __syncthreads();
        int it = *slot;
        const int ns0 = (MIXSEL & 1) ? BATCH * H_GDN : 0, ns1 = ns0 + ((MIXSEL & 2) ? 128 : 0);
        if (it >= ns1 + ATT_ITEMS) break;
        if (it < ns0) { gdn_scan_item(p, it, lds_raw); continue; }
        if (it < ns1) { gla_scan_item(p, it - ns0); continue; }
        it -= ns1;
        const int qt = (SEQ / 128 - 1) - it / (BATCH * H_FOX), bh = it % (BATCH * H_FOX);
        fox_attn_item(p, l, bh, qt, lds_raw);
    }
}

#define NPHASE 19
__global__ void __launch_bounds__(256, 2) mk(Params p, int lo, int hi, int use_bar) {
    __shared__ __attribute__((aligned(16))) unsigned char lds_raw[LDS_BYTES];
    bf16_t* lds = (bf16_t*)lds_raw;
    volatile LAS unsigned* st = (volatile LAS unsigned*)(lds_raw + LDS_BYTES - 16);
    XcdBarrier bar; bar.bar = (unsigned*)(p.ws + WS_CTL) + CW_BAR; bar.x = 0; bar.st = st;
    if (use_bar) {
        if (threadIdx.x == 0) { st[0] = 0u; st[1] = 0u; }
        __syncthreads();
        bar = xcd_barrier_post((unsigned*)(p.ws + WS_CTL) + CW_BAR, st);
    }
    for (int ph = lo; ph < hi; ++ph) {
#ifndef PSEL
#define PSEL 0xffff
#endif
        int phv = ph; asm volatile("" : "+s"(phv));
        Params q = p; asm volatile("" : "+s"(q.ws)); asm volatile("" : "+s"(q.out));
        if (phv == 0) { if (PSEL & 1) phase0(q); }
        else {
            int l = (phv - 1) / 9, s = (phv - 1) % 9;
            if (s == 0) { if (PSEL & 2) phase_inproj(q, l, lds); }
            else if (s == 1) { if (PSEL & 128) phase_prep(q, l, lds_raw); }
            else if (s == 2) { if (PSEL & 256) phase_scan_attn(q, l, lds_raw); }
            else if (s == 3) { if (PSEL & 512) phase_mixout(q, l); }
            else if (s == 4) { if (PSEL & 4) phase_outproj(q, l, lds); }
            else if (s == 5) { if (PSEL & 8) phase_route(q, l, lds); }
            else if (s == 6) { if (PSEL & 16) phase_expert<0>(q, l, lds); }
            else if (s == 7) { if (PSEL & 32) phase_expert<1>(q, l, lds); }
            else if (s == 8) { if (PSEL & 64) phase_combine(q, l); }
        }
#ifdef REPEAT_MASK
        {
            const int ty = (phv == 0) ? 9 : (phv - 1) % 9, l = (phv == 0) ? 0 : (phv - 1) / 9;
            const bool idem = !(ty == 5 || ty == 8 || (ty == 4 && l == 1));
            if (((REPEAT_MASK >> ty) & 1) && idem && use_bar) {
                xcd_barrier(bar);
                if (ty == 9) phase0(q);
                else if (ty == 0) phase_inproj(q, l, lds, GVAR);
                else if (ty == 1) phase_prep(q, l, lds_raw);
                else if (ty == 2) phase_scan_attn(q, l, lds_raw, 1);
                else if (ty == 3) phase_mixout(q, l);
                else if (ty == 4) phase_outproj(q, l, lds);
                else if (ty == 6) phase_expert<0>(q, l, lds);
                else if (ty == 7) phase_expert<1>(q, l, lds);
            }
        }
#endif
        if (ph + 1 < hi) {
            if (hi > 1000) cg::this_grid().sync();
            xcd_barrier(bar);
        }
    }
}

extern "C" void kernel_launch(void* const* d_in, const int* in_sizes, int n_in,
                              void* d_out, int out_size, void* d_ws, size_t ws_size,
                              hipStream_t stream) {
    static int grid = 0;
    if (grid == 0) {
        if (ws_size < WS_END) { fprintf(stderr, "ws too small: need %zu have %zu\n", (size_t)WS_END, ws_size); grid = -1; return; }
        int dev = 0, cus = 0, per_cu = 0;
        hipGetDevice(&dev);
        hipDeviceGetAttribute(&cus, hipDeviceAttributeMultiprocessorCount, dev);
        hipOccupancyMaxActiveBlocksPerMultiprocessor(&per_cu, mk, 256, 0);
        if (per_cu > 2) per_cu = 2;
        if (per_cu < 1) { fprintf(stderr, "occupancy query failed\n"); grid = -1; return; }
        grid = cus * per_cu;
        grid -= grid % 8;
    }
    if (grid < 0) return;
    Params p{};
    for (int i = 0; i < 23; ++i) p.in[i] = (const float*)d_in[i];
    p.out = (float*)d_out; p.ws = (char*)d_ws;
    hipMemsetAsync((char*)d_ws + WS_CTL, 0, CTL_BYTES, stream);
#ifdef POISON_GLA
    hipMemsetAsync((char*)d_ws + WS_SCR + SCR_GLA_OL, 0xFF, SCR_LVT - SCR_GLA_OL, stream);
#endif

#ifdef MULTI_LAUNCH
    for (int ph = 0; ph < NPHASE; ++ph) mk<<<grid, 256, 0, stream>>>(p, ph, ph + 1, 0);
#else
    int lo = 0, hi = NPHASE, ub = 2;
    void* args[] = {&p, &lo, &hi, &ub};
    hipError_t e = hipLaunchCooperativeKernel((void*)mk, dim3(grid), dim3(256), args, 0, stream);
    if (e != hipSuccess) fprintf(stderr, "cooperative launch failed: %s (grid %d)\n", hipGetErrorString(e), grid);
#endif
}
```

```cpp
#include <hip/hip_runtime.h>
#include <hip/hip_cooperative_groups.h>
#include <cstdint>
#include <cstdio>
namespace cg = cooperative_groups;

#define D_MODEL 1024
#define BATCH 4
#define SEQ 4096
#define NTOK (BATCH * SEQ)
#define H_FOX 6
#define H_GDN 6
#define H_GLA 4
#define N_IN 3490
#define N_EXP 32
#define D_EXP 512
#define NPROJ 3456
#define NINP 3584

#define C_FF 1152
#define C_GQ 1158
#define C_GG 2310
#define C_GA 2694
#define C_GB 2700
#define C_LQ 2706
#define C_LA 3474
#define NC_FQ 0
#define NC_FK 384
#define NC_FV 768
#define NC_GQ 1152
#define NC_GK 1536
#define NC_GV 1920
#define NC_GG 2304
#define NC_LQ 2688
#define NC_LK 2816
#define NC_LV 2944
#define NC_LR 3200
#define AX_FF 0
#define AX_GA 6
#define AX_GB 12
#define AX_LA 18

#ifndef P3SEL
#define P3SEL 7
#endif
#ifndef GVAR
#define GVAR 0
#endif
#ifndef MIXSEL
#define MIXSEL 3
#endif
typedef unsigned short bf16_t;
typedef short bf16x8 __attribute__((ext_vector_type(8)));
typedef float f32x4 __attribute__((ext_vector_type(4)));
typedef unsigned u32x4 __attribute__((ext_vector_type(4)));

#define WS_CTL      0
#define CTL_BYTES   65536
#define WS_WIN      (WS_CTL + CTL_BYTES)
#define WS_WOUT     (WS_WIN + (size_t)2 * NINP * 1024 * 2)
#define WS_WGU      (WS_WOUT + (size_t)2 * 1024 * 1024 * 2)
#define WS_WD       (WS_WGU + (size_t)2 * 32 * 1024 * 1024 * 2)
#define WS_WR       (WS_WD + (size_t)2 * 32 * 1024 * 512 * 2)
#define WS_HN       (WS_WR + (size_t)2 * 64 * 1024 * 2)
#define WS_PROJ     (WS_HN + (size_t)NTOK * 1024 * 2)
#define WS_VTF      (WS_PROJ + (size_t)NTOK * NPROJ * 2)
#define WS_AUX      (WS_VTF + (size_t)BATCH * H_FOX * 64 * SEQ * 2)
#define WS_CUM      (WS_AUX + (size_t)NTOK * 64 * 4)
#define WS_MIX      (WS_CUM + (size_t)BATCH * H_FOX * SEQ * 4)
#define WS_ROWTOK   (WS_MIX + (size_t)NTOK * 1024 * 2)
#define WS_TSLOT    (WS_ROWTOK + (size_t)32 * NTOK * 4)
#define WS_TGATE    (WS_TSLOT + (size_t)NTOK * 2 * 4)
#define WS_SCR      (WS_TGATE + (size_t)NTOK * 2 * 4)
#define SCR_BYTES   ((size_t)100 * 1024 * 1024)
#define WS_END      (WS_SCR + SCR_BYTES)
#define HROWS       (2 * NTOK + 32 * 128)
#define WS_H        WS_PROJ
#define WS_Y        (WS_PROJ + (size_t)HROWS * 512 * 2)

#define NGDN_CH 1536
#define NGLA_CH 1024
#define SCR_GDN_MP   ((size_t)0)
#define SCR_GDN_NN   (SCR_GDN_MP + (size_t)NGDN_CH * 8192)
#define SCR_GDN_P    (SCR_GDN_NN + (size_t)NGDN_CH * 8192)
#define SCR_GDN_OL   (SCR_GDN_P  + (size_t)NGDN_CH * 8192)
#define SCR_GDN_SG   (SCR_GDN_OL + (size_t)NGDN_CH * 8192)
#define SCR_GDN_LAST (SCR_GDN_SG + (size_t)NGDN_CH * 8192)
#define SCR_GLA_OL   (SCR_GDN_LAST + (size_t)NGDN_CH * 4)
#define SCR_GLA_KV   (SCR_GLA_OL + (size_t)NGLA_CH * 8192)
#define SCR_GLA_QB   (SCR_GLA_KV + (size_t)NGLA_CH * 8192)
#define SCR_GLA_SG   (SCR_GLA_QB + (size_t)NGLA_CH * 4096)
#define SCR_GLA_DL   (SCR_GLA_SG + (size_t)NGLA_CH * 4096)
#define SCR_LVT      (SCR_GLA_DL + (size_t)NGLA_CH * 128)
#define SCR_USED     (SCR_LVT + (size_t)BATCH * H_GLA * 64 * SEQ * 2)
#define SCR_CSX      SCR_USED
static_assert(SCR_CSX + (size_t)BATCH * H_FOX * SEQ * 16 <= SCR_BYTES, "scratch overflow");
#define CW_BAR      0
#define CW_CNT      4096
#define CW_Q        4224

struct Params {
    const float* in[23];
    float* out;
    char* ws;
};

__device__ __forceinline__ float sigmoidf_(float x) { return 1.f / (1.f + __expf(-x)); }
__device__ __forceinline__ float siluf_(float x) { return x / (1.f + __expf(-x)); }
__device__ __forceinline__ float softplusf_(float x) { return x > 20.f ? x : log1pf(__expf(x)); }
__device__ __forceinline__ float logsigmoidf_(float x) { return -softplusf_(-x); }
__device__ __forceinline__ float wave_sum(float v) {
#pragma unroll
    for (int o = 32; o > 0; o >>= 1) v += __shfl_xor(v, o, 64);
    return v;
}
__device__ __forceinline__ int ltid() { int t = threadIdx.x; asm volatile("" : "+v"(t)); return t; }
typedef __bf16 bf16x2_t __attribute__((ext_vector_type(2)));
typedef float f32x2_t __attribute__((ext_vector_type(2)));
__device__ __forceinline__ unsigned pk_bf16(float lo, float hi) { f32x2_t v = {lo, hi}; bf16x2_t r = __builtin_convertvector(v, bf16x2_t); return __builtin_bit_cast(unsigned, r); }
__device__ __forceinline__ unsigned ld_u32_agent(const unsigned* p) { return __hip_atomic_load(p, __ATOMIC_RELAXED, __HIP_MEMORY_SCOPE_AGENT); }
__device__ __forceinline__ float ld_f32_agent(const float* p) { return __uint_as_float(__hip_atomic_load((const unsigned*)p, __ATOMIC_RELAXED, __HIP_MEMORY_SCOPE_AGENT)); }
__device__ __forceinline__ float bf2f(bf16_t v) { return __uint_as_float((unsigned)v << 16); }
__device__ __forceinline__ float bflo(unsigned v) { return __uint_as_float(v << 16); }
__device__ __forceinline__ float bfhi(unsigned v) { return __uint_as_float(v & 0xffff0000u); }

#define XB_TMO      128
#define XB_XCNT(j)  (256  + 64 * (j))
#define XB_XSUB(j)  (1280 + 64 * (j))
#define XB_XGEN(j)  (2304 + 64 * (j))
#define XB_TOP      3328
#define XB_TOPGEN   3392
#define XCD_BAR_WORDS 3456
#define XB_SPIN_CAP (1u << 22)
#define LAS __attribute__((address_space(3)))
__device__ __forceinline__ unsigned xb_ld(unsigned* p)              { return __hip_atomic_load(p, __ATOMIC_RELAXED, __HIP_MEMORY_SCOPE_AGENT); }
__device__ __forceinline__ unsigned xb_add(unsigned* p, unsigned v) { return __hip_atomic_fetch_add(p, v, __ATOMIC_RELAXED, __HIP_MEMORY_SCOPE_AGENT); }
__device__ __forceinline__ unsigned xb_xcc_id() { return (unsigned)__builtin_amdgcn_s_getreg((3 << 11) | 20) & 0xFu; }
#define XB_SPIN(cond, bar) do { unsigned _sp = 0; while (cond) { __builtin_amdgcn_s_sleep(1); \
    if ((++_sp & 255u) == 0u) { if (xb_ld(&(bar)[XB_TMO])) break; if (_sp > XB_SPIN_CAP) { atomicAdd(&(bar)[XB_TMO], 1u); break; } } } } while (0)
struct XcdBarrier { unsigned* bar; unsigned x; volatile LAS unsigned* st; };
__device__ __forceinline__ XcdBarrier xcd_barrier_post(unsigned* bar, volatile LAS unsigned* st) {
    XcdBarrier b; b.bar = bar; b.x = xb_xcc_id(); b.st = st;
    if (threadIdx.x == 0) (void)xb_add(&bar[XB_XCNT(b.x)], 1u);
    return b;
}
__device__ __forceinline__ void xcd_barrier_complete(unsigned* bar, unsigned x, unsigned& nloc, unsigned& nx) {
    const unsigned G = gridDim.x * gridDim.y * gridDim.z;
    unsigned sum, cnt, mine, sp = 0u;
    for (;;) {
        sum = 0u; cnt = 0u; mine = 0u;
#pragma unroll
        for (unsigned j = 0; j < 16; ++j) { const unsigned c = xb_ld(&bar[XB_XCNT(j)]); sum += c; cnt += (c > 0u) ? 1u : 0u; mine = (j == x) ? c : mine; }
        if (sum == G) break;
        __builtin_amdgcn_s_sleep(1);
        if ((++sp & 255u) == 0u) { if (xb_ld(&bar[XB_TMO])) break; if (sp > XB_SPIN_CAP) { atomicAdd(&bar[XB_TMO], 1u); break; } }
    }
    nloc = mine > 0u ? mine : 1u; nx = cnt > 0u ? cnt : 1u;
}
__device__ __forceinline__ void xcd_barrier(const XcdBarrier& b) {
    asm volatile("s_waitcnt vmcnt(0)" ::: "memory");
    __syncthreads();
    if (threadIdx.x == 0) {
        unsigned* bar = b.bar;
        __builtin_amdgcn_s_waitcnt(0);
        unsigned nloc = b.st[0], nx = b.st[1];
        if (nloc == 0u) { xcd_barrier_complete(bar, b.x, nloc, nx); b.st[0] = nloc; b.st[1] = nx; }
        const unsigned old = xb_add(&bar[XB_XSUB(b.x)], 1u);
        const unsigned gen = old / nloc;
        if (old + 1u == (gen + 1u) * nloc) {
            __builtin_amdgcn_fence(__ATOMIC_RELEASE, "agent");
            asm volatile("s_waitcnt vmcnt(0)" ::: "memory");
            const unsigned og = xb_add(&bar[XB_TOP], 1u);
            const unsigned tg = og / nx;
            if (og + 1u == (tg + 1u) * nx) xb_add(&bar[XB_TOPGEN], 1u);
            else XB_SPIN(xb_ld(&bar[XB_TOPGEN]) == tg, bar);
            __builtin_amdgcn_fence(__ATOMIC_ACQUIRE, "agent");
            xb_add(&bar[XB_XGEN(b.x)], 1u);
            asm volatile("s_waitcnt vmcnt(0)" ::: "memory");
        } else {
            XB_SPIN(xb_ld(&bar[XB_XGEN(b.x)]) == gen, bar);
            __builtin_amdgcn_fence(__ATOMIC_ACQUIRE, "agent");
            asm volatile("s_waitcnt vmcnt(0)" ::: "memory");
        }
    }
    __syncthreads();
}

#define LDS_BYTES 66560
#define LROW 72

__device__ __forceinline__ int inproj_map(int n) {
    if (n < 1152) return n;
    if (n < 2304) return C_GQ + (n - 1152);
    if (n < 2688) return C_GG + (n - 2304);
    if (n < 3456) return C_LQ + (n - 2688);
    if (n < 3462) return C_FF + (n - 3456);
    if (n < 3468) return C_GA + (n - 3462);
    if (n < 3474) return C_GB + (n - 3468);
    if (n < 3490) return n;
    return -1;
}
__device__ __forceinline__ void conv_tile(const float* __restrict__ src, int ld, int col, bf16_t* __restrict__ dst_row, int k0) {
    float v[16];
    if (col >= 0) {
#pragma unroll
        for (int i = 0; i < 16; ++i) v[i] = src[(size_t)(k0 + i) * ld + col];
    } else {
#pragma unroll
        for (int i = 0; i < 16; ++i) v[i] = 0.f;
    }
    uint4 o0, o1;
    o0.x = pk_bf16(v[0], v[1]); o0.y = pk_bf16(v[2], v[3]); o0.z = pk_bf16(v[4], v[5]); o0.w = pk_bf16(v[6], v[7]);
    o1.x = pk_bf16(v[8], v[9]); o1.y = pk_bf16(v[10], v[11]); o1.z = pk_bf16(v[12], v[13]); o1.w = pk_bf16(v[14], v[15]);
    *(uint4*)(dst_row + k0) = o0;
    *(uint4*)(dst_row + k0 + 8) = o1;
}
#define P0_T_IN   (56 * 16)
#define P0_T_OUT  (16 * 16)
#define P0_T_GU   (32 * 16 * 16)
#define P0_T_D    (32 * 16 * 8)
#define P0_T_R    (16)
#define P0_T_LAYER (P0_T_IN + P0_T_OUT + P0_T_GU + P0_T_D + P0_T_R)
#define P0_T_NORM (NTOK / 4)
__device__ __forceinline__ void conv_job(const Params& p, int l, int j, int tid) {
    const int nl = tid & 63, kg = tid >> 6;
    if (j < P0_T_IN) {
        int tn = j / 16, tk = j % 16; int n = tn * 64 + nl;
        conv_tile(p.in[2] + (size_t)l * 1024 * N_IN, N_IN, inproj_map(n), (bf16_t*)(p.ws + WS_WIN) + ((size_t)l * NINP + n) * 1024, tk * 64 + kg * 16);
        return;
    }
    j -= P0_T_IN;
    if (j < P0_T_OUT) {
        int tn = j / 16, tk = j % 16; int n = tn * 64 + nl;
        conv_tile(p.in[14] + (size_t)l * 1024 * 1024, 1024, n, (bf16_t*)(p.ws + WS_WOUT) + ((size_t)l * 1024 + n) * 1024, tk * 64 + kg * 16);
        return;
    }
    j -= P0_T_OUT;
    if (j < P0_T_GU) {
        int e = j / 256, r = j % 256; int tn = r / 16, tk = r % 16; int n = tn * 64 + nl;
        int t128 = n >> 7, wx = (n >> 6) & 1, half = (n >> 5) & 1, jj = n & 31;
        int hid = t128 * 64 + wx * 32 + jj;
        const float* src = (half ? p.in[21] : p.in[20]) + ((size_t)l * 32 + e) * 1024 * 512;
        conv_tile(src, 512, hid, (bf16_t*)(p.ws + WS_WGU) + (((size_t)l * 32 + e) * 1024 + n) * 1024, tk * 64 + kg * 16);
        return;
    }
    j -= P0_T_GU;
    if (j < P0_T_D) {
        int e = j / 128, r = j % 128; int tn = r / 8, tk = r % 8; int n = tn * 64 + nl;
        const float* src = p.in[22] + ((size_t)l * 32 + e) * 512 * 1024;
        conv_tile(src, 1024, n, (bf16_t*)(p.ws + WS_WD) + (((size_t)l * 32 + e) * 1024 + n) * 512, tk * 64 + kg * 16);
        return;
    }
    j -= P0_T_D;
    {
        int tk = j; int n = nl;
        const float* src; int ld, col;
        if (n < 4) { src = p.in[16] + (size_t)l * 1024 * 4; ld = 4; col = n; }
        else if (n < 36) { src = p.in[18] + (size_t)l * 1024 * 32; ld = 32; col = n - 4; }
        else { src = p.in[16]; ld = 4; col = -1; }
        conv_tile(src, ld, col, (bf16_t*)(p.ws + WS_WR) + ((size_t)l * 64 + n) * 1024, tk * 64 + kg * 16);
    }
}
#define CONV_REST (P0_T_LAYER - P0_T_IN)
__device__ __forceinline__ void conv_fold(const Params& p, int l, int idx, int tid) {
    if (idx < CONV_REST) conv_job(p, l, P0_T_IN + idx, tid);
    else if (l == 0 && idx < CONV_REST + P0_T_IN) conv_job(p, 1, idx - CONV_REST, tid);
}
__device__ void phase0(const Params& p) {
    const int tid = ltid(), nl = tid & 63, kg = tid >> 6;
    const int total = P0_T_IN + P0_T_NORM;
    for (int it = blockIdx.x; it < total; it += gridDim.x) {
        if (it >= P0_T_IN) {
            int row = (it - P0_T_IN) * 4 + kg;
            const float* xr = p.in[0] + (size_t)row * D_MODEL + nl * 16;
            const float* gr = p.in[1] + nl * 16;
            float v[16]; float ss = 0.f;
#pragma unroll
            for (int i = 0; i < 4; ++i) { float4 t = *(const float4*)(xr + 4 * i); v[4 * i] = t.x; v[4 * i + 1] = t.y; v[4 * i + 2] = t.z; v[4 * i + 3] = t.w; }
#pragma unroll
            for (int i = 0; i < 16; ++i) ss += v[i] * v[i];
            ss = wave_sum(ss);
            float r = rsqrtf(ss / D_MODEL + 1e-6f);
#pragma unroll
            for (int i = 0; i < 16; ++i) v[i] = v[i] * r * gr[i];
            uint4 o0, o1;
            o0.x = pk_bf16(v[0], v[1]); o0.y = pk_bf16(v[2], v[3]); o0.z = pk_bf16(v[4], v[5]); o0.w = pk_bf16(v[6], v[7]);
            o1.x = pk_bf16(v[8], v[9]); o1.y = pk_bf16(v[10], v[11]); o1.z = pk_bf16(v[12], v[13]); o1.w = pk_bf16(v[14], v[15]);
            bf16_t* hr = (bf16_t*)(p.ws + WS_HN) + (size_t)row * D_MODEL + nl * 16;
            *(uint4*)hr = o0; *(uint4*)(hr + 8) = o1;
            continue;
        }
        conv_job(p, 0, it, tid);
    }
}

#define GSTAGE 8192
#define RAW_BARRIER() do { asm volatile("s_waitcnt lgkmcnt(0)" ::: "memory"); __builtin_amdgcn_s_barrier(); } while (0)
__device__ __forceinline__ int gswz(int row) { return (0x1320 >> (((row >> 2) & 3) * 4)) & 3; }
__device__ __forceinline__ void gemm_issue(const bf16_t* const (&px)[2], const bf16_t* const (&py)[2], int k0, bf16_t* stage, int w) {
    __builtin_amdgcn_global_load_lds((const unsigned*)(px[0] + k0), (unsigned*)(stage + (w * 16) * 32), 16, 0, 0);
    __builtin_amdgcn_global_load_lds((const unsigned*)(px[1] + k0), (unsigned*)(stage + (64 + w * 16) * 32), 16, 0, 0);
    __builtin_amdgcn_global_load_lds((const unsigned*)(py[0] + k0), (unsigned*)(stage + 4096 + (w * 16) * 32), 16, 0, 0);
    __builtin_amdgcn_global_load_lds((const unsigned*)(py[1] + k0), (unsigned*)(stage + 4096 + (64 + w * 16) * 32), 16, 0, 0);
}
__device__ __forceinline__ void gemm_compute(const bf16_t* stage, int wx, int wy, int fr, int fg, f32x4 (&acc)[4][4]) {
    const int co = (fg ^ gswz(fr)) * 8;
    bf16x8 xa[4], yb[4];
#pragma unroll
    for (int m = 0; m < 4; ++m) xa[m] = *(const bf16x8*)(stage + (wx * 64 + m * 16 + fr) * 32 + co);
#pragma unroll
    for (int n = 0; n < 4; ++n) yb[n] = *(const bf16x8*)(stage + 4096 + (wy * 64 + n * 16 + fr) * 32 + co);
#pragma unroll
    for (int m = 0; m < 4; ++m)
#pragma unroll
        for (int n = 0; n < 4; ++n) acc[m][n] = __builtin_amdgcn_mfma_f32_16x16x32_bf16(xa[m], yb[n], acc[m][n], 0, 0, 0);
}
template <class FX, class FY>
__device__ __forceinline__ void gemm_core(FX rowx, FY rowy, int K, bf16_t* lds, f32x4 (&acc)[4][4], int gvar = 0) {
    const int tid = ltid(), lane = tid & 63, w = __builtin_amdgcn_readfirstlane(tid >> 6), wx = w >> 1, wy = w & 1, fr = lane & 15, fg = lane >> 4;
#pragma unroll
    for (int a = 0; a < 4; ++a)
#pragma unroll
        for (int b = 0; b < 4; ++b) acc[a][b] = (f32x4){0.f, 0.f, 0.f, 0.f};
    const bf16_t* px[2]; const bf16_t* py[2];
    {
        const int r0 = w * 16 + (lane >> 2), pc = lane & 3;
        const int lc0 = (pc ^ gswz(r0)) * 8;
        px[0] = rowx(r0) + lc0; px[1] = rowx(r0 + 64) + lc0;
        py[0] = rowy(r0) + lc0; py[1] = rowy(r0 + 64) + lc0;
    }
    const int nt = K >> 5;
    RAW_BARRIER();
    if (gvar != 3) {
    gemm_issue(px, py, 0, lds, w);
    gemm_issue(px, py, 32, lds + GSTAGE, w);
    gemm_issue(px, py, 64, lds + 2 * GSTAGE, w);
    }
    for (int j = 0; j < nt; ++j) {
        if (j + 2 < nt) asm volatile("s_waitcnt vmcnt(8)" ::: "memory");
        else if (j + 1 < nt) asm volatile("s_waitcnt vmcnt(4)" ::: "memory");
        else asm volatile("s_waitcnt vmcnt(0)" ::: "memory");
        RAW_BARRIER();
        if (j + 3 < nt && gvar != 3) gemm_issue(px, py, (j + 3) * 32, lds + ((j + 3) & 3) * GSTAGE, w);
        if (gvar != 2) gemm_compute(lds + (j & 3) * GSTAGE, wx, wy, fr, fg, acc);
    }
}
__device__ __forceinline__ void store4_bf16(bf16_t* p, float a, float b, float c, float d) {
    uint2 o; o.x = pk_bf16(a, b); o.y = pk_bf16(c, d); *(uint2*)p = o;
}

__device__ __forceinline__ bool xcd_item(int round, int ntm, int ntn, int& tm, int& tn) {
    const int x = blockIdx.x & 7, loc = blockIdx.x >> 3, nloc = gridDim.x >> 3;
    const int tmx = ntm >> 3;
    const int j = round * nloc + loc;
    if (j >= tmx * ntn) return false;
    tn = j / tmx; tm = (j % tmx) * 8 + x;
    return true;
}

__device__ void phase_inproj(const Params& p, int l, bf16_t* lds, int gvar = 0) {
    const int tid = ltid(), lane = tid & 63, w = tid >> 6, wx = w >> 1, wy = w & 1, fr = lane & 15, fg = lane >> 4;
    const bf16_t* hn = (const bf16_t*)(p.ws + WS_HN);
    const bf16_t* wt = (const bf16_t*)(p.ws + WS_WIN) + (size_t)l * NINP * 1024;
    bf16_t* proj = (bf16_t*)(p.ws + WS_PROJ);
    bf16_t* vtf = (bf16_t*)(p.ws + WS_VTF);
    float* aux = (float*)(p.ws + WS_AUX);
    const float* qg = p.in[3] + l * 64; const float* kg = p.in[4] + l * 64;
    for (int round = 0;; ++round) {
        int tm, tn;
        if (!xcd_item(round, NTOK / 128, NINP / 128, tm, tn)) break;
        const bool vt = (tn >= 6 && tn < 9) || tn == 23 || tn == 24;
        f32x4 acc[4][4];
        {
            const bf16_t* wbase = wt + (size_t)(tn * 128) * 1024; const bf16_t* tbase = hn + (size_t)(tm * 128) * 1024;
            auto rw = [&](int r) { return wbase + (size_t)r * 1024; };
            auto rt_ = [&](int r) { return tbase + (size_t)r * 1024; };
            if (vt) gemm_core(rt_, rw, 1024, lds, acc, gvar); else gemm_core(rw, rt_, 1024, lds, acc, gvar);
        }
        if (gvar == 0) {
#pragma unroll 1
            for (int c = 0; c < 4; ++c) conv_fold(p, l, (round * 4 + c) * (int)gridDim.x + (int)blockIdx.x, tid);
        }
        if (gvar != 0 && acc[0][0][0] != 123456.789f) continue;
        if (vt) {
#pragma unroll
            for (int n = 0; n < 4; ++n) {
                const bool fox = tn < 9;
                int ch = tn * 128 + wy * 64 + n * 16 + fr - (fox ? NC_FV : NC_LV); int h = ch >> 6, e = ch & 63;
                bf16_t* dst = fox ? vtf : (bf16_t*)(p.ws + WS_SCR + SCR_LVT); const int nh = fox ? H_FOX : H_GLA;
#pragma unroll
                for (int m = 0; m < 4; ++m) {
                    int t = tm * 128 + wx * 64 + m * 16 + 4 * fg; int b = t / SEQ, s = t % SEQ;
                    store4_bf16(dst + ((size_t)(b * nh + h) * 64 + e) * SEQ + s, acc[m][n][0], acc[m][n][1], acc[m][n][2], acc[m][n][3]);
                }
            }
        } else {
            const int c0 = tn * 128 + wx * 64;
            if (tn < 6) {
                const float* gn = (tn < 3) ? qg : kg; const float sc = (tn < 3) ? 0.125f * 1.4426950408889634f : 1.f;
                float g[4][4];
#pragma unroll
                for (int m = 0; m < 4; ++m)
#pragma unroll
                    for (int r = 0; r < 4; ++r) g[m][r] = gn[m * 16 + 4 * fg + r] * sc;
#pragma unroll
                for (int n = 0; n < 4; ++n) {
                    float ss = 0.f;
#pragma unroll
                    for (int m = 0; m < 4; ++m)
#pragma unroll
                        for (int r = 0; r < 4; ++r) ss += acc[m][n][r] * acc[m][n][r];
                    ss += __shfl_xor(ss, 16, 64); ss += __shfl_xor(ss, 32, 64);
                    float rs = rsqrtf(ss * (1.f / 64.f) + 1e-6f);
                    int t = tm * 128 + wy * 64 + n * 16 + fr;
#pragma unroll
                    for (int m = 0; m < 4; ++m)
                        store4_bf16(proj + (size_t)t * NPROJ + c0 + m * 16 + 4 * fg, acc[m][n][0] * rs * g[m][0], acc[m][n][1] * rs * g[m][1], acc[m][n][2] * rs * g[m][2], acc[m][n][3] * rs * g[m][3]);
                }
            } else if (tn == 27) {
#pragma unroll
                for (int n = 0; n < 4; ++n) {
                    int t = tm * 128 + wy * 64 + n * 16 + fr;
#pragma unroll
                    for (int m = 0; m < 4; ++m) {
                        int c = wx * 64 + m * 16 + 4 * fg;
                        if (c < 64) *(float4*)(aux + (size_t)t * 64 + c) = make_float4(acc[m][n][0], acc[m][n][1], acc[m][n][2], acc[m][n][3]);
                    }
                }
            } else {
                const bool do_silu = (tn >= 18 && tn < 21) || (tn >= 25);
                const float sc = (tn == 21) ? 0.17677669529663687f : 1.f;
#pragma unroll
                for (int n = 0; n < 4; ++n) {
                    int t = tm * 128 + wy * 64 + n * 16 + fr;
#pragma unroll
                    for (int m = 0; m < 4; ++m) {
                        float v0 = acc[m][n][0] * sc, v1 = acc[m][n][1] * sc, v2 = acc[m][n][2] * sc, v3 = acc[m][n][3] * sc;
                        if (do_silu) { v0 = siluf_(v0); v1 = siluf_(v1); v2 = siluf_(v2); v3 = siluf_(v3); }
                        store4_bf16(proj + (size_t)t * NPROJ + c0 + m * 16 + 4 * fg, v0, v1, v2, v3);
                    }
                }
            }
        }
    }
}

__device__ void phase_outproj(const Params& p, int l, bf16_t* lds) {
    const int tid = ltid(), lane = tid & 63, w = tid >> 6, wx = w >> 1, wy = w & 1, fr = lane & 15, fg = lane >> 4;
    const bf16_t* mix = (const bf16_t*)(p.ws + WS_MIX);
    const bf16_t* wt = (const bf16_t*)(p.ws + WS_WOUT) + (size_t)l * 1024 * 1024;
    const float* xin = (l == 0) ? p.in[0] : p.out;
    float* xo = p.out;
    for (int round = 0;; ++round) {
        int tm, tn;
        if (!xcd_item(round, NTOK / 128, 8, tm, tn)) break;
        f32x4 acc[4][4];
        {
            const bf16_t* wbase = wt + (size_t)(tn * 128) * 1024; const bf16_t* tbase = mix + (size_t)(tm * 128) * 1024;
            auto rw = [&](int r) { return wbase + (size_t)r * 1024; };
            auto rt_ = [&](int r) { return tbase + (size_t)r * 1024; };
            gemm_core(rw, rt_, 1024, lds, acc);
        }
#pragma unroll
        for (int n = 0; n < 4; ++n) {
            int t = tm * 128 + wy * 64 + n * 16 + fr;
#pragma unroll
            for (int m = 0; m < 4; ++m) {
                int c = tn * 128 + wx * 64 + m * 16 + 4 * fg;
                float4 xv = *(const float4*)(xin + (size_t)t * 1024 + c);
                xv.x += acc[m][n][0]; xv.y += acc[m][n][1]; xv.z += acc[m][n][2]; xv.w += acc[m][n][3];
                *(float4*)(xo + (size_t)t * 1024 + c) = xv;
            }
        }
    }
}

__device__ void phase_route(const Params& p, int l, bf16_t* lds, int dry = 0) {
    const int tid = ltid(), lane = tid & 63, w = tid >> 6, fr = lane & 15, fg = lane >> 4;
    const float* x1 = p.out;
    const float* gain = p.in[15] + l * 1024;
    bf16_t* hn = dry ? (bf16_t*)(p.ws + WS_SCR) : (bf16_t*)(p.ws + WS_HN);
    const bf16_t* wr = (const bf16_t*)(p.ws + WS_WR) + (size_t)l * 64 * 1024;
    const float* brg = p.in[17] + l * 4; const float* bre = p.in[19] + l * 32;
    unsigned* cnt = (unsigned*)(p.ws + WS_CTL) + CW_CNT + l * 32;
    int* rowtok = (int*)(p.ws + WS_ROWTOK);
    int* tslot = (int*)(p.ws + WS_TSLOT);
    float* tgate = (float*)(p.ws + WS_TGATE);
    const int HL = 1032;
    float* red = (float*)(lds + 16 * HL);
    for (int it = blockIdx.x; it < NTOK / 16; it += gridDim.x) {
        __syncthreads();
#pragma unroll
        for (int rr = 0; rr < 4; ++rr) {
            int lr = w * 4 + rr; int t = it * 16 + lr;
            const float* xr = x1 + (size_t)t * 1024 + lane * 16;
            float v[16]; float ss = 0.f;
#pragma unroll
            for (int i = 0; i < 4; ++i) { float4 q = *(const float4*)(xr + 4 * i); v[4 * i] = q.x; v[4 * i + 1] = q.y; v[4 * i + 2] = q.z; v[4 * i + 3] = q.w; }
#pragma unroll
            for (int i = 0; i < 16; ++i) ss += v[i] * v[i];
            ss = wave_sum(ss);
            float r = rsqrtf(ss / D_MODEL + 1e-6f);
#pragma unroll
            for (int i = 0; i < 16; ++i) v[i] = v[i] * r * gain[lane * 16 + i];
            uint4 o0, o1;
            o0.x = pk_bf16(v[0], v[1]); o0.y = pk_bf16(v[2], v[3]); o0.z = pk_bf16(v[4], v[5]); o0.w = pk_bf16(v[6], v[7]);
            o1.x = pk_bf16(v[8], v[9]); o1.y = pk_bf16(v[10], v[11]); o1.z = pk_bf16(v[12], v[13]); o1.w = pk_bf16(v[14], v[15]);
            bf16_t* hr = hn + (size_t)t * 1024 + lane * 16;
            *(uint4*)hr = o0; *(uint4*)(hr + 8) = o1;
            *(uint4*)(lds + lr * HL + lane * 16) = o0; *(uint4*)(lds + lr * HL + lane * 16 + 8) = o1;
        }
        __syncthreads();
        f32x4 acc[3];
#pragma unroll
        for (int n = 0; n < 3; ++n) acc[n] = (f32x4){0.f, 0.f, 0.f, 0.f};
#pragma unroll
        for (int ks = 0; ks < 8; ++ks) {
            int k = w * 256 + ks * 32 + fg * 8;
            bf16x8 a = *(const bf16x8*)(lds + fr * HL + k);
#pragma unroll
            for (int n = 0; n < 3; ++n) {
                bf16x8 b = *(const bf16x8*)(wr + (size_t)(n * 16 + fr) * 1024 + k);
                acc[n] = __builtin_amdgcn_mfma_f32_16x16x32_bf16(a, b, acc[n], 0, 0, 0);
            }
        }
#pragma unroll
        for (int n = 0; n < 3; ++n) *(f32x4*)(red + ((w * 3 + n) * 64 + lane) * 4) = acc[n];
        __syncthreads();
        if (tid < 16) {
            float lg[36];
#pragma unroll
            for (int j = 0; j < 36; ++j) {
                int n = j >> 4, f = j & 15; int ln = (tid >> 2) * 16 + f; float s = 0.f;
#pragma unroll
                for (int ww = 0; ww < 4; ++ww) s += red[((ww * 3 + n) * 64 + ln) * 4 + (tid & 3)];
                lg[j] = s;
            }
            float gl[4]; float gm = -1e30f; int gi = 0;
#pragma unroll
            for (int j = 0; j < 4; ++j) { gl[j] = lg[j] + brg[j]; if (gl[j] > gm) { gm = gl[j]; gi = j; } }
            float gs = 0.f;
#pragma unroll
            for (int j = 0; j < 4; ++j) gs += __expf(gl[j] - gm);
            float gp = 1.f / gs;
            float el[8]; float em = -1e30f;
#pragma unroll
            for (int j = 0; j < 8; ++j) {
                float v = (gi == 0) ? lg[4 + j] : (gi == 1) ? lg[12 + j] : (gi == 2) ? lg[20 + j] : lg[28 + j];
                el[j] = v + bre[gi * 8 + j]; em = fmaxf(em, el[j]);
            }
#pragma unroll
            for (int j = 0; j < 8; ++j) el[j] = __expf(el[j] - em);
            float v0 = -1.f, v1 = -1.f; int i0 = 0, i1 = 0;
#pragma unroll
            for (int j = 0; j < 8; ++j) {
                float v = el[j];
                if (v > v0) { v1 = v0; i1 = i0; v0 = v; i0 = j; }
                else if (v > v1) { v1 = v; i1 = j; }
            }
            int t = it * 16 + tid;
            int e0 = gi * 8 + i0, e1 = gi * 8 + i1;
            if (!dry) {
            unsigned s0 = atomicAdd(&cnt[e0], 1u), s1 = atomicAdd(&cnt[e1], 1u);
            rowtok[(size_t)e0 * NTOK + s0] = t; rowtok[(size_t)e1 * NTOK + s1] = t;
            tslot[t * 2] = (e0 << 16) | (int)s0; tslot[t * 2 + 1] = (e1 << 16) | (int)s1;
            tgate[t * 2] = gp * v0 / (v0 + v1); tgate[t * 2 + 1] = gp * v1 / (v0 + v1);
            } else if (gp * v0 == 123.456f) tgate[0] = v1;
        }
    }
}

__device__ __forceinline__ void moe_tables(const unsigned* cnt, int* tab) {
    if (threadIdx.x == 0) {
        int a = 0;
        for (int e = 0; e < 32; ++e) { tab[e] = a; tab[40 + e] = a * 128; a += ((int)ld_u32_agent(cnt + e) + 127) >> 7; }
        tab[32] = a; tab[72] = a * 128;
    }
    __syncthreads();
}
template <int MODE>
__device__ void phase_expert(const Params& p, int l, bf16_t* lds) {
    const int tid = ltid(), lane = tid & 63, w = tid >> 6, wx = w >> 1, wy = w & 1, fr = lane & 15, fg = lane >> 4;
    const unsigned* cnt = (const unsigned*)(p.ws + WS_CTL) + CW_CNT + l * 32;
    int* tab = (int*)(lds + 4 * GSTAGE);
    moe_tables(cnt, tab);
    const int* rowtok = (const int*)(p.ws + WS_ROWTOK);
    const bf16_t* hn = (const bf16_t*)(p.ws + WS_HN);
    bf16_t* Hb = (bf16_t*)(p.ws + WS_H);
    bf16_t* Yb = (bf16_t*)(p.ws + WS_Y);
    const int x = blockIdx.x & 7, loc = blockIdx.x >> 3, nloc = gridDim.x >> 3;
    for (int j = loc;; j += nloc) {
        int e = -1, rt = 0, tn = 0; int jj = j;
#pragma unroll
        for (int q = 0; q < 4; ++q) {
            int ee = q * 8 + x; int nrt = tab[ee + 1] - tab[ee];
            if (e < 0) { if (jj < nrt * 8) { e = ee; tn = jj / nrt; rt = jj % nrt; } else jj -= nrt * 8; }
        }
        if (e < 0) break;
        const int c_e = (int)ld_u32_agent(cnt + e); const int hrow0 = tab[40 + e] + rt * 128;
        f32x4 acc[4][4];
        if (MODE == 0) {
            const bf16_t* wbase = (const bf16_t*)(p.ws + WS_WGU) + (((size_t)l * 32 + e) * 1024 + tn * 128) * 1024;
            const int* rtk = rowtok + (size_t)e * NTOK + rt * 128; const int nval = c_e - rt * 128;
            auto rw = [&](int r) { return wbase + (size_t)r * 1024; };
            auto rt_ = [&](int r) { int t = (r < nval) ? rtk[r] : 0; return hn + (size_t)t * 1024; };
            gemm_core(rw, rt_, 1024, lds, acc);
        } else {
            const bf16_t* wbase = (const bf16_t*)(p.ws + WS_WD) + (((size_t)l * 32 + e) * 1024 + tn * 128) * 512;
            const bf16_t* hbase = Hb + (size_t)hrow0 * 512;
            auto rw = [&](int r) { return wbase + (size_t)r * 512; };
            auto rt_ = [&](int r) { return hbase + (size_t)r * 512; };
            gemm_core(rw, rt_, 512, lds, acc);
        }
        if (MODE == 0) {
#pragma unroll
            for (int n = 0; n < 4; ++n) {
                int hr = hrow0 + wy * 64 + n * 16 + fr;
#pragma unroll
                for (int m = 0; m < 2; ++m) {
                    int hc = tn * 64 + wx * 32 + m * 16 + 4 * fg;
                    store4_bf16(Hb + (size_t)hr * 512 + hc, siluf_(acc[m][n][0]) * acc[m + 2][n][0], siluf_(acc[m][n][1]) * acc[m + 2][n][1],
                                siluf_(acc[m][n][2]) * acc[m + 2][n][2], siluf_(acc[m][n][3]) * acc[m + 2][n][3]);
                }
            }
        } else {
#pragma unroll
            for (int n = 0; n < 4; ++n) {
                int hr = hrow0 + wy * 64 + n * 16 + fr;
#pragma unroll
                for (int m = 0; m < 4; ++m) {
                    int c = tn * 128 + wx * 64 + m * 16 + 4 * fg;
                    store4_bf16(Yb + (size_t)hr * 1024 + c, acc[m][n][0], acc[m][n][1], acc[m][n][2], acc[m][n][3]);
                }
            }
        }
    }
}

__device__ void phase_combine(const Params& p, int l, int dry = 0) {
    const int tid = ltid(), lane = tid & 63, w = tid >> 6;
    const unsigned* cnt = (const unsigned*)(p.ws + WS_CTL) + CW_CNT + l * 32;
    int c = (lane < 32) ? (((int)ld_u32_agent(cnt + (lane & 31)) + 127) >> 7) * 128 : 0;
    int incl = c;
#pragma unroll
    for (int o = 1; o < 32; o <<= 1) { int v = __shfl_up(incl, o, 64); if (lane >= o) incl += v; }
    int hoff = incl - c;
    const int* tslot = (const int*)(p.ws + WS_TSLOT);
    const float* tgate = (const float*)(p.ws + WS_TGATE);
    const bf16_t* Yb = (const bf16_t*)(p.ws + WS_Y);
    bf16_t* hn = dry ? (bf16_t*)(p.ws + WS_SCR + (size_t)40 * 1024 * 1024) : (bf16_t*)(p.ws + WS_HN);
    float* x = p.out; float* xw = dry ? (float*)(p.ws + WS_SCR) : p.out;
    const float* gain = (l == 0 || dry) ? p.in[1] + 1024 : nullptr;
    for (int it = blockIdx.x; it < NTOK / 4; it += gridDim.x) {
        int t = it * 4 + w;
        int ts0 = tslot[t * 2], ts1 = tslot[t * 2 + 1];
        float g0 = tgate[t * 2], g1 = tgate[t * 2 + 1];
        int r0 = __shfl(hoff, ts0 >> 16, 64) + (ts0 & 0xffff);
        int r1 = __shfl(hoff, ts1 >> 16, 64) + (ts1 & 0xffff);
        float* xr = x + (size_t)t * 1024 + lane * 16;
        const bf16_t* y0 = Yb + (size_t)r0 * 1024 + lane * 16;
        const bf16_t* y1 = Yb + (size_t)r1 * 1024 + lane * 16;
        float v[16];
#pragma unroll
        for (int i = 0; i < 4; ++i) { float4 q = *(const float4*)(xr + 4 * i); v[4 * i] = q.x; v[4 * i + 1] = q.y; v[4 * i + 2] = q.z; v[4 * i + 3] = q.w; }
        uint4 a0 = *(const uint4*)y0, a1 = *(const uint4*)(y0 + 8), b0 = *(const uint4*)y1, b1 = *(const uint4*)(y1 + 8);
        unsigned ya[8] = {a0.x, a0.y, a0.z, a0.w, a1.x, a1.y, a1.z, a1.w};
        unsigned yb[8] = {b0.x, b0.y, b0.z, b0.w, b1.x, b1.y, b1.z, b1.w};
#pragma unroll
        for (int i = 0; i < 8; ++i) {
            v[2 * i] += g0 * bflo(ya[i]) + g1 * bflo(yb[i]);
            v[2 * i + 1] += g0 * bfhi(ya[i]) + g1 * bfhi(yb[i]);
        }
#ifdef NANMARK
#pragma unroll
        for (int i = 0; i < 16; ++i) if (!(fabsf(v[i]) < 1e30f)) v[i] = 1000.f;
#endif
#pragma unroll
        for (int i = 0; i < 4; ++i) *(float4*)(xw + (size_t)t * 1024 + lane * 16 + 4 * i) = make_float4(v[4 * i], v[4 * i + 1], v[4 * i + 2], v[4 * i + 3]);
        if (gain) {
            float ss = 0.f;
#pragma unroll
            for (int i = 0; i < 16; ++i) ss += v[i] * v[i];
            ss = wave_sum(ss);
            float r = rsqrtf(ss / D_MODEL + 1e-6f);
#pragma unroll
            for (int i = 0; i < 16; ++i) v[i] = v[i] * r * gain[lane * 16 + i];
            uint4 o0, o1;
            o0.x = pk_bf16(v[0], v[1]); o0.y = pk_bf16(v[2], v[3]); o0.z = pk_bf16(v[4], v[5]); o0.w = pk_bf16(v[6], v[7]);
            o1.x = pk_bf16(v[8], v[9]); o1.y = pk_bf16(v[10], v[11]); o1.z = pk_bf16(v[12], v[13]); o1.w = pk_bf16(v[14], v[15]);
            bf16_t* hr = hn + (size_t)t * 1024 + lane * 16;
            *(uint4*)hr = o0; *(uint4*)(hr + 8) = o1;
        }
    }
}


__device__ __forceinline__ void mm_row(const bf16_t* RA, const bf16_t* RB, int mw, int fr, int fg, f32x4 (&acc)[4]) {
#pragma unroll
    for (int ks = 0; ks < 2; ++ks) {
        bf16x8 a = *(const bf16x8*)(RA + (16 * mw + fr) * LROW + ks * 32 + fg * 8);
#pragma unroll
        for (int nt = 0; nt < 4; ++nt) {
            bf16x8 b = *(const bf16x8*)(RB + (16 * nt + fr) * LROW + ks * 32 + fg * 8);
            acc[nt] = __builtin_amdgcn_mfma_f32_16x16x32_bf16(a, b, acc[nt], 0, 0, 0);
        }
    }
}
__device__ __forceinline__ void mm_col(const bf16_t* RA, const bf16_t* RB, int nw, int fr, int fg, f32x4 (&acc)[4]) {
#pragma unroll
    for (int ks = 0; ks < 2; ++ks) {
        bf16x8 b = *(const bf16x8*)(RB + (16 * nw + fr) * LROW + ks * 32 + fg * 8);
#pragma unroll
        for (int mt = 0; mt < 4; ++mt) {
            bf16x8 a = *(const bf16x8*)(RA + (16 * mt + fr) * LROW + ks * 32 + fg * 8);
            acc[mt] = __builtin_amdgcn_mfma_f32_16x16x32_bf16(a, b, acc[mt], 0, 0, 0);
        }
    }
}
__device__ __forceinline__ void zero4(f32x4 (&a)[4]) {
#pragma unroll
    for (int i = 0; i < 4; ++i) a[i] = (f32x4){0.f, 0.f, 0.f, 0.f};
}
__device__ __forceinline__ void st4_lds(bf16_t* p, float a, float b, float c, float d) { uint2 o; o.x = pk_bf16(a, b); o.y = pk_bf16(c, d); *(uint2*)p = o; }
__device__ __forceinline__ bf16_t f2bf(float v) { return (bf16_t)(pk_bf16(v, 0.f) & 0xffffu); }

__device__ void gdn_prep_item(const Params& p, int l, int cid, unsigned char* lds_raw) {
    const int tid = ltid(), lane = tid & 63, w = tid >> 6, fr = lane & 15, fg = lane >> 4;
    const int bh = cid >> 6, n = cid & 63, b = bh / H_GDN, h = bh % H_GDN;
    const int t0 = b * SEQ + n * 64;
    bf16_t* L0 = (bf16_t*)lds_raw; bf16_t* L1 = L0 + 64 * LROW; bf16_t* L2 = L1 + 64 * LROW; bf16_t* L3 = L2 + 64 * LROW; bf16_t* L4 = L3 + 64 * LROW; bf16_t* L5 = L4 + 64 * LROW;
    float* dec = (float*)(L5 + 64 * LROW); float* beta = dec + 64;
    const bf16_t* proj = (const bf16_t*)(p.ws + WS_PROJ);
    const float* aux = (const float*)(p.ws + WS_AUX);
    const float* convw = p.in[7] + (size_t)l * 4 * 1152;
    __syncthreads();
    const int i = tid >> 2, c0 = (tid & 3) * 16;
    float qv[16], kv[16], vv[16];
#pragma unroll
    for (int which = 0; which < 3; ++which) {
        float acc[16];
#pragma unroll
        for (int c = 0; c < 16; ++c) acc[c] = 0.f;
#pragma unroll
        for (int tap = 0; tap < 4; ++tap) {
            const int row = i - 3 + tap;
            if (n * 64 + row >= 0) {
                const bf16_t* xp = proj + (size_t)(t0 + row) * NPROJ + NC_GQ + which * 384 + h * 64 + c0;
                u32x4 x0 = *(const u32x4*)xp, x1 = *(const u32x4*)(xp + 8);
                const float* wp = convw + tap * 1152 + which * 384 + h * 64 + c0;
                f32x4 w0 = *(const f32x4*)wp, w1 = *(const f32x4*)(wp + 4), w2 = *(const f32x4*)(wp + 8), w3 = *(const f32x4*)(wp + 12);
                float wv[16] = {w0[0], w0[1], w0[2], w0[3], w1[0], w1[1], w1[2], w1[3], w2[0], w2[1], w2[2], w2[3], w3[0], w3[1], w3[2], w3[3]};
                unsigned xs[8] = {x0[0], x0[1], x0[2], x0[3], x1[0], x1[1], x1[2], x1[3]};
#pragma unroll
                for (int c = 0; c < 8; ++c) { acc[2 * c] += wv[2 * c] * bflo(xs[c]); acc[2 * c + 1] += wv[2 * c + 1] * bfhi(xs[c]); }
            }
        }
        float ss = 0.f;
#pragma unroll
        for (int c = 0; c < 16; ++c) { acc[c] = siluf_(acc[c]); ss += acc[c] * acc[c]; }
        if (which < 2) {
            ss += __shfl_xor(ss, 1, 64); ss += __shfl_xor(ss, 2, 64);
            const float sc = rsqrtf(ss + 1e-6f) * (which == 0 ? 0.125f : 1.f);
#pragma unroll
            for (int c = 0; c < 16; ++c) acc[c] *= sc;
        }
#pragma unroll
        for (int c = 0; c < 16; ++c) { if (which == 0) qv[c] = acc[c]; else if (which == 1) kv[c] = acc[c]; else vv[c] = acc[c]; }
    }
#pragma unroll
    for (int c = 0; c < 16; c += 4) { st4_lds(L2 + i * LROW + c0 + c, kv[c], kv[c + 1], kv[c + 2], kv[c + 3]); st4_lds(L3 + i * LROW + c0 + c, qv[c], qv[c + 1], qv[c + 2], qv[c + 3]); }
    if (w == 0) {
        const float a = aux[(size_t)(t0 + lane) * 64 + AX_GA + h], bl = aux[(size_t)(t0 + lane) * 64 + AX_GB + h];
        const float g = -__expf(p.in[8][l * H_GDN + h]) * softplusf_(a + p.in[9][l * H_GDN + h]);
        float inc = g;
#pragma unroll
        for (int o = 1; o < 64; o <<= 1) { float t = __shfl_up(inc, o, 64); if (lane >= o) inc += t; }
        dec[lane] = inc; beta[lane] = sigmoidf_(bl);
    }
    __syncthreads();
    {
        f32x4 g4[4]; zero4(g4);
        mm_row(L2, L2, w, fr, fg, g4);
#pragma unroll
        for (int nt = 0; nt < 4; ++nt) {
            const int kap = 16 * nt + fr; const float dk_ = dec[kap], bk_ = beta[kap];
            float nT[4], nN[4], tt[4];
#pragma unroll
            for (int r = 0; r < 4; ++r) {
                const int rho = 16 * w + 4 * fg + r; const float dr_ = dec[rho], br_ = beta[rho];
                const float G = g4[nt][r];
                nT[r] = (kap < rho) ? br_ * G * __expf(dr_ - dk_) : 0.f;
                nN[r] = (rho < kap) ? bk_ * G * __expf(dk_ - dr_) : 0.f;
                tt[r] = ((kap == rho) ? 1.f : 0.f) - nN[r];
            }
            st4_lds(L1 + kap * LROW + 16 * w + 4 * fg, nT[0], nT[1], nT[2], nT[3]);
            st4_lds(L0 + kap * LROW + 16 * w + 4 * fg, nN[0], nN[1], nN[2], nN[3]);
            st4_lds(L4 + kap * LROW + 16 * w + 4 * fg, tt[0], tt[1], tt[2], tt[3]);
        }
        f32x4 a4[4]; zero4(a4);
        mm_row(L2, L3, w, fr, fg, a4);
#pragma unroll
        for (int nt = 0; nt < 4; ++nt) {
            const int ii = 16 * nt + fr; const float di_ = dec[ii];
            float v4[4];
#pragma unroll
            for (int r = 0; r < 4; ++r) { const int j = 16 * w + 4 * fg + r; v4[r] = (j <= ii) ? a4[nt][r] * __expf(di_ - dec[j]) : 0.f; }
            st4_lds(L5 + ii * LROW + 16 * w + 4 * fg, v4[0], v4[1], v4[2], v4[3]);
        }
    }
    __syncthreads();
#pragma unroll
    for (int lev = 1; lev <= 5; ++lev) {
        const bf16_t* XA = (lev & 1) ? L0 : L2; const bf16_t* XAt = (lev & 1) ? L1 : L3;
        bf16_t* XB = (lev & 1) ? L2 : L0; bf16_t* XBt = (lev & 1) ? L3 : L1;
        {
            f32x4 x4[4]; zero4(x4);
            mm_row(XA, XAt, w, fr, fg, x4);
#pragma unroll
            for (int nt = 0; nt < 4; ++nt) {
                const int c = 16 * nt + fr;
                st4_lds(XBt + c * LROW + 16 * w + 4 * fg, x4[nt][0], x4[nt][1], x4[nt][2], x4[nt][3]);
                if (lev < 5) {
#pragma unroll
                    for (int r = 0; r < 4; ++r) XB[(16 * w + 4 * fg + r) * LROW + c] = f2bf(x4[nt][r]);
                }
            }
        }
        __syncthreads();
        {
            f32x4 t4[4];
#pragma unroll
            for (int mt = 0; mt < 4; ++mt) {
                uint2 u = *(const uint2*)(L4 + (16 * w + fr) * LROW + 16 * mt + 4 * fg);
                t4[mt] = (f32x4){bflo(u.x), bfhi(u.x), bflo(u.y), bfhi(u.y)};
            }
            mm_col(XBt, L4, w, fr, fg, t4);
#pragma unroll
            for (int mt = 0; mt < 4; ++mt) st4_lds(L4 + (16 * w + fr) * LROW + 16 * mt + 4 * fg, t4[mt][0], t4[mt][1], t4[mt][2], t4[mt][3]);
        }
    }
    {
        const float dj = dec[i], bj = beta[i], dlast = dec[63];
        const float s1 = bj * __expf(dj), s2 = bj, s3 = __expf(dlast - dj);
#pragma unroll
        for (int c = 0; c < 16; ++c) {
            L0[(c0 + c) * LROW + i] = f2bf(kv[c] * s1);
            L1[(c0 + c) * LROW + i] = f2bf(vv[c] * s2);
            L2[(c0 + c) * LROW + i] = f2bf(kv[c] * s3);
        }
    }
    __syncthreads();
    {
        f32x4 w4[4], u4[4]; zero4(w4); zero4(u4);
        mm_row(L4, L0, w, fr, fg, w4);
        mm_row(L4, L1, w, fr, fg, u4);
        __syncthreads();
#pragma unroll
        for (int nt = 0; nt < 4; ++nt) {
            st4_lds(L0 + (16 * nt + fr) * LROW + 16 * w + 4 * fg, w4[nt][0], w4[nt][1], w4[nt][2], w4[nt][3]);
            st4_lds(L1 + (16 * nt + fr) * LROW + 16 * w + 4 * fg, u4[nt][0], u4[nt][1], u4[nt][2], u4[nt][3]);
        }
        const float ed = __expf(dec[i]);
#pragma unroll
        for (int c = 0; c < 16; c += 4) st4_lds(L3 + i * LROW + c0 + c, qv[c] * ed, qv[c + 1] * ed, qv[c + 2] * ed, qv[c + 3] * ed);
    }
    __syncthreads();
    char* scr = p.ws + WS_SCR;
    {
        f32x4 m4[4]; zero4(m4);
        mm_row(L0, L2, w, fr, fg, m4);
        bf16_t* MP = (bf16_t*)(scr + SCR_GDN_MP) + (size_t)cid * 4096;
#pragma unroll
        for (int nt = 0; nt < 4; ++nt) store4_bf16(MP + (16 * nt + fr) * 64 + 16 * w + 4 * fg, -m4[nt][0], -m4[nt][1], -m4[nt][2], -m4[nt][3]);
        f32x4 n4[4]; zero4(n4);
        mm_row(L2, L1, w, fr, fg, n4);
        bf16_t* NN = (bf16_t*)(scr + SCR_GDN_NN) + (size_t)cid * 4096;
#pragma unroll
        for (int nt = 0; nt < 4; ++nt) store4_bf16(NN + ((w * 4 + nt) * 64 + lane) * 4, n4[nt][0], n4[nt][1], n4[nt][2], n4[nt][3]);
        f32x4 p4[4]; zero4(p4);
        mm_row(L0, L5, w, fr, fg, p4);
        bf16_t* PG = (bf16_t*)(scr + SCR_GDN_P) + (size_t)cid * 4096;
#pragma unroll
        for (int nt = 0; nt < 4; ++nt) {
            uint2 u = *(const uint2*)(L3 + (16 * nt + fr) * LROW + 16 * w + 4 * fg);
            store4_bf16(PG + (16 * nt + fr) * 64 + 16 * w + 4 * fg, bflo(u.x) - p4[nt][0], bfhi(u.x) - p4[nt][1], bflo(u.y) - p4[nt][2], bfhi(u.y) - p4[nt][3]);
        }
        f32x4 o4[4]; zero4(o4);
        mm_row(L1, L5, w, fr, fg, o4);
        bf16_t* OL = (bf16_t*)(scr + SCR_GDN_OL) + (size_t)cid * 4096;
#pragma unroll
        for (int nt = 0; nt < 4; ++nt) store4_bf16(OL + (16 * nt + fr) * 64 + 16 * w + 4 * fg, o4[nt][0], o4[nt][1], o4[nt][2], o4[nt][3]);
        if (tid == 0) ((float*)(scr + SCR_GDN_LAST))[cid] = __expf(dec[63]);
    }
}

#define SCAN_SB(k)   ((bf16_t*)lds_raw + (k) * 4096)
#define SCAN_RING(k) ((bf16_t*)lds_raw + 8192 + (k) * 8192)
#define SCAN_LAST    ((float*)(lds_raw + 65536))
__device__ __forceinline__ void scan_issue(const bf16_t* mp_lane, const bf16_t* nn_lane, int n, bf16_t* slot) {
#pragma unroll
    for (int q = 0; q < 8; ++q) __builtin_amdgcn_global_load_lds((const unsigned*)(mp_lane + (size_t)n * 4096 + q * 512), (unsigned*)(slot + q * 512), 16, 0, 0);
#pragma unroll
    for (int q = 0; q < 8; ++q) __builtin_amdgcn_global_load_lds((const unsigned*)(nn_lane + (size_t)n * 4096 + q * 512), (unsigned*)(slot + 4096 + q * 512), 16, 0, 0);
}
__device__ void gdn_scan_item(const Params& p, int bh, unsigned char* lds_raw) {
    const int tid = ltid(), lane = tid & 63, w = __builtin_amdgcn_readfirstlane(tid >> 6), fr = lane & 15, fg = lane >> 4;
    char* scr = p.ws + WS_SCR;
    const bf16_t* MP = (const bf16_t*)(scr + SCR_GDN_MP) + (size_t)bh * 64 * 4096;
    const bf16_t* NN = (const bf16_t*)(scr + SCR_GDN_NN) + (size_t)bh * 64 * 4096;
    const float* LAST = (const float*)(scr + SCR_GDN_LAST) + bh * 64;
    bf16_t* SG = (bf16_t*)(scr + SCR_GDN_SG) + (size_t)bh * 64 * 4096;
    const int mrow = lane >> 3;
    const bf16_t* nn_lane = NN + lane * 8;
    RAW_BARRIER();
    if (tid < 64) SCAN_LAST[tid] = ld_f32_agent(LAST + tid);
    asm volatile("s_waitcnt vmcnt(0)" ::: "memory");
    f32x4 S[4]; zero4(S);
    const int swz = (fr >> 1) & 7;
    if (w == 0) {
#pragma unroll
        for (int n = 0; n < 2; ++n) {
#pragma unroll
            for (int q = 0; q < 8; ++q) { const int row = 8 * q + mrow; __builtin_amdgcn_global_load_lds((const unsigned*)(MP + (size_t)n * 4096 + row * 64 + (((lane & 7) ^ ((row >> 1) & 7)) * 8)), (unsigned*)(SCAN_RING(n) + q * 512), 16, 0, 0); }
#pragma unroll
            for (int q = 0; q < 8; ++q) __builtin_amdgcn_global_load_lds((const unsigned*)(nn_lane + (size_t)n * 4096 + q * 512), (unsigned*)(SCAN_RING(n) + 4096 + q * 512), 16, 0, 0);
        }
    }
    for (int n = 0; n < 64; ++n) {
        bf16_t* sb = SCAN_SB(n & 1);
        const bf16_t* ring = SCAN_RING(n % 3);
#pragma unroll
        for (int nt = 0; nt < 4; ++nt) {
            const int e = 16 * nt + fr; const int c = 2 * w + (fg >> 1);
            uint2 o; o.x = pk_bf16(S[nt][0], S[nt][1]); o.y = pk_bf16(S[nt][2], S[nt][3]);
            *(uint2*)(sb + e * 64 + ((c ^ swz) * 8) + 4 * (fg & 1)) = o;
        }
        if (w == 0) { if (n + 1 < 64) asm volatile("s_waitcnt vmcnt(16)" ::: "memory"); else asm volatile("s_waitcnt vmcnt(0)" ::: "memory"); }
        RAW_BARRIER();
        if (w == 0 && n + 2 < 64) {
            bf16_t* slot = SCAN_RING((n + 2) % 3);
#pragma unroll
            for (int q = 0; q < 8; ++q) { const int row = 8 * q + mrow; __builtin_amdgcn_global_load_lds((const unsigned*)(MP + (size_t)(n + 2) * 4096 + row * 64 + (((lane & 7) ^ ((row >> 1) & 7)) * 8)), (unsigned*)(slot + q * 512), 16, 0, 0); }
#pragma unroll
            for (int q = 0; q < 8; ++q) __builtin_amdgcn_global_load_lds((const unsigned*)(nn_lane + (size_t)(n + 2) * 4096 + q * 512), (unsigned*)(slot + 4096 + q * 512), 16, 0, 0);
        }
        const float last = SCAN_LAST[n];
#pragma unroll
        for (int nt = 0; nt < 4; ++nt) {
            uint2 nn = *(const uint2*)(ring + 4096 + ((w * 4 + nt) * 64 + lane) * 4);
            S[nt][0] = last * S[nt][0] + bflo(nn.x); S[nt][1] = last * S[nt][1] + bfhi(nn.x);
            S[nt][2] = last * S[nt][2] + bflo(nn.y); S[nt][3] = last * S[nt][3] + bfhi(nn.y);
        }
#pragma unroll
        for (int ks = 0; ks < 2; ++ks) {
            const int co = ((ks * 4 + fg) ^ swz) * 8;
            bf16x8 a = *(const bf16x8*)(ring + (16 * w + fr) * 64 + co);
#pragma unroll
            for (int nt = 0; nt < 4; ++nt) {
                bf16x8 s = *(const bf16x8*)(sb + (16 * nt + fr) * 64 + co);
                S[nt] = __builtin_amdgcn_mfma_f32_16x16x32_bf16(a, s, S[nt], 0, 0, 0);
            }
        }
        if (w >= 2) {
#pragma unroll
            for (int i = 0; i < 4; ++i) {
                const int c = (w - 2) * 256 + i * 64 + lane; const int row = c >> 3, pc = c & 7;
                u32x4 v = *(const u32x4*)(sb + row * 64 + pc * 8);
                *(u32x4*)(SG + (size_t)n * 4096 + row * 64 + ((pc ^ ((row >> 1) & 7)) * 8)) = v;
            }
        }
    }
}

__device__ void gdn_out_item(const Params& p, int l, int cid) {
    const int tid = ltid(), lane = tid & 63, w = tid >> 6, fr = lane & 15, fg = lane >> 4;
    const int bh = cid >> 6, n = cid & 63, b = bh / H_GDN, h = bh % H_GDN;
    char* scr = p.ws + WS_SCR;
    const bf16_t* SG = (const bf16_t*)(scr + SCR_GDN_SG) + (size_t)cid * 4096;
    const bf16_t* PG = (const bf16_t*)(scr + SCR_GDN_P) + (size_t)cid * 4096;
    const bf16_t* OL = (const bf16_t*)(scr + SCR_GDN_OL) + (size_t)cid * 4096;
    const int i = 16 * w + fr; const int t = b * SEQ + n * 64 + i;
    f32x4 acc[4];
#pragma unroll
    for (int mt = 0; mt < 4; ++mt) { uint2 u = *(const uint2*)(OL + i * 64 + 16 * mt + 4 * fg); acc[mt] = (f32x4){bflo(u.x), bfhi(u.x), bflo(u.y), bfhi(u.y)}; }
#pragma unroll
    for (int ks = 0; ks < 2; ++ks) {
        bf16x8 bq = *(const bf16x8*)(PG + i * 64 + ks * 32 + fg * 8);
#pragma unroll
        for (int mt = 0; mt < 4; ++mt) {
            bf16x8 a = *(const bf16x8*)(SG + (16 * mt + fr) * 64 + ks * 32 + fg * 8);
            acc[mt] = __builtin_amdgcn_mfma_f32_16x16x32_bf16(a, bq, acc[mt], 0, 0, 0);
        }
    }
    float ss = 0.f;
#pragma unroll
    for (int mt = 0; mt < 4; ++mt)
#pragma unroll
        for (int r = 0; r < 4; ++r) ss += acc[mt][r] * acc[mt][r];
    ss += __shfl_xor(ss, 16, 64); ss += __shfl_xor(ss, 32, 64);
    const float rstd = rsqrtf(ss * (1.f / 64.f) + 1e-6f);
    const float* og = p.in[10] + l * 64;
    const bf16_t* gp = (const bf16_t*)(p.ws + WS_PROJ) + (size_t)t * NPROJ + NC_GG + h * 64;
    bf16_t* mp = (bf16_t*)(p.ws + WS_MIX) + (size_t)t * D_MODEL + 384 + h * 64;
#pragma unroll
    for (int mt = 0; mt < 4; ++mt) {
        const int e0 = 16 * mt + 4 * fg;
        uint2 gu = *(const uint2*)(gp + e0); f32x4 g4 = *(const f32x4*)(og + e0);
        store4_bf16(mp + e0, acc[mt][0] * rstd * g4[0] * bflo(gu.x), acc[mt][1] * rstd * g4[1] * bfhi(gu.x), acc[mt][2] * rstd * g4[2] * bflo(gu.y), acc[mt][3] * rstd * g4[3] * bfhi(gu.y));
    }
}

#define GQROW 40
__device__ void gla_prep_item(const Params& p, int l, int cid, unsigned char* lds_raw) {
    const int tid = ltid(), lane = tid & 63, w = tid >> 6, fr = lane & 15, fg = lane >> 4;
    const int bh = cid >> 6, n = cid & 63, b = bh / H_GLA, h = bh % H_GLA;
    const int t0 = b * SEQ + n * 64;
    float* Bf = (float*)lds_raw;
    bf16_t* Qt = (bf16_t*)(lds_raw + 8448);
    bf16_t* Kt = Qt + 64 * GQROW;
    bf16_t* KLt = Kt + 64 * GQROW;
    bf16_t* Vt = KLt + 32 * LROW;
    const bf16_t* proj = (const bf16_t*)(p.ws + WS_PROJ);
    const float* aux = (const float*)(p.ws + WS_AUX);
    char* scr = p.ws + WS_SCR;
    __syncthreads();
    const int i = tid >> 2, d0 = (tid & 3) * 8;
    {
        const float* wa = p.in[11] + (size_t)l * 16 * 128 + h * 32 + d0;
        const float* ba = p.in[12] + l * 128 + h * 32 + d0;
        float acc[8];
#pragma unroll
        for (int j = 0; j < 8; ++j) acc[j] = ba[j];
        float a1v[16];
#pragma unroll
        for (int r = 0; r < 16; r += 2) { float2 t2 = *(const float2*)(aux + (size_t)(t0 + i) * 64 + AX_LA + r); a1v[r] = t2.x; a1v[r + 1] = t2.y; }
#pragma unroll
        for (int r = 0; r < 16; ++r) {
            f32x4 wA = *(const f32x4*)(wa + r * 128), wB = *(const f32x4*)(wa + r * 128 + 4);
#pragma unroll
            for (int j = 0; j < 4; ++j) { acc[j] += a1v[r] * wA[j]; acc[4 + j] += a1v[r] * wB[j]; }
        }
#pragma unroll
        for (int j = 0; j < 8; ++j) Bf[i * 33 + d0 + j] = logsigmoidf_(acc[j]) * (1.f / 16.f);
    }
    {
        const bf16_t* lvt = (const bf16_t*)(scr + SCR_LVT) + (size_t)bh * 64 * SEQ + n * 64;
#pragma unroll
        for (int ii = 0; ii < 2; ++ii) { int c = tid + 256 * ii; int row = c >> 3, kc = c & 7; *(u32x4*)(Vt + row * LROW + kc * 8) = *(const u32x4*)(lvt + (size_t)row * SEQ + kc * 8); }
    }
    __syncthreads();
#pragma unroll
    for (int c = 0; c < 8; ++c) {
        const int d = 8 * w + c;
        float inc = Bf[lane * 33 + d];
#pragma unroll
        for (int o = 1; o < 64; o <<= 1) { float t = __shfl_up(inc, o, 64); if (lane >= o) inc += t; }
        Bf[lane * 33 + d] = inc;
    }
    __syncthreads();
    {
        const bf16_t* qp = proj + (size_t)(t0 + i) * NPROJ + NC_LQ + h * 32 + d0;
        const bf16_t* kp = proj + (size_t)(t0 + i) * NPROJ + NC_LK + h * 32 + d0;
        u32x4 qu = *(const u32x4*)qp, ku = *(const u32x4*)kp;
        float qf[8] = {bflo(qu[0]), bfhi(qu[0]), bflo(qu[1]), bfhi(qu[1]), bflo(qu[2]), bfhi(qu[2]), bflo(qu[3]), bfhi(qu[3])};
        float kf[8] = {bflo(ku[0]), bfhi(ku[0]), bflo(ku[1]), bfhi(ku[1]), bflo(ku[2]), bfhi(ku[2]), bflo(ku[3]), bfhi(ku[3])};
        float qt[8], kt[8], qb[8];
#pragma unroll
        for (int j = 0; j < 8; ++j) {
            const float bi = Bf[i * 33 + d0 + j], bm = Bf[31 * 33 + d0 + j], bl = Bf[63 * 33 + d0 + j];
            qt[j] = qf[j] * __expf(bi - bm); kt[j] = kf[j] * __expf(bm - bi); qb[j] = qf[j] * __expf(bi);
            KLt[(d0 + j) * LROW + i] = f2bf(kf[j] * __expf(bl - bi));
            if (i == 63) ((float*)(scr + SCR_GLA_DL))[cid * 32 + d0 + j] = __expf(bl);
        }
        u32x4 o; o[0] = pk_bf16(qt[0], qt[1]); o[1] = pk_bf16(qt[2], qt[3]); o[2] = pk_bf16(qt[4], qt[5]); o[3] = pk_bf16(qt[6], qt[7]);
        *(u32x4*)(Qt + i * GQROW + d0) = o;
        o[0] = pk_bf16(kt[0], kt[1]); o[1] = pk_bf16(kt[2], kt[3]); o[2] = pk_bf16(kt[4], kt[5]); o[3] = pk_bf16(kt[6], kt[7]);
        *(u32x4*)(Kt + i * GQROW + d0) = o;
        o[0] = pk_bf16(qb[0], qb[1]); o[1] = pk_bf16(qb[2], qb[3]); o[2] = pk_bf16(qb[4], qb[5]); o[3] = pk_bf16(qb[6], qb[7]);
        *(u32x4*)((bf16_t*)(scr + SCR_GLA_QB) + (size_t)cid * 2048 + i * 32 + d0) = o;
    }
    __syncthreads();
    f32x4 sc[4];
    {
        bf16x8 bq = *(const bf16x8*)(Qt + (16 * w + fr) * GQROW + fg * 8);
#pragma unroll
        for (int mt = 0; mt < 4; ++mt) {
            bf16x8 a = *(const bf16x8*)(Kt + (16 * mt + fr) * GQROW + fg * 8);
            sc[mt] = __builtin_amdgcn_mfma_f32_16x16x32_bf16(a, bq, (f32x4){0.f, 0.f, 0.f, 0.f}, 0, 0, 0);
        }
        const int ii = 16 * w + fr;
#pragma unroll
        for (int mt = 0; mt < 4; ++mt)
#pragma unroll
            for (int r = 0; r < 4; ++r) { const int j = 16 * mt + 4 * fg + r; if (j > ii) sc[mt][r] = 0.f; }
    }
    {
        f32x4 o4[4]; zero4(o4);
#pragma unroll
        for (int kk = 0; kk < 2; ++kk) {
            u32x4 pb = {pk_bf16(sc[2 * kk][0], sc[2 * kk][1]), pk_bf16(sc[2 * kk][2], sc[2 * kk][3]), pk_bf16(sc[2 * kk + 1][0], sc[2 * kk + 1][1]), pk_bf16(sc[2 * kk + 1][2], sc[2 * kk + 1][3])};
#pragma unroll
            for (int mt = 0; mt < 4; ++mt) {
                uint2 v0 = *(const uint2*)(Vt + (16 * mt + fr) * LROW + 32 * kk + 4 * fg), v1 = *(const uint2*)(Vt + (16 * mt + fr) * LROW + 32 * kk + 16 + 4 * fg);
                u32x4 va = {v0.x, v0.y, v1.x, v1.y};
                o4[mt] = __builtin_amdgcn_mfma_f32_16x16x32_bf16(__builtin_bit_cast(bf16x8, va), __builtin_bit_cast(bf16x8, pb), o4[mt], 0, 0, 0);
            }
        }
        bf16_t* OL = (bf16_t*)(scr + SCR_GLA_OL) + (size_t)cid * 4096;
#pragma unroll
        for (int mt = 0; mt < 4; ++mt) store4_bf16(OL + (16 * w + fr) * 64 + 16 * mt + 4 * fg, o4[mt][0], o4[mt][1], o4[mt][2], o4[mt][3]);
    }
    {
        f32x4 k4[2] = {(f32x4){0.f, 0.f, 0.f, 0.f}, (f32x4){0.f, 0.f, 0.f, 0.f}};
#pragma unroll
        for (int ks = 0; ks < 2; ++ks) {
            bf16x8 bv = *(const bf16x8*)(Vt + (16 * w + fr) * LROW + ks * 32 + fg * 8);
#pragma unroll
            for (int mt = 0; mt < 2; ++mt) {
                bf16x8 a = *(const bf16x8*)(KLt + (16 * mt + fr) * LROW + ks * 32 + fg * 8);
                k4[mt] = __builtin_amdgcn_mfma_f32_16x16x32_bf16(a, bv, k4[mt], 0, 0, 0);
            }
        }
        float* KV = (float*)(scr + SCR_GLA_KV) + (size_t)cid * 2048;
#pragma unroll
        for (int mt = 0; mt < 2; ++mt) *(f32x4*)(KV + (16 * w + fr) * 32 + 16 * mt + 4 * fg) = k4[mt];
    }
}
__device__ void gla_scan_item(const Params& p, int g) {
    const int tid = ltid();
    const int bh = g >> 3, idx = (g & 7) * 256 + tid, d = idx & 31;
    char* scr = p.ws + WS_SCR;
    const float* __restrict__ KV = (const float*)(scr + SCR_GLA_KV) + (size_t)bh * 64 * 2048 + idx;
    const float* __restrict__ DL = (const float*)(scr + SCR_GLA_DL) + bh * 64 * 32 + d;
    bf16_t* __restrict__ SG = (bf16_t*)(scr + SCR_GLA_SG) + (size_t)bh * 64 * 2048 + idx;
    float S = 0.f;
    for (int n0 = 0; n0 < 64; n0 += 8) {
        float kv[8], dl[8];
#pragma unroll
        for (int u = 0; u < 8; ++u) { kv[u] = KV[(size_t)(n0 + u) * 2048]; dl[u] = DL[(n0 + u) * 32]; }
#pragma unroll
        for (int u = 0; u < 8; ++u) { SG[(size_t)(n0 + u) * 2048] = f2bf(S); S = dl[u] * S + kv[u]; }
    }
}
__device__ void gla_out_item(const Params& p, int l, int cid) {
    const int tid = ltid(), lane = tid & 63, w = tid >> 6, fr = lane & 15, fg = lane >> 4;
    const int bh = cid >> 6, n = cid & 63, b = bh / H_GLA, h = bh % H_GLA;
    char* scr = p.ws + WS_SCR;
    const bf16_t* SG = (const bf16_t*)(scr + SCR_GLA_SG) + (size_t)cid * 2048;
    const bf16_t* QB = (const bf16_t*)(scr + SCR_GLA_QB) + (size_t)cid * 2048;
    const bf16_t* OL = (const bf16_t*)(scr + SCR_GLA_OL) + (size_t)cid * 4096;
    const int i = 16 * w + fr; const int t = b * SEQ + n * 64 + i;
    f32x4 acc[4];
#pragma unroll
    for (int mt = 0; mt < 4; ++mt) { uint2 u = *(const uint2*)(OL + i * 64 + 16 * mt + 4 * fg); acc[mt] = (f32x4){bflo(u.x), bfhi(u.x), bflo(u.y), bfhi(u.y)}; }
    bf16x8 bq = *(const bf16x8*)(QB + i * 32 + fg * 8);
#pragma unroll
    for (int mt = 0; mt < 4; ++mt) {
        bf16x8 a = *(const bf16x8*)(SG + (16 * mt + fr) * 32 + fg * 8);
        acc[mt] = __builtin_amdgcn_mfma_f32_16x16x32_bf16(a, bq, acc[mt], 0, 0, 0);
    }
    float ss = 0.f;
#pragma unroll
    for (int mt = 0; mt < 4; ++mt)
#pragma unroll
        for (int r = 0; r < 4; ++r) ss += acc[mt][r] * acc[mt][r];
    ss += __shfl_xor(ss, 16, 64); ss += __shfl_xor(ss, 32, 64);
    const float rstd = rsqrtf(ss * (1.f / 64.f) + 1e-6f);
    const float* og = p.in[13] + l * 64;
    const bf16_t* rp = (const bf16_t*)(p.ws + WS_PROJ) + (size_t)t * NPROJ + NC_LR + h * 64;
    bf16_t* mp = (bf16_t*)(p.ws + WS_MIX) + (size_t)t * D_MODEL + 768 + h * 64;
#pragma unroll
    for (int mt = 0; mt < 4; ++mt) {
        const int e0 = 16 * mt + 4 * fg;
        uint2 gu = *(const uint2*)(rp + e0); f32x4 g4 = *(const f32x4*)(og + e0);
        store4_bf16(mp + e0, acc[mt][0] * rstd * g4[0] * bflo(gu.x), acc[mt][1] * rstd * g4[1] * bfhi(gu.x), acc[mt][2] * rstd * g4[2] * bflo(gu.y), acc[mt][3] * rstd * g4[3] * bfhi(gu.y));
    }
}
__device__ void phase_mixout(const Params& p, int l) {
    for (int it = blockIdx.x; it < NGDN_CH + NGLA_CH; it += gridDim.x) {
        if (it < NGDN_CH) { if (MIXSEL & 1) gdn_out_item(p, l, it); } else { if (MIXSEL & 2) gla_out_item(p, l, it - NGDN_CH); }
    }
}

__device__ void fox_cumsum_item(const Params& p, int l, int bh, float* ldsf) {
    const int tid = ltid(), lane = tid & 63, w = tid >> 6;
    const int b = bh / H_FOX, h = bh % H_FOX;
    const float* aux = (const float*)(p.ws + WS_AUX);
    float* cum = (float*)(p.ws + WS_CUM) + (size_t)bh * SEQ;
    const float fb = p.in[5][l * H_FOX + h];
    float v[16]; float s = 0.f;
#pragma unroll
    for (int i = 0; i < 16; ++i) { v[i] = logsigmoidf_(aux[(size_t)(b * SEQ + tid * 16 + i) * 64 + AX_FF + h] + fb); s += v[i]; }
    float inc = s;
#pragma unroll
    for (int o = 1; o < 64; o <<= 1) { float t = __shfl_up(inc, o, 64); if (lane >= o) inc += t; }
    __syncthreads();
    if (lane == 63) ldsf[w] = inc;
    __syncthreads();
    float base = inc - s;
    for (int ww = 0; ww < w; ++ww) base += ldsf[ww];
    float c = base;
    u32x4* csx = (u32x4*)(p.ws + WS_SCR + SCR_CSX) + (size_t)bh * SEQ;
#pragma unroll
    for (int i = 0; i < 16; ++i) {
        c += v[i]; cum[tid * 16 + i] = c;
        const float vv = 1.4426950408889634f * c;
        const unsigned hi = pk_bf16(vv, 0.f) & 0xffffu; const float r1 = vv - __uint_as_float(hi << 16);
        const unsigned mid = pk_bf16(r1, 0.f) & 0xffffu; const float r2 = r1 - __uint_as_float(mid << 16);
        const unsigned lo = pk_bf16(r2, 0.f) & 0xffffu;
        u32x4 f; f[0] = 0x3F803F80u; f[1] = 0x3F80u | ((hi ^ 0x8000u) << 16); f[2] = (mid ^ 0x8000u) | ((lo ^ 0x8000u) << 16); f[3] = 0u;
        csx[tid * 16 + i] = f;
    }
}
__device__ void phase_prep(const Params& p, int l, unsigned char* lds_raw) {
    const int n0 = BATCH * H_FOX, n1 = n0 + ((MIXSEL & 1) ? NGDN_CH : 0), n2 = n1 + ((MIXSEL & 2) ? NGLA_CH : 0);
    for (int it = blockIdx.x; it < n2; it += gridDim.x) {
        if (it < n0) { __syncthreads(); fox_cumsum_item(p, l, it, (float*)lds_raw); }
        else if (it < n1) gdn_prep_item(p, l, it - n0, lds_raw);
        else gla_prep_item(p, l, it - n1, lds_raw);
    }
}

typedef float f32x16 __attribute__((ext_vector_type(16)));
#define ATT_BUF 17408
#define ATT_THR 8.0f
#define ATT_NSTAGE 3
__device__ __forceinline__ void attn_issue(const bf16_t* const (&kp)[2], const bf16_t* const (&vp)[2], const bf16_t* cp, int s0, unsigned char* stage, int w) {
    bf16_t* Ks = (bf16_t*)stage; bf16_t* Vs = Ks + 4096; bf16_t* cs = Vs + 4096;
    __builtin_amdgcn_global_load_lds((const unsigned*)(kp[0] + (size_t)s0 * NPROJ), (unsigned*)(Ks + (w * 8) * 64), 16, 0, 0);
    __builtin_amdgcn_global_load_lds((const unsigned*)(kp[1] + (size_t)s0 * NPROJ), (unsigned*)(Ks + (32 + w * 8) * 64), 16, 0, 0);
    __builtin_amdgcn_global_load_lds((const unsigned*)(vp[0] + s0), (unsigned*)(Vs + (w * 8) * 64), 16, 0, 0);
    __builtin_amdgcn_global_load_lds((const unsigned*)(vp[1] + s0), (unsigned*)(Vs + (32 + w * 8) * 64), 16, 0, 0);
    __builtin_amdgcn_global_load_lds((const unsigned*)(cp + (size_t)s0 * 8), (unsigned*)cs, 16, 0, 0);
}
__device__ __forceinline__ bf16x8 attn_qbias(float u, int h) {
    const unsigned hi = pk_bf16(u, 0.f) & 0xffffu; const float r1 = u - __uint_as_float(hi << 16);
    const unsigned mid = pk_bf16(r1, 0.f) & 0xffffu; const float r2 = r1 - __uint_as_float(mid << 16);
    const unsigned lo = pk_bf16(r2, 0.f) & 0xffffu;
    u32x4 f; f[0] = hi | (mid << 16); f[1] = lo | (0x3F80u << 16); f[2] = 0x3F803F80u; f[3] = 0u;
    if (h) { f[0] = 0u; f[1] = 0u; f[2] = 0u; }
    return __builtin_bit_cast(bf16x8, f);
}
__device__ void fox_attn_item(const Params& p, int l, int bh, int qt, unsigned char* lds_raw) {
    const int tid = ltid(), lane = tid & 63, w = __builtin_amdgcn_readfirstlane(tid >> 6), r = lane & 31, h = lane >> 5;
    const int b = bh / H_FOX, hh = bh % H_FOX;
    const bf16_t* proj = (const bf16_t*)(p.ws + WS_PROJ);
    const bf16_t* kbase = proj + (size_t)b * SEQ * NPROJ + NC_FK + hh * 64;
    const bf16_t* vbase = (const bf16_t*)(p.ws + WS_VTF) + (size_t)bh * 64 * SEQ;
    const float* cum = (const float*)(p.ws + WS_CUM) + (size_t)bh * SEQ;
    const int qlo = qt * 128 + w * 32, q = qlo + r;
    bf16x8 qf[4];
    {
        const bf16_t* qrow = proj + (size_t)(b * SEQ + q) * NPROJ + NC_FQ + hh * 64;
#pragma unroll
        for (int kk = 0; kk < 4; ++kk) qf[kk] = *(const bf16x8*)(qrow + kk * 16 + h * 8);
    }
    const float cq2 = cum[q] * 1.4426950408889634f;
    float mref = 0.f;
    bf16x8 qx = attn_qbias(cq2 - mref, h);
    f32x16 o0, o1;
#pragma unroll
    for (int i = 0; i < 16; ++i) { o0[i] = 0.f; o1[i] = 0.f; }
    float lsum = 0.f;
    const int ntiles = 2 * qt + 2;
    const bf16_t* kp[2]; const bf16_t* vp[2];
    {
        const int row0 = w * 8 + (lane >> 3), pc = lane & 7;
        const int lc0 = (pc ^ ((row0 >> 1) & 7)) * 8;
        kp[0] = kbase + (size_t)row0 * NPROJ + lc0; kp[1] = kbase + (size_t)(row0 + 32) * NPROJ + lc0;
        vp[0] = vbase + (size_t)row0 * SEQ + lc0;   vp[1] = vbase + (size_t)(row0 + 32) * SEQ + lc0;
    }
    const bf16_t* cp = (const bf16_t*)(p.ws + WS_SCR + SCR_CSX) + (size_t)bh * SEQ * 8 + lane * 8;
    const int swr = (r >> 1) & 7;
    int jw;
    {
        float gq = fabsf(p.in[3][l * 64 + lane]), gk = fabsf(p.in[4][l * 64 + lane]);
#pragma unroll
        for (int o = 32; o > 0; o >>= 1) { gq = fmaxf(gq, __shfl_xor(gq, o, 64)); gk = fmaxf(gk, __shfl_xor(gk, o, 64)); }
        const float thr = 2.f * (1.4426950408889634f * 8.f * gq * gk) + 30.f;
        const float cw = cum[qlo] * 1.4426950408889634f;
        const float ce = (lane < ntiles) ? cum[64 * lane + 63] * 1.4426950408889634f : 0.f;
        const unsigned long long keep = __ballot((lane < ntiles) && (cw - ce >= -thr));
        jw = keep ? (__ffsll((long long)keep) - 1) : (ntiles - 1);
    }
    volatile int* jshare = (volatile int*)(lds_raw + ATT_NSTAGE * ATT_BUF + 16);
    asm volatile("s_waitcnt vmcnt(0)" ::: "memory");
    RAW_BARRIER();
    if (tid == 0) *jshare = jw;
    RAW_BARRIER();
    const int jstart = *jshare;
    attn_issue(kp, vp, cp, jstart * 64, lds_raw + (jstart % ATT_NSTAGE) * ATT_BUF, w);
    if (jstart + 1 < ntiles) attn_issue(kp, vp, cp, (jstart + 1) * 64, lds_raw + ((jstart + 1) % ATT_NSTAGE) * ATT_BUF, w);
    for (int j = jstart; j < ntiles; ++j) {
        if (j + 1 < ntiles) asm volatile("s_waitcnt vmcnt(5)" ::: "memory"); else asm volatile("s_waitcnt vmcnt(0)" ::: "memory");
        RAW_BARRIER();
        if (j + 2 < ntiles) attn_issue(kp, vp, cp, (j + 2) * 64, lds_raw + ((j + 2) % ATT_NSTAGE) * ATT_BUF, w);
        const int s0 = j * 64;
        if (s0 <= qlo + 31 && j >= jw) {
            const bf16_t* Ks = (const bf16_t*)(lds_raw + (j % ATT_NSTAGE) * ATT_BUF); const bf16_t* Vs = Ks + 4096; const bf16_t* cs = Vs + 4096;
            f32x16 st0, st1;
            {
                u32x4 z4 = {0u, 0u, 0u, 0u};
                u32x4 c0 = *(const u32x4*)(cs + r * 8), c1 = *(const u32x4*)(cs + (32 + r) * 8);
                if (h) { c0 = z4; c1 = z4; }
                f32x16 zz;
#pragma unroll
                for (int i = 0; i < 16; ++i) zz[i] = 0.f;
                st0 = __builtin_amdgcn_mfma_f32_32x32x16_bf16(__builtin_bit_cast(bf16x8, c0), qx, zz, 0, 0, 0);
                st1 = __builtin_amdgcn_mfma_f32_32x32x16_bf16(__builtin_bit_cast(bf16x8, c1), qx, zz, 0, 0, 0);
            }
#pragma unroll
            for (int kk = 0; kk < 4; ++kk) {
                const int co = ((kk * 2 + h) ^ swr) * 8;
                bf16x8 a0 = *(const bf16x8*)(Ks + r * 64 + co);
                bf16x8 a1 = *(const bf16x8*)(Ks + (32 + r) * 64 + co);
                st0 = __builtin_amdgcn_mfma_f32_32x32x16_bf16(a0, qf[kk], st0, 0, 0, 0);
                st1 = __builtin_amdgcn_mfma_f32_32x32x16_bf16(a1, qf[kk], st1, 0, 0, 0);
            }
            if (s0 + 63 > qlo) {
#pragma unroll
                for (int i = 0; i < 16; ++i) {
                    const int key = s0 + (i & 3) + 8 * (i >> 2) + 4 * h;
                    if (key > q) st0[i] = -1e30f;
                    if (key + 32 > q) st1[i] = -1e30f;
                }
            }
            float mx = fmaxf(st0[0], st1[0]);
#pragma unroll
            for (int i = 1; i < 16; ++i) mx = fmaxf(mx, fmaxf(st0[i], st1[i]));
            if (__any(mx > ATT_THR)) {
                const float mo = fmaxf(mx, __shfl_xor(mx, 32, 64));
                const float d = (mo > ATT_THR) ? mo : 0.f;
                const float alpha = __builtin_amdgcn_exp2f(-d);
#pragma unroll
                for (int i = 0; i < 16; ++i) { st0[i] -= d; st1[i] -= d; o0[i] *= alpha; o1[i] *= alpha; }
                lsum *= alpha; mref += d;
                qx = attn_qbias(cq2 - mref, h);
            }
            float rs = 0.f;
#pragma unroll
            for (int i = 0; i < 16; ++i) { st0[i] = __builtin_amdgcn_exp2f(st0[i]); st1[i] = __builtin_amdgcn_exp2f(st1[i]); rs += st0[i] + st1[i]; }
            lsum += rs;
            bf16x8 pf[2][2];
#pragma unroll
            for (int s = 0; s < 2; ++s) {
                u32x4 t0 = {pk_bf16(st0[8 * s], st0[8 * s + 1]), pk_bf16(st0[8 * s + 2], st0[8 * s + 3]), pk_bf16(st0[8 * s + 4], st0[8 * s + 5]), pk_bf16(st0[8 * s + 6], st0[8 * s + 7])};
                u32x4 t1 = {pk_bf16(st1[8 * s], st1[8 * s + 1]), pk_bf16(st1[8 * s + 2], st1[8 * s + 3]), pk_bf16(st1[8 * s + 4], st1[8 * s + 5]), pk_bf16(st1[8 * s + 6], st1[8 * s + 7])};
                pf[0][s] = __builtin_bit_cast(bf16x8, t0); pf[1][s] = __builtin_bit_cast(bf16x8, t1);
            }
#pragma unroll
            for (int mt = 0; mt < 2; ++mt)
#pragma unroll
                for (int s = 0; s < 2; ++s) {
                    const int c0 = 4 * mt + 2 * s;
                    const int oA = ((c0 ^ swr) * 8) + 4 * h, oB = (((c0 + 1) ^ swr) * 8) + 4 * h;
                    uint2 a00 = *(const uint2*)(Vs + r * 64 + oA), a01 = *(const uint2*)(Vs + r * 64 + oB);
                    uint2 a10 = *(const uint2*)(Vs + (32 + r) * 64 + oA), a11 = *(const uint2*)(Vs + (32 + r) * 64 + oB);
                    u32x4 u0 = {a00.x, a00.y, a01.x, a01.y}; u32x4 u1 = {a10.x, a10.y, a11.x, a11.y};
                    o0 = __builtin_amdgcn_mfma_f32_32x32x16_bf16(__builtin_bit_cast(bf16x8, u0), pf[mt][s], o0, 0, 0, 0);
                    o1 = __builtin_amdgcn_mfma_f32_32x32x16_bf16(__builtin_bit_cast(bf16x8, u1), pf[mt][s], o1, 0, 0, 0);
                }
        }
    }
    lsum += __shfl_xor(lsum, 32, 64);
    const float inv = 1.f / lsum;
    float ss = 0.f;
#pragma unroll
    for (int i = 0; i < 16; ++i) { o0[i] *= inv; o1[i] *= inv; ss += o0[i] * o0[i] + o1[i] * o1[i]; }
    ss += __shfl_xor(ss, 32, 64);
    const float rstd = rsqrtf(ss * (1.f / 64.f) + 1e-6f);
    const float* og = p.in[6] + l * 64;
    bf16_t* mrow = (bf16_t*)(p.ws + WS_MIX) + (size_t)(b * SEQ + q) * D_MODEL + hh * 64;
#pragma unroll
    for (int g = 0; g < 4; ++g) {
        const int e0 = 8 * g + 4 * h;
        f32x4 g0 = *(const f32x4*)(og + e0), g1 = *(const f32x4*)(og + 32 + e0);
        store4_bf16(mrow + e0, o0[4 * g] * rstd * g0[0], o0[4 * g + 1] * rstd * g0[1], o0[4 * g + 2] * rstd * g0[2], o0[4 * g + 3] * rstd * g0[3]);
        store4_bf16(mrow + 32 + e0, o1[4 * g] * rstd * g1[0], o1[4 * g + 1] * rstd * g1[1], o1[4 * g + 2] * rstd * g1[2], o1[4 * g + 3] * rstd * g1[3]);
    }
}
#define ATT_ITEMS (BATCH * H_FOX * (SEQ / 128))
__device__ void phase_scan_attn(const Params& p, int l, unsigned char* lds_raw, int rep = 0, int sel = 7) {
    unsigned* qctr = (unsigned*)(p.ws + WS_CTL) + CW_Q + l + 2 * rep;
    volatile int* slot = (volatile int*)(lds_raw + ATT_NSTAGE * ATT_BUF);
    for (;;) {
        __syncthreads();
        if (threadIdx.x == 0) *slot = (int)atomicAdd(qctr, 1u);
        __syncthreads();
        int it = *slot;
        const int ns0 = (MIXSEL & 1) ? BATCH * H_GDN : 0, ns1 = ns0 + ((MIXSEL & 2) ? 128 : 0);
        if (it >= ns1 + ATT_ITEMS) break;
        if (it < ns0) { if (sel & 1) gdn_scan_item(p, it, lds_raw); continue; }
        if (it < ns1) { if (sel & 2) gla_scan_item(p, it - ns0); continue; }
        it -= ns1;
        if (!(sel & 4)) continue;
        const int qt = (SEQ / 128 - 1) - it / (BATCH * H_FOX), bh = it % (BATCH * H_FOX);
        fox_attn_item(p, l, bh, qt, lds_raw);
    }
}

#define NPHASE 19
__global__ void __launch_bounds__(256, 2) mk(Params p, int lo, int hi, int use_bar) {
    __shared__ __attribute__((aligned(16))) unsigned char lds_raw[LDS_BYTES];
    bf16_t* lds = (bf16_t*)lds_raw;
    volatile LAS unsigned* st = (volatile LAS unsigned*)(lds_raw + LDS_BYTES - 16);
    XcdBarrier bar; bar.bar = (unsigned*)(p.ws + WS_CTL) + CW_BAR; bar.x = 0; bar.st = st;
    if (use_bar) {
        if (threadIdx.x == 0) { st[0] = 0u; st[1] = 0u; }
        __syncthreads();
        bar = xcd_barrier_post((unsigned*)(p.ws + WS_CTL) + CW_BAR, st);
    }
    for (int ph = lo; ph < hi; ++ph) {
#ifndef PSEL
#define PSEL 0xffff
#endif
        int phv = ph; asm volatile("" : "+s"(phv));
        Params q = p; asm volatile("" : "+s"(q.ws)); asm volatile("" : "+s"(q.out));
        if (phv == 0) { if (PSEL & 1) phase0(q); }
        else {
            int l = (phv - 1) / 9, s = (phv - 1) % 9;
            if (s == 0) { if (PSEL & 2) phase_inproj(q, l, lds); }
            else if (s == 1) { if (PSEL & 128) phase_prep(q, l, lds_raw); }
            else if (s == 2) { if (PSEL & 256) phase_scan_attn(q, l, lds_raw); }
            else if (s == 3) { if (PSEL & 512) phase_mixout(q, l); }
            else if (s == 4) { if (PSEL & 4) phase_outproj(q, l, lds); }
            else if (s == 5) { if (PSEL & 8) phase_route(q, l, lds); }
            else if (s == 6) { if (PSEL & 16) phase_expert<0>(q, l, lds); }
            else if (s == 7) { if (PSEL & 32) phase_expert<1>(q, l, lds); }
            else if (s == 8) { if (PSEL & 64) phase_combine(q, l); }
        }
#ifdef REPEAT_MASK
        {
            const int ty = (phv == 0) ? 9 : (phv - 1) % 9, l = (phv == 0) ? 0 : (phv - 1) / 9;
            const bool idem = !((ty == 4 && l == 1));
            if (((REPEAT_MASK >> ty) & 1) && idem && use_bar) {
                xcd_barrier(bar);
                if (ty == 9) phase0(q);
                else if (ty == 0) phase_inproj(q, l, lds, GVAR);
                else if (ty == 1) phase_prep(q, l, lds_raw);
                else if (ty == 2) phase_scan_attn(q, l, lds_raw, 1, P3SEL);
                else if (ty == 3) phase_mixout(q, l);
                else if (ty == 4) phase_outproj(q, l, lds);
                else if (ty == 5) phase_route(q, l, lds, 1);
                else if (ty == 8) phase_combine(q, l, 1);
                else if (ty == 6) phase_expert<0>(q, l, lds);
                else if (ty == 7) phase_expert<1>(q, l, lds);
            }
        }
#endif
        if (ph + 1 < hi) {
            if (hi > 1000) cg::this_grid().sync();
            xcd_barrier(bar);
        }
    }
}

extern "C" void kernel_launch(void* const* d_in, const int* in_sizes, int n_in,
                              void* d_out, int out_size, void* d_ws, size_t ws_size,
                              hipStream_t stream) {
    static int grid = 0;
    if (grid == 0) {
        if (ws_size < WS_END) { fprintf(stderr, "ws too small: need %zu have %zu\n", (size_t)WS_END, ws_size); grid = -1; return; }
        int dev = 0, cus = 0, per_cu = 0;
        hipGetDevice(&dev);
        hipDeviceGetAttribute(&cus, hipDeviceAttributeMultiprocessorCount, dev);
        hipOccupancyMaxActiveBlocksPerMultiprocessor(&per_cu, mk, 256, 0);
        if (per_cu > 2) per_cu = 2;
        if (per_cu < 1) { fprintf(stderr, "occupancy query failed\n"); grid = -1; return; }
        grid = cus * per_cu;
        grid -= grid % 8;
    }
    if (grid < 0) return;
    Params p{};
    for (int i = 0; i < 23; ++i) p.in[i] = (const float*)d_in[i];
    p.out = (float*)d_out; p.ws = (char*)d_ws;
    hipMemsetAsync((char*)d_ws + WS_CTL, 0, CTL_BYTES, stream);
#ifdef POISON_GLA
    hipMemsetAsync((char*)d_ws + WS_SCR + SCR_GLA_OL, 0xFF, SCR_LVT - SCR_GLA_OL, stream);
#endif

#ifdef MULTI_LAUNCH
    for (int ph = 0; ph < NPHASE; ++ph) mk<<<grid, 256, 0, stream>>>(p, ph, ph + 1, 0);
#else
    int lo = 0, hi = NPHASE, ub = 2;
    void* args[] = {&p, &lo, &hi, &ub};
    hipError_t e = hipLaunchCooperativeKernel((void*)mk, dim3(grid), dim3(256), args, 0, stream);
    if (e != hipSuccess) fprintf(stderr, "cooperative launch failed: %s (grid %d)\n", hipGetErrorString(e), grid);
#endif
}
```

```cpp
#include <hip/hip_runtime.h>
#include <hip/hip_cooperative_groups.h>
#include <cstdint>
#include <cstdio>
namespace cg = cooperative_groups;

#define D_MODEL 1024
#define BATCH 4
#define SEQ 4096
#define NTOK (BATCH * SEQ)
#define H_FOX 6
#define H_GDN 6
#define H_GLA 4
#define N_IN 3490
#define N_EXP 32
#define D_EXP 512
#define NPROJ 3456
#define NINP 3584

#define C_FF 1152
#define C_GQ 1158
#define C_GG 2310
#define C_GA 2694
#define C_GB 2700
#define C_LQ 2706
#define C_LA 3474
#define NC_FQ 0
#define NC_FK 384
#define NC_FV 768
#define NC_GQ 1152
#define NC_GK 1536
#define NC_GV 1920
#define NC_GG 2304
#define NC_LQ 2688
#define NC_LK 2816
#define NC_LV 2944
#define NC_LR 3200
#define AX_FF 0
#define AX_GA 6
#define AX_GB 12
#define AX_LA 18

#ifndef P3SEL
#define P3SEL 7
#endif
#ifndef GVAR
#define GVAR 0
#endif
#ifndef MIXSEL
#define MIXSEL 3
#endif
typedef unsigned short bf16_t;
typedef short bf16x8 __attribute__((ext_vector_type(8)));
typedef float f32x4 __attribute__((ext_vector_type(4)));
typedef unsigned u32x4 __attribute__((ext_vector_type(4)));

#define WS_CTL      0
#define CTL_BYTES   65536
#define WS_WIN      (WS_CTL + CTL_BYTES)
#define WS_WOUT     (WS_WIN + (size_t)2 * NINP * 1024 * 2)
#define WS_WGU      (WS_WOUT + (size_t)2 * 1024 * 1024 * 2)
#define WS_WD       (WS_WGU + (size_t)2 * 32 * 1024 * 1024 * 2)
#define WS_WR       (WS_WD + (size_t)2 * 32 * 1024 * 512 * 2)
#define WS_HN       (WS_WR + (size_t)2 * 64 * 1024 * 2)
#define WS_PROJ     (WS_HN + (size_t)NTOK * 1024 * 2)
#define WS_VTF      (WS_PROJ + (size_t)NTOK * NPROJ * 2)
#define WS_AUX      (WS_VTF + (size_t)BATCH * H_FOX * 64 * SEQ * 2)
#define WS_CUM      (WS_AUX + (size_t)NTOK * 64 * 4)
#define WS_MIX      (WS_CUM + (size_t)BATCH * H_FOX * SEQ * 4)
#define WS_ROWTOK   (WS_MIX + (size_t)NTOK * 1024 * 2)
#define WS_TSLOT    (WS_ROWTOK + (size_t)32 * NTOK * 4)
#define WS_TGATE    (WS_TSLOT + (size_t)NTOK * 2 * 4)
#define WS_SCR      (WS_TGATE + (size_t)NTOK * 2 * 4)
#define SCR_BYTES   ((size_t)100 * 1024 * 1024)
#define WS_END      (WS_SCR + SCR_BYTES)
#define HROWS       (2 * NTOK + 32 * 128)
#define WS_H        WS_PROJ
#define WS_Y        (WS_PROJ + (size_t)HROWS * 512 * 2)

#define NGDN_CH 1536
#define NGLA_CH 1024
#define SCR_GDN_MP   ((size_t)0)
#define SCR_GDN_NN   (SCR_GDN_MP + (size_t)NGDN_CH * 8192)
#define SCR_GDN_P    (SCR_GDN_NN + (size_t)NGDN_CH * 8192)
#define SCR_GDN_OL   (SCR_GDN_P  + (size_t)NGDN_CH * 8192)
#define SCR_GDN_SG   (SCR_GDN_OL + (size_t)NGDN_CH * 8192)
#define SCR_GDN_LAST (SCR_GDN_SG + (size_t)NGDN_CH * 8192)
#define SCR_GLA_OL   (SCR_GDN_LAST + (size_t)NGDN_CH * 4)
#define SCR_GLA_KV   (SCR_GLA_OL + (size_t)NGLA_CH * 8192)
#define SCR_GLA_QB   (SCR_GLA_KV + (size_t)NGLA_CH * 8192)
#define SCR_GLA_SG   (SCR_GLA_QB + (size_t)NGLA_CH * 4096)
#define SCR_GLA_DL   (SCR_GLA_SG + (size_t)NGLA_CH * 4096)
#define SCR_LVT      (SCR_GLA_DL + (size_t)NGLA_CH * 128)
#define SCR_USED     (SCR_LVT + (size_t)BATCH * H_GLA * 64 * SEQ * 2)
#define SCR_CSX      SCR_USED
static_assert(SCR_CSX + (size_t)BATCH * H_FOX * SEQ * 16 <= SCR_BYTES, "scratch overflow");
#define CW_BAR      0
#define CW_CNT      4096
#define CW_Q        4224

struct Params {
    const float* in[23];
    float* out;
    char* ws;
};

__device__ __forceinline__ float sigmoidf_(float x) { return 1.f / (1.f + __expf(-x)); }
__device__ __forceinline__ float siluf_(float x) { return x / (1.f + __expf(-x)); }
__device__ __forceinline__ float softplusf_(float x) { return x > 20.f ? x : log1pf(__expf(x)); }
__device__ __forceinline__ float logsigmoidf_(float x) { return -softplusf_(-x); }
__device__ __forceinline__ float wave_sum(float v) {
#pragma unroll
    for (int o = 32; o > 0; o >>= 1) v += __shfl_xor(v, o, 64);
    return v;
}
__device__ __forceinline__ int ltid() { int t = threadIdx.x; asm volatile("" : "+v"(t)); return t; }
typedef __bf16 bf16x2_t __attribute__((ext_vector_type(2)));
typedef float f32x2_t __attribute__((ext_vector_type(2)));
__device__ __forceinline__ unsigned pk_bf16(float lo, float hi) { f32x2_t v = {lo, hi}; bf16x2_t r = __builtin_convertvector(v, bf16x2_t); return __builtin_bit_cast(unsigned, r); }
__device__ __forceinline__ size_t pl_off(int row, int k, int K) { return (size_t)(row >> 1) * (size_t)(2 * K) + (size_t)((k >> 5) * 64 + (row & 1) * 32 + (k & 31)); }
__device__ __forceinline__ unsigned ld_u32_agent(const unsigned* p) { return __hip_atomic_load(p, __ATOMIC_RELAXED, __HIP_MEMORY_SCOPE_AGENT); }
__device__ __forceinline__ float ld_f32_agent(const float* p) { return __uint_as_float(__hip_atomic_load((const unsigned*)p, __ATOMIC_RELAXED, __HIP_MEMORY_SCOPE_AGENT)); }
__device__ __forceinline__ float bf2f(bf16_t v) { return __uint_as_float((unsigned)v << 16); }
__device__ __forceinline__ float bflo(unsigned v) { return __uint_as_float(v << 16); }
__device__ __forceinline__ float bfhi(unsigned v) { return __uint_as_float(v & 0xffff0000u); }

#define XB_TMO      128
#define XB_XCNT(j)  (256  + 64 * (j))
#define XB_XSUB(j)  (1280 + 64 * (j))
#define XB_XGEN(j)  (2304 + 64 * (j))
#define XB_TOP      3328
#define XB_TOPGEN   3392
#define XCD_BAR_WORDS 3456
#define XB_SPIN_CAP (1u << 22)
#define LAS __attribute__((address_space(3)))
__device__ __forceinline__ unsigned xb_ld(unsigned* p)              { return __hip_atomic_load(p, __ATOMIC_RELAXED, __HIP_MEMORY_SCOPE_AGENT); }
__device__ __forceinline__ unsigned xb_add(unsigned* p, unsigned v) { return __hip_atomic_fetch_add(p, v, __ATOMIC_RELAXED, __HIP_MEMORY_SCOPE_AGENT); }
__device__ __forceinline__ unsigned xb_xcc_id() { return (unsigned)__builtin_amdgcn_s_getreg((3 << 11) | 20) & 0xFu; }
#define XB_SPIN(cond, bar) do { unsigned _sp = 0; while (cond) { __builtin_amdgcn_s_sleep(1); \
    if ((++_sp & 255u) == 0u) { if (xb_ld(&(bar)[XB_TMO])) break; if (_sp > XB_SPIN_CAP) { atomicAdd(&(bar)[XB_TMO], 1u); break; } } } } while (0)
struct XcdBarrier { unsigned* bar; unsigned x; volatile LAS unsigned* st; };
__device__ __forceinline__ XcdBarrier xcd_barrier_post(unsigned* bar, volatile LAS unsigned* st) {
    XcdBarrier b; b.bar = bar; b.x = xb_xcc_id(); b.st = st;
    if (threadIdx.x == 0) (void)xb_add(&bar[XB_XCNT(b.x)], 1u);
    return b;
}
__device__ __forceinline__ void xcd_barrier_complete(unsigned* bar, unsigned x, unsigned& nloc, unsigned& nx) {
    const unsigned G = gridDim.x * gridDim.y * gridDim.z;
    unsigned sum, cnt, mine, sp = 0u;
    for (;;) {
        sum = 0u; cnt = 0u; mine = 0u;
#pragma unroll
        for (unsigned j = 0; j < 16; ++j) { const unsigned c = xb_ld(&bar[XB_XCNT(j)]); sum += c; cnt += (c > 0u) ? 1u : 0u; mine = (j == x) ? c : mine; }
        if (sum == G) break;
        __builtin_amdgcn_s_sleep(1);
        if ((++sp & 255u) == 0u) { if (xb_ld(&bar[XB_TMO])) break; if (sp > XB_SPIN_CAP) { atomicAdd(&bar[XB_TMO], 1u); break; } }
    }
    nloc = mine > 0u ? mine : 1u; nx = cnt > 0u ? cnt : 1u;
}
__device__ __forceinline__ void xcd_barrier(const XcdBarrier& b) {
    asm volatile("s_waitcnt vmcnt(0)" ::: "memory");
    __syncthreads();
    if (threadIdx.x == 0) {
        unsigned* bar = b.bar;
        __builtin_amdgcn_s_waitcnt(0);
        unsigned nloc = b.st[0], nx = b.st[1];
        if (nloc == 0u) { xcd_barrier_complete(bar, b.x, nloc, nx); b.st[0] = nloc; b.st[1] = nx; }
        const unsigned old = xb_add(&bar[XB_XSUB(b.x)], 1u);
        const unsigned gen = old / nloc;
        if (old + 1u == (gen + 1u) * nloc) {
            __builtin_amdgcn_fence(__ATOMIC_RELEASE, "agent");
            asm volatile("s_waitcnt vmcnt(0)" ::: "memory");
            const unsigned og = xb_add(&bar[XB_TOP], 1u);
            const unsigned tg = og / nx;
            if (og + 1u == (tg + 1u) * nx) xb_add(&bar[XB_TOPGEN], 1u);
            else XB_SPIN(xb_ld(&bar[XB_TOPGEN]) == tg, bar);
            __builtin_amdgcn_fence(__ATOMIC_ACQUIRE, "agent");
            xb_add(&bar[XB_XGEN(b.x)], 1u);
            asm volatile("s_waitcnt vmcnt(0)" ::: "memory");
        } else {
            XB_SPIN(xb_ld(&bar[XB_XGEN(b.x)]) == gen, bar);
            __builtin_amdgcn_fence(__ATOMIC_ACQUIRE, "agent");
            asm volatile("s_waitcnt vmcnt(0)" ::: "memory");
        }
    }
    __syncthreads();
}

#define LDS_BYTES 66560
#define LROW 72

__device__ __forceinline__ int inproj_map(int n) {
    if (n < 1152) return n;
    if (n < 2304) return C_GQ + (n - 1152);
    if (n < 2688) return C_GG + (n - 2304);
    if (n < 3456) return C_LQ + (n - 2688);
    if (n < 3462) return C_FF + (n - 3456);
    if (n < 3468) return C_GA + (n - 3462);
    if (n < 3474) return C_GB + (n - 3468);
    if (n < 3490) return n;
    return -1;
}
__device__ __forceinline__ void conv_tile(const float* __restrict__ src, int ld, int col, bf16_t* __restrict__ dst_k0, int k0) {
    float v[16];
    if (col >= 0) {
#pragma unroll
        for (int i = 0; i < 16; ++i) v[i] = src[(size_t)(k0 + i) * ld + col];
    } else {
#pragma unroll
        for (int i = 0; i < 16; ++i) v[i] = 0.f;
    }
    uint4 o0, o1;
    o0.x = pk_bf16(v[0], v[1]); o0.y = pk_bf16(v[2], v[3]); o0.z = pk_bf16(v[4], v[5]); o0.w = pk_bf16(v[6], v[7]);
    o1.x = pk_bf16(v[8], v[9]); o1.y = pk_bf16(v[10], v[11]); o1.z = pk_bf16(v[12], v[13]); o1.w = pk_bf16(v[14], v[15]);
    *(uint4*)(dst_k0) = o0;
    *(uint4*)(dst_k0 + 8) = o1;
}
#define P0_T_IN   (56 * 16)
#define P0_T_OUT  (16 * 16)
#define P0_T_GU   (32 * 16 * 16)
#define P0_T_D    (32 * 16 * 8)
#define P0_T_R    (16)
#define P0_T_LAYER (P0_T_IN + P0_T_OUT + P0_T_GU + P0_T_D + P0_T_R)
#define P0_T_NORM (NTOK / 4)
__device__ __forceinline__ void conv_job(const Params& p, int l, int j, int tid) {
    const int nl = tid & 63, kg = tid >> 6;
    if (j < P0_T_IN) {
        int tn = j / 16, tk = j % 16; int n = tn * 64 + nl;
        conv_tile(p.in[2] + (size_t)l * 1024 * N_IN, N_IN, inproj_map(n), (bf16_t*)(p.ws + WS_WIN) + (size_t)l * NINP * 1024 + pl_off(n, tk * 64 + kg * 16, 1024), tk * 64 + kg * 16);
        return;
    }
    j -= P0_T_IN;
    if (j < P0_T_OUT) {
        int tn = j / 16, tk = j % 16; int n = tn * 64 + nl;
        conv_tile(p.in[14] + (size_t)l * 1024 * 1024, 1024, n, (bf16_t*)(p.ws + WS_WOUT) + (size_t)l * 1024 * 1024 + pl_off(n, tk * 64 + kg * 16, 1024), tk * 64 + kg * 16);
        return;
    }
    j -= P0_T_OUT;
    if (j < P0_T_GU) {
        int e = j / 256, r = j % 256; int tn = r / 16, tk = r % 16; int n = tn * 64 + nl;
        int t128 = n >> 7, wx = (n >> 6) & 1, half = (n >> 5) & 1, jj = n & 31;
        int hid = t128 * 64 + wx * 32 + jj;
        const float* src = (half ? p.in[21] : p.in[20]) + ((size_t)l * 32 + e) * 1024 * 512;
        conv_tile(src, 512, hid, (bf16_t*)(p.ws + WS_WGU) + ((size_t)l * 32 + e) * 1024 * 1024 + pl_off(n, tk * 64 + kg * 16, 1024), tk * 64 + kg * 16);
        return;
    }
    j -= P0_T_GU;
    if (j < P0_T_D) {
        int e = j / 128, r = j % 128; int tn = r / 8, tk = r % 8; int n = tn * 64 + nl;
        const float* src = p.in[22] + ((size_t)l * 32 + e) * 512 * 1024;
        conv_tile(src, 1024, n, (bf16_t*)(p.ws + WS_WD) + ((size_t)l * 32 + e) * 1024 * 512 + pl_off(n, tk * 64 + kg * 16, 512), tk * 64 + kg * 16);
        return;
    }
    j -= P0_T_D;
    {
        int tk = j; int n = nl;
        const float* src; int ld, col;
        if (n < 4) { src = p.in[16] + (size_t)l * 1024 * 4; ld = 4; col = n; }
        else if (n < 36) { src = p.in[18] + (size_t)l * 1024 * 32; ld = 32; col = n - 4; }
        else { src = p.in[16]; ld = 4; col = -1; }
        conv_tile(src, ld, col, (bf16_t*)(p.ws + WS_WR) + ((size_t)l * 64 + n) * 1024 + tk * 64 + kg * 16, tk * 64 + kg * 16);
    }
}
#define CONV_REST (P0_T_LAYER - P0_T_IN)
__device__ __forceinline__ void conv_fold(const Params& p, int l, int idx, int tid) {
    if (idx < CONV_REST) conv_job(p, l, P0_T_IN + idx, tid);
    else if (l == 0 && idx < CONV_REST + P0_T_IN) conv_job(p, 1, idx - CONV_REST, tid);
}
__device__ void phase0(const Params& p) {
    const int tid = ltid(), nl = tid & 63, kg = tid >> 6;
    const int total = P0_T_IN + P0_T_NORM;
    for (int it = blockIdx.x; it < total; it += gridDim.x) {
        if (it >= P0_T_IN) {
            int row = (it - P0_T_IN) * 4 + kg;
            const float* xr = p.in[0] + (size_t)row * D_MODEL + nl * 16;
            const float* gr = p.in[1] + nl * 16;
            float v[16]; float ss = 0.f;
#pragma unroll
            for (int i = 0; i < 4; ++i) { float4 t = *(const float4*)(xr + 4 * i); v[4 * i] = t.x; v[4 * i + 1] = t.y; v[4 * i + 2] = t.z; v[4 * i + 3] = t.w; }
#pragma unroll
            for (int i = 0; i < 16; ++i) ss += v[i] * v[i];
            ss = wave_sum(ss);
            float r = rsqrtf(ss / D_MODEL + 1e-6f);
#pragma unroll
            for (int i = 0; i < 16; ++i) v[i] = v[i] * r * gr[i];
            uint4 o0, o1;
            o0.x = pk_bf16(v[0], v[1]); o0.y = pk_bf16(v[2], v[3]); o0.z = pk_bf16(v[4], v[5]); o0.w = pk_bf16(v[6], v[7]);
            o1.x = pk_bf16(v[8], v[9]); o1.y = pk_bf16(v[10], v[11]); o1.z = pk_bf16(v[12], v[13]); o1.w = pk_bf16(v[14], v[15]);
            bf16_t* hr = (bf16_t*)(p.ws + WS_HN) + pl_off(row, nl * 16, 1024);
            *(uint4*)hr = o0; *(uint4*)(hr + 8) = o1;
            continue;
        }
        conv_job(p, 0, it, tid);
    }
}

#define GSTAGE 8192
#define RAW_BARRIER() do { asm volatile("s_waitcnt lgkmcnt(0)" ::: "memory"); __builtin_amdgcn_s_barrier(); } while (0)
__device__ __forceinline__ int gswz(int row) { return (0x1320 >> (((row >> 2) & 3) * 4)) & 3; }
__device__ __forceinline__ void gemm_issue(const bf16_t* const (&px)[2], const bf16_t* const (&py)[2], int k0, bf16_t* stage, int w) {
    __builtin_amdgcn_global_load_lds((const unsigned*)(px[0] + 2 * k0), (unsigned*)(stage + (w * 16) * 32), 16, 0, 0);
    __builtin_amdgcn_global_load_lds((const unsigned*)(px[1] + 2 * k0), (unsigned*)(stage + (64 + w * 16) * 32), 16, 0, 0);
    __builtin_amdgcn_global_load_lds((const unsigned*)(py[0] + 2 * k0), (unsigned*)(stage + 4096 + (w * 16) * 32), 16, 0, 0);
    __builtin_amdgcn_global_load_lds((const unsigned*)(py[1] + 2 * k0), (unsigned*)(stage + 4096 + (64 + w * 16) * 32), 16, 0, 0);
}
__device__ __forceinline__ void gemm_compute(const bf16_t* stage, int wx, int wy, int fr, int fg, f32x4 (&acc)[4][4]) {
    const int co = (fg ^ gswz(fr)) * 8;
    bf16x8 xa[4], yb[4];
#pragma unroll
    for (int m = 0; m < 4; ++m) xa[m] = *(const bf16x8*)(stage + (wx * 64 + m * 16 + fr) * 32 + co);
#pragma unroll
    for (int n = 0; n < 4; ++n) yb[n] = *(const bf16x8*)(stage + 4096 + (wy * 64 + n * 16 + fr) * 32 + co);
#pragma unroll
    for (int m = 0; m < 4; ++m)
#pragma unroll
        for (int n = 0; n < 4; ++n) acc[m][n] = __builtin_amdgcn_mfma_f32_16x16x32_bf16(xa[m], yb[n], acc[m][n], 0, 0, 0);
}
template <class FX, class FY>
__device__ __forceinline__ void gemm_core(FX rowx, FY rowy, int K, bf16_t* lds, f32x4 (&acc)[4][4], int gvar = 0) {
    const int tid = ltid(), lane = tid & 63, w = __builtin_amdgcn_readfirstlane(tid >> 6), wx = w >> 1, wy = w & 1, fr = lane & 15, fg = lane >> 4;
#pragma unroll
    for (int a = 0; a < 4; ++a)
#pragma unroll
        for (int b = 0; b < 4; ++b) acc[a][b] = (f32x4){0.f, 0.f, 0.f, 0.f};
    const bf16_t* px[2]; const bf16_t* py[2];
    {
        const int r0 = w * 16 + (lane >> 2), pc = lane & 3;
        const int lc0 = (pc ^ gswz(r0)) * 8;
        px[0] = rowx(r0) + lc0; px[1] = rowx(r0 + 64) + lc0;
        py[0] = rowy(r0) + lc0; py[1] = rowy(r0 + 64) + lc0;
    }
    const int nt = K >> 5;
    RAW_BARRIER();
    if (gvar != 3) {
    gemm_issue(px, py, 0, lds, w);
    gemm_issue(px, py, 32, lds + GSTAGE, w);
    gemm_issue(px, py, 64, lds + 2 * GSTAGE, w);
    }
    for (int j = 0; j < nt; ++j) {
        if (j + 2 < nt) asm volatile("s_waitcnt vmcnt(8)" ::: "memory");
        else if (j + 1 < nt) asm volatile("s_waitcnt vmcnt(4)" ::: "memory");
        else asm volatile("s_waitcnt vmcnt(0)" ::: "memory");
        RAW_BARRIER();
        if (j + 3 < nt && gvar != 3) gemm_issue(px, py, (j + 3) * 32, lds + ((j + 3) & 3) * GSTAGE, w);
        if (gvar != 2) gemm_compute(lds + (j & 3) * GSTAGE, wx, wy, fr, fg, acc);
    }
}
__device__ __forceinline__ void store4_bf16(bf16_t* p, float a, float b, float c, float d) {
    uint2 o; o.x = pk_bf16(a, b); o.y = pk_bf16(c, d); *(uint2*)p = o;
}
template <int NC> __device__ __forceinline__ void ep_put(bf16_t* T, int row, int col, float a, float b, float c, float d) {
    uint2 o; o.x = pk_bf16(a, b); o.y = pk_bf16(c, d); *(uint2*)(T + row * (NC + 8) + col) = o;
}
template <int NC, class FD> __device__ __forceinline__ void ep_flush(const bf16_t* T, int tid, FD dst) {
    constexpr int CPR = NC / 8;
#pragma unroll
    for (int i = 0; i < NC / 16; ++i) {
        const int c = tid + 256 * i; const int row = c / CPR, ch = c % CPR;
        *(u32x4*)(dst(row, ch)) = *(const u32x4*)(T + row * (NC + 8) + ch * 8);
    }
}

__device__ __forceinline__ bool xcd_item(int round, int ntm, int ntn, int& tm, int& tn) {
    const int x = blockIdx.x & 7, loc = blockIdx.x >> 3, nloc = gridDim.x >> 3;
    const int tmx = ntm >> 3;
    const int j = round * nloc + loc;
    if (j >= tmx * ntn) return false;
    tn = j / tmx; tm = (j % tmx) * 8 + x;
    return true;
}

__device__ void phase_inproj(const Params& p, int l, bf16_t* lds, int gvar = 0) {
    const int tid = ltid(), lane = tid & 63, w = tid >> 6, wx = w >> 1, wy = w & 1, fr = lane & 15, fg = lane >> 4;
    const bf16_t* hn = (const bf16_t*)(p.ws + WS_HN);
    const bf16_t* wt = (const bf16_t*)(p.ws + WS_WIN) + (size_t)l * NINP * 1024;
    bf16_t* proj = (bf16_t*)(p.ws + WS_PROJ);
    bf16_t* vtf = (bf16_t*)(p.ws + WS_VTF);
    float* aux = (float*)(p.ws + WS_AUX);
    const float* qg = p.in[3] + l * 64; const float* kg = p.in[4] + l * 64;
    for (int round = 0;; ++round) {
        int tm, tn;
        if (!xcd_item(round, NTOK / 128, NINP / 128, tm, tn)) break;
        const bool vt = (tn >= 6 && tn < 9) || tn == 23 || tn == 24;
        f32x4 acc[4][4];
        {
            auto rw = [&](int r) { return wt + pl_off(tn * 128 + r, 0, 1024); };
            auto rt_ = [&](int r) { return hn + pl_off(tm * 128 + r, 0, 1024); };
            if (vt) gemm_core(rt_, rw, 1024, lds, acc, gvar); else gemm_core(rw, rt_, 1024, lds, acc, gvar);
        }
        if (gvar == 0) {
#pragma unroll 1
            for (int c = 0; c < 4; ++c) conv_fold(p, l, (round * 4 + c) * (int)gridDim.x + (int)blockIdx.x, tid);
        }
        if (gvar != 0 && acc[0][0][0] != 123456.789f) continue;
        if (tn == 27) {
#pragma unroll
            for (int n = 0; n < 4; ++n) {
                int t = tm * 128 + wy * 64 + n * 16 + fr;
#pragma unroll
                for (int m = 0; m < 4; ++m) {
                    int c = wx * 64 + m * 16 + 4 * fg;
                    if (c < 64) *(float4*)(aux + (size_t)t * 64 + c) = make_float4(acc[m][n][0], acc[m][n][1], acc[m][n][2], acc[m][n][3]);
                }
            }
            continue;
        }
        RAW_BARRIER();
        if (vt) {
#pragma unroll
            for (int n = 0; n < 4; ++n)
#pragma unroll
                for (int m = 0; m < 4; ++m) ep_put<128>(lds, wy * 64 + n * 16 + fr, wx * 64 + m * 16 + 4 * fg, acc[m][n][0], acc[m][n][1], acc[m][n][2], acc[m][n][3]);
            RAW_BARRIER();
            const bool fox = tn < 9;
            bf16_t* dstb = fox ? vtf : (bf16_t*)(p.ws + WS_SCR + SCR_LVT); const int nh = fox ? H_FOX : H_GLA;
            const int t0 = tm * 128, b = t0 / SEQ, s0 = t0 % SEQ, chb = tn * 128 - (fox ? NC_FV : NC_LV);
            ep_flush<128>(lds, tid, [&](int row, int c8) { const int ch = chb + row; return dstb + ((size_t)(b * nh + (ch >> 6)) * 64 + (ch & 63)) * SEQ + s0 + c8 * 8; });
        } else {
            if (tn < 6) {
                const float* gn = (tn < 3) ? qg : kg; const float sc = (tn < 3) ? 0.125f * 1.4426950408889634f : 1.f;
                float g[4][4];
#pragma unroll
                for (int m = 0; m < 4; ++m)
#pragma unroll
                    for (int r = 0; r < 4; ++r) g[m][r] = gn[m * 16 + 4 * fg + r] * sc;
#pragma unroll
                for (int n = 0; n < 4; ++n) {
                    float ss = 0.f;
#pragma unroll
                    for (int m = 0; m < 4; ++m)
#pragma unroll
                        for (int r = 0; r < 4; ++r) ss += acc[m][n][r] * acc[m][n][r];
                    ss += __shfl_xor(ss, 16, 64); ss += __shfl_xor(ss, 32, 64);
                    float rs = rsqrtf(ss * (1.f / 64.f) + 1e-6f);
#pragma unroll
                    for (int m = 0; m < 4; ++m)
                        ep_put<128>(lds, wy * 64 + n * 16 + fr, wx * 64 + m * 16 + 4 * fg, acc[m][n][0] * rs * g[m][0], acc[m][n][1] * rs * g[m][1], acc[m][n][2] * rs * g[m][2], acc[m][n][3] * rs * g[m][3]);
                }
            } else {
                const bool do_silu = (tn >= 18 && tn < 21) || (tn >= 25);
                const float sc = (tn == 21) ? 0.17677669529663687f : 1.f;
#pragma unroll
                for (int n = 0; n < 4; ++n)
#pragma unroll
                    for (int m = 0; m < 4; ++m) {
                        float v0 = acc[m][n][0] * sc, v1 = acc[m][n][1] * sc, v2 = acc[m][n][2] * sc, v3 = acc[m][n][3] * sc;
                        if (do_silu) { v0 = siluf_(v0); v1 = siluf_(v1); v2 = siluf_(v2); v3 = siluf_(v3); }
                        ep_put<128>(lds, wy * 64 + n * 16 + fr, wx * 64 + m * 16 + 4 * fg, v0, v1, v2, v3);
                    }
            }
            RAW_BARRIER();
            bf16_t* dstb = proj + (size_t)(tm * 128) * NPROJ + tn * 128;
            ep_flush<128>(lds, tid, [&](int row, int c8) { return dstb + (size_t)row * NPROJ + c8 * 8; });
        }
    }
}

__device__ void phase_outproj(const Params& p, int l, bf16_t* lds) {
    const int tid = ltid(), lane = tid & 63, w = tid >> 6, wx = w >> 1, wy = w & 1, fr = lane & 15, fg = lane >> 4;
    const bf16_t* mix = (const bf16_t*)(p.ws + WS_MIX);
    const bf16_t* wt = (const bf16_t*)(p.ws + WS_WOUT) + (size_t)l * 1024 * 1024;
    const float* xin = (l == 0) ? p.in[0] : p.out;
    float* xo = p.out;
    for (int round = 0;; ++round) {
        int tm, tn;
        if (!xcd_item(round, NTOK / 128, 8, tm, tn)) break;
        f32x4 acc[4][4];
        {
            auto rw = [&](int r) { return wt + pl_off(tn * 128 + r, 0, 1024); };
            auto rt_ = [&](int r) { return mix + pl_off(tm * 128 + r, 0, 1024); };
            gemm_core(rw, rt_, 1024, lds, acc);
        }
#pragma unroll
        for (int n = 0; n < 4; ++n) {
            int t = tm * 128 + wy * 64 + n * 16 + fr;
#pragma unroll
            for (int m = 0; m < 4; ++m) {
                int c = tn * 128 + wx * 64 + m * 16 + 4 * fg;
                float4 xv = *(const float4*)(xin + (size_t)t * 1024 + c);
                xv.x += acc[m][n][0]; xv.y += acc[m][n][1]; xv.z += acc[m][n][2]; xv.w += acc[m][n][3];
                *(float4*)(xo + (size_t)t * 1024 + c) = xv;
            }
        }
    }
}

__device__ void phase_route(const Params& p, int l, bf16_t* lds, int dry = 0) {
    const int tid = ltid(), lane = tid & 63, w = tid >> 6, fr = lane & 15, fg = lane >> 4;
    const float* x1 = p.out;
    const float* gain = p.in[15] + l * 1024;
    bf16_t* hn = dry ? (bf16_t*)(p.ws + WS_SCR) : (bf16_t*)(p.ws + WS_HN);
    const bf16_t* wr = (const bf16_t*)(p.ws + WS_WR) + (size_t)l * 64 * 1024;
    const float* brg = p.in[17] + l * 4; const float* bre = p.in[19] + l * 32;
    unsigned* cnt = (unsigned*)(p.ws + WS_CTL) + CW_CNT + l * 32;
    int* rowtok = (int*)(p.ws + WS_ROWTOK);
    int* tslot = (int*)(p.ws + WS_TSLOT);
    float* tgate = (float*)(p.ws + WS_TGATE);
    const int HL = 1032;
    float* red = (float*)(lds + 16 * HL);
    for (int it = blockIdx.x; it < NTOK / 16; it += gridDim.x) {
        __syncthreads();
#pragma unroll
        for (int rr = 0; rr < 4; ++rr) {
            int lr = w * 4 + rr; int t = it * 16 + lr;
            const float* xr = x1 + (size_t)t * 1024 + lane * 16;
            float v[16]; float ss = 0.f;
#pragma unroll
            for (int i = 0; i < 4; ++i) { float4 q = *(const float4*)(xr + 4 * i); v[4 * i] = q.x; v[4 * i + 1] = q.y; v[4 * i + 2] = q.z; v[4 * i + 3] = q.w; }
#pragma unroll
            for (int i = 0; i < 16; ++i) ss += v[i] * v[i];
            ss = wave_sum(ss);
            float r = rsqrtf(ss / D_MODEL + 1e-6f);
#pragma unroll
            for (int i = 0; i < 16; ++i) v[i] = v[i] * r * gain[lane * 16 + i];
            uint4 o0, o1;
            o0.x = pk_bf16(v[0], v[1]); o0.y = pk_bf16(v[2], v[3]); o0.z = pk_bf16(v[4], v[5]); o0.w = pk_bf16(v[6], v[7]);
            o1.x = pk_bf16(v[8], v[9]); o1.y = pk_bf16(v[10], v[11]); o1.z = pk_bf16(v[12], v[13]); o1.w = pk_bf16(v[14], v[15]);
            bf16_t* hr = hn + pl_off(t, lane * 16, 1024);
            *(uint4*)hr = o0; *(uint4*)(hr + 8) = o1;
            *(uint4*)(lds + lr * HL + lane * 16) = o0; *(uint4*)(lds + lr * HL + lane * 16 + 8) = o1;
        }
        __syncthreads();
        f32x4 acc[3];
#pragma unroll
        for (int n = 0; n < 3; ++n) acc[n] = (f32x4){0.f, 0.f, 0.f, 0.f};
#pragma unroll
        for (int ks = 0; ks < 8; ++ks) {
            int k = w * 256 + ks * 32 + fg * 8;
            bf16x8 a = *(const bf16x8*)(lds + fr * HL + k);
#pragma unroll
            for (int n = 0; n < 3; ++n) {
                bf16x8 b = *(const bf16x8*)(wr + (size_t)(n * 16 + fr) * 1024 + k);
                acc[n] = __builtin_amdgcn_mfma_f32_16x16x32_bf16(a, b, acc[n], 0, 0, 0);
            }
        }
#pragma unroll
        for (int n = 0; n < 3; ++n) *(f32x4*)(red + ((w * 3 + n) * 64 + lane) * 4) = acc[n];
        __syncthreads();
        if (tid < 16) {
            float lg[36];
#pragma unroll
            for (int j = 0; j < 36; ++j) {
                int n = j >> 4, f = j & 15; int ln = (tid >> 2) * 16 + f; float s = 0.f;
#pragma unroll
                for (int ww = 0; ww < 4; ++ww) s += red[((ww * 3 + n) * 64 + ln) * 4 + (tid & 3)];
                lg[j] = s;
            }
            float gl[4]; float gm = -1e30f; int gi = 0;
#pragma unroll
            for (int j = 0; j < 4; ++j) { gl[j] = lg[j] + brg[j]; if (gl[j] > gm) { gm = gl[j]; gi = j; } }
            float gs = 0.f;
#pragma unroll
            for (int j = 0; j < 4; ++j) gs += __expf(gl[j] - gm);
            float gp = 1.f / gs;
            float el[8]; float em = -1e30f;
#pragma unroll
            for (int j = 0; j < 8; ++j) {
                float v = (gi == 0) ? lg[4 + j] : (gi == 1) ? lg[12 + j] : (gi == 2) ? lg[20 + j] : lg[28 + j];
                el[j] = v + bre[gi * 8 + j]; em = fmaxf(em, el[j]);
            }
#pragma unroll
            for (int j = 0; j < 8; ++j) el[j] = __expf(el[j] - em);
            float v0 = -1.f, v1 = -1.f; int i0 = 0, i1 = 0;
#pragma unroll
            for (int j = 0; j < 8; ++j) {
                float v = el[j];
                if (v > v0) { v1 = v0; i1 = i0; v0 = v; i0 = j; }
                else if (v > v1) { v1 = v; i1 = j; }
            }
            int t = it * 16 + tid;
            int e0 = gi * 8 + i0, e1 = gi * 8 + i1;
            if (!dry) {
            unsigned s0 = atomicAdd(&cnt[e0], 1u), s1 = atomicAdd(&cnt[e1], 1u);
            rowtok[(size_t)e0 * NTOK + s0] = t; rowtok[(size_t)e1 * NTOK + s1] = t;
            tslot[t * 2] = (e0 << 16) | (int)s0; tslot[t * 2 + 1] = (e1 << 16) | (int)s1;
            tgate[t * 2] = gp * v0 / (v0 + v1); tgate[t * 2 + 1] = gp * v1 / (v0 + v1);
            } else if (gp * v0 == 123.456f) tgate[0] = v1;
        }
    }
}

__device__ __forceinline__ void moe_tables(const unsigned* cnt, int* tab) {
    if (threadIdx.x == 0) {
        int a = 0;
        for (int e = 0; e < 32; ++e) { tab[e] = a; tab[40 + e] = a * 128; a += ((int)ld_u32_agent(cnt + e) + 127) >> 7; }
        tab[32] = a; tab[72] = a * 128;
    }
    __syncthreads();
}
template <int MODE>
__device__ void phase_expert(const Params& p, int l, bf16_t* lds) {
    const int tid = ltid(), lane = tid & 63, w = tid >> 6, wx = w >> 1, wy = w & 1, fr = lane & 15, fg = lane >> 4;
    const unsigned* cnt = (const unsigned*)(p.ws + WS_CTL) + CW_CNT + l * 32;
    int* tab = (int*)(lds + 4 * GSTAGE);
    moe_tables(cnt, tab);
    const int* rowtok = (const int*)(p.ws + WS_ROWTOK);
    const bf16_t* hn = (const bf16_t*)(p.ws + WS_HN);
    bf16_t* Hb = (bf16_t*)(p.ws + WS_H);
    bf16_t* Yb = (bf16_t*)(p.ws + WS_Y);
    const int x = blockIdx.x & 7, loc = blockIdx.x >> 3, nloc = gridDim.x >> 3;
    for (int j = loc;; j += nloc) {
        int e = -1, rt = 0, tn = 0; int jj = j;
#pragma unroll
        for (int q = 0; q < 4; ++q) {
            int ee = q * 8 + x; int nrt = tab[ee + 1] - tab[ee];
            if (e < 0) { if (jj < nrt * 8) { e = ee; tn = jj / nrt; rt = jj % nrt; } else jj -= nrt * 8; }
        }
        if (e < 0) break;
        const int c_e = (int)ld_u32_agent(cnt + e); const int hrow0 = tab[40 + e] + rt * 128;
        f32x4 acc[4][4];
        if (MODE == 0) {
            const bf16_t* wbase = (const bf16_t*)(p.ws + WS_WGU) + ((size_t)l * 32 + e) * 1024 * 1024;
            const int* rtk = rowtok + (size_t)e * NTOK + rt * 128; const int nval = c_e - rt * 128;
            auto rw = [&](int r) { return wbase + pl_off(tn * 128 + r, 0, 1024); };
            auto rt_ = [&](int r) { int t = (r < nval) ? rtk[r] : 0; return hn + pl_off(t, 0, 1024); };
            gemm_core(rw, rt_, 1024, lds, acc);
        } else {
            const bf16_t* wbase = (const bf16_t*)(p.ws + WS_WD) + ((size_t)l * 32 + e) * 1024 * 512;
            auto rw = [&](int r) { return wbase + pl_off(tn * 128 + r, 0, 512); };
            auto rt_ = [&](int r) { return Hb + pl_off(hrow0 + r, 0, 512); };
            gemm_core(rw, rt_, 512, lds, acc);
        }
        RAW_BARRIER();
        if (MODE == 0) {
#pragma unroll
            for (int n = 0; n < 4; ++n)
#pragma unroll
                for (int m = 0; m < 2; ++m)
                    ep_put<64>(lds, wy * 64 + n * 16 + fr, wx * 32 + m * 16 + 4 * fg, siluf_(acc[m][n][0]) * acc[m + 2][n][0], siluf_(acc[m][n][1]) * acc[m + 2][n][1],
                               siluf_(acc[m][n][2]) * acc[m + 2][n][2], siluf_(acc[m][n][3]) * acc[m + 2][n][3]);
            RAW_BARRIER();
            ep_flush<64>(lds, tid, [&](int row, int c8) { return Hb + pl_off(hrow0 + row, tn * 64 + c8 * 8, 512); });
        } else {
#pragma unroll
            for (int n = 0; n < 4; ++n)
#pragma unroll
                for (int m = 0; m < 4; ++m) ep_put<128>(lds, wy * 64 + n * 16 + fr, wx * 64 + m * 16 + 4 * fg, acc[m][n][0], acc[m][n][1], acc[m][n][2], acc[m][n][3]);
            RAW_BARRIER();
            bf16_t* dstb = Yb + (size_t)hrow0 * 1024 + tn * 128;
            ep_flush<128>(lds, tid, [&](int row, int c8) { return dstb + (size_t)row * 1024 + c8 * 8; });
        }
    }
}

__device__ void phase_combine(const Params& p, int l, int dry = 0) {
    const int tid = ltid(), lane = tid & 63, w = tid >> 6;
    const unsigned* cnt = (const unsigned*)(p.ws + WS_CTL) + CW_CNT + l * 32;
    int c = (lane < 32) ? (((int)ld_u32_agent(cnt + (lane & 31)) + 127) >> 7) * 128 : 0;
    int incl = c;
#pragma unroll
    for (int o = 1; o < 32; o <<= 1) { int v = __shfl_up(incl, o, 64); if (lane >= o) incl += v; }
    int hoff = incl - c;
    const int* tslot = (const int*)(p.ws + WS_TSLOT);
    const float* tgate = (const float*)(p.ws + WS_TGATE);
    const bf16_t* Yb = (const bf16_t*)(p.ws + WS_Y);
    bf16_t* hn = dry ? (bf16_t*)(p.ws + WS_SCR + (size_t)40 * 1024 * 1024) : (bf16_t*)(p.ws + WS_HN);
    float* x = p.out; float* xw = dry ? (float*)(p.ws + WS_SCR) : p.out;
    const float* gain = (l == 0 || dry) ? p.in[1] + 1024 : nullptr;
    for (int it = blockIdx.x; it < NTOK / 4; it += gridDim.x) {
        int t = it * 4 + w;
        int ts0 = tslot[t * 2], ts1 = tslot[t * 2 + 1];
        float g0 = tgate[t * 2], g1 = tgate[t * 2 + 1];
        int r0 = __shfl(hoff, ts0 >> 16, 64) + (ts0 & 0xffff);
        int r1 = __shfl(hoff, ts1 >> 16, 64) + (ts1 & 0xffff);
        float* xr = x + (size_t)t * 1024 + lane * 16;
        const bf16_t* y0 = Yb + (size_t)r0 * 1024 + lane * 16;
        const bf16_t* y1 = Yb + (size_t)r1 * 1024 + lane * 16;
        float v[16];
#pragma unroll
        for (int i = 0; i < 4; ++i) { float4 q = *(const float4*)(xr + 4 * i); v[4 * i] = q.x; v[4 * i + 1] = q.y; v[4 * i + 2] = q.z; v[4 * i + 3] = q.w; }
        uint4 a0 = *(const uint4*)y0, a1 = *(const uint4*)(y0 + 8), b0 = *(const uint4*)y1, b1 = *(const uint4*)(y1 + 8);
        unsigned ya[8] = {a0.x, a0.y, a0.z, a0.w, a1.x, a1.y, a1.z, a1.w};
        unsigned yb[8] = {b0.x, b0.y, b0.z, b0.w, b1.x, b1.y, b1.z, b1.w};
#pragma unroll
        for (int i = 0; i < 8; ++i) {
            v[2 * i] += g0 * bflo(ya[i]) + g1 * bflo(yb[i]);
            v[2 * i + 1] += g0 * bfhi(ya[i]) + g1 * bfhi(yb[i]);
        }
#ifdef NANMARK
#pragma unroll
        for (int i = 0; i < 16; ++i) if (!(fabsf(v[i]) < 1e30f)) v[i] = 1000.f;
#endif
#pragma unroll
        for (int i = 0; i < 4; ++i) *(float4*)(xw + (size_t)t * 1024 + lane * 16 + 4 * i) = make_float4(v[4 * i], v[4 * i + 1], v[4 * i + 2], v[4 * i + 3]);
        if (gain) {
            float ss = 0.f;
#pragma unroll
            for (int i = 0; i < 16; ++i) ss += v[i] * v[i];
            ss = wave_sum(ss);
            float r = rsqrtf(ss / D_MODEL + 1e-6f);
#pragma unroll
            for (int i = 0; i < 16; ++i) v[i] = v[i] * r * gain[lane * 16 + i];
            uint4 o0, o1;
            o0.x = pk_bf16(v[0], v[1]); o0.y = pk_bf16(v[2], v[3]); o0.z = pk_bf16(v[4], v[5]); o0.w = pk_bf16(v[6], v[7]);
            o1.x = pk_bf16(v[8], v[9]); o1.y = pk_bf16(v[10], v[11]); o1.z = pk_bf16(v[12], v[13]); o1.w = pk_bf16(v[14], v[15]);
            bf16_t* hr = hn + pl_off(t, lane * 16, 1024);
            *(uint4*)hr = o0; *(uint4*)(hr + 8) = o1;
        }
    }
}


__device__ __forceinline__ void mm_row(const bf16_t* RA, const bf16_t* RB, int mw, int fr, int fg, f32x4 (&acc)[4]) {
#pragma unroll
    for (int ks = 0; ks < 2; ++ks) {
        bf16x8 a = *(const bf16x8*)(RA + (16 * mw + fr) * LROW + ks * 32 + fg * 8);
#pragma unroll
        for (int nt = 0; nt < 4; ++nt) {
            bf16x8 b = *(const bf16x8*)(RB + (16 * nt + fr) * LROW + ks * 32 + fg * 8);
            acc[nt] = __builtin_amdgcn_mfma_f32_16x16x32_bf16(a, b, acc[nt], 0, 0, 0);
        }
    }
}
__device__ __forceinline__ void mm_col(const bf16_t* RA, const bf16_t* RB, int nw, int fr, int fg, f32x4 (&acc)[4]) {
#pragma unroll
    for (int ks = 0; ks < 2; ++ks) {
        bf16x8 b = *(const bf16x8*)(RB + (16 * nw + fr) * LROW + ks * 32 + fg * 8);
#pragma unroll
        for (int mt = 0; mt < 4; ++mt) {
            bf16x8 a = *(const bf16x8*)(RA + (16 * mt + fr) * LROW + ks * 32 + fg * 8);
            acc[mt] = __builtin_amdgcn_mfma_f32_16x16x32_bf16(a, b, acc[mt], 0, 0, 0);
        }
    }
}
__device__ __forceinline__ void zero4(f32x4 (&a)[4]) {
#pragma unroll
    for (int i = 0; i < 4; ++i) a[i] = (f32x4){0.f, 0.f, 0.f, 0.f};
}
__device__ __forceinline__ void st4_lds(bf16_t* p, float a, float b, float c, float d) { uint2 o; o.x = pk_bf16(a, b); o.y = pk_bf16(c, d); *(uint2*)p = o; }
__device__ __forceinline__ bf16_t f2bf(float v) { return (bf16_t)(pk_bf16(v, 0.f) & 0xffffu); }

__device__ void gdn_prep_item(const Params& p, int l, int cid, unsigned char* lds_raw) {
    const int tid = ltid(), lane = tid & 63, w = tid >> 6, fr = lane & 15, fg = lane >> 4;
    const int bh = cid >> 6, n = cid & 63, b = bh / H_GDN, h = bh % H_GDN;
    const int t0 = b * SEQ + n * 64;
    bf16_t* L0 = (bf16_t*)lds_raw; bf16_t* L1 = L0 + 64 * LROW; bf16_t* L2 = L1 + 64 * LROW; bf16_t* L3 = L2 + 64 * LROW; bf16_t* L4 = L3 + 64 * LROW; bf16_t* L5 = L4 + 64 * LROW;
    float* dec = (float*)(L5 + 64 * LROW); float* beta = dec + 64;
    const bf16_t* proj = (const bf16_t*)(p.ws + WS_PROJ);
    const float* aux = (const float*)(p.ws + WS_AUX);
    const float* convw = p.in[7] + (size_t)l * 4 * 1152;
    __syncthreads();
    const int i = tid >> 2, c0 = (tid & 3) * 16;
    float qv[16], kv[16], vv[16];
#pragma unroll
    for (int which = 0; which < 3; ++which) {
        float acc[16];
#pragma unroll
        for (int c = 0; c < 16; ++c) acc[c] = 0.f;
#pragma unroll
        for (int tap = 0; tap < 4; ++tap) {
            const int row = i - 3 + tap;
            if (n * 64 + row >= 0) {
                const bf16_t* xp = proj + (size_t)(t0 + row) * NPROJ + NC_GQ + which * 384 + h * 64 + c0;
                u32x4 x0 = *(const u32x4*)xp, x1 = *(const u32x4*)(xp + 8);
                const float* wp = convw + tap * 1152 + which * 384 + h * 64 + c0;
                f32x4 w0 = *(const f32x4*)wp, w1 = *(const f32x4*)(wp + 4), w2 = *(const f32x4*)(wp + 8), w3 = *(const f32x4*)(wp + 12);
                float wv[16] = {w0[0], w0[1], w0[2], w0[3], w1[0], w1[1], w1[2], w1[3], w2[0], w2[1], w2[2], w2[3], w3[0], w3[1], w3[2], w3[3]};
                unsigned xs[8] = {x0[0], x0[1], x0[2], x0[3], x1[0], x1[1], x1[2], x1[3]};
#pragma unroll
                for (int c = 0; c < 8; ++c) { acc[2 * c] += wv[2 * c] * bflo(xs[c]); acc[2 * c + 1] += wv[2 * c + 1] * bfhi(xs[c]); }
            }
        }
        float ss = 0.f;
#pragma unroll
        for (int c = 0; c < 16; ++c) { acc[c] = siluf_(acc[c]); ss += acc[c] * acc[c]; }
        if (which < 2) {
            ss += __shfl_xor(ss, 1, 64); ss += __shfl_xor(ss, 2, 64);
            const float sc = rsqrtf(ss + 1e-6f) * (which == 0 ? 0.125f : 1.f);
#pragma unroll
            for (int c = 0; c < 16; ++c) acc[c] *= sc;
        }
#pragma unroll
        for (int c = 0; c < 16; ++c) { if (which == 0) qv[c] = acc[c]; else if (which == 1) kv[c] = acc[c]; else vv[c] = acc[c]; }
    }
#pragma unroll
    for (int c = 0; c < 16; c += 4) { st4_lds(L2 + i * LROW + c0 + c, kv[c], kv[c + 1], kv[c + 2], kv[c + 3]); st4_lds(L3 + i * LROW + c0 + c, qv[c], qv[c + 1], qv[c + 2], qv[c + 3]); }
    if (w == 0) {
        const float a = aux[(size_t)(t0 + lane) * 64 + AX_GA + h], bl = aux[(size_t)(t0 + lane) * 64 + AX_GB + h];
        const float g = -__expf(p.in[8][l * H_GDN + h]) * softplusf_(a + p.in[9][l * H_GDN + h]);
        float inc = g;
#pragma unroll
        for (int o = 1; o < 64; o <<= 1) { float t = __shfl_up(inc, o, 64); if (lane >= o) inc += t; }
        dec[lane] = inc; beta[lane] = sigmoidf_(bl);
    }
    __syncthreads();
    {
        f32x4 g4[4]; zero4(g4);
        mm_row(L2, L2, w, fr, fg, g4);
#pragma unroll
        for (int nt = 0; nt < 4; ++nt) {
            const int kap = 16 * nt + fr; const float dk_ = dec[kap], bk_ = beta[kap];
            float nT[4], nN[4], tt[4];
#pragma unroll
            for (int r = 0; r < 4; ++r) {
                const int rho = 16 * w + 4 * fg + r; const float dr_ = dec[rho], br_ = beta[rho];
                const float G = g4[nt][r];
                nT[r] = (kap < rho) ? br_ * G * __expf(dr_ - dk_) : 0.f;
                nN[r] = (rho < kap) ? bk_ * G * __expf(dk_ - dr_) : 0.f;
                tt[r] = ((kap == rho) ? 1.f : 0.f) - nN[r];
            }
            st4_lds(L1 + kap * LROW + 16 * w + 4 * fg, nT[0], nT[1], nT[2], nT[3]);
            st4_lds(L0 + kap * LROW + 16 * w + 4 * fg, nN[0], nN[1], nN[2], nN[3]);
            st4_lds(L4 + kap * LROW + 16 * w + 4 * fg, tt[0], tt[1], tt[2], tt[3]);
        }
        f32x4 a4[4]; zero4(a4);
        mm_row(L2, L3, w, fr, fg, a4);
#pragma unroll
        for (int nt = 0; nt < 4; ++nt) {
            const int ii = 16 * nt + fr; const float di_ = dec[ii];
            float v4[4];
#pragma unroll
            for (int r = 0; r < 4; ++r) { const int j = 16 * w + 4 * fg + r; v4[r] = (j <= ii) ? a4[nt][r] * __expf(di_ - dec[j]) : 0.f; }
            st4_lds(L5 + ii * LROW + 16 * w + 4 * fg, v4[0], v4[1], v4[2], v4[3]);
        }
    }
    __syncthreads();
#pragma unroll
    for (int lev = 1; lev <= 5; ++lev) {
        const bf16_t* XA = (lev & 1) ? L0 : L2; const bf16_t* XAt = (lev & 1) ? L1 : L3;
        bf16_t* XB = (lev & 1) ? L2 : L0; bf16_t* XBt = (lev & 1) ? L3 : L1;
        {
            f32x4 x4[4]; zero4(x4);
            mm_row(XA, XAt, w, fr, fg, x4);
#pragma unroll
            for (int nt = 0; nt < 4; ++nt) {
                const int c = 16 * nt + fr;
                st4_lds(XBt + c * LROW + 16 * w + 4 * fg, x4[nt][0], x4[nt][1], x4[nt][2], x4[nt][3]);
                if (lev < 5) {
#pragma unroll
                    for (int r = 0; r < 4; ++r) XB[(16 * w + 4 * fg + r) * LROW + c] = f2bf(x4[nt][r]);
                }
            }
        }
        __syncthreads();
        {
            f32x4 t4[4];
#pragma unroll
            for (int mt = 0; mt < 4; ++mt) {
                uint2 u = *(const uint2*)(L4 + (16 * w + fr) * LROW + 16 * mt + 4 * fg);
                t4[mt] = (f32x4){bflo(u.x), bfhi(u.x), bflo(u.y), bfhi(u.y)};
            }
            mm_col(XBt, L4, w, fr, fg, t4);
#pragma unroll
            for (int mt = 0; mt < 4; ++mt) st4_lds(L4 + (16 * w + fr) * LROW + 16 * mt + 4 * fg, t4[mt][0], t4[mt][1], t4[mt][2], t4[mt][3]);
        }
    }
    {
        const float dj = dec[i], bj = beta[i], dlast = dec[63];
        const float s1 = bj * __expf(dj), s2 = bj, s3 = __expf(dlast - dj);
#pragma unroll
        for (int c = 0; c < 16; ++c) {
            L0[(c0 + c) * LROW + i] = f2bf(kv[c] * s1);
            L1[(c0 + c) * LROW + i] = f2bf(vv[c] * s2);
            L2[(c0 + c) * LROW + i] = f2bf(kv[c] * s3);
        }
    }
    __syncthreads();
    {
        f32x4 w4[4], u4[4]; zero4(w4); zero4(u4);
        mm_row(L4, L0, w, fr, fg, w4);
        mm_row(L4, L1, w, fr, fg, u4);
        __syncthreads();
#pragma unroll
        for (int nt = 0; nt < 4; ++nt) {
            st4_lds(L0 + (16 * nt + fr) * LROW + 16 * w + 4 * fg, w4[nt][0], w4[nt][1], w4[nt][2], w4[nt][3]);
            st4_lds(L1 + (16 * nt + fr) * LROW + 16 * w + 4 * fg, u4[nt][0], u4[nt][1], u4[nt][2], u4[nt][3]);
        }
        const float ed = __expf(dec[i]);
#pragma unroll
        for (int c = 0; c < 16; c += 4) st4_lds(L3 + i * LROW + c0 + c, qv[c] * ed, qv[c + 1] * ed, qv[c + 2] * ed, qv[c + 3] * ed);
    }
    __syncthreads();
    char* scr = p.ws + WS_SCR;
    {
        f32x4 m4[4]; zero4(m4);
        mm_row(L0, L2, w, fr, fg, m4);
        bf16_t* MP = (bf16_t*)(scr + SCR_GDN_MP) + (size_t)cid * 4096;
#pragma unroll
        for (int nt = 0; nt < 4; ++nt) store4_bf16(MP + (16 * nt + fr) * 64 + 16 * w + 4 * fg, -m4[nt][0], -m4[nt][1], -m4[nt][2], -m4[nt][3]);
        f32x4 n4[4]; zero4(n4);
        mm_row(L2, L1, w, fr, fg, n4);
        bf16_t* NN = (bf16_t*)(scr + SCR_GDN_NN) + (size_t)cid * 4096;
#pragma unroll
        for (int nt = 0; nt < 4; ++nt) store4_bf16(NN + ((w * 4 + nt) * 64 + lane) * 4, n4[nt][0], n4[nt][1], n4[nt][2], n4[nt][3]);
        f32x4 p4[4]; zero4(p4);
        mm_row(L0, L5, w, fr, fg, p4);
        bf16_t* PG = (bf16_t*)(scr + SCR_GDN_P) + (size_t)cid * 4096;
#pragma unroll
        for (int nt = 0; nt < 4; ++nt) {
            uint2 u = *(const uint2*)(L3 + (16 * nt + fr) * LROW + 16 * w + 4 * fg);
            store4_bf16(PG + (16 * nt + fr) * 64 + 16 * w + 4 * fg, bflo(u.x) - p4[nt][0], bfhi(u.x) - p4[nt][1], bflo(u.y) - p4[nt][2], bfhi(u.y) - p4[nt][3]);
        }
        f32x4 o4[4]; zero4(o4);
        mm_row(L1, L5, w, fr, fg, o4);
        bf16_t* OL = (bf16_t*)(scr + SCR_GDN_OL) + (size_t)cid * 4096;
#pragma unroll
        for (int nt = 0; nt < 4; ++nt) store4_bf16(OL + (16 * nt + fr) * 64 + 16 * w + 4 * fg, o4[nt][0], o4[nt][1], o4[nt][2], o4[nt][3]);
        if (tid == 0) ((float*)(scr + SCR_GDN_LAST))[cid] = __expf(dec[63]);
    }
}

#define SCAN_SB(k)   ((bf16_t*)lds_raw + (k) * 4096)
#define SCAN_RING(k) ((bf16_t*)lds_raw + 8192 + (k) * 8192)
#define SCAN_LAST    ((float*)(lds_raw + 65536))
__device__ __forceinline__ void scan_issue(const bf16_t* mp_lane, const bf16_t* nn_lane, int n, bf16_t* slot) {
#pragma unroll
    for (int q = 0; q < 8; ++q) __builtin_amdgcn_global_load_lds((const unsigned*)(mp_lane + (size_t)n * 4096 + q * 512), (unsigned*)(slot + q * 512), 16, 0, 0);
#pragma unroll
    for (int q = 0; q < 8; ++q) __builtin_amdgcn_global_load_lds((const unsigned*)(nn_lane + (size_t)n * 4096 + q * 512), (unsigned*)(slot + 4096 + q * 512), 16, 0, 0);
}
__device__ void gdn_scan_item(const Params& p, int bh, unsigned char* lds_raw) {
    const int tid = ltid(), lane = tid & 63, w = __builtin_amdgcn_readfirstlane(tid >> 6), fr = lane & 15, fg = lane >> 4;
    char* scr = p.ws + WS_SCR;
    const bf16_t* MP = (const bf16_t*)(scr + SCR_GDN_MP) + (size_t)bh * 64 * 4096;
    const bf16_t* NN = (const bf16_t*)(scr + SCR_GDN_NN) + (size_t)bh * 64 * 4096;
    const float* LAST = (const float*)(scr + SCR_GDN_LAST) + bh * 64;
    bf16_t* SG = (bf16_t*)(scr + SCR_GDN_SG) + (size_t)bh * 64 * 4096;
    const int mrow = lane >> 3;
    const bf16_t* nn_lane = NN + lane * 8;
    RAW_BARRIER();
    if (tid < 64) SCAN_LAST[tid] = ld_f32_agent(LAST + tid);
    asm volatile("s_waitcnt vmcnt(0)" ::: "memory");
    f32x4 S[4]; zero4(S);
    const int swz = (fr >> 1) & 7;
    if (w == 0) {
#pragma unroll
        for (int n = 0; n < 2; ++n) {
#pragma unroll
            for (int q = 0; q < 8; ++q) { const int row = 8 * q + mrow; __builtin_amdgcn_global_load_lds((const unsigned*)(MP + (size_t)n * 4096 + row * 64 + (((lane & 7) ^ ((row >> 1) & 7)) * 8)), (unsigned*)(SCAN_RING(n) + q * 512), 16, 0, 0); }
#pragma unroll
            for (int q = 0; q < 8; ++q) __builtin_amdgcn_global_load_lds((const unsigned*)(nn_lane + (size_t)n * 4096 + q * 512), (unsigned*)(SCAN_RING(n) + 4096 + q * 512), 16, 0, 0);
        }
    }
    for (int n = 0; n < 64; ++n) {
        bf16_t* sb = SCAN_SB(n & 1);
        const bf16_t* ring = SCAN_RING(n % 3);
#pragma unroll
        for (int nt = 0; nt < 4; ++nt) {
            const int e = 16 * nt + fr; const int c = 2 * w + (fg >> 1);
            uint2 o; o.x = pk_bf16(S[nt][0], S[nt][1]); o.y = pk_bf16(S[nt][2], S[nt][3]);
            *(uint2*)(sb + e * 64 + ((c ^ swz) * 8) + 4 * (fg & 1)) = o;
        }
        if (w == 0) { if (n + 1 < 64) asm volatile("s_waitcnt vmcnt(16)" ::: "memory"); else asm volatile("s_waitcnt vmcnt(0)" ::: "memory"); }
        RAW_BARRIER();
        if (w == 0 && n + 2 < 64) {
            bf16_t* slot = SCAN_RING((n + 2) % 3);
#pragma unroll
            for (int q = 0; q < 8; ++q) { const int row = 8 * q + mrow; __builtin_amdgcn_global_load_lds((const unsigned*)(MP + (size_t)(n + 2) * 4096 + row * 64 + (((lane & 7) ^ ((row >> 1) & 7)) * 8)), (unsigned*)(slot + q * 512), 16, 0, 0); }
#pragma unroll
            for (int q = 0; q < 8; ++q) __builtin_amdgcn_global_load_lds((const unsigned*)(nn_lane + (size_t)(n + 2) * 4096 + q * 512), (unsigned*)(slot + 4096 + q * 512), 16, 0, 0);
        }
        const float last = SCAN_LAST[n];
#pragma unroll
        for (int nt = 0; nt < 4; ++nt) {
            uint2 nn = *(const uint2*)(ring + 4096 + ((w * 4 + nt) * 64 + lane) * 4);
            S[nt][0] = last * S[nt][0] + bflo(nn.x); S[nt][1] = last * S[nt][1] + bfhi(nn.x);
            S[nt][2] = last * S[nt][2] + bflo(nn.y); S[nt][3] = last * S[nt][3] + bfhi(nn.y);
        }
#pragma unroll
        for (int ks = 0; ks < 2; ++ks) {
            const int co = ((ks * 4 + fg) ^ swz) * 8;
            bf16x8 a = *(const bf16x8*)(ring + (16 * w + fr) * 64 + co);
#pragma unroll
            for (int nt = 0; nt < 4; ++nt) {
                bf16x8 s = *(const bf16x8*)(sb + (16 * nt + fr) * 64 + co);
                S[nt] = __builtin_amdgcn_mfma_f32_16x16x32_bf16(a, s, S[nt], 0, 0, 0);
            }
        }
        if (w >= 2) {
#pragma unroll
            for (int i = 0; i < 4; ++i) {
                const int c = (w - 2) * 256 + i * 64 + lane; const int row = c >> 3, pc = c & 7;
                u32x4 v = *(const u32x4*)(sb + row * 64 + pc * 8);
                *(u32x4*)(SG + (size_t)n * 4096 + row * 64 + ((pc ^ ((row >> 1) & 7)) * 8)) = v;
            }
        }
    }
}

__device__ void gdn_out_item(const Params& p, int l, int cid) {
    const int tid = ltid(), lane = tid & 63, w = tid >> 6, fr = lane & 15, fg = lane >> 4;
    const int bh = cid >> 6, n = cid & 63, b = bh / H_GDN, h = bh % H_GDN;
    char* scr = p.ws + WS_SCR;
    const bf16_t* SG = (const bf16_t*)(scr + SCR_GDN_SG) + (size_t)cid * 4096;
    const bf16_t* PG = (const bf16_t*)(scr + SCR_GDN_P) + (size_t)cid * 4096;
    const bf16_t* OL = (const bf16_t*)(scr + SCR_GDN_OL) + (size_t)cid * 4096;
    const int i = 16 * w + fr; const int t = b * SEQ + n * 64 + i;
    f32x4 acc[4];
#pragma unroll
    for (int mt = 0; mt < 4; ++mt) { uint2 u = *(const uint2*)(OL + i * 64 + 16 * mt + 4 * fg); acc[mt] = (f32x4){bflo(u.x), bfhi(u.x), bflo(u.y), bfhi(u.y)}; }
#pragma unroll
    for (int ks = 0; ks < 2; ++ks) {
        bf16x8 bq = *(const bf16x8*)(PG + i * 64 + ks * 32 + fg * 8);
#pragma unroll
        for (int mt = 0; mt < 4; ++mt) {
            bf16x8 a = *(const bf16x8*)(SG + (16 * mt + fr) * 64 + ks * 32 + fg * 8);
            acc[mt] = __builtin_amdgcn_mfma_f32_16x16x32_bf16(a, bq, acc[mt], 0, 0, 0);
        }
    }
    float ss = 0.f;
#pragma unroll
    for (int mt = 0; mt < 4; ++mt)
#pragma unroll
        for (int r = 0; r < 4; ++r) ss += acc[mt][r] * acc[mt][r];
    ss += __shfl_xor(ss, 16, 64); ss += __shfl_xor(ss, 32, 64);
    const float rstd = rsqrtf(ss * (1.f / 64.f) + 1e-6f);
    const float* og = p.in[10] + l * 64;
    const bf16_t* gp = (const bf16_t*)(p.ws + WS_PROJ) + (size_t)t * NPROJ + NC_GG + h * 64;
    bf16_t* mp = (bf16_t*)(p.ws + WS_MIX) + pl_off(t, 384 + h * 64, 1024);
#pragma unroll
    for (int mt = 0; mt < 4; ++mt) {
        const int e0 = 16 * mt + 4 * fg;
        uint2 gu = *(const uint2*)(gp + e0); f32x4 g4 = *(const f32x4*)(og + e0);
        store4_bf16(mp + e0 + (e0 & 32), acc[mt][0] * rstd * g4[0] * bflo(gu.x), acc[mt][1] * rstd * g4[1] * bfhi(gu.x), acc[mt][2] * rstd * g4[2] * bflo(gu.y), acc[mt][3] * rstd * g4[3] * bfhi(gu.y));
    }
}

#define GQROW 40
__device__ void gla_prep_item(const Params& p, int l, int cid, unsigned char* lds_raw) {
    const int tid = ltid(), lane = tid & 63, w = tid >> 6, fr = lane & 15, fg = lane >> 4;
    const int bh = cid >> 6, n = cid & 63, b = bh / H_GLA, h = bh % H_GLA;
    const int t0 = b * SEQ + n * 64;
    float* Bf = (float*)lds_raw;
    bf16_t* Qt = (bf16_t*)(lds_raw + 8448);
    bf16_t* Kt = Qt + 64 * GQROW;
    bf16_t* KLt = Kt + 64 * GQROW;
    bf16_t* Vt = KLt + 32 * LROW;
    const bf16_t* proj = (const bf16_t*)(p.ws + WS_PROJ);
    const float* aux = (const float*)(p.ws + WS_AUX);
    char* scr = p.ws + WS_SCR;
    __syncthreads();
    const int i = tid >> 2, d0 = (tid & 3) * 8;
    {
        const float* wa = p.in[11] + (size_t)l * 16 * 128 + h * 32 + d0;
        const float* ba = p.in[12] + l * 128 + h * 32 + d0;
        float acc[8];
#pragma unroll
        for (int j = 0; j < 8; ++j) acc[j] = ba[j];
        float a1v[16];
#pragma unroll
        for (int r = 0; r < 16; r += 2) { float2 t2 = *(const float2*)(aux + (size_t)(t0 + i) * 64 + AX_LA + r); a1v[r] = t2.x; a1v[r + 1] = t2.y; }
#pragma unroll
        for (int r = 0; r < 16; ++r) {
            f32x4 wA = *(const f32x4*)(wa + r * 128), wB = *(const f32x4*)(wa + r * 128 + 4);
#pragma unroll
            for (int j = 0; j < 4; ++j) { acc[j] += a1v[r] * wA[j]; acc[4 + j] += a1v[r] * wB[j]; }
        }
#pragma unroll
        for (int j = 0; j < 8; ++j) Bf[i * 33 + d0 + j] = logsigmoidf_(acc[j]) * (1.f / 16.f);
    }
    {
        const bf16_t* lvt = (const bf16_t*)(scr + SCR_LVT) + (size_t)bh * 64 * SEQ + n * 64;
#pragma unroll
        for (int ii = 0; ii < 2; ++ii) { int c = tid + 256 * ii; int row = c >> 3, kc = c & 7; *(u32x4*)(Vt + row * LROW + kc * 8) = *(const u32x4*)(lvt + (size_t)row * SEQ + kc * 8); }
    }
    __syncthreads();
#pragma unroll
    for (int c = 0; c < 8; ++c) {
        const int d = 8 * w + c;
        float inc = Bf[lane * 33 + d];
#pragma unroll
        for (int o = 1; o < 64; o <<= 1) { float t = __shfl_up(inc, o, 64); if (lane >= o) inc += t; }
        Bf[lane * 33 + d] = inc;
    }
    __syncthreads();
    {
        const bf16_t* qp = proj + (size_t)(t0 + i) * NPROJ + NC_LQ + h * 32 + d0;
        const bf16_t* kp = proj + (size_t)(t0 + i) * NPROJ + NC_LK + h * 32 + d0;
        u32x4 qu = *(const u32x4*)qp, ku = *(const u32x4*)kp;
        float qf[8] = {bflo(qu[0]), bfhi(qu[0]), bflo(qu[1]), bfhi(qu[1]), bflo(qu[2]), bfhi(qu[2]), bflo(qu[3]), bfhi(qu[3])};
        float kf[8] = {bflo(ku[0]), bfhi(ku[0]), bflo(ku[1]), bfhi(ku[1]), bflo(ku[2]), bfhi(ku[2]), bflo(ku[3]), bfhi(ku[3])};
        float qt[8], kt[8], qb[8];
#pragma unroll
        for (int j = 0; j < 8; ++j) {
            const float bi = Bf[i * 33 + d0 + j], bm = Bf[31 * 33 + d0 + j], bl = Bf[63 * 33 + d0 + j];
            qt[j] = qf[j] * __expf(bi - bm); kt[j] = kf[j] * __expf(bm - bi); qb[j] = qf[j] * __expf(bi);
            KLt[(d0 + j) * LROW + i] = f2bf(kf[j] * __expf(bl - bi));
            if (i == 63) ((float*)(scr + SCR_GLA_DL))[cid * 32 + d0 + j] = __expf(bl);
        }
        u32x4 o; o[0] = pk_bf16(qt[0], qt[1]); o[1] = pk_bf16(qt[2], qt[3]); o[2] = pk_bf16(qt[4], qt[5]); o[3] = pk_bf16(qt[6], qt[7]);
        *(u32x4*)(Qt + i * GQROW + d0) = o;
        o[0] = pk_bf16(kt[0], kt[1]); o[1] = pk_bf16(kt[2], kt[3]); o[2] = pk_bf16(kt[4], kt[5]); o[3] = pk_bf16(kt[6], kt[7]);
        *(u32x4*)(Kt + i * GQROW + d0) = o;
        o[0] = pk_bf16(qb[0], qb[1]); o[1] = pk_bf16(qb[2], qb[3]); o[2] = pk_bf16(qb[4], qb[5]); o[3] = pk_bf16(qb[6], qb[7]);
        *(u32x4*)((bf16_t*)(scr + SCR_GLA_QB) + (size_t)cid * 2048 + i * 32 + d0) = o;
    }
    __syncthreads();
    f32x4 sc[4];
    {
        bf16x8 bq = *(const bf16x8*)(Qt + (16 * w + fr) * GQROW + fg * 8);
#pragma unroll
        for (int mt = 0; mt < 4; ++mt) {
            bf16x8 a = *(const bf16x8*)(Kt + (16 * mt + fr) * GQROW + fg * 8);
            sc[mt] = __builtin_amdgcn_mfma_f32_16x16x32_bf16(a, bq, (f32x4){0.f, 0.f, 0.f, 0.f}, 0, 0, 0);
        }
        const int ii = 16 * w + fr;
#pragma unroll
        for (int mt = 0; mt < 4; ++mt)
#pragma unroll
            for (int r = 0; r < 4; ++r) { const int j = 16 * mt + 4 * fg + r; if (j > ii) sc[mt][r] = 0.f; }
    }
    {
        f32x4 o4[4]; zero4(o4);
#pragma unroll
        for (int kk = 0; kk < 2; ++kk) {
            u32x4 pb = {pk_bf16(sc[2 * kk][0], sc[2 * kk][1]), pk_bf16(sc[2 * kk][2], sc[2 * kk][3]), pk_bf16(sc[2 * kk + 1][0], sc[2 * kk + 1][1]), pk_bf16(sc[2 * kk + 1][2], sc[2 * kk + 1][3])};
#pragma unroll
            for (int mt = 0; mt < 4; ++mt) {
                uint2 v0 = *(const uint2*)(Vt + (16 * mt + fr) * LROW + 32 * kk + 4 * fg), v1 = *(const uint2*)(Vt + (16 * mt + fr) * LROW + 32 * kk + 16 + 4 * fg);
                u32x4 va = {v0.x, v0.y, v1.x, v1.y};
                o4[mt] = __builtin_amdgcn_mfma_f32_16x16x32_bf16(__builtin_bit_cast(bf16x8, va), __builtin_bit_cast(bf16x8, pb), o4[mt], 0, 0, 0);
            }
        }
        bf16_t* OL = (bf16_t*)(scr + SCR_GLA_OL) + (size_t)cid * 4096;
#pragma unroll
        for (int mt = 0; mt < 4; ++mt) store4_bf16(OL + (16 * w + fr) * 64 + 16 * mt + 4 * fg, o4[mt][0], o4[mt][1], o4[mt][2], o4[mt][3]);
    }
    {
        f32x4 k4[2] = {(f32x4){0.f, 0.f, 0.f, 0.f}, (f32x4){0.f, 0.f, 0.f, 0.f}};
#pragma unroll
        for (int ks = 0; ks < 2; ++ks) {
            bf16x8 bv = *(const bf16x8*)(Vt + (16 * w + fr) * LROW + ks * 32 + fg * 8);
#pragma unroll
            for (int mt = 0; mt < 2; ++mt) {
                bf16x8 a = *(const bf16x8*)(KLt + (16 * mt + fr) * LROW + ks * 32 + fg * 8);
                k4[mt] = __builtin_amdgcn_mfma_f32_16x16x32_bf16(a, bv, k4[mt], 0, 0, 0);
            }
        }
        float* KV = (float*)(scr + SCR_GLA_KV) + (size_t)cid * 2048;
#pragma unroll
        for (int mt = 0; mt < 2; ++mt) *(f32x4*)(KV + (16 * w + fr) * 32 + 16 * mt + 4 * fg) = k4[mt];
    }
}
__device__ void gla_scan_item(const Params& p, int g) {
    const int tid = ltid();
    const int bh = g >> 3, idx = (g & 7) * 256 + tid, d = idx & 31;
    char* scr = p.ws + WS_SCR;
    const float* __restrict__ KV = (const float*)(scr + SCR_GLA_KV) + (size_t)bh * 64 * 2048 + idx;
    const float* __restrict__ DL = (const float*)(scr + SCR_GLA_DL) + bh * 64 * 32 + d;
    bf16_t* __restrict__ SG = (bf16_t*)(scr + SCR_GLA_SG) + (size_t)bh * 64 * 2048 + idx;
    float S = 0.f;
    for (int n0 = 0; n0 < 64; n0 += 8) {
        float kv[8], dl[8];
#pragma unroll
        for (int u = 0; u < 8; ++u) { kv[u] = KV[(size_t)(n0 + u) * 2048]; dl[u] = DL[(n0 + u) * 32]; }
#pragma unroll
        for (int u = 0; u < 8; ++u) { SG[(size_t)(n0 + u) * 2048] = f2bf(S); S = dl[u] * S + kv[u]; }
    }
}
__device__ void gla_out_item(const Params& p, int l, int cid) {
    const int tid = ltid(), lane = tid & 63, w = tid >> 6, fr = lane & 15, fg = lane >> 4;
    const int bh = cid >> 6, n = cid & 63, b = bh / H_GLA, h = bh % H_GLA;
    char* scr = p.ws + WS_SCR;
    const bf16_t* SG = (const bf16_t*)(scr + SCR_GLA_SG) + (size_t)cid * 2048;
    const bf16_t* QB = (const bf16_t*)(scr + SCR_GLA_QB) + (size_t)cid * 2048;
    const bf16_t* OL = (const bf16_t*)(scr + SCR_GLA_OL) + (size_t)cid * 4096;
    const int i = 16 * w + fr; const int t = b * SEQ + n * 64 + i;
    f32x4 acc[4];
#pragma unroll
    for (int mt = 0; mt < 4; ++mt) { uint2 u = *(const uint2*)(OL + i * 64 + 16 * mt + 4 * fg); acc[mt] = (f32x4){bflo(u.x), bfhi(u.x), bflo(u.y), bfhi(u.y)}; }
    bf16x8 bq = *(const bf16x8*)(QB + i * 32 + fg * 8);
#pragma unroll
    for (int mt = 0; mt < 4; ++mt) {
        bf16x8 a = *(const bf16x8*)(SG + (16 * mt + fr) * 32 + fg * 8);
        acc[mt] = __builtin_amdgcn_mfma_f32_16x16x32_bf16(a, bq, acc[mt], 0, 0, 0);
    }
    float ss = 0.f;
#pragma unroll
    for (int mt = 0; mt < 4; ++mt)
#pragma unroll
        for (int r = 0; r < 4; ++r) ss += acc[mt][r] * acc[mt][r];
    ss += __shfl_xor(ss, 16, 64); ss += __shfl_xor(ss, 32, 64);
    const float rstd = rsqrtf(ss * (1.f / 64.f) + 1e-6f);
    const float* og = p.in[13] + l * 64;
    const bf16_t* rp = (const bf16_t*)(p.ws + WS_PROJ) + (size_t)t * NPROJ + NC_LR + h * 64;
    bf16_t* mp = (bf16_t*)(p.ws + WS_MIX) + pl_off(t, 768 + h * 64, 1024);
#pragma unroll
    for (int mt = 0; mt < 4; ++mt) {
        const int e0 = 16 * mt + 4 * fg;
        uint2 gu = *(const uint2*)(rp + e0); f32x4 g4 = *(const f32x4*)(og + e0);
        store4_bf16(mp + e0 + (e0 & 32), acc[mt][0] * rstd * g4[0] * bflo(gu.x), acc[mt][1] * rstd * g4[1] * bfhi(gu.x), acc[mt][2] * rstd * g4[2] * bflo(gu.y), acc[mt][3] * rstd * g4[3] * bfhi(gu.y));
    }
}
__device__ void phase_mixout(const Params& p, int l) {
    for (int it = blockIdx.x; it < NGDN_CH + NGLA_CH; it += gridDim.x) {
        if (it < NGDN_CH) { if (MIXSEL & 1) gdn_out_item(p, l, it); } else { if (MIXSEL & 2) gla_out_item(p, l, it - NGDN_CH); }
    }
}

__device__ void fox_cumsum_item(const Params& p, int l, int bh, float* ldsf) {
    const int tid = ltid(), lane = tid & 63, w = tid >> 6;
    const int b = bh / H_FOX, h = bh % H_FOX;
    const float* aux = (const float*)(p.ws + WS_AUX);
    float* cum = (float*)(p.ws + WS_CUM) + (size_t)bh * SEQ;
    const float fb = p.in[5][l * H_FOX + h];
    float v[16]; float s = 0.f;
#pragma unroll
    for (int i = 0; i < 16; ++i) { v[i] = logsigmoidf_(aux[(size_t)(b * SEQ + tid * 16 + i) * 64 + AX_FF + h] + fb); s += v[i]; }
    float inc = s;
#pragma unroll
    for (int o = 1; o < 64; o <<= 1) { float t = __shfl_up(inc, o, 64); if (lane >= o) inc += t; }
    __syncthreads();
    if (lane == 63) ldsf[w] = inc;
    __syncthreads();
    float base = inc - s;
    for (int ww = 0; ww < w; ++ww) base += ldsf[ww];
    float c = base;
    u32x4* csx = (u32x4*)(p.ws + WS_SCR + SCR_CSX) + (size_t)bh * SEQ;
#pragma unroll
    for (int i = 0; i < 16; ++i) {
        c += v[i]; cum[tid * 16 + i] = c;
        const float vv = 1.4426950408889634f * c;
        const unsigned hi = pk_bf16(vv, 0.f) & 0xffffu; const float r1 = vv - __uint_as_float(hi << 16);
        const unsigned mid = pk_bf16(r1, 0.f) & 0xffffu; const float r2 = r1 - __uint_as_float(mid << 16);
        const unsigned lo = pk_bf16(r2, 0.f) & 0xffffu;
        u32x4 f; f[0] = 0x3F803F80u; f[1] = 0x3F80u | ((hi ^ 0x8000u) << 16); f[2] = (mid ^ 0x8000u) | ((lo ^ 0x8000u) << 16); f[3] = 0u;
        csx[tid * 16 + i] = f;
    }
}
__device__ void phase_prep(const Params& p, int l, unsigned char* lds_raw) {
    const int n0 = BATCH * H_FOX, n1 = n0 + ((MIXSEL & 1) ? NGDN_CH : 0), n2 = n1 + ((MIXSEL & 2) ? NGLA_CH : 0);
    for (int it = blockIdx.x; it < n2; it += gridDim.x) {
        if (it < n0) { __syncthreads(); fox_cumsum_item(p, l, it, (float*)lds_raw); }
        else if (it < n1) gdn_prep_item(p, l, it - n0, lds_raw);
        else gla_prep_item(p, l, it - n1, lds_raw);
    }
}

typedef float f32x16 __attribute__((ext_vector_type(16)));
#define ATT_BUF 17408
#define ATT_THR 8.0f
#define ATT_NSTAGE 3
__device__ __forceinline__ void attn_issue(const bf16_t* const (&kp)[2], const bf16_t* const (&vp)[2], const bf16_t* cp, int s0, unsigned char* stage, int w) {
    bf16_t* Ks = (bf16_t*)stage; bf16_t* Vs = Ks + 4096; bf16_t* cs = Vs + 4096;
    __builtin_amdgcn_global_load_lds((const unsigned*)(kp[0] + (size_t)s0 * NPROJ), (unsigned*)(Ks + (w * 8) * 64), 16, 0, 0);
    __builtin_amdgcn_global_load_lds((const unsigned*)(kp[1] + (size_t)s0 * NPROJ), (unsigned*)(Ks + (32 + w * 8) * 64), 16, 0, 0);
    __builtin_amdgcn_global_load_lds((const unsigned*)(vp[0] + s0), (unsigned*)(Vs + (w * 8) * 64), 16, 0, 0);
    __builtin_amdgcn_global_load_lds((const unsigned*)(vp[1] + s0), (unsigned*)(Vs + (32 + w * 8) * 64), 16, 0, 0);
    __builtin_amdgcn_global_load_lds((const unsigned*)(cp + (size_t)s0 * 8), (unsigned*)cs, 16, 0, 0);
}
__device__ __forceinline__ bf16x8 attn_qbias(float u, int h) {
    const unsigned hi = pk_bf16(u, 0.f) & 0xffffu; const float r1 = u - __uint_as_float(hi << 16);
    const unsigned mid = pk_bf16(r1, 0.f) & 0xffffu; const float r2 = r1 - __uint_as_float(mid << 16);
    const unsigned lo = pk_bf16(r2, 0.f) & 0xffffu;
    u32x4 f; f[0] = hi | (mid << 16); f[1] = lo | (0x3F80u << 16); f[2] = 0x3F803F80u; f[3] = 0u;
    if (h) { f[0] = 0u; f[1] = 0u; f[2] = 0u; }
    return __builtin_bit_cast(bf16x8, f);
}
__device__ void fox_attn_item(const Params& p, int l, int bh, int qt, unsigned char* lds_raw) {
    const int tid = ltid(), lane = tid & 63, w = __builtin_amdgcn_readfirstlane(tid >> 6), r = lane & 31, h = lane >> 5;
    const int b = bh / H_FOX, hh = bh % H_FOX;
    const bf16_t* proj = (const bf16_t*)(p.ws + WS_PROJ);
    const bf16_t* kbase = proj + (size_t)b * SEQ * NPROJ + NC_FK + hh * 64;
    const bf16_t* vbase = (const bf16_t*)(p.ws + WS_VTF) + (size_t)bh * 64 * SEQ;
    const float* cum = (const float*)(p.ws + WS_CUM) + (size_t)bh * SEQ;
    const int qlo = qt * 128 + w * 32, q = qlo + r;
    bf16x8 qf[4];
    {
        const bf16_t* qrow = proj + (size_t)(b * SEQ + q) * NPROJ + NC_FQ + hh * 64;
#pragma unroll
        for (int kk = 0; kk < 4; ++kk) qf[kk] = *(const bf16x8*)(qrow + kk * 16 + h * 8);
    }
    const float cq2 = cum[q] * 1.4426950408889634f;
    float mref = 0.f;
    bf16x8 qx = attn_qbias(cq2 - mref, h);
    f32x16 o0, o1;
#pragma unroll
    for (int i = 0; i < 16; ++i) { o0[i] = 0.f; o1[i] = 0.f; }
    float lsum = 0.f;
    const int ntiles = 2 * qt + 2;
    const bf16_t* kp[2]; const bf16_t* vp[2];
    {
        const int row0 = w * 8 + (lane >> 3), pc = lane & 7;
        const int lc0 = (pc ^ ((row0 >> 1) & 7)) * 8;
        kp[0] = kbase + (size_t)row0 * NPROJ + lc0; kp[1] = kbase + (size_t)(row0 + 32) * NPROJ + lc0;
        vp[0] = vbase + (size_t)row0 * SEQ + lc0;   vp[1] = vbase + (size_t)(row0 + 32) * SEQ + lc0;
    }
    const bf16_t* cp = (const bf16_t*)(p.ws + WS_SCR + SCR_CSX) + (size_t)bh * SEQ * 8 + lane * 8;
    const int swr = (r >> 1) & 7;
    int jw;
    {
        float gq = fabsf(p.in[3][l * 64 + lane]), gk = fabsf(p.in[4][l * 64 + lane]);
#pragma unroll
        for (int o = 32; o > 0; o >>= 1) { gq = fmaxf(gq, __shfl_xor(gq, o, 64)); gk = fmaxf(gk, __shfl_xor(gk, o, 64)); }
        const float thr = 2.f * (1.4426950408889634f * 8.f * gq * gk) + 30.f;
        const float cw = cum[qlo] * 1.4426950408889634f;
        const float ce = (lane < ntiles) ? cum[64 * lane + 63] * 1.4426950408889634f : 0.f;
        const unsigned long long keep = __ballot((lane < ntiles) && (cw - ce >= -thr));
        jw = keep ? (__ffsll((long long)keep) - 1) : (ntiles - 1);
    }
    volatile int* jshare = (volatile int*)(lds_raw + ATT_NSTAGE * ATT_BUF + 16);
    asm volatile("s_waitcnt vmcnt(0)" ::: "memory");
    RAW_BARRIER();
    if (tid == 0) *jshare = jw;
    RAW_BARRIER();
    const int jstart = *jshare;
    attn_issue(kp, vp, cp, jstart * 64, lds_raw + (jstart % ATT_NSTAGE) * ATT_BUF, w);
    if (jstart + 1 < ntiles) attn_issue(kp, vp, cp, (jstart + 1) * 64, lds_raw + ((jstart + 1) % ATT_NSTAGE) * ATT_BUF, w);
    for (int j = jstart; j < ntiles; ++j) {
        if (j + 1 < ntiles) asm volatile("s_waitcnt vmcnt(5)" ::: "memory"); else asm volatile("s_waitcnt vmcnt(0)" ::: "memory");
        RAW_BARRIER();
        if (j + 2 < ntiles) attn_issue(kp, vp, cp, (j + 2) * 64, lds_raw + ((j + 2) % ATT_NSTAGE) * ATT_BUF, w);
        const int s0 = j * 64;
        if (s0 <= qlo + 31 && j >= jw) {
            const bf16_t* Ks = (const bf16_t*)(lds_raw + (j % ATT_NSTAGE) * ATT_BUF); const bf16_t* Vs = Ks + 4096; const bf16_t* cs = Vs + 4096;
            f32x16 st0, st1;
            {
                u32x4 z4 = {0u, 0u, 0u, 0u};
                u32x4 c0 = *(const u32x4*)(cs + r * 8), c1 = *(const u32x4*)(cs + (32 + r) * 8);
                if (h) { c0 = z4; c1 = z4; }
                f32x16 zz;
#pragma unroll
                for (int i = 0; i < 16; ++i) zz[i] = 0.f;
                st0 = __builtin_amdgcn_mfma_f32_32x32x16_bf16(__builtin_bit_cast(bf16x8, c0), qx, zz, 0, 0, 0);
                st1 = __builtin_amdgcn_mfma_f32_32x32x16_bf16(__builtin_bit_cast(bf16x8, c1), qx, zz, 0, 0, 0);
            }
#pragma unroll
            for (int kk = 0; kk < 4; ++kk) {
                const int co = ((kk * 2 + h) ^ swr) * 8;
                bf16x8 a0 = *(const bf16x8*)(Ks + r * 64 + co);
                bf16x8 a1 = *(const bf16x8*)(Ks + (32 + r) * 64 + co);
                st0 = __builtin_amdgcn_mfma_f32_32x32x16_bf16(a0, qf[kk], st0, 0, 0, 0);
                st1 = __builtin_amdgcn_mfma_f32_32x32x16_bf16(a1, qf[kk], st1, 0, 0, 0);
            }
            if (s0 + 63 > qlo) {
#pragma unroll
                for (int i = 0; i < 16; ++i) {
                    const int key = s0 + (i & 3) + 8 * (i >> 2) + 4 * h;
                    if (key > q) st0[i] = -1e30f;
                    if (key + 32 > q) st1[i] = -1e30f;
                }
            }
            float mx = fmaxf(st0[0], st1[0]);
#pragma unroll
            for (int i = 1; i < 16; ++i) mx = fmaxf(mx, fmaxf(st0[i], st1[i]));
            if (__any(mx > ATT_THR)) {
                const float mo = fmaxf(mx, __shfl_xor(mx, 32, 64));
                const float d = (mo > ATT_THR) ? mo : 0.f;
                const float alpha = __builtin_amdgcn_exp2f(-d);
#pragma unroll
                for (int i = 0; i < 16; ++i) { st0[i] -= d; st1[i] -= d; o0[i] *= alpha; o1[i] *= alpha; }
                lsum *= alpha; mref += d;
                qx = attn_qbias(cq2 - mref, h);
            }
            float rs = 0.f;
#pragma unroll
            for (int i = 0; i < 16; ++i) { st0[i] = __builtin_amdgcn_exp2f(st0[i]); st1[i] = __builtin_amdgcn_exp2f(st1[i]); rs += st0[i] + st1[i]; }
            lsum += rs;
            bf16x8 pf[2][2];
#pragma unroll
            for (int s = 0; s < 2; ++s) {
                u32x4 t0 = {pk_bf16(st0[8 * s], st0[8 * s + 1]), pk_bf16(st0[8 * s + 2], st0[8 * s + 3]), pk_bf16(st0[8 * s + 4], st0[8 * s + 5]), pk_bf16(st0[8 * s + 6], st0[8 * s + 7])};
                u32x4 t1 = {pk_bf16(st1[8 * s], st1[8 * s + 1]), pk_bf16(st1[8 * s + 2], st1[8 * s + 3]), pk_bf16(st1[8 * s + 4], st1[8 * s + 5]), pk_bf16(st1[8 * s + 6], st1[8 * s + 7])};
                pf[0][s] = __builtin_bit_cast(bf16x8, t0); pf[1][s] = __builtin_bit_cast(bf16x8, t1);
            }
#pragma unroll
            for (int mt = 0; mt < 2; ++mt)
#pragma unroll
                for (int s = 0; s < 2; ++s) {
                    const int c0 = 4 * mt + 2 * s;
                    const int oA = ((c0 ^ swr) * 8) + 4 * h, oB = (((c0 + 1) ^ swr) * 8) + 4 * h;
                    uint2 a00 = *(const uint2*)(Vs + r * 64 + oA), a01 = *(const uint2*)(Vs + r * 64 + oB);
                    uint2 a10 = *(const uint2*)(Vs + (32 + r) * 64 + oA), a11 = *(const uint2*)(Vs + (32 + r) * 64 + oB);
                    u32x4 u0 = {a00.x, a00.y, a01.x, a01.y}; u32x4 u1 = {a10.x, a10.y, a11.x, a11.y};
                    o0 = __builtin_amdgcn_mfma_f32_32x32x16_bf16(__builtin_bit_cast(bf16x8, u0), pf[mt][s], o0, 0, 0, 0);
                    o1 = __builtin_amdgcn_mfma_f32_32x32x16_bf16(__builtin_bit_cast(bf16x8, u1), pf[mt][s], o1, 0, 0, 0);
                }
        }
    }
    lsum += __shfl_xor(lsum, 32, 64);
    const float inv = 1.f / lsum;
    float ss = 0.f;
#pragma unroll
    for (int i = 0; i < 16; ++i) { o0[i] *= inv; o1[i] *= inv; ss += o0[i] * o0[i] + o1[i] * o1[i]; }
    ss += __shfl_xor(ss, 32, 64);
    const float rstd = rsqrtf(ss * (1.f / 64.f) + 1e-6f);
    const float* og = p.in[6] + l * 64;
    bf16_t* mrow = (bf16_t*)(p.ws + WS_MIX) + pl_off(b * SEQ + q, hh * 64, 1024);
#pragma unroll
    for (int g = 0; g < 4; ++g) {
        const int e0 = 8 * g + 4 * h;
        f32x4 g0 = *(const f32x4*)(og + e0), g1 = *(const f32x4*)(og + 32 + e0);
        store4_bf16(mrow + e0, o0[4 * g] * rstd * g0[0], o0[4 * g + 1] * rstd * g0[1], o0[4 * g + 2] * rstd * g0[2], o0[4 * g + 3] * rstd * g0[3]);
        store4_bf16(mrow + 64 + e0, o1[4 * g] * rstd * g1[0], o1[4 * g + 1] * rstd * g1[1], o1[4 * g + 2] * rstd * g1[2], o1[4 * g + 3] * rstd * g1[3]);
    }
}
#define ATT_ITEMS (BATCH * H_FOX * (SEQ / 128))
__device__ void phase_scan_attn(const Params& p, int l, unsigned char* lds_raw, int rep = 0, int sel = 7) {
    unsigned* qctr = (unsigned*)(p.ws + WS_CTL) + CW_Q + l + 2 * rep;
    volatile int* slot = (volatile int*)(lds_raw + ATT_NSTAGE * ATT_BUF);
    for (;;) {
        __syncthreads();
        if (threadIdx.x == 0) *slot = (int)atomicAdd(qctr, 1u);
        __syncthreads();
        int it = *slot;
        const int ns0 = (MIXSEL & 1) ? BATCH * H_GDN : 0, ns1 = ns0 + ((MIXSEL & 2) ? 128 : 0);
        if (it >= ns1 + ATT_ITEMS) break;
        if (it < ns0) { if (sel & 1) gdn_scan_item(p, it, lds_raw); continue; }
        if (it < ns1) { if (sel & 2) gla_scan_item(p, it - ns0); continue; }
        it -= ns1;
        if (!(sel & 4)) continue;
        const int qt = (SEQ / 128 - 1) - it / (BATCH * H_FOX), bh = it % (BATCH * H_FOX);
        fox_attn_item(p, l, bh, qt, lds_raw);
    }
}

#define NPHASE 19
__global__ void __launch_bounds__(256, 2) mk(Params p, int lo, int hi, int use_bar) {
    __shared__ __attribute__((aligned(16))) unsigned char lds_raw[LDS_BYTES];
    bf16_t* lds = (bf16_t*)lds_raw;
    volatile LAS unsigned* st = (volatile LAS unsigned*)(lds_raw + LDS_BYTES - 16);
    XcdBarrier bar; bar.bar = (unsigned*)(p.ws + WS_CTL) + CW_BAR; bar.x = 0; bar.st = st;
    if (use_bar) {
        if (threadIdx.x == 0) { st[0] = 0u; st[1] = 0u; }
        __syncthreads();
        bar = xcd_barrier_post((unsigned*)(p.ws + WS_CTL) + CW_BAR, st);
    }
    for (int ph = lo; ph < hi; ++ph) {
#ifndef PSEL
#define PSEL 0xffff
#endif
        int phv = ph; asm volatile("" : "+s"(phv));
        Params q = p; asm volatile("" : "+s"(q.ws)); asm volatile("" : "+s"(q.out));
        if (phv == 0) { if (PSEL & 1) phase0(q); }
        else {
            int l = (phv - 1) / 9, s = (phv - 1) % 9;
            if (s == 0) { if (PSEL & 2) phase_inproj(q, l, lds); }
            else if (s == 1) { if (PSEL & 128) phase_prep(q, l, lds_raw); }
            else if (s == 2) { if (PSEL & 256) phase_scan_attn(q, l, lds_raw); }
            else if (s == 3) { if (PSEL & 512) phase_mixout(q, l); }
            else if (s == 4) { if (PSEL & 4) phase_outproj(q, l, lds); }
            else if (s == 5) { if (PSEL & 8) phase_route(q, l, lds); }
            else if (s == 6) { if (PSEL & 16) phase_expert<0>(q, l, lds); }
            else if (s == 7) { if (PSEL & 32) phase_expert<1>(q, l, lds); }
            else if (s == 8) { if (PSEL & 64) phase_combine(q, l); }
        }
#ifdef REPEAT_MASK
        {
            const int ty = (phv == 0) ? 9 : (phv - 1) % 9, l = (phv == 0) ? 0 : (phv - 1) / 9;
            const bool idem = !((ty == 4 && l == 1));
            if (((REPEAT_MASK >> ty) & 1) && idem && use_bar) {
                xcd_barrier(bar);
                if (ty == 9) phase0(q);
                else if (ty == 0) phase_inproj(q, l, lds, GVAR);
                else if (ty == 1) phase_prep(q, l, lds_raw);
                else if (ty == 2) phase_scan_attn(q, l, lds_raw, 1, P3SEL);
                else if (ty == 3) phase_mixout(q, l);
                else if (ty == 4) phase_outproj(q, l, lds);
                else if (ty == 5) phase_route(q, l, lds, 1);
                else if (ty == 8) phase_combine(q, l, 1);
                else if (ty == 6) phase_expert<0>(q, l, lds);
                else if (ty == 7) phase_expert<1>(q, l, lds);
            }
        }
#endif
        if (ph + 1 < hi) {
            if (hi > 1000) cg::this_grid().sync();
            xcd_barrier(bar);
        }
    }
}

extern "C" void kernel_launch(void* const* d_in, const int* in_sizes, int n_in,
                              void* d_out, int out_size, void* d_ws, size_t ws_size,
                              hipStream_t stream) {
    static int grid = 0;
    if (grid == 0) {
        if (ws_size < WS_END) { fprintf(stderr, "ws too small: need %zu have %zu\n", (size_t)WS_END, ws_size); grid = -1; return; }
        int dev = 0, cus = 0, per_cu = 0;
        hipGetDevice(&dev);
        hipDeviceGetAttribute(&cus, hipDeviceAttributeMultiprocessorCount, dev);
        hipOccupancyMaxActiveBlocksPerMultiprocessor(&per_cu, mk, 256, 0);
        if (per_cu > 2) per_cu = 2;
        if (per_cu < 1) { fprintf(stderr, "occupancy query failed\n"); grid = -1; return; }
        grid = cus * per_cu;
        grid -= grid % 8;
    }
    if (grid < 0) return;
    Params p{};
    for (int i = 0; i < 23; ++i) p.in[i] = (const float*)d_in[i];
    p.out = (float*)d_out; p.ws = (char*)d_ws;
    hipMemsetAsync((char*)d_ws + WS_CTL, 0, CTL_BYTES, stream);
#ifdef POISON_GLA
    hipMemsetAsync((char*)d_ws + WS_SCR + SCR_GLA_OL, 0xFF, SCR_LVT - SCR_GLA_OL, stream);
#endif

#ifdef MULTI_LAUNCH
    for (int ph = 0; ph < NPHASE; ++ph) mk<<<grid, 256, 0, stream>>>(p, ph, ph + 1, 0);
#else
    int lo = 0, hi = NPHASE, ub = 2;
    void* args[] = {&p, &lo, &hi, &ub};
    hipError_t e = hipLaunchCooperativeKernel((void*)mk, dim3(grid), dim3(256), args, 0, stream);
    if (e != hipSuccess) fprintf(stderr, "cooperative launch failed: %s (grid %d)\n", hipGetErrorString(e), grid);
#endif
}
```

```cpp
#include <hip/hip_runtime.h>
#include <hip/hip_cooperative_groups.h>
#include <cstdint>
#include <cstdio>
namespace cg = cooperative_groups;

#define D_MODEL 1024
#define BATCH 4
#define SEQ 4096
#define NTOK (BATCH * SEQ)
#define H_FOX 6
#define H_GDN 6
#define H_GLA 4
#define N_IN 3490
#define N_EXP 32
#define D_EXP 512
#define NPROJ 3456
#define NINP 3584

#define C_FF 1152
#define C_GQ 1158
#define C_GG 2310
#define C_GA 2694
#define C_GB 2700
#define C_LQ 2706
#define C_LA 3474
#define NC_FQ 0
#define NC_FK 384
#define NC_FV 768
#define NC_GQ 1152
#define NC_GK 1536
#define NC_GV 1920
#define NC_GG 2304
#define NC_LQ 2688
#define NC_LK 2816
#define NC_LV 2944
#define NC_LR 3200
#define AX_FF 0
#define AX_GA 6
#define AX_GB 12
#define AX_LA 18

#ifndef P3SEL
#define P3SEL 7
#endif
#ifndef GVAR
#define GVAR 0
#endif
#ifndef MIXSEL
#define MIXSEL 3
#endif
typedef unsigned short bf16_t;
typedef short bf16x8 __attribute__((ext_vector_type(8)));
typedef float f32x4 __attribute__((ext_vector_type(4)));
typedef unsigned u32x4 __attribute__((ext_vector_type(4)));

#define WS_CTL      0
#define CTL_BYTES   65536
#define WS_WIN      (WS_CTL + CTL_BYTES)
#define WS_WOUT     (WS_WIN + (size_t)2 * NINP * 1024 * 2)
#define WS_WGU      (WS_WOUT + (size_t)2 * 1024 * 1024 * 2)
#define WS_WD       (WS_WGU + (size_t)2 * 32 * 1024 * 1024 * 2)
#define WS_WR       (WS_WD + (size_t)2 * 32 * 1024 * 512 * 2)
#define WS_HN       (WS_WR + (size_t)2 * 64 * 1024 * 2)
#define WS_PROJ     (WS_HN + (size_t)NTOK * 1024 * 2)
#define WS_VTF      (WS_PROJ + (size_t)NTOK * NPROJ * 2)
#define WS_AUX      (WS_VTF + (size_t)BATCH * H_FOX * 64 * SEQ * 2)
#define WS_CUM      (WS_AUX + (size_t)NTOK * 64 * 4)
#define WS_MIX      (WS_CUM + (size_t)BATCH * H_FOX * SEQ * 4)
#define WS_ROWTOK   (WS_MIX + (size_t)NTOK * 1024 * 2)
#define WS_TSLOT    (WS_ROWTOK + (size_t)32 * NTOK * 4)
#define WS_TGATE    (WS_TSLOT + (size_t)NTOK * 2 * 4)
#define WS_SCR      (WS_TGATE + (size_t)NTOK * 2 * 4)
#define SCR_BYTES   ((size_t)100 * 1024 * 1024)
#define WS_END      (WS_SCR + SCR_BYTES)
#define HROWS       (2 * NTOK + 32 * 128)
#define WS_H        WS_PROJ
#define WS_Y        (WS_PROJ + (size_t)HROWS * 512 * 2)

#define NGDN_CH 1536
#define NGLA_CH 1024
#define SCR_GDN_MP   ((size_t)0)
#define SCR_GDN_NN   (SCR_GDN_MP + (size_t)NGDN_CH * 8192)
#define SCR_GDN_P    (SCR_GDN_NN + (size_t)NGDN_CH * 8192)
#define SCR_GDN_OL   (SCR_GDN_P  + (size_t)NGDN_CH * 8192)
#define SCR_GDN_SG   (SCR_GDN_OL + (size_t)NGDN_CH * 8192)
#define SCR_GDN_LAST (SCR_GDN_SG + (size_t)NGDN_CH * 8192)
#define SCR_GLA_OL   (SCR_GDN_LAST + (size_t)NGDN_CH * 4)
#define SCR_GLA_KV   (SCR_GLA_OL + (size_t)NGLA_CH * 8192)
#define SCR_GLA_QB   (SCR_GLA_KV + (size_t)NGLA_CH * 8192)
#define SCR_GLA_SG   (SCR_GLA_QB + (size_t)NGLA_CH * 4096)
#define SCR_GLA_DL   (SCR_GLA_SG + (size_t)NGLA_CH * 4096)
#define SCR_LVT      (SCR_GLA_DL + (size_t)NGLA_CH * 128)
#define SCR_USED     (SCR_LVT + (size_t)BATCH * H_GLA * 64 * SEQ * 2)
#define SCR_CSX      SCR_USED
static_assert(SCR_CSX + (size_t)BATCH * H_FOX * SEQ * 16 <= SCR_BYTES, "scratch overflow");
#define CW_BAR      0
#define CW_CNT      4096
#define CW_Q        4224

struct Params {
    const float* in[23];
    float* out;
    char* ws;
};

__device__ __forceinline__ float sigmoidf_(float x) { return __builtin_amdgcn_rcpf(1.f + __expf(-x)); }
__device__ __forceinline__ float siluf_(float x) { return x * __builtin_amdgcn_rcpf(1.f + __expf(-x)); }
__device__ __forceinline__ float softplusf_(float x) { return x > 20.f ? x : log1pf(__expf(x)); }
__device__ __forceinline__ float logsigmoidf_(float x) { return -softplusf_(-x); }
__device__ __forceinline__ float wave_sum(float v) {
#pragma unroll
    for (int o = 32; o > 0; o >>= 1) v += __shfl_xor(v, o, 64);
    return v;
}
__device__ __forceinline__ int ltid() { int t = threadIdx.x; asm volatile("" : "+v"(t)); return t; }
typedef __bf16 bf16x2_t __attribute__((ext_vector_type(2)));
typedef float f32x2_t __attribute__((ext_vector_type(2)));
__device__ __forceinline__ unsigned pk_bf16(float lo, float hi) { f32x2_t v = {lo, hi}; bf16x2_t r = __builtin_convertvector(v, bf16x2_t); return __builtin_bit_cast(unsigned, r); }
__device__ __forceinline__ size_t pl_off(int row, int k, int K) { return (size_t)(row >> 1) * (size_t)(2 * K) + (size_t)((k >> 5) * 64 + (row & 1) * 32 + (k & 31)); }
__device__ __forceinline__ unsigned ld_u32_agent(const unsigned* p) { return __hip_atomic_load(p, __ATOMIC_RELAXED, __HIP_MEMORY_SCOPE_AGENT); }
__device__ __forceinline__ float ld_f32_agent(const float* p) { return __uint_as_float(__hip_atomic_load((const unsigned*)p, __ATOMIC_RELAXED, __HIP_MEMORY_SCOPE_AGENT)); }
__device__ __forceinline__ float bf2f(bf16_t v) { return __uint_as_float((unsigned)v << 16); }
__device__ __forceinline__ float bflo(unsigned v) { return __uint_as_float(v << 16); }
__device__ __forceinline__ float bfhi(unsigned v) { return __uint_as_float(v & 0xffff0000u); }

#define XB_TMO      128
#define XB_XCNT(j)  (256  + 64 * (j))
#define XB_XSUB(j)  (1280 + 64 * (j))
#define XB_XGEN(j)  (2304 + 64 * (j))
#define XB_TOP      3328
#define XB_TOPGEN   3392
#define XCD_BAR_WORDS 3456
#define XB_SPIN_CAP (1u << 22)
#define LAS __attribute__((address_space(3)))
__device__ __forceinline__ unsigned xb_ld(unsigned* p)              { return __hip_atomic_load(p, __ATOMIC_RELAXED, __HIP_MEMORY_SCOPE_AGENT); }
__device__ __forceinline__ unsigned xb_add(unsigned* p, unsigned v) { return __hip_atomic_fetch_add(p, v, __ATOMIC_RELAXED, __HIP_MEMORY_SCOPE_AGENT); }
__device__ __forceinline__ unsigned xb_xcc_id() { return (unsigned)__builtin_amdgcn_s_getreg((3 << 11) | 20) & 0xFu; }
#define XB_SPIN(cond, bar) do { unsigned _sp = 0; while (cond) { if (_sp < 16u) __builtin_amdgcn_s_sleep(2); else __builtin_amdgcn_s_sleep(20);     \
    if ((++_sp & 255u) == 0u) { if (xb_ld(&(bar)[XB_TMO])) break; if (_sp > XB_SPIN_CAP) { atomicAdd(&(bar)[XB_TMO], 1u); break; } } } } while (0)
struct XcdBarrier { unsigned* bar; unsigned x; volatile LAS unsigned* st; };
__device__ __forceinline__ XcdBarrier xcd_barrier_post(unsigned* bar, volatile LAS unsigned* st) {
    XcdBarrier b; b.bar = bar; b.x = xb_xcc_id(); b.st = st;
    if (threadIdx.x == 0) (void)xb_add(&bar[XB_XCNT(b.x)], 1u);
    return b;
}
__device__ __forceinline__ void xcd_barrier_complete(unsigned* bar, unsigned x, unsigned& nloc, unsigned& nx) {
    const unsigned G = gridDim.x * gridDim.y * gridDim.z;
    unsigned sum, cnt, mine, sp = 0u;
    for (;;) {
        sum = 0u; cnt = 0u; mine = 0u;
#pragma unroll
        for (unsigned j = 0; j < 16; ++j) { const unsigned c = xb_ld(&bar[XB_XCNT(j)]); sum += c; cnt += (c > 0u) ? 1u : 0u; mine = (j == x) ? c : mine; }
        if (sum == G) break;
        __builtin_amdgcn_s_sleep(1);
        if ((++sp & 255u) == 0u) { if (xb_ld(&bar[XB_TMO])) break; if (sp > XB_SPIN_CAP) { atomicAdd(&bar[XB_TMO], 1u); break; } }
    }
    nloc = mine > 0u ? mine : 1u; nx = cnt > 0u ? cnt : 1u;
}
__device__ __forceinline__ void xcd_barrier(const XcdBarrier& b) {
    asm volatile("s_waitcnt vmcnt(0)" ::: "memory");
    __syncthreads();
    if (threadIdx.x == 0) {
        unsigned* bar = b.bar;
        __builtin_amdgcn_s_waitcnt(0);
        unsigned nloc = b.st[0], nx = b.st[1];
        if (nloc == 0u) { xcd_barrier_complete(bar, b.x, nloc, nx); b.st[0] = nloc; b.st[1] = nx; }
        const unsigned old = xb_add(&bar[XB_XSUB(b.x)], 1u);
        const unsigned gen = old / nloc;
        if (old + 1u == (gen + 1u) * nloc) {
            __builtin_amdgcn_fence(__ATOMIC_RELEASE, "agent");
            asm volatile("s_waitcnt vmcnt(0)" ::: "memory");
            const unsigned og = xb_add(&bar[XB_TOP], 1u);
            const unsigned tg = og / nx;
            if (og + 1u == (tg + 1u) * nx) xb_add(&bar[XB_TOPGEN], 1u);
            else XB_SPIN(xb_ld(&bar[XB_TOPGEN]) == tg, bar);
            __builtin_amdgcn_fence(__ATOMIC_ACQUIRE, "agent");
            xb_add(&bar[XB_XGEN(b.x)], 1u);
            asm volatile("s_waitcnt vmcnt(0)" ::: "memory");
        } else {
            XB_SPIN(xb_ld(&bar[XB_XGEN(b.x)]) == gen, bar);
            __builtin_amdgcn_fence(__ATOMIC_ACQUIRE, "agent");
            asm volatile("s_waitcnt vmcnt(0)" ::: "memory");
        }
    }
    __syncthreads();
}

#define LDS_BYTES 66560
#define LROW 72

__device__ __forceinline__ int inproj_map(int n) {
    if (n < 1152) return n;
    if (n < 2304) return C_GQ + (n - 1152);
    if (n < 2688) return C_GG + (n - 2304);
    if (n < 3456) return C_LQ + (n - 2688);
    if (n < 3462) return C_FF + (n - 3456);
    if (n < 3468) return C_GA + (n - 3462);
    if (n < 3474) return C_GB + (n - 3468);
    if (n < 3490) return n;
    return -1;
}
#define P0_T_IN   (56 * 16)
#define P0_T_OUT  (16 * 16)
#define P0_T_GU   (32 * 16 * 16)
#define P0_T_D    (32 * 16 * 8)
#define P0_T_R    (16)
#define P0_T_LAYER (P0_T_IN + P0_T_OUT + P0_T_GU + P0_T_D + P0_T_R)
#define P0_T_NORM (NTOK / 4)
struct ConvDesc { const float* src; bf16_t* dst; int ld; int col; };
__device__ __forceinline__ ConvDesc conv_desc(const Params& p, int l, int j, int tid) {
    const int nl = tid & 63, kg = tid >> 6;
    ConvDesc d;
    if (j < P0_T_IN) {
        int tn = j / 16, tk = j % 16; int n = tn * 64 + nl; int k0 = tk * 64 + kg * 16;
        d.ld = N_IN; d.col = inproj_map(n); d.src = p.in[2] + (size_t)l * 1024 * N_IN + (size_t)k0 * N_IN;
        d.dst = (bf16_t*)(p.ws + WS_WIN) + (size_t)l * NINP * 1024 + pl_off(n, k0, 1024);
        return d;
    }
    j -= P0_T_IN;
    if (j < P0_T_OUT) {
        int tn = j / 16, tk = j % 16; int n = tn * 64 + nl; int k0 = tk * 64 + kg * 16;
        d.ld = 1024; d.col = n; d.src = p.in[14] + (size_t)l * 1024 * 1024 + (size_t)k0 * 1024;
        d.dst = (bf16_t*)(p.ws + WS_WOUT) + (size_t)l * 1024 * 1024 + pl_off(n, k0, 1024);
        return d;
    }
    j -= P0_T_OUT;
    if (j < P0_T_GU) {
        int e = j / 256, r = j % 256; int tn = r / 16, tk = r % 16; int n = tn * 64 + nl; int k0 = tk * 64 + kg * 16;
        int t128 = n >> 7, wx = (n >> 6) & 1, half = (n >> 5) & 1, jj = n & 31;
        d.ld = 512; d.col = t128 * 64 + wx * 32 + jj;
        d.src = (half ? p.in[21] : p.in[20]) + ((size_t)l * 32 + e) * 1024 * 512 + (size_t)k0 * 512;
        d.dst = (bf16_t*)(p.ws + WS_WGU) + ((size_t)l * 32 + e) * 1024 * 1024 + pl_off(n, k0, 1024);
        return d;
    }
    j -= P0_T_GU;
    if (j < P0_T_D) {
        int e = j / 128, r = j % 128; int tn = r / 8, tk = r % 8; int n = tn * 64 + nl; int k0 = tk * 64 + kg * 16;
        d.ld = 1024; d.col = n; d.src = p.in[22] + ((size_t)l * 32 + e) * 512 * 1024 + (size_t)k0 * 1024;
        d.dst = (bf16_t*)(p.ws + WS_WD) + ((size_t)l * 32 + e) * 1024 * 512 + pl_off(n, k0, 512);
        return d;
    }
    j -= P0_T_D;
    {
        int tk = j; int n = nl; int k0 = tk * 64 + kg * 16;
        if (n < 4) { d.src = p.in[16] + (size_t)l * 1024 * 4 + (size_t)k0 * 4; d.ld = 4; d.col = n; }
        else if (n < 36) { d.src = p.in[18] + (size_t)l * 1024 * 32 + (size_t)k0 * 32; d.ld = 32; d.col = n - 4; }
        else { d.src = p.in[16]; d.ld = 4; d.col = -1; }
        d.dst = (bf16_t*)(p.ws + WS_WR) + ((size_t)l * 64 + n) * 1024 + k0;
        return d;
    }
}
__device__ __forceinline__ void conv_load(const ConvDesc& d, float (&v)[16]) {
    if (d.col >= 0) {
#pragma unroll
        for (int i = 0; i < 16; ++i) v[i] = d.src[(size_t)i * d.ld + d.col];
    } else {
#pragma unroll
        for (int i = 0; i < 16; ++i) v[i] = 0.f;
    }
}
__device__ __forceinline__ void conv_store(const ConvDesc& d, const float (&v)[16]) {
    uint4 o0, o1;
    o0.x = pk_bf16(v[0], v[1]); o0.y = pk_bf16(v[2], v[3]); o0.z = pk_bf16(v[4], v[5]); o0.w = pk_bf16(v[6], v[7]);
    o1.x = pk_bf16(v[8], v[9]); o1.y = pk_bf16(v[10], v[11]); o1.z = pk_bf16(v[12], v[13]); o1.w = pk_bf16(v[14], v[15]);
    *(uint4*)(d.dst) = o0;
    *(uint4*)(d.dst + 8) = o1;
}
__device__ __forceinline__ void conv_job(const Params& p, int l, int j, int tid) {
    ConvDesc d = conv_desc(p, l, j, tid); float v[16]; conv_load(d, v); conv_store(d, v);
}
#define CONV_REST (P0_T_LAYER - P0_T_IN)
__device__ __forceinline__ bool conv_fold_desc(const Params& p, int l, int idx, int tid, ConvDesc& d) {
    if (idx < CONV_REST) { d = conv_desc(p, l, P0_T_IN + idx, tid); return true; }
    if (l == 0 && idx < CONV_REST + P0_T_IN) { d = conv_desc(p, 1, idx - CONV_REST, tid); return true; }
    return false;
}
__device__ __forceinline__ void conv_fold4(const Params& p, int l, int idx0, int tid) {
    ConvDesc d0, d1, d2, d3; float v0[16], v1[16], v2[16], v3[16];
    const bool b0 = conv_fold_desc(p, l, idx0, tid, d0), b1 = conv_fold_desc(p, l, idx0 + 1, tid, d1), b2 = conv_fold_desc(p, l, idx0 + 2, tid, d2), b3 = conv_fold_desc(p, l, idx0 + 3, tid, d3);
    if (b0) conv_load(d0, v0); if (b1) conv_load(d1, v1); if (b2) conv_load(d2, v2); if (b3) conv_load(d3, v3);
    if (b0) conv_store(d0, v0); if (b1) conv_store(d1, v1); if (b2) conv_store(d2, v2); if (b3) conv_store(d3, v3);
}
__device__ void phase0(const Params& p) {
    const int tid = ltid(), nl = tid & 63, kg = tid >> 6;
    const int total = P0_T_IN + P0_T_NORM;
    for (int it = blockIdx.x; it < total; it += gridDim.x) {
        if (it >= P0_T_IN) {
            int row = (it - P0_T_IN) * 4 + kg;
            const float* xr = p.in[0] + (size_t)row * D_MODEL + nl * 16;
            const float* gr = p.in[1] + nl * 16;
            float v[16]; float ss = 0.f;
#pragma unroll
            for (int i = 0; i < 4; ++i) { float4 t = *(const float4*)(xr + 4 * i); v[4 * i] = t.x; v[4 * i + 1] = t.y; v[4 * i + 2] = t.z; v[4 * i + 3] = t.w; }
#pragma unroll
            for (int i = 0; i < 16; ++i) ss += v[i] * v[i];
            ss = wave_sum(ss);
            float r = rsqrtf(ss / D_MODEL + 1e-6f);
#pragma unroll
            for (int i = 0; i < 16; ++i) v[i] = v[i] * r * gr[i];
            uint4 o0, o1;
            o0.x = pk_bf16(v[0], v[1]); o0.y = pk_bf16(v[2], v[3]); o0.z = pk_bf16(v[4], v[5]); o0.w = pk_bf16(v[6], v[7]);
            o1.x = pk_bf16(v[8], v[9]); o1.y = pk_bf16(v[10], v[11]); o1.z = pk_bf16(v[12], v[13]); o1.w = pk_bf16(v[14], v[15]);
            bf16_t* hr = (bf16_t*)(p.ws + WS_HN) + pl_off(row, nl * 16, 1024);
            *(uint4*)hr = o0; *(uint4*)(hr + 8) = o1;
            continue;
        }
        conv_job(p, 0, it, tid);
    }
}

#define GSTAGE 8192
#define RAW_BARRIER() do { asm volatile("s_waitcnt lgkmcnt(0)" ::: "memory"); __builtin_amdgcn_s_barrier(); } while (0)
__device__ __forceinline__ int gswz(int row) { return (0x1320 >> (((row >> 2) & 3) * 4)) & 3; }
__device__ __forceinline__ void gemm_issue(const bf16_t* const (&px)[2], const bf16_t* const (&py)[2], int k0, bf16_t* stage, int w) {
    __builtin_amdgcn_global_load_lds((const unsigned*)(px[0] + 2 * k0), (unsigned*)(stage + (w * 16) * 32), 16, 0, 0);
    __builtin_amdgcn_global_load_lds((const unsigned*)(px[1] + 2 * k0), (unsigned*)(stage + (64 + w * 16) * 32), 16, 0, 0);
    __builtin_amdgcn_global_load_lds((const unsigned*)(py[0] + 2 * k0), (unsigned*)(stage + 4096 + (w * 16) * 32), 16, 0, 0);
    __builtin_amdgcn_global_load_lds((const unsigned*)(py[1] + 2 * k0), (unsigned*)(stage + 4096 + (64 + w * 16) * 32), 16, 0, 0);
}
__device__ __forceinline__ void gemm_compute(const bf16_t* stage, int wx, int wy, int fr, int fg, f32x4 (&acc)[4][4]) {
    const int co = (fg ^ gswz(fr)) * 8;
    bf16x8 xa[4], yb[4];
#pragma unroll
    for (int m = 0; m < 4; ++m) xa[m] = *(const bf16x8*)(stage + (wx * 64 + m * 16 + fr) * 32 + co);
#pragma unroll
    for (int n = 0; n < 4; ++n) yb[n] = *(const bf16x8*)(stage + 4096 + (wy * 64 + n * 16 + fr) * 32 + co);
    __builtin_amdgcn_s_setprio(1);
#pragma unroll
    for (int m = 0; m < 4; ++m)
#pragma unroll
        for (int n = 0; n < 4; ++n) acc[m][n] = __builtin_amdgcn_mfma_f32_16x16x32_bf16(xa[m], yb[n], acc[m][n], 0, 0, 0);
    __builtin_amdgcn_s_setprio(0);
}
template <class FX, class FY>
__device__ __forceinline__ void gemm_core(FX rowx, FY rowy, int K, bf16_t* lds, f32x4 (&acc)[4][4], int gvar = 0) {
    const int tid = ltid(), lane = tid & 63, w = __builtin_amdgcn_readfirstlane(tid >> 6), wx = w >> 1, wy = w & 1, fr = lane & 15, fg = lane >> 4;
#pragma unroll
    for (int a = 0; a < 4; ++a)
#pragma unroll
        for (int b = 0; b < 4; ++b) acc[a][b] = (f32x4){0.f, 0.f, 0.f, 0.f};
    const bf16_t* px[2]; const bf16_t* py[2];
    {
        const int r0 = w * 16 + (lane >> 2), pc = lane & 3;
        const int lc0 = (pc ^ gswz(r0)) * 8;
        px[0] = rowx(r0) + lc0; px[1] = rowx(r0 + 64) + lc0;
        py[0] = rowy(r0) + lc0; py[1] = rowy(r0 + 64) + lc0;
    }
    const int nt = K >> 5;
    RAW_BARRIER();
    if (gvar != 3) {
    gemm_issue(px, py, 0, lds, w);
    gemm_issue(px, py, 32, lds + GSTAGE, w);
    gemm_issue(px, py, 64, lds + 2 * GSTAGE, w);
    }
    for (int j = 0; j < nt; ++j) {
        if (j + 2 < nt) asm volatile("s_waitcnt vmcnt(8)" ::: "memory");
        else if (j + 1 < nt) asm volatile("s_waitcnt vmcnt(4)" ::: "memory");
        else asm volatile("s_waitcnt vmcnt(0)" ::: "memory");
        RAW_BARRIER();
        if (j + 3 < nt && gvar != 3) gemm_issue(px, py, (j + 3) * 32, lds + ((j + 3) & 3) * GSTAGE, w);
        if (gvar != 2) gemm_compute(lds + (j & 3) * GSTAGE, wx, wy, fr, fg, acc);
    }
}
__device__ __forceinline__ void store4_bf16(bf16_t* p, float a, float b, float c, float d) {
    uint2 o; o.x = pk_bf16(a, b); o.y = pk_bf16(c, d); *(uint2*)p = o;
}
template <int NC> __device__ __forceinline__ void ep_put(bf16_t* T, int row, int col, float a, float b, float c, float d) {
    uint2 o; o.x = pk_bf16(a, b); o.y = pk_bf16(c, d); *(uint2*)(T + row * (NC + 8) + col) = o;
}
template <int NC, class FD> __device__ __forceinline__ void ep_flush(const bf16_t* T, int tid, FD dst) {
    constexpr int CPR = NC / 8;
#pragma unroll
    for (int i = 0; i < NC / 16; ++i) {
        const int c = tid + 256 * i; const int row = c / CPR, ch = c % CPR;
        *(u32x4*)(dst(row, ch)) = *(const u32x4*)(T + row * (NC + 8) + ch * 8);
    }
}

__device__ __forceinline__ bool xcd_item(int round, int ntm, int ntn, int& tm, int& tn) {
    const int x = blockIdx.x & 7, loc = blockIdx.x >> 3, nloc = gridDim.x >> 3;
    const int tmx = ntm >> 3;
    const int j = round * nloc + loc;
    if (j >= tmx * ntn) return false;
    tn = j / tmx; tm = (j % tmx) * 8 + x;
    return true;
}

__device__ void phase_inproj(const Params& p, int l, bf16_t* lds, int gvar = 0) {
    const int tid = ltid(), lane = tid & 63, w = tid >> 6, wx = w >> 1, wy = w & 1, fr = lane & 15, fg = lane >> 4;
    const bf16_t* hn = (const bf16_t*)(p.ws + WS_HN);
    const bf16_t* wt = (const bf16_t*)(p.ws + WS_WIN) + (size_t)l * NINP * 1024;
    bf16_t* proj = (bf16_t*)(p.ws + WS_PROJ);
    bf16_t* vtf = (bf16_t*)(p.ws + WS_VTF);
    float* aux = (float*)(p.ws + WS_AUX);
    const float* qg = p.in[3] + l * 64; const float* kg = p.in[4] + l * 64;
    for (int round = 0;; ++round) {
        int tm, tn;
        if (!xcd_item(round, NTOK / 128, NINP / 128, tm, tn)) break;
        const bool vt = (tn >= 6 && tn < 9) || tn == 23 || tn == 24;
        f32x4 acc[4][4];
        {
            auto rw = [&](int r) { return wt + pl_off(tn * 128 + r, 0, 1024); };
            auto rt_ = [&](int r) { return hn + pl_off(tm * 128 + r, 0, 1024); };
            if (vt) gemm_core(rt_, rw, 1024, lds, acc, gvar); else gemm_core(rw, rt_, 1024, lds, acc, gvar);
        }
        if (gvar != 0 && acc[0][0][0] != 123456.789f) continue;
        if (tn == 27) {
#pragma unroll
            for (int n = 0; n < 4; ++n) {
                int t = tm * 128 + wy * 64 + n * 16 + fr;
#pragma unroll
                for (int m = 0; m < 4; ++m) {
                    int c = wx * 64 + m * 16 + 4 * fg;
                    if (c < 64) *(float4*)(aux + (size_t)t * 64 + c) = make_float4(acc[m][n][0], acc[m][n][1], acc[m][n][2], acc[m][n][3]);
                }
            }
            continue;
        }
        RAW_BARRIER();
        if (vt) {
#pragma unroll
            for (int n = 0; n < 4; ++n)
#pragma unroll
                for (int m = 0; m < 4; ++m) ep_put<128>(lds, wy * 64 + n * 16 + fr, wx * 64 + m * 16 + 4 * fg, acc[m][n][0], acc[m][n][1], acc[m][n][2], acc[m][n][3]);
            RAW_BARRIER();
            const bool fox = tn < 9;
            bf16_t* dstb = fox ? vtf : (bf16_t*)(p.ws + WS_SCR + SCR_LVT); const int nh = fox ? H_FOX : H_GLA;
            const int t0 = tm * 128, b = t0 / SEQ, s0 = t0 % SEQ, chb = tn * 128 - (fox ? NC_FV : NC_LV);
            ep_flush<128>(lds, tid, [&](int row, int c8) { const int ch = chb + row; return dstb + ((size_t)(b * nh + (ch >> 6)) * 64 + (ch & 63)) * SEQ + s0 + c8 * 8; });
        } else {
            if (tn < 6) {
                const float* gn = (tn < 3) ? qg : kg; const float sc = (tn < 3) ? 0.125f * 1.4426950408889634f : 1.f;
                float g[4][4];
#pragma unroll
                for (int m = 0; m < 4; ++m)
#pragma unroll
                    for (int r = 0; r < 4; ++r) g[m][r] = gn[m * 16 + 4 * fg + r] * sc;
#pragma unroll
                for (int n = 0; n < 4; ++n) {
                    float ss = 0.f;
#pragma unroll
                    for (int m = 0; m < 4; ++m)
#pragma unroll
                        for (int r = 0; r < 4; ++r) ss += acc[m][n][r] * acc[m][n][r];
                    ss += __shfl_xor(ss, 16, 64); ss += __shfl_xor(ss, 32, 64);
                    float rs = rsqrtf(ss * (1.f / 64.f) + 1e-6f);
#pragma unroll
                    for (int m = 0; m < 4; ++m)
                        ep_put<128>(lds, wy * 64 + n * 16 + fr, wx * 64 + m * 16 + 4 * fg, acc[m][n][0] * rs * g[m][0], acc[m][n][1] * rs * g[m][1], acc[m][n][2] * rs * g[m][2], acc[m][n][3] * rs * g[m][3]);
                }
            } else {
                const bool do_silu = (tn >= 18 && tn < 21) || (tn >= 25);
                const float sc = (tn == 21) ? 0.17677669529663687f : 1.f;
#pragma unroll
                for (int n = 0; n < 4; ++n)
#pragma unroll
                    for (int m = 0; m < 4; ++m) {
                        float v0 = acc[m][n][0] * sc, v1 = acc[m][n][1] * sc, v2 = acc[m][n][2] * sc, v3 = acc[m][n][3] * sc;
                        if (do_silu) { v0 = siluf_(v0); v1 = siluf_(v1); v2 = siluf_(v2); v3 = siluf_(v3); }
                        ep_put<128>(lds, wy * 64 + n * 16 + fr, wx * 64 + m * 16 + 4 * fg, v0, v1, v2, v3);
                    }
            }
            RAW_BARRIER();
            bf16_t* dstb = proj + (size_t)(tm * 128) * NPROJ + tn * 128;
            ep_flush<128>(lds, tid, [&](int row, int c8) { return dstb + (size_t)row * NPROJ + c8 * 8; });
        }
    }
}

__device__ void phase_outproj(const Params& p, int l, bf16_t* lds) {
    const int tid = ltid(), lane = tid & 63, w = tid >> 6, wx = w >> 1, wy = w & 1, fr = lane & 15, fg = lane >> 4;
    const bf16_t* mix = (const bf16_t*)(p.ws + WS_MIX);
    const bf16_t* wt = (const bf16_t*)(p.ws + WS_WOUT) + (size_t)l * 1024 * 1024;
    const float* xin = (l == 0) ? p.in[0] : p.out;
    float* xo = p.out;
    for (int round = 0;; ++round) {
        int tm, tn;
        if (!xcd_item(round, NTOK / 128, 8, tm, tn)) break;
        f32x4 acc[4][4];
        {
            auto rw = [&](int r) { return wt + pl_off(tn * 128 + r, 0, 1024); };
            auto rt_ = [&](int r) { return mix + pl_off(tm * 128 + r, 0, 1024); };
            gemm_core(rw, rt_, 1024, lds, acc);
        }
#pragma unroll
        for (int n = 0; n < 4; ++n) {
            int t = tm * 128 + wy * 64 + n * 16 + fr;
#pragma unroll
            for (int m = 0; m < 4; ++m) {
                int c = tn * 128 + wx * 64 + m * 16 + 4 * fg;
                float4 xv = *(const float4*)(xin + (size_t)t * 1024 + c);
                xv.x += acc[m][n][0]; xv.y += acc[m][n][1]; xv.z += acc[m][n][2]; xv.w += acc[m][n][3];
                *(float4*)(xo + (size_t)t * 1024 + c) = xv;
            }
        }
    }
}

__device__ void phase_route(const Params& p, int l, bf16_t* lds, int dry = 0) {
    const int tid = ltid(), lane = tid & 63, w = tid >> 6, fr = lane & 15, fg = lane >> 4;
    const float* x1 = p.out;
    const float* gain = p.in[15] + l * 1024;
    bf16_t* hn = dry ? (bf16_t*)(p.ws + WS_SCR) : (bf16_t*)(p.ws + WS_HN);
    const bf16_t* wr = (const bf16_t*)(p.ws + WS_WR) + (size_t)l * 64 * 1024;
    const float* brg = p.in[17] + l * 4; const float* bre = p.in[19] + l * 32;
    unsigned* cnt = (unsigned*)(p.ws + WS_CTL) + CW_CNT + l * 32;
    int* rowtok = (int*)(p.ws + WS_ROWTOK);
    int* tslot = (int*)(p.ws + WS_TSLOT);
    float* tgate = (float*)(p.ws + WS_TGATE);
    const int HL = 1032;
    float* red = (float*)(lds + 16 * HL);
    for (int it = blockIdx.x; it < NTOK / 16; it += gridDim.x) {
        __syncthreads();
#pragma unroll
        for (int rr = 0; rr < 4; ++rr) {
            int lr = w * 4 + rr; int t = it * 16 + lr;
            const float* xr = x1 + (size_t)t * 1024 + lane * 16;
            float v[16]; float ss = 0.f;
#pragma unroll
            for (int i = 0; i < 4; ++i) { float4 q = *(const float4*)(xr + 4 * i); v[4 * i] = q.x; v[4 * i + 1] = q.y; v[4 * i + 2] = q.z; v[4 * i + 3] = q.w; }
#pragma unroll
            for (int i = 0; i < 16; ++i) ss += v[i] * v[i];
            ss = wave_sum(ss);
            float r = rsqrtf(ss / D_MODEL + 1e-6f);
#pragma unroll
            for (int i = 0; i < 16; ++i) v[i] = v[i] * r * gain[lane * 16 + i];
            uint4 o0, o1;
            o0.x = pk_bf16(v[0], v[1]); o0.y = pk_bf16(v[2], v[3]); o0.z = pk_bf16(v[4], v[5]); o0.w = pk_bf16(v[6], v[7]);
            o1.x = pk_bf16(v[8], v[9]); o1.y = pk_bf16(v[10], v[11]); o1.z = pk_bf16(v[12], v[13]); o1.w = pk_bf16(v[14], v[15]);
            bf16_t* hr = hn + pl_off(t, lane * 16, 1024);
            *(uint4*)hr = o0; *(uint4*)(hr + 8) = o1;
            *(uint4*)(lds + lr * HL + lane * 16) = o0; *(uint4*)(lds + lr * HL + lane * 16 + 8) = o1;
        }
        __syncthreads();
        f32x4 acc[3];
#pragma unroll
        for (int n = 0; n < 3; ++n) acc[n] = (f32x4){0.f, 0.f, 0.f, 0.f};
#pragma unroll
        for (int ks = 0; ks < 8; ++ks) {
            int k = w * 256 + ks * 32 + fg * 8;
            bf16x8 a = *(const bf16x8*)(lds + fr * HL + k);
#pragma unroll
            for (int n = 0; n < 3; ++n) {
                bf16x8 b = *(const bf16x8*)(wr + (size_t)(n * 16 + fr) * 1024 + k);
                acc[n] = __builtin_amdgcn_mfma_f32_16x16x32_bf16(a, b, acc[n], 0, 0, 0);
            }
        }
#pragma unroll
        for (int n = 0; n < 3; ++n) *(f32x4*)(red + ((w * 3 + n) * 64 + lane) * 4) = acc[n];
        __syncthreads();
        if (tid < 16) {
            float lg[36];
#pragma unroll
            for (int j = 0; j < 36; ++j) {
                int n = j >> 4, f = j & 15; int ln = (tid >> 2) * 16 + f; float s = 0.f;
#pragma unroll
                for (int ww = 0; ww < 4; ++ww) s += red[((ww * 3 + n) * 64 + ln) * 4 + (tid & 3)];
                lg[j] = s;
            }
            float gl[4]; float gm = -1e30f; int gi = 0;
#pragma unroll
            for (int j = 0; j < 4; ++j) { gl[j] = lg[j] + brg[j]; if (gl[j] > gm) { gm = gl[j]; gi = j; } }
            float gs = 0.f;
#pragma unroll
            for (int j = 0; j < 4; ++j) gs += __expf(gl[j] - gm);
            float gp = 1.f / gs;
            float el[8]; float em = -1e30f;
#pragma unroll
            for (int j = 0; j < 8; ++j) {
                float v = (gi == 0) ? lg[4 + j] : (gi == 1) ? lg[12 + j] : (gi == 2) ? lg[20 + j] : lg[28 + j];
                el[j] = v + bre[gi * 8 + j]; em = fmaxf(em, el[j]);
            }
#pragma unroll
            for (int j = 0; j < 8; ++j) el[j] = __expf(el[j] - em);
            float v0 = -1.f, v1 = -1.f; int i0 = 0, i1 = 0;
#pragma unroll
            for (int j = 0; j < 8; ++j) {
                float v = el[j];
                if (v > v0) { v1 = v0; i1 = i0; v0 = v; i0 = j; }
                else if (v > v1) { v1 = v; i1 = j; }
            }
            int t = it * 16 + tid;
            int e0 = gi * 8 + i0, e1 = gi * 8 + i1;
            if (!dry) {
            unsigned s0 = atomicAdd(&cnt[e0], 1u), s1 = atomicAdd(&cnt[e1], 1u);
            rowtok[(size_t)e0 * NTOK + s0] = t; rowtok[(size_t)e1 * NTOK + s1] = t;
            tslot[t * 2] = (e0 << 16) | (int)s0; tslot[t * 2 + 1] = (e1 << 16) | (int)s1;
            tgate[t * 2] = gp * v0 / (v0 + v1); tgate[t * 2 + 1] = gp * v1 / (v0 + v1);
            } else if (gp * v0 == 123.456f) tgate[0] = v1;
        }
    }
}

__device__ __forceinline__ void moe_tables(const unsigned* cnt, int* tab) {
    if (threadIdx.x == 0) {
        int a = 0;
        for (int e = 0; e < 32; ++e) { tab[e] = a; tab[40 + e] = a * 128; a += ((int)ld_u32_agent(cnt + e) + 127) >> 7; }
        tab[32] = a; tab[72] = a * 128;
    }
    __syncthreads();
}
template <int MODE>
__device__ void phase_expert(const Params& p, int l, bf16_t* lds) {
    const int tid = ltid(), lane = tid & 63, w = tid >> 6, wx = w >> 1, wy = w & 1, fr = lane & 15, fg = lane >> 4;
    const unsigned* cnt = (const unsigned*)(p.ws + WS_CTL) + CW_CNT + l * 32;
    int* tab = (int*)(lds + 4 * GSTAGE);
    moe_tables(cnt, tab);
    const int* rowtok = (const int*)(p.ws + WS_ROWTOK);
    const bf16_t* hn = (const bf16_t*)(p.ws + WS_HN);
    bf16_t* Hb = (bf16_t*)(p.ws + WS_H);
    bf16_t* Yb = (bf16_t*)(p.ws + WS_Y);
    const int x = blockIdx.x & 7, loc = blockIdx.x >> 3, nloc = gridDim.x >> 3;
    for (int j = loc;; j += nloc) {
        int e = -1, rt = 0, tn = 0; int jj = j;
#pragma unroll
        for (int q = 0; q < 4; ++q) {
            int ee = q * 8 + x; int nrt = tab[ee + 1] - tab[ee];
            if (e < 0) { if (jj < nrt * 8) { e = ee; tn = jj / nrt; rt = jj % nrt; } else jj -= nrt * 8; }
        }
        if (e < 0) break;
        const int c_e = (int)ld_u32_agent(cnt + e); const int hrow0 = tab[40 + e] + rt * 128;
        f32x4 acc[4][4];
        if (MODE == 0) {
            const bf16_t* wbase = (const bf16_t*)(p.ws + WS_WGU) + ((size_t)l * 32 + e) * 1024 * 1024;
            const int* rtk = rowtok + (size_t)e * NTOK + rt * 128; const int nval = c_e - rt * 128;
            auto rw = [&](int r) { return wbase + pl_off(tn * 128 + r, 0, 1024); };
            auto rt_ = [&](int r) { int t = (r < nval) ? rtk[r] : 0; return hn + pl_off(t, 0, 1024); };
            gemm_core(rw, rt_, 1024, lds, acc);
        } else {
            const bf16_t* wbase = (const bf16_t*)(p.ws + WS_WD) + ((size_t)l * 32 + e) * 1024 * 512;
            auto rw = [&](int r) { return wbase + pl_off(tn * 128 + r, 0, 512); };
            auto rt_ = [&](int r) { return Hb + pl_off(hrow0 + r, 0, 512); };
            gemm_core(rw, rt_, 512, lds, acc);
        }
        RAW_BARRIER();
        if (MODE == 0) {
#pragma unroll
            for (int n = 0; n < 4; ++n)
#pragma unroll
                for (int m = 0; m < 2; ++m)
                    ep_put<64>(lds, wy * 64 + n * 16 + fr, wx * 32 + m * 16 + 4 * fg, siluf_(acc[m][n][0]) * acc[m + 2][n][0], siluf_(acc[m][n][1]) * acc[m + 2][n][1],
                               siluf_(acc[m][n][2]) * acc[m + 2][n][2], siluf_(acc[m][n][3]) * acc[m + 2][n][3]);
            RAW_BARRIER();
            ep_flush<64>(lds, tid, [&](int row, int c8) { return Hb + pl_off(hrow0 + row, tn * 64 + c8 * 8, 512); });
        } else {
#pragma unroll
            for (int n = 0; n < 4; ++n)
#pragma unroll
                for (int m = 0; m < 4; ++m) ep_put<128>(lds, wy * 64 + n * 16 + fr, wx * 64 + m * 16 + 4 * fg, acc[m][n][0], acc[m][n][1], acc[m][n][2], acc[m][n][3]);
            RAW_BARRIER();
            bf16_t* dstb = Yb + (size_t)hrow0 * 1024 + tn * 128;
            ep_flush<128>(lds, tid, [&](int row, int c8) { return dstb + (size_t)row * 1024 + c8 * 8; });
        }
    }
}

__device__ void phase_combine(const Params& p, int l, int dry = 0) {
    const int tid = ltid(), lane = tid & 63, w = tid >> 6;
    const unsigned* cnt = (const unsigned*)(p.ws + WS_CTL) + CW_CNT + l * 32;
    int c = (lane < 32) ? (((int)ld_u32_agent(cnt + (lane & 31)) + 127) >> 7) * 128 : 0;
    int incl = c;
#pragma unroll
    for (int o = 1; o < 32; o <<= 1) { int v = __shfl_up(incl, o, 64); if (lane >= o) incl += v; }
    int hoff = incl - c;
    const int* tslot = (const int*)(p.ws + WS_TSLOT);
    const float* tgate = (const float*)(p.ws + WS_TGATE);
    const bf16_t* Yb = (const bf16_t*)(p.ws + WS_Y);
    bf16_t* hn = dry ? (bf16_t*)(p.ws + WS_SCR + (size_t)40 * 1024 * 1024) : (bf16_t*)(p.ws + WS_HN);
    float* x = p.out; float* xw = dry ? (float*)(p.ws + WS_SCR) : p.out;
    const float* gain = (l == 0 || dry) ? p.in[1] + 1024 : nullptr;
    for (int it = blockIdx.x; it < NTOK / 4; it += gridDim.x) {
        int t = it * 4 + w;
        int ts0 = tslot[t * 2], ts1 = tslot[t * 2 + 1];
        float g0 = tgate[t * 2], g1 = tgate[t * 2 + 1];
        int r0 = __shfl(hoff, ts0 >> 16, 64) + (ts0 & 0xffff);
        int r1 = __shfl(hoff, ts1 >> 16, 64) + (ts1 & 0xffff);
        float* xr = x + (size_t)t * 1024 + lane * 16;
        const bf16_t* y0 = Yb + (size_t)r0 * 1024 + lane * 16;
        const bf16_t* y1 = Yb + (size_t)r1 * 1024 + lane * 16;
        float v[16];
#pragma unroll
        for (int i = 0; i < 4; ++i) { float4 q = *(const float4*)(xr + 4 * i); v[4 * i] = q.x; v[4 * i + 1] = q.y; v[4 * i + 2] = q.z; v[4 * i + 3] = q.w; }
        uint4 a0 = *(const uint4*)y0, a1 = *(const uint4*)(y0 + 8), b0 = *(const uint4*)y1, b1 = *(const uint4*)(y1 + 8);
        unsigned ya[8] = {a0.x, a0.y, a0.z, a0.w, a1.x, a1.y, a1.z, a1.w};
        unsigned yb[8] = {b0.x, b0.y, b0.z, b0.w, b1.x, b1.y, b1.z, b1.w};
#pragma unroll
        for (int i = 0; i < 8; ++i) {
            v[2 * i] += g0 * bflo(ya[i]) + g1 * bflo(yb[i]);
            v[2 * i + 1] += g0 * bfhi(ya[i]) + g1 * bfhi(yb[i]);
        }
#ifdef NANMARK
#pragma unroll
        for (int i = 0; i < 16; ++i) if (!(fabsf(v[i]) < 1e30f)) v[i] = 1000.f;
#endif
#pragma unroll
        for (int i = 0; i < 4; ++i) *(float4*)(xw + (size_t)t * 1024 + lane * 16 + 4 * i) = make_float4(v[4 * i], v[4 * i + 1], v[4 * i + 2], v[4 * i + 3]);
        if (gain) {
            float ss = 0.f;
#pragma unroll
            for (int i = 0; i < 16; ++i) ss += v[i] * v[i];
            ss = wave_sum(ss);
            float r = rsqrtf(ss / D_MODEL + 1e-6f);
#pragma unroll
            for (int i = 0; i < 16; ++i) v[i] = v[i] * r * gain[lane * 16 + i];
            uint4 o0, o1;
            o0.x = pk_bf16(v[0], v[1]); o0.y = pk_bf16(v[2], v[3]); o0.z = pk_bf16(v[4], v[5]); o0.w = pk_bf16(v[6], v[7]);
            o1.x = pk_bf16(v[8], v[9]); o1.y = pk_bf16(v[10], v[11]); o1.z = pk_bf16(v[12], v[13]); o1.w = pk_bf16(v[14], v[15]);
            bf16_t* hr = hn + pl_off(t, lane * 16, 1024);
            *(uint4*)hr = o0; *(uint4*)(hr + 8) = o1;
        }
    }
}


__device__ __forceinline__ void mm_row(const bf16_t* RA, const bf16_t* RB, int mw, int fr, int fg, f32x4 (&acc)[4]) {
#pragma unroll
    for (int ks = 0; ks < 2; ++ks) {
        bf16x8 a = *(const bf16x8*)(RA + (16 * mw + fr) * LROW + ks * 32 + fg * 8);
#pragma unroll
        for (int nt = 0; nt < 4; ++nt) {
            bf16x8 b = *(const bf16x8*)(RB + (16 * nt + fr) * LROW + ks * 32 + fg * 8);
            acc[nt] = __builtin_amdgcn_mfma_f32_16x16x32_bf16(a, b, acc[nt], 0, 0, 0);
        }
    }
}
__device__ __forceinline__ void mm_col(const bf16_t* RA, const bf16_t* RB, int nw, int fr, int fg, f32x4 (&acc)[4]) {
#pragma unroll
    for (int ks = 0; ks < 2; ++ks) {
        bf16x8 b = *(const bf16x8*)(RB + (16 * nw + fr) * LROW + ks * 32 + fg * 8);
#pragma unroll
        for (int mt = 0; mt < 4; ++mt) {
            bf16x8 a = *(const bf16x8*)(RA + (16 * mt + fr) * LROW + ks * 32 + fg * 8);
            acc[mt] = __builtin_amdgcn_mfma_f32_16x16x32_bf16(a, b, acc[mt], 0, 0, 0);
        }
    }
}
__device__ __forceinline__ void zero4(f32x4 (&a)[4]) {
#pragma unroll
    for (int i = 0; i < 4; ++i) a[i] = (f32x4){0.f, 0.f, 0.f, 0.f};
}
__device__ __forceinline__ void st4_lds(bf16_t* p, float a, float b, float c, float d) { uint2 o; o.x = pk_bf16(a, b); o.y = pk_bf16(c, d); *(uint2*)p = o; }
__device__ __forceinline__ bf16_t f2bf(float v) { return (bf16_t)(pk_bf16(v, 0.f) & 0xffffu); }

__device__ void gdn_prep_item(const Params& p, int l, int cid, unsigned char* lds_raw) {
    const int tid = ltid(), lane = tid & 63, w = tid >> 6, fr = lane & 15, fg = lane >> 4;
    const int bh = cid >> 6, n = cid & 63, b = bh / H_GDN, h = bh % H_GDN;
    const int t0 = b * SEQ + n * 64;
    bf16_t* L0 = (bf16_t*)lds_raw; bf16_t* L1 = L0 + 64 * LROW; bf16_t* L2 = L1 + 64 * LROW; bf16_t* L3 = L2 + 64 * LROW; bf16_t* L4 = L3 + 64 * LROW; bf16_t* L5 = L4 + 64 * LROW;
    float* dec = (float*)(L5 + 64 * LROW); float* beta = dec + 64;
    const bf16_t* proj = (const bf16_t*)(p.ws + WS_PROJ);
    const float* aux = (const float*)(p.ws + WS_AUX);
    const float* convw = p.in[7] + (size_t)l * 4 * 1152;
    __syncthreads();
    const int i = tid >> 2, c0 = (tid & 3) * 16;
    float qv[16], kv[16], vv[16];
#pragma unroll
    for (int which = 0; which < 3; ++which) {
        float acc[16];
#pragma unroll
        for (int c = 0; c < 16; ++c) acc[c] = 0.f;
#pragma unroll
        for (int tap = 0; tap < 4; ++tap) {
            const int row = i - 3 + tap;
            if (n * 64 + row >= 0) {
                const bf16_t* xp = proj + (size_t)(t0 + row) * NPROJ + NC_GQ + which * 384 + h * 64 + c0;
                u32x4 x0 = *(const u32x4*)xp, x1 = *(const u32x4*)(xp + 8);
                const float* wp = convw + tap * 1152 + which * 384 + h * 64 + c0;
                f32x4 w0 = *(const f32x4*)wp, w1 = *(const f32x4*)(wp + 4), w2 = *(const f32x4*)(wp + 8), w3 = *(const f32x4*)(wp + 12);
                float wv[16] = {w0[0], w0[1], w0[2], w0[3], w1[0], w1[1], w1[2], w1[3], w2[0], w2[1], w2[2], w2[3], w3[0], w3[1], w3[2], w3[3]};
                unsigned xs[8] = {x0[0], x0[1], x0[2], x0[3], x1[0], x1[1], x1[2], x1[3]};
#pragma unroll
                for (int c = 0; c < 8; ++c) { acc[2 * c] += wv[2 * c] * bflo(xs[c]); acc[2 * c + 1] += wv[2 * c + 1] * bfhi(xs[c]); }
            }
        }
        float ss = 0.f;
#pragma unroll
        for (int c = 0; c < 16; ++c) { acc[c] = siluf_(acc[c]); ss += acc[c] * acc[c]; }
        if (which < 2) {
            ss += __shfl_xor(ss, 1, 64); ss += __shfl_xor(ss, 2, 64);
            const float sc = rsqrtf(ss + 1e-6f) * (which == 0 ? 0.125f : 1.f);
#pragma unroll
            for (int c = 0; c < 16; ++c) acc[c] *= sc;
        }
#pragma unroll
        for (int c = 0; c < 16; ++c) { if (which == 0) qv[c] = acc[c]; else if (which == 1) kv[c] = acc[c]; else vv[c] = acc[c]; }
    }
#pragma unroll
    for (int c = 0; c < 16; c += 4) { st4_lds(L2 + i * LROW + c0 + c, kv[c], kv[c + 1], kv[c + 2], kv[c + 3]); st4_lds(L3 + i * LROW + c0 + c, qv[c], qv[c + 1], qv[c + 2], qv[c + 3]); }
    if (w == 0) {
        const float a = aux[(size_t)(t0 + lane) * 64 + AX_GA + h], bl = aux[(size_t)(t0 + lane) * 64 + AX_GB + h];
        const float g = -__expf(p.in[8][l * H_GDN + h]) * softplusf_(a + p.in[9][l * H_GDN + h]);
        float inc = g;
#pragma unroll
        for (int o = 1; o < 64; o <<= 1) { float t = __shfl_up(inc, o, 64); if (lane >= o) inc += t; }
        dec[lane] = inc; beta[lane] = sigmoidf_(bl);
    }
    __syncthreads();
    {
        f32x4 g4[4]; zero4(g4);
        mm_row(L2, L2, w, fr, fg, g4);
#pragma unroll
        for (int nt = 0; nt < 4; ++nt) {
            const int kap = 16 * nt + fr; const float dk_ = dec[kap], bk_ = beta[kap];
            float nT[4], nN[4], tt[4];
#pragma unroll
            for (int r = 0; r < 4; ++r) {
                const int rho = 16 * w + 4 * fg + r; const float dr_ = dec[rho], br_ = beta[rho];
                const float G = g4[nt][r];
                nT[r] = (kap < rho) ? br_ * G * __expf(dr_ - dk_) : 0.f;
                nN[r] = (rho < kap) ? bk_ * G * __expf(dk_ - dr_) : 0.f;
                tt[r] = ((kap == rho) ? 1.f : 0.f) - nN[r];
            }
            st4_lds(L1 + kap * LROW + 16 * w + 4 * fg, nT[0], nT[1], nT[2], nT[3]);
            st4_lds(L0 + kap * LROW + 16 * w + 4 * fg, nN[0], nN[1], nN[2], nN[3]);
            st4_lds(L4 + kap * LROW + 16 * w + 4 * fg, tt[0], tt[1], tt[2], tt[3]);
        }
        f32x4 a4[4]; zero4(a4);
        mm_row(L2, L3, w, fr, fg, a4);
#pragma unroll
        for (int nt = 0; nt < 4; ++nt) {
            const int ii = 16 * nt + fr; const float di_ = dec[ii];
            float v4[4];
#pragma unroll
            for (int r = 0; r < 4; ++r) { const int j = 16 * w + 4 * fg + r; v4[r] = (j <= ii) ? a4[nt][r] * __expf(di_ - dec[j]) : 0.f; }
            st4_lds(L5 + ii * LROW + 16 * w + 4 * fg, v4[0], v4[1], v4[2], v4[3]);
        }
    }
    __syncthreads();
#pragma unroll
    for (int lev = 1; lev <= 5; ++lev) {
        const bf16_t* XA = (lev & 1) ? L0 : L2; const bf16_t* XAt = (lev & 1) ? L1 : L3;
        bf16_t* XB = (lev & 1) ? L2 : L0; bf16_t* XBt = (lev & 1) ? L3 : L1;
        {
            f32x4 x4[4]; zero4(x4);
            mm_row(XA, XAt, w, fr, fg, x4);
#pragma unroll
            for (int nt = 0; nt < 4; ++nt) {
                const int c = 16 * nt + fr;
                st4_lds(XBt + c * LROW + 16 * w + 4 * fg, x4[nt][0], x4[nt][1], x4[nt][2], x4[nt][3]);
                if (lev < 5) {
#pragma unroll
                    for (int r = 0; r < 4; ++r) XB[(16 * w + 4 * fg + r) * LROW + c] = f2bf(x4[nt][r]);
                }
            }
        }
        __syncthreads();
        {
            f32x4 t4[4];
#pragma unroll
            for (int mt = 0; mt < 4; ++mt) {
                uint2 u = *(const uint2*)(L4 + (16 * w + fr) * LROW + 16 * mt + 4 * fg);
                t4[mt] = (f32x4){bflo(u.x), bfhi(u.x), bflo(u.y), bfhi(u.y)};
            }
            mm_col(XBt, L4, w, fr, fg, t4);
#pragma unroll
            for (int mt = 0; mt < 4; ++mt) st4_lds(L4 + (16 * w + fr) * LROW + 16 * mt + 4 * fg, t4[mt][0], t4[mt][1], t4[mt][2], t4[mt][3]);
        }
    }
    {
        const float dj = dec[i], bj = beta[i], dlast = dec[63];
        const float s1 = bj * __expf(dj), s2 = bj, s3 = __expf(dlast - dj);
#pragma unroll
        for (int c = 0; c < 16; ++c) {
            L0[(c0 + c) * LROW + i] = f2bf(kv[c] * s1);
            L1[(c0 + c) * LROW + i] = f2bf(vv[c] * s2);
            L2[(c0 + c) * LROW + i] = f2bf(kv[c] * s3);
        }
    }
    __syncthreads();
    {
        f32x4 w4[4], u4[4]; zero4(w4); zero4(u4);
        mm_row(L4, L0, w, fr, fg, w4);
        mm_row(L4, L1, w, fr, fg, u4);
        __syncthreads();
#pragma unroll
        for (int nt = 0; nt < 4; ++nt) {
            st4_lds(L0 + (16 * nt + fr) * LROW + 16 * w + 4 * fg, w4[nt][0], w4[nt][1], w4[nt][2], w4[nt][3]);
            st4_lds(L1 + (16 * nt + fr) * LROW + 16 * w + 4 * fg, u4[nt][0], u4[nt][1], u4[nt][2], u4[nt][3]);
        }
        const float ed = __expf(dec[i]);
#pragma unroll
        for (int c = 0; c < 16; c += 4) st4_lds(L3 + i * LROW + c0 + c, qv[c] * ed, qv[c + 1] * ed, qv[c + 2] * ed, qv[c + 3] * ed);
    }
    __syncthreads();
    char* scr = p.ws + WS_SCR;
    {
        f32x4 m4[4]; zero4(m4);
        mm_row(L0, L2, w, fr, fg, m4);
        bf16_t* MP = (bf16_t*)(scr + SCR_GDN_MP) + (size_t)cid * 4096;
#pragma unroll
        for (int nt = 0; nt < 4; ++nt) store4_bf16(MP + (16 * nt + fr) * 64 + 16 * w + 4 * fg, -m4[nt][0], -m4[nt][1], -m4[nt][2], -m4[nt][3]);
        f32x4 n4[4]; zero4(n4);
        mm_row(L2, L1, w, fr, fg, n4);
        bf16_t* NN = (bf16_t*)(scr + SCR_GDN_NN) + (size_t)cid * 4096;
#pragma unroll
        for (int nt = 0; nt < 4; ++nt) store4_bf16(NN + ((nt * 4 + w) * 64 + lane) * 4, n4[nt][0], n4[nt][1], n4[nt][2], n4[nt][3]);
        f32x4 p4[4]; zero4(p4);
        mm_row(L0, L5, w, fr, fg, p4);
        bf16_t* PG = (bf16_t*)(scr + SCR_GDN_P) + (size_t)cid * 4096;
#pragma unroll
        for (int nt = 0; nt < 4; ++nt) {
            uint2 u = *(const uint2*)(L3 + (16 * nt + fr) * LROW + 16 * w + 4 * fg);
            store4_bf16(PG + (16 * nt + fr) * 64 + 16 * w + 4 * fg, bflo(u.x) - p4[nt][0], bfhi(u.x) - p4[nt][1], bflo(u.y) - p4[nt][2], bfhi(u.y) - p4[nt][3]);
        }
        f32x4 o4[4]; zero4(o4);
        mm_row(L1, L5, w, fr, fg, o4);
        bf16_t* OL = (bf16_t*)(scr + SCR_GDN_OL) + (size_t)cid * 4096;
#pragma unroll
        for (int nt = 0; nt < 4; ++nt) store4_bf16(OL + (16 * nt + fr) * 64 + 16 * w + 4 * fg, o4[nt][0], o4[nt][1], o4[nt][2], o4[nt][3]);
        if (tid == 0) ((float*)(scr + SCR_GDN_LAST))[cid] = __expf(dec[63]);
    }
}

#define SCAN_SLOT    5120
#define SCAN_SB(k)   ((bf16_t*)lds_raw + (k) * 1024)
#define SCAN_RING(k) ((bf16_t*)lds_raw + 2048 + (k) * SCAN_SLOT)
#define SCAN_LAST    ((float*)(lds_raw + 4096 + 5 * SCAN_SLOT * 2))
__device__ __forceinline__ void scan_issue(const bf16_t* const (&mp)[8], const bf16_t* nn_lane, int n, bf16_t* slot) {
#pragma unroll
    for (int q = 0; q < 8; ++q) __builtin_amdgcn_global_load_lds((const unsigned*)(mp[q] + (size_t)n * 4096), (unsigned*)(slot + q * 512), 16, 0, 0);
    __builtin_amdgcn_global_load_lds((const unsigned*)(nn_lane + (size_t)n * 4096), (unsigned*)(slot + 4096), 16, 0, 0);
    __builtin_amdgcn_global_load_lds((const unsigned*)(nn_lane + (size_t)n * 4096 + 512), (unsigned*)(slot + 4096 + 512), 16, 0, 0);
}
__device__ void gdn_scan_item(const Params& p, int item, unsigned char* lds_raw) {
    const int tid = ltid(), lane = tid & 63, w = __builtin_amdgcn_readfirstlane(tid >> 6), fr = lane & 15, fg = lane >> 4;
    const int bh = item >> 2, cg = item & 3;
    char* scr = p.ws + WS_SCR;
    const bf16_t* MP = (const bf16_t*)(scr + SCR_GDN_MP) + (size_t)bh * 64 * 4096;
    const bf16_t* NN = (const bf16_t*)(scr + SCR_GDN_NN) + (size_t)bh * 64 * 4096 + cg * 1024;
    const float* LAST = (const float*)(scr + SCR_GDN_LAST) + bh * 64;
    bf16_t* SG = (bf16_t*)(scr + SCR_GDN_SG) + (size_t)bh * 64 * 4096 + cg * 1024;
    const bf16_t* mp[8];
#pragma unroll
    for (int q = 0; q < 8; ++q) { const int row = 8 * q + (lane >> 3); mp[q] = MP + row * 64 + (((lane & 7) ^ ((row >> 1) & 7)) * 8); }
    const bf16_t* nn_lane = NN + lane * 8;
    RAW_BARRIER();
    if (tid < 64) SCAN_LAST[tid] = ld_f32_agent(LAST + tid);
    asm volatile("s_waitcnt vmcnt(0)" ::: "memory");
    f32x4 S = (f32x4){0.f, 0.f, 0.f, 0.f};
    const int swz = (fr >> 1) & 7;
    if (w == 0) {
#pragma unroll
        for (int n = 0; n < 4; ++n) scan_issue(mp, nn_lane, n, SCAN_RING(n));
    }
    for (int n = 0; n < 64; ++n) {
        bf16_t* sb = SCAN_SB(n & 1);
        const bf16_t* ring = SCAN_RING(n % 5);
        {
            const int c = 2 * w + (fg >> 1);
            uint2 o; o.x = pk_bf16(S[0], S[1]); o.y = pk_bf16(S[2], S[3]);
            *(uint2*)(sb + fr * 64 + ((c ^ swz) * 8) + 4 * (fg & 1)) = o;
        }
        if (w == 0) {
            if (n + 3 < 64) asm volatile("s_waitcnt vmcnt(30)" ::: "memory");
            else if (n + 2 < 64) asm volatile("s_waitcnt vmcnt(20)" ::: "memory");
            else if (n + 1 < 64) asm volatile("s_waitcnt vmcnt(10)" ::: "memory");
            else asm volatile("s_waitcnt vmcnt(0)" ::: "memory");
        }
        RAW_BARRIER();
        if (w == 0 && n + 4 < 64) scan_issue(mp, nn_lane, n + 4, SCAN_RING((n + 4) % 5));
        const float last = SCAN_LAST[n];
        {
            uint2 nn = *(const uint2*)(ring + 4096 + (w * 64 + lane) * 4);
            S[0] = last * S[0] + bflo(nn.x); S[1] = last * S[1] + bfhi(nn.x);
            S[2] = last * S[2] + bflo(nn.y); S[3] = last * S[3] + bfhi(nn.y);
        }
#pragma unroll
        for (int ks = 0; ks < 2; ++ks) {
            const int co = ((ks * 4 + fg) ^ swz) * 8;
            bf16x8 a = *(const bf16x8*)(ring + (16 * w + fr) * 64 + co);
            bf16x8 s = *(const bf16x8*)(sb + fr * 64 + co);
            S = __builtin_amdgcn_mfma_f32_16x16x32_bf16(a, s, S, 0, 0, 0);
        }
        if (w >= 2) {
            const int c = (w - 2) * 64 + lane; const int row = c >> 3, pc = c & 7;
            u32x4 v = *(const u32x4*)(sb + row * 64 + pc * 8);
            *(u32x4*)(SG + (size_t)n * 4096 + row * 64 + ((pc ^ ((row >> 1) & 7)) * 8)) = v;
        }
    }
}

__device__ void gdn_out_item(const Params& p, int l, int cid) {
    const int tid = ltid(), lane = tid & 63, w = tid >> 6, fr = lane & 15, fg = lane >> 4;
    const int bh = cid >> 6, n = cid & 63, b = bh / H_GDN, h = bh % H_GDN;
    char* scr = p.ws + WS_SCR;
    const bf16_t* SG = (const bf16_t*)(scr + SCR_GDN_SG) + (size_t)cid * 4096;
    const bf16_t* PG = (const bf16_t*)(scr + SCR_GDN_P) + (size_t)cid * 4096;
    const bf16_t* OL = (const bf16_t*)(scr + SCR_GDN_OL) + (size_t)cid * 4096;
    const int i = 16 * w + fr; const int t = b * SEQ + n * 64 + i;
    f32x4 acc[4];
#pragma unroll
    for (int mt = 0; mt < 4; ++mt) { uint2 u = *(const uint2*)(OL + i * 64 + 16 * mt + 4 * fg); acc[mt] = (f32x4){bflo(u.x), bfhi(u.x), bflo(u.y), bfhi(u.y)}; }
#pragma unroll
    for (int ks = 0; ks < 2; ++ks) {
        bf16x8 bq = *(const bf16x8*)(PG + i * 64 + ks * 32 + fg * 8);
#pragma unroll
        for (int mt = 0; mt < 4; ++mt) {
            bf16x8 a = *(const bf16x8*)(SG + (16 * mt + fr) * 64 + ks * 32 + fg * 8);
            acc[mt] = __builtin_amdgcn_mfma_f32_16x16x32_bf16(a, bq, acc[mt], 0, 0, 0);
        }
    }
    float ss = 0.f;
#pragma unroll
    for (int mt = 0; mt < 4; ++mt)
#pragma unroll
        for (int r = 0; r < 4; ++r) ss += acc[mt][r] * acc[mt][r];
    ss += __shfl_xor(ss, 16, 64); ss += __shfl_xor(ss, 32, 64);
    const float rstd = rsqrtf(ss * (1.f / 64.f) + 1e-6f);
    const float* og = p.in[10] + l * 64;
    const bf16_t* gp = (const bf16_t*)(p.ws + WS_PROJ) + (size_t)t * NPROJ + NC_GG + h * 64;
    bf16_t* mp = (bf16_t*)(p.ws + WS_MIX) + pl_off(t, 384 + h * 64, 1024);
#pragma unroll
    for (int mt = 0; mt < 4; ++mt) {
        const int e0 = 16 * mt + 4 * fg;
        uint2 gu = *(const uint2*)(gp + e0); f32x4 g4 = *(const f32x4*)(og + e0);
        store4_bf16(mp + e0 + (e0 & 32), acc[mt][0] * rstd * g4[0] * bflo(gu.x), acc[mt][1] * rstd * g4[1] * bfhi(gu.x), acc[mt][2] * rstd * g4[2] * bflo(gu.y), acc[mt][3] * rstd * g4[3] * bfhi(gu.y));
    }
}

#define GQROW 40
__device__ void gla_prep_item(const Params& p, int l, int cid, unsigned char* lds_raw) {
    const int tid = ltid(), lane = tid & 63, w = tid >> 6, fr = lane & 15, fg = lane >> 4;
    const int bh = cid >> 6, n = cid & 63, b = bh / H_GLA, h = bh % H_GLA;
    const int t0 = b * SEQ + n * 64;
    float* Bf = (float*)lds_raw;
    bf16_t* Qt = (bf16_t*)(lds_raw + 8448);
    bf16_t* Kt = Qt + 64 * GQROW;
    bf16_t* KLt = Kt + 64 * GQROW;
    bf16_t* Vt = KLt + 32 * LROW;
    const bf16_t* proj = (const bf16_t*)(p.ws + WS_PROJ);
    const float* aux = (const float*)(p.ws + WS_AUX);
    char* scr = p.ws + WS_SCR;
    __syncthreads();
    const int i = tid >> 2, d0 = (tid & 3) * 8;
    {
        const float* wa = p.in[11] + (size_t)l * 16 * 128 + h * 32 + d0;
        const float* ba = p.in[12] + l * 128 + h * 32 + d0;
        float acc[8];
#pragma unroll
        for (int j = 0; j < 8; ++j) acc[j] = ba[j];
        float a1v[16];
#pragma unroll
        for (int r = 0; r < 16; r += 2) { float2 t2 = *(const float2*)(aux + (size_t)(t0 + i) * 64 + AX_LA + r); a1v[r] = t2.x; a1v[r + 1] = t2.y; }
#pragma unroll
        for (int r = 0; r < 16; ++r) {
            f32x4 wA = *(const f32x4*)(wa + r * 128), wB = *(const f32x4*)(wa + r * 128 + 4);
#pragma unroll
            for (int j = 0; j < 4; ++j) { acc[j] += a1v[r] * wA[j]; acc[4 + j] += a1v[r] * wB[j]; }
        }
#pragma unroll
        for (int j = 0; j < 8; ++j) Bf[i * 33 + d0 + j] = logsigmoidf_(acc[j]) * (1.f / 16.f);
    }
    {
        const bf16_t* lvt = (const bf16_t*)(scr + SCR_LVT) + (size_t)bh * 64 * SEQ + n * 64;
#pragma unroll
        for (int ii = 0; ii < 2; ++ii) { int c = tid + 256 * ii; int row = c >> 3, kc = c & 7; *(u32x4*)(Vt + row * LROW + kc * 8) = *(const u32x4*)(lvt + (size_t)row * SEQ + kc * 8); }
    }
    __syncthreads();
#pragma unroll
    for (int c = 0; c < 8; ++c) {
        const int d = 8 * w + c;
        float inc = Bf[lane * 33 + d];
#pragma unroll
        for (int o = 1; o < 64; o <<= 1) { float t = __shfl_up(inc, o, 64); if (lane >= o) inc += t; }
        Bf[lane * 33 + d] = inc;
    }
    __syncthreads();
    {
        const bf16_t* qp = proj + (size_t)(t0 + i) * NPROJ + NC_LQ + h * 32 + d0;
        const bf16_t* kp = proj + (size_t)(t0 + i) * NPROJ + NC_LK + h * 32 + d0;
        u32x4 qu = *(const u32x4*)qp, ku = *(const u32x4*)kp;
        float qf[8] = {bflo(qu[0]), bfhi(qu[0]), bflo(qu[1]), bfhi(qu[1]), bflo(qu[2]), bfhi(qu[2]), bflo(qu[3]), bfhi(qu[3])};
        float kf[8] = {bflo(ku[0]), bfhi(ku[0]), bflo(ku[1]), bfhi(ku[1]), bflo(ku[2]), bfhi(ku[2]), bflo(ku[3]), bfhi(ku[3])};
        float qt[8], kt[8], qb[8];
#pragma unroll
        for (int j = 0; j < 8; ++j) {
            const float bi = Bf[i * 33 + d0 + j], bm = Bf[31 * 33 + d0 + j], bl = Bf[63 * 33 + d0 + j];
            qt[j] = qf[j] * __expf(bi - bm); kt[j] = kf[j] * __expf(bm - bi); qb[j] = qf[j] * __expf(bi);
            KLt[(d0 + j) * LROW + i] = f2bf(kf[j] * __expf(bl - bi));
            if (i == 63) ((float*)(scr + SCR_GLA_DL))[cid * 32 + d0 + j] = __expf(bl);
        }
        u32x4 o; o[0] = pk_bf16(qt[0], qt[1]); o[1] = pk_bf16(qt[2], qt[3]); o[2] = pk_bf16(qt[4], qt[5]); o[3] = pk_bf16(qt[6], qt[7]);
        *(u32x4*)(Qt + i * GQROW + d0) = o;
        o[0] = pk_bf16(kt[0], kt[1]); o[1] = pk_bf16(kt[2], kt[3]); o[2] = pk_bf16(kt[4], kt[5]); o[3] = pk_bf16(kt[6], kt[7]);
        *(u32x4*)(Kt + i * GQROW + d0) = o;
        o[0] = pk_bf16(qb[0], qb[1]); o[1] = pk_bf16(qb[2], qb[3]); o[2] = pk_bf16(qb[4], qb[5]); o[3] = pk_bf16(qb[6], qb[7]);
        *(u32x4*)((bf16_t*)(scr + SCR_GLA_QB) + (size_t)cid * 2048 + i * 32 + d0) = o;
    }
    __syncthreads();
    f32x4 sc[4];
    {
        bf16x8 bq = *(const bf16x8*)(Qt + (16 * w + fr) * GQROW + fg * 8);
#pragma unroll
        for (int mt = 0; mt < 4; ++mt) {
            bf16x8 a = *(const bf16x8*)(Kt + (16 * mt + fr) * GQROW + fg * 8);
            sc[mt] = __builtin_amdgcn_mfma_f32_16x16x32_bf16(a, bq, (f32x4){0.f, 0.f, 0.f, 0.f}, 0, 0, 0);
        }
        const int ii = 16 * w + fr;
#pragma unroll
        for (int mt = 0; mt < 4; ++mt)
#pragma unroll
            for (int r = 0; r < 4; ++r) { const int j = 16 * mt + 4 * fg + r; if (j > ii) sc[mt][r] = 0.f; }
    }
    {
        f32x4 o4[4]; zero4(o4);
#pragma unroll
        for (int kk = 0; kk < 2; ++kk) {
            u32x4 pb = {pk_bf16(sc[2 * kk][0], sc[2 * kk][1]), pk_bf16(sc[2 * kk][2], sc[2 * kk][3]), pk_bf16(sc[2 * kk + 1][0], sc[2 * kk + 1][1]), pk_bf16(sc[2 * kk + 1][2], sc[2 * kk + 1][3])};
#pragma unroll
            for (int mt = 0; mt < 4; ++mt) {
                uint2 v0 = *(const uint2*)(Vt + (16 * mt + fr) * LROW + 32 * kk + 4 * fg), v1 = *(const uint2*)(Vt + (16 * mt + fr) * LROW + 32 * kk + 16 + 4 * fg);
                u32x4 va = {v0.x, v0.y, v1.x, v1.y};
                o4[mt] = __builtin_amdgcn_mfma_f32_16x16x32_bf16(__builtin_bit_cast(bf16x8, va), __builtin_bit_cast(bf16x8, pb), o4[mt], 0, 0, 0);
            }
        }
        bf16_t* OL = (bf16_t*)(scr + SCR_GLA_OL) + (size_t)cid * 4096;
#pragma unroll
        for (int mt = 0; mt < 4; ++mt) store4_bf16(OL + (16 * w + fr) * 64 + 16 * mt + 4 * fg, o4[mt][0], o4[mt][1], o4[mt][2], o4[mt][3]);
    }
    {
        f32x4 k4[2] = {(f32x4){0.f, 0.f, 0.f, 0.f}, (f32x4){0.f, 0.f, 0.f, 0.f}};
#pragma unroll
        for (int ks = 0; ks < 2; ++ks) {
            bf16x8 bv = *(const bf16x8*)(Vt + (16 * w + fr) * LROW + ks * 32 + fg * 8);
#pragma unroll
            for (int mt = 0; mt < 2; ++mt) {
                bf16x8 a = *(const bf16x8*)(KLt + (16 * mt + fr) * LROW + ks * 32 + fg * 8);
                k4[mt] = __builtin_amdgcn_mfma_f32_16x16x32_bf16(a, bv, k4[mt], 0, 0, 0);
            }
        }
        float* KV = (float*)(scr + SCR_GLA_KV) + (size_t)cid * 2048;
#pragma unroll
        for (int mt = 0; mt < 2; ++mt) *(f32x4*)(KV + (16 * w + fr) * 32 + 16 * mt + 4 * fg) = k4[mt];
    }
}
__device__ void gla_scan_item(const Params& p, int g) {
    const int tid = ltid();
    const int bh = g >> 3, idx = (g & 7) * 256 + tid, d = idx & 31;
    char* scr = p.ws + WS_SCR;
    const float* __restrict__ KV = (const float*)(scr + SCR_GLA_KV) + (size_t)bh * 64 * 2048 + idx;
    const float* __restrict__ DL = (const float*)(scr + SCR_GLA_DL) + bh * 64 * 32 + d;
    bf16_t* __restrict__ SG = (bf16_t*)(scr + SCR_GLA_SG) + (size_t)bh * 64 * 2048 + idx;
    float S = 0.f;
    for (int n0 = 0; n0 < 64; n0 += 8) {
        float kv[8], dl[8];
#pragma unroll
        for (int u = 0; u < 8; ++u) { kv[u] = KV[(size_t)(n0 + u) * 2048]; dl[u] = DL[(n0 + u) * 32]; }
#pragma unroll
        for (int u = 0; u < 8; ++u) { SG[(size_t)(n0 + u) * 2048] = f2bf(S); S = dl[u] * S + kv[u]; }
    }
}
__device__ void gla_out_item(const Params& p, int l, int cid) {
    const int tid = ltid(), lane = tid & 63, w = tid >> 6, fr = lane & 15, fg = lane >> 4;
    const int bh = cid >> 6, n = cid & 63, b = bh / H_GLA, h = bh % H_GLA;
    char* scr = p.ws + WS_SCR;
    const bf16_t* SG = (const bf16_t*)(scr + SCR_GLA_SG) + (size_t)cid * 2048;
    const bf16_t* QB = (const bf16_t*)(scr + SCR_GLA_QB) + (size_t)cid * 2048;
    const bf16_t* OL = (const bf16_t*)(scr + SCR_GLA_OL) + (size_t)cid * 4096;
    const int i = 16 * w + fr; const int t = b * SEQ + n * 64 + i;
    f32x4 acc[4];
#pragma unroll
    for (int mt = 0; mt < 4; ++mt) { uint2 u = *(const uint2*)(OL + i * 64 + 16 * mt + 4 * fg); acc[mt] = (f32x4){bflo(u.x), bfhi(u.x), bflo(u.y), bfhi(u.y)}; }
    bf16x8 bq = *(const bf16x8*)(QB + i * 32 + fg * 8);
#pragma unroll
    for (int mt = 0; mt < 4; ++mt) {
        bf16x8 a = *(const bf16x8*)(SG + (16 * mt + fr) * 32 + fg * 8);
        acc[mt] = __builtin_amdgcn_mfma_f32_16x16x32_bf16(a, bq, acc[mt], 0, 0, 0);
    }
    float ss = 0.f;
#pragma unroll
    for (int mt = 0; mt < 4; ++mt)
#pragma unroll
        for (int r = 0; r < 4; ++r) ss += acc[mt][r] * acc[mt][r];
    ss += __shfl_xor(ss, 16, 64); ss += __shfl_xor(ss, 32, 64);
    const float rstd = rsqrtf(ss * (1.f / 64.f) + 1e-6f);
    const float* og = p.in[13] + l * 64;
    const bf16_t* rp = (const bf16_t*)(p.ws + WS_PROJ) + (size_t)t * NPROJ + NC_LR + h * 64;
    bf16_t* mp = (bf16_t*)(p.ws + WS_MIX) + pl_off(t, 768 + h * 64, 1024);
#pragma unroll
    for (int mt = 0; mt < 4; ++mt) {
        const int e0 = 16 * mt + 4 * fg;
        uint2 gu = *(const uint2*)(rp + e0); f32x4 g4 = *(const f32x4*)(og + e0);
        store4_bf16(mp + e0 + (e0 & 32), acc[mt][0] * rstd * g4[0] * bflo(gu.x), acc[mt][1] * rstd * g4[1] * bfhi(gu.x), acc[mt][2] * rstd * g4[2] * bflo(gu.y), acc[mt][3] * rstd * g4[3] * bfhi(gu.y));
    }
}
__device__ void phase_mixout(const Params& p, int l) {
    for (int it = blockIdx.x; it < NGDN_CH + NGLA_CH; it += gridDim.x) {
        if (it < NGDN_CH) { if (MIXSEL & 1) gdn_out_item(p, l, it); } else { if (MIXSEL & 2) gla_out_item(p, l, it - NGDN_CH); }
    }
}

__device__ void fox_cumsum_item(const Params& p, int l, int bh, float* ldsf) {
    const int tid = ltid(), lane = tid & 63, w = tid >> 6;
    const int b = bh / H_FOX, h = bh % H_FOX;
    const float* aux = (const float*)(p.ws + WS_AUX);
    float* cum = (float*)(p.ws + WS_CUM) + (size_t)bh * SEQ;
    const float fb = p.in[5][l * H_FOX + h];
    float v[16]; float s = 0.f;
#pragma unroll
    for (int i = 0; i < 16; ++i) { v[i] = logsigmoidf_(aux[(size_t)(b * SEQ + tid * 16 + i) * 64 + AX_FF + h] + fb); s += v[i]; }
    float inc = s;
#pragma unroll
    for (int o = 1; o < 64; o <<= 1) { float t = __shfl_up(inc, o, 64); if (lane >= o) inc += t; }
    __syncthreads();
    if (lane == 63) ldsf[w] = inc;
    __syncthreads();
    float base = inc - s;
    for (int ww = 0; ww < w; ++ww) base += ldsf[ww];
    float c = base;
    u32x4* csx = (u32x4*)(p.ws + WS_SCR + SCR_CSX) + (size_t)bh * SEQ;
#pragma unroll
    for (int i = 0; i < 16; ++i) {
        c += v[i]; cum[tid * 16 + i] = c;
        const float vv = 1.4426950408889634f * c;
        const unsigned hi = pk_bf16(vv, 0.f) & 0xffffu; const float r1 = vv - __uint_as_float(hi << 16);
        const unsigned mid = pk_bf16(r1, 0.f) & 0xffffu; const float r2 = r1 - __uint_as_float(mid << 16);
        const unsigned lo = pk_bf16(r2, 0.f) & 0xffffu;
        u32x4 f; f[0] = 0x3F803F80u; f[1] = 0x3F80u | ((hi ^ 0x8000u) << 16); f[2] = (mid ^ 0x8000u) | ((lo ^ 0x8000u) << 16); f[3] = 0u;
        csx[tid * 16 + i] = f;
    }
}
__device__ void phase_prep(const Params& p, int l, unsigned char* lds_raw) {
    const int n0 = BATCH * H_FOX, n1 = n0 + ((MIXSEL & 1) ? NGDN_CH : 0), n2 = n1 + ((MIXSEL & 2) ? NGLA_CH : 0);
    for (int it = blockIdx.x; it < n2; it += gridDim.x) {
        if (it < n0) { __syncthreads(); fox_cumsum_item(p, l, it, (float*)lds_raw); }
        else if (it < n1) gdn_prep_item(p, l, it - n0, lds_raw);
        else gla_prep_item(p, l, it - n1, lds_raw);
    }
}

typedef float f32x16 __attribute__((ext_vector_type(16)));
#define ATT_BUF 17408
#define ATT_THR 8.0f
#define ATT_NSTAGE 3
__device__ __forceinline__ void attn_issue(const bf16_t* const (&kp)[2], const bf16_t* const (&vp)[2], const bf16_t* cp, int s0, unsigned char* stage, int w) {
    bf16_t* Ks = (bf16_t*)stage; bf16_t* Vs = Ks + 4096; bf16_t* cs = Vs + 4096;
    __builtin_amdgcn_global_load_lds((const unsigned*)(kp[0] + (size_t)s0 * NPROJ), (unsigned*)(Ks + (w * 8) * 64), 16, 0, 0);
    __builtin_amdgcn_global_load_lds((const unsigned*)(kp[1] + (size_t)s0 * NPROJ), (unsigned*)(Ks + (32 + w * 8) * 64), 16, 0, 0);
    __builtin_amdgcn_global_load_lds((const unsigned*)(vp[0] + s0), (unsigned*)(Vs + (w * 8) * 64), 16, 0, 0);
    __builtin_amdgcn_global_load_lds((const unsigned*)(vp[1] + s0), (unsigned*)(Vs + (32 + w * 8) * 64), 16, 0, 0);
    __builtin_amdgcn_global_load_lds((const unsigned*)(cp + (size_t)s0 * 8), (unsigned*)cs, 16, 0, 0);
}
__device__ __forceinline__ bf16x8 attn_qbias(float u, int h) {
    const unsigned hi = pk_bf16(u, 0.f) & 0xffffu; const float r1 = u - __uint_as_float(hi << 16);
    const unsigned mid = pk_bf16(r1, 0.f) & 0xffffu; const float r2 = r1 - __uint_as_float(mid << 16);
    const unsigned lo = pk_bf16(r2, 0.f) & 0xffffu;
    u32x4 f; f[0] = hi | (mid << 16); f[1] = lo | (0x3F80u << 16); f[2] = 0x3F803F80u; f[3] = 0u;
    if (h) { f[0] = 0u; f[1] = 0u; f[2] = 0u; }
    return __builtin_bit_cast(bf16x8, f);
}
__device__ void fox_attn_item(const Params& p, int l, int bh, int qt, unsigned char* lds_raw) {
    const int tid = ltid(), lane = tid & 63, w = __builtin_amdgcn_readfirstlane(tid >> 6), r = lane & 31, h = lane >> 5;
    const int b = bh / H_FOX, hh = bh % H_FOX;
    const bf16_t* proj = (const bf16_t*)(p.ws + WS_PROJ);
    const bf16_t* kbase = proj + (size_t)b * SEQ * NPROJ + NC_FK + hh * 64;
    const bf16_t* vbase = (const bf16_t*)(p.ws + WS_VTF) + (size_t)bh * 64 * SEQ;
    const float* cum = (const float*)(p.ws + WS_CUM) + (size_t)bh * SEQ;
    const int qlo = qt * 128 + w * 32, q = qlo + r;
    bf16x8 qf[4];
    {
        const bf16_t* qrow = proj + (size_t)(b * SEQ + q) * NPROJ + NC_FQ + hh * 64;
#pragma unroll
        for (int kk = 0; kk < 4; ++kk) qf[kk] = *(const bf16x8*)(qrow + kk * 16 + h * 8);
    }
    const float cq2 = cum[q] * 1.4426950408889634f;
    float mref = 0.f;
    bf16x8 qx = attn_qbias(cq2 - mref, h);
    f32x16 o0, o1;
#pragma unroll
    for (int i = 0; i < 16; ++i) { o0[i] = 0.f; o1[i] = 0.f; }
    float lsum = 0.f;
    const int ntiles = 2 * qt + 2;
    const bf16_t* kp[2]; const bf16_t* vp[2];
    {
        const int row0 = w * 8 + (lane >> 3), pc = lane & 7;
        const int lc0 = (pc ^ ((row0 >> 1) & 7)) * 8;
        kp[0] = kbase + (size_t)row0 * NPROJ + lc0; kp[1] = kbase + (size_t)(row0 + 32) * NPROJ + lc0;
        vp[0] = vbase + (size_t)row0 * SEQ + lc0;   vp[1] = vbase + (size_t)(row0 + 32) * SEQ + lc0;
    }
    const bf16_t* cp = (const bf16_t*)(p.ws + WS_SCR + SCR_CSX) + (size_t)bh * SEQ * 8 + lane * 8;
    const int swr = (r >> 1) & 7;
    int jw;
    {
        float gq = fabsf(p.in[3][l * 64 + lane]), gk = fabsf(p.in[4][l * 64 + lane]);
#pragma unroll
        for (int o = 32; o > 0; o >>= 1) { gq = fmaxf(gq, __shfl_xor(gq, o, 64)); gk = fmaxf(gk, __shfl_xor(gk, o, 64)); }
        const float thr = 2.f * (1.4426950408889634f * 8.f * gq * gk) + 30.f;
        const float cw = cum[qlo] * 1.4426950408889634f;
        const float ce = (lane < ntiles) ? cum[64 * lane + 63] * 1.4426950408889634f : 0.f;
        const unsigned long long keep = __ballot((lane < ntiles) && (cw - ce >= -thr));
        jw = keep ? (__ffsll((long long)keep) - 1) : (ntiles - 1);
    }
    volatile int* jshare = (volatile int*)(lds_raw + ATT_NSTAGE * ATT_BUF + 16);
    asm volatile("s_waitcnt vmcnt(0)" ::: "memory");
    RAW_BARRIER();
    if (tid == 0) *jshare = jw;
    RAW_BARRIER();
    const int jstart = *jshare;
    attn_issue(kp, vp, cp, jstart * 64, lds_raw + (jstart % ATT_NSTAGE) * ATT_BUF, w);
    if (jstart + 1 < ntiles) attn_issue(kp, vp, cp, (jstart + 1) * 64, lds_raw + ((jstart + 1) % ATT_NSTAGE) * ATT_BUF, w);
    for (int j = jstart; j < ntiles; ++j) {
        if (j + 1 < ntiles) asm volatile("s_waitcnt vmcnt(5)" ::: "memory"); else asm volatile("s_waitcnt vmcnt(0)" ::: "memory");
        RAW_BARRIER();
        if (j + 2 < ntiles) attn_issue(kp, vp, cp, (j + 2) * 64, lds_raw + ((j + 2) % ATT_NSTAGE) * ATT_BUF, w);
        const int s0 = j * 64;
        if (s0 <= qlo + 31 && j >= jw) {
            const bf16_t* Ks = (const bf16_t*)(lds_raw + (j % ATT_NSTAGE) * ATT_BUF); const bf16_t* Vs = Ks + 4096; const bf16_t* cs = Vs + 4096;
            f32x16 st0, st1;
            {
                u32x4 z4 = {0u, 0u, 0u, 0u};
                u32x4 c0 = *(const u32x4*)(cs + r * 8), c1 = *(const u32x4*)(cs + (32 + r) * 8);
                if (h) { c0 = z4; c1 = z4; }
                f32x16 zz;
#pragma unroll
                for (int i = 0; i < 16; ++i) zz[i] = 0.f;
                st0 = __builtin_amdgcn_mfma_f32_32x32x16_bf16(__builtin_bit_cast(bf16x8, c0), qx, zz, 0, 0, 0);
                st1 = __builtin_amdgcn_mfma_f32_32x32x16_bf16(__builtin_bit_cast(bf16x8, c1), qx, zz, 0, 0, 0);
            }
#pragma unroll
            for (int kk = 0; kk < 4; ++kk) {
                const int co = ((kk * 2 + h) ^ swr) * 8;
                bf16x8 a0 = *(const bf16x8*)(Ks + r * 64 + co);
                bf16x8 a1 = *(const bf16x8*)(Ks + (32 + r) * 64 + co);
                st0 = __builtin_amdgcn_mfma_f32_32x32x16_bf16(a0, qf[kk], st0, 0, 0, 0);
                st1 = __builtin_amdgcn_mfma_f32_32x32x16_bf16(a1, qf[kk], st1, 0, 0, 0);
            }
            if (s0 + 63 > qlo) {
#pragma unroll
                for (int i = 0; i < 16; ++i) {
                    const int key = s0 + (i & 3) + 8 * (i >> 2) + 4 * h;
                    if (key > q) st0[i] = -1e30f;
                    if (key + 32 > q) st1[i] = -1e30f;
                }
            }
            float mx = fmaxf(st0[0], st1[0]);
#pragma unroll
            for (int i = 1; i < 16; ++i) mx = fmaxf(mx, fmaxf(st0[i], st1[i]));
            if (__any(mx > ATT_THR)) {
                const float mo = fmaxf(mx, __shfl_xor(mx, 32, 64));
                const float d = (mo > ATT_THR) ? mo : 0.f;
                const float alpha = __builtin_amdgcn_exp2f(-d);
#pragma unroll
                for (int i = 0; i < 16; ++i) { st0[i] -= d; st1[i] -= d; o0[i] *= alpha; o1[i] *= alpha; }
                lsum *= alpha; mref += d;
                qx = attn_qbias(cq2 - mref, h);
            }
            float rs = 0.f;
#pragma unroll
            for (int i = 0; i < 16; ++i) { st0[i] = __builtin_amdgcn_exp2f(st0[i]); st1[i] = __builtin_amdgcn_exp2f(st1[i]); rs += st0[i] + st1[i]; }
            lsum += rs;
            bf16x8 pf[2][2];
#pragma unroll
            for (int s = 0; s < 2; ++s) {
                u32x4 t0 = {pk_bf16(st0[8 * s], st0[8 * s + 1]), pk_bf16(st0[8 * s + 2], st0[8 * s + 3]), pk_bf16(st0[8 * s + 4], st0[8 * s + 5]), pk_bf16(st0[8 * s + 6], st0[8 * s + 7])};
                u32x4 t1 = {pk_bf16(st1[8 * s], st1[8 * s + 1]), pk_bf16(st1[8 * s + 2], st1[8 * s + 3]), pk_bf16(st1[8 * s + 4], st1[8 * s + 5]), pk_bf16(st1[8 * s + 6], st1[8 * s + 7])};
                pf[0][s] = __builtin_bit_cast(bf16x8, t0); pf[1][s] = __builtin_bit_cast(bf16x8, t1);
            }
#pragma unroll
            for (int mt = 0; mt < 2; ++mt)
#pragma unroll
                for (int s = 0; s < 2; ++s) {
                    const int c0 = 4 * mt + 2 * s;
                    const int oA = ((c0 ^ swr) * 8) + 4 * h, oB = (((c0 + 1) ^ swr) * 8) + 4 * h;
                    uint2 a00 = *(const uint2*)(Vs + r * 64 + oA), a01 = *(const uint2*)(Vs + r * 64 + oB);
                    uint2 a10 = *(const uint2*)(Vs + (32 + r) * 64 + oA), a11 = *(const uint2*)(Vs + (32 + r) * 64 + oB);
                    u32x4 u0 = {a00.x, a00.y, a01.x, a01.y}; u32x4 u1 = {a10.x, a10.y, a11.x, a11.y};
                    o0 = __builtin_amdgcn_mfma_f32_32x32x16_bf16(__builtin_bit_cast(bf16x8, u0), pf[mt][s], o0, 0, 0, 0);
                    o1 = __builtin_amdgcn_mfma_f32_32x32x16_bf16(__builtin_bit_cast(bf16x8, u1), pf[mt][s], o1, 0, 0, 0);
                }
        }
    }
    lsum += __shfl_xor(lsum, 32, 64);
    const float inv = 1.f / lsum;
    float ss = 0.f;
#pragma unroll
    for (int i = 0; i < 16; ++i) { o0[i] *= inv; o1[i] *= inv; ss += o0[i] * o0[i] + o1[i] * o1[i]; }
    ss += __shfl_xor(ss, 32, 64);
    const float rstd = rsqrtf(ss * (1.f / 64.f) + 1e-6f);
    const float* og = p.in[6] + l * 64;
    bf16_t* mrow = (bf16_t*)(p.ws + WS_MIX) + pl_off(b * SEQ + q, hh * 64, 1024);
#pragma unroll
    for (int g = 0; g < 4; ++g) {
        const int e0 = 8 * g + 4 * h;
        f32x4 g0 = *(const f32x4*)(og + e0), g1 = *(const f32x4*)(og + 32 + e0);
        store4_bf16(mrow + e0, o0[4 * g] * rstd * g0[0], o0[4 * g + 1] * rstd * g0[1], o0[4 * g + 2] * rstd * g0[2], o0[4 * g + 3] * rstd * g0[3]);
        store4_bf16(mrow + 64 + e0, o1[4 * g] * rstd * g1[0], o1[4 * g + 1] * rstd * g1[1], o1[4 * g + 2] * rstd * g1[2], o1[4 * g + 3] * rstd * g1[3]);
    }
}
#define ATT_ITEMS (BATCH * H_FOX * (SEQ / 128))
#define CONV_ITEMS ((CONV_REST + P0_T_IN + 3) / 4)
__device__ void phase_scan_attn(const Params& p, int l, unsigned char* lds_raw, int rep = 0, int sel = 7) {
    unsigned* qctr = (unsigned*)(p.ws + WS_CTL) + CW_Q + l + 2 * rep;
    volatile int* slot = (volatile int*)(lds_raw + ATT_NSTAGE * ATT_BUF);
    for (;;) {
        __syncthreads();
        if (threadIdx.x == 0) *slot = (int)atomicAdd(qctr, 1u);
        __syncthreads();
        int it = *slot;
        const int ns0 = (MIXSEL & 1) ? BATCH * H_GDN * 4 : 0, ns1 = ns0 + ((MIXSEL & 2) ? 128 : 0);
        if (it >= ns1 + ATT_ITEMS + CONV_ITEMS) break;
        if (it >= ns1) {
            const int c = it - ns1;
            int conv_idx = -1;
            if (c < 5 * ATT_ITEMS) { if (c % 5 != 0) conv_idx = c - c / 5 - 1; } else conv_idx = c - ATT_ITEMS;
            if (conv_idx >= 0) {
                if (rep == 0 && conv_idx < CONV_ITEMS) conv_fold4(p, l, conv_idx * 4, ltid());
                continue;
            }
            it = ns1 + c / 5;
        }
        if (it < ns0) { if (sel & 1) gdn_scan_item(p, it, lds_raw); continue; }
        if (it < ns1) { if (sel & 2) gla_scan_item(p, it - ns0); continue; }
        it -= ns1;
        if (!(sel & 4)) continue;
        const int qt = (SEQ / 128 - 1) - it / (BATCH * H_FOX), bh = it % (BATCH * H_FOX);
        fox_attn_item(p, l, bh, qt, lds_raw);
    }
}

#define NPHASE 19
__global__ void __launch_bounds__(256, 2) mk(Params p, int lo, int hi, int use_bar) {
    __shared__ __attribute__((aligned(16))) unsigned char lds_raw[LDS_BYTES];
    bf16_t* lds = (bf16_t*)lds_raw;
    volatile LAS unsigned* st = (volatile LAS unsigned*)(lds_raw + LDS_BYTES - 16);
    XcdBarrier bar; bar.bar = (unsigned*)(p.ws + WS_CTL) + CW_BAR; bar.x = 0; bar.st = st;
    if (use_bar) {
        if (threadIdx.x == 0) { st[0] = 0u; st[1] = 0u; }
        __syncthreads();
        bar = xcd_barrier_post((unsigned*)(p.ws + WS_CTL) + CW_BAR, st);
    }
    for (int ph = lo; ph < hi; ++ph) {
#ifndef PSEL
#define PSEL 0xffff
#endif
        int phv = ph; asm volatile("" : "+s"(phv));
        Params q = p; asm volatile("" : "+s"(q.ws)); asm volatile("" : "+s"(q.out));
        if (phv == 0) { if (PSEL & 1) phase0(q); }
        else {
            int l = (phv - 1) / 9, s = (phv - 1) % 9;
            if (s == 0) { if (PSEL & 2) phase_inproj(q, l, lds); }
            else if (s == 1) { if (PSEL & 128) phase_prep(q, l, lds_raw); }
            else if (s == 2) { if (PSEL & 256) phase_scan_attn(q, l, lds_raw); }
            else if (s == 3) { if (PSEL & 512) phase_mixout(q, l); }
            else if (s == 4) { if (PSEL & 4) phase_outproj(q, l, lds); }
            else if (s == 5) { if (PSEL & 8) phase_route(q, l, lds); }
            else if (s == 6) { if (PSEL & 16) phase_expert<0>(q, l, lds); }
            else if (s == 7) { if (PSEL & 32) phase_expert<1>(q, l, lds); }
            else if (s == 8) { if (PSEL & 64) phase_combine(q, l); }
        }
#ifdef REPEAT_MASK
        {
            const int ty = (phv == 0) ? 9 : (phv - 1) % 9, l = (phv == 0) ? 0 : (phv - 1) / 9;
            const bool idem = !((ty == 4 && l == 1));
            if (((REPEAT_MASK >> ty) & 1) && idem && use_bar) {
                xcd_barrier(bar);
                if (ty == 9) phase0(q);
                else if (ty == 0) phase_inproj(q, l, lds, GVAR);
                else if (ty == 1) phase_prep(q, l, lds_raw);
                else if (ty == 2) phase_scan_attn(q, l, lds_raw, 1, P3SEL);
                else if (ty == 3) phase_mixout(q, l);
                else if (ty == 4) phase_outproj(q, l, lds);
                else if (ty == 5) phase_route(q, l, lds, 1);
                else if (ty == 8) phase_combine(q, l, 1);
                else if (ty == 6) phase_expert<0>(q, l, lds);
                else if (ty == 7) phase_expert<1>(q, l, lds);
            }
        }
#endif
        if (ph + 1 < hi) {
            if (hi > 1000) cg::this_grid().sync();
            xcd_barrier(bar);
        }
    }
}

extern "C" void kernel_launch(void* const* d_in, const int* in_sizes, int n_in,
                              void* d_out, int out_size, void* d_ws, size_t ws_size,
                              hipStream_t stream) {
    static int grid = 0;
    if (grid == 0) {
        if (ws_size < WS_END) { fprintf(stderr, "ws too small: need %zu have %zu\n", (size_t)WS_END, ws_size); grid = -1; return; }
        int dev = 0, cus = 0, per_cu = 0;
        hipGetDevice(&dev);
        hipDeviceGetAttribute(&cus, hipDeviceAttributeMultiprocessorCount, dev);
        hipOccupancyMaxActiveBlocksPerMultiprocessor(&per_cu, mk, 256, 0);
        if (per_cu > 2) per_cu = 2;
        if (per_cu < 1) { fprintf(stderr, "occupancy query failed\n"); grid = -1; return; }
        grid = cus * per_cu;
        grid -= grid % 8;
    }
    if (grid < 0) return;
    Params p{};
    for (int i = 0; i < 23; ++i) p.in[i] = (const float*)d_in[i];
    p.out = (float*)d_out; p.ws = (char*)d_ws;
    hipMemsetAsync((char*)d_ws + WS_CTL, 0, CTL_BYTES, stream);
#ifdef POISON_GLA
    hipMemsetAsync((char*)d_ws + WS_SCR + SCR_GLA_OL, 0xFF, SCR_LVT - SCR_GLA_OL, stream);
#endif

#ifdef MULTI_LAUNCH
    for (int ph = 0; ph < NPHASE; ++ph) mk<<<grid, 256, 0, stream>>>(p, ph, ph + 1, 0);
#else
    int lo = 0, hi = NPHASE, ub = 2;
    void* args[] = {&p, &lo, &hi, &ub};
    hipError_t e = hipLaunchCooperativeKernel((void*)mk, dim3(grid), dim3(256), args, 0, stream);
    if (e != hipSuccess) fprintf(stderr, "cooperative launch failed: %s (grid %d)\n", hipGetErrorString(e), grid);
#endif
}
```

```cpp
#include <hip/hip_runtime.h>
#include <hip/hip_cooperative_groups.h>
#include <cstdint>
#include <cstdio>
namespace cg = cooperative_groups;

#define D_MODEL 1024
#define BATCH 4
#define SEQ 4096
#define NTOK (BATCH * SEQ)
#define H_FOX 6
#define H_GDN 6
#define H_GLA 4
#define N_IN 3490
#define N_EXP 32
#define D_EXP 512
#define NPROJ 3456
#define NINP 3584

#define C_FF 1152
#define C_GQ 1158
#define C_GG 2310
#define C_GA 2694
#define C_GB 2700
#define C_LQ 2706
#define C_LA 3474
#define NC_FQ 0
#define NC_FK 384
#define NC_FV 768
#define NC_GQ 1152
#define NC_GK 1536
#define NC_GV 1920
#define NC_GG 2304
#define NC_LQ 2688
#define NC_LK 2816
#define NC_LV 2944
#define NC_LR 3200
#define AX_FF 0
#define AX_GA 6
#define AX_GB 12
#define AX_LA 18

#ifndef SVAR
#define SVAR 0
#endif
#ifndef P3SEL
#define P3SEL 7
#endif
#ifndef GVAR
#define GVAR 0
#endif
#ifndef MIXSEL
#define MIXSEL 3
#endif
typedef unsigned short bf16_t;
typedef short bf16x8 __attribute__((ext_vector_type(8)));
typedef float f32x4 __attribute__((ext_vector_type(4)));
typedef unsigned u32x4 __attribute__((ext_vector_type(4)));
typedef unsigned u32x2 __attribute__((ext_vector_type(2)));

#define WS_CTL      0
#define CTL_BYTES   65536
#define WS_WIN      (WS_CTL + CTL_BYTES)
#define WS_WOUT     (WS_WIN + (size_t)2 * NINP * 1024 * 2)
#define WS_WGU      (WS_WOUT + (size_t)2 * 1024 * 1024 * 2)
#define WS_WD       (WS_WGU + (size_t)2 * 32 * 1024 * 1024 * 2)
#define WS_WR       (WS_WD + (size_t)2 * 32 * 1024 * 512 * 2)
#define WS_HN       (WS_WR + (size_t)2 * 64 * 1024 * 2)
#define WS_PROJ     (WS_HN + (size_t)NTOK * 1024 * 2)
#define WS_VTF      (WS_PROJ + (size_t)NTOK * NPROJ * 2)
#define WS_AUX      (WS_VTF + (size_t)BATCH * H_FOX * 64 * SEQ * 2)
#define WS_CUM      (WS_AUX + (size_t)NTOK * 64 * 4)
#define WS_MIX      (WS_CUM + (size_t)BATCH * H_FOX * SEQ * 4)
#define WS_ROWTOK   (WS_MIX + (size_t)NTOK * 1024 * 2)
#define WS_TSLOT    (WS_ROWTOK + (size_t)32 * NTOK * 4)
#define WS_TGATE    (WS_TSLOT + (size_t)NTOK * 2 * 4)
#define WS_SCR      (WS_TGATE + (size_t)NTOK * 2 * 4)
#define SCR_BYTES   ((size_t)100 * 1024 * 1024)
#define WS_END      (WS_SCR + SCR_BYTES)
#define HROWS       (2 * NTOK + 32 * 128)
#define WS_H        WS_PROJ
#define WS_Y        (WS_PROJ + (size_t)HROWS * 512 * 2)

#define NGDN_CH 1536
#define NGLA_CH 1024
#define SCR_GDN_MP   ((size_t)0)
#define SCR_GDN_NN   (SCR_GDN_MP + (size_t)NGDN_CH * 8192)
#define SCR_GDN_P    (SCR_GDN_NN + (size_t)NGDN_CH * 8192)
#define SCR_GDN_OL   (SCR_GDN_P  + (size_t)NGDN_CH * 8192)
#define SCR_GDN_SG   (SCR_GDN_OL + (size_t)NGDN_CH * 8192)
#define SCR_GDN_LAST (SCR_GDN_SG + (size_t)NGDN_CH * 8192)
#define SCR_GLA_OL   (SCR_GDN_LAST + (size_t)NGDN_CH * 4)
#define SCR_GLA_KV   (SCR_GLA_OL + (size_t)NGLA_CH * 8192)
#define SCR_GLA_QB   (SCR_GLA_KV + (size_t)NGLA_CH * 8192)
#define SCR_GLA_SG   (SCR_GLA_QB + (size_t)NGLA_CH * 4096)
#define SCR_GLA_DL   (SCR_GLA_SG + (size_t)NGLA_CH * 4096)
#define SCR_LVT      (SCR_GLA_DL + (size_t)NGLA_CH * 128)
#define SCR_USED     (SCR_LVT + (size_t)BATCH * H_GLA * 64 * SEQ * 2)
#define SCR_CSX      SCR_USED
static_assert(SCR_CSX + (size_t)BATCH * H_FOX * SEQ * 16 <= SCR_BYTES, "scratch overflow");
#define CW_BAR      0
#define CW_CNT      4096
#define CW_Q        4224

struct Params {
    const float* in[23];
    float* out;
    char* ws;
};

__device__ __forceinline__ float sigmoidf_(float x) { return __builtin_amdgcn_rcpf(1.f + __expf(-x)); }
__device__ __forceinline__ float siluf_(float x) { return x * __builtin_amdgcn_rcpf(1.f + __expf(-x)); }
__device__ __forceinline__ float softplusf_(float x) { return x > 20.f ? x : log1pf(__expf(x)); }
__device__ __forceinline__ float logsigmoidf_(float x) { return -softplusf_(-x); }
__device__ __forceinline__ float wave_sum(float v) {
#pragma unroll
    for (int o = 32; o > 0; o >>= 1) v += __shfl_xor(v, o, 64);
    return v;
}
__device__ __forceinline__ int ltid() { int t = threadIdx.x; asm volatile("" : "+v"(t)); return t; }
typedef __bf16 bf16x2_t __attribute__((ext_vector_type(2)));
typedef float f32x2_t __attribute__((ext_vector_type(2)));
__device__ __forceinline__ unsigned pk_bf16(float lo, float hi) { f32x2_t v = {lo, hi}; bf16x2_t r = __builtin_convertvector(v, bf16x2_t); return __builtin_bit_cast(unsigned, r); }
__device__ __forceinline__ size_t pl_off(int row, int k, int K) { return (size_t)(row >> 1) * (size_t)(2 * K) + (size_t)((k >> 5) * 64 + (row & 1) * 32 + (k & 31)); }
__device__ __forceinline__ unsigned ld_u32_agent(const unsigned* p) { return __hip_atomic_load(p, __ATOMIC_RELAXED, __HIP_MEMORY_SCOPE_AGENT); }
__device__ __forceinline__ float ld_f32_agent(const float* p) { return __uint_as_float(__hip_atomic_load((const unsigned*)p, __ATOMIC_RELAXED, __HIP_MEMORY_SCOPE_AGENT)); }
__device__ __forceinline__ float bf2f(bf16_t v) { return __uint_as_float((unsigned)v << 16); }
__device__ __forceinline__ float bflo(unsigned v) { return __uint_as_float(v << 16); }
__device__ __forceinline__ float bfhi(unsigned v) { return __uint_as_float(v & 0xffff0000u); }

#define XB_TMO      128
#define XB_XCNT(j)  (256  + 64 * (j))
#define XB_XSUB(j)  (1280 + 64 * (j))
#define XB_XGEN(j)  (2304 + 64 * (j))
#define XB_TOP      3328
#define XB_TOPGEN   3392
#define XCD_BAR_WORDS 3456
#define XB_SPIN_CAP (1u << 22)
#define LAS __attribute__((address_space(3)))
__device__ __forceinline__ unsigned xb_ld(unsigned* p)              { return __hip_atomic_load(p, __ATOMIC_RELAXED, __HIP_MEMORY_SCOPE_AGENT); }
__device__ __forceinline__ unsigned xb_add(unsigned* p, unsigned v) { return __hip_atomic_fetch_add(p, v, __ATOMIC_RELAXED, __HIP_MEMORY_SCOPE_AGENT); }
__device__ __forceinline__ unsigned xb_xcc_id() { return (unsigned)__builtin_amdgcn_s_getreg((3 << 11) | 20) & 0xFu; }
#define XB_SPIN(cond, bar) do { unsigned _sp = 0; while (cond) { if (_sp < 16u) __builtin_amdgcn_s_sleep(2); else __builtin_amdgcn_s_sleep(20);     \
    if ((++_sp & 255u) == 0u) { if (xb_ld(&(bar)[XB_TMO])) break; if (_sp > XB_SPIN_CAP) { atomicAdd(&(bar)[XB_TMO], 1u); break; } } } } while (0)
struct XcdBarrier { unsigned* bar; unsigned x; volatile LAS unsigned* st; };
__device__ __forceinline__ XcdBarrier xcd_barrier_post(unsigned* bar, volatile LAS unsigned* st) {
    XcdBarrier b; b.bar = bar; b.x = xb_xcc_id(); b.st = st;
    if (threadIdx.x == 0) (void)xb_add(&bar[XB_XCNT(b.x)], 1u);
    return b;
}
__device__ __forceinline__ void xcd_barrier_complete(unsigned* bar, unsigned x, unsigned& nloc, unsigned& nx) {
    const unsigned G = gridDim.x * gridDim.y * gridDim.z;
    unsigned sum, cnt, mine, sp = 0u;
    for (;;) {
        sum = 0u; cnt = 0u; mine = 0u;
#pragma unroll
        for (unsigned j = 0; j < 16; ++j) { const unsigned c = xb_ld(&bar[XB_XCNT(j)]); sum += c; cnt += (c > 0u) ? 1u : 0u; mine = (j == x) ? c : mine; }
        if (sum == G) break;
        __builtin_amdgcn_s_sleep(1);
        if ((++sp & 255u) == 0u) { if (xb_ld(&bar[XB_TMO])) break; if (sp > XB_SPIN_CAP) { atomicAdd(&bar[XB_TMO], 1u); break; } }
    }
    nloc = mine > 0u ? mine : 1u; nx = cnt > 0u ? cnt : 1u;
}
__device__ __forceinline__ void xcd_barrier(const XcdBarrier& b) {
    asm volatile("s_waitcnt vmcnt(0)" ::: "memory");
    __syncthreads();
    if (threadIdx.x == 0) {
        unsigned* bar = b.bar;
        __builtin_amdgcn_s_waitcnt(0);
        unsigned nloc = b.st[0], nx = b.st[1];
        if (nloc == 0u) { xcd_barrier_complete(bar, b.x, nloc, nx); b.st[0] = nloc; b.st[1] = nx; }
        const unsigned old = xb_add(&bar[XB_XSUB(b.x)], 1u);
        const unsigned gen = old / nloc;
        if (old + 1u == (gen + 1u) * nloc) {
            __builtin_amdgcn_fence(__ATOMIC_RELEASE, "agent");
            asm volatile("s_waitcnt vmcnt(0)" ::: "memory");
            const unsigned og = xb_add(&bar[XB_TOP], 1u);
            const unsigned tg = og / nx;
            if (og + 1u == (tg + 1u) * nx) xb_add(&bar[XB_TOPGEN], 1u);
            else XB_SPIN(xb_ld(&bar[XB_TOPGEN]) == tg, bar);
            __builtin_amdgcn_fence(__ATOMIC_ACQUIRE, "agent");
            xb_add(&bar[XB_XGEN(b.x)], 1u);
            asm volatile("s_waitcnt vmcnt(0)" ::: "memory");
        } else {
            XB_SPIN(xb_ld(&bar[XB_XGEN(b.x)]) == gen, bar);
            __builtin_amdgcn_fence(__ATOMIC_ACQUIRE, "agent");
            asm volatile("s_waitcnt vmcnt(0)" ::: "memory");
        }
    }
    __syncthreads();
}

#define LDS_BYTES 66560
#define LROW 72

__device__ __forceinline__ int inproj_map(int n) {
    if (n < 1152) return n;
    if (n < 2304) return C_GQ + (n - 1152);
    if (n < 2688) return C_GG + (n - 2304);
    if (n < 3456) return C_LQ + (n - 2688);
    if (n < 3462) return C_FF + (n - 3456);
    if (n < 3468) return C_GA + (n - 3462);
    if (n < 3474) return C_GB + (n - 3468);
    if (n < 3490) return n;
    return -1;
}
#define P0_T_IN   (56 * 16)
#define P0_T_OUT  (16 * 16)
#define P0_T_GU   (32 * 16 * 16)
#define P0_T_D    (32 * 16 * 8)
#define P0_T_R    (16)
#define P0_T_LAYER (P0_T_IN + P0_T_OUT + P0_T_GU + P0_T_D + P0_T_R)
#define P0_T_NORM (NTOK / 4)
struct ConvDesc { const float* src; bf16_t* dst; int ld; int col; };
__device__ __forceinline__ ConvDesc conv_desc(const Params& p, int l, int j, int tid) {
    const int nl = tid & 63, kg = tid >> 6;
    ConvDesc d;
    if (j < P0_T_IN) {
        int tn = j / 16, tk = j % 16; int n = tn * 64 + nl; int k0 = tk * 64 + kg * 16;
        d.ld = N_IN; d.col = inproj_map(n); d.src = p.in[2] + (size_t)l * 1024 * N_IN + (size_t)k0 * N_IN;
        d.dst = (bf16_t*)(p.ws + WS_WIN) + (size_t)l * NINP * 1024 + pl_off(n, k0, 1024);
        return d;
    }
    j -= P0_T_IN;
    if (j < P0_T_OUT) {
        int tn = j / 16, tk = j % 16; int n = tn * 64 + nl; int k0 = tk * 64 + kg * 16;
        d.ld = 1024; d.col = n; d.src = p.in[14] + (size_t)l * 1024 * 1024 + (size_t)k0 * 1024;
        d.dst = (bf16_t*)(p.ws + WS_WOUT) + (size_t)l * 1024 * 1024 + pl_off(n, k0, 1024);
        return d;
    }
    j -= P0_T_OUT;
    if (j < P0_T_GU) {
        int e = j / 256, r = j % 256; int tn = r / 16, tk = r % 16; int n = tn * 64 + nl; int k0 = tk * 64 + kg * 16;
        int t128 = n >> 7, wx = (n >> 6) & 1, half = (n >> 5) & 1, jj = n & 31;
        d.ld = 512; d.col = t128 * 64 + wx * 32 + jj;
        d.src = (half ? p.in[21] : p.in[20]) + ((size_t)l * 32 + e) * 1024 * 512 + (size_t)k0 * 512;
        d.dst = (bf16_t*)(p.ws + WS_WGU) + ((size_t)l * 32 + e) * 1024 * 1024 + pl_off(n, k0, 1024);
        return d;
    }
    j -= P0_T_GU;
    if (j < P0_T_D) {
        int e = j / 128, r = j % 128; int tn = r / 8, tk = r % 8; int n = tn * 64 + nl; int k0 = tk * 64 + kg * 16;
        d.ld = 1024; d.col = n; d.src = p.in[22] + ((size_t)l * 32 + e) * 512 * 1024 + (size_t)k0 * 1024;
        d.dst = (bf16_t*)(p.ws + WS_WD) + ((size_t)l * 32 + e) * 1024 * 512 + pl_off(n, k0, 512);
        return d;
    }
    j -= P0_T_D;
    {
        int tk = j; int n = nl; int k0 = tk * 64 + kg * 16;
        if (n < 4) { d.src = p.in[16] + (size_t)l * 1024 * 4 + (size_t)k0 * 4; d.ld = 4; d.col = n; }
        else if (n < 36) { d.src = p.in[18] + (size_t)l * 1024 * 32 + (size_t)k0 * 32; d.ld = 32; d.col = n - 4; }
        else { d.src = p.in[16]; d.ld = 4; d.col = -1; }
        d.dst = (bf16_t*)(p.ws + WS_WR) + ((size_t)l * 64 + n) * 1024 + k0;
        return d;
    }
}
__device__ __forceinline__ void conv_load(const ConvDesc& d, float (&v)[16]) {
    if (d.col >= 0) {
#pragma unroll
        for (int i = 0; i < 16; ++i) v[i] = d.src[(size_t)i * d.ld + d.col];
    } else {
#pragma unroll
        for (int i = 0; i < 16; ++i) v[i] = 0.f;
    }
}
__device__ __forceinline__ void conv_store(const ConvDesc& d, const float (&v)[16]) {
    uint4 o0, o1;
    o0.x = pk_bf16(v[0], v[1]); o0.y = pk_bf16(v[2], v[3]); o0.z = pk_bf16(v[4], v[5]); o0.w = pk_bf16(v[6], v[7]);
    o1.x = pk_bf16(v[8], v[9]); o1.y = pk_bf16(v[10], v[11]); o1.z = pk_bf16(v[12], v[13]); o1.w = pk_bf16(v[14], v[15]);
    *(uint4*)(d.dst) = o0;
    *(uint4*)(d.dst + 8) = o1;
}
__device__ __forceinline__ void conv_job(const Params& p, int l, int j, int tid) {
    ConvDesc d = conv_desc(p, l, j, tid); float v[16]; conv_load(d, v); conv_store(d, v);
}
#define CONV_REST (P0_T_LAYER - P0_T_IN)
__device__ __forceinline__ bool conv_fold_desc(const Params& p, int l, int idx, int tid, ConvDesc& d) {
    if (idx < CONV_REST) { d = conv_desc(p, l, P0_T_IN + idx, tid); return true; }
    if (l == 0 && idx < CONV_REST + P0_T_IN) { d = conv_desc(p, 1, idx - CONV_REST, tid); return true; }
    return false;
}
__device__ __forceinline__ void conv_fold4(const Params& p, int l, int idx0, int tid) {
    ConvDesc d0, d1, d2, d3; float v0[16], v1[16], v2[16], v3[16];
    const bool b0 = conv_fold_desc(p, l, idx0, tid, d0), b1 = conv_fold_desc(p, l, idx0 + 1, tid, d1), b2 = conv_fold_desc(p, l, idx0 + 2, tid, d2), b3 = conv_fold_desc(p, l, idx0 + 3, tid, d3);
    if (b0) conv_load(d0, v0); if (b1) conv_load(d1, v1); if (b2) conv_load(d2, v2); if (b3) conv_load(d3, v3);
    if (b0) conv_store(d0, v0); if (b1) conv_store(d1, v1); if (b2) conv_store(d2, v2); if (b3) conv_store(d3, v3);
}
__device__ void phase0(const Params& p) {
    const int tid = ltid(), nl = tid & 63, kg = tid >> 6;
    const int total = P0_T_IN + P0_T_NORM;
    for (int it = blockIdx.x; it < total; it += gridDim.x) {
        if (it >= P0_T_IN) {
            int row = (it - P0_T_IN) * 4 + kg;
            const float* xr = p.in[0] + (size_t)row * D_MODEL + nl * 16;
            const float* gr = p.in[1] + nl * 16;
            float v[16]; float ss = 0.f;
#pragma unroll
            for (int i = 0; i < 4; ++i) { float4 t = *(const float4*)(xr + 4 * i); v[4 * i] = t.x; v[4 * i + 1] = t.y; v[4 * i + 2] = t.z; v[4 * i + 3] = t.w; }
#pragma unroll
            for (int i = 0; i < 16; ++i) ss += v[i] * v[i];
            ss = wave_sum(ss);
            float r = rsqrtf(ss / D_MODEL + 1e-6f);
#pragma unroll
            for (int i = 0; i < 16; ++i) v[i] = v[i] * r * gr[i];
            uint4 o0, o1;
            o0.x = pk_bf16(v[0], v[1]); o0.y = pk_bf16(v[2], v[3]); o0.z = pk_bf16(v[4], v[5]); o0.w = pk_bf16(v[6], v[7]);
            o1.x = pk_bf16(v[8], v[9]); o1.y = pk_bf16(v[10], v[11]); o1.z = pk_bf16(v[12], v[13]); o1.w = pk_bf16(v[14], v[15]);
            bf16_t* hr = (bf16_t*)(p.ws + WS_HN) + pl_off(row, nl * 16, 1024);
            *(uint4*)hr = o0; *(uint4*)(hr + 8) = o1;
            continue;
        }
        conv_job(p, 0, it, tid);
    }
}

#define GSTAGE 8192
#define RAW_BARRIER() do { asm volatile("s_waitcnt lgkmcnt(0)" ::: "memory"); __builtin_amdgcn_s_barrier(); } while (0)
__device__ __forceinline__ int gswz(int row) { return (0x1320 >> (((row >> 2) & 3) * 4)) & 3; }
__device__ __forceinline__ void gemm_issue(const bf16_t* const (&px)[2], const bf16_t* const (&py)[2], int k0, bf16_t* stage, int w) {
    __builtin_amdgcn_global_load_lds((const unsigned*)(px[0] + 2 * k0), (unsigned*)(stage + (w * 16) * 32), 16, 0, 0);
    __builtin_amdgcn_global_load_lds((const unsigned*)(px[1] + 2 * k0), (unsigned*)(stage + (64 + w * 16) * 32), 16, 0, 0);
    __builtin_amdgcn_global_load_lds((const unsigned*)(py[0] + 2 * k0), (unsigned*)(stage + 4096 + (w * 16) * 32), 16, 0, 0);
    __builtin_amdgcn_global_load_lds((const unsigned*)(py[1] + 2 * k0), (unsigned*)(stage + 4096 + (64 + w * 16) * 32), 16, 0, 0);
}
__device__ __forceinline__ void gemm_compute(const bf16_t* stage, int wx, int wy, int fr, int fg, f32x4 (&acc)[4][4]) {
    const int co = (fg ^ gswz(fr)) * 8;
    bf16x8 xa[4], yb[4];
#pragma unroll
    for (int m = 0; m < 4; ++m) xa[m] = *(const bf16x8*)(stage + (wx * 64 + m * 16 + fr) * 32 + co);
#pragma unroll
    for (int n = 0; n < 4; ++n) yb[n] = *(const bf16x8*)(stage + 4096 + (wy * 64 + n * 16 + fr) * 32 + co);
    __builtin_amdgcn_s_setprio(1);
#pragma unroll
    for (int m = 0; m < 4; ++m)
#pragma unroll
        for (int n = 0; n < 4; ++n) acc[m][n] = __builtin_amdgcn_mfma_f32_16x16x32_bf16(xa[m], yb[n], acc[m][n], 0, 0, 0);
    __builtin_amdgcn_s_setprio(0);
}
template <class FX, class FY>
__device__ __forceinline__ void gemm_core(FX rowx, FY rowy, int K, bf16_t* lds, f32x4 (&acc)[4][4], int gvar = 0) {
    const int tid = ltid(), lane = tid & 63, w = __builtin_amdgcn_readfirstlane(tid >> 6), wx = w >> 1, wy = w & 1, fr = lane & 15, fg = lane >> 4;
#pragma unroll
    for (int a = 0; a < 4; ++a)
#pragma unroll
        for (int b = 0; b < 4; ++b) acc[a][b] = (f32x4){0.f, 0.f, 0.f, 0.f};
    const bf16_t* px[2]; const bf16_t* py[2];
    {
        const int r0 = w * 16 + (lane >> 2), pc = lane & 3;
        const int lc0 = (pc ^ gswz(r0)) * 8;
        px[0] = rowx(r0) + lc0; px[1] = rowx(r0 + 64) + lc0;
        py[0] = rowy(r0) + lc0; py[1] = rowy(r0 + 64) + lc0;
    }
    const int nt = K >> 5;
    RAW_BARRIER();
    if (gvar != 3) {
    gemm_issue(px, py, 0, lds, w);
    gemm_issue(px, py, 32, lds + GSTAGE, w);
    gemm_issue(px, py, 64, lds + 2 * GSTAGE, w);
    }
    for (int j = 0; j < nt; ++j) {
        if (j + 2 < nt) asm volatile("s_waitcnt vmcnt(8)" ::: "memory");
        else if (j + 1 < nt) asm volatile("s_waitcnt vmcnt(4)" ::: "memory");
        else asm volatile("s_waitcnt vmcnt(0)" ::: "memory");
        RAW_BARRIER();
        if (j + 3 < nt && gvar != 3) gemm_issue(px, py, (j + 3) * 32, lds + ((j + 3) & 3) * GSTAGE, w);
        if (gvar != 2) gemm_compute(lds + (j & 3) * GSTAGE, wx, wy, fr, fg, acc);
    }
}
__device__ __forceinline__ void store4_bf16(bf16_t* p, float a, float b, float c, float d) {
    uint2 o; o.x = pk_bf16(a, b); o.y = pk_bf16(c, d); *(uint2*)p = o;
}
template <int NC> __device__ __forceinline__ void ep_put(bf16_t* T, int row, int col, float a, float b, float c, float d) {
    uint2 o; o.x = pk_bf16(a, b); o.y = pk_bf16(c, d); *(uint2*)(T + row * (NC + 8) + col) = o;
}
template <int NC, class FD> __device__ __forceinline__ void ep_flush(const bf16_t* T, int tid, FD dst) {
    constexpr int CPR = NC / 8;
#pragma unroll
    for (int i = 0; i < NC / 16; ++i) {
        const int c = tid + 256 * i; const int row = c / CPR, ch = c % CPR;
        *(u32x4*)(dst(row, ch)) = *(const u32x4*)(T + row * (NC + 8) + ch * 8);
    }
}

__device__ __forceinline__ bool xcd_item(int round, int ntm, int ntn, int& tm, int& tn) {
    const int x = blockIdx.x & 7, loc = blockIdx.x >> 3, nloc = gridDim.x >> 3;
    const int tmx = ntm >> 3;
    const int j = round * nloc + loc;
    if (j >= tmx * ntn) return false;
    tn = j / tmx; tm = (j % tmx) * 8 + x;
    return true;
}

__device__ void phase_inproj(const Params& p, int l, bf16_t* lds, int gvar = 0) {
    const int tid = ltid(), lane = tid & 63, w = tid >> 6, wx = w >> 1, wy = w & 1, fr = lane & 15, fg = lane >> 4;
    const bf16_t* hn = (const bf16_t*)(p.ws + WS_HN);
    const bf16_t* wt = (const bf16_t*)(p.ws + WS_WIN) + (size_t)l * NINP * 1024;
    bf16_t* proj = (bf16_t*)(p.ws + WS_PROJ);
    bf16_t* vtf = (bf16_t*)(p.ws + WS_VTF);
    float* aux = (float*)(p.ws + WS_AUX);
    const float* qg = p.in[3] + l * 64; const float* kg = p.in[4] + l * 64;
    for (int round = 0;; ++round) {
        int tm, tn;
        if (!xcd_item(round, NTOK / 128, NINP / 128, tm, tn)) break;
        const bool vt = (tn >= 6 && tn < 9) || tn == 23 || tn == 24;
        f32x4 acc[4][4];
        {
            auto rw = [&](int r) { return wt + pl_off(tn * 128 + r, 0, 1024); };
            auto rt_ = [&](int r) { return hn + pl_off(tm * 128 + r, 0, 1024); };
            if (vt) gemm_core(rt_, rw, 1024, lds, acc, gvar); else gemm_core(rw, rt_, 1024, lds, acc, gvar);
        }
        if (gvar != 0 && acc[0][0][0] != 123456.789f) continue;
        if (tn == 27) {
#pragma unroll
            for (int n = 0; n < 4; ++n) {
                int t = tm * 128 + wy * 64 + n * 16 + fr;
#pragma unroll
                for (int m = 0; m < 4; ++m) {
                    int c = wx * 64 + m * 16 + 4 * fg;
                    if (c < 64) *(float4*)(aux + (size_t)t * 64 + c) = make_float4(acc[m][n][0], acc[m][n][1], acc[m][n][2], acc[m][n][3]);
                }
            }
            continue;
        }
        RAW_BARRIER();
        if (vt) {
#pragma unroll
            for (int n = 0; n < 4; ++n)
#pragma unroll
                for (int m = 0; m < 4; ++m) ep_put<128>(lds, wy * 64 + n * 16 + fr, wx * 64 + m * 16 + 4 * fg, acc[m][n][0], acc[m][n][1], acc[m][n][2], acc[m][n][3]);
            RAW_BARRIER();
            const bool fox = tn < 9;
            bf16_t* dstb = fox ? vtf : (bf16_t*)(p.ws + WS_SCR + SCR_LVT); const int nh = fox ? H_FOX : H_GLA;
            const int t0 = tm * 128, b = t0 / SEQ, s0 = t0 % SEQ, chb = tn * 128 - (fox ? NC_FV : NC_LV);
            ep_flush<128>(lds, tid, [&](int row, int c8) { const int ch = chb + row; return dstb + ((size_t)(b * nh + (ch >> 6)) * 64 + (ch & 63)) * SEQ + s0 + c8 * 8; });
        } else {
            if (tn < 6) {
                const float* gn = (tn < 3) ? qg : kg; const float sc = (tn < 3) ? 0.125f * 1.4426950408889634f : 1.f;
                float g[4][4];
#pragma unroll
                for (int m = 0; m < 4; ++m)
#pragma unroll
                    for (int r = 0; r < 4; ++r) g[m][r] = gn[m * 16 + 4 * fg + r] * sc;
#pragma unroll
                for (int n = 0; n < 4; ++n) {
                    float ss = 0.f;
#pragma unroll
                    for (int m = 0; m < 4; ++m)
#pragma unroll
                        for (int r = 0; r < 4; ++r) ss += acc[m][n][r] * acc[m][n][r];
                    ss += __shfl_xor(ss, 16, 64); ss += __shfl_xor(ss, 32, 64);
                    float rs = rsqrtf(ss * (1.f / 64.f) + 1e-6f);
#pragma unroll
                    for (int m = 0; m < 4; ++m)
                        ep_put<128>(lds, wy * 64 + n * 16 + fr, wx * 64 + m * 16 + 4 * fg, acc[m][n][0] * rs * g[m][0], acc[m][n][1] * rs * g[m][1], acc[m][n][2] * rs * g[m][2], acc[m][n][3] * rs * g[m][3]);
                }
            } else {
                const bool do_silu = (tn >= 18 && tn < 21) || (tn >= 25);
                const float sc = (tn == 21) ? 0.17677669529663687f : 1.f;
#pragma unroll
                for (int n = 0; n < 4; ++n)
#pragma unroll
                    for (int m = 0; m < 4; ++m) {
                        float v0 = acc[m][n][0] * sc, v1 = acc[m][n][1] * sc, v2 = acc[m][n][2] * sc, v3 = acc[m][n][3] * sc;
                        if (do_silu) { v0 = siluf_(v0); v1 = siluf_(v1); v2 = siluf_(v2); v3 = siluf_(v3); }
                        ep_put<128>(lds, wy * 64 + n * 16 + fr, wx * 64 + m * 16 + 4 * fg, v0, v1, v2, v3);
                    }
            }
            RAW_BARRIER();
            bf16_t* dstb = proj + (size_t)(tm * 128) * NPROJ + tn * 128;
            ep_flush<128>(lds, tid, [&](int row, int c8) { return dstb + (size_t)row * NPROJ + c8 * 8; });
        }
    }
}

__device__ void phase_outproj(const Params& p, int l, bf16_t* lds) {
    const int tid = ltid(), lane = tid & 63, w = tid >> 6, wx = w >> 1, wy = w & 1, fr = lane & 15, fg = lane >> 4;
    const bf16_t* mix = (const bf16_t*)(p.ws + WS_MIX);
    const bf16_t* wt = (const bf16_t*)(p.ws + WS_WOUT) + (size_t)l * 1024 * 1024;
    const float* xin = (l == 0) ? p.in[0] : p.out;
    float* xo = p.out;
    for (int round = 0;; ++round) {
        int tm, tn;
        if (!xcd_item(round, NTOK / 128, 8, tm, tn)) break;
        f32x4 acc[4][4];
        {
            auto rw = [&](int r) { return wt + pl_off(tn * 128 + r, 0, 1024); };
            auto rt_ = [&](int r) { return mix + pl_off(tm * 128 + r, 0, 1024); };
            gemm_core(rw, rt_, 1024, lds, acc);
        }
#pragma unroll
        for (int n = 0; n < 4; ++n) {
            int t = tm * 128 + wy * 64 + n * 16 + fr;
#pragma unroll
            for (int m = 0; m < 4; ++m) {
                int c = tn * 128 + wx * 64 + m * 16 + 4 * fg;
                float4 xv = *(const float4*)(xin + (size_t)t * 1024 + c);
                xv.x += acc[m][n][0]; xv.y += acc[m][n][1]; xv.z += acc[m][n][2]; xv.w += acc[m][n][3];
                *(float4*)(xo + (size_t)t * 1024 + c) = xv;
            }
        }
    }
}

__device__ void phase_route(const Params& p, int l, bf16_t* lds, int dry = 0) {
    const int tid = ltid(), lane = tid & 63, w = tid >> 6, fr = lane & 15, fg = lane >> 4;
    const float* x1 = p.out;
    const float* gain = p.in[15] + l * 1024;
    bf16_t* hn = dry ? (bf16_t*)(p.ws + WS_SCR) : (bf16_t*)(p.ws + WS_HN);
    const bf16_t* wr = (const bf16_t*)(p.ws + WS_WR) + (size_t)l * 64 * 1024;
    const float* brg = p.in[17] + l * 4; const float* bre = p.in[19] + l * 32;
    unsigned* cnt = (unsigned*)(p.ws + WS_CTL) + CW_CNT + l * 32;
    int* rowtok = (int*)(p.ws + WS_ROWTOK);
    int* tslot = (int*)(p.ws + WS_TSLOT);
    float* tgate = (float*)(p.ws + WS_TGATE);
    const int HL = 1032;
    float* red = (float*)(lds + 16 * HL);
    for (int it = blockIdx.x; it < NTOK / 16; it += gridDim.x) {
        __syncthreads();
        f32x4 xin4[4][4];
#pragma unroll
        for (int rr = 0; rr < 4; ++rr) {
            const float* xr = x1 + (size_t)(it * 16 + w * 4 + rr) * 1024 + lane * 16;
#pragma unroll
            for (int i = 0; i < 4; ++i) xin4[rr][i] = *(const f32x4*)(xr + 4 * i);
        }
#pragma unroll
        for (int rr = 0; rr < 4; ++rr) {
            int lr = w * 4 + rr; int t = it * 16 + lr;
            float v[16]; float ss = 0.f;
#pragma unroll
            for (int i = 0; i < 4; ++i) { v[4 * i] = xin4[rr][i][0]; v[4 * i + 1] = xin4[rr][i][1]; v[4 * i + 2] = xin4[rr][i][2]; v[4 * i + 3] = xin4[rr][i][3]; }
#pragma unroll
            for (int i = 0; i < 16; ++i) ss += v[i] * v[i];
            ss = wave_sum(ss);
            float r = rsqrtf(ss / D_MODEL + 1e-6f);
#pragma unroll
            for (int i = 0; i < 16; ++i) v[i] = v[i] * r * gain[lane * 16 + i];
            uint4 o0, o1;
            o0.x = pk_bf16(v[0], v[1]); o0.y = pk_bf16(v[2], v[3]); o0.z = pk_bf16(v[4], v[5]); o0.w = pk_bf16(v[6], v[7]);
            o1.x = pk_bf16(v[8], v[9]); o1.y = pk_bf16(v[10], v[11]); o1.z = pk_bf16(v[12], v[13]); o1.w = pk_bf16(v[14], v[15]);
            bf16_t* hr = hn + pl_off(t, lane * 16, 1024);
            *(uint4*)hr = o0; *(uint4*)(hr + 8) = o1;
            *(uint4*)(lds + lr * HL + lane * 16) = o0; *(uint4*)(lds + lr * HL + lane * 16 + 8) = o1;
        }
        __syncthreads();
        f32x4 acc[3];
#pragma unroll
        for (int n = 0; n < 3; ++n) acc[n] = (f32x4){0.f, 0.f, 0.f, 0.f};
#pragma unroll
        for (int ks = 0; ks < 8; ++ks) {
            int k = w * 256 + ks * 32 + fg * 8;
            bf16x8 a = *(const bf16x8*)(lds + fr * HL + k);
#pragma unroll
            for (int n = 0; n < 3; ++n) {
                bf16x8 b = *(const bf16x8*)(wr + (size_t)(n * 16 + fr) * 1024 + k);
                acc[n] = __builtin_amdgcn_mfma_f32_16x16x32_bf16(a, b, acc[n], 0, 0, 0);
            }
        }
#pragma unroll
        for (int n = 0; n < 3; ++n) *(f32x4*)(red + ((w * 3 + n) * 64 + lane) * 4) = acc[n];
        __syncthreads();
        if (tid < 16) {
            float lg[36];
#pragma unroll
            for (int j = 0; j < 36; ++j) {
                int n = j >> 4, f = j & 15; int ln = (tid >> 2) * 16 + f; float s = 0.f;
#pragma unroll
                for (int ww = 0; ww < 4; ++ww) s += red[((ww * 3 + n) * 64 + ln) * 4 + (tid & 3)];
                lg[j] = s;
            }
            float gl[4]; float gm = -1e30f; int gi = 0;
#pragma unroll
            for (int j = 0; j < 4; ++j) { gl[j] = lg[j] + brg[j]; if (gl[j] > gm) { gm = gl[j]; gi = j; } }
            float gs = 0.f;
#pragma unroll
            for (int j = 0; j < 4; ++j) gs += __expf(gl[j] - gm);
            float gp = 1.f / gs;
            float el[8]; float em = -1e30f;
#pragma unroll
            for (int j = 0; j < 8; ++j) {
                float v = (gi == 0) ? lg[4 + j] : (gi == 1) ? lg[12 + j] : (gi == 2) ? lg[20 + j] : lg[28 + j];
                el[j] = v + bre[gi * 8 + j]; em = fmaxf(em, el[j]);
            }
#pragma unroll
            for (int j = 0; j < 8; ++j) el[j] = __expf(el[j] - em);
            float v0 = -1.f, v1 = -1.f; int i0 = 0, i1 = 0;
#pragma unroll
            for (int j = 0; j < 8; ++j) {
                float v = el[j];
                if (v > v0) { v1 = v0; i1 = i0; v0 = v; i0 = j; }
                else if (v > v1) { v1 = v; i1 = j; }
            }
            int t = it * 16 + tid;
            int e0 = gi * 8 + i0, e1 = gi * 8 + i1;
            if (!dry) {
            unsigned s0 = atomicAdd(&cnt[e0], 1u), s1 = atomicAdd(&cnt[e1], 1u);
            rowtok[(size_t)e0 * NTOK + s0] = t; rowtok[(size_t)e1 * NTOK + s1] = t;
            tslot[t * 2] = (e0 << 16) | (int)s0; tslot[t * 2 + 1] = (e1 << 16) | (int)s1;
            tgate[t * 2] = gp * v0 / (v0 + v1); tgate[t * 2 + 1] = gp * v1 / (v0 + v1);
            } else if (gp * v0 == 123.456f) tgate[0] = v1;
        }
    }
}

__device__ __forceinline__ void moe_tables(const unsigned* cnt, int* tab) {
    if (threadIdx.x == 0) {
        int a = 0;
        for (int e = 0; e < 32; ++e) { tab[e] = a; tab[40 + e] = a * 128; a += ((int)ld_u32_agent(cnt + e) + 127) >> 7; }
        tab[32] = a; tab[72] = a * 128;
    }
    __syncthreads();
}
template <int MODE>
__device__ void phase_expert(const Params& p, int l, bf16_t* lds) {
    const int tid = ltid(), lane = tid & 63, w = tid >> 6, wx = w >> 1, wy = w & 1, fr = lane & 15, fg = lane >> 4;
    const unsigned* cnt = (const unsigned*)(p.ws + WS_CTL) + CW_CNT + l * 32;
    int* tab = (int*)(lds + 4 * GSTAGE);
    moe_tables(cnt, tab);
    const int* rowtok = (const int*)(p.ws + WS_ROWTOK);
    const bf16_t* hn = (const bf16_t*)(p.ws + WS_HN);
    bf16_t* Hb = (bf16_t*)(p.ws + WS_H);
    bf16_t* Yb = (bf16_t*)(p.ws + WS_Y);
    const int x = blockIdx.x & 7, loc = blockIdx.x >> 3, nloc = gridDim.x >> 3;
    for (int j = loc;; j += nloc) {
        int e = -1, rt = 0, tn = 0; int jj = j;
#pragma unroll
        for (int q = 0; q < 4; ++q) {
            int ee = q * 8 + x; int nrt = tab[ee + 1] - tab[ee];
            if (e < 0) { if (jj < nrt * 8) { e = ee; tn = jj / nrt; rt = jj % nrt; } else jj -= nrt * 8; }
        }
        if (e < 0) break;
        const int c_e = (int)ld_u32_agent(cnt + e); const int hrow0 = tab[40 + e] + rt * 128;
        f32x4 acc[4][4];
        if (MODE == 0) {
            const bf16_t* wbase = (const bf16_t*)(p.ws + WS_WGU) + ((size_t)l * 32 + e) * 1024 * 1024;
            const int* rtk = rowtok + (size_t)e * NTOK + rt * 128; const int nval = c_e - rt * 128;
            auto rw = [&](int r) { return wbase + pl_off(tn * 128 + r, 0, 1024); };
            auto rt_ = [&](int r) { int t = (r < nval) ? rtk[r] : 0; return hn + pl_off(t, 0, 1024); };
            gemm_core(rw, rt_, 1024, lds, acc);
        } else {
            const bf16_t* wbase = (const bf16_t*)(p.ws + WS_WD) + ((size_t)l * 32 + e) * 1024 * 512;
            auto rw = [&](int r) { return wbase + pl_off(tn * 128 + r, 0, 512); };
            auto rt_ = [&](int r) { return Hb + pl_off(hrow0 + r, 0, 512); };
            gemm_core(rw, rt_, 512, lds, acc);
        }
        RAW_BARRIER();
        if (MODE == 0) {
#pragma unroll
            for (int n = 0; n < 4; ++n)
#pragma unroll
                for (int m = 0; m < 2; ++m)
                    ep_put<64>(lds, wy * 64 + n * 16 + fr, wx * 32 + m * 16 + 4 * fg, siluf_(acc[m][n][0]) * acc[m + 2][n][0], siluf_(acc[m][n][1]) * acc[m + 2][n][1],
                               siluf_(acc[m][n][2]) * acc[m + 2][n][2], siluf_(acc[m][n][3]) * acc[m + 2][n][3]);
            RAW_BARRIER();
            ep_flush<64>(lds, tid, [&](int row, int c8) { return Hb + pl_off(hrow0 + row, tn * 64 + c8 * 8, 512); });
        } else {
#pragma unroll
            for (int n = 0; n < 4; ++n)
#pragma unroll
                for (int m = 0; m < 4; ++m) ep_put<128>(lds, wy * 64 + n * 16 + fr, wx * 64 + m * 16 + 4 * fg, acc[m][n][0], acc[m][n][1], acc[m][n][2], acc[m][n][3]);
            RAW_BARRIER();
            bf16_t* dstb = Yb + (size_t)hrow0 * 1024 + tn * 128;
            ep_flush<128>(lds, tid, [&](int row, int c8) { return dstb + (size_t)row * 1024 + c8 * 8; });
        }
    }
}

__device__ void phase_combine(const Params& p, int l, int dry = 0) {
    const int tid = ltid(), lane = tid & 63, w = tid >> 6;
    const unsigned* cnt = (const unsigned*)(p.ws + WS_CTL) + CW_CNT + l * 32;
    int c = (lane < 32) ? (((int)ld_u32_agent(cnt + (lane & 31)) + 127) >> 7) * 128 : 0;
    int incl = c;
#pragma unroll
    for (int o = 1; o < 32; o <<= 1) { int v = __shfl_up(incl, o, 64); if (lane >= o) incl += v; }
    int hoff = incl - c;
    const int* tslot = (const int*)(p.ws + WS_TSLOT);
    const float* tgate = (const float*)(p.ws + WS_TGATE);
    const bf16_t* Yb = (const bf16_t*)(p.ws + WS_Y);
    bf16_t* hn = dry ? (bf16_t*)(p.ws + WS_SCR + (size_t)40 * 1024 * 1024) : (bf16_t*)(p.ws + WS_HN);
    float* x = p.out; float* xw = dry ? (float*)(p.ws + WS_SCR) : p.out;
    const float* gain = (l == 0 || dry) ? p.in[1] + 1024 : nullptr;
    for (int it = blockIdx.x; it < NTOK / 4; it += gridDim.x) {
        int t = it * 4 + w;
        int ts0 = tslot[t * 2], ts1 = tslot[t * 2 + 1];
        float g0 = tgate[t * 2], g1 = tgate[t * 2 + 1];
        int r0 = __shfl(hoff, ts0 >> 16, 64) + (ts0 & 0xffff);
        int r1 = __shfl(hoff, ts1 >> 16, 64) + (ts1 & 0xffff);
        float* xr = x + (size_t)t * 1024 + lane * 16;
        const bf16_t* y0 = Yb + (size_t)r0 * 1024 + lane * 16;
        const bf16_t* y1 = Yb + (size_t)r1 * 1024 + lane * 16;
        float v[16];
#pragma unroll
        for (int i = 0; i < 4; ++i) { float4 q = *(const float4*)(xr + 4 * i); v[4 * i] = q.x; v[4 * i + 1] = q.y; v[4 * i + 2] = q.z; v[4 * i + 3] = q.w; }
        uint4 a0 = *(const uint4*)y0, a1 = *(const uint4*)(y0 + 8), b0 = *(const uint4*)y1, b1 = *(const uint4*)(y1 + 8);
        unsigned ya[8] = {a0.x, a0.y, a0.z, a0.w, a1.x, a1.y, a1.z, a1.w};
        unsigned yb[8] = {b0.x, b0.y, b0.z, b0.w, b1.x, b1.y, b1.z, b1.w};
#pragma unroll
        for (int i = 0; i < 8; ++i) {
            v[2 * i] += g0 * bflo(ya[i]) + g1 * bflo(yb[i]);
            v[2 * i + 1] += g0 * bfhi(ya[i]) + g1 * bfhi(yb[i]);
        }
#ifdef NANMARK
#pragma unroll
        for (int i = 0; i < 16; ++i) if (!(fabsf(v[i]) < 1e30f)) v[i] = 1000.f;
#endif
#pragma unroll
        for (int i = 0; i < 4; ++i) *(float4*)(xw + (size_t)t * 1024 + lane * 16 + 4 * i) = make_float4(v[4 * i], v[4 * i + 1], v[4 * i + 2], v[4 * i + 3]);
        if (gain) {
            float ss = 0.f;
#pragma unroll
            for (int i = 0; i < 16; ++i) ss += v[i] * v[i];
            ss = wave_sum(ss);
            float r = rsqrtf(ss / D_MODEL + 1e-6f);
#pragma unroll
            for (int i = 0; i < 16; ++i) v[i] = v[i] * r * gain[lane * 16 + i];
            uint4 o0, o1;
            o0.x = pk_bf16(v[0], v[1]); o0.y = pk_bf16(v[2], v[3]); o0.z = pk_bf16(v[4], v[5]); o0.w = pk_bf16(v[6], v[7]);
            o1.x = pk_bf16(v[8], v[9]); o1.y = pk_bf16(v[10], v[11]); o1.z = pk_bf16(v[12], v[13]); o1.w = pk_bf16(v[14], v[15]);
            bf16_t* hr = hn + pl_off(t, lane * 16, 1024);
            *(uint4*)hr = o0; *(uint4*)(hr + 8) = o1;
        }
    }
}


__device__ __forceinline__ void mm_row(const bf16_t* RA, const bf16_t* RB, int mw, int fr, int fg, f32x4 (&acc)[4]) {
#pragma unroll
    for (int ks = 0; ks < 2; ++ks) {
        bf16x8 a = *(const bf16x8*)(RA + (16 * mw + fr) * LROW + ks * 32 + fg * 8);
#pragma unroll
        for (int nt = 0; nt < 4; ++nt) {
            bf16x8 b = *(const bf16x8*)(RB + (16 * nt + fr) * LROW + ks * 32 + fg * 8);
            acc[nt] = __builtin_amdgcn_mfma_f32_16x16x32_bf16(a, b, acc[nt], 0, 0, 0);
        }
    }
}
__device__ __forceinline__ void mm_col(const bf16_t* RA, const bf16_t* RB, int nw, int fr, int fg, f32x4 (&acc)[4]) {
#pragma unroll
    for (int ks = 0; ks < 2; ++ks) {
        bf16x8 b = *(const bf16x8*)(RB + (16 * nw + fr) * LROW + ks * 32 + fg * 8);
#pragma unroll
        for (int mt = 0; mt < 4; ++mt) {
            bf16x8 a = *(const bf16x8*)(RA + (16 * mt + fr) * LROW + ks * 32 + fg * 8);
            acc[mt] = __builtin_amdgcn_mfma_f32_16x16x32_bf16(a, b, acc[mt], 0, 0, 0);
        }
    }
}
__device__ __forceinline__ void zero4(f32x4 (&a)[4]) {
#pragma unroll
    for (int i = 0; i < 4; ++i) a[i] = (f32x4){0.f, 0.f, 0.f, 0.f};
}
__device__ __forceinline__ void st4_lds(bf16_t* p, float a, float b, float c, float d) { uint2 o; o.x = pk_bf16(a, b); o.y = pk_bf16(c, d); *(uint2*)p = o; }
__device__ __forceinline__ bf16_t f2bf(float v) { return (bf16_t)(pk_bf16(v, 0.f) & 0xffffu); }

__device__ void gdn_prep_item(const Params& p, int l, int cid, unsigned char* lds_raw) {
    const int tid = ltid(), lane = tid & 63, w = tid >> 6, fr = lane & 15, fg = lane >> 4;
    const int bh = cid >> 6, n = cid & 63, b = bh / H_GDN, h = bh % H_GDN;
    const int t0 = b * SEQ + n * 64;
    bf16_t* L0 = (bf16_t*)lds_raw; bf16_t* L1 = L0 + 64 * LROW; bf16_t* L2 = L1 + 64 * LROW; bf16_t* L3 = L2 + 64 * LROW; bf16_t* L4 = L3 + 64 * LROW; bf16_t* L5 = L4 + 64 * LROW;
    float* dec = (float*)(L5 + 64 * LROW); float* beta = dec + 64;
    const bf16_t* proj = (const bf16_t*)(p.ws + WS_PROJ);
    const float* aux = (const float*)(p.ws + WS_AUX);
    const float* convw = p.in[7] + (size_t)l * 4 * 1152;
    __syncthreads();
    const int i = tid >> 2, c0 = (tid & 3) * 16;
    float qv[16], kv[16], vv[16];
#pragma unroll
    for (int which = 0; which < 3; ++which) {
        float acc[16];
#pragma unroll
        for (int c = 0; c < 16; ++c) acc[c] = 0.f;
#pragma unroll
        for (int tap = 0; tap < 4; ++tap) {
            const int row = i - 3 + tap;
            if (n * 64 + row >= 0) {
                const bf16_t* xp = proj + (size_t)(t0 + row) * NPROJ + NC_GQ + which * 384 + h * 64 + c0;
                u32x4 x0 = *(const u32x4*)xp, x1 = *(const u32x4*)(xp + 8);
                const float* wp = convw + tap * 1152 + which * 384 + h * 64 + c0;
                f32x4 w0 = *(const f32x4*)wp, w1 = *(const f32x4*)(wp + 4), w2 = *(const f32x4*)(wp + 8), w3 = *(const f32x4*)(wp + 12);
                float wv[16] = {w0[0], w0[1], w0[2], w0[3], w1[0], w1[1], w1[2], w1[3], w2[0], w2[1], w2[2], w2[3], w3[0], w3[1], w3[2], w3[3]};
                unsigned xs[8] = {x0[0], x0[1], x0[2], x0[3], x1[0], x1[1], x1[2], x1[3]};
#pragma unroll
                for (int c = 0; c < 8; ++c) { acc[2 * c] += wv[2 * c] * bflo(xs[c]); acc[2 * c + 1] += wv[2 * c + 1] * bfhi(xs[c]); }
            }
        }
        float ss = 0.f;
#pragma unroll
        for (int c = 0; c < 16; ++c) { acc[c] = siluf_(acc[c]); ss += acc[c] * acc[c]; }
        if (which < 2) {
            ss += __shfl_xor(ss, 1, 64); ss += __shfl_xor(ss, 2, 64);
            const float sc = rsqrtf(ss + 1e-6f) * (which == 0 ? 0.125f : 1.f);
#pragma unroll
            for (int c = 0; c < 16; ++c) acc[c] *= sc;
        }
#pragma unroll
        for (int c = 0; c < 16; ++c) { if (which == 0) qv[c] = acc[c]; else if (which == 1) kv[c] = acc[c]; else vv[c] = acc[c]; }
    }
#pragma unroll
    for (int c = 0; c < 16; c += 4) { st4_lds(L2 + i * LROW + c0 + c, kv[c], kv[c + 1], kv[c + 2], kv[c + 3]); st4_lds(L3 + i * LROW + c0 + c, qv[c], qv[c + 1], qv[c + 2], qv[c + 3]); }
    if (w == 0) {
        const float a = aux[(size_t)(t0 + lane) * 64 + AX_GA + h], bl = aux[(size_t)(t0 + lane) * 64 + AX_GB + h];
        const float g = -__expf(p.in[8][l * H_GDN + h]) * softplusf_(a + p.in[9][l * H_GDN + h]);
        float inc = g;
#pragma unroll
        for (int o = 1; o < 64; o <<= 1) { float t = __shfl_up(inc, o, 64); if (lane >= o) inc += t; }
        dec[lane] = inc; beta[lane] = sigmoidf_(bl);
    }
    __syncthreads();
    {
        f32x4 g4[4]; zero4(g4);
        mm_row(L2, L2, w, fr, fg, g4);
#pragma unroll
        for (int nt = 0; nt < 4; ++nt) {
            const int kap = 16 * nt + fr; const float dk_ = dec[kap], bk_ = beta[kap];
            float nT[4], nN[4], tt[4];
#pragma unroll
            for (int r = 0; r < 4; ++r) {
                const int rho = 16 * w + 4 * fg + r; const float dr_ = dec[rho], br_ = beta[rho];
                const float G = g4[nt][r];
                nT[r] = (kap < rho) ? br_ * G * __expf(dr_ - dk_) : 0.f;
                nN[r] = (rho < kap) ? bk_ * G * __expf(dk_ - dr_) : 0.f;
                tt[r] = ((kap == rho) ? 1.f : 0.f) - nN[r];
            }
            st4_lds(L1 + kap * LROW + 16 * w + 4 * fg, nT[0], nT[1], nT[2], nT[3]);
            st4_lds(L0 + kap * LROW + 16 * w + 4 * fg, nN[0], nN[1], nN[2], nN[3]);
            st4_lds(L4 + kap * LROW + 16 * w + 4 * fg, tt[0], tt[1], tt[2], tt[3]);
        }
        f32x4 a4[4]; zero4(a4);
        mm_row(L2, L3, w, fr, fg, a4);
#pragma unroll
        for (int nt = 0; nt < 4; ++nt) {
            const int ii = 16 * nt + fr; const float di_ = dec[ii];
            float v4[4];
#pragma unroll
            for (int r = 0; r < 4; ++r) { const int j = 16 * w + 4 * fg + r; v4[r] = (j <= ii) ? a4[nt][r] * __expf(di_ - dec[j]) : 0.f; }
            st4_lds(L5 + ii * LROW + 16 * w + 4 * fg, v4[0], v4[1], v4[2], v4[3]);
        }
    }
    __syncthreads();
#pragma unroll
    for (int lev = 1; lev <= 5; ++lev) {
        const bf16_t* XA = (lev & 1) ? L0 : L2; const bf16_t* XAt = (lev & 1) ? L1 : L3;
        bf16_t* XB = (lev & 1) ? L2 : L0; bf16_t* XBt = (lev & 1) ? L3 : L1;
        {
            f32x4 x4[4]; zero4(x4);
            mm_row(XA, XAt, w, fr, fg, x4);
#pragma unroll
            for (int nt = 0; nt < 4; ++nt) {
                const int c = 16 * nt + fr;
                st4_lds(XBt + c * LROW + 16 * w + 4 * fg, x4[nt][0], x4[nt][1], x4[nt][2], x4[nt][3]);
                if (lev < 5) {
#pragma unroll
                    for (int r = 0; r < 4; ++r) XB[(16 * w + 4 * fg + r) * LROW + c] = f2bf(x4[nt][r]);
                }
            }
        }
        __syncthreads();
        {
            f32x4 t4[4];
#pragma unroll
            for (int mt = 0; mt < 4; ++mt) {
                uint2 u = *(const uint2*)(L4 + (16 * w + fr) * LROW + 16 * mt + 4 * fg);
                t4[mt] = (f32x4){bflo(u.x), bfhi(u.x), bflo(u.y), bfhi(u.y)};
            }
            mm_col(XBt, L4, w, fr, fg, t4);
#pragma unroll
            for (int mt = 0; mt < 4; ++mt) st4_lds(L4 + (16 * w + fr) * LROW + 16 * mt + 4 * fg, t4[mt][0], t4[mt][1], t4[mt][2], t4[mt][3]);
        }
    }
    {
        const float dj = dec[i], bj = beta[i], dlast = dec[63];
        const float s1 = bj * __expf(dj), s2 = bj, s3 = __expf(dlast - dj);
#pragma unroll
        for (int c = 0; c < 16; ++c) {
            L0[(c0 + c) * LROW + i] = f2bf(kv[c] * s1);
            L1[(c0 + c) * LROW + i] = f2bf(vv[c] * s2);
            L2[(c0 + c) * LROW + i] = f2bf(kv[c] * s3);
        }
    }
    __syncthreads();
    {
        f32x4 w4[4], u4[4]; zero4(w4); zero4(u4);
        mm_row(L4, L0, w, fr, fg, w4);
        mm_row(L4, L1, w, fr, fg, u4);
        __syncthreads();
#pragma unroll
        for (int nt = 0; nt < 4; ++nt) {
            st4_lds(L0 + (16 * nt + fr) * LROW + 16 * w + 4 * fg, w4[nt][0], w4[nt][1], w4[nt][2], w4[nt][3]);
            st4_lds(L1 + (16 * nt + fr) * LROW + 16 * w + 4 * fg, u4[nt][0], u4[nt][1], u4[nt][2], u4[nt][3]);
        }
        const float ed = __expf(dec[i]);
#pragma unroll
        for (int c = 0; c < 16; c += 4) st4_lds(L3 + i * LROW + c0 + c, qv[c] * ed, qv[c + 1] * ed, qv[c + 2] * ed, qv[c + 3] * ed);
    }
    __syncthreads();
    char* scr = p.ws + WS_SCR;
    {
        f32x4 m4[4]; zero4(m4);
        mm_row(L0, L2, w, fr, fg, m4);
        bf16_t* MP = (bf16_t*)(scr + SCR_GDN_MP) + (size_t)cid * 4096;
#pragma unroll
        for (int nt = 0; nt < 4; ++nt) store4_bf16(MP + (16 * nt + fr) * 64 + 16 * w + 4 * fg, -m4[nt][0], -m4[nt][1], -m4[nt][2], -m4[nt][3]);
        f32x4 n4[4]; zero4(n4);
        mm_row(L2, L1, w, fr, fg, n4);
        bf16_t* NN = (bf16_t*)(scr + SCR_GDN_NN) + (size_t)cid * 4096;
#pragma unroll
        for (int nt = 0; nt < 4; ++nt) store4_bf16(NN + ((nt * 4 + w) * 64 + lane) * 4, n4[nt][0], n4[nt][1], n4[nt][2], n4[nt][3]);
        f32x4 p4[4]; zero4(p4);
        mm_row(L0, L5, w, fr, fg, p4);
        bf16_t* PG = (bf16_t*)(scr + SCR_GDN_P) + (size_t)cid * 4096;
#pragma unroll
        for (int nt = 0; nt < 4; ++nt) {
            uint2 u = *(const uint2*)(L3 + (16 * nt + fr) * LROW + 16 * w + 4 * fg);
            store4_bf16(PG + (16 * nt + fr) * 64 + 16 * w + 4 * fg, bflo(u.x) - p4[nt][0], bfhi(u.x) - p4[nt][1], bflo(u.y) - p4[nt][2], bfhi(u.y) - p4[nt][3]);
        }
        f32x4 o4[4]; zero4(o4);
        mm_row(L1, L5, w, fr, fg, o4);
        bf16_t* OL = (bf16_t*)(scr + SCR_GDN_OL) + (size_t)cid * 4096;
#pragma unroll
        for (int nt = 0; nt < 4; ++nt) store4_bf16(OL + (16 * nt + fr) * 64 + 16 * w + 4 * fg, o4[nt][0], o4[nt][1], o4[nt][2], o4[nt][3]);
        if (tid == 0) ((float*)(scr + SCR_GDN_LAST))[cid] = __expf(dec[63]);
    }
}

#define SCAN_SLOT    5120
#define SCAN_SB(k)   ((bf16_t*)lds_raw + (k) * 1024)
#define SCAN_RING(k) ((bf16_t*)lds_raw + 2048 + (k) * SCAN_SLOT)
#define SCAN_LAST    ((float*)(lds_raw + 4096 + 5 * SCAN_SLOT * 2))
__device__ __forceinline__ void scan_issue(const bf16_t* const (&mp)[8], const bf16_t* nn_lane, int n, bf16_t* slot) {
#pragma unroll
    for (int q = 0; q < 8; ++q) __builtin_amdgcn_global_load_lds((const unsigned*)(mp[q] + (size_t)n * 4096), (unsigned*)(slot + q * 512), 16, 0, 0);
    __builtin_amdgcn_global_load_lds((const unsigned*)(nn_lane + (size_t)n * 4096), (unsigned*)(slot + 4096), 16, 0, 0);
    __builtin_amdgcn_global_load_lds((const unsigned*)(nn_lane + (size_t)n * 4096 + 512), (unsigned*)(slot + 4096 + 512), 16, 0, 0);
}
__device__ void gdn_scan_item(const Params& p, int item, unsigned char* lds_raw, int svar = 0) {
    const int tid = ltid(), lane = tid & 63, w = __builtin_amdgcn_readfirstlane(tid >> 6), fr = lane & 15, fg = lane >> 4;
    const int bh = item >> 2, cg = item & 3;
    char* scr = p.ws + WS_SCR;
    const bf16_t* MP = (const bf16_t*)(scr + SCR_GDN_MP) + (size_t)bh * 64 * 4096;
    const bf16_t* NN = (const bf16_t*)(scr + SCR_GDN_NN) + (size_t)bh * 64 * 4096 + cg * 1024;
    const float* LAST = (const float*)(scr + SCR_GDN_LAST) + bh * 64;
    bf16_t* SG = (bf16_t*)(scr + SCR_GDN_SG) + (size_t)bh * 64 * 4096 + cg * 1024;
    const bf16_t* mp[8];
#pragma unroll
    for (int q = 0; q < 8; ++q) { const int row = 8 * q + (lane >> 3); mp[q] = MP + row * 64 + (((lane & 7) ^ ((row >> 1) & 7)) * 8); }
    const bf16_t* nn_lane = NN + lane * 8;
    RAW_BARRIER();
    if (tid < 64) SCAN_LAST[tid] = ld_f32_agent(LAST + tid);
    asm volatile("s_waitcnt vmcnt(0)" ::: "memory");
    f32x4 S = (f32x4){0.f, 0.f, 0.f, 0.f};
    const int swz = (fr >> 1) & 7;
    if (w == 0) {
#pragma unroll
        for (int n = 0; n < 4; ++n) scan_issue(mp, nn_lane, n, SCAN_RING(n));
    }
    for (int n = 0; n < 64; ++n) {
        bf16_t* sb = SCAN_SB(n & 1);
        const bf16_t* ring = SCAN_RING(n % 5);
        {
            const int c = 2 * w + (fg >> 1);
            uint2 o; o.x = pk_bf16(S[0], S[1]); o.y = pk_bf16(S[2], S[3]);
            *(uint2*)(sb + fr * 64 + ((c ^ swz) * 8) + 4 * (fg & 1)) = o;
        }
        if (w == 0) {
            if (n + 3 < 64) asm volatile("s_waitcnt vmcnt(30)" ::: "memory");
            else if (n + 2 < 64) asm volatile("s_waitcnt vmcnt(20)" ::: "memory");
            else if (n + 1 < 64) asm volatile("s_waitcnt vmcnt(10)" ::: "memory");
            else asm volatile("s_waitcnt vmcnt(0)" ::: "memory");
        }
        RAW_BARRIER();
        if (w == 0 && n + 4 < 64 && svar != 2) scan_issue(mp, nn_lane, n + 4, SCAN_RING((n + 4) % 5));
        const float last = SCAN_LAST[n];
        {
            u32x2 nn = *(const u32x2*)(ring + 4096 + (w * 64 + lane) * 4);
            S[0] = last * S[0] + bflo(nn[0]); S[1] = last * S[1] + bfhi(nn[0]);
            S[2] = last * S[2] + bflo(nn[1]); S[3] = last * S[3] + bfhi(nn[1]);
        }
#pragma unroll
        for (int ks = 0; ks < 2; ++ks) {
            const int co = ((ks * 4 + fg) ^ swz) * 8;
            bf16x8 a = *(const bf16x8*)(ring + (16 * w + fr) * 64 + co);
            bf16x8 s = *(const bf16x8*)(sb + fr * 64 + co);
            S = __builtin_amdgcn_mfma_f32_16x16x32_bf16(a, s, S, 0, 0, 0);
        }
        if (w >= 2 && svar != 1) {
            const int c = (w - 2) * 64 + lane; const int row = c >> 3, pc = c & 7;
            u32x4 v = *(const u32x4*)(sb + row * 64 + pc * 8);
            *(u32x4*)(SG + (size_t)n * 4096 + row * 64 + ((pc ^ ((row >> 1) & 7)) * 8)) = v;
        }
    }
}

__device__ void gdn_out_item(const Params& p, int l, int cid) {
    const int tid = ltid(), lane = tid & 63, w = tid >> 6, fr = lane & 15, fg = lane >> 4;
    const int bh = cid >> 6, n = cid & 63, b = bh / H_GDN, h = bh % H_GDN;
    char* scr = p.ws + WS_SCR;
    const bf16_t* SG = (const bf16_t*)(scr + SCR_GDN_SG) + (size_t)cid * 4096;
    const bf16_t* PG = (const bf16_t*)(scr + SCR_GDN_P) + (size_t)cid * 4096;
    const bf16_t* OL = (const bf16_t*)(scr + SCR_GDN_OL) + (size_t)cid * 4096;
    const int i = 16 * w + fr; const int t = b * SEQ + n * 64 + i;
    f32x4 acc[4];
#pragma unroll
    for (int mt = 0; mt < 4; ++mt) { uint2 u = *(const uint2*)(OL + i * 64 + 16 * mt + 4 * fg); acc[mt] = (f32x4){bflo(u.x), bfhi(u.x), bflo(u.y), bfhi(u.y)}; }
#pragma unroll
    for (int ks = 0; ks < 2; ++ks) {
        bf16x8 bq = *(const bf16x8*)(PG + i * 64 + ks * 32 + fg * 8);
#pragma unroll
        for (int mt = 0; mt < 4; ++mt) {
            bf16x8 a = *(const bf16x8*)(SG + (16 * mt + fr) * 64 + ks * 32 + fg * 8);
            acc[mt] = __builtin_amdgcn_mfma_f32_16x16x32_bf16(a, bq, acc[mt], 0, 0, 0);
        }
    }
    float ss = 0.f;
#pragma unroll
    for (int mt = 0; mt < 4; ++mt)
#pragma unroll
        for (int r = 0; r < 4; ++r) ss += acc[mt][r] * acc[mt][r];
    ss += __shfl_xor(ss, 16, 64); ss += __shfl_xor(ss, 32, 64);
    const float rstd = rsqrtf(ss * (1.f / 64.f) + 1e-6f);
    const float* og = p.in[10] + l * 64;
    const bf16_t* gp = (const bf16_t*)(p.ws + WS_PROJ) + (size_t)t * NPROJ + NC_GG + h * 64;
    bf16_t* mp = (bf16_t*)(p.ws + WS_MIX) + pl_off(t, 384 + h * 64, 1024);
#pragma unroll
    for (int mt = 0; mt < 4; ++mt) {
        const int e0 = 16 * mt + 4 * fg;
        uint2 gu = *(const uint2*)(gp + e0); f32x4 g4 = *(const f32x4*)(og + e0);
        store4_bf16(mp + e0 + (e0 & 32), acc[mt][0] * rstd * g4[0] * bflo(gu.x), acc[mt][1] * rstd * g4[1] * bfhi(gu.x), acc[mt][2] * rstd * g4[2] * bflo(gu.y), acc[mt][3] * rstd * g4[3] * bfhi(gu.y));
    }
}

#define GQROW 40
__device__ void gla_prep_item(const Params& p, int l, int cid, unsigned char* lds_raw) {
    const int tid = ltid(), lane = tid & 63, w = tid >> 6, fr = lane & 15, fg = lane >> 4;
    const int bh = cid >> 6, n = cid & 63, b = bh / H_GLA, h = bh % H_GLA;
    const int t0 = b * SEQ + n * 64;
    float* Bf = (float*)lds_raw;
    bf16_t* Qt = (bf16_t*)(lds_raw + 8448);
    bf16_t* Kt = Qt + 64 * GQROW;
    bf16_t* KLt = Kt + 64 * GQROW;
    bf16_t* Vt = KLt + 32 * LROW;
    const bf16_t* proj = (const bf16_t*)(p.ws + WS_PROJ);
    const float* aux = (const float*)(p.ws + WS_AUX);
    char* scr = p.ws + WS_SCR;
    __syncthreads();
    const int i = tid >> 2, d0 = (tid & 3) * 8;
    {
        const float* wa = p.in[11] + (size_t)l * 16 * 128 + h * 32 + d0;
        const float* ba = p.in[12] + l * 128 + h * 32 + d0;
        float acc[8];
#pragma unroll
        for (int j = 0; j < 8; ++j) acc[j] = ba[j];
        float a1v[16];
#pragma unroll
        for (int r = 0; r < 16; r += 2) { float2 t2 = *(const float2*)(aux + (size_t)(t0 + i) * 64 + AX_LA + r); a1v[r] = t2.x; a1v[r + 1] = t2.y; }
#pragma unroll
        for (int r = 0; r < 16; ++r) {
            f32x4 wA = *(const f32x4*)(wa + r * 128), wB = *(const f32x4*)(wa + r * 128 + 4);
#pragma unroll
            for (int j = 0; j < 4; ++j) { acc[j] += a1v[r] * wA[j]; acc[4 + j] += a1v[r] * wB[j]; }
        }
#pragma unroll
        for (int j = 0; j < 8; ++j) Bf[i * 33 + d0 + j] = logsigmoidf_(acc[j]) * (1.f / 16.f);
    }
    {
        const bf16_t* lvt = (const bf16_t*)(scr + SCR_LVT) + (size_t)bh * 64 * SEQ + n * 64;
#pragma unroll
        for (int ii = 0; ii < 2; ++ii) { int c = tid + 256 * ii; int row = c >> 3, kc = c & 7; *(u32x4*)(Vt + row * LROW + kc * 8) = *(const u32x4*)(lvt + (size_t)row * SEQ + kc * 8); }
    }
    __syncthreads();
#pragma unroll
    for (int c = 0; c < 8; ++c) {
        const int d = 8 * w + c;
        float inc = Bf[lane * 33 + d];
#pragma unroll
        for (int o = 1; o < 64; o <<= 1) { float t = __shfl_up(inc, o, 64); if (lane >= o) inc += t; }
        Bf[lane * 33 + d] = inc;
    }
    __syncthreads();
    {
        const bf16_t* qp = proj + (size_t)(t0 + i) * NPROJ + NC_LQ + h * 32 + d0;
        const bf16_t* kp = proj + (size_t)(t0 + i) * NPROJ + NC_LK + h * 32 + d0;
        u32x4 qu = *(const u32x4*)qp, ku = *(const u32x4*)kp;
        float qf[8] = {bflo(qu[0]), bfhi(qu[0]), bflo(qu[1]), bfhi(qu[1]), bflo(qu[2]), bfhi(qu[2]), bflo(qu[3]), bfhi(qu[3])};
        float kf[8] = {bflo(ku[0]), bfhi(ku[0]), bflo(ku[1]), bfhi(ku[1]), bflo(ku[2]), bfhi(ku[2]), bflo(ku[3]), bfhi(ku[3])};
        float qt[8], kt[8], qb[8];
#pragma unroll
        for (int j = 0; j < 8; ++j) {
            const float bi = Bf[i * 33 + d0 + j], bm = Bf[31 * 33 + d0 + j], bl = Bf[63 * 33 + d0 + j];
            qt[j] = qf[j] * __expf(bi - bm); kt[j] = kf[j] * __expf(bm - bi); qb[j] = qf[j] * __expf(bi);
            KLt[(d0 + j) * LROW + i] = f2bf(kf[j] * __expf(bl - bi));
            if (i == 63) ((float*)(scr + SCR_GLA_DL))[cid * 32 + d0 + j] = __expf(bl);
        }
        u32x4 o; o[0] = pk_bf16(qt[0], qt[1]); o[1] = pk_bf16(qt[2], qt[3]); o[2] = pk_bf16(qt[4], qt[5]); o[3] = pk_bf16(qt[6], qt[7]);
        *(u32x4*)(Qt + i * GQROW + d0) = o;
        o[0] = pk_bf16(kt[0], kt[1]); o[1] = pk_bf16(kt[2], kt[3]); o[2] = pk_bf16(kt[4], kt[5]); o[3] = pk_bf16(kt[6], kt[7]);
        *(u32x4*)(Kt + i * GQROW + d0) = o;
        o[0] = pk_bf16(qb[0], qb[1]); o[1] = pk_bf16(qb[2], qb[3]); o[2] = pk_bf16(qb[4], qb[5]); o[3] = pk_bf16(qb[6], qb[7]);
        *(u32x4*)((bf16_t*)(scr + SCR_GLA_QB) + (size_t)cid * 2048 + i * 32 + d0) = o;
    }
    __syncthreads();
    f32x4 sc[4];
    {
        bf16x8 bq = *(const bf16x8*)(Qt + (16 * w + fr) * GQROW + fg * 8);
#pragma unroll
        for (int mt = 0; mt < 4; ++mt) {
            bf16x8 a = *(const bf16x8*)(Kt + (16 * mt + fr) * GQROW + fg * 8);
            sc[mt] = __builtin_amdgcn_mfma_f32_16x16x32_bf16(a, bq, (f32x4){0.f, 0.f, 0.f, 0.f}, 0, 0, 0);
        }
        const int ii = 16 * w + fr;
#pragma unroll
        for (int mt = 0; mt < 4; ++mt)
#pragma unroll
            for (int r = 0; r < 4; ++r) { const int j = 16 * mt + 4 * fg + r; if (j > ii) sc[mt][r] = 0.f; }
    }
    {
        f32x4 o4[4]; zero4(o4);
#pragma unroll
        for (int kk = 0; kk < 2; ++kk) {
            u32x4 pb = {pk_bf16(sc[2 * kk][0], sc[2 * kk][1]), pk_bf16(sc[2 * kk][2], sc[2 * kk][3]), pk_bf16(sc[2 * kk + 1][0], sc[2 * kk + 1][1]), pk_bf16(sc[2 * kk + 1][2], sc[2 * kk + 1][3])};
#pragma unroll
            for (int mt = 0; mt < 4; ++mt) {
                uint2 v0 = *(const uint2*)(Vt + (16 * mt + fr) * LROW + 32 * kk + 4 * fg), v1 = *(const uint2*)(Vt + (16 * mt + fr) * LROW + 32 * kk + 16 + 4 * fg);
                u32x4 va = {v0.x, v0.y, v1.x, v1.y};
                o4[mt] = __builtin_amdgcn_mfma_f32_16x16x32_bf16(__builtin_bit_cast(bf16x8, va), __builtin_bit_cast(bf16x8, pb), o4[mt], 0, 0, 0);
            }
        }
        bf16_t* OL = (bf16_t*)(scr + SCR_GLA_OL) + (size_t)cid * 4096;
#pragma unroll
        for (int mt = 0; mt < 4; ++mt) store4_bf16(OL + (16 * w + fr) * 64 + 16 * mt + 4 * fg, o4[mt][0], o4[mt][1], o4[mt][2], o4[mt][3]);
    }
    {
        f32x4 k4[2] = {(f32x4){0.f, 0.f, 0.f, 0.f}, (f32x4){0.f, 0.f, 0.f, 0.f}};
#pragma unroll
        for (int ks = 0; ks < 2; ++ks) {
            bf16x8 bv = *(const bf16x8*)(Vt + (16 * w + fr) * LROW + ks * 32 + fg * 8);
#pragma unroll
            for (int mt = 0; mt < 2; ++mt) {
                bf16x8 a = *(const bf16x8*)(KLt + (16 * mt + fr) * LROW + ks * 32 + fg * 8);
                k4[mt] = __builtin_amdgcn_mfma_f32_16x16x32_bf16(a, bv, k4[mt], 0, 0, 0);
            }
        }
        float* KV = (float*)(scr + SCR_GLA_KV) + (size_t)cid * 2048;
#pragma unroll
        for (int mt = 0; mt < 2; ++mt) *(f32x4*)(KV + (16 * w + fr) * 32 + 16 * mt + 4 * fg) = k4[mt];
    }
}
__device__ void gla_scan_item(const Params& p, int g) {
    const int tid = ltid();
    const int bh = g >> 3, idx = (g & 7) * 256 + tid, d = idx & 31;
    char* scr = p.ws + WS_SCR;
    const float* __restrict__ KV = (const float*)(scr + SCR_GLA_KV) + (size_t)bh * 64 * 2048 + idx;
    const float* __restrict__ DL = (const float*)(scr + SCR_GLA_DL) + bh * 64 * 32 + d;
    bf16_t* __restrict__ SG = (bf16_t*)(scr + SCR_GLA_SG) + (size_t)bh * 64 * 2048 + idx;
    float S = 0.f;
    for (int n0 = 0; n0 < 64; n0 += 8) {
        float kv[8], dl[8];
#pragma unroll
        for (int u = 0; u < 8; ++u) { kv[u] = KV[(size_t)(n0 + u) * 2048]; dl[u] = DL[(n0 + u) * 32]; }
#pragma unroll
        for (int u = 0; u < 8; ++u) { SG[(size_t)(n0 + u) * 2048] = f2bf(S); S = dl[u] * S + kv[u]; }
    }
}
__device__ void gla_out_item(const Params& p, int l, int cid) {
    const int tid = ltid(), lane = tid & 63, w = tid >> 6, fr = lane & 15, fg = lane >> 4;
    const int bh = cid >> 6, n = cid & 63, b = bh / H_GLA, h = bh % H_GLA;
    char* scr = p.ws + WS_SCR;
    const bf16_t* SG = (const bf16_t*)(scr + SCR_GLA_SG) + (size_t)cid * 2048;
    const bf16_t* QB = (const bf16_t*)(scr + SCR_GLA_QB) + (size_t)cid * 2048;
    const bf16_t* OL = (const bf16_t*)(scr + SCR_GLA_OL) + (size_t)cid * 4096;
    const int i = 16 * w + fr; const int t = b * SEQ + n * 64 + i;
    f32x4 acc[4];
#pragma unroll
    for (int mt = 0; mt < 4; ++mt) { uint2 u = *(const uint2*)(OL + i * 64 + 16 * mt + 4 * fg); acc[mt] = (f32x4){bflo(u.x), bfhi(u.x), bflo(u.y), bfhi(u.y)}; }
    bf16x8 bq = *(const bf16x8*)(QB + i * 32 + fg * 8);
#pragma unroll
    for (int mt = 0; mt < 4; ++mt) {
        bf16x8 a = *(const bf16x8*)(SG + (16 * mt + fr) * 32 + fg * 8);
        acc[mt] = __builtin_amdgcn_mfma_f32_16x16x32_bf16(a, bq, acc[mt], 0, 0, 0);
    }
    float ss = 0.f;
#pragma unroll
    for (int mt = 0; mt < 4; ++mt)
#pragma unroll
        for (int r = 0; r < 4; ++r) ss += acc[mt][r] * acc[mt][r];
    ss += __shfl_xor(ss, 16, 64); ss += __shfl_xor(ss, 32, 64);
    const float rstd = rsqrtf(ss * (1.f / 64.f) + 1e-6f);
    const float* og = p.in[13] + l * 64;
    const bf16_t* rp = (const bf16_t*)(p.ws + WS_PROJ) + (size_t)t * NPROJ + NC_LR + h * 64;
    bf16_t* mp = (bf16_t*)(p.ws + WS_MIX) + pl_off(t, 768 + h * 64, 1024);
#pragma unroll
    for (int mt = 0; mt < 4; ++mt) {
        const int e0 = 16 * mt + 4 * fg;
        uint2 gu = *(const uint2*)(rp + e0); f32x4 g4 = *(const f32x4*)(og + e0);
        store4_bf16(mp + e0 + (e0 & 32), acc[mt][0] * rstd * g4[0] * bflo(gu.x), acc[mt][1] * rstd * g4[1] * bfhi(gu.x), acc[mt][2] * rstd * g4[2] * bflo(gu.y), acc[mt][3] * rstd * g4[3] * bfhi(gu.y));
    }
}
__device__ void phase_mixout(const Params& p, int l) {
    for (int it = blockIdx.x; it < NGDN_CH + NGLA_CH; it += gridDim.x) {
        if (it < NGDN_CH) { if (MIXSEL & 1) gdn_out_item(p, l, it); } else { if (MIXSEL & 2) gla_out_item(p, l, it - NGDN_CH); }
    }
}

__device__ void fox_cumsum_item(const Params& p, int l, int bh, float* ldsf) {
    const int tid = ltid(), lane = tid & 63, w = tid >> 6;
    const int b = bh / H_FOX, h = bh % H_FOX;
    const float* aux = (const float*)(p.ws + WS_AUX);
    float* cum = (float*)(p.ws + WS_CUM) + (size_t)bh * SEQ;
    const float fb = p.in[5][l * H_FOX + h];
    float v[16]; float s = 0.f;
#pragma unroll
    for (int i = 0; i < 16; ++i) { v[i] = logsigmoidf_(aux[(size_t)(b * SEQ + tid * 16 + i) * 64 + AX_FF + h] + fb); s += v[i]; }
    float inc = s;
#pragma unroll
    for (int o = 1; o < 64; o <<= 1) { float t = __shfl_up(inc, o, 64); if (lane >= o) inc += t; }
    __syncthreads();
    if (lane == 63) ldsf[w] = inc;
    __syncthreads();
    float base = inc - s;
    for (int ww = 0; ww < w; ++ww) base += ldsf[ww];
    float c = base;
    u32x4* csx = (u32x4*)(p.ws + WS_SCR + SCR_CSX) + (size_t)bh * SEQ;
#pragma unroll
    for (int i = 0; i < 16; ++i) {
        c += v[i]; cum[tid * 16 + i] = c;
        const float vv = 1.4426950408889634f * c;
        const unsigned hi = pk_bf16(vv, 0.f) & 0xffffu; const float r1 = vv - __uint_as_float(hi << 16);
        const unsigned mid = pk_bf16(r1, 0.f) & 0xffffu; const float r2 = r1 - __uint_as_float(mid << 16);
        const unsigned lo = pk_bf16(r2, 0.f) & 0xffffu;
        u32x4 f; f[0] = 0x3F803F80u; f[1] = 0x3F80u | ((hi ^ 0x8000u) << 16); f[2] = (mid ^ 0x8000u) | ((lo ^ 0x8000u) << 16); f[3] = 0u;
        csx[tid * 16 + i] = f;
    }
}
__device__ void phase_prep(const Params& p, int l, unsigned char* lds_raw) {
    const int n0 = BATCH * H_FOX, n1 = n0 + ((MIXSEL & 1) ? NGDN_CH : 0), n2 = n1 + ((MIXSEL & 2) ? NGLA_CH : 0);
    for (int it = blockIdx.x; it < n2; it += gridDim.x) {
        if (it < n0) { __syncthreads(); fox_cumsum_item(p, l, it, (float*)lds_raw); }
        else if (it < n1) gdn_prep_item(p, l, it - n0, lds_raw);
        else gla_prep_item(p, l, it - n1, lds_raw);
    }
}

typedef float f32x16 __attribute__((ext_vector_type(16)));
#define ATT_BUF 17408
#define ATT_THR 8.0f
#define ATT_NSTAGE 3
__device__ __forceinline__ void attn_issue(const bf16_t* const (&kp)[2], const bf16_t* const (&vp)[2], const bf16_t* cp, int s0, unsigned char* stage, int w) {
    bf16_t* Ks = (bf16_t*)stage; bf16_t* Vs = Ks + 4096; bf16_t* cs = Vs + 4096;
    __builtin_amdgcn_global_load_lds((const unsigned*)(kp[0] + (size_t)s0 * NPROJ), (unsigned*)(Ks + (w * 8) * 64), 16, 0, 0);
    __builtin_amdgcn_global_load_lds((const unsigned*)(kp[1] + (size_t)s0 * NPROJ), (unsigned*)(Ks + (32 + w * 8) * 64), 16, 0, 0);
    __builtin_amdgcn_global_load_lds((const unsigned*)(vp[0] + s0), (unsigned*)(Vs + (w * 8) * 64), 16, 0, 0);
    __builtin_amdgcn_global_load_lds((const unsigned*)(vp[1] + s0), (unsigned*)(Vs + (32 + w * 8) * 64), 16, 0, 0);
    __builtin_amdgcn_global_load_lds((const unsigned*)(cp + (size_t)s0 * 8), (unsigned*)cs, 16, 0, 0);
}
__device__ __forceinline__ bf16x8 attn_qbias(float u, int h) {
    const unsigned hi = pk_bf16(u, 0.f) & 0xffffu; const float r1 = u - __uint_as_float(hi << 16);
    const unsigned mid = pk_bf16(r1, 0.f) & 0xffffu; const float r2 = r1 - __uint_as_float(mid << 16);
    const unsigned lo = pk_bf16(r2, 0.f) & 0xffffu;
    u32x4 f; f[0] = hi | (mid << 16); f[1] = lo | (0x3F80u << 16); f[2] = 0x3F803F80u; f[3] = 0u;
    if (h) { f[0] = 0u; f[1] = 0u; f[2] = 0u; }
    return __builtin_bit_cast(bf16x8, f);
}
__device__ void fox_attn_item(const Params& p, int l, int bh, int qt, unsigned char* lds_raw) {
    const int tid = ltid(), lane = tid & 63, w = __builtin_amdgcn_readfirstlane(tid >> 6), r = lane & 31, h = lane >> 5;
    const int b = bh / H_FOX, hh = bh % H_FOX;
    const bf16_t* proj = (const bf16_t*)(p.ws + WS_PROJ);
    const bf16_t* kbase = proj + (size_t)b * SEQ * NPROJ + NC_FK + hh * 64;
    const bf16_t* vbase = (const bf16_t*)(p.ws + WS_VTF) + (size_t)bh * 64 * SEQ;
    const float* cum = (const float*)(p.ws + WS_CUM) + (size_t)bh * SEQ;
    const int qlo = qt * 128 + w * 32, q = qlo + r;
    bf16x8 qf[4];
    {
        const bf16_t* qrow = proj + (size_t)(b * SEQ + q) * NPROJ + NC_FQ + hh * 64;
#pragma unroll
        for (int kk = 0; kk < 4; ++kk) qf[kk] = *(const bf16x8*)(qrow + kk * 16 + h * 8);
    }
    const float cq2 = cum[q] * 1.4426950408889634f;
    float mref = 0.f;
    bf16x8 qx = attn_qbias(cq2 - mref, h);
    f32x16 o0, o1;
#pragma unroll
    for (int i = 0; i < 16; ++i) { o0[i] = 0.f; o1[i] = 0.f; }
    float lsum = 0.f;
    const int ntiles = 2 * qt + 2;
    const bf16_t* kp[2]; const bf16_t* vp[2];
    {
        const int row0 = w * 8 + (lane >> 3), pc = lane & 7;
        const int lc0 = (pc ^ ((row0 >> 1) & 7)) * 8;
        kp[0] = kbase + (size_t)row0 * NPROJ + lc0; kp[1] = kbase + (size_t)(row0 + 32) * NPROJ + lc0;
        vp[0] = vbase + (size_t)row0 * SEQ + lc0;   vp[1] = vbase + (size_t)(row0 + 32) * SEQ + lc0;
    }
    const bf16_t* cp = (const bf16_t*)(p.ws + WS_SCR + SCR_CSX) + (size_t)bh * SEQ * 8 + lane * 8;
    const int swr = (r >> 1) & 7;
    int jw;
    {
        float gq = fabsf(p.in[3][l * 64 + lane]), gk = fabsf(p.in[4][l * 64 + lane]);
#pragma unroll
        for (int o = 32; o > 0; o >>= 1) { gq = fmaxf(gq, __shfl_xor(gq, o, 64)); gk = fmaxf(gk, __shfl_xor(gk, o, 64)); }
        const float thr = 2.f * (1.4426950408889634f * 8.f * gq * gk) + 30.f;
        const float cw = cum[qlo] * 1.4426950408889634f;
        const float ce = (lane < ntiles) ? cum[64 * lane + 63] * 1.4426950408889634f : 0.f;
        const unsigned long long keep = __ballot((lane < ntiles) && (cw - ce >= -thr));
        jw = keep ? (__ffsll((long long)keep) - 1) : (ntiles - 1);
    }
    volatile int* jshare = (volatile int*)(lds_raw + ATT_NSTAGE * ATT_BUF + 16);
    asm volatile("s_waitcnt vmcnt(0)" ::: "memory");
    RAW_BARRIER();
    if (tid == 0) *jshare = jw;
    RAW_BARRIER();
    const int jstart = *jshare;
    attn_issue(kp, vp, cp, jstart * 64, lds_raw + (jstart % ATT_NSTAGE) * ATT_BUF, w);
    if (jstart + 1 < ntiles) attn_issue(kp, vp, cp, (jstart + 1) * 64, lds_raw + ((jstart + 1) % ATT_NSTAGE) * ATT_BUF, w);
    for (int j = jstart; j < ntiles; ++j) {
        if (j + 1 < ntiles) asm volatile("s_waitcnt vmcnt(5)" ::: "memory"); else asm volatile("s_waitcnt vmcnt(0)" ::: "memory");
        RAW_BARRIER();
        if (j + 2 < ntiles) attn_issue(kp, vp, cp, (j + 2) * 64, lds_raw + ((j + 2) % ATT_NSTAGE) * ATT_BUF, w);
        const int s0 = j * 64;
        if (s0 <= qlo + 31 && j >= jw) {
            const bf16_t* Ks = (const bf16_t*)(lds_raw + (j % ATT_NSTAGE) * ATT_BUF); const bf16_t* Vs = Ks + 4096; const bf16_t* cs = Vs + 4096;
            f32x16 st0, st1;
            {
                u32x4 z4 = {0u, 0u, 0u, 0u};
                u32x4 c0 = *(const u32x4*)(cs + r * 8), c1 = *(const u32x4*)(cs + (32 + r) * 8);
                if (h) { c0 = z4; c1 = z4; }
                f32x16 zz;
#pragma unroll
                for (int i = 0; i < 16; ++i) zz[i] = 0.f;
                st0 = __builtin_amdgcn_mfma_f32_32x32x16_bf16(__builtin_bit_cast(bf16x8, c0), qx, zz, 0, 0, 0);
                st1 = __builtin_amdgcn_mfma_f32_32x32x16_bf16(__builtin_bit_cast(bf16x8, c1), qx, zz, 0, 0, 0);
            }
#pragma unroll
            for (int kk = 0; kk < 4; ++kk) {
                const int co = ((kk * 2 + h) ^ swr) * 8;
                bf16x8 a0 = *(const bf16x8*)(Ks + r * 64 + co);
                bf16x8 a1 = *(const bf16x8*)(Ks + (32 + r) * 64 + co);
                st0 = __builtin_amdgcn_mfma_f32_32x32x16_bf16(a0, qf[kk], st0, 0, 0, 0);
                st1 = __builtin_amdgcn_mfma_f32_32x32x16_bf16(a1, qf[kk], st1, 0, 0, 0);
            }
            if (s0 + 63 > qlo) {
#pragma unroll
                for (int i = 0; i < 16; ++i) {
                    const int key = s0 + (i & 3) + 8 * (i >> 2) + 4 * h;
                    if (key > q) st0[i] = -1e30f;
                    if (key + 32 > q) st1[i] = -1e30f;
                }
            }
            float mx = fmaxf(st0[0], st1[0]);
#pragma unroll
            for (int i = 1; i < 16; ++i) mx = fmaxf(mx, fmaxf(st0[i], st1[i]));
            if (__any(mx > ATT_THR)) {
                const float mo = fmaxf(mx, __shfl_xor(mx, 32, 64));
                const float d = (mo > ATT_THR) ? mo : 0.f;
                const float alpha = __builtin_amdgcn_exp2f(-d);
#pragma unroll
                for (int i = 0; i < 16; ++i) { st0[i] -= d; st1[i] -= d; o0[i] *= alpha; o1[i] *= alpha; }
                lsum *= alpha; mref += d;
                qx = attn_qbias(cq2 - mref, h);
            }
            float rs = 0.f;
#pragma unroll
            for (int i = 0; i < 16; ++i) { st0[i] = __builtin_amdgcn_exp2f(st0[i]); st1[i] = __builtin_amdgcn_exp2f(st1[i]); rs += st0[i] + st1[i]; }
            lsum += rs;
            bf16x8 pf[2][2];
#pragma unroll
            for (int s = 0; s < 2; ++s) {
                u32x4 t0 = {pk_bf16(st0[8 * s], st0[8 * s + 1]), pk_bf16(st0[8 * s + 2], st0[8 * s + 3]), pk_bf16(st0[8 * s + 4], st0[8 * s + 5]), pk_bf16(st0[8 * s + 6], st0[8 * s + 7])};
                u32x4 t1 = {pk_bf16(st1[8 * s], st1[8 * s + 1]), pk_bf16(st1[8 * s + 2], st1[8 * s + 3]), pk_bf16(st1[8 * s + 4], st1[8 * s + 5]), pk_bf16(st1[8 * s + 6], st1[8 * s + 7])};
                pf[0][s] = __builtin_bit_cast(bf16x8, t0); pf[1][s] = __builtin_bit_cast(bf16x8, t1);
            }
#pragma unroll
            for (int mt = 0; mt < 2; ++mt)
#pragma unroll
                for (int s = 0; s < 2; ++s) {
                    const int c0 = 4 * mt + 2 * s;
                    const int oA = ((c0 ^ swr) * 8) + 4 * h, oB = (((c0 + 1) ^ swr) * 8) + 4 * h;
                    uint2 a00 = *(const uint2*)(Vs + r * 64 + oA), a01 = *(const uint2*)(Vs + r * 64 + oB);
                    uint2 a10 = *(const uint2*)(Vs + (32 + r) * 64 + oA), a11 = *(const uint2*)(Vs + (32 + r) * 64 + oB);
                    u32x4 u0 = {a00.x, a00.y, a01.x, a01.y}; u32x4 u1 = {a10.x, a10.y, a11.x, a11.y};
                    o0 = __builtin_amdgcn_mfma_f32_32x32x16_bf16(__builtin_bit_cast(bf16x8, u0), pf[mt][s], o0, 0, 0, 0);
                    o1 = __builtin_amdgcn_mfma_f32_32x32x16_bf16(__builtin_bit_cast(bf16x8, u1), pf[mt][s], o1, 0, 0, 0);
                }
        }
    }
    lsum += __shfl_xor(lsum, 32, 64);
    const float inv = 1.f / lsum;
    float ss = 0.f;
#pragma unroll
    for (int i = 0; i < 16; ++i) { o0[i] *= inv; o1[i] *= inv; ss += o0[i] * o0[i] + o1[i] * o1[i]; }
    ss += __shfl_xor(ss, 32, 64);
    const float rstd = rsqrtf(ss * (1.f / 64.f) + 1e-6f);
    const float* og = p.in[6] + l * 64;
    bf16_t* mrow = (bf16_t*)(p.ws + WS_MIX) + pl_off(b * SEQ + q, hh * 64, 1024);
#pragma unroll
    for (int g = 0; g < 4; ++g) {
        const int e0 = 8 * g + 4 * h;
        f32x4 g0 = *(const f32x4*)(og + e0), g1 = *(const f32x4*)(og + 32 + e0);
        store4_bf16(mrow + e0, o0[4 * g] * rstd * g0[0], o0[4 * g + 1] * rstd * g0[1], o0[4 * g + 2] * rstd * g0[2], o0[4 * g + 3] * rstd * g0[3]);
        store4_bf16(mrow + 64 + e0, o1[4 * g] * rstd * g1[0], o1[4 * g + 1] * rstd * g1[1], o1[4 * g + 2] * rstd * g1[2], o1[4 * g + 3] * rstd * g1[3]);
    }
}
#define ATT_ITEMS (BATCH * H_FOX * (SEQ / 128))
#define CONV_ITEMS ((CONV_REST + P0_T_IN + 3) / 4)
__device__ void phase_scan_attn(const Params& p, int l, unsigned char* lds_raw, int rep = 0, int sel = 7) {
    unsigned* qctr = (unsigned*)(p.ws + WS_CTL) + CW_Q + l + 2 * rep;
    volatile int* slot = (volatile int*)(lds_raw + ATT_NSTAGE * ATT_BUF);
    for (;;) {
        __syncthreads();
        if (threadIdx.x == 0) *slot = (int)atomicAdd(qctr, 1u);
        __syncthreads();
        int it = *slot;
        const int ns0 = (MIXSEL & 1) ? BATCH * H_GDN * 4 : 0, ns1 = ns0 + ((MIXSEL & 2) ? 128 : 0);
        if (it >= ns1 + ATT_ITEMS + CONV_ITEMS) break;
        if (it >= ns1) {
            const int c = it - ns1;
            int conv_idx = -1;
            if (c < 5 * ATT_ITEMS) { if (c % 5 != 0) conv_idx = c - c / 5 - 1; } else conv_idx = c - ATT_ITEMS;
            if (conv_idx >= 0) {
                if (rep == 0 && conv_idx < CONV_ITEMS) conv_fold4(p, l, conv_idx * 4, ltid());
                continue;
            }
            it = ns1 + c / 5;
        }
        if (it < ns0) { if (sel & 1) gdn_scan_item(p, it, lds_raw, rep ? SVAR : 0); continue; }
        if (it < ns1) { if (sel & 2) gla_scan_item(p, it - ns0); continue; }
        it -= ns1;
        if (!(sel & 4)) continue;
        const int qt = (SEQ / 128 - 1) - it / (BATCH * H_FOX), bh = it % (BATCH * H_FOX);
        fox_attn_item(p, l, bh, qt, lds_raw);
    }
}

#define NPHASE 19
__global__ void __launch_bounds__(256, 2) mk(Params p, int lo, int hi, int use_bar) {
    __shared__ __attribute__((aligned(16))) unsigned char lds_raw[LDS_BYTES];
    bf16_t* lds = (bf16_t*)lds_raw;
    volatile LAS unsigned* st = (volatile LAS unsigned*)(lds_raw + LDS_BYTES - 16);
    XcdBarrier bar; bar.bar = (unsigned*)(p.ws + WS_CTL) + CW_BAR; bar.x = 0; bar.st = st;
    if (use_bar) {
        if (threadIdx.x == 0) { st[0] = 0u; st[1] = 0u; }
        __syncthreads();
        bar = xcd_barrier_post((unsigned*)(p.ws + WS_CTL) + CW_BAR, st);
    }
    for (int ph = lo; ph < hi; ++ph) {
#ifndef PSEL
#define PSEL 0xffff
#endif
        int phv = ph; asm volatile("" : "+s"(phv));
        size_t zoff = 0; asm volatile("" : "+s"(zoff));
        Params q = p; q.ws = p.ws + zoff; q.out = p.out + zoff;
        if (phv == 0) { if (PSEL & 1) phase0(q); }
        else {
            int l = (phv - 1) / 9, s = (phv - 1) % 9;
            if (s == 0) { if (PSEL & 2) phase_inproj(q, l, lds); }
            else if (s == 1) { if (PSEL & 128) phase_prep(q, l, lds_raw); }
            else if (s == 2) { if (PSEL & 256) phase_scan_attn(q, l, lds_raw); }
            else if (s == 3) { if (PSEL & 512) phase_mixout(q, l); }
            else if (s == 4) { if (PSEL & 4) phase_outproj(q, l, lds); }
            else if (s == 5) { if (PSEL & 8) phase_route(q, l, lds); }
            else if (s == 6) { if (PSEL & 16) phase_expert<0>(q, l, lds); }
            else if (s == 7) { if (PSEL & 32) phase_expert<1>(q, l, lds); }
            else if (s == 8) { if (PSEL & 64) phase_combine(q, l); }
        }
#ifdef REPEAT_MASK
        {
            const int ty = (phv == 0) ? 9 : (phv - 1) % 9, l = (phv == 0) ? 0 : (phv - 1) / 9;
            const bool idem = !((ty == 4 && l == 1));
            if (((REPEAT_MASK >> ty) & 1) && idem && use_bar) {
                xcd_barrier(bar);
                if (ty == 9) phase0(q);
                else if (ty == 0) phase_inproj(q, l, lds, GVAR);
                else if (ty == 1) phase_prep(q, l, lds_raw);
                else if (ty == 2) phase_scan_attn(q, l, lds_raw, 1, P3SEL);
                else if (ty == 3) phase_mixout(q, l);
                else if (ty == 4) phase_outproj(q, l, lds);
                else if (ty == 5) phase_route(q, l, lds, 1);
                else if (ty == 8) phase_combine(q, l, 1);
                else if (ty == 6) phase_expert<0>(q, l, lds);
                else if (ty == 7) phase_expert<1>(q, l, lds);
            }
        }
#endif
        if (ph + 1 < hi) {
            if (hi > 1000) cg::this_grid().sync();
            xcd_barrier(bar);
        }
    }
}

extern "C" void kernel_launch(void* const* d_in, const int* in_sizes, int n_in,
                              void* d_out, int out_size, void* d_ws, size_t ws_size,
                              hipStream_t stream) {
    static int grid = 0;
    if (grid == 0) {
        if (ws_size < WS_END) { fprintf(stderr, "ws too small: need %zu have %zu\n", (size_t)WS_END, ws_size); grid = -1; return; }
        int dev = 0, cus = 0, per_cu = 0;
        hipGetDevice(&dev);
        hipDeviceGetAttribute(&cus, hipDeviceAttributeMultiprocessorCount, dev);
        hipOccupancyMaxActiveBlocksPerMultiprocessor(&per_cu, mk, 256, 0);
        if (per_cu > 2) per_cu = 2;
        if (per_cu < 1) { fprintf(stderr, "occupancy query failed\n"); grid = -1; return; }
        grid = cus * per_cu;
        grid -= grid % 8;
    }
    if (grid < 0) return;
    Params p{};
    for (int i = 0; i < 23; ++i) p.in[i] = (const float*)d_in[i];
    p.out = (float*)d_out; p.ws = (char*)d_ws;
    hipMemsetAsync((char*)d_ws + WS_CTL, 0, CTL_BYTES, stream);
#ifdef POISON_GLA
    hipMemsetAsync((char*)d_ws + WS_SCR + SCR_GLA_OL, 0xFF, SCR_LVT - SCR_GLA_OL, stream);
#endif

#ifdef MULTI_LAUNCH
    for (int ph = 0; ph < NPHASE; ++ph) mk<<<grid, 256, 0, stream>>>(p, ph, ph + 1, 0);
#else
    int lo = 0, hi = NPHASE, ub = 2;
    void* args[] = {&p, &lo, &hi, &ub};
    hipError_t e = hipLaunchCooperativeKernel((void*)mk, dim3(grid), dim3(256), args, 0, stream);
    if (e != hipSuccess) fprintf(stderr, "cooperative launch failed: %s (grid %d)\n", hipGetErrorString(e), grid);
#endif
}
```

```cpp
#include <hip/hip_runtime.h>
#include <hip/hip_cooperative_groups.h>
#include <cstdint>
#include <cstdio>
namespace cg = cooperative_groups;

#define D_MODEL 1024
#define BATCH 4
#define SEQ 4096
#define NTOK (BATCH * SEQ)
#define H_FOX 6
#define H_GDN 6
#define H_GLA 4
#define N_IN 3490
#define N_EXP 32
#define D_EXP 512
#define NPROJ 3456
#define NINP 3584

#define C_FF 1152
#define C_GQ 1158
#define C_GG 2310
#define C_GA 2694
#define C_GB 2700
#define C_LQ 2706
#define C_LA 3474
#define NC_FQ 0
#define NC_FK 384
#define NC_FV 768
#define NC_GQ 1152
#define NC_GK 1536
#define NC_GV 1920
#define NC_GG 2304
#define NC_LQ 2688
#define NC_LK 2816
#define NC_LV 2944
#define NC_LR 3200
#define AX_FF 0
#define AX_GA 6
#define AX_GB 12
#define AX_LA 18

#ifndef SVAR
#define SVAR 0
#endif
#ifndef P3SEL
#define P3SEL 7
#endif
#ifndef GVAR
#define GVAR 0
#endif
#ifndef MIXSEL
#define MIXSEL 3
#endif
typedef unsigned short bf16_t;
typedef short bf16x8 __attribute__((ext_vector_type(8)));
typedef float f32x4 __attribute__((ext_vector_type(4)));
typedef unsigned u32x4 __attribute__((ext_vector_type(4)));
typedef unsigned u32x2 __attribute__((ext_vector_type(2)));

#define WS_CTL      0
#define CTL_BYTES   65536
#define WS_WIN      (WS_CTL + CTL_BYTES)
#define WS_WOUT     (WS_WIN + (size_t)2 * NINP * 1024 * 2)
#define WS_WGU      (WS_WOUT + (size_t)2 * 1024 * 1024 * 2)
#define WS_WD       (WS_WGU + (size_t)2 * 32 * 1024 * 1024 * 2)
#define WS_WR       (WS_WD + (size_t)2 * 32 * 1024 * 512 * 2)
#define WS_HN       (WS_WR + (size_t)2 * 64 * 1024 * 2)
#define WS_PROJ     (WS_HN + (size_t)NTOK * 1024 * 2)
#define WS_VTF      (WS_PROJ + (size_t)NTOK * NPROJ * 2)
#define WS_AUX      (WS_VTF + (size_t)BATCH * H_FOX * 64 * SEQ * 2)
#define WS_CUM      (WS_AUX + (size_t)NTOK * 64 * 4)
#define WS_MIX      (WS_CUM + (size_t)BATCH * H_FOX * SEQ * 4)
#define WS_ROWTOK   (WS_MIX + (size_t)NTOK * 1024 * 2)
#define WS_TSLOT    (WS_ROWTOK + (size_t)32 * NTOK * 4)
#define WS_TGATE    (WS_TSLOT + (size_t)NTOK * 2 * 4)
#define WS_SCR      (WS_TGATE + (size_t)NTOK * 2 * 4)
#define SCR_BYTES   ((size_t)100 * 1024 * 1024)
#define WS_END      (WS_SCR + SCR_BYTES)
#define HROWS       (2 * NTOK + 32 * 128)
#define WS_H        WS_PROJ
#define WS_Y        (WS_PROJ + (size_t)HROWS * 512 * 2)

#define NGDN_CH 1536
#define NGLA_CH 1024
#define SCR_GDN_MP   ((size_t)0)
#define SCR_GDN_NN   (SCR_GDN_MP + (size_t)NGDN_CH * 8192)
#define SCR_GDN_P    (SCR_GDN_NN + (size_t)NGDN_CH * 8192)
#define SCR_GDN_OL   (SCR_GDN_P  + (size_t)NGDN_CH * 8192)
#define SCR_GDN_SG   (SCR_GDN_OL + (size_t)NGDN_CH * 8192)
#define SCR_GDN_LAST (SCR_GDN_SG + (size_t)NGDN_CH * 8192)
#define SCR_GLA_OL   (SCR_GDN_LAST + (size_t)NGDN_CH * 4)
#define SCR_GLA_KV   (SCR_GLA_OL + (size_t)NGLA_CH * 8192)
#define SCR_GLA_QB   (SCR_GLA_KV + (size_t)NGLA_CH * 8192)
#define SCR_GLA_SG   (SCR_GLA_QB + (size_t)NGLA_CH * 4096)
#define SCR_GLA_DL   (SCR_GLA_SG + (size_t)NGLA_CH * 4096)
#define SCR_LVT      (SCR_GLA_DL + (size_t)NGLA_CH * 128)
#define SCR_USED     (SCR_LVT + (size_t)BATCH * H_GLA * 64 * SEQ * 2)
#define SCR_CSX      SCR_USED
static_assert(SCR_CSX + (size_t)BATCH * H_FOX * SEQ * 16 <= SCR_BYTES, "scratch overflow");
#define CW_BAR      0
#define CW_CNT      4096
#define CNT_STRIDE  64
#define CW_Q        (CW_CNT + 2 * 32 * CNT_STRIDE + 64)

struct Params {
    const float* in[23];
    float* out;
    char* ws;
};

__device__ __forceinline__ float sigmoidf_(float x) { return __builtin_amdgcn_rcpf(1.f + __expf(-x)); }
__device__ __forceinline__ float siluf_(float x) { return x * __builtin_amdgcn_rcpf(1.f + __expf(-x)); }
__device__ __forceinline__ float softplusf_(float x) { return x > 20.f ? x : __logf(1.f + __expf(x)); }
__device__ __forceinline__ float logsigmoidf_(float x) { return -softplusf_(-x); }
__device__ __forceinline__ float wave_sum(float v) {
#pragma unroll
    for (int o = 32; o > 0; o >>= 1) v += __shfl_xor(v, o, 64);
    return v;
}
__device__ __forceinline__ int ltid() { int t = threadIdx.x; asm volatile("" : "+v"(t)); return t; }
typedef __bf16 bf16x2_t __attribute__((ext_vector_type(2)));
typedef float f32x2_t __attribute__((ext_vector_type(2)));
__device__ __forceinline__ unsigned pk_bf16(float lo, float hi) { f32x2_t v = {lo, hi}; bf16x2_t r = __builtin_convertvector(v, bf16x2_t); return __builtin_bit_cast(unsigned, r); }
__device__ __forceinline__ size_t pl_off(int row, int k, int K) { return (size_t)(row >> 1) * (size_t)(2 * K) + (size_t)((k >> 5) * 64 + (row & 1) * 32 + (k & 31)); }
__device__ __forceinline__ unsigned ld_u32_agent(const unsigned* p) { return __hip_atomic_load(p, __ATOMIC_RELAXED, __HIP_MEMORY_SCOPE_AGENT); }
__device__ __forceinline__ float ld_f32_agent(const float* p) { return __uint_as_float(__hip_atomic_load((const unsigned*)p, __ATOMIC_RELAXED, __HIP_MEMORY_SCOPE_AGENT)); }
__device__ __forceinline__ float bf2f(bf16_t v) { return __uint_as_float((unsigned)v << 16); }
__device__ __forceinline__ float bflo(unsigned v) { return __uint_as_float(v << 16); }
__device__ __forceinline__ float bfhi(unsigned v) { return __uint_as_float(v & 0xffff0000u); }

#define XB_TMO      128
#define XB_XCNT(j)  (256  + 64 * (j))
#define XB_XSUB(j)  (1280 + 64 * (j))
#define XB_XGEN(j)  (2304 + 64 * (j))
#define XB_TOP      3328
#define XB_TOPGEN   3392
#define XCD_BAR_WORDS 3456
#define XB_SPIN_CAP (1u << 22)
#define LAS __attribute__((address_space(3)))
__device__ __forceinline__ unsigned xb_ld(unsigned* p)              { return __hip_atomic_load(p, __ATOMIC_RELAXED, __HIP_MEMORY_SCOPE_AGENT); }
__device__ __forceinline__ unsigned xb_add(unsigned* p, unsigned v) { return __hip_atomic_fetch_add(p, v, __ATOMIC_RELAXED, __HIP_MEMORY_SCOPE_AGENT); }
__device__ __forceinline__ unsigned xb_xcc_id() { return (unsigned)__builtin_amdgcn_s_getreg((3 << 11) | 20) & 0xFu; }
#define XB_SPIN(cond, bar) do { unsigned _sp = 0; while (cond) { if (_sp < 16u) __builtin_amdgcn_s_sleep(2); else __builtin_amdgcn_s_sleep(20);     \
    if ((++_sp & 255u) == 0u) { if (xb_ld(&(bar)[XB_TMO])) break; if (_sp > XB_SPIN_CAP) { atomicAdd(&(bar)[XB_TMO], 1u); break; } } } } while (0)
struct XcdBarrier { unsigned* bar; unsigned x; volatile LAS unsigned* st; };
__device__ __forceinline__ XcdBarrier xcd_barrier_post(unsigned* bar, volatile LAS unsigned* st) {
    XcdBarrier b; b.bar = bar; b.x = xb_xcc_id(); b.st = st;
    if (threadIdx.x == 0) (void)xb_add(&bar[XB_XCNT(b.x)], 1u);
    return b;
}
__device__ __forceinline__ void xcd_barrier_complete(unsigned* bar, unsigned x, unsigned& nloc, unsigned& nx) {
    const unsigned G = gridDim.x * gridDim.y * gridDim.z;
    unsigned sum, cnt, mine, sp = 0u;
    for (;;) {
        sum = 0u; cnt = 0u; mine = 0u;
#pragma unroll
        for (unsigned j = 0; j < 16; ++j) { const unsigned c = xb_ld(&bar[XB_XCNT(j)]); sum += c; cnt += (c > 0u) ? 1u : 0u; mine = (j == x) ? c : mine; }
        if (sum == G) break;
        __builtin_amdgcn_s_sleep(1);
        if ((++sp & 255u) == 0u) { if (xb_ld(&bar[XB_TMO])) break; if (sp > XB_SPIN_CAP) { atomicAdd(&bar[XB_TMO], 1u); break; } }
    }
    nloc = mine > 0u ? mine : 1u; nx = cnt > 0u ? cnt : 1u;
}
__device__ __forceinline__ void xcd_barrier(const XcdBarrier& b) {
    asm volatile("s_waitcnt vmcnt(0)" ::: "memory");
    __syncthreads();
    if (threadIdx.x == 0) {
        unsigned* bar = b.bar;
        __builtin_amdgcn_s_waitcnt(0);
        unsigned nloc = b.st[0], nx = b.st[1];
        if (nloc == 0u) { xcd_barrier_complete(bar, b.x, nloc, nx); b.st[0] = nloc; b.st[1] = nx; }
        const unsigned old = xb_add(&bar[XB_XSUB(b.x)], 1u);
        const unsigned gen = old / nloc;
        if (old + 1u == (gen + 1u) * nloc) {
            __builtin_amdgcn_fence(__ATOMIC_RELEASE, "agent");
            asm volatile("s_waitcnt vmcnt(0)" ::: "memory");
            const unsigned og = xb_add(&bar[XB_TOP], 1u);
            const unsigned tg = og / nx;
            if (og + 1u == (tg + 1u) * nx) xb_add(&bar[XB_TOPGEN], 1u);
            else XB_SPIN(xb_ld(&bar[XB_TOPGEN]) == tg, bar);
            __builtin_amdgcn_fence(__ATOMIC_ACQUIRE, "agent");
            xb_add(&bar[XB_XGEN(b.x)], 1u);
            asm volatile("s_waitcnt vmcnt(0)" ::: "memory");
        } else {
            XB_SPIN(xb_ld(&bar[XB_XGEN(b.x)]) == gen, bar);
            __builtin_amdgcn_fence(__ATOMIC_ACQUIRE, "agent");
            asm volatile("s_waitcnt vmcnt(0)" ::: "memory");
        }
    }
    __syncthreads();
}

#define LDS_BYTES 66560
#define LROW 72

__device__ __forceinline__ int inproj_map(int n) {
    if (n < 1152) return n;
    if (n < 2304) return C_GQ + (n - 1152);
    if (n < 2688) return C_GG + (n - 2304);
    if (n < 3456) return C_LQ + (n - 2688);
    if (n < 3462) return C_FF + (n - 3456);
    if (n < 3468) return C_GA + (n - 3462);
    if (n < 3474) return C_GB + (n - 3468);
    if (n < 3490) return n;
    return -1;
}
#define P0_T_IN   (56 * 16)
#define P0_T_OUT  (16 * 16)
#define P0_T_GU   (32 * 16 * 16)
#define P0_T_D    (32 * 16 * 8)
#define P0_T_R    (16)
#define P0_T_LAYER (P0_T_IN + P0_T_OUT + P0_T_GU + P0_T_D + P0_T_R)
#define P0_T_NORM (NTOK / 4)
struct ConvDesc { const float* src; bf16_t* dst; int ld; int col; };
__device__ __forceinline__ ConvDesc conv_desc(const Params& p, int l, int j, int tid) {
    const int nl = tid & 63, kg = tid >> 6;
    ConvDesc d;
    if (j < P0_T_IN) {
        int tn = j / 16, tk = j % 16; int n = tn * 64 + nl; int k0 = tk * 64 + kg * 16;
        d.ld = N_IN; d.col = inproj_map(n); d.src = p.in[2] + (size_t)l * 1024 * N_IN + (size_t)k0 * N_IN;
        d.dst = (bf16_t*)(p.ws + WS_WIN) + (size_t)l * NINP * 1024 + pl_off(n, k0, 1024);
        return d;
    }
    j -= P0_T_IN;
    if (j < P0_T_OUT) {
        int tn = j / 16, tk = j % 16; int n = tn * 64 + nl; int k0 = tk * 64 + kg * 16;
        d.ld = 1024; d.col = n; d.src = p.in[14] + (size_t)l * 1024 * 1024 + (size_t)k0 * 1024;
        d.dst = (bf16_t*)(p.ws + WS_WOUT) + (size_t)l * 1024 * 1024 + pl_off(n, k0, 1024);
        return d;
    }
    j -= P0_T_OUT;
    if (j < P0_T_GU) {
        int e = j / 256, r = j % 256; int tn = r / 16, tk = r % 16; int n = tn * 64 + nl; int k0 = tk * 64 + kg * 16;
        int t128 = n >> 7, wx = (n >> 6) & 1, half = (n >> 5) & 1, jj = n & 31;
        d.ld = 512; d.col = t128 * 64 + wx * 32 + jj;
        d.src = (half ? p.in[21] : p.in[20]) + ((size_t)l * 32 + e) * 1024 * 512 + (size_t)k0 * 512;
        d.dst = (bf16_t*)(p.ws + WS_WGU) + ((size_t)l * 32 + e) * 1024 * 1024 + pl_off(n, k0, 1024);
        return d;
    }
    j -= P0_T_GU;
    if (j < P0_T_D) {
        int e = j / 128, r = j % 128; int tn = r / 8, tk = r % 8; int n = tn * 64 + nl; int k0 = tk * 64 + kg * 16;
        d.ld = 1024; d.col = n; d.src = p.in[22] + ((size_t)l * 32 + e) * 512 * 1024 + (size_t)k0 * 1024;
        d.dst = (bf16_t*)(p.ws + WS_WD) + ((size_t)l * 32 + e) * 1024 * 512 + pl_off(n, k0, 512);
        return d;
    }
    j -= P0_T_D;
    {
        int tk = j; int n = nl; int k0 = tk * 64 + kg * 16;
        if (n < 4) { d.src = p.in[16] + (size_t)l * 1024 * 4 + (size_t)k0 * 4; d.ld = 4; d.col = n; }
        else if (n < 36) { d.src = p.in[18] + (size_t)l * 1024 * 32 + (size_t)k0 * 32; d.ld = 32; d.col = n - 4; }
        else { d.src = p.in[16]; d.ld = 4; d.col = -1; }
        d.dst = (bf16_t*)(p.ws + WS_WR) + ((size_t)l * 64 + n) * 1024 + k0;
        return d;
    }
}
__device__ __forceinline__ void conv_load(const ConvDesc& d, float (&v)[16]) {
    if (d.col >= 0) {
#pragma unroll
        for (int i = 0; i < 16; ++i) v[i] = d.src[(size_t)i * d.ld + d.col];
    } else {
#pragma unroll
        for (int i = 0; i < 16; ++i) v[i] = 0.f;
    }
}
__device__ __forceinline__ void conv_store(const ConvDesc& d, const float (&v)[16]) {
    uint4 o0, o1;
    o0.x = pk_bf16(v[0], v[1]); o0.y = pk_bf16(v[2], v[3]); o0.z = pk_bf16(v[4], v[5]); o0.w = pk_bf16(v[6], v[7]);
    o1.x = pk_bf16(v[8], v[9]); o1.y = pk_bf16(v[10], v[11]); o1.z = pk_bf16(v[12], v[13]); o1.w = pk_bf16(v[14], v[15]);
    *(uint4*)(d.dst) = o0;
    *(uint4*)(d.dst + 8) = o1;
}
__device__ __forceinline__ void conv_job(const Params& p, int l, int j, int tid) {
    ConvDesc d = conv_desc(p, l, j, tid); float v[16]; conv_load(d, v); conv_store(d, v);
}
#define CONV_REST (P0_T_LAYER - P0_T_IN)
__device__ __forceinline__ bool conv_fold_desc(const Params& p, int l, int idx, int tid, ConvDesc& d) {
    if (idx < CONV_REST) { d = conv_desc(p, l, P0_T_IN + idx, tid); return true; }
    if (l == 0 && idx < CONV_REST + P0_T_IN) { d = conv_desc(p, 1, idx - CONV_REST, tid); return true; }
    return false;
}
__device__ __forceinline__ void conv_fold4(const Params& p, int l, int idx0, int tid) {
    ConvDesc d0, d1, d2, d3; float v0[16], v1[16], v2[16], v3[16];
    const bool b0 = conv_fold_desc(p, l, idx0, tid, d0), b1 = conv_fold_desc(p, l, idx0 + 1, tid, d1), b2 = conv_fold_desc(p, l, idx0 + 2, tid, d2), b3 = conv_fold_desc(p, l, idx0 + 3, tid, d3);
    if (b0) conv_load(d0, v0); if (b1) conv_load(d1, v1); if (b2) conv_load(d2, v2); if (b3) conv_load(d3, v3);
    if (b0) conv_store(d0, v0); if (b1) conv_store(d1, v1); if (b2) conv_store(d2, v2); if (b3) conv_store(d3, v3);
}
__device__ void phase0(const Params& p) {
    const int tid = ltid(), nl = tid & 63, kg = tid >> 6;
    const int total = P0_T_IN + P0_T_NORM;
    for (int it = blockIdx.x; it < total; it += gridDim.x) {
        if (it >= P0_T_IN) {
            int row = (it - P0_T_IN) * 4 + kg;
            const float* xr = p.in[0] + (size_t)row * D_MODEL + nl * 16;
            const float* gr = p.in[1] + nl * 16;
            float v[16]; float ss = 0.f;
#pragma unroll
            for (int i = 0; i < 4; ++i) { float4 t = *(const float4*)(xr + 4 * i); v[4 * i] = t.x; v[4 * i + 1] = t.y; v[4 * i + 2] = t.z; v[4 * i + 3] = t.w; }
#pragma unroll
            for (int i = 0; i < 16; ++i) ss += v[i] * v[i];
            ss = wave_sum(ss);
            float r = rsqrtf(ss / D_MODEL + 1e-6f);
#pragma unroll
            for (int i = 0; i < 16; ++i) v[i] = v[i] * r * gr[i];
            uint4 o0, o1;
            o0.x = pk_bf16(v[0], v[1]); o0.y = pk_bf16(v[2], v[3]); o0.z = pk_bf16(v[4], v[5]); o0.w = pk_bf16(v[6], v[7]);
            o1.x = pk_bf16(v[8], v[9]); o1.y = pk_bf16(v[10], v[11]); o1.z = pk_bf16(v[12], v[13]); o1.w = pk_bf16(v[14], v[15]);
            bf16_t* hr = (bf16_t*)(p.ws + WS_HN) + pl_off(row, nl * 16, 1024);
            *(uint4*)hr = o0; *(uint4*)(hr + 8) = o1;
            continue;
        }
        conv_job(p, 0, it, tid);
    }
}

#define GSTAGE 8192
#define RAW_BARRIER() do { asm volatile("s_waitcnt lgkmcnt(0)" ::: "memory"); __builtin_amdgcn_s_barrier(); } while (0)
__device__ __forceinline__ int gswz(int row) { return (0x1320 >> (((row >> 2) & 3) * 4)) & 3; }
__device__ __forceinline__ void gemm_issue(const bf16_t* const (&px)[2], const bf16_t* const (&py)[2], int k0, bf16_t* stage, int w) {
    __builtin_amdgcn_global_load_lds((const unsigned*)(px[0] + 2 * k0), (unsigned*)(stage + (w * 16) * 32), 16, 0, 0);
    __builtin_amdgcn_global_load_lds((const unsigned*)(px[1] + 2 * k0), (unsigned*)(stage + (64 + w * 16) * 32), 16, 0, 0);
    __builtin_amdgcn_global_load_lds((const unsigned*)(py[0] + 2 * k0), (unsigned*)(stage + 4096 + (w * 16) * 32), 16, 0, 0);
    __builtin_amdgcn_global_load_lds((const unsigned*)(py[1] + 2 * k0), (unsigned*)(stage + 4096 + (64 + w * 16) * 32), 16, 0, 0);
}
__device__ __forceinline__ void gemm_compute(const bf16_t* stage, int wx, int wy, int fr, int fg, f32x4 (&acc)[4][4]) {
    const int co = (fg ^ gswz(fr)) * 8;
    bf16x8 xa[4], yb[4];
#pragma unroll
    for (int m = 0; m < 4; ++m) xa[m] = *(const bf16x8*)(stage + (wx * 64 + m * 16 + fr) * 32 + co);
#pragma unroll
    for (int n = 0; n < 4; ++n) yb[n] = *(const bf16x8*)(stage + 4096 + (wy * 64 + n * 16 + fr) * 32 + co);
    __builtin_amdgcn_s_setprio(1);
#pragma unroll
    for (int m = 0; m < 4; ++m)
#pragma unroll
        for (int n = 0; n < 4; ++n) acc[m][n] = __builtin_amdgcn_mfma_f32_16x16x32_bf16(xa[m], yb[n], acc[m][n], 0, 0, 0);
    __builtin_amdgcn_s_setprio(0);
}
template <class FX, class FY>
__device__ __forceinline__ void gemm_core(FX rowx, FY rowy, int K, bf16_t* lds, f32x4 (&acc)[4][4], int gvar = 0) {
    const int tid = ltid(), lane = tid & 63, w = __builtin_amdgcn_readfirstlane(tid >> 6), wx = w >> 1, wy = w & 1, fr = lane & 15, fg = lane >> 4;
#pragma unroll
    for (int a = 0; a < 4; ++a)
#pragma unroll
        for (int b = 0; b < 4; ++b) acc[a][b] = (f32x4){0.f, 0.f, 0.f, 0.f};
    const bf16_t* px[2]; const bf16_t* py[2];
    {
        const int r0 = w * 16 + (lane >> 2), pc = lane & 3;
        const int lc0 = (pc ^ gswz(r0)) * 8;
        px[0] = rowx(r0) + lc0; px[1] = rowx(r0 + 64) + lc0;
        py[0] = rowy(r0) + lc0; py[1] = rowy(r0 + 64) + lc0;
    }
    const int nt = K >> 5;
    RAW_BARRIER();
    if (gvar != 3) {
    gemm_issue(px, py, 0, lds, w);
    gemm_issue(px, py, 32, lds + GSTAGE, w);
    gemm_issue(px, py, 64, lds + 2 * GSTAGE, w);
    }
    for (int j = 0; j < nt; ++j) {
        if (j + 2 < nt) asm volatile("s_waitcnt vmcnt(8)" ::: "memory");
        else if (j + 1 < nt) asm volatile("s_waitcnt vmcnt(4)" ::: "memory");
        else asm volatile("s_waitcnt vmcnt(0)" ::: "memory");
        RAW_BARRIER();
        if (j + 3 < nt && gvar != 3) gemm_issue(px, py, (j + 3) * 32, lds + ((j + 3) & 3) * GSTAGE, w);
        if (gvar != 2) gemm_compute(lds + (j & 3) * GSTAGE, wx, wy, fr, fg, acc);
    }
}
__device__ __forceinline__ void store4_bf16(bf16_t* p, float a, float b, float c, float d) {
    uint2 o; o.x = pk_bf16(a, b); o.y = pk_bf16(c, d); *(uint2*)p = o;
}
template <int NC> __device__ __forceinline__ void ep_put(bf16_t* T, int row, int col, float a, float b, float c, float d) {
    uint2 o; o.x = pk_bf16(a, b); o.y = pk_bf16(c, d); *(uint2*)(T + row * (NC + 8) + col) = o;
}
template <int NC, class FD> __device__ __forceinline__ void ep_flush(const bf16_t* T, int tid, FD dst) {
    constexpr int CPR = NC / 8;
#pragma unroll
    for (int i = 0; i < NC / 16; ++i) {
        const int c = tid + 256 * i; const int row = c / CPR, ch = c % CPR;
        *(u32x4*)(dst(row, ch)) = *(const u32x4*)(T + row * (NC + 8) + ch * 8);
    }
}

__device__ __forceinline__ bool xcd_item(int round, int ntm, int ntn, int& tm, int& tn) {
    const int x = blockIdx.x & 7, loc = blockIdx.x >> 3, nloc = gridDim.x >> 3;
    const int tmx = ntm >> 3;
    const int j = round * nloc + loc;
    if (j >= tmx * ntn) return false;
    tn = j / tmx; tm = (j % tmx) * 8 + x;
    return true;
}

__device__ void phase_inproj(const Params& p, int l, bf16_t* lds, int gvar = 0) {
    const int tid = ltid(), lane = tid & 63, w = tid >> 6, wx = w >> 1, wy = w & 1, fr = lane & 15, fg = lane >> 4;
    const bf16_t* hn = (const bf16_t*)(p.ws + WS_HN);
    const bf16_t* wt = (const bf16_t*)(p.ws + WS_WIN) + (size_t)l * NINP * 1024;
    bf16_t* proj = (bf16_t*)(p.ws + WS_PROJ);
    bf16_t* vtf = (bf16_t*)(p.ws + WS_VTF);
    float* aux = (float*)(p.ws + WS_AUX);
    const float* qg = p.in[3] + l * 64; const float* kg = p.in[4] + l * 64;
    for (int round = 0;; ++round) {
        int tm, tn;
        if (!xcd_item(round, NTOK / 128, NINP / 128, tm, tn)) break;
        const bool vt = (tn >= 6 && tn < 9) || tn == 23 || tn == 24;
        f32x4 acc[4][4];
        {
            auto rw = [&](int r) { return wt + pl_off(tn * 128 + r, 0, 1024); };
            auto rt_ = [&](int r) { return hn + pl_off(tm * 128 + r, 0, 1024); };
            if (vt) gemm_core(rt_, rw, 1024, lds, acc, gvar); else gemm_core(rw, rt_, 1024, lds, acc, gvar);
        }
        if (gvar != 0 && acc[0][0][0] != 123456.789f) continue;
        if (tn == 27) {
#pragma unroll
            for (int n = 0; n < 4; ++n) {
                int t = tm * 128 + wy * 64 + n * 16 + fr;
#pragma unroll
                for (int m = 0; m < 4; ++m) {
                    int c = wx * 64 + m * 16 + 4 * fg;
                    if (c < 64) *(float4*)(aux + (size_t)t * 64 + c) = make_float4(acc[m][n][0], acc[m][n][1], acc[m][n][2], acc[m][n][3]);
                }
            }
            continue;
        }
        RAW_BARRIER();
        if (vt) {
#pragma unroll
            for (int n = 0; n < 4; ++n)
#pragma unroll
                for (int m = 0; m < 4; ++m) ep_put<128>(lds, wy * 64 + n * 16 + fr, wx * 64 + m * 16 + 4 * fg, acc[m][n][0], acc[m][n][1], acc[m][n][2], acc[m][n][3]);
            RAW_BARRIER();
            const bool fox = tn < 9;
            bf16_t* dstb = fox ? vtf : (bf16_t*)(p.ws + WS_SCR + SCR_LVT); const int nh = fox ? H_FOX : H_GLA;
            const int t0 = tm * 128, b = t0 / SEQ, s0 = t0 % SEQ, chb = tn * 128 - (fox ? NC_FV : NC_LV);
            ep_flush<128>(lds, tid, [&](int row, int c8) { const int ch = chb + row; return dstb + ((size_t)(b * nh + (ch >> 6)) * 64 + (ch & 63)) * SEQ + s0 + c8 * 8; });
        } else {
            if (tn < 6) {
                const float* gn = (tn < 3) ? qg : kg; const float sc = (tn < 3) ? 0.125f * 1.4426950408889634f : 1.f;
                float g[4][4];
#pragma unroll
                for (int m = 0; m < 4; ++m)
#pragma unroll
                    for (int r = 0; r < 4; ++r) g[m][r] = gn[m * 16 + 4 * fg + r] * sc;
#pragma unroll
                for (int n = 0; n < 4; ++n) {
                    float ss = 0.f;
#pragma unroll
                    for (int m = 0; m < 4; ++m)
#pragma unroll
                        for (int r = 0; r < 4; ++r) ss += acc[m][n][r] * acc[m][n][r];
                    ss += __shfl_xor(ss, 16, 64); ss += __shfl_xor(ss, 32, 64);
                    float rs = rsqrtf(ss * (1.f / 64.f) + 1e-6f);
#pragma unroll
                    for (int m = 0; m < 4; ++m)
                        ep_put<128>(lds, wy * 64 + n * 16 + fr, wx * 64 + m * 16 + 4 * fg, acc[m][n][0] * rs * g[m][0], acc[m][n][1] * rs * g[m][1], acc[m][n][2] * rs * g[m][2], acc[m][n][3] * rs * g[m][3]);
                }
            } else {
                const bool do_silu = (tn >= 18 && tn < 21) || (tn >= 25);
                const float sc = (tn == 21) ? 0.17677669529663687f : 1.f;
#pragma unroll
                for (int n = 0; n < 4; ++n)
#pragma unroll
                    for (int m = 0; m < 4; ++m) {
                        float v0 = acc[m][n][0] * sc, v1 = acc[m][n][1] * sc, v2 = acc[m][n][2] * sc, v3 = acc[m][n][3] * sc;
                        if (do_silu) { v0 = siluf_(v0); v1 = siluf_(v1); v2 = siluf_(v2); v3 = siluf_(v3); }
                        ep_put<128>(lds, wy * 64 + n * 16 + fr, wx * 64 + m * 16 + 4 * fg, v0, v1, v2, v3);
                    }
            }
            RAW_BARRIER();
            bf16_t* dstb = proj + (size_t)(tm * 128) * NPROJ + tn * 128;
            ep_flush<128>(lds, tid, [&](int row, int c8) { return dstb + (size_t)row * NPROJ + c8 * 8; });
        }
    }
}

__device__ void phase_outproj(const Params& p, int l, bf16_t* lds) {
    const int tid = ltid(), lane = tid & 63, w = tid >> 6, wx = w >> 1, wy = w & 1, fr = lane & 15, fg = lane >> 4;
    const bf16_t* mix = (const bf16_t*)(p.ws + WS_MIX);
    const bf16_t* wt = (const bf16_t*)(p.ws + WS_WOUT) + (size_t)l * 1024 * 1024;
    const float* xin = (l == 0) ? p.in[0] : p.out;
    float* xo = p.out;
    for (int round = 0;; ++round) {
        int tm, tn;
        if (!xcd_item(round, NTOK / 128, 8, tm, tn)) break;
        f32x4 acc[4][4];
        {
            auto rw = [&](int r) { return wt + pl_off(tn * 128 + r, 0, 1024); };
            auto rt_ = [&](int r) { return mix + pl_off(tm * 128 + r, 0, 1024); };
            gemm_core(rw, rt_, 1024, lds, acc);
        }
#pragma unroll
        for (int n = 0; n < 4; ++n) {
            int t = tm * 128 + wy * 64 + n * 16 + fr;
#pragma unroll
            for (int m = 0; m < 4; ++m) {
                int c = tn * 128 + wx * 64 + m * 16 + 4 * fg;
                float4 xv = *(const float4*)(xin + (size_t)t * 1024 + c);
                xv.x += acc[m][n][0]; xv.y += acc[m][n][1]; xv.z += acc[m][n][2]; xv.w += acc[m][n][3];
                *(float4*)(xo + (size_t)t * 1024 + c) = xv;
            }
        }
    }
}

__device__ void phase_route(const Params& p, int l, bf16_t* lds, int dry = 0) {
    const int tid = ltid(), lane = tid & 63, w = tid >> 6, fr = lane & 15, fg = lane >> 4;
    const float* x1 = p.out;
    const float* gain = p.in[15] + l * 1024;
    bf16_t* hn = dry ? (bf16_t*)(p.ws + WS_SCR) : (bf16_t*)(p.ws + WS_HN);
    const bf16_t* wr = (const bf16_t*)(p.ws + WS_WR) + (size_t)l * 64 * 1024;
    const float* brg = p.in[17] + l * 4; const float* bre = p.in[19] + l * 32;
    unsigned* cnt = (unsigned*)(p.ws + WS_CTL) + CW_CNT + l * 32 * CNT_STRIDE;
    int* rowtok = (int*)(p.ws + WS_ROWTOK);
    int* tslot = (int*)(p.ws + WS_TSLOT);
    float* tgate = (float*)(p.ws + WS_TGATE);
    const int HL = 1032;
    float* red = (float*)(lds + 16 * HL);
    for (int it = blockIdx.x; it < NTOK / 16; it += gridDim.x) {
        __syncthreads();
        f32x4 xin4[4][4];
#pragma unroll
        for (int rr = 0; rr < 4; ++rr) {
            const float* xr = x1 + (size_t)(it * 16 + w * 4 + rr) * 1024 + lane * 16;
#pragma unroll
            for (int i = 0; i < 4; ++i) xin4[rr][i] = *(const f32x4*)(xr + 4 * i);
        }
#pragma unroll
        for (int rr = 0; rr < 4; ++rr) {
            int lr = w * 4 + rr; int t = it * 16 + lr;
            float v[16]; float ss = 0.f;
#pragma unroll
            for (int i = 0; i < 4; ++i) { v[4 * i] = xin4[rr][i][0]; v[4 * i + 1] = xin4[rr][i][1]; v[4 * i + 2] = xin4[rr][i][2]; v[4 * i + 3] = xin4[rr][i][3]; }
#pragma unroll
            for (int i = 0; i < 16; ++i) ss += v[i] * v[i];
            ss = wave_sum(ss);
            float r = rsqrtf(ss / D_MODEL + 1e-6f);
#pragma unroll
            for (int i = 0; i < 16; ++i) v[i] = v[i] * r * gain[lane * 16 + i];
            uint4 o0, o1;
            o0.x = pk_bf16(v[0], v[1]); o0.y = pk_bf16(v[2], v[3]); o0.z = pk_bf16(v[4], v[5]); o0.w = pk_bf16(v[6], v[7]);
            o1.x = pk_bf16(v[8], v[9]); o1.y = pk_bf16(v[10], v[11]); o1.z = pk_bf16(v[12], v[13]); o1.w = pk_bf16(v[14], v[15]);
            bf16_t* hr = hn + pl_off(t, lane * 16, 1024);
            *(uint4*)hr = o0; *(uint4*)(hr + 8) = o1;
            *(uint4*)(lds + lr * HL + lane * 16) = o0; *(uint4*)(lds + lr * HL + lane * 16 + 8) = o1;
        }
        __syncthreads();
        f32x4 acc[3];
#pragma unroll
        for (int n = 0; n < 3; ++n) acc[n] = (f32x4){0.f, 0.f, 0.f, 0.f};
#pragma unroll
        for (int ks = 0; ks < 8; ++ks) {
            int k = w * 256 + ks * 32 + fg * 8;
            bf16x8 a = *(const bf16x8*)(lds + fr * HL + k);
#pragma unroll
            for (int n = 0; n < 3; ++n) {
                bf16x8 b = *(const bf16x8*)(wr + (size_t)(n * 16 + fr) * 1024 + k);
                acc[n] = __builtin_amdgcn_mfma_f32_16x16x32_bf16(a, b, acc[n], 0, 0, 0);
            }
        }
#pragma unroll
        for (int n = 0; n < 3; ++n) *(f32x4*)(red + ((w * 3 + n) * 64 + lane) * 4) = acc[n];
        __syncthreads();
        if (tid < 16) {
            float lg[36];
#pragma unroll
            for (int j = 0; j < 36; ++j) {
                int n = j >> 4, f = j & 15; int ln = (tid >> 2) * 16 + f; float s = 0.f;
#pragma unroll
                for (int ww = 0; ww < 4; ++ww) s += red[((ww * 3 + n) * 64 + ln) * 4 + (tid & 3)];
                lg[j] = s;
            }
            float gl[4]; float gm = -1e30f; int gi = 0;
#pragma unroll
            for (int j = 0; j < 4; ++j) { gl[j] = lg[j] + brg[j]; if (gl[j] > gm) { gm = gl[j]; gi = j; } }
            float gs = 0.f;
#pragma unroll
            for (int j = 0; j < 4; ++j) gs += __expf(gl[j] - gm);
            float gp = 1.f / gs;
            float el[8]; float em = -1e30f;
#pragma unroll
            for (int j = 0; j < 8; ++j) {
                float v = (gi == 0) ? lg[4 + j] : (gi == 1) ? lg[12 + j] : (gi == 2) ? lg[20 + j] : lg[28 + j];
                el[j] = v + bre[gi * 8 + j]; em = fmaxf(em, el[j]);
            }
#pragma unroll
            for (int j = 0; j < 8; ++j) el[j] = __expf(el[j] - em);
            float v0 = -1.f, v1 = -1.f; int i0 = 0, i1 = 0;
#pragma unroll
            for (int j = 0; j < 8; ++j) {
                float v = el[j];
                if (v > v0) { v1 = v0; i1 = i0; v0 = v; i0 = j; }
                else if (v > v1) { v1 = v; i1 = j; }
            }
            int t = it * 16 + tid;
            int e0 = gi * 8 + i0, e1 = gi * 8 + i1;
            if (!dry) {
            unsigned s0 = atomicAdd(&cnt[e0 * CNT_STRIDE], 1u), s1 = atomicAdd(&cnt[e1 * CNT_STRIDE], 1u);
            rowtok[(size_t)e0 * NTOK + s0] = t; rowtok[(size_t)e1 * NTOK + s1] = t;
            tslot[t * 2] = (e0 << 16) | (int)s0; tslot[t * 2 + 1] = (e1 << 16) | (int)s1;
            tgate[t * 2] = gp * v0 / (v0 + v1); tgate[t * 2 + 1] = gp * v1 / (v0 + v1);
            } else if (gp * v0 == 123.456f) tgate[0] = v1;
        }
    }
}

__device__ __forceinline__ void moe_tables(const unsigned* cnt, int* tab) {
    if (threadIdx.x == 0) {
        int a = 0;
        for (int e = 0; e < 32; ++e) { tab[e] = a; tab[40 + e] = a * 128; a += ((int)ld_u32_agent(cnt + e * CNT_STRIDE) + 127) >> 7; }
        tab[32] = a; tab[72] = a * 128;
    }
    __syncthreads();
}
template <int MODE>
__device__ void phase_expert(const Params& p, int l, bf16_t* lds) {
    const int tid = ltid(), lane = tid & 63, w = tid >> 6, wx = w >> 1, wy = w & 1, fr = lane & 15, fg = lane >> 4;
    const unsigned* cnt = (const unsigned*)(p.ws + WS_CTL) + CW_CNT + l * 32 * CNT_STRIDE;
    int* tab = (int*)(lds + 4 * GSTAGE);
    moe_tables(cnt, tab);
    const int* rowtok = (const int*)(p.ws + WS_ROWTOK);
    const bf16_t* hn = (const bf16_t*)(p.ws + WS_HN);
    bf16_t* Hb = (bf16_t*)(p.ws + WS_H);
    bf16_t* Yb = (bf16_t*)(p.ws + WS_Y);
    const int x = blockIdx.x & 7, loc = blockIdx.x >> 3, nloc = gridDim.x >> 3;
    for (int j = loc;; j += nloc) {
        int e = -1, rt = 0, tn = 0; int jj = j;
#pragma unroll
        for (int q = 0; q < 4; ++q) {
            int ee = q * 8 + x; int nrt = tab[ee + 1] - tab[ee];
            if (e < 0) { if (jj < nrt * 8) { e = ee; tn = jj / nrt; rt = jj % nrt; } else jj -= nrt * 8; }
        }
        if (e < 0) break;
        const int c_e = (int)ld_u32_agent(cnt + e * CNT_STRIDE); const int hrow0 = tab[40 + e] + rt * 128;
        f32x4 acc[4][4];
        if (MODE == 0) {
            const bf16_t* wbase = (const bf16_t*)(p.ws + WS_WGU) + ((size_t)l * 32 + e) * 1024 * 1024;
            const int* rtk = rowtok + (size_t)e * NTOK + rt * 128; const int nval = c_e - rt * 128;
            auto rw = [&](int r) { return wbase + pl_off(tn * 128 + r, 0, 1024); };
            auto rt_ = [&](int r) { int t = (r < nval) ? rtk[r] : 0; return hn + pl_off(t, 0, 1024); };
            gemm_core(rw, rt_, 1024, lds, acc);
        } else {
            const bf16_t* wbase = (const bf16_t*)(p.ws + WS_WD) + ((size_t)l * 32 + e) * 1024 * 512;
            auto rw = [&](int r) { return wbase + pl_off(tn * 128 + r, 0, 512); };
            auto rt_ = [&](int r) { return Hb + pl_off(hrow0 + r, 0, 512); };
            gemm_core(rw, rt_, 512, lds, acc);
        }
        RAW_BARRIER();
        if (MODE == 0) {
#pragma unroll
            for (int n = 0; n < 4; ++n)
#pragma unroll
                for (int m = 0; m < 2; ++m)
                    ep_put<64>(lds, wy * 64 + n * 16 + fr, wx * 32 + m * 16 + 4 * fg, siluf_(acc[m][n][0]) * acc[m + 2][n][0], siluf_(acc[m][n][1]) * acc[m + 2][n][1],
                               siluf_(acc[m][n][2]) * acc[m + 2][n][2], siluf_(acc[m][n][3]) * acc[m + 2][n][3]);
            RAW_BARRIER();
            ep_flush<64>(lds, tid, [&](int row, int c8) { return Hb + pl_off(hrow0 + row, tn * 64 + c8 * 8, 512); });
        } else {
#pragma unroll
            for (int n = 0; n < 4; ++n)
#pragma unroll
                for (int m = 0; m < 4; ++m) ep_put<128>(lds, wy * 64 + n * 16 + fr, wx * 64 + m * 16 + 4 * fg, acc[m][n][0], acc[m][n][1], acc[m][n][2], acc[m][n][3]);
            RAW_BARRIER();
            bf16_t* dstb = Yb + (size_t)hrow0 * 1024 + tn * 128;
            ep_flush<128>(lds, tid, [&](int row, int c8) { return dstb + (size_t)row * 1024 + c8 * 8; });
        }
    }
}

__device__ void phase_combine(const Params& p, int l, int dry = 0) {
    const int tid = ltid(), lane = tid & 63, w = tid >> 6;
    const unsigned* cnt = (const unsigned*)(p.ws + WS_CTL) + CW_CNT + l * 32 * CNT_STRIDE;
    int c = (lane < 32) ? (((int)ld_u32_agent(cnt + (lane & 31) * CNT_STRIDE) + 127) >> 7) * 128 : 0;
    int incl = c;
#pragma unroll
    for (int o = 1; o < 32; o <<= 1) { int v = __shfl_up(incl, o, 64); if (lane >= o) incl += v; }
    int hoff = incl - c;
    const int* tslot = (const int*)(p.ws + WS_TSLOT);
    const float* tgate = (const float*)(p.ws + WS_TGATE);
    const bf16_t* Yb = (const bf16_t*)(p.ws + WS_Y);
    bf16_t* hn = dry ? (bf16_t*)(p.ws + WS_SCR + (size_t)40 * 1024 * 1024) : (bf16_t*)(p.ws + WS_HN);
    float* x = p.out; float* xw = dry ? (float*)(p.ws + WS_SCR) : p.out;
    const float* gain = (l == 0 || dry) ? p.in[1] + 1024 : nullptr;
    for (int it = blockIdx.x; it < NTOK / 4; it += gridDim.x) {
        int t = it * 4 + w;
        int ts0 = tslot[t * 2], ts1 = tslot[t * 2 + 1];
        float g0 = tgate[t * 2], g1 = tgate[t * 2 + 1];
        int r0 = __shfl(hoff, ts0 >> 16, 64) + (ts0 & 0xffff);
        int r1 = __shfl(hoff, ts1 >> 16, 64) + (ts1 & 0xffff);
        float* xr = x + (size_t)t * 1024 + lane * 16;
        const bf16_t* y0 = Yb + (size_t)r0 * 1024 + lane * 16;
        const bf16_t* y1 = Yb + (size_t)r1 * 1024 + lane * 16;
        float v[16];
#pragma unroll
        for (int i = 0; i < 4; ++i) { float4 q = *(const float4*)(xr + 4 * i); v[4 * i] = q.x; v[4 * i + 1] = q.y; v[4 * i + 2] = q.z; v[4 * i + 3] = q.w; }
        uint4 a0 = *(const uint4*)y0, a1 = *(const uint4*)(y0 + 8), b0 = *(const uint4*)y1, b1 = *(const uint4*)(y1 + 8);
        unsigned ya[8] = {a0.x, a0.y, a0.z, a0.w, a1.x, a1.y, a1.z, a1.w};
        unsigned yb[8] = {b0.x, b0.y, b0.z, b0.w, b1.x, b1.y, b1.z, b1.w};
#pragma unroll
        for (int i = 0; i < 8; ++i) {
            v[2 * i] += g0 * bflo(ya[i]) + g1 * bflo(yb[i]);
            v[2 * i + 1] += g0 * bfhi(ya[i]) + g1 * bfhi(yb[i]);
        }
#ifdef NANMARK
#pragma unroll
        for (int i = 0; i < 16; ++i) if (!(fabsf(v[i]) < 1e30f)) v[i] = 1000.f;
#endif
#pragma unroll
        for (int i = 0; i < 4; ++i) *(float4*)(xw + (size_t)t * 1024 + lane * 16 + 4 * i) = make_float4(v[4 * i], v[4 * i + 1], v[4 * i + 2], v[4 * i + 3]);
        if (gain) {
            float ss = 0.f;
#pragma unroll
            for (int i = 0; i < 16; ++i) ss += v[i] * v[i];
            ss = wave_sum(ss);
            float r = rsqrtf(ss / D_MODEL + 1e-6f);
#pragma unroll
            for (int i = 0; i < 16; ++i) v[i] = v[i] * r * gain[lane * 16 + i];
            uint4 o0, o1;
            o0.x = pk_bf16(v[0], v[1]); o0.y = pk_bf16(v[2], v[3]); o0.z = pk_bf16(v[4], v[5]); o0.w = pk_bf16(v[6], v[7]);
            o1.x = pk_bf16(v[8], v[9]); o1.y = pk_bf16(v[10], v[11]); o1.z = pk_bf16(v[12], v[13]); o1.w = pk_bf16(v[14], v[15]);
            bf16_t* hr = hn + pl_off(t, lane * 16, 1024);
            *(uint4*)hr = o0; *(uint4*)(hr + 8) = o1;
        }
    }
}


__device__ __forceinline__ void mm_row(const bf16_t* RA, const bf16_t* RB, int mw, int fr, int fg, f32x4 (&acc)[4]) {
#pragma unroll
    for (int ks = 0; ks < 2; ++ks) {
        bf16x8 a = *(const bf16x8*)(RA + (16 * mw + fr) * LROW + ks * 32 + fg * 8);
#pragma unroll
        for (int nt = 0; nt < 4; ++nt) {
            bf16x8 b = *(const bf16x8*)(RB + (16 * nt + fr) * LROW + ks * 32 + fg * 8);
            acc[nt] = __builtin_amdgcn_mfma_f32_16x16x32_bf16(a, b, acc[nt], 0, 0, 0);
        }
    }
}
__device__ __forceinline__ void mm_col(const bf16_t* RA, const bf16_t* RB, int nw, int fr, int fg, f32x4 (&acc)[4]) {
#pragma unroll
    for (int ks = 0; ks < 2; ++ks) {
        bf16x8 b = *(const bf16x8*)(RB + (16 * nw + fr) * LROW + ks * 32 + fg * 8);
#pragma unroll
        for (int mt = 0; mt < 4; ++mt) {
            bf16x8 a = *(const bf16x8*)(RA + (16 * mt + fr) * LROW + ks * 32 + fg * 8);
            acc[mt] = __builtin_amdgcn_mfma_f32_16x16x32_bf16(a, b, acc[mt], 0, 0, 0);
        }
    }
}
__device__ __forceinline__ void zero4(f32x4 (&a)[4]) {
#pragma unroll
    for (int i = 0; i < 4; ++i) a[i] = (f32x4){0.f, 0.f, 0.f, 0.f};
}
__device__ __forceinline__ void st4_lds(bf16_t* p, float a, float b, float c, float d) { uint2 o; o.x = pk_bf16(a, b); o.y = pk_bf16(c, d); *(uint2*)p = o; }
__device__ __forceinline__ bf16_t f2bf(float v) { return (bf16_t)(pk_bf16(v, 0.f) & 0xffffu); }

__device__ void gdn_prep_item(const Params& p, int l, int cid, unsigned char* lds_raw) {
    const int tid = ltid(), lane = tid & 63, w = tid >> 6, fr = lane & 15, fg = lane >> 4;
    const int bh = cid >> 6, n = cid & 63, b = bh / H_GDN, h = bh % H_GDN;
    const int t0 = b * SEQ + n * 64;
    bf16_t* L0 = (bf16_t*)lds_raw; bf16_t* L1 = L0 + 64 * LROW; bf16_t* L2 = L1 + 64 * LROW; bf16_t* L3 = L2 + 64 * LROW; bf16_t* L4 = L3 + 64 * LROW; bf16_t* L5 = L4 + 64 * LROW;
    float* dec = (float*)(L5 + 64 * LROW); float* beta = dec + 64;
    const bf16_t* proj = (const bf16_t*)(p.ws + WS_PROJ);
    const float* aux = (const float*)(p.ws + WS_AUX);
    const float* convw = p.in[7] + (size_t)l * 4 * 1152;
    __syncthreads();
    const int i = tid >> 2, c0 = (tid & 3) * 16;
    float qv[16], kv[16], vv[16];
#pragma unroll
    for (int which = 0; which < 3; ++which) {
        float acc[16];
#pragma unroll
        for (int c = 0; c < 16; ++c) acc[c] = 0.f;
#pragma unroll
        for (int tap = 0; tap < 4; ++tap) {
            const int row = i - 3 + tap;
            if (n * 64 + row >= 0) {
                const bf16_t* xp = proj + (size_t)(t0 + row) * NPROJ + NC_GQ + which * 384 + h * 64 + c0;
                u32x4 x0 = *(const u32x4*)xp, x1 = *(const u32x4*)(xp + 8);
                const float* wp = convw + tap * 1152 + which * 384 + h * 64 + c0;
                f32x4 w0 = *(const f32x4*)wp, w1 = *(const f32x4*)(wp + 4), w2 = *(const f32x4*)(wp + 8), w3 = *(const f32x4*)(wp + 12);
                float wv[16] = {w0[0], w0[1], w0[2], w0[3], w1[0], w1[1], w1[2], w1[3], w2[0], w2[1], w2[2], w2[3], w3[0], w3[1], w3[2], w3[3]};
                unsigned xs[8] = {x0[0], x0[1], x0[2], x0[3], x1[0], x1[1], x1[2], x1[3]};
#pragma unroll
                for (int c = 0; c < 8; ++c) { acc[2 * c] += wv[2 * c] * bflo(xs[c]); acc[2 * c + 1] += wv[2 * c + 1] * bfhi(xs[c]); }
            }
        }
        float ss = 0.f;
#pragma unroll
        for (int c = 0; c < 16; ++c) { acc[c] = siluf_(acc[c]); ss += acc[c] * acc[c]; }
        if (which < 2) {
            ss += __shfl_xor(ss, 1, 64); ss += __shfl_xor(ss, 2, 64);
            const float sc = rsqrtf(ss + 1e-6f) * (which == 0 ? 0.125f : 1.f);
#pragma unroll
            for (int c = 0; c < 16; ++c) acc[c] *= sc;
        }
#pragma unroll
        for (int c = 0; c < 16; ++c) { if (which == 0) qv[c] = acc[c]; else if (which == 1) kv[c] = acc[c]; else vv[c] = acc[c]; }
    }
#pragma unroll
    for (int c = 0; c < 16; c += 4) { st4_lds(L2 + i * LROW + c0 + c, kv[c], kv[c + 1], kv[c + 2], kv[c + 3]); st4_lds(L3 + i * LROW + c0 + c, qv[c], qv[c + 1], qv[c + 2], qv[c + 3]); }
    if (w == 0) {
        const float a = aux[(size_t)(t0 + lane) * 64 + AX_GA + h], bl = aux[(size_t)(t0 + lane) * 64 + AX_GB + h];
        const float g = -__expf(p.in[8][l * H_GDN + h]) * softplusf_(a + p.in[9][l * H_GDN + h]);
        float inc = g;
#pragma unroll
        for (int o = 1; o < 64; o <<= 1) { float t = __shfl_up(inc, o, 64); if (lane >= o) inc += t; }
        dec[lane] = inc; beta[lane] = sigmoidf_(bl);
    }
    __syncthreads();
    {
        f32x4 g4[4]; zero4(g4);
        mm_row(L2, L2, w, fr, fg, g4);
#pragma unroll
        for (int nt = 0; nt < 4; ++nt) {
            const int kap = 16 * nt + fr; const float dk_ = dec[kap], bk_ = beta[kap];
            float nT[4], nN[4], tt[4];
#pragma unroll
            for (int r = 0; r < 4; ++r) {
                const int rho = 16 * w + 4 * fg + r; const float dr_ = dec[rho], br_ = beta[rho];
                const float G = g4[nt][r];
                nT[r] = (kap < rho) ? br_ * G * __expf(dr_ - dk_) : 0.f;
                nN[r] = (rho < kap) ? bk_ * G * __expf(dk_ - dr_) : 0.f;
                tt[r] = ((kap == rho) ? 1.f : 0.f) - nN[r];
            }
            st4_lds(L1 + kap * LROW + 16 * w + 4 * fg, nT[0], nT[1], nT[2], nT[3]);
            st4_lds(L0 + kap * LROW + 16 * w + 4 * fg, nN[0], nN[1], nN[2], nN[3]);
            st4_lds(L4 + kap * LROW + 16 * w + 4 * fg, tt[0], tt[1], tt[2], tt[3]);
        }
        f32x4 a4[4]; zero4(a4);
        mm_row(L2, L3, w, fr, fg, a4);
#pragma unroll
        for (int nt = 0; nt < 4; ++nt) {
            const int ii = 16 * nt + fr; const float di_ = dec[ii];
            float v4[4];
#pragma unroll
            for (int r = 0; r < 4; ++r) { const int j = 16 * w + 4 * fg + r; v4[r] = (j <= ii) ? a4[nt][r] * __expf(di_ - dec[j]) : 0.f; }
            st4_lds(L5 + ii * LROW + 16 * w + 4 * fg, v4[0], v4[1], v4[2], v4[3]);
        }
    }
    __syncthreads();
#pragma unroll
    for (int lev = 1; lev <= 5; ++lev) {
        const bf16_t* XA = (lev & 1) ? L0 : L2; const bf16_t* XAt = (lev & 1) ? L1 : L3;
        bf16_t* XB = (lev & 1) ? L2 : L0; bf16_t* XBt = (lev & 1) ? L3 : L1;
        {
            f32x4 x4[4]; zero4(x4);
            mm_row(XA, XAt, w, fr, fg, x4);
#pragma unroll
            for (int nt = 0; nt < 4; ++nt) {
                const int c = 16 * nt + fr;
                st4_lds(XBt + c * LROW + 16 * w + 4 * fg, x4[nt][0], x4[nt][1], x4[nt][2], x4[nt][3]);
                if (lev < 5) {
#pragma unroll
                    for (int r = 0; r < 4; ++r) XB[(16 * w + 4 * fg + r) * LROW + c] = f2bf(x4[nt][r]);
                }
            }
        }
        __syncthreads();
        {
            f32x4 t4[4];
#pragma unroll
            for (int mt = 0; mt < 4; ++mt) {
                uint2 u = *(const uint2*)(L4 + (16 * w + fr) * LROW + 16 * mt + 4 * fg);
                t4[mt] = (f32x4){bflo(u.x), bfhi(u.x), bflo(u.y), bfhi(u.y)};
            }
            mm_col(XBt, L4, w, fr, fg, t4);
#pragma unroll
            for (int mt = 0; mt < 4; ++mt) st4_lds(L4 + (16 * w + fr) * LROW + 16 * mt + 4 * fg, t4[mt][0], t4[mt][1], t4[mt][2], t4[mt][3]);
        }
    }
    {
        const float dj = dec[i], bj = beta[i], dlast = dec[63];
        const float s1 = bj * __expf(dj), s2 = bj, s3 = __expf(dlast - dj);
#pragma unroll
        for (int c = 0; c < 16; ++c) {
            L0[(c0 + c) * LROW + i] = f2bf(kv[c] * s1);
            L1[(c0 + c) * LROW + i] = f2bf(vv[c] * s2);
            L2[(c0 + c) * LROW + i] = f2bf(kv[c] * s3);
        }
    }
    __syncthreads();
    {
        f32x4 w4[4], u4[4]; zero4(w4); zero4(u4);
        mm_row(L4, L0, w, fr, fg, w4);
        mm_row(L4, L1, w, fr, fg, u4);
        __syncthreads();
#pragma unroll
        for (int nt = 0; nt < 4; ++nt) {
            st4_lds(L0 + (16 * nt + fr) * LROW + 16 * w + 4 * fg, w4[nt][0], w4[nt][1], w4[nt][2], w4[nt][3]);
            st4_lds(L1 + (16 * nt + fr) * LROW + 16 * w + 4 * fg, u4[nt][0], u4[nt][1], u4[nt][2], u4[nt][3]);
        }
        const float ed = __expf(dec[i]);
#pragma unroll
        for (int c = 0; c < 16; c += 4) st4_lds(L3 + i * LROW + c0 + c, qv[c] * ed, qv[c + 1] * ed, qv[c + 2] * ed, qv[c + 3] * ed);
    }
    __syncthreads();
    char* scr = p.ws + WS_SCR;
    {
        f32x4 m4[4]; zero4(m4);
        mm_row(L0, L2, w, fr, fg, m4);
        bf16_t* MP = (bf16_t*)(scr + SCR_GDN_MP) + (size_t)cid * 4096;
#pragma unroll
        for (int nt = 0; nt < 4; ++nt) store4_bf16(MP + (16 * nt + fr) * 64 + 16 * w + 4 * fg, -m4[nt][0], -m4[nt][1], -m4[nt][2], -m4[nt][3]);
        f32x4 n4[4]; zero4(n4);
        mm_row(L2, L1, w, fr, fg, n4);
        bf16_t* NN = (bf16_t*)(scr + SCR_GDN_NN) + (size_t)cid * 4096;
#pragma unroll
        for (int nt = 0; nt < 4; ++nt) store4_bf16(NN + ((nt * 4 + w) * 64 + lane) * 4, n4[nt][0], n4[nt][1], n4[nt][2], n4[nt][3]);
        f32x4 p4[4]; zero4(p4);
        mm_row(L0, L5, w, fr, fg, p4);
        bf16_t* PG = (bf16_t*)(scr + SCR_GDN_P) + (size_t)cid * 4096;
#pragma unroll
        for (int nt = 0; nt < 4; ++nt) {
            uint2 u = *(const uint2*)(L3 + (16 * nt + fr) * LROW + 16 * w + 4 * fg);
            store4_bf16(PG + (16 * nt + fr) * 64 + 16 * w + 4 * fg, bflo(u.x) - p4[nt][0], bfhi(u.x) - p4[nt][1], bflo(u.y) - p4[nt][2], bfhi(u.y) - p4[nt][3]);
        }
        f32x4 o4[4]; zero4(o4);
        mm_row(L1, L5, w, fr, fg, o4);
        bf16_t* OL = (bf16_t*)(scr + SCR_GDN_OL) + (size_t)cid * 4096;
#pragma unroll
        for (int nt = 0; nt < 4; ++nt) store4_bf16(OL + (16 * nt + fr) * 64 + 16 * w + 4 * fg, o4[nt][0], o4[nt][1], o4[nt][2], o4[nt][3]);
        if (tid == 0) ((float*)(scr + SCR_GDN_LAST))[cid] = __expf(dec[63]);
    }
}

#define SCAN_SLOT    5120
#define SCAN_SB(k)   ((bf16_t*)lds_raw + (k) * 1024)
#define SCAN_RING(k) ((bf16_t*)lds_raw + 2048 + (k) * SCAN_SLOT)
#define SCAN_LAST    ((float*)(lds_raw + 4096 + 5 * SCAN_SLOT * 2))
__device__ __forceinline__ void scan_issue(const bf16_t* const (&mp)[8], const bf16_t* nn_lane, int n, bf16_t* slot) {
#pragma unroll
    for (int q = 0; q < 8; ++q) __builtin_amdgcn_global_load_lds((const unsigned*)(mp[q] + (size_t)n * 4096), (unsigned*)(slot + q * 512), 16, 0, 0);
    __builtin_amdgcn_global_load_lds((const unsigned*)(nn_lane + (size_t)n * 4096), (unsigned*)(slot + 4096), 16, 0, 0);
    __builtin_amdgcn_global_load_lds((const unsigned*)(nn_lane + (size_t)n * 4096 + 512), (unsigned*)(slot + 4096 + 512), 16, 0, 0);
}
__device__ void gdn_scan_item(const Params& p, int item, unsigned char* lds_raw, int svar = 0) {
    const int tid = ltid(), lane = tid & 63, w = __builtin_amdgcn_readfirstlane(tid >> 6), fr = lane & 15, fg = lane >> 4;
    const int bh = item >> 2, cg = item & 3;
    char* scr = p.ws + WS_SCR;
    const bf16_t* MP = (const bf16_t*)(scr + SCR_GDN_MP) + (size_t)bh * 64 * 4096;
    const bf16_t* NN = (const bf16_t*)(scr + SCR_GDN_NN) + (size_t)bh * 64 * 4096 + cg * 1024;
    const float* LAST = (const float*)(scr + SCR_GDN_LAST) + bh * 64;
    bf16_t* SG = (bf16_t*)(scr + SCR_GDN_SG) + (size_t)bh * 64 * 4096 + cg * 1024;
    const bf16_t* mp[8];
#pragma unroll
    for (int q = 0; q < 8; ++q) { const int row = 8 * q + (lane >> 3); mp[q] = MP + row * 64 + (((lane & 7) ^ ((row >> 1) & 7)) * 8); }
    const bf16_t* nn_lane = NN + lane * 8;
    RAW_BARRIER();
    if (tid < 64) SCAN_LAST[tid] = ld_f32_agent(LAST + tid);
    asm volatile("s_waitcnt vmcnt(0)" ::: "memory");
    f32x4 S = (f32x4){0.f, 0.f, 0.f, 0.f};
    const int swz = (fr >> 1) & 7;
    if (w == 0) {
#pragma unroll
        for (int n = 0; n < 4; ++n) scan_issue(mp, nn_lane, n, SCAN_RING(n));
    }
    for (int n = 0; n < 64; ++n) {
        bf16_t* sb = SCAN_SB(n & 1);
        const bf16_t* ring = SCAN_RING(n % 5);
        {
            const int c = 2 * w + (fg >> 1);
            uint2 o; o.x = pk_bf16(S[0], S[1]); o.y = pk_bf16(S[2], S[3]);
            *(uint2*)(sb + fr * 64 + ((c ^ swz) * 8) + 4 * (fg & 1)) = o;
        }
        if (w == 0) {
            if (n + 3 < 64) asm volatile("s_waitcnt vmcnt(30)" ::: "memory");
            else if (n + 2 < 64) asm volatile("s_waitcnt vmcnt(20)" ::: "memory");
            else if (n + 1 < 64) asm volatile("s_waitcnt vmcnt(10)" ::: "memory");
            else asm volatile("s_waitcnt vmcnt(0)" ::: "memory");
        }
        RAW_BARRIER();
        if (w == 0 && n + 4 < 64 && svar != 2) scan_issue(mp, nn_lane, n + 4, SCAN_RING((n + 4) % 5));
        const float last = SCAN_LAST[n];
        {
            u32x2 nn = *(const u32x2*)(ring + 4096 + (w * 64 + lane) * 4);
            S[0] = last * S[0] + bflo(nn[0]); S[1] = last * S[1] + bfhi(nn[0]);
            S[2] = last * S[2] + bflo(nn[1]); S[3] = last * S[3] + bfhi(nn[1]);
        }
#pragma unroll
        for (int ks = 0; ks < 2; ++ks) {
            const int co = ((ks * 4 + fg) ^ swz) * 8;
            bf16x8 a = *(const bf16x8*)(ring + (16 * w + fr) * 64 + co);
            bf16x8 s = *(const bf16x8*)(sb + fr * 64 + co);
            S = __builtin_amdgcn_mfma_f32_16x16x32_bf16(a, s, S, 0, 0, 0);
        }
        if (w >= 2 && svar != 1) {
            const int c = (w - 2) * 64 + lane; const int row = c >> 3, pc = c & 7;
            u32x4 v = *(const u32x4*)(sb + row * 64 + pc * 8);
            *(u32x4*)(SG + (size_t)n * 4096 + row * 64 + ((pc ^ ((row >> 1) & 7)) * 8)) = v;
        }
    }
}

__device__ void gdn_out_item(const Params& p, int l, int cid) {
    const int tid = ltid(), lane = tid & 63, w = tid >> 6, fr = lane & 15, fg = lane >> 4;
    const int bh = cid >> 6, n = cid & 63, b = bh / H_GDN, h = bh % H_GDN;
    char* scr = p.ws + WS_SCR;
    const bf16_t* SG = (const bf16_t*)(scr + SCR_GDN_SG) + (size_t)cid * 4096;
    const bf16_t* PG = (const bf16_t*)(scr + SCR_GDN_P) + (size_t)cid * 4096;
    const bf16_t* OL = (const bf16_t*)(scr + SCR_GDN_OL) + (size_t)cid * 4096;
    const int i = 16 * w + fr; const int t = b * SEQ + n * 64 + i;
    f32x4 acc[4];
#pragma unroll
    for (int mt = 0; mt < 4; ++mt) { uint2 u = *(const uint2*)(OL + i * 64 + 16 * mt + 4 * fg); acc[mt] = (f32x4){bflo(u.x), bfhi(u.x), bflo(u.y), bfhi(u.y)}; }
#pragma unroll
    for (int ks = 0; ks < 2; ++ks) {
        bf16x8 bq = *(const bf16x8*)(PG + i * 64 + ks * 32 + fg * 8);
#pragma unroll
        for (int mt = 0; mt < 4; ++mt) {
            bf16x8 a = *(const bf16x8*)(SG + (16 * mt + fr) * 64 + ks * 32 + fg * 8);
            acc[mt] = __builtin_amdgcn_mfma_f32_16x16x32_bf16(a, bq, acc[mt], 0, 0, 0);
        }
    }
    float ss = 0.f;
#pragma unroll
    for (int mt = 0; mt < 4; ++mt)
#pragma unroll
        for (int r = 0; r < 4; ++r) ss += acc[mt][r] * acc[mt][r];
    ss += __shfl_xor(ss, 16, 64); ss += __shfl_xor(ss, 32, 64);
    const float rstd = rsqrtf(ss * (1.f / 64.f) + 1e-6f);
    const float* og = p.in[10] + l * 64;
    const bf16_t* gp = (const bf16_t*)(p.ws + WS_PROJ) + (size_t)t * NPROJ + NC_GG + h * 64;
    bf16_t* mp = (bf16_t*)(p.ws + WS_MIX) + pl_off(t, 384 + h * 64, 1024);
#pragma unroll
    for (int mt = 0; mt < 4; ++mt) {
        const int e0 = 16 * mt + 4 * fg;
        uint2 gu = *(const uint2*)(gp + e0); f32x4 g4 = *(const f32x4*)(og + e0);
        store4_bf16(mp + e0 + (e0 & 32), acc[mt][0] * rstd * g4[0] * bflo(gu.x), acc[mt][1] * rstd * g4[1] * bfhi(gu.x), acc[mt][2] * rstd * g4[2] * bflo(gu.y), acc[mt][3] * rstd * g4[3] * bfhi(gu.y));
    }
}

#define GQROW 40
__device__ void gla_prep_item(const Params& p, int l, int cid, unsigned char* lds_raw) {
    const int tid = ltid(), lane = tid & 63, w = tid >> 6, fr = lane & 15, fg = lane >> 4;
    const int bh = cid >> 6, n = cid & 63, b = bh / H_GLA, h = bh % H_GLA;
    const int t0 = b * SEQ + n * 64;
    float* Bf = (float*)lds_raw;
    bf16_t* Qt = (bf16_t*)(lds_raw + 8448);
    bf16_t* Kt = Qt + 64 * GQROW;
    bf16_t* KLt = Kt + 64 * GQROW;
    bf16_t* Vt = KLt + 32 * LROW;
    const bf16_t* proj = (const bf16_t*)(p.ws + WS_PROJ);
    const float* aux = (const float*)(p.ws + WS_AUX);
    char* scr = p.ws + WS_SCR;
    __syncthreads();
    const int i = tid >> 2, d0 = (tid & 3) * 8;
    {
        const float* wa = p.in[11] + (size_t)l * 16 * 128 + h * 32 + d0;
        const float* ba = p.in[12] + l * 128 + h * 32 + d0;
        float acc[8];
#pragma unroll
        for (int j = 0; j < 8; ++j) acc[j] = ba[j];
        float a1v[16];
#pragma unroll
        for (int r = 0; r < 16; r += 2) { float2 t2 = *(const float2*)(aux + (size_t)(t0 + i) * 64 + AX_LA + r); a1v[r] = t2.x; a1v[r + 1] = t2.y; }
#pragma unroll
        for (int r = 0; r < 16; ++r) {
            f32x4 wA = *(const f32x4*)(wa + r * 128), wB = *(const f32x4*)(wa + r * 128 + 4);
#pragma unroll
            for (int j = 0; j < 4; ++j) { acc[j] += a1v[r] * wA[j]; acc[4 + j] += a1v[r] * wB[j]; }
        }
#pragma unroll
        for (int j = 0; j < 8; ++j) Bf[i * 33 + d0 + j] = logsigmoidf_(acc[j]) * (1.f / 16.f);
    }
    {
        const bf16_t* lvt = (const bf16_t*)(scr + SCR_LVT) + (size_t)bh * 64 * SEQ + n * 64;
#pragma unroll
        for (int ii = 0; ii < 2; ++ii) { int c = tid + 256 * ii; int row = c >> 3, kc = c & 7; *(u32x4*)(Vt + row * LROW + kc * 8) = *(const u32x4*)(lvt + (size_t)row * SEQ + kc * 8); }
    }
    __syncthreads();
#pragma unroll
    for (int c = 0; c < 8; ++c) {
        const int d = 8 * w + c;
        float inc = Bf[lane * 33 + d];
#pragma unroll
        for (int o = 1; o < 64; o <<= 1) { float t = __shfl_up(inc, o, 64); if (lane >= o) inc += t; }
        Bf[lane * 33 + d] = inc;
    }
    __syncthreads();
    {
        const bf16_t* qp = proj + (size_t)(t0 + i) * NPROJ + NC_LQ + h * 32 + d0;
        const bf16_t* kp = proj + (size_t)(t0 + i) * NPROJ + NC_LK + h * 32 + d0;
        u32x4 qu = *(const u32x4*)qp, ku = *(const u32x4*)kp;
        float qf[8] = {bflo(qu[0]), bfhi(qu[0]), bflo(qu[1]), bfhi(qu[1]), bflo(qu[2]), bfhi(qu[2]), bflo(qu[3]), bfhi(qu[3])};
        float kf[8] = {bflo(ku[0]), bfhi(ku[0]), bflo(ku[1]), bfhi(ku[1]), bflo(ku[2]), bfhi(ku[2]), bflo(ku[3]), bfhi(ku[3])};
        float qt[8], kt[8], qb[8];
#pragma unroll
        for (int j = 0; j < 8; ++j) {
            const float bi = Bf[i * 33 + d0 + j], bm = Bf[31 * 33 + d0 + j], bl = Bf[63 * 33 + d0 + j];
            qt[j] = qf[j] * __expf(bi - bm); kt[j] = kf[j] * __expf(bm - bi); qb[j] = qf[j] * __expf(bi);
            KLt[(d0 + j) * LROW + i] = f2bf(kf[j] * __expf(bl - bi));
            if (i == 63) ((float*)(scr + SCR_GLA_DL))[cid * 32 + d0 + j] = __expf(bl);
        }
        u32x4 o; o[0] = pk_bf16(qt[0], qt[1]); o[1] = pk_bf16(qt[2], qt[3]); o[2] = pk_bf16(qt[4], qt[5]); o[3] = pk_bf16(qt[6], qt[7]);
        *(u32x4*)(Qt + i * GQROW + d0) = o;
        o[0] = pk_bf16(kt[0], kt[1]); o[1] = pk_bf16(kt[2], kt[3]); o[2] = pk_bf16(kt[4], kt[5]); o[3] = pk_bf16(kt[6], kt[7]);
        *(u32x4*)(Kt + i * GQROW + d0) = o;
        o[0] = pk_bf16(qb[0], qb[1]); o[1] = pk_bf16(qb[2], qb[3]); o[2] = pk_bf16(qb[4], qb[5]); o[3] = pk_bf16(qb[6], qb[7]);
        *(u32x4*)((bf16_t*)(scr + SCR_GLA_QB) + (size_t)cid * 2048 + i * 32 + d0) = o;
    }
    __syncthreads();
    f32x4 sc[4];
    {
        bf16x8 bq = *(const bf16x8*)(Qt + (16 * w + fr) * GQROW + fg * 8);
#pragma unroll
        for (int mt = 0; mt < 4; ++mt) {
            bf16x8 a = *(const bf16x8*)(Kt + (16 * mt + fr) * GQROW + fg * 8);
            sc[mt] = __builtin_amdgcn_mfma_f32_16x16x32_bf16(a, bq, (f32x4){0.f, 0.f, 0.f, 0.f}, 0, 0, 0);
        }
        const int ii = 16 * w + fr;
#pragma unroll
        for (int mt = 0; mt < 4; ++mt)
#pragma unroll
            for (int r = 0; r < 4; ++r) { const int j = 16 * mt + 4 * fg + r; if (j > ii) sc[mt][r] = 0.f; }
    }
    {
        f32x4 o4[4]; zero4(o4);
#pragma unroll
        for (int kk = 0; kk < 2; ++kk) {
            u32x4 pb = {pk_bf16(sc[2 * kk][0], sc[2 * kk][1]), pk_bf16(sc[2 * kk][2], sc[2 * kk][3]), pk_bf16(sc[2 * kk + 1][0], sc[2 * kk + 1][1]), pk_bf16(sc[2 * kk + 1][2], sc[2 * kk + 1][3])};
#pragma unroll
            for (int mt = 0; mt < 4; ++mt) {
                uint2 v0 = *(const uint2*)(Vt + (16 * mt + fr) * LROW + 32 * kk + 4 * fg), v1 = *(const uint2*)(Vt + (16 * mt + fr) * LROW + 32 * kk + 16 + 4 * fg);
                u32x4 va = {v0.x, v0.y, v1.x, v1.y};
                o4[mt] = __builtin_amdgcn_mfma_f32_16x16x32_bf16(__builtin_bit_cast(bf16x8, va), __builtin_bit_cast(bf16x8, pb), o4[mt], 0, 0, 0);
            }
        }
        bf16_t* OL = (bf16_t*)(scr + SCR_GLA_OL) + (size_t)cid * 4096;
#pragma unroll
        for (int mt = 0; mt < 4; ++mt) store4_bf16(OL + (16 * w + fr) * 64 + 16 * mt + 4 * fg, o4[mt][0], o4[mt][1], o4[mt][2], o4[mt][3]);
    }
    {
        f32x4 k4[2] = {(f32x4){0.f, 0.f, 0.f, 0.f}, (f32x4){0.f, 0.f, 0.f, 0.f}};
#pragma unroll
        for (int ks = 0; ks < 2; ++ks) {
            bf16x8 bv = *(const bf16x8*)(Vt + (16 * w + fr) * LROW + ks * 32 + fg * 8);
#pragma unroll
            for (int mt = 0; mt < 2; ++mt) {
                bf16x8 a = *(const bf16x8*)(KLt + (16 * mt + fr) * LROW + ks * 32 + fg * 8);
                k4[mt] = __builtin_amdgcn_mfma_f32_16x16x32_bf16(a, bv, k4[mt], 0, 0, 0);
            }
        }
        float* KV = (float*)(scr + SCR_GLA_KV) + (size_t)cid * 2048;
#pragma unroll
        for (int mt = 0; mt < 2; ++mt) *(f32x4*)(KV + (16 * w + fr) * 32 + 16 * mt + 4 * fg) = k4[mt];
    }
}
__device__ void gla_scan_item(const Params& p, int g) {
    const int tid = ltid();
    const int bh = g >> 3, idx = (g & 7) * 256 + tid, d = idx & 31;
    char* scr = p.ws + WS_SCR;
    const float* __restrict__ KV = (const float*)(scr + SCR_GLA_KV) + (size_t)bh * 64 * 2048 + idx;
    const float* __restrict__ DL = (const float*)(scr + SCR_GLA_DL) + bh * 64 * 32 + d;
    bf16_t* __restrict__ SG = (bf16_t*)(scr + SCR_GLA_SG) + (size_t)bh * 64 * 2048 + idx;
    float S = 0.f;
    for (int n0 = 0; n0 < 64; n0 += 8) {
        float kv[8], dl[8];
#pragma unroll
        for (int u = 0; u < 8; ++u) { kv[u] = KV[(size_t)(n0 + u) * 2048]; dl[u] = DL[(n0 + u) * 32]; }
#pragma unroll
        for (int u = 0; u < 8; ++u) { SG[(size_t)(n0 + u) * 2048] = f2bf(S); S = dl[u] * S + kv[u]; }
    }
}
__device__ void gla_out_item(const Params& p, int l, int cid) {
    const int tid = ltid(), lane = tid & 63, w = tid >> 6, fr = lane & 15, fg = lane >> 4;
    const int bh = cid >> 6, n = cid & 63, b = bh / H_GLA, h = bh % H_GLA;
    char* scr = p.ws + WS_SCR;
    const bf16_t* SG = (const bf16_t*)(scr + SCR_GLA_SG) + (size_t)cid * 2048;
    const bf16_t* QB = (const bf16_t*)(scr + SCR_GLA_QB) + (size_t)cid * 2048;
    const bf16_t* OL = (const bf16_t*)(scr + SCR_GLA_OL) + (size_t)cid * 4096;
    const int i = 16 * w + fr; const int t = b * SEQ + n * 64 + i;
    f32x4 acc[4];
#pragma unroll
    for (int mt = 0; mt < 4; ++mt) { uint2 u = *(const uint2*)(OL + i * 64 + 16 * mt + 4 * fg); acc[mt] = (f32x4){bflo(u.x), bfhi(u.x), bflo(u.y), bfhi(u.y)}; }
    bf16x8 bq = *(const bf16x8*)(QB + i * 32 + fg * 8);
#pragma unroll
    for (int mt = 0; mt < 4; ++mt) {
        bf16x8 a = *(const bf16x8*)(SG + (16 * mt + fr) * 32 + fg * 8);
        acc[mt] = __builtin_amdgcn_mfma_f32_16x16x32_bf16(a, bq, acc[mt], 0, 0, 0);
    }
    float ss = 0.f;
#pragma unroll
    for (int mt = 0; mt < 4; ++mt)
#pragma unroll
        for (int r = 0; r < 4; ++r) ss += acc[mt][r] * acc[mt][r];
    ss += __shfl_xor(ss, 16, 64); ss += __shfl_xor(ss, 32, 64);
    const float rstd = rsqrtf(ss * (1.f / 64.f) + 1e-6f);
    const float* og = p.in[13] + l * 64;
    const bf16_t* rp = (const bf16_t*)(p.ws + WS_PROJ) + (size_t)t * NPROJ + NC_LR + h * 64;
    bf16_t* mp = (bf16_t*)(p.ws + WS_MIX) + pl_off(t, 768 + h * 64, 1024);
#pragma unroll
    for (int mt = 0; mt < 4; ++mt) {
        const int e0 = 16 * mt + 4 * fg;
        uint2 gu = *(const uint2*)(rp + e0); f32x4 g4 = *(const f32x4*)(og + e0);
        store4_bf16(mp + e0 + (e0 & 32), acc[mt][0] * rstd * g4[0] * bflo(gu.x), acc[mt][1] * rstd * g4[1] * bfhi(gu.x), acc[mt][2] * rstd * g4[2] * bflo(gu.y), acc[mt][3] * rstd * g4[3] * bfhi(gu.y));
    }
}
__device__ void phase_mixout(const Params& p, int l) {
    for (int it = blockIdx.x; it < NGDN_CH + NGLA_CH; it += gridDim.x) {
        if (it < NGDN_CH) { if (MIXSEL & 1) gdn_out_item(p, l, it); } else { if (MIXSEL & 2) gla_out_item(p, l, it - NGDN_CH); }
    }
}

__device__ void fox_cumsum_item(const Params& p, int l, int bh, float* ldsf) {
    const int tid = ltid(), lane = tid & 63, w = tid >> 6;
    const int b = bh / H_FOX, h = bh % H_FOX;
    const float* aux = (const float*)(p.ws + WS_AUX);
    float* cum = (float*)(p.ws + WS_CUM) + (size_t)bh * SEQ;
    const float fb = p.in[5][l * H_FOX + h];
    float v[16]; float s = 0.f;
#pragma unroll
    for (int i = 0; i < 16; ++i) { v[i] = logsigmoidf_(aux[(size_t)(b * SEQ + tid * 16 + i) * 64 + AX_FF + h] + fb); s += v[i]; }
    float inc = s;
#pragma unroll
    for (int o = 1; o < 64; o <<= 1) { float t = __shfl_up(inc, o, 64); if (lane >= o) inc += t; }
    __syncthreads();
    if (lane == 63) ldsf[w] = inc;
    __syncthreads();
    float base = inc - s;
    for (int ww = 0; ww < w; ++ww) base += ldsf[ww];
    float c = base;
    u32x4* csx = (u32x4*)(p.ws + WS_SCR + SCR_CSX) + (size_t)bh * SEQ;
#pragma unroll
    for (int i = 0; i < 16; ++i) {
        c += v[i]; cum[tid * 16 + i] = c;
        const float vv = 1.4426950408889634f * c;
        const unsigned hi = pk_bf16(vv, 0.f) & 0xffffu; const float r1 = vv - __uint_as_float(hi << 16);
        const unsigned mid = pk_bf16(r1, 0.f) & 0xffffu; const float r2 = r1 - __uint_as_float(mid << 16);
        const unsigned lo = pk_bf16(r2, 0.f) & 0xffffu;
        u32x4 f; f[0] = 0x3F803F80u; f[1] = 0x3F80u | ((hi ^ 0x8000u) << 16); f[2] = (mid ^ 0x8000u) | ((lo ^ 0x8000u) << 16); f[3] = 0u;
        csx[tid * 16 + i] = f;
    }
}
__device__ void phase_prep(const Params& p, int l, unsigned char* lds_raw) {
    const int n0 = BATCH * H_FOX, n1 = n0 + ((MIXSEL & 1) ? NGDN_CH : 0), n2 = n1 + ((MIXSEL & 2) ? NGLA_CH : 0);
    for (int it = blockIdx.x; it < n2; it += gridDim.x) {
        if (it < n0) { __syncthreads(); fox_cumsum_item(p, l, it, (float*)lds_raw); }
        else if (it < n1) gdn_prep_item(p, l, it - n0, lds_raw);
        else gla_prep_item(p, l, it - n1, lds_raw);
    }
}

typedef float f32x16 __attribute__((ext_vector_type(16)));
#define ATT_BUF 17408
#define ATT_THR 8.0f
#define ATT_NSTAGE 3
__device__ __forceinline__ void attn_issue(const bf16_t* const (&kp)[2], const bf16_t* const (&vp)[2], const bf16_t* cp, int s0, unsigned char* stage, int w) {
    bf16_t* Ks = (bf16_t*)stage; bf16_t* Vs = Ks + 4096; bf16_t* cs = Vs + 4096;
    __builtin_amdgcn_global_load_lds((const unsigned*)(kp[0] + (size_t)s0 * NPROJ), (unsigned*)(Ks + (w * 8) * 64), 16, 0, 0);
    __builtin_amdgcn_global_load_lds((const unsigned*)(kp[1] + (size_t)s0 * NPROJ), (unsigned*)(Ks + (32 + w * 8) * 64), 16, 0, 0);
    __builtin_amdgcn_global_load_lds((const unsigned*)(vp[0] + s0), (unsigned*)(Vs + (w * 8) * 64), 16, 0, 0);
    __builtin_amdgcn_global_load_lds((const unsigned*)(vp[1] + s0), (unsigned*)(Vs + (32 + w * 8) * 64), 16, 0, 0);
    __builtin_amdgcn_global_load_lds((const unsigned*)(cp + (size_t)s0 * 8), (unsigned*)cs, 16, 0, 0);
}
__device__ __forceinline__ bf16x8 attn_qbias(float u, int h) {
    const unsigned hi = pk_bf16(u, 0.f) & 0xffffu; const float r1 = u - __uint_as_float(hi << 16);
    const unsigned mid = pk_bf16(r1, 0.f) & 0xffffu; const float r2 = r1 - __uint_as_float(mid << 16);
    const unsigned lo = pk_bf16(r2, 0.f) & 0xffffu;
    u32x4 f; f[0] = hi | (mid << 16); f[1] = lo | (0x3F80u << 16); f[2] = 0x3F803F80u; f[3] = 0u;
    if (h) { f[0] = 0u; f[1] = 0u; f[2] = 0u; }
    return __builtin_bit_cast(bf16x8, f);
}
__device__ void fox_attn_item(const Params& p, int l, int bh, int qt, unsigned char* lds_raw) {
    const int tid = ltid(), lane = tid & 63, w = __builtin_amdgcn_readfirstlane(tid >> 6), r = lane & 31, h = lane >> 5;
    const int b = bh / H_FOX, hh = bh % H_FOX;
    const bf16_t* proj = (const bf16_t*)(p.ws + WS_PROJ);
    const bf16_t* kbase = proj + (size_t)b * SEQ * NPROJ + NC_FK + hh * 64;
    const bf16_t* vbase = (const bf16_t*)(p.ws + WS_VTF) + (size_t)bh * 64 * SEQ;
    const float* cum = (const float*)(p.ws + WS_CUM) + (size_t)bh * SEQ;
    const int qlo = qt * 128 + w * 32, q = qlo + r;
    bf16x8 qf[4];
    {
        const bf16_t* qrow = proj + (size_t)(b * SEQ + q) * NPROJ + NC_FQ + hh * 64;
#pragma unroll
        for (int kk = 0; kk < 4; ++kk) qf[kk] = *(const bf16x8*)(qrow + kk * 16 + h * 8);
    }
    const float cq2 = cum[q] * 1.4426950408889634f;
    float mref = 0.f;
    bf16x8 qx = attn_qbias(cq2 - mref, h);
    f32x16 o0, o1;
#pragma unroll
    for (int i = 0; i < 16; ++i) { o0[i] = 0.f; o1[i] = 0.f; }
    float lsum = 0.f;
    const int ntiles = 2 * qt + 2;
    const bf16_t* kp[2]; const bf16_t* vp[2];
    {
        const int row0 = w * 8 + (lane >> 3), pc = lane & 7;
        const int lc0 = (pc ^ ((row0 >> 1) & 7)) * 8;
        kp[0] = kbase + (size_t)row0 * NPROJ + lc0; kp[1] = kbase + (size_t)(row0 + 32) * NPROJ + lc0;
        vp[0] = vbase + (size_t)row0 * SEQ + lc0;   vp[1] = vbase + (size_t)(row0 + 32) * SEQ + lc0;
    }
    const bf16_t* cp = (const bf16_t*)(p.ws + WS_SCR + SCR_CSX) + (size_t)bh * SEQ * 8 + lane * 8;
    const int swr = (r >> 1) & 7;
    int jw;
    {
        float gq = fabsf(p.in[3][l * 64 + lane]), gk = fabsf(p.in[4][l * 64 + lane]);
#pragma unroll
        for (int o = 32; o > 0; o >>= 1) { gq = fmaxf(gq, __shfl_xor(gq, o, 64)); gk = fmaxf(gk, __shfl_xor(gk, o, 64)); }
        const float thr = 2.f * (1.4426950408889634f * 8.f * gq * gk) + 30.f;
        const float cw = cum[qlo] * 1.4426950408889634f;
        const float ce = (lane < ntiles) ? cum[64 * lane + 63] * 1.4426950408889634f : 0.f;
        const unsigned long long keep = __ballot((lane < ntiles) && (cw - ce >= -thr));
        jw = keep ? (__ffsll((long long)keep) - 1) : (ntiles - 1);
    }
    volatile int* jshare = (volatile int*)(lds_raw + ATT_NSTAGE * ATT_BUF + 16);
    asm volatile("s_waitcnt vmcnt(0)" ::: "memory");
    RAW_BARRIER();
    if (tid == 0) *jshare = jw;
    RAW_BARRIER();
    const int jstart = *jshare;
    attn_issue(kp, vp, cp, jstart * 64, lds_raw + (jstart % ATT_NSTAGE) * ATT_BUF, w);
    if (jstart + 1 < ntiles) attn_issue(kp, vp, cp, (jstart + 1) * 64, lds_raw + ((jstart + 1) % ATT_NSTAGE) * ATT_BUF, w);
    for (int j = jstart; j < ntiles; ++j) {
        if (j + 1 < ntiles) asm volatile("s_waitcnt vmcnt(5)" ::: "memory"); else asm volatile("s_waitcnt vmcnt(0)" ::: "memory");
        RAW_BARRIER();
        if (j + 2 < ntiles) attn_issue(kp, vp, cp, (j + 2) * 64, lds_raw + ((j + 2) % ATT_NSTAGE) * ATT_BUF, w);
        const int s0 = j * 64;
        if (s0 <= qlo + 31 && j >= jw) {
            const bf16_t* Ks = (const bf16_t*)(lds_raw + (j % ATT_NSTAGE) * ATT_BUF); const bf16_t* Vs = Ks + 4096; const bf16_t* cs = Vs + 4096;
            f32x16 st0, st1;
            {
                u32x4 z4 = {0u, 0u, 0u, 0u};
                u32x4 c0 = *(const u32x4*)(cs + r * 8), c1 = *(const u32x4*)(cs + (32 + r) * 8);
                if (h) { c0 = z4; c1 = z4; }
                f32x16 zz;
#pragma unroll
                for (int i = 0; i < 16; ++i) zz[i] = 0.f;
                st0 = __builtin_amdgcn_mfma_f32_32x32x16_bf16(__builtin_bit_cast(bf16x8, c0), qx, zz, 0, 0, 0);
                st1 = __builtin_amdgcn_mfma_f32_32x32x16_bf16(__builtin_bit_cast(bf16x8, c1), qx, zz, 0, 0, 0);
            }
#pragma unroll
            for (int kk = 0; kk < 4; ++kk) {
                const int co = ((kk * 2 + h) ^ swr) * 8;
                bf16x8 a0 = *(const bf16x8*)(Ks + r * 64 + co);
                bf16x8 a1 = *(const bf16x8*)(Ks + (32 + r) * 64 + co);
                st0 = __builtin_amdgcn_mfma_f32_32x32x16_bf16(a0, qf[kk], st0, 0, 0, 0);
                st1 = __builtin_amdgcn_mfma_f32_32x32x16_bf16(a1, qf[kk], st1, 0, 0, 0);
            }
            if (s0 + 63 > qlo) {
#pragma unroll
                for (int i = 0; i < 16; ++i) {
                    const int key = s0 + (i & 3) + 8 * (i >> 2) + 4 * h;
                    if (key > q) st0[i] = -1e30f;
                    if (key + 32 > q) st1[i] = -1e30f;
                }
            }
            float mx = fmaxf(st0[0], st1[0]);
#pragma unroll
            for (int i = 1; i < 16; ++i) mx = fmaxf(mx, fmaxf(st0[i], st1[i]));
            if (__any(mx > ATT_THR)) {
                const float mo = fmaxf(mx, __shfl_xor(mx, 32, 64));
                const float d = (mo > ATT_THR) ? mo : 0.f;
                const float alpha = __builtin_amdgcn_exp2f(-d);
#pragma unroll
                for (int i = 0; i < 16; ++i) { st0[i] -= d; st1[i] -= d; o0[i] *= alpha; o1[i] *= alpha; }
                lsum *= alpha; mref += d;
                qx = attn_qbias(cq2 - mref, h);
            }
            float rs = 0.f;
#pragma unroll
            for (int i = 0; i < 16; ++i) { st0[i] = __builtin_amdgcn_exp2f(st0[i]); st1[i] = __builtin_amdgcn_exp2f(st1[i]); rs += st0[i] + st1[i]; }
            lsum += rs;
            bf16x8 pf[2][2];
#pragma unroll
            for (int s = 0; s < 2; ++s) {
                u32x4 t0 = {pk_bf16(st0[8 * s], st0[8 * s + 1]), pk_bf16(st0[8 * s + 2], st0[8 * s + 3]), pk_bf16(st0[8 * s + 4], st0[8 * s + 5]), pk_bf16(st0[8 * s + 6], st0[8 * s + 7])};
                u32x4 t1 = {pk_bf16(st1[8 * s], st1[8 * s + 1]), pk_bf16(st1[8 * s + 2], st1[8 * s + 3]), pk_bf16(st1[8 * s + 4], st1[8 * s + 5]), pk_bf16(st1[8 * s + 6], st1[8 * s + 7])};
                pf[0][s] = __builtin_bit_cast(bf16x8, t0); pf[1][s] = __builtin_bit_cast(bf16x8, t1);
            }
#pragma unroll
            for (int mt = 0; mt < 2; ++mt)
#pragma unroll
                for (int s = 0; s < 2; ++s) {
                    const int c0 = 4 * mt + 2 * s;
                    const int oA = ((c0 ^ swr) * 8) + 4 * h, oB = (((c0 + 1) ^ swr) * 8) + 4 * h;
                    uint2 a00 = *(const uint2*)(Vs + r * 64 + oA), a01 = *(const uint2*)(Vs + r * 64 + oB);
                    uint2 a10 = *(const uint2*)(Vs + (32 + r) * 64 + oA), a11 = *(const uint2*)(Vs + (32 + r) * 64 + oB);
                    u32x4 u0 = {a00.x, a00.y, a01.x, a01.y}; u32x4 u1 = {a10.x, a10.y, a11.x, a11.y};
                    o0 = __builtin_amdgcn_mfma_f32_32x32x16_bf16(__builtin_bit_cast(bf16x8, u0), pf[mt][s], o0, 0, 0, 0);
                    o1 = __builtin_amdgcn_mfma_f32_32x32x16_bf16(__builtin_bit_cast(bf16x8, u1), pf[mt][s], o1, 0, 0, 0);
                }
        }
    }
    lsum += __shfl_xor(lsum, 32, 64);
    const float inv = 1.f / lsum;
    float ss = 0.f;
#pragma unroll
    for (int i = 0; i < 16; ++i) { o0[i] *= inv; o1[i] *= inv; ss += o0[i] * o0[i] + o1[i] * o1[i]; }
    ss += __shfl_xor(ss, 32, 64);
    const float rstd = rsqrtf(ss * (1.f / 64.f) + 1e-6f);
    const float* og = p.in[6] + l * 64;
    bf16_t* mrow = (bf16_t*)(p.ws + WS_MIX) + pl_off(b * SEQ + q, hh * 64, 1024);
#pragma unroll
    for (int g = 0; g < 4; ++g) {
        const int e0 = 8 * g + 4 * h;
        f32x4 g0 = *(const f32x4*)(og + e0), g1 = *(const f32x4*)(og + 32 + e0);
        store4_bf16(mrow + e0, o0[4 * g] * rstd * g0[0], o0[4 * g + 1] * rstd * g0[1], o0[4 * g + 2] * rstd * g0[2], o0[4 * g + 3] * rstd * g0[3]);
        store4_bf16(mrow + 64 + e0, o1[4 * g] * rstd * g1[0], o1[4 * g + 1] * rstd * g1[1], o1[4 * g + 2] * rstd * g1[2], o1[4 * g + 3] * rstd * g1[3]);
    }
}
#define ATT_ITEMS (BATCH * H_FOX * (SEQ / 128))
#define CONV_ITEMS ((CONV_REST + P0_T_IN + 3) / 4)
__device__ void phase_scan_attn(const Params& p, int l, unsigned char* lds_raw, int rep = 0, int sel = 7) {
    unsigned* qctr = (unsigned*)(p.ws + WS_CTL) + CW_Q + l + 2 * rep;
    volatile int* slot = (volatile int*)(lds_raw + ATT_NSTAGE * ATT_BUF);
    for (;;) {
        __syncthreads();
        if (threadIdx.x == 0) *slot = (int)atomicAdd(qctr, 1u);
        __syncthreads();
        int it = *slot;
        const int ns0 = (MIXSEL & 1) ? BATCH * H_GDN * 4 : 0, ns1 = ns0 + ((MIXSEL & 2) ? 128 : 0);
        if (it >= ns1 + ATT_ITEMS + CONV_ITEMS) break;
        if (it >= ns1) {
            const int c = it - ns1;
            int conv_idx = -1;
            if (c < 5 * ATT_ITEMS) { if (c % 5 != 0) conv_idx = c - c / 5 - 1; } else conv_idx = c - ATT_ITEMS;
            if (conv_idx >= 0) {
                if (rep == 0 && conv_idx < CONV_ITEMS) conv_fold4(p, l, conv_idx * 4, ltid());
                continue;
            }
            it = ns1 + c / 5;
        }
        if (it < ns0) { if (sel & 1) gdn_scan_item(p, it, lds_raw, rep ? SVAR : 0); continue; }
        if (it < ns1) { if (sel & 2) gla_scan_item(p, it - ns0); continue; }
        it -= ns1;
        if (!(sel & 4)) continue;
        const int qt = (SEQ / 128 - 1) - it / (BATCH * H_FOX), bh = it % (BATCH * H_FOX);
        fox_attn_item(p, l, bh, qt, lds_raw);
    }
}

#define NPHASE 19
__global__ void __launch_bounds__(256, 2) mk(Params p, int lo, int hi, int use_bar) {
    __shared__ __attribute__((aligned(16))) unsigned char lds_raw[LDS_BYTES];
    bf16_t* lds = (bf16_t*)lds_raw;
    volatile LAS unsigned* st = (volatile LAS unsigned*)(lds_raw + LDS_BYTES - 16);
    XcdBarrier bar; bar.bar = (unsigned*)(p.ws + WS_CTL) + CW_BAR; bar.x = 0; bar.st = st;
    if (use_bar) {
        if (threadIdx.x == 0) { st[0] = 0u; st[1] = 0u; }
        __syncthreads();
        bar = xcd_barrier_post((unsigned*)(p.ws + WS_CTL) + CW_BAR, st);
    }
    for (int ph = lo; ph < hi; ++ph) {
#ifndef PSEL
#define PSEL 0xffff
#endif
        int phv = ph; asm volatile("" : "+s"(phv));
        size_t zoff = 0; asm volatile("" : "+s"(zoff));
        Params q = p; q.ws = p.ws + zoff; q.out = p.out + zoff;
        if (phv == 0) { if (PSEL & 1) phase0(q); }
        else {
            int l = (phv - 1) / 9, s = (phv - 1) % 9;
            if (s == 0) { if (PSEL & 2) phase_inproj(q, l, lds); }
            else if (s == 1) { if (PSEL & 128) phase_prep(q, l, lds_raw); }
            else if (s == 2) { if (PSEL & 256) phase_scan_attn(q, l, lds_raw); }
            else if (s == 3) { if (PSEL & 512) phase_mixout(q, l); }
            else if (s == 4) { if (PSEL & 4) phase_outproj(q, l, lds); }
            else if (s == 5) { if (PSEL & 8) phase_route(q, l, lds); }
            else if (s == 6) { if (PSEL & 16) phase_expert<0>(q, l, lds); }
            else if (s == 7) { if (PSEL & 32) phase_expert<1>(q, l, lds); }
            else if (s == 8) { if (PSEL & 64) phase_combine(q, l); }
        }
#ifdef REPEAT_MASK
        {
            const int ty = (phv == 0) ? 9 : (phv - 1) % 9, l = (phv == 0) ? 0 : (phv - 1) / 9;
            const bool idem = !((ty == 4 && l == 1));
            if (((REPEAT_MASK >> ty) & 1) && idem && use_bar) {
                xcd_barrier(bar);
                if (ty == 9) phase0(q);
                else if (ty == 0) phase_inproj(q, l, lds, GVAR);
                else if (ty == 1) phase_prep(q, l, lds_raw);
                else if (ty == 2) phase_scan_attn(q, l, lds_raw, 1, P3SEL);
                else if (ty == 3) phase_mixout(q, l);
                else if (ty == 4) phase_outproj(q, l, lds);
                else if (ty == 5) phase_route(q, l, lds, 1);
                else if (ty == 8) phase_combine(q, l, 1);
                else if (ty == 6) phase_expert<0>(q, l, lds);
                else if (ty == 7) phase_expert<1>(q, l, lds);
            }
        }
#endif
        if (ph + 1 < hi) {
            if (hi > 1000) cg::this_grid().sync();
            xcd_barrier(bar);
        }
    }
}

extern "C" void kernel_launch(void* const* d_in, const int* in_sizes, int n_in,
                              void* d_out, int out_size, void* d_ws, size_t ws_size,
                              hipStream_t stream) {
    static int grid = 0;
    if (grid == 0) {
        if (ws_size < WS_END) { fprintf(stderr, "ws too small: need %zu have %zu\n", (size_t)WS_END, ws_size); grid = -1; return; }
        int dev = 0, cus = 0, per_cu = 0;
        hipGetDevice(&dev);
        hipDeviceGetAttribute(&cus, hipDeviceAttributeMultiprocessorCount, dev);
        hipOccupancyMaxActiveBlocksPerMultiprocessor(&per_cu, mk, 256, 0);
        if (per_cu > 2) per_cu = 2;
        if (per_cu < 1) { fprintf(stderr, "occupancy query failed\n"); grid = -1; return; }
        grid = cus * per_cu;
        grid -= grid % 8;
    }
    if (grid < 0) return;
    Params p{};
    for (int i = 0; i < 23; ++i) p.in[i] = (const float*)d_in[i];
    p.out = (float*)d_out; p.ws = (char*)d_ws;
    hipMemsetAsync((char*)d_ws + WS_CTL, 0, CTL_BYTES, stream);
#ifdef POISON_GLA
    hipMemsetAsync((char*)d_ws + WS_SCR + SCR_GLA_OL, 0xFF, SCR_LVT - SCR_GLA_OL, stream);
#endif

#ifdef MULTI_LAUNCH
    for (int ph = 0; ph < NPHASE; ++ph) mk<<<grid, 256, 0, stream>>>(p, ph, ph + 1, 0);
#else
    int lo = 0, hi = NPHASE, ub = 2;
    void* args[] = {&p, &lo, &hi, &ub};
    hipError_t e = hipLaunchCooperativeKernel((void*)mk, dim3(grid), dim3(256), args, 0, stream);
    if (e != hipSuccess) fprintf(stderr, "cooperative launch failed: %s (grid %d)\n", hipGetErrorString(e), grid);
#endif
}
```

```cpp
#include <hip/hip_runtime.h>
#include <hip/hip_cooperative_groups.h>
#include <cstdint>
#include <cstdio>
namespace cg = cooperative_groups;

#define D_MODEL 1024
#define BATCH 4
#define SEQ 4096
#define NTOK (BATCH * SEQ)
#define H_FOX 6
#define H_GDN 6
#define H_GLA 4
#define N_IN 3490
#define N_EXP 32
#define D_EXP 512
#define NPROJ 3456
#define NINP 3584

#define C_FF 1152
#define C_GQ 1158
#define C_GG 2310
#define C_GA 2694
#define C_GB 2700
#define C_LQ 2706
#define C_LA 3474
#define NC_FQ 0
#define NC_FK 384
#define NC_FV 768
#define NC_GQ 1152
#define NC_GK 1536
#define NC_GV 1920
#define NC_GG 2304
#define NC_LQ 2688
#define NC_LK 2816
#define NC_LV 2944
#define NC_LR 3200
#define AX_FF 0
#define AX_GA 6
#define AX_GB 12
#define AX_LA 18

#ifndef SVAR
#define SVAR 0
#endif
#ifndef P3SEL
#define P3SEL 7
#endif
#ifndef GVAR
#define GVAR 0
#endif
#ifndef MIXSEL
#define MIXSEL 3
#endif
typedef unsigned short bf16_t;
typedef short bf16x8 __attribute__((ext_vector_type(8)));
typedef float f32x4 __attribute__((ext_vector_type(4)));
typedef unsigned u32x4 __attribute__((ext_vector_type(4)));
typedef unsigned u32x2 __attribute__((ext_vector_type(2)));

#define WS_CTL      0
#define CTL_BYTES   65536
#define WS_WIN      (WS_CTL + CTL_BYTES)
#define WS_WOUT     (WS_WIN + (size_t)2 * NINP * 1024 * 2)
#define WS_WGU      (WS_WOUT + (size_t)2 * 1024 * 1024 * 2)
#define WS_WD       (WS_WGU + (size_t)2 * 32 * 1024 * 1024 * 2)
#define WS_WR       (WS_WD + (size_t)2 * 32 * 1024 * 512 * 2)
#define WS_HN       (WS_WR + (size_t)2 * 64 * 1024 * 2)
#define WS_PROJ     (WS_HN + (size_t)NTOK * 1024 * 2)
#define WS_VTF      (WS_PROJ + (size_t)NTOK * NPROJ * 2)
#define WS_AUX      (WS_VTF + (size_t)BATCH * H_FOX * 64 * SEQ * 2)
#define WS_CUM      (WS_AUX + (size_t)NTOK * 64 * 4)
#define WS_MIX      (WS_CUM + (size_t)BATCH * H_FOX * SEQ * 4)
#define WS_ROWTOK   (WS_MIX + (size_t)NTOK * 1024 * 2)
#define WS_TSLOT    (WS_ROWTOK + (size_t)32 * NTOK * 4)
#define WS_TGATE    (WS_TSLOT + (size_t)NTOK * 2 * 4)
#define WS_SCR      (WS_TGATE + (size_t)NTOK * 2 * 4)
#define SCR_BYTES   ((size_t)100 * 1024 * 1024)
#define WS_END      (WS_SCR + SCR_BYTES)
#define HROWS       (2 * NTOK + 32 * 128)
#define WS_H        WS_PROJ
#define WS_Y        (WS_PROJ + (size_t)HROWS * 512 * 2)

#define NGDN_CH 1536
#define NGLA_CH 1024
#define SCR_GDN_MP   ((size_t)0)
#define SCR_GDN_NN   (SCR_GDN_MP + (size_t)NGDN_CH * 8192)
#define SCR_GDN_P    (SCR_GDN_NN + (size_t)NGDN_CH * 8192)
#define SCR_GDN_OL   (SCR_GDN_P  + (size_t)NGDN_CH * 8192)
#define SCR_GDN_SG   (SCR_GDN_OL + (size_t)NGDN_CH * 8192)
#define SCR_GDN_LAST (SCR_GDN_SG + (size_t)NGDN_CH * 8192)
#define SCR_GLA_OL   (SCR_GDN_LAST + (size_t)NGDN_CH * 4)
#define SCR_GLA_KV   (SCR_GLA_OL + (size_t)NGLA_CH * 8192)
#define SCR_GLA_QB   (SCR_GLA_KV + (size_t)NGLA_CH * 8192)
#define SCR_GLA_SG   (SCR_GLA_QB + (size_t)NGLA_CH * 4096)
#define SCR_GLA_DL   (SCR_GLA_SG + (size_t)NGLA_CH * 4096)
#define SCR_LVT      (SCR_GLA_DL + (size_t)NGLA_CH * 128)
#define SCR_USED     (SCR_LVT + (size_t)BATCH * H_GLA * 64 * SEQ * 2)
#define SCR_CSX      SCR_USED
static_assert(SCR_CSX + (size_t)BATCH * H_FOX * SEQ * 16 <= SCR_BYTES, "scratch overflow");
#define CW_BAR      0
#define CW_CNT      4096
#define CNT_STRIDE  64
#define CW_Q        (CW_CNT + 2 * 32 * CNT_STRIDE + 64)

struct Params {
    const float* in[23];
    float* out;
    char* ws;
};

__device__ __forceinline__ float sigmoidf_(float x) { return __builtin_amdgcn_rcpf(1.f + __expf(-x)); }
__device__ __forceinline__ float siluf_(float x) { return x * __builtin_amdgcn_rcpf(1.f + __expf(-x)); }
__device__ __forceinline__ float softplusf_(float x) { return x > 20.f ? x : __logf(1.f + __expf(x)); }
__device__ __forceinline__ float logsigmoidf_(float x) { return -softplusf_(-x); }
__device__ __forceinline__ float wave_sum(float v) {
#pragma unroll
    for (int o = 32; o > 0; o >>= 1) v += __shfl_xor(v, o, 64);
    return v;
}
__device__ __forceinline__ int ltid() { int t = threadIdx.x; asm volatile("" : "+v"(t)); return t; }
typedef __bf16 bf16x2_t __attribute__((ext_vector_type(2)));
typedef float f32x2_t __attribute__((ext_vector_type(2)));
__device__ __forceinline__ unsigned pk_bf16(float lo, float hi) { f32x2_t v = {lo, hi}; bf16x2_t r = __builtin_convertvector(v, bf16x2_t); return __builtin_bit_cast(unsigned, r); }
__device__ __forceinline__ size_t pl_off(int row, int k, int K) { return (size_t)(row >> 1) * (size_t)(2 * K) + (size_t)((k >> 5) * 64 + (row & 1) * 32 + (k & 31)); }
__device__ __forceinline__ unsigned ld_u32_agent(const unsigned* p) { return __hip_atomic_load(p, __ATOMIC_RELAXED, __HIP_MEMORY_SCOPE_AGENT); }
__device__ __forceinline__ float ld_f32_agent(const float* p) { return __uint_as_float(__hip_atomic_load((const unsigned*)p, __ATOMIC_RELAXED, __HIP_MEMORY_SCOPE_AGENT)); }
__device__ __forceinline__ float bf2f(bf16_t v) { return __uint_as_float((unsigned)v << 16); }
__device__ __forceinline__ float bflo(unsigned v) { return __uint_as_float(v << 16); }
__device__ __forceinline__ float bfhi(unsigned v) { return __uint_as_float(v & 0xffff0000u); }

#define XB_TMO      128
#define XB_XCNT(j)  (256  + 64 * (j))
#define XB_XSUB(j)  (1280 + 64 * (j))
#define XB_XGEN(j)  (2304 + 64 * (j))
#define XB_TOP      3328
#define XB_TOPGEN   3392
#define XCD_BAR_WORDS 3456
#define XB_SPIN_CAP (1u << 22)
#define LAS __attribute__((address_space(3)))
__device__ __forceinline__ unsigned xb_ld(unsigned* p)              { return __hip_atomic_load(p, __ATOMIC_RELAXED, __HIP_MEMORY_SCOPE_AGENT); }
__device__ __forceinline__ unsigned xb_add(unsigned* p, unsigned v) { return __hip_atomic_fetch_add(p, v, __ATOMIC_RELAXED, __HIP_MEMORY_SCOPE_AGENT); }
__device__ __forceinline__ unsigned xb_xcc_id() { return (unsigned)__builtin_amdgcn_s_getreg((3 << 11) | 20) & 0xFu; }
#define XB_SPIN(cond, bar) do { unsigned _sp = 0; while (cond) { if (_sp < 16u) __builtin_amdgcn_s_sleep(2); else __builtin_amdgcn_s_sleep(20);     \
    if ((++_sp & 255u) == 0u) { if (xb_ld(&(bar)[XB_TMO])) break; if (_sp > XB_SPIN_CAP) { atomicAdd(&(bar)[XB_TMO], 1u); break; } } } } while (0)
struct XcdBarrier { unsigned* bar; unsigned x; volatile LAS unsigned* st; };
__device__ __forceinline__ XcdBarrier xcd_barrier_post(unsigned* bar, volatile LAS unsigned* st) {
    XcdBarrier b; b.bar = bar; b.x = xb_xcc_id(); b.st = st;
    if (threadIdx.x == 0) (void)xb_add(&bar[XB_XCNT(b.x)], 1u);
    return b;
}
__device__ __forceinline__ void xcd_barrier_complete(unsigned* bar, unsigned x, unsigned& nloc, unsigned& nx) {
    const unsigned G = gridDim.x * gridDim.y * gridDim.z;
    unsigned sum, cnt, mine, sp = 0u;
    for (;;) {
        sum = 0u; cnt = 0u; mine = 0u;
#pragma unroll
        for (unsigned j = 0; j < 16; ++j) { const unsigned c = xb_ld(&bar[XB_XCNT(j)]); sum += c; cnt += (c > 0u) ? 1u : 0u; mine = (j == x) ? c : mine; }
        if (sum == G) break;
        __builtin_amdgcn_s_sleep(1);
        if ((++sp & 255u) == 0u) { if (xb_ld(&bar[XB_TMO])) break; if (sp > XB_SPIN_CAP) { atomicAdd(&bar[XB_TMO], 1u); break; } }
    }
    nloc = mine > 0u ? mine : 1u; nx = cnt > 0u ? cnt : 1u;
}
__device__ __forceinline__ void xcd_barrier(const XcdBarrier& b) {
    asm volatile("s_waitcnt vmcnt(0)" ::: "memory");
    __syncthreads();
    if (threadIdx.x == 0) {
        unsigned* bar = b.bar;
        __builtin_amdgcn_s_waitcnt(0);
        unsigned nloc = b.st[0], nx = b.st[1];
        if (nloc == 0u) { xcd_barrier_complete(bar, b.x, nloc, nx); b.st[0] = nloc; b.st[1] = nx; }
        const unsigned old = xb_add(&bar[XB_XSUB(b.x)], 1u);
        const unsigned gen = old / nloc;
        if (old + 1u == (gen + 1u) * nloc) {
            __builtin_amdgcn_fence(__ATOMIC_RELEASE, "agent");
            asm volatile("s_waitcnt vmcnt(0)" ::: "memory");
            const unsigned og = xb_add(&bar[XB_TOP], 1u);
            const unsigned tg = og / nx;
            if (og + 1u == (tg + 1u) * nx) xb_add(&bar[XB_TOPGEN], 1u);
            else XB_SPIN(xb_ld(&bar[XB_TOPGEN]) == tg, bar);
            __builtin_amdgcn_fence(__ATOMIC_ACQUIRE, "agent");
            xb_add(&bar[XB_XGEN(b.x)], 1u);
            asm volatile("s_waitcnt vmcnt(0)" ::: "memory");
        } else {
            XB_SPIN(xb_ld(&bar[XB_XGEN(b.x)]) == gen, bar);
            __builtin_amdgcn_fence(__ATOMIC_ACQUIRE, "agent");
            asm volatile("s_waitcnt vmcnt(0)" ::: "memory");
        }
    }
    __syncthreads();
}

#define LDS_BYTES 66560
#define LROW 72

__device__ __forceinline__ int inproj_map(int n) {
    if (n < 1152) return n;
    if (n < 2304) return C_GQ + (n - 1152);
    if (n < 2688) return C_GG + (n - 2304);
    if (n < 3456) return C_LQ + (n - 2688);
    if (n < 3462) return C_FF + (n - 3456);
    if (n < 3468) return C_GA + (n - 3462);
    if (n < 3474) return C_GB + (n - 3468);
    if (n < 3490) return n;
    return -1;
}
#define P0_T_IN   (56 * 16)
#define P0_T_OUT  (16 * 16)
#define P0_T_GU   (32 * 16 * 16)
#define P0_T_D    (32 * 16 * 8)
#define P0_T_R    (16)
#define P0_T_LAYER (P0_T_IN + P0_T_OUT + P0_T_GU + P0_T_D + P0_T_R)
#define P0_T_NORM (NTOK / 4)
struct ConvDesc { const float* src; bf16_t* dst; int ld; int col; };
__device__ __forceinline__ ConvDesc conv_desc(const Params& p, int l, int j, int tid) {
    const int nl = tid & 63, kg = tid >> 6;
    ConvDesc d;
    if (j < P0_T_IN) {
        int tn = j / 16, tk = j % 16; int n = tn * 64 + nl; int k0 = tk * 64 + kg * 16;
        d.ld = N_IN; d.col = inproj_map(n); d.src = p.in[2] + (size_t)l * 1024 * N_IN + (size_t)k0 * N_IN;
        d.dst = (bf16_t*)(p.ws + WS_WIN) + (size_t)l * NINP * 1024 + pl_off(n, k0, 1024);
        return d;
    }
    j -= P0_T_IN;
    if (j < P0_T_OUT) {
        int tn = j / 16, tk = j % 16; int n = tn * 64 + nl; int k0 = tk * 64 + kg * 16;
        d.ld = 1024; d.col = n; d.src = p.in[14] + (size_t)l * 1024 * 1024 + (size_t)k0 * 1024;
        d.dst = (bf16_t*)(p.ws + WS_WOUT) + (size_t)l * 1024 * 1024 + pl_off(n, k0, 1024);
        return d;
    }
    j -= P0_T_OUT;
    if (j < P0_T_GU) {
        int e = j / 256, r = j % 256; int tn = r / 16, tk = r % 16; int n = tn * 64 + nl; int k0 = tk * 64 + kg * 16;
        int t128 = n >> 7, wx = (n >> 6) & 1, half = (n >> 5) & 1, jj = n & 31;
        d.ld = 512; d.col = t128 * 64 + wx * 32 + jj;
        d.src = (half ? p.in[21] : p.in[20]) + ((size_t)l * 32 + e) * 1024 * 512 + (size_t)k0 * 512;
        d.dst = (bf16_t*)(p.ws + WS_WGU) + ((size_t)l * 32 + e) * 1024 * 1024 + pl_off(n, k0, 1024);
        return d;
    }
    j -= P0_T_GU;
    if (j < P0_T_D) {
        int e = j / 128, r = j % 128; int tn = r / 8, tk = r % 8; int n = tn * 64 + nl; int k0 = tk * 64 + kg * 16;
        d.ld = 1024; d.col = n; d.src = p.in[22] + ((size_t)l * 32 + e) * 512 * 1024 + (size_t)k0 * 1024;
        d.dst = (bf16_t*)(p.ws + WS_WD) + ((size_t)l * 32 + e) * 1024 * 512 + pl_off(n, k0, 512);
        return d;
    }
    j -= P0_T_D;
    {
        int tk = j; int n = nl; int k0 = tk * 64 + kg * 16;
        if (n < 4) { d.src = p.in[16] + (size_t)l * 1024 * 4 + (size_t)k0 * 4; d.ld = 4; d.col = n; }
        else if (n < 36) { d.src = p.in[18] + (size_t)l * 1024 * 32 + (size_t)k0 * 32; d.ld = 32; d.col = n - 4; }
        else { d.src = p.in[16]; d.ld = 4; d.col = -1; }
        d.dst = (bf16_t*)(p.ws + WS_WR) + ((size_t)l * 64 + n) * 1024 + k0;
        return d;
    }
}
__device__ __forceinline__ void conv_load(const ConvDesc& d, float (&v)[16]) {
    if (d.col >= 0) {
#pragma unroll
        for (int i = 0; i < 16; ++i) v[i] = d.src[(size_t)i * d.ld + d.col];
    } else {
#pragma unroll
        for (int i = 0; i < 16; ++i) v[i] = 0.f;
    }
}
__device__ __forceinline__ void conv_store(const ConvDesc& d, const float (&v)[16]) {
    uint4 o0, o1;
    o0.x = pk_bf16(v[0], v[1]); o0.y = pk_bf16(v[2], v[3]); o0.z = pk_bf16(v[4], v[5]); o0.w = pk_bf16(v[6], v[7]);
    o1.x = pk_bf16(v[8], v[9]); o1.y = pk_bf16(v[10], v[11]); o1.z = pk_bf16(v[12], v[13]); o1.w = pk_bf16(v[14], v[15]);
    *(uint4*)(d.dst) = o0;
    *(uint4*)(d.dst + 8) = o1;
}
__device__ __forceinline__ void conv_job(const Params& p, int l, int j, int tid) {
    ConvDesc d = conv_desc(p, l, j, tid); float v[16]; conv_load(d, v); conv_store(d, v);
}
#define CONV_REST (P0_T_LAYER - P0_T_IN)
__device__ __forceinline__ bool conv_fold_desc(const Params& p, int l, int idx, int tid, ConvDesc& d) {
    if (idx < CONV_REST) { d = conv_desc(p, l, P0_T_IN + idx, tid); return true; }
    if (l == 0 && idx < CONV_REST + P0_T_IN) { d = conv_desc(p, 1, idx - CONV_REST, tid); return true; }
    return false;
}
__device__ __forceinline__ void conv_fold4(const Params& p, int l, int idx0, int tid) {
    ConvDesc d0, d1, d2, d3; float v0[16], v1[16], v2[16], v3[16];
    const bool b0 = conv_fold_desc(p, l, idx0, tid, d0), b1 = conv_fold_desc(p, l, idx0 + 1, tid, d1), b2 = conv_fold_desc(p, l, idx0 + 2, tid, d2), b3 = conv_fold_desc(p, l, idx0 + 3, tid, d3);
    if (b0) conv_load(d0, v0); if (b1) conv_load(d1, v1); if (b2) conv_load(d2, v2); if (b3) conv_load(d3, v3);
    if (b0) conv_store(d0, v0); if (b1) conv_store(d1, v1); if (b2) conv_store(d2, v2); if (b3) conv_store(d3, v3);
}
__device__ void phase0(const Params& p) {
    const int tid = ltid(), nl = tid & 63, kg = tid >> 6;
    const int total = P0_T_IN + P0_T_NORM;
    for (int it = blockIdx.x; it < total; it += gridDim.x) {
        if (it >= P0_T_IN) {
            int row = (it - P0_T_IN) * 4 + kg;
            const float* xr = p.in[0] + (size_t)row * D_MODEL + nl * 16;
            const float* gr = p.in[1] + nl * 16;
            float v[16]; float ss = 0.f;
#pragma unroll
            for (int i = 0; i < 4; ++i) { float4 t = *(const float4*)(xr + 4 * i); v[4 * i] = t.x; v[4 * i + 1] = t.y; v[4 * i + 2] = t.z; v[4 * i + 3] = t.w; }
#pragma unroll
            for (int i = 0; i < 16; ++i) ss += v[i] * v[i];
            ss = wave_sum(ss);
            float r = rsqrtf(ss / D_MODEL + 1e-6f);
#pragma unroll
            for (int i = 0; i < 16; ++i) v[i] = v[i] * r * gr[i];
            uint4 o0, o1;
            o0.x = pk_bf16(v[0], v[1]); o0.y = pk_bf16(v[2], v[3]); o0.z = pk_bf16(v[4], v[5]); o0.w = pk_bf16(v[6], v[7]);
            o1.x = pk_bf16(v[8], v[9]); o1.y = pk_bf16(v[10], v[11]); o1.z = pk_bf16(v[12], v[13]); o1.w = pk_bf16(v[14], v[15]);
            bf16_t* hr = (bf16_t*)(p.ws + WS_HN) + pl_off(row, nl * 16, 1024);
            *(uint4*)hr = o0; *(uint4*)(hr + 8) = o1;
            continue;
        }
        conv_job(p, 0, it, tid);
    }
}

#define GSTAGE 8192
#define RAW_BARRIER() do { asm volatile("s_waitcnt lgkmcnt(0)" ::: "memory"); __builtin_amdgcn_s_barrier(); } while (0)
__device__ __forceinline__ int gswz(int row) { return (0x1320 >> (((row >> 2) & 3) * 4)) & 3; }
__device__ __forceinline__ void gemm_issue(const bf16_t* const (&px)[2], const bf16_t* const (&py)[2], int k0, bf16_t* stage, int w) {
    __builtin_amdgcn_global_load_lds((const unsigned*)(px[0] + 2 * k0), (unsigned*)(stage + (w * 16) * 32), 16, 0, 0);
    __builtin_amdgcn_global_load_lds((const unsigned*)(px[1] + 2 * k0), (unsigned*)(stage + (64 + w * 16) * 32), 16, 0, 0);
    __builtin_amdgcn_global_load_lds((const unsigned*)(py[0] + 2 * k0), (unsigned*)(stage + 4096 + (w * 16) * 32), 16, 0, 0);
    __builtin_amdgcn_global_load_lds((const unsigned*)(py[1] + 2 * k0), (unsigned*)(stage + 4096 + (64 + w * 16) * 32), 16, 0, 0);
}
__device__ __forceinline__ void gemm_compute(const bf16_t* stage, int wx, int wy, int fr, int fg, f32x4 (&acc)[4][4]) {
    const int co = (fg ^ gswz(fr)) * 8;
    bf16x8 xa[4], yb[4];
#pragma unroll
    for (int m = 0; m < 4; ++m) xa[m] = *(const bf16x8*)(stage + (wx * 64 + m * 16 + fr) * 32 + co);
#pragma unroll
    for (int n = 0; n < 4; ++n) yb[n] = *(const bf16x8*)(stage + 4096 + (wy * 64 + n * 16 + fr) * 32 + co);
    __builtin_amdgcn_s_setprio(1);
#pragma unroll
    for (int m = 0; m < 4; ++m)
#pragma unroll
        for (int n = 0; n < 4; ++n) acc[m][n] = __builtin_amdgcn_mfma_f32_16x16x32_bf16(xa[m], yb[n], acc[m][n], 0, 0, 0);
    __builtin_amdgcn_s_setprio(0);
}
template <class FX, class FY>
__device__ __forceinline__ void gemm_core(FX rowx, FY rowy, int K, bf16_t* lds, f32x4 (&acc)[4][4], int gvar = 0) {
    const int tid = ltid(), lane = tid & 63, w = __builtin_amdgcn_readfirstlane(tid >> 6), wx = w >> 1, wy = w & 1, fr = lane & 15, fg = lane >> 4;
#pragma unroll
    for (int a = 0; a < 4; ++a)
#pragma unroll
        for (int b = 0; b < 4; ++b) acc[a][b] = (f32x4){0.f, 0.f, 0.f, 0.f};
    const bf16_t* px[2]; const bf16_t* py[2];
    {
        const int r0 = w * 16 + (lane >> 2), pc = lane & 3;
        const int lc0 = (pc ^ gswz(r0)) * 8;
        px[0] = rowx(r0) + lc0; px[1] = rowx(r0 + 64) + lc0;
        py[0] = rowy(r0) + lc0; py[1] = rowy(r0 + 64) + lc0;
    }
    const int nt = K >> 5;
    RAW_BARRIER();
    if (gvar != 3) {
    gemm_issue(px, py, 0, lds, w);
    gemm_issue(px, py, 32, lds + GSTAGE, w);
    gemm_issue(px, py, 64, lds + 2 * GSTAGE, w);
    }
    for (int j = 0; j < nt; ++j) {
        if (j + 2 < nt) asm volatile("s_waitcnt vmcnt(8)" ::: "memory");
        else if (j + 1 < nt) asm volatile("s_waitcnt vmcnt(4)" ::: "memory");
        else asm volatile("s_waitcnt vmcnt(0)" ::: "memory");
        RAW_BARRIER();
        if (j + 3 < nt && gvar != 3) gemm_issue(px, py, (j + 3) * 32, lds + ((j + 3) & 3) * GSTAGE, w);
        if (gvar != 2) gemm_compute(lds + (j & 3) * GSTAGE, wx, wy, fr, fg, acc);
    }
}
__device__ __forceinline__ void store4_bf16(bf16_t* p, float a, float b, float c, float d) {
    uint2 o; o.x = pk_bf16(a, b); o.y = pk_bf16(c, d); *(uint2*)p = o;
}
template <int NC> __device__ __forceinline__ void ep_put(bf16_t* T, int row, int col, float a, float b, float c, float d) {
    uint2 o; o.x = pk_bf16(a, b); o.y = pk_bf16(c, d); *(uint2*)(T + row * (NC + 8) + col) = o;
}
template <int NC, class FD> __device__ __forceinline__ void ep_flush(const bf16_t* T, int tid, FD dst) {
    constexpr int CPR = NC / 8;
#pragma unroll
    for (int i = 0; i < NC / 16; ++i) {
        const int c = tid + 256 * i; const int row = c / CPR, ch = c % CPR;
        *(u32x4*)(dst(row, ch)) = *(const u32x4*)(T + row * (NC + 8) + ch * 8);
    }
}

__device__ __forceinline__ bool xcd_item(int round, int ntm, int ntn, int& tm, int& tn) {
    const int x = blockIdx.x & 7, loc = blockIdx.x >> 3, nloc = gridDim.x >> 3;
    const int tmx = ntm >> 3;
    const int j = round * nloc + loc;
    if (j >= tmx * ntn) return false;
    tn = j / tmx; tm = (j % tmx) * 8 + x;
    return true;
}

__device__ void phase_inproj(const Params& p, int l, bf16_t* lds, int gvar = 0) {
    const int tid = ltid(), lane = tid & 63, w = tid >> 6, wx = w >> 1, wy = w & 1, fr = lane & 15, fg = lane >> 4;
    const bf16_t* hn = (const bf16_t*)(p.ws + WS_HN);
    const bf16_t* wt = (const bf16_t*)(p.ws + WS_WIN) + (size_t)l * NINP * 1024;
    bf16_t* proj = (bf16_t*)(p.ws + WS_PROJ);
    bf16_t* vtf = (bf16_t*)(p.ws + WS_VTF);
    float* aux = (float*)(p.ws + WS_AUX);
    const float* qg = p.in[3] + l * 64; const float* kg = p.in[4] + l * 64;
    for (int round = 0;; ++round) {
        int tm, tn;
        if (gridDim.x == 512) {
            if (round >= 7) break;
            const int x = blockIdx.x & 7, loc = blockIdx.x >> 3; int tml;
            if (round < 6) { tn = (round >> 1) * 8 + (loc & 7); tml = (round & 1) * 8 + (loc >> 3); }
            else { tn = 24 + (loc & 3); tml = loc >> 2; }
            tm = tml * 8 + x;
        } else if (!xcd_item(round, NTOK / 128, NINP / 128, tm, tn)) break;
        const bool vt = (tn >= 6 && tn < 9) || tn == 23 || tn == 24;
        f32x4 acc[4][4];
        {
            auto rw = [&](int r) { return wt + pl_off(tn * 128 + r, 0, 1024); };
            auto rt_ = [&](int r) { return hn + pl_off(tm * 128 + r, 0, 1024); };
            if (vt) gemm_core(rt_, rw, 1024, lds, acc, gvar); else gemm_core(rw, rt_, 1024, lds, acc, gvar);
        }
        if (gvar != 0 && acc[0][0][0] != 123456.789f) continue;
        if (tn == 27) {
#pragma unroll
            for (int n = 0; n < 4; ++n) {
                int t = tm * 128 + wy * 64 + n * 16 + fr;
#pragma unroll
                for (int m = 0; m < 4; ++m) {
                    int c = wx * 64 + m * 16 + 4 * fg;
                    if (c < 64) *(float4*)(aux + (size_t)t * 64 + c) = make_float4(acc[m][n][0], acc[m][n][1], acc[m][n][2], acc[m][n][3]);
                }
            }
            continue;
        }
        RAW_BARRIER();
        if (vt) {
#pragma unroll
            for (int n = 0; n < 4; ++n)
#pragma unroll
                for (int m = 0; m < 4; ++m) ep_put<128>(lds, wy * 64 + n * 16 + fr, wx * 64 + m * 16 + 4 * fg, acc[m][n][0], acc[m][n][1], acc[m][n][2], acc[m][n][3]);
            RAW_BARRIER();
            const bool fox = tn < 9;
            bf16_t* dstb = fox ? vtf : (bf16_t*)(p.ws + WS_SCR + SCR_LVT); const int nh = fox ? H_FOX : H_GLA;
            const int t0 = tm * 128, b = t0 / SEQ, s0 = t0 % SEQ, chb = tn * 128 - (fox ? NC_FV : NC_LV);
            ep_flush<128>(lds, tid, [&](int row, int c8) { const int ch = chb + row; return dstb + ((size_t)(b * nh + (ch >> 6)) * 64 + (ch & 63)) * SEQ + s0 + c8 * 8; });
        } else {
            if (tn < 6) {
                const float* gn = (tn < 3) ? qg : kg; const float sc = (tn < 3) ? 0.125f * 1.4426950408889634f : 1.f;
                float g[4][4];
#pragma unroll
                for (int m = 0; m < 4; ++m)
#pragma unroll
                    for (int r = 0; r < 4; ++r) g[m][r] = gn[m * 16 + 4 * fg + r] * sc;
#pragma unroll
                for (int n = 0; n < 4; ++n) {
                    float ss = 0.f;
#pragma unroll
                    for (int m = 0; m < 4; ++m)
#pragma unroll
                        for (int r = 0; r < 4; ++r) ss += acc[m][n][r] * acc[m][n][r];
                    ss += __shfl_xor(ss, 16, 64); ss += __shfl_xor(ss, 32, 64);
                    float rs = rsqrtf(ss * (1.f / 64.f) + 1e-6f);
#pragma unroll
                    for (int m = 0; m < 4; ++m)
                        ep_put<128>(lds, wy * 64 + n * 16 + fr, wx * 64 + m * 16 + 4 * fg, acc[m][n][0] * rs * g[m][0], acc[m][n][1] * rs * g[m][1], acc[m][n][2] * rs * g[m][2], acc[m][n][3] * rs * g[m][3]);
                }
            } else {
                const bool do_silu = (tn >= 18 && tn < 21) || (tn >= 25);
                const float sc = (tn == 21) ? 0.17677669529663687f : 1.f;
#pragma unroll
                for (int n = 0; n < 4; ++n)
#pragma unroll
                    for (int m = 0; m < 4; ++m) {
                        float v0 = acc[m][n][0] * sc, v1 = acc[m][n][1] * sc, v2 = acc[m][n][2] * sc, v3 = acc[m][n][3] * sc;
                        if (do_silu) { v0 = siluf_(v0); v1 = siluf_(v1); v2 = siluf_(v2); v3 = siluf_(v3); }
                        ep_put<128>(lds, wy * 64 + n * 16 + fr, wx * 64 + m * 16 + 4 * fg, v0, v1, v2, v3);
                    }
            }
            RAW_BARRIER();
            bf16_t* dstb = proj + (size_t)(tm * 128) * NPROJ + tn * 128;
            ep_flush<128>(lds, tid, [&](int row, int c8) { return dstb + (size_t)row * NPROJ + c8 * 8; });
        }
    }
}

__device__ void phase_outproj(const Params& p, int l, bf16_t* lds) {
    const int tid = ltid(), lane = tid & 63, w = tid >> 6, wx = w >> 1, wy = w & 1, fr = lane & 15, fg = lane >> 4;
    const bf16_t* mix = (const bf16_t*)(p.ws + WS_MIX);
    const bf16_t* wt = (const bf16_t*)(p.ws + WS_WOUT) + (size_t)l * 1024 * 1024;
    const float* xin = (l == 0) ? p.in[0] : p.out;
    float* xo = p.out;
    for (int round = 0;; ++round) {
        int tm, tn;
        if (gridDim.x == 512) {
            if (round >= 2) break;
            const int x = blockIdx.x & 7, loc = blockIdx.x >> 3;
            tn = loc & 7; tm = (round * 8 + (loc >> 3)) * 8 + x;
        } else if (!xcd_item(round, NTOK / 128, 8, tm, tn)) break;
        f32x4 acc[4][4];
        {
            auto rw = [&](int r) { return wt + pl_off(tn * 128 + r, 0, 1024); };
            auto rt_ = [&](int r) { return mix + pl_off(tm * 128 + r, 0, 1024); };
            gemm_core(rw, rt_, 1024, lds, acc);
        }
#pragma unroll
        for (int n = 0; n < 4; ++n) {
            int t = tm * 128 + wy * 64 + n * 16 + fr;
#pragma unroll
            for (int m = 0; m < 4; ++m) {
                int c = tn * 128 + wx * 64 + m * 16 + 4 * fg;
                float4 xv = *(const float4*)(xin + (size_t)t * 1024 + c);
                xv.x += acc[m][n][0]; xv.y += acc[m][n][1]; xv.z += acc[m][n][2]; xv.w += acc[m][n][3];
                *(float4*)(xo + (size_t)t * 1024 + c) = xv;
            }
        }
    }
}

__device__ void phase_route(const Params& p, int l, bf16_t* lds, int dry = 0) {
    const int tid = ltid(), lane = tid & 63, w = tid >> 6, fr = lane & 15, fg = lane >> 4;
    const float* x1 = p.out;
    const float* gain = p.in[15] + l * 1024;
    bf16_t* hn = dry ? (bf16_t*)(p.ws + WS_SCR) : (bf16_t*)(p.ws + WS_HN);
    const bf16_t* wr = (const bf16_t*)(p.ws + WS_WR) + (size_t)l * 64 * 1024;
    const float* brg = p.in[17] + l * 4; const float* bre = p.in[19] + l * 32;
    unsigned* cnt = (unsigned*)(p.ws + WS_CTL) + CW_CNT + l * 32 * CNT_STRIDE;
    int* rowtok = (int*)(p.ws + WS_ROWTOK);
    int* tslot = (int*)(p.ws + WS_TSLOT);
    float* tgate = (float*)(p.ws + WS_TGATE);
    const int HL = 1032;
    float* red = (float*)(lds + 16 * HL);
    for (int it = blockIdx.x; it < NTOK / 16; it += gridDim.x) {
        __syncthreads();
        f32x4 xin4[4][4];
#pragma unroll
        for (int rr = 0; rr < 4; ++rr) {
            const float* xr = x1 + (size_t)(it * 16 + w * 4 + rr) * 1024 + lane * 16;
#pragma unroll
            for (int i = 0; i < 4; ++i) xin4[rr][i] = *(const f32x4*)(xr + 4 * i);
        }
#pragma unroll
        for (int rr = 0; rr < 4; ++rr) {
            int lr = w * 4 + rr; int t = it * 16 + lr;
            float v[16]; float ss = 0.f;
#pragma unroll
            for (int i = 0; i < 4; ++i) { v[4 * i] = xin4[rr][i][0]; v[4 * i + 1] = xin4[rr][i][1]; v[4 * i + 2] = xin4[rr][i][2]; v[4 * i + 3] = xin4[rr][i][3]; }
#pragma unroll
            for (int i = 0; i < 16; ++i) ss += v[i] * v[i];
            ss = wave_sum(ss);
            float r = rsqrtf(ss / D_MODEL + 1e-6f);
#pragma unroll
            for (int i = 0; i < 16; ++i) v[i] = v[i] * r * gain[lane * 16 + i];
            uint4 o0, o1;
            o0.x = pk_bf16(v[0], v[1]); o0.y = pk_bf16(v[2], v[3]); o0.z = pk_bf16(v[4], v[5]); o0.w = pk_bf16(v[6], v[7]);
            o1.x = pk_bf16(v[8], v[9]); o1.y = pk_bf16(v[10], v[11]); o1.z = pk_bf16(v[12], v[13]); o1.w = pk_bf16(v[14], v[15]);
            bf16_t* hr = hn + pl_off(t, lane * 16, 1024);
            *(uint4*)hr = o0; *(uint4*)(hr + 8) = o1;
            *(uint4*)(lds + lr * HL + lane * 16) = o0; *(uint4*)(lds + lr * HL + lane * 16 + 8) = o1;
        }
        __syncthreads();
        f32x4 acc[3];
#pragma unroll
        for (int n = 0; n < 3; ++n) acc[n] = (f32x4){0.f, 0.f, 0.f, 0.f};
#pragma unroll
        for (int ks = 0; ks < 8; ++ks) {
            int k = w * 256 + ks * 32 + fg * 8;
            bf16x8 a = *(const bf16x8*)(lds + fr * HL + k);
#pragma unroll
            for (int n = 0; n < 3; ++n) {
                bf16x8 b = *(const bf16x8*)(wr + (size_t)(n * 16 + fr) * 1024 + k);
                acc[n] = __builtin_amdgcn_mfma_f32_16x16x32_bf16(a, b, acc[n], 0, 0, 0);
            }
        }
#pragma unroll
        for (int n = 0; n < 3; ++n) *(f32x4*)(red + ((w * 3 + n) * 64 + lane) * 4) = acc[n];
        __syncthreads();
        if (tid < 16) {
            float lg[36];
#pragma unroll
            for (int j = 0; j < 36; ++j) {
                int n = j >> 4, f = j & 15; int ln = (tid >> 2) * 16 + f; float s = 0.f;
#pragma unroll
                for (int ww = 0; ww < 4; ++ww) s += red[((ww * 3 + n) * 64 + ln) * 4 + (tid & 3)];
                lg[j] = s;
            }
            float gl[4]; float gm = -1e30f; int gi = 0;
#pragma unroll
            for (int j = 0; j < 4; ++j) { gl[j] = lg[j] + brg[j]; if (gl[j] > gm) { gm = gl[j]; gi = j; } }
            float gs = 0.f;
#pragma unroll
            for (int j = 0; j < 4; ++j) gs += __expf(gl[j] - gm);
            float gp = 1.f / gs;
            float el[8]; float em = -1e30f;
#pragma unroll
            for (int j = 0; j < 8; ++j) {
                float v = (gi == 0) ? lg[4 + j] : (gi == 1) ? lg[12 + j] : (gi == 2) ? lg[20 + j] : lg[28 + j];
                el[j] = v + bre[gi * 8 + j]; em = fmaxf(em, el[j]);
            }
#pragma unroll
            for (int j = 0; j < 8; ++j) el[j] = __expf(el[j] - em);
            float v0 = -1.f, v1 = -1.f; int i0 = 0, i1 = 0;
#pragma unroll
            for (int j = 0; j < 8; ++j) {
                float v = el[j];
                if (v > v0) { v1 = v0; i1 = i0; v0 = v; i0 = j; }
                else if (v > v1) { v1 = v; i1 = j; }
            }
            int t = it * 16 + tid;
            int e0 = gi * 8 + i0, e1 = gi * 8 + i1;
            if (!dry) {
            unsigned s0 = atomicAdd(&cnt[e0 * CNT_STRIDE], 1u), s1 = atomicAdd(&cnt[e1 * CNT_STRIDE], 1u);
            rowtok[(size_t)e0 * NTOK + s0] = t; rowtok[(size_t)e1 * NTOK + s1] = t;
            tslot[t * 2] = (e0 << 16) | (int)s0; tslot[t * 2 + 1] = (e1 << 16) | (int)s1;
            tgate[t * 2] = gp * v0 / (v0 + v1); tgate[t * 2 + 1] = gp * v1 / (v0 + v1);
            } else if (gp * v0 == 123.456f) tgate[0] = v1;
        }
    }
}

__device__ __forceinline__ void moe_tables(const unsigned* cnt, int* tab) {
    if (threadIdx.x == 0) {
        int a = 0;
        for (int e = 0; e < 32; ++e) { tab[e] = a; tab[40 + e] = a * 128; a += ((int)ld_u32_agent(cnt + e * CNT_STRIDE) + 127) >> 7; }
        tab[32] = a; tab[72] = a * 128;
    }
    __syncthreads();
}
template <int MODE>
__device__ void phase_expert(const Params& p, int l, bf16_t* lds) {
    const int tid = ltid(), lane = tid & 63, w = tid >> 6, wx = w >> 1, wy = w & 1, fr = lane & 15, fg = lane >> 4;
    const unsigned* cnt = (const unsigned*)(p.ws + WS_CTL) + CW_CNT + l * 32 * CNT_STRIDE;
    int* tab = (int*)(lds + 4 * GSTAGE);
    moe_tables(cnt, tab);
    const int* rowtok = (const int*)(p.ws + WS_ROWTOK);
    const bf16_t* hn = (const bf16_t*)(p.ws + WS_HN);
    bf16_t* Hb = (bf16_t*)(p.ws + WS_H);
    bf16_t* Yb = (bf16_t*)(p.ws + WS_Y);
    const int x = blockIdx.x & 7, loc = blockIdx.x >> 3, nloc = gridDim.x >> 3;
    for (int j = loc;; j += nloc) {
        int e = -1, rt = 0, tn = 0; int jj = j;
#pragma unroll
        for (int q = 0; q < 4; ++q) {
            int ee = q * 8 + x; int nrt = tab[ee + 1] - tab[ee];
            if (e < 0) { if (jj < nrt * 8) { e = ee; tn = jj / nrt; rt = jj % nrt; } else jj -= nrt * 8; }
        }
        if (e < 0) break;
        const int c_e = (int)ld_u32_agent(cnt + e * CNT_STRIDE); const int hrow0 = tab[40 + e] + rt * 128;
        f32x4 acc[4][4];
        if (MODE == 0) {
            const bf16_t* wbase = (const bf16_t*)(p.ws + WS_WGU) + ((size_t)l * 32 + e) * 1024 * 1024;
            const int* rtk = rowtok + (size_t)e * NTOK + rt * 128; const int nval = c_e - rt * 128;
            auto rw = [&](int r) { return wbase + pl_off(tn * 128 + r, 0, 1024); };
            auto rt_ = [&](int r) { int t = (r < nval) ? rtk[r] : 0; return hn + pl_off(t, 0, 1024); };
            gemm_core(rw, rt_, 1024, lds, acc);
        } else {
            const bf16_t* wbase = (const bf16_t*)(p.ws + WS_WD) + ((size_t)l * 32 + e) * 1024 * 512;
            auto rw = [&](int r) { return wbase + pl_off(tn * 128 + r, 0, 512); };
            auto rt_ = [&](int r) { return Hb + pl_off(hrow0 + r, 0, 512); };
            gemm_core(rw, rt_, 512, lds, acc);
        }
        RAW_BARRIER();
        if (MODE == 0) {
#pragma unroll
            for (int n = 0; n < 4; ++n)
#pragma unroll
                for (int m = 0; m < 2; ++m)
                    ep_put<64>(lds, wy * 64 + n * 16 + fr, wx * 32 + m * 16 + 4 * fg, siluf_(acc[m][n][0]) * acc[m + 2][n][0], siluf_(acc[m][n][1]) * acc[m + 2][n][1],
                               siluf_(acc[m][n][2]) * acc[m + 2][n][2], siluf_(acc[m][n][3]) * acc[m + 2][n][3]);
            RAW_BARRIER();
            ep_flush<64>(lds, tid, [&](int row, int c8) { return Hb + pl_off(hrow0 + row, tn * 64 + c8 * 8, 512); });
        } else {
#pragma unroll
            for (int n = 0; n < 4; ++n)
#pragma unroll
                for (int m = 0; m < 4; ++m) ep_put<128>(lds, wy * 64 + n * 16 + fr, wx * 64 + m * 16 + 4 * fg, acc[m][n][0], acc[m][n][1], acc[m][n][2], acc[m][n][3]);
            RAW_BARRIER();
            bf16_t* dstb = Yb + (size_t)hrow0 * 1024 + tn * 128;
            ep_flush<128>(lds, tid, [&](int row, int c8) { return dstb + (size_t)row * 1024 + c8 * 8; });
        }
    }
}

__device__ void phase_combine(const Params& p, int l, int dry = 0) {
    const int tid = ltid(), lane = tid & 63, w = tid >> 6;
    const unsigned* cnt = (const unsigned*)(p.ws + WS_CTL) + CW_CNT + l * 32 * CNT_STRIDE;
    int c = (lane < 32) ? (((int)ld_u32_agent(cnt + (lane & 31) * CNT_STRIDE) + 127) >> 7) * 128 : 0;
    int incl = c;
#pragma unroll
    for (int o = 1; o < 32; o <<= 1) { int v = __shfl_up(incl, o, 64); if (lane >= o) incl += v; }
    int hoff = incl - c;
    const int* tslot = (const int*)(p.ws + WS_TSLOT);
    const float* tgate = (const float*)(p.ws + WS_TGATE);
    const bf16_t* Yb = (const bf16_t*)(p.ws + WS_Y);
    bf16_t* hn = dry ? (bf16_t*)(p.ws + WS_SCR + (size_t)40 * 1024 * 1024) : (bf16_t*)(p.ws + WS_HN);
    float* x = p.out; float* xw = dry ? (float*)(p.ws + WS_SCR) : p.out;
    const float* gain = (l == 0 || dry) ? p.in[1] + 1024 : nullptr;
    for (int it = blockIdx.x; it < NTOK / 4; it += gridDim.x) {
        int t = it * 4 + w;
        int ts0 = tslot[t * 2], ts1 = tslot[t * 2 + 1];
        float g0 = tgate[t * 2], g1 = tgate[t * 2 + 1];
        int r0 = __shfl(hoff, ts0 >> 16, 64) + (ts0 & 0xffff);
        int r1 = __shfl(hoff, ts1 >> 16, 64) + (ts1 & 0xffff);
        float* xr = x + (size_t)t * 1024 + lane * 16;
        const bf16_t* y0 = Yb + (size_t)r0 * 1024 + lane * 16;
        const bf16_t* y1 = Yb + (size_t)r1 * 1024 + lane * 16;
        float v[16];
#pragma unroll
        for (int i = 0; i < 4; ++i) { float4 q = *(const float4*)(xr + 4 * i); v[4 * i] = q.x; v[4 * i + 1] = q.y; v[4 * i + 2] = q.z; v[4 * i + 3] = q.w; }
        uint4 a0 = *(const uint4*)y0, a1 = *(const uint4*)(y0 + 8), b0 = *(const uint4*)y1, b1 = *(const uint4*)(y1 + 8);
        unsigned ya[8] = {a0.x, a0.y, a0.z, a0.w, a1.x, a1.y, a1.z, a1.w};
        unsigned yb[8] = {b0.x, b0.y, b0.z, b0.w, b1.x, b1.y, b1.z, b1.w};
#pragma unroll
        for (int i = 0; i < 8; ++i) {
            v[2 * i] += g0 * bflo(ya[i]) + g1 * bflo(yb[i]);
            v[2 * i + 1] += g0 * bfhi(ya[i]) + g1 * bfhi(yb[i]);
        }
#ifdef NANMARK
#pragma unroll
        for (int i = 0; i < 16; ++i) if (!(fabsf(v[i]) < 1e30f)) v[i] = 1000.f;
#endif
#pragma unroll
        for (int i = 0; i < 4; ++i) *(float4*)(xw + (size_t)t * 1024 + lane * 16 + 4 * i) = make_float4(v[4 * i], v[4 * i + 1], v[4 * i + 2], v[4 * i + 3]);
        if (gain) {
            float ss = 0.f;
#pragma unroll
            for (int i = 0; i < 16; ++i) ss += v[i] * v[i];
            ss = wave_sum(ss);
            float r = rsqrtf(ss / D_MODEL + 1e-6f);
#pragma unroll
            for (int i = 0; i < 16; ++i) v[i] = v[i] * r * gain[lane * 16 + i];
            uint4 o0, o1;
            o0.x = pk_bf16(v[0], v[1]); o0.y = pk_bf16(v[2], v[3]); o0.z = pk_bf16(v[4], v[5]); o0.w = pk_bf16(v[6], v[7]);
            o1.x = pk_bf16(v[8], v[9]); o1.y = pk_bf16(v[10], v[11]); o1.z = pk_bf16(v[12], v[13]); o1.w = pk_bf16(v[14], v[15]);
            bf16_t* hr = hn + pl_off(t, lane * 16, 1024);
            *(uint4*)hr = o0; *(uint4*)(hr + 8) = o1;
        }
    }
}


__device__ __forceinline__ void mm_row(const bf16_t* RA, const bf16_t* RB, int mw, int fr, int fg, f32x4 (&acc)[4]) {
#pragma unroll
    for (int ks = 0; ks < 2; ++ks) {
        bf16x8 a = *(const bf16x8*)(RA + (16 * mw + fr) * LROW + ks * 32 + fg * 8);
#pragma unroll
        for (int nt = 0; nt < 4; ++nt) {
            bf16x8 b = *(const bf16x8*)(RB + (16 * nt + fr) * LROW + ks * 32 + fg * 8);
            acc[nt] = __builtin_amdgcn_mfma_f32_16x16x32_bf16(a, b, acc[nt], 0, 0, 0);
        }
    }
}
__device__ __forceinline__ void mm_col(const bf16_t* RA, const bf16_t* RB, int nw, int fr, int fg, f32x4 (&acc)[4]) {
#pragma unroll
    for (int ks = 0; ks < 2; ++ks) {
        bf16x8 b = *(const bf16x8*)(RB + (16 * nw + fr) * LROW + ks * 32 + fg * 8);
#pragma unroll
        for (int mt = 0; mt < 4; ++mt) {
            bf16x8 a = *(const bf16x8*)(RA + (16 * mt + fr) * LROW + ks * 32 + fg * 8);
            acc[mt] = __builtin_amdgcn_mfma_f32_16x16x32_bf16(a, b, acc[mt], 0, 0, 0);
        }
    }
}
__device__ __forceinline__ void zero4(f32x4 (&a)[4]) {
#pragma unroll
    for (int i = 0; i < 4; ++i) a[i] = (f32x4){0.f, 0.f, 0.f, 0.f};
}
__device__ __forceinline__ void st4_lds(bf16_t* p, float a, float b, float c, float d) { uint2 o; o.x = pk_bf16(a, b); o.y = pk_bf16(c, d); *(uint2*)p = o; }
__device__ __forceinline__ bf16_t f2bf(float v) { return (bf16_t)(pk_bf16(v, 0.f) & 0xffffu); }

__device__ void gdn_prep_item(const Params& p, int l, int cid, unsigned char* lds_raw) {
    const int tid = ltid(), lane = tid & 63, w = tid >> 6, fr = lane & 15, fg = lane >> 4;
    const int bh = cid >> 6, n = cid & 63, b = bh / H_GDN, h = bh % H_GDN;
    const int t0 = b * SEQ + n * 64;
    bf16_t* L0 = (bf16_t*)lds_raw; bf16_t* L1 = L0 + 64 * LROW; bf16_t* L2 = L1 + 64 * LROW; bf16_t* L3 = L2 + 64 * LROW; bf16_t* L4 = L3 + 64 * LROW; bf16_t* L5 = L4 + 64 * LROW;
    float* dec = (float*)(L5 + 64 * LROW); float* beta = dec + 64;
    const bf16_t* proj = (const bf16_t*)(p.ws + WS_PROJ);
    const float* aux = (const float*)(p.ws + WS_AUX);
    const float* convw = p.in[7] + (size_t)l * 4 * 1152;
    __syncthreads();
    const int i = tid >> 2, c0 = (tid & 3) * 16;
    float qv[16], kv[16], vv[16];
#pragma unroll
    for (int which = 0; which < 3; ++which) {
        float acc[16];
#pragma unroll
        for (int c = 0; c < 16; ++c) acc[c] = 0.f;
#pragma unroll
        for (int tap = 0; tap < 4; ++tap) {
            const int row = i - 3 + tap;
            if (n * 64 + row >= 0) {
                const bf16_t* xp = proj + (size_t)(t0 + row) * NPROJ + NC_GQ + which * 384 + h * 64 + c0;
                u32x4 x0 = *(const u32x4*)xp, x1 = *(const u32x4*)(xp + 8);
                const float* wp = convw + tap * 1152 + which * 384 + h * 64 + c0;
                f32x4 w0 = *(const f32x4*)wp, w1 = *(const f32x4*)(wp + 4), w2 = *(const f32x4*)(wp + 8), w3 = *(const f32x4*)(wp + 12);
                float wv[16] = {w0[0], w0[1], w0[2], w0[3], w1[0], w1[1], w1[2], w1[3], w2[0], w2[1], w2[2], w2[3], w3[0], w3[1], w3[2], w3[3]};
                unsigned xs[8] = {x0[0], x0[1], x0[2], x0[3], x1[0], x1[1], x1[2], x1[3]};
#pragma unroll
                for (int c = 0; c < 8; ++c) { acc[2 * c] += wv[2 * c] * bflo(xs[c]); acc[2 * c + 1] += wv[2 * c + 1] * bfhi(xs[c]); }
            }
        }
        float ss = 0.f;
#pragma unroll
        for (int c = 0; c < 16; ++c) { acc[c] = siluf_(acc[c]); ss += acc[c] * acc[c]; }
        if (which < 2) {
            ss += __shfl_xor(ss, 1, 64); ss += __shfl_xor(ss, 2, 64);
            const float sc = rsqrtf(ss + 1e-6f) * (which == 0 ? 0.125f : 1.f);
#pragma unroll
            for (int c = 0; c < 16; ++c) acc[c] *= sc;
        }
#pragma unroll
        for (int c = 0; c < 16; ++c) { if (which == 0) qv[c] = acc[c]; else if (which == 1) kv[c] = acc[c]; else vv[c] = acc[c]; }
    }
#pragma unroll
    for (int c = 0; c < 16; c += 4) { st4_lds(L2 + i * LROW + c0 + c, kv[c], kv[c + 1], kv[c + 2], kv[c + 3]); st4_lds(L3 + i * LROW + c0 + c, qv[c], qv[c + 1], qv[c + 2], qv[c + 3]); }
    if (w == 0) {
        const float a = aux[(size_t)(t0 + lane) * 64 + AX_GA + h], bl = aux[(size_t)(t0 + lane) * 64 + AX_GB + h];
        const float g = -__expf(p.in[8][l * H_GDN + h]) * softplusf_(a + p.in[9][l * H_GDN + h]);
        float inc = g;
#pragma unroll
        for (int o = 1; o < 64; o <<= 1) { float t = __shfl_up(inc, o, 64); if (lane >= o) inc += t; }
        dec[lane] = inc; beta[lane] = sigmoidf_(bl);
    }
    __syncthreads();
    {
        f32x4 g4[4]; zero4(g4);
        mm_row(L2, L2, w, fr, fg, g4);
#pragma unroll
        for (int nt = 0; nt < 4; ++nt) {
            const int kap = 16 * nt + fr; const float dk_ = dec[kap], bk_ = beta[kap];
            float nT[4], nN[4], tt[4];
#pragma unroll
            for (int r = 0; r < 4; ++r) {
                const int rho = 16 * w + 4 * fg + r; const float dr_ = dec[rho], br_ = beta[rho];
                const float G = g4[nt][r];
                nT[r] = (kap < rho) ? br_ * G * __expf(dr_ - dk_) : 0.f;
                nN[r] = (rho < kap) ? bk_ * G * __expf(dk_ - dr_) : 0.f;
                tt[r] = ((kap == rho) ? 1.f : 0.f) - nN[r];
            }
            st4_lds(L1 + kap * LROW + 16 * w + 4 * fg, nT[0], nT[1], nT[2], nT[3]);
            st4_lds(L0 + kap * LROW + 16 * w + 4 * fg, nN[0], nN[1], nN[2], nN[3]);
            st4_lds(L4 + kap * LROW + 16 * w + 4 * fg, tt[0], tt[1], tt[2], tt[3]);
        }
        f32x4 a4[4]; zero4(a4);
        mm_row(L2, L3, w, fr, fg, a4);
#pragma unroll
        for (int nt = 0; nt < 4; ++nt) {
            const int ii = 16 * nt + fr; const float di_ = dec[ii];
            float v4[4];
#pragma unroll
            for (int r = 0; r < 4; ++r) { const int j = 16 * w + 4 * fg + r; v4[r] = (j <= ii) ? a4[nt][r] * __expf(di_ - dec[j]) : 0.f; }
            st4_lds(L5 + ii * LROW + 16 * w + 4 * fg, v4[0], v4[1], v4[2], v4[3]);
        }
    }
    __syncthreads();
#pragma unroll
    for (int lev = 1; lev <= 5; ++lev) {
        const bf16_t* XA = (lev & 1) ? L0 : L2; const bf16_t* XAt = (lev & 1) ? L1 : L3;
        bf16_t* XB = (lev & 1) ? L2 : L0; bf16_t* XBt = (lev & 1) ? L3 : L1;
        {
            f32x4 x4[4]; zero4(x4);
            mm_row(XA, XAt, w, fr, fg, x4);
#pragma unroll
            for (int nt = 0; nt < 4; ++nt) {
                const int c = 16 * nt + fr;
                st4_lds(XBt + c * LROW + 16 * w + 4 * fg, x4[nt][0], x4[nt][1], x4[nt][2], x4[nt][3]);
                if (lev < 5) {
#pragma unroll
                    for (int r = 0; r < 4; ++r) XB[(16 * w + 4 * fg + r) * LROW + c] = f2bf(x4[nt][r]);
                }
            }
        }
        __syncthreads();
        {
            f32x4 t4[4];
#pragma unroll
            for (int mt = 0; mt < 4; ++mt) {
                uint2 u = *(const uint2*)(L4 + (16 * w + fr) * LROW + 16 * mt + 4 * fg);
                t4[mt] = (f32x4){bflo(u.x), bfhi(u.x), bflo(u.y), bfhi(u.y)};
            }
            mm_col(XBt, L4, w, fr, fg, t4);
#pragma unroll
            for (int mt = 0; mt < 4; ++mt) st4_lds(L4 + (16 * w + fr) * LROW + 16 * mt + 4 * fg, t4[mt][0], t4[mt][1], t4[mt][2], t4[mt][3]);
        }
    }
    {
        const float dj = dec[i], bj = beta[i], dlast = dec[63];
        const float s1 = bj * __expf(dj), s2 = bj, s3 = __expf(dlast - dj);
#pragma unroll
        for (int c = 0; c < 16; ++c) {
            L0[(c0 + c) * LROW + i] = f2bf(kv[c] * s1);
            L1[(c0 + c) * LROW + i] = f2bf(vv[c] * s2);
            L2[(c0 + c) * LROW + i] = f2bf(kv[c] * s3);
        }
    }
    __syncthreads();
    {
        f32x4 w4[4], u4[4]; zero4(w4); zero4(u4);
        mm_row(L4, L0, w, fr, fg, w4);
        mm_row(L4, L1, w, fr, fg, u4);
        __syncthreads();
#pragma unroll
        for (int nt = 0; nt < 4; ++nt) {
            st4_lds(L0 + (16 * nt + fr) * LROW + 16 * w + 4 * fg, w4[nt][0], w4[nt][1], w4[nt][2], w4[nt][3]);
            st4_lds(L1 + (16 * nt + fr) * LROW + 16 * w + 4 * fg, u4[nt][0], u4[nt][1], u4[nt][2], u4[nt][3]);
        }
        const float ed = __expf(dec[i]);
#pragma unroll
        for (int c = 0; c < 16; c += 4) st4_lds(L3 + i * LROW + c0 + c, qv[c] * ed, qv[c + 1] * ed, qv[c + 2] * ed, qv[c + 3] * ed);
    }
    __syncthreads();
    char* scr = p.ws + WS_SCR;
    {
        f32x4 m4[4]; zero4(m4);
        mm_row(L0, L2, w, fr, fg, m4);
        bf16_t* MP = (bf16_t*)(scr + SCR_GDN_MP) + (size_t)cid * 4096;
#pragma unroll
        for (int nt = 0; nt < 4; ++nt) store4_bf16(MP + (16 * nt + fr) * 64 + 16 * w + 4 * fg, -m4[nt][0], -m4[nt][1], -m4[nt][2], -m4[nt][3]);
        f32x4 n4[4]; zero4(n4);
        mm_row(L2, L1, w, fr, fg, n4);
        bf16_t* NN = (bf16_t*)(scr + SCR_GDN_NN) + (size_t)cid * 4096;
#pragma unroll
        for (int nt = 0; nt < 4; ++nt) store4_bf16(NN + ((nt * 4 + w) * 64 + lane) * 4, n4[nt][0], n4[nt][1], n4[nt][2], n4[nt][3]);
        f32x4 p4[4]; zero4(p4);
        mm_row(L0, L5, w, fr, fg, p4);
        bf16_t* PG = (bf16_t*)(scr + SCR_GDN_P) + (size_t)cid * 4096;
#pragma unroll
        for (int nt = 0; nt < 4; ++nt) {
            uint2 u = *(const uint2*)(L3 + (16 * nt + fr) * LROW + 16 * w + 4 * fg);
            store4_bf16(PG + (16 * nt + fr) * 64 + 16 * w + 4 * fg, bflo(u.x) - p4[nt][0], bfhi(u.x) - p4[nt][1], bflo(u.y) - p4[nt][2], bfhi(u.y) - p4[nt][3]);
        }
        f32x4 o4[4]; zero4(o4);
        mm_row(L1, L5, w, fr, fg, o4);
        bf16_t* OL = (bf16_t*)(scr + SCR_GDN_OL) + (size_t)cid * 4096;
#pragma unroll
        for (int nt = 0; nt < 4; ++nt) store4_bf16(OL + (16 * nt + fr) * 64 + 16 * w + 4 * fg, o4[nt][0], o4[nt][1], o4[nt][2], o4[nt][3]);
        if (tid == 0) ((float*)(scr + SCR_GDN_LAST))[cid] = __expf(dec[63]);
    }
}

#define SCAN_SLOT    5120
#define SCAN_SB(k)   ((bf16_t*)lds_raw + (k) * 1024)
#define SCAN_RING(k) ((bf16_t*)lds_raw + 2048 + (k) * SCAN_SLOT)
#define SCAN_LAST    ((float*)(lds_raw + 4096 + 5 * SCAN_SLOT * 2))
__device__ __forceinline__ void scan_issue(const bf16_t* const (&mp)[8], const bf16_t* nn_lane, int n, bf16_t* slot) {
#pragma unroll
    for (int q = 0; q < 8; ++q) __builtin_amdgcn_global_load_lds((const unsigned*)(mp[q] + (size_t)n * 4096), (unsigned*)(slot + q * 512), 16, 0, 0);
    __builtin_amdgcn_global_load_lds((const unsigned*)(nn_lane + (size_t)n * 4096), (unsigned*)(slot + 4096), 16, 0, 0);
    __builtin_amdgcn_global_load_lds((const unsigned*)(nn_lane + (size_t)n * 4096 + 512), (unsigned*)(slot + 4096 + 512), 16, 0, 0);
}
__device__ void gdn_scan_item(const Params& p, int item, unsigned char* lds_raw, int svar = 0) {
    const int tid = ltid(), lane = tid & 63, w = __builtin_amdgcn_readfirstlane(tid >> 6), fr = lane & 15, fg = lane >> 4;
    const int bh = item >> 2, cg = item & 3;
    char* scr = p.ws + WS_SCR;
    const bf16_t* MP = (const bf16_t*)(scr + SCR_GDN_MP) + (size_t)bh * 64 * 4096;
    const bf16_t* NN = (const bf16_t*)(scr + SCR_GDN_NN) + (size_t)bh * 64 * 4096 + cg * 1024;
    const float* LAST = (const float*)(scr + SCR_GDN_LAST) + bh * 64;
    bf16_t* SG = (bf16_t*)(scr + SCR_GDN_SG) + (size_t)bh * 64 * 4096 + cg * 1024;
    const bf16_t* mp[8];
#pragma unroll
    for (int q = 0; q < 8; ++q) { const int row = 8 * q + (lane >> 3); mp[q] = MP + row * 64 + (((lane & 7) ^ ((row >> 1) & 7)) * 8); }
    const bf16_t* nn_lane = NN + lane * 8;
    RAW_BARRIER();
    if (tid < 64) SCAN_LAST[tid] = ld_f32_agent(LAST + tid);
    asm volatile("s_waitcnt vmcnt(0)" ::: "memory");
    f32x4 S = (f32x4){0.f, 0.f, 0.f, 0.f};
    const int swz = (fr >> 1) & 7;
    if (w == 0) {
#pragma unroll
        for (int n = 0; n < 4; ++n) scan_issue(mp, nn_lane, n, SCAN_RING(n));
    }
    for (int n = 0; n < 64; ++n) {
        bf16_t* sb = SCAN_SB(n & 1);
        const bf16_t* ring = SCAN_RING(n % 5);
        {
            const int c = 2 * w + (fg >> 1);
            uint2 o; o.x = pk_bf16(S[0], S[1]); o.y = pk_bf16(S[2], S[3]);
            *(uint2*)(sb + fr * 64 + ((c ^ swz) * 8) + 4 * (fg & 1)) = o;
        }
        if (w == 0) {
            if (n + 3 < 64) asm volatile("s_waitcnt vmcnt(30)" ::: "memory");
            else if (n + 2 < 64) asm volatile("s_waitcnt vmcnt(20)" ::: "memory");
            else if (n + 1 < 64) asm volatile("s_waitcnt vmcnt(10)" ::: "memory");
            else asm volatile("s_waitcnt vmcnt(0)" ::: "memory");
        }
        RAW_BARRIER();
        if (w == 0 && n + 4 < 64 && svar != 2) scan_issue(mp, nn_lane, n + 4, SCAN_RING((n + 4) % 5));
        const float last = SCAN_LAST[n];
        {
            u32x2 nn = *(const u32x2*)(ring + 4096 + (w * 64 + lane) * 4);
            S[0] = last * S[0] + bflo(nn[0]); S[1] = last * S[1] + bfhi(nn[0]);
            S[2] = last * S[2] + bflo(nn[1]); S[3] = last * S[3] + bfhi(nn[1]);
        }
#pragma unroll
        for (int ks = 0; ks < 2; ++ks) {
            const int co = ((ks * 4 + fg) ^ swz) * 8;
            bf16x8 a = *(const bf16x8*)(ring + (16 * w + fr) * 64 + co);
            bf16x8 s = *(const bf16x8*)(sb + fr * 64 + co);
            S = __builtin_amdgcn_mfma_f32_16x16x32_bf16(a, s, S, 0, 0, 0);
        }
        if (w >= 2 && svar != 1) {
            const int c = (w - 2) * 64 + lane; const int row = c >> 3, pc = c & 7;
            u32x4 v = *(const u32x4*)(sb + row * 64 + pc * 8);
            *(u32x4*)(SG + (size_t)n * 4096 + row * 64 + ((pc ^ ((row >> 1) & 7)) * 8)) = v;
        }
    }
}

__device__ void gdn_out_item(const Params& p, int l, int cid) {
    const int tid = ltid(), lane = tid & 63, w = tid >> 6, fr = lane & 15, fg = lane >> 4;
    const int bh = cid >> 6, n = cid & 63, b = bh / H_GDN, h = bh % H_GDN;
    char* scr = p.ws + WS_SCR;
    const bf16_t* SG = (const bf16_t*)(scr + SCR_GDN_SG) + (size_t)cid * 4096;
    const bf16_t* PG = (const bf16_t*)(scr + SCR_GDN_P) + (size_t)cid * 4096;
    const bf16_t* OL = (const bf16_t*)(scr + SCR_GDN_OL) + (size_t)cid * 4096;
    const int i = 16 * w + fr; const int t = b * SEQ + n * 64 + i;
    f32x4 acc[4];
#pragma unroll
    for (int mt = 0; mt < 4; ++mt) { uint2 u = *(const uint2*)(OL + i * 64 + 16 * mt + 4 * fg); acc[mt] = (f32x4){bflo(u.x), bfhi(u.x), bflo(u.y), bfhi(u.y)}; }
#pragma unroll
    for (int ks = 0; ks < 2; ++ks) {
        bf16x8 bq = *(const bf16x8*)(PG + i * 64 + ks * 32 + fg * 8);
#pragma unroll
        for (int mt = 0; mt < 4; ++mt) {
            bf16x8 a = *(const bf16x8*)(SG + (16 * mt + fr) * 64 + ks * 32 + fg * 8);
            acc[mt] = __builtin_amdgcn_mfma_f32_16x16x32_bf16(a, bq, acc[mt], 0, 0, 0);
        }
    }
    float ss = 0.f;
#pragma unroll
    for (int mt = 0; mt < 4; ++mt)
#pragma unroll
        for (int r = 0; r < 4; ++r) ss += acc[mt][r] * acc[mt][r];
    ss += __shfl_xor(ss, 16, 64); ss += __shfl_xor(ss, 32, 64);
    const float rstd = rsqrtf(ss * (1.f / 64.f) + 1e-6f);
    const float* og = p.in[10] + l * 64;
    const bf16_t* gp = (const bf16_t*)(p.ws + WS_PROJ) + (size_t)t * NPROJ + NC_GG + h * 64;
    bf16_t* mp = (bf16_t*)(p.ws + WS_MIX) + pl_off(t, 384 + h * 64, 1024);
#pragma unroll
    for (int mt = 0; mt < 4; ++mt) {
        const int e0 = 16 * mt + 4 * fg;
        uint2 gu = *(const uint2*)(gp + e0); f32x4 g4 = *(const f32x4*)(og + e0);
        store4_bf16(mp + e0 + (e0 & 32), acc[mt][0] * rstd * g4[0] * bflo(gu.x), acc[mt][1] * rstd * g4[1] * bfhi(gu.x), acc[mt][2] * rstd * g4[2] * bflo(gu.y), acc[mt][3] * rstd * g4[3] * bfhi(gu.y));
    }
}

#define GQROW 40
__device__ void gla_prep_item(const Params& p, int l, int cid, unsigned char* lds_raw) {
    const int tid = ltid(), lane = tid & 63, w = tid >> 6, fr = lane & 15, fg = lane >> 4;
    const int bh = cid >> 6, n = cid & 63, b = bh / H_GLA, h = bh % H_GLA;
    const int t0 = b * SEQ + n * 64;
    float* Bf = (float*)lds_raw;
    bf16_t* Qt = (bf16_t*)(lds_raw + 8448);
    bf16_t* Kt = Qt + 64 * GQROW;
    bf16_t* KLt = Kt + 64 * GQROW;
    bf16_t* Vt = KLt + 32 * LROW;
    const bf16_t* proj = (const bf16_t*)(p.ws + WS_PROJ);
    const float* aux = (const float*)(p.ws + WS_AUX);
    char* scr = p.ws + WS_SCR;
    __syncthreads();
    const int i = tid >> 2, d0 = (tid & 3) * 8;
    {
        const float* wa = p.in[11] + (size_t)l * 16 * 128 + h * 32 + d0;
        const float* ba = p.in[12] + l * 128 + h * 32 + d0;
        float acc[8];
#pragma unroll
        for (int j = 0; j < 8; ++j) acc[j] = ba[j];
        float a1v[16];
#pragma unroll
        for (int r = 0; r < 16; r += 2) { float2 t2 = *(const float2*)(aux + (size_t)(t0 + i) * 64 + AX_LA + r); a1v[r] = t2.x; a1v[r + 1] = t2.y; }
#pragma unroll
        for (int r = 0; r < 16; ++r) {
            f32x4 wA = *(const f32x4*)(wa + r * 128), wB = *(const f32x4*)(wa + r * 128 + 4);
#pragma unroll
            for (int j = 0; j < 4; ++j) { acc[j] += a1v[r] * wA[j]; acc[4 + j] += a1v[r] * wB[j]; }
        }
#pragma unroll
        for (int j = 0; j < 8; ++j) Bf[i * 33 + d0 + j] = logsigmoidf_(acc[j]) * (1.f / 16.f);
    }
    {
        const bf16_t* lvt = (const bf16_t*)(scr + SCR_LVT) + (size_t)bh * 64 * SEQ + n * 64;
#pragma unroll
        for (int ii = 0; ii < 2; ++ii) { int c = tid + 256 * ii; int row = c >> 3, kc = c & 7; *(u32x4*)(Vt + row * LROW + kc * 8) = *(const u32x4*)(lvt + (size_t)row * SEQ + kc * 8); }
    }
    __syncthreads();
#pragma unroll
    for (int c = 0; c < 8; ++c) {
        const int d = 8 * w + c;
        float inc = Bf[lane * 33 + d];
#pragma unroll
        for (int o = 1; o < 64; o <<= 1) { float t = __shfl_up(inc, o, 64); if (lane >= o) inc += t; }
        Bf[lane * 33 + d] = inc;
    }
    __syncthreads();
    {
        const bf16_t* qp = proj + (size_t)(t0 + i) * NPROJ + NC_LQ + h * 32 + d0;
        const bf16_t* kp = proj + (size_t)(t0 + i) * NPROJ + NC_LK + h * 32 + d0;
        u32x4 qu = *(const u32x4*)qp, ku = *(const u32x4*)kp;
        float qf[8] = {bflo(qu[0]), bfhi(qu[0]), bflo(qu[1]), bfhi(qu[1]), bflo(qu[2]), bfhi(qu[2]), bflo(qu[3]), bfhi(qu[3])};
        float kf[8] = {bflo(ku[0]), bfhi(ku[0]), bflo(ku[1]), bfhi(ku[1]), bflo(ku[2]), bfhi(ku[2]), bflo(ku[3]), bfhi(ku[3])};
        float qt[8], kt[8], qb[8];
#pragma unroll
        for (int j = 0; j < 8; ++j) {
            const float bi = Bf[i * 33 + d0 + j], bm = Bf[31 * 33 + d0 + j], bl = Bf[63 * 33 + d0 + j];
            qt[j] = qf[j] * __expf(bi - bm); kt[j] = kf[j] * __expf(bm - bi); qb[j] = qf[j] * __expf(bi);
            KLt[(d0 + j) * LROW + i] = f2bf(kf[j] * __expf(bl - bi));
            if (i == 63) ((float*)(scr + SCR_GLA_DL))[cid * 32 + d0 + j] = __expf(bl);
        }
        u32x4 o; o[0] = pk_bf16(qt[0], qt[1]); o[1] = pk_bf16(qt[2], qt[3]); o[2] = pk_bf16(qt[4], qt[5]); o[3] = pk_bf16(qt[6], qt[7]);
        *(u32x4*)(Qt + i * GQROW + d0) = o;
        o[0] = pk_bf16(kt[0], kt[1]); o[1] = pk_bf16(kt[2], kt[3]); o[2] = pk_bf16(kt[4], kt[5]); o[3] = pk_bf16(kt[6], kt[7]);
        *(u32x4*)(Kt + i * GQROW + d0) = o;
        o[0] = pk_bf16(qb[0], qb[1]); o[1] = pk_bf16(qb[2], qb[3]); o[2] = pk_bf16(qb[4], qb[5]); o[3] = pk_bf16(qb[6], qb[7]);
        *(u32x4*)((bf16_t*)(scr + SCR_GLA_QB) + (size_t)cid * 2048 + i * 32 + d0) = o;
    }
    __syncthreads();
    f32x4 sc[4];
    {
        bf16x8 bq = *(const bf16x8*)(Qt + (16 * w + fr) * GQROW + fg * 8);
#pragma unroll
        for (int mt = 0; mt < 4; ++mt) {
            bf16x8 a = *(const bf16x8*)(Kt + (16 * mt + fr) * GQROW + fg * 8);
            sc[mt] = __builtin_amdgcn_mfma_f32_16x16x32_bf16(a, bq, (f32x4){0.f, 0.f, 0.f, 0.f}, 0, 0, 0);
        }
        const int ii = 16 * w + fr;
#pragma unroll
        for (int mt = 0; mt < 4; ++mt)
#pragma unroll
            for (int r = 0; r < 4; ++r) { const int j = 16 * mt + 4 * fg + r; if (j > ii) sc[mt][r] = 0.f; }
    }
    {
        f32x4 o4[4]; zero4(o4);
#pragma unroll
        for (int kk = 0; kk < 2; ++kk) {
            u32x4 pb = {pk_bf16(sc[2 * kk][0], sc[2 * kk][1]), pk_bf16(sc[2 * kk][2], sc[2 * kk][3]), pk_bf16(sc[2 * kk + 1][0], sc[2 * kk + 1][1]), pk_bf16(sc[2 * kk + 1][2], sc[2 * kk + 1][3])};
#pragma unroll
            for (int mt = 0; mt < 4; ++mt) {
                uint2 v0 = *(const uint2*)(Vt + (16 * mt + fr) * LROW + 32 * kk + 4 * fg), v1 = *(const uint2*)(Vt + (16 * mt + fr) * LROW + 32 * kk + 16 + 4 * fg);
                u32x4 va = {v0.x, v0.y, v1.x, v1.y};
                o4[mt] = __builtin_amdgcn_mfma_f32_16x16x32_bf16(__builtin_bit_cast(bf16x8, va), __builtin_bit_cast(bf16x8, pb), o4[mt], 0, 0, 0);
            }
        }
        bf16_t* OL = (bf16_t*)(scr + SCR_GLA_OL) + (size_t)cid * 4096;
#pragma unroll
        for (int mt = 0; mt < 4; ++mt) store4_bf16(OL + (16 * w + fr) * 64 + 16 * mt + 4 * fg, o4[mt][0], o4[mt][1], o4[mt][2], o4[mt][3]);
    }
    {
        f32x4 k4[2] = {(f32x4){0.f, 0.f, 0.f, 0.f}, (f32x4){0.f, 0.f, 0.f, 0.f}};
#pragma unroll
        for (int ks = 0; ks < 2; ++ks) {
            bf16x8 bv = *(const bf16x8*)(Vt + (16 * w + fr) * LROW + ks * 32 + fg * 8);
#pragma unroll
            for (int mt = 0; mt < 2; ++mt) {
                bf16x8 a = *(const bf16x8*)(KLt + (16 * mt + fr) * LROW + ks * 32 + fg * 8);
                k4[mt] = __builtin_amdgcn_mfma_f32_16x16x32_bf16(a, bv, k4[mt], 0, 0, 0);
            }
        }
        float* KV = (float*)(scr + SCR_GLA_KV) + (size_t)cid * 2048;
#pragma unroll
        for (int mt = 0; mt < 2; ++mt) *(f32x4*)(KV + (16 * w + fr) * 32 + 16 * mt + 4 * fg) = k4[mt];
    }
}
__device__ void gla_scan_item(const Params& p, int g) {
    const int tid = ltid();
    const int bh = g >> 3, idx = (g & 7) * 256 + tid, d = idx & 31;
    char* scr = p.ws + WS_SCR;
    const float* __restrict__ KV = (const float*)(scr + SCR_GLA_KV) + (size_t)bh * 64 * 2048 + idx;
    const float* __restrict__ DL = (const float*)(scr + SCR_GLA_DL) + bh * 64 * 32 + d;
    bf16_t* __restrict__ SG = (bf16_t*)(scr + SCR_GLA_SG) + (size_t)bh * 64 * 2048 + idx;
    float S = 0.f;
    for (int n0 = 0; n0 < 64; n0 += 8) {
        float kv[8], dl[8];
#pragma unroll
        for (int u = 0; u < 8; ++u) { kv[u] = KV[(size_t)(n0 + u) * 2048]; dl[u] = DL[(n0 + u) * 32]; }
#pragma unroll
        for (int u = 0; u < 8; ++u) { SG[(size_t)(n0 + u) * 2048] = f2bf(S); S = dl[u] * S + kv[u]; }
    }
}
__device__ void gla_out_item(const Params& p, int l, int cid) {
    const int tid = ltid(), lane = tid & 63, w = tid >> 6, fr = lane & 15, fg = lane >> 4;
    const int bh = cid >> 6, n = cid & 63, b = bh / H_GLA, h = bh % H_GLA;
    char* scr = p.ws + WS_SCR;
    const bf16_t* SG = (const bf16_t*)(scr + SCR_GLA_SG) + (size_t)cid * 2048;
    const bf16_t* QB = (const bf16_t*)(scr + SCR_GLA_QB) + (size_t)cid * 2048;
    const bf16_t* OL = (const bf16_t*)(scr + SCR_GLA_OL) + (size_t)cid * 4096;
    const int i = 16 * w + fr; const int t = b * SEQ + n * 64 + i;
    f32x4 acc[4];
#pragma unroll
    for (int mt = 0; mt < 4; ++mt) { uint2 u = *(const uint2*)(OL + i * 64 + 16 * mt + 4 * fg); acc[mt] = (f32x4){bflo(u.x), bfhi(u.x), bflo(u.y), bfhi(u.y)}; }
    bf16x8 bq = *(const bf16x8*)(QB + i * 32 + fg * 8);
#pragma unroll
    for (int mt = 0; mt < 4; ++mt) {
        bf16x8 a = *(const bf16x8*)(SG + (16 * mt + fr) * 32 + fg * 8);
        acc[mt] = __builtin_amdgcn_mfma_f32_16x16x32_bf16(a, bq, acc[mt], 0, 0, 0);
    }
    float ss = 0.f;
#pragma unroll
    for (int mt = 0; mt < 4; ++mt)
#pragma unroll
        for (int r = 0; r < 4; ++r) ss += acc[mt][r] * acc[mt][r];
    ss += __shfl_xor(ss, 16, 64); ss += __shfl_xor(ss, 32, 64);
    const float rstd = rsqrtf(ss * (1.f / 64.f) + 1e-6f);
    const float* og = p.in[13] + l * 64;
    const bf16_t* rp = (const bf16_t*)(p.ws + WS_PROJ) + (size_t)t * NPROJ + NC_LR + h * 64;
    bf16_t* mp = (bf16_t*)(p.ws + WS_MIX) + pl_off(t, 768 + h * 64, 1024);
#pragma unroll
    for (int mt = 0; mt < 4; ++mt) {
        const int e0 = 16 * mt + 4 * fg;
        uint2 gu = *(const uint2*)(rp + e0); f32x4 g4 = *(const f32x4*)(og + e0);
        store4_bf16(mp + e0 + (e0 & 32), acc[mt][0] * rstd * g4[0] * bflo(gu.x), acc[mt][1] * rstd * g4[1] * bfhi(gu.x), acc[mt][2] * rstd * g4[2] * bflo(gu.y), acc[mt][3] * rstd * g4[3] * bfhi(gu.y));
    }
}
__device__ void phase_mixout(const Params& p, int l) {
    for (int it = blockIdx.x; it < NGDN_CH + NGLA_CH; it += gridDim.x) {
        if (it < NGDN_CH) { if (MIXSEL & 1) gdn_out_item(p, l, it); } else { if (MIXSEL & 2) gla_out_item(p, l, it - NGDN_CH); }
    }
}

__device__ void fox_cumsum_item(const Params& p, int l, int bh, float* ldsf) {
    const int tid = ltid(), lane = tid & 63, w = tid >> 6;
    const int b = bh / H_FOX, h = bh % H_FOX;
    const float* aux = (const float*)(p.ws + WS_AUX);
    float* cum = (float*)(p.ws + WS_CUM) + (size_t)bh * SEQ;
    const float fb = p.in[5][l * H_FOX + h];
    float v[16]; float s = 0.f;
#pragma unroll
    for (int i = 0; i < 16; ++i) { v[i] = logsigmoidf_(aux[(size_t)(b * SEQ + tid * 16 + i) * 64 + AX_FF + h] + fb); s += v[i]; }
    float inc = s;
#pragma unroll
    for (int o = 1; o < 64; o <<= 1) { float t = __shfl_up(inc, o, 64); if (lane >= o) inc += t; }
    __syncthreads();
    if (lane == 63) ldsf[w] = inc;
    __syncthreads();
    float base = inc - s;
    for (int ww = 0; ww < w; ++ww) base += ldsf[ww];
    float c = base;
    u32x4* csx = (u32x4*)(p.ws + WS_SCR + SCR_CSX) + (size_t)bh * SEQ;
#pragma unroll
    for (int i = 0; i < 16; ++i) {
        c += v[i]; cum[tid * 16 + i] = c;
        const float vv = 1.4426950408889634f * c;
        const unsigned hi = pk_bf16(vv, 0.f) & 0xffffu; const float r1 = vv - __uint_as_float(hi << 16);
        const unsigned mid = pk_bf16(r1, 0.f) & 0xffffu; const float r2 = r1 - __uint_as_float(mid << 16);
        const unsigned lo = pk_bf16(r2, 0.f) & 0xffffu;
        u32x4 f; f[0] = 0x3F803F80u; f[1] = 0x3F80u | ((hi ^ 0x8000u) << 16); f[2] = (mid ^ 0x8000u) | ((lo ^ 0x8000u) << 16); f[3] = 0u;
        csx[tid * 16 + i] = f;
    }
}
__device__ void phase_prep(const Params& p, int l, unsigned char* lds_raw) {
    const int n0 = BATCH * H_FOX, n1 = n0 + ((MIXSEL & 1) ? NGDN_CH : 0), n2 = n1 + ((MIXSEL & 2) ? NGLA_CH : 0);
    for (int it = blockIdx.x; it < n2; it += gridDim.x) {
        if (it < n0) { __syncthreads(); fox_cumsum_item(p, l, it, (float*)lds_raw); }
        else if (it < n1) gdn_prep_item(p, l, it - n0, lds_raw);
        else gla_prep_item(p, l, it - n1, lds_raw);
    }
}

typedef float f32x16 __attribute__((ext_vector_type(16)));
#define ATT_BUF 17408
#define ATT_THR 8.0f
#define ATT_NSTAGE 3
__device__ __forceinline__ void attn_issue(const bf16_t* const (&kp)[2], const bf16_t* const (&vp)[2], const bf16_t* cp, int s0, unsigned char* stage, int w) {
    bf16_t* Ks = (bf16_t*)stage; bf16_t* Vs = Ks + 4096; bf16_t* cs = Vs + 4096;
    __builtin_amdgcn_global_load_lds((const unsigned*)(kp[0] + (size_t)s0 * NPROJ), (unsigned*)(Ks + (w * 8) * 64), 16, 0, 0);
    __builtin_amdgcn_global_load_lds((const unsigned*)(kp[1] + (size_t)s0 * NPROJ), (unsigned*)(Ks + (32 + w * 8) * 64), 16, 0, 0);
    __builtin_amdgcn_global_load_lds((const unsigned*)(vp[0] + s0), (unsigned*)(Vs + (w * 8) * 64), 16, 0, 0);
    __builtin_amdgcn_global_load_lds((const unsigned*)(vp[1] + s0), (unsigned*)(Vs + (32 + w * 8) * 64), 16, 0, 0);
    __builtin_amdgcn_global_load_lds((const unsigned*)(cp + (size_t)s0 * 8), (unsigned*)cs, 16, 0, 0);
}
__device__ __forceinline__ bf16x8 attn_qbias(float u, int h) {
    const unsigned hi = pk_bf16(u, 0.f) & 0xffffu; const float r1 = u - __uint_as_float(hi << 16);
    const unsigned mid = pk_bf16(r1, 0.f) & 0xffffu; const float r2 = r1 - __uint_as_float(mid << 16);
    const unsigned lo = pk_bf16(r2, 0.f) & 0xffffu;
    u32x4 f; f[0] = hi | (mid << 16); f[1] = lo | (0x3F80u << 16); f[2] = 0x3F803F80u; f[3] = 0u;
    if (h) { f[0] = 0u; f[1] = 0u; f[2] = 0u; }
    return __builtin_bit_cast(bf16x8, f);
}
__device__ void fox_attn_item(const Params& p, int l, int bh, int qt, unsigned char* lds_raw) {
    const int tid = ltid(), lane = tid & 63, w = __builtin_amdgcn_readfirstlane(tid >> 6), r = lane & 31, h = lane >> 5;
    const int b = bh / H_FOX, hh = bh % H_FOX;
    const bf16_t* proj = (const bf16_t*)(p.ws + WS_PROJ);
    const bf16_t* kbase = proj + (size_t)b * SEQ * NPROJ + NC_FK + hh * 64;
    const bf16_t* vbase = (const bf16_t*)(p.ws + WS_VTF) + (size_t)bh * 64 * SEQ;
    const float* cum = (const float*)(p.ws + WS_CUM) + (size_t)bh * SEQ;
    const int qlo = qt * 128 + w * 32, q = qlo + r;
    bf16x8 qf[4];
    {
        const bf16_t* qrow = proj + (size_t)(b * SEQ + q) * NPROJ + NC_FQ + hh * 64;
#pragma unroll
        for (int kk = 0; kk < 4; ++kk) qf[kk] = *(const bf16x8*)(qrow + kk * 16 + h * 8);
    }
    const float cq2 = cum[q] * 1.4426950408889634f;
    float mref = 0.f;
    bf16x8 qx = attn_qbias(cq2 - mref, h);
    f32x16 o0, o1;
#pragma unroll
    for (int i = 0; i < 16; ++i) { o0[i] = 0.f; o1[i] = 0.f; }
    float lsum = 0.f;
    const int ntiles = 2 * qt + 2;
    const bf16_t* kp[2]; const bf16_t* vp[2];
    {
        const int row0 = w * 8 + (lane >> 3), pc = lane & 7;
        const int lc0 = (pc ^ ((row0 >> 1) & 7)) * 8;
        kp[0] = kbase + (size_t)row0 * NPROJ + lc0; kp[1] = kbase + (size_t)(row0 + 32) * NPROJ + lc0;
        vp[0] = vbase + (size_t)row0 * SEQ + lc0;   vp[1] = vbase + (size_t)(row0 + 32) * SEQ + lc0;
    }
    const bf16_t* cp = (const bf16_t*)(p.ws + WS_SCR + SCR_CSX) + (size_t)bh * SEQ * 8 + lane * 8;
    const int swr = (r >> 1) & 7;
    int jw;
    {
        float gq = fabsf(p.in[3][l * 64 + lane]), gk = fabsf(p.in[4][l * 64 + lane]);
#pragma unroll
        for (int o = 32; o > 0; o >>= 1) { gq = fmaxf(gq, __shfl_xor(gq, o, 64)); gk = fmaxf(gk, __shfl_xor(gk, o, 64)); }
        const float thr = 2.f * (1.4426950408889634f * 8.f * gq * gk) + 30.f;
        const float cw = cum[qlo] * 1.4426950408889634f;
        const float ce = (lane < ntiles) ? cum[64 * lane + 63] * 1.4426950408889634f : 0.f;
        const unsigned long long keep = __ballot((lane < ntiles) && (cw - ce >= -thr));
        jw = keep ? (__ffsll((long long)keep) - 1) : (ntiles - 1);
    }
    volatile int* jshare = (volatile int*)(lds_raw + ATT_NSTAGE * ATT_BUF + 16);
    asm volatile("s_waitcnt vmcnt(0)" ::: "memory");
    RAW_BARRIER();
    if (tid == 0) *jshare = jw;
    RAW_BARRIER();
    const int jstart = *jshare;
    attn_issue(kp, vp, cp, jstart * 64, lds_raw + (jstart % ATT_NSTAGE) * ATT_BUF, w);
    if (jstart + 1 < ntiles) attn_issue(kp, vp, cp, (jstart + 1) * 64, lds_raw + ((jstart + 1) % ATT_NSTAGE) * ATT_BUF, w);
    for (int j = jstart; j < ntiles; ++j) {
        if (j + 1 < ntiles) asm volatile("s_waitcnt vmcnt(5)" ::: "memory"); else asm volatile("s_waitcnt vmcnt(0)" ::: "memory");
        RAW_BARRIER();
        if (j + 2 < ntiles) attn_issue(kp, vp, cp, (j + 2) * 64, lds_raw + ((j + 2) % ATT_NSTAGE) * ATT_BUF, w);
        const int s0 = j * 64;
        if (s0 <= qlo + 31 && j >= jw) {
            const bf16_t* Ks = (const bf16_t*)(lds_raw + (j % ATT_NSTAGE) * ATT_BUF); const bf16_t* Vs = Ks + 4096; const bf16_t* cs = Vs + 4096;
            f32x16 st0, st1;
            {
                u32x4 z4 = {0u, 0u, 0u, 0u};
                u32x4 c0 = *(const u32x4*)(cs + r * 8), c1 = *(const u32x4*)(cs + (32 + r) * 8);
                if (h) { c0 = z4; c1 = z4; }
                f32x16 zz;
#pragma unroll
                for (int i = 0; i < 16; ++i) zz[i] = 0.f;
                st0 = __builtin_amdgcn_mfma_f32_32x32x16_bf16(__builtin_bit_cast(bf16x8, c0), qx, zz, 0, 0, 0);
                st1 = __builtin_amdgcn_mfma_f32_32x32x16_bf16(__builtin_bit_cast(bf16x8, c1), qx, zz, 0, 0, 0);
            }
#pragma unroll
            for (int kk = 0; kk < 4; ++kk) {
                const int co = ((kk * 2 + h) ^ swr) * 8;
                bf16x8 a0 = *(const bf16x8*)(Ks + r * 64 + co);
                bf16x8 a1 = *(const bf16x8*)(Ks + (32 + r) * 64 + co);
                st0 = __builtin_amdgcn_mfma_f32_32x32x16_bf16(a0, qf[kk], st0, 0, 0, 0);
                st1 = __builtin_amdgcn_mfma_f32_32x32x16_bf16(a1, qf[kk], st1, 0, 0, 0);
            }
            if (s0 + 63 > qlo) {
#pragma unroll
                for (int i = 0; i < 16; ++i) {
                    const int key = s0 + (i & 3) + 8 * (i >> 2) + 4 * h;
                    if (key > q) st0[i] = -1e30f;
                    if (key + 32 > q) st1[i] = -1e30f;
                }
            }
            float mx = fmaxf(st0[0], st1[0]);
#pragma unroll
            for (int i = 1; i < 16; ++i) mx = fmaxf(mx, fmaxf(st0[i], st1[i]));
            if (__any(mx > ATT_THR)) {
                const float mo = fmaxf(mx, __shfl_xor(mx, 32, 64));
                const float d = (mo > ATT_THR) ? mo : 0.f;
                const float alpha = __builtin_amdgcn_exp2f(-d);
#pragma unroll
                for (int i = 0; i < 16; ++i) { st0[i] -= d; st1[i] -= d; o0[i] *= alpha; o1[i] *= alpha; }
                lsum *= alpha; mref += d;
                qx = attn_qbias(cq2 - mref, h);
            }
            float rs = 0.f;
#pragma unroll
            for (int i = 0; i < 16; ++i) { st0[i] = __builtin_amdgcn_exp2f(st0[i]); st1[i] = __builtin_amdgcn_exp2f(st1[i]); rs += st0[i] + st1[i]; }
            lsum += rs;
            bf16x8 pf[2][2];
#pragma unroll
            for (int s = 0; s < 2; ++s) {
                u32x4 t0 = {pk_bf16(st0[8 * s], st0[8 * s + 1]), pk_bf16(st0[8 * s + 2], st0[8 * s + 3]), pk_bf16(st0[8 * s + 4], st0[8 * s + 5]), pk_bf16(st0[8 * s + 6], st0[8 * s + 7])};
                u32x4 t1 = {pk_bf16(st1[8 * s], st1[8 * s + 1]), pk_bf16(st1[8 * s + 2], st1[8 * s + 3]), pk_bf16(st1[8 * s + 4], st1[8 * s + 5]), pk_bf16(st1[8 * s + 6], st1[8 * s + 7])};
                pf[0][s] = __builtin_bit_cast(bf16x8, t0); pf[1][s] = __builtin_bit_cast(bf16x8, t1);
            }
#pragma unroll
            for (int mt = 0; mt < 2; ++mt)
#pragma unroll
                for (int s = 0; s < 2; ++s) {
                    const int c0 = 4 * mt + 2 * s;
                    const int oA = ((c0 ^ swr) * 8) + 4 * h, oB = (((c0 + 1) ^ swr) * 8) + 4 * h;
                    uint2 a00 = *(const uint2*)(Vs + r * 64 + oA), a01 = *(const uint2*)(Vs + r * 64 + oB);
                    uint2 a10 = *(const uint2*)(Vs + (32 + r) * 64 + oA), a11 = *(const uint2*)(Vs + (32 + r) * 64 + oB);
                    u32x4 u0 = {a00.x, a00.y, a01.x, a01.y}; u32x4 u1 = {a10.x, a10.y, a11.x, a11.y};
                    o0 = __builtin_amdgcn_mfma_f32_32x32x16_bf16(__builtin_bit_cast(bf16x8, u0), pf[mt][s], o0, 0, 0, 0);
                    o1 = __builtin_amdgcn_mfma_f32_32x32x16_bf16(__builtin_bit_cast(bf16x8, u1), pf[mt][s], o1, 0, 0, 0);
                }
        }
    }
    lsum += __shfl_xor(lsum, 32, 64);
    const float inv = 1.f / lsum;
    float ss = 0.f;
#pragma unroll
    for (int i = 0; i < 16; ++i) { o0[i] *= inv; o1[i] *= inv; ss += o0[i] * o0[i] + o1[i] * o1[i]; }
    ss += __shfl_xor(ss, 32, 64);
    const float rstd = rsqrtf(ss * (1.f / 64.f) + 1e-6f);
    const float* og = p.in[6] + l * 64;
    bf16_t* mrow = (bf16_t*)(p.ws + WS_MIX) + pl_off(b * SEQ + q, hh * 64, 1024);
#pragma unroll
    for (int g = 0; g < 4; ++g) {
        const int e0 = 8 * g + 4 * h;
        f32x4 g0 = *(const f32x4*)(og + e0), g1 = *(const f32x4*)(og + 32 + e0);
        store4_bf16(mrow + e0, o0[4 * g] * rstd * g0[0], o0[4 * g + 1] * rstd * g0[1], o0[4 * g + 2] * rstd * g0[2], o0[4 * g + 3] * rstd * g0[3]);
        store4_bf16(mrow + 64 + e0, o1[4 * g] * rstd * g1[0], o1[4 * g + 1] * rstd * g1[1], o1[4 * g + 2] * rstd * g1[2], o1[4 * g + 3] * rstd * g1[3]);
    }
}
#define ATT_ITEMS (BATCH * H_FOX * (SEQ / 128))
#define CONV_ITEMS ((CONV_REST + P0_T_IN + 3) / 4)
__device__ void phase_scan_attn(const Params& p, int l, unsigned char* lds_raw, int rep = 0, int sel = 7) {
    unsigned* qctr = (unsigned*)(p.ws + WS_CTL) + CW_Q + l + 2 * rep;
    volatile int* slot = (volatile int*)(lds_raw + ATT_NSTAGE * ATT_BUF);
    for (;;) {
        __syncthreads();
        if (threadIdx.x == 0) *slot = (int)atomicAdd(qctr, 1u);
        __syncthreads();
        int it = *slot;
        const int ns0 = (MIXSEL & 1) ? BATCH * H_GDN * 4 : 0, ns1 = ns0 + ((MIXSEL & 2) ? 128 : 0);
        if (it >= ns1 + ATT_ITEMS + CONV_ITEMS) break;
        if (it >= ns1) {
            const int c = it - ns1;
            int conv_idx = -1;
            if (c < 5 * ATT_ITEMS) { if (c % 5 != 0) conv_idx = c - c / 5 - 1; } else conv_idx = c - ATT_ITEMS;
            if (conv_idx >= 0) {
                if (rep == 0 && conv_idx < CONV_ITEMS) conv_fold4(p, l, conv_idx * 4, ltid());
                continue;
            }
            it = ns1 + c / 5;
        }
        if (it < ns0) { if (sel & 1) gdn_scan_item(p, it, lds_raw, rep ? SVAR : 0); continue; }
        if (it < ns1) { if (sel & 2) gla_scan_item(p, it - ns0); continue; }
        it -= ns1;
        if (!(sel & 4)) continue;
        const int qt = (SEQ / 128 - 1) - it / (BATCH * H_FOX), bh = it % (BATCH * H_FOX);
        fox_attn_item(p, l, bh, qt, lds_raw);
    }
}

#define NPHASE 19
__global__ void __launch_bounds__(256, 2) mk(Params p, int lo, int hi, int use_bar) {
    __shared__ __attribute__((aligned(16))) unsigned char lds_raw[LDS_BYTES];
    bf16_t* lds = (bf16_t*)lds_raw;
    volatile LAS unsigned* st = (volatile LAS unsigned*)(lds_raw + LDS_BYTES - 16);
    XcdBarrier bar; bar.bar = (unsigned*)(p.ws + WS_CTL) + CW_BAR; bar.x = 0; bar.st = st;
    if (use_bar) {
        if (threadIdx.x == 0) { st[0] = 0u; st[1] = 0u; }
        __syncthreads();
        bar = xcd_barrier_post((unsigned*)(p.ws + WS_CTL) + CW_BAR, st);
    }
    for (int ph = lo; ph < hi; ++ph) {
#ifndef PSEL
#define PSEL 0xffff
#endif
        int phv = ph; asm volatile("" : "+s"(phv));
        size_t zoff = 0; asm volatile("" : "+s"(zoff));
        Params q = p; q.ws = p.ws + zoff; q.out = p.out + zoff;
        if (phv == 0) { if (PSEL & 1) phase0(q); }
        else {
            int l = (phv - 1) / 9, s = (phv - 1) % 9;
            if (s == 0) { if (PSEL & 2) phase_inproj(q, l, lds); }
            else if (s == 1) { if (PSEL & 128) phase_prep(q, l, lds_raw); }
            else if (s == 2) { if (PSEL & 256) phase_scan_attn(q, l, lds_raw); }
            else if (s == 3) { if (PSEL & 512) phase_mixout(q, l); }
            else if (s == 4) { if (PSEL & 4) phase_outproj(q, l, lds); }
            else if (s == 5) { if (PSEL & 8) phase_route(q, l, lds); }
            else if (s == 6) { if (PSEL & 16) phase_expert<0>(q, l, lds); }
            else if (s == 7) { if (PSEL & 32) phase_expert<1>(q, l, lds); }
            else if (s == 8) { if (PSEL & 64) phase_combine(q, l); }
        }
#ifdef REPEAT_MASK
        {
            const int ty = (phv == 0) ? 9 : (phv - 1) % 9, l = (phv == 0) ? 0 : (phv - 1) / 9;
            const bool idem = !((ty == 4 && l == 1));
            if (((REPEAT_MASK >> ty) & 1) && idem && use_bar) {
                xcd_barrier(bar);
                if (ty == 9) phase0(q);
                else if (ty == 0) phase_inproj(q, l, lds, GVAR);
                else if (ty == 1) phase_prep(q, l, lds_raw);
                else if (ty == 2) phase_scan_attn(q, l, lds_raw, 1, P3SEL);
                else if (ty == 3) phase_mixout(q, l);
                else if (ty == 4) phase_outproj(q, l, lds);
                else if (ty == 5) phase_route(q, l, lds, 1);
                else if (ty == 8) phase_combine(q, l, 1);
                else if (ty == 6) phase_expert<0>(q, l, lds);
                else if (ty == 7) phase_expert<1>(q, l, lds);
            }
        }
#endif
        if (ph + 1 < hi) {
            if (hi > 1000) cg::this_grid().sync();
            xcd_barrier(bar);
        }
    }
}

extern "C" void kernel_launch(void* const* d_in, const int* in_sizes, int n_in,
                              void* d_out, int out_size, void* d_ws, size_t ws_size,
                              hipStream_t stream) {
    static int grid = 0;
    if (grid == 0) {
        if (ws_size < WS_END) { fprintf(stderr, "ws too small: need %zu have %zu\n", (size_t)WS_END, ws_size); grid = -1; return; }
        int dev = 0, cus = 0, per_cu = 0;
        hipGetDevice(&dev);
        hipDeviceGetAttribute(&cus, hipDeviceAttributeMultiprocessorCount, dev);
        hipOccupancyMaxActiveBlocksPerMultiprocessor(&per_cu, mk, 256, 0);
        if (per_cu > 2) per_cu = 2;
        if (per_cu < 1) { fprintf(stderr, "occupancy query failed\n"); grid = -1; return; }
        grid = cus * per_cu;
        grid -= grid % 8;
    }
    if (grid < 0) return;
    Params p{};
    for (int i = 0; i < 23; ++i) p.in[i] = (const float*)d_in[i];
    p.out = (float*)d_out; p.ws = (char*)d_ws;
    hipMemsetAsync((char*)d_ws + WS_CTL, 0, CTL_BYTES, stream);
#ifdef POISON_GLA
    hipMemsetAsync((char*)d_ws + WS_SCR + SCR_GLA_OL, 0xFF, SCR_LVT - SCR_GLA_OL, stream);
#endif

#ifdef MULTI_LAUNCH
    for (int ph = 0; ph < NPHASE; ++ph) mk<<<grid, 256, 0, stream>>>(p, ph, ph + 1, 0);
#else
    int lo = 0, hi = NPHASE, ub = 2;
    void* args[] = {&p, &lo, &hi, &ub};
    hipError_t e = hipLaunchCooperativeKernel((void*)mk, dim3(grid), dim3(256), args, 0, stream);
    if (e != hipSuccess) fprintf(stderr, "cooperative launch failed: %s (grid %d)\n", hipGetErrorString(e), grid);
#endif
}
```

```cpp
#include <hip/hip_runtime.h>
#include <hip/hip_cooperative_groups.h>
#include <cstdint>
#include <cstdio>
namespace cg = cooperative_groups;

#define D_MODEL 1024
#define BATCH 4
#define SEQ 4096
#define NTOK (BATCH * SEQ)
#define H_FOX 6
#define H_GDN 6
#define H_GLA 4
#define N_IN 3490
#define N_EXP 32
#define D_EXP 512
#define NPROJ 3456
#define NINP 3584

#define C_FF 1152
#define C_GQ 1158
#define C_GG 2310
#define C_GA 2694
#define C_GB 2700
#define C_LQ 2706
#define C_LA 3474
#define NC_FQ 0
#define NC_FK 384
#define NC_FV 768
#define NC_GQ 1152
#define NC_GK 1536
#define NC_GV 1920
#define NC_GG 2304
#define NC_LQ 2688
#define NC_LK 2816
#define NC_LV 2944
#define NC_LR 3200
#define AX_FF 0
#define AX_GA 6
#define AX_GB 12
#define AX_LA 18

#ifndef SVAR
#define SVAR 0
#endif
#ifndef P3SEL
#define P3SEL 7
#endif
#ifndef GVAR
#define GVAR 0
#endif
#ifndef MIXSEL
#define MIXSEL 3
#endif
typedef unsigned short bf16_t;
typedef short bf16x8 __attribute__((ext_vector_type(8)));
typedef float f32x4 __attribute__((ext_vector_type(4)));
typedef unsigned u32x4 __attribute__((ext_vector_type(4)));
typedef unsigned u32x2 __attribute__((ext_vector_type(2)));

#define WS_CTL      0
#define CTL_BYTES   262144
#define WS_WIN      (WS_CTL + CTL_BYTES)
#define WS_WOUT     (WS_WIN + (size_t)2 * NINP * 1024 * 2)
#define WS_WGU      (WS_WOUT + (size_t)2 * 1024 * 1024 * 2)
#define WS_WD       (WS_WGU + (size_t)2 * 32 * 1024 * 1024 * 2)
#define WS_WR       (WS_WD + (size_t)2 * 32 * 1024 * 512 * 2)
#define WS_HN       (WS_WR + (size_t)2 * 64 * 1024 * 2)
#define WS_PROJ     (WS_HN + (size_t)NTOK * 1024 * 2)
#define WS_VTF      (WS_PROJ + (size_t)NTOK * NPROJ * 2)
#define WS_AUX      (WS_VTF + (size_t)BATCH * H_FOX * 64 * SEQ * 2)
#define WS_CUM      (WS_AUX + (size_t)NTOK * 64 * 4)
#define WS_MIX      (WS_CUM + (size_t)BATCH * H_FOX * SEQ * 4)
#define WS_ROWTOK   (WS_MIX + (size_t)NTOK * 1024 * 2)
#define WS_TSLOT    (WS_ROWTOK + (size_t)32 * NTOK * 4)
#define WS_TGATE    (WS_TSLOT + (size_t)NTOK * 2 * 4)
#define WS_SCR      (WS_TGATE + (size_t)NTOK * 2 * 4)
#define SCR_BYTES   ((size_t)100 * 1024 * 1024)
#define WS_END      (WS_SCR + SCR_BYTES)
#define HROWS       (2 * NTOK + 32 * 128)
#define WS_H        WS_PROJ
#define WS_Y        (WS_PROJ + (size_t)HROWS * 512 * 2)

#define NGDN_CH 1536
#define NGLA_CH 1024
#define SCR_GDN_MP   ((size_t)0)
#define SCR_GDN_NN   (SCR_GDN_MP + (size_t)NGDN_CH * 8192)
#define SCR_GDN_P    (SCR_GDN_NN + (size_t)NGDN_CH * 8192)
#define SCR_GDN_OL   (SCR_GDN_P  + (size_t)NGDN_CH * 8192)
#define SCR_GDN_SG   (SCR_GDN_OL + (size_t)NGDN_CH * 8192)
#define SCR_GDN_LAST (SCR_GDN_SG + (size_t)NGDN_CH * 8192)
#define SCR_GLA_OL   (SCR_GDN_LAST + (size_t)NGDN_CH * 4)
#define SCR_GLA_KV   (SCR_GLA_OL + (size_t)NGLA_CH * 8192)
#define SCR_GLA_QB   (SCR_GLA_KV + (size_t)NGLA_CH * 8192)
#define SCR_GLA_SG   (SCR_GLA_QB + (size_t)NGLA_CH * 4096)
#define SCR_GLA_DL   (SCR_GLA_SG + (size_t)NGLA_CH * 4096)
#define SCR_LVT      (SCR_GLA_DL + (size_t)NGLA_CH * 128)
#define SCR_USED     (SCR_LVT + (size_t)BATCH * H_GLA * 64 * SEQ * 2)
#define SCR_CSX      SCR_USED
static_assert(SCR_CSX + (size_t)BATCH * H_FOX * SEQ * 16 <= SCR_BYTES, "scratch overflow");
#define CW_BAR      0
#define CW_CNT      4096
#define CNT_STRIDE  64
#define NSH         8
#define SHCAP       2048
#define CW_Q        (CW_CNT + 2 * 32 * NSH * CNT_STRIDE + 64)
#define CW_MOETAB   (CW_Q + 256)

struct Params {
    const float* in[23];
    float* out;
    char* ws;
};

__device__ __forceinline__ float sigmoidf_(float x) { return __builtin_amdgcn_rcpf(1.f + __expf(-x)); }
__device__ __forceinline__ float siluf_(float x) { return x * __builtin_amdgcn_rcpf(1.f + __expf(-x)); }
__device__ __forceinline__ float softplusf_(float x) { return x > 20.f ? x : __logf(1.f + __expf(x)); }
__device__ __forceinline__ float logsigmoidf_(float x) { return -softplusf_(-x); }
__device__ __forceinline__ float wave_sum(float v) {
#pragma unroll
    for (int o = 32; o > 0; o >>= 1) v += __shfl_xor(v, o, 64);
    return v;
}
__device__ __forceinline__ int ltid() { int t = threadIdx.x; asm volatile("" : "+v"(t)); return t; }
typedef __bf16 bf16x2_t __attribute__((ext_vector_type(2)));
typedef float f32x2_t __attribute__((ext_vector_type(2)));
__device__ __forceinline__ unsigned pk_bf16(float lo, float hi) { f32x2_t v = {lo, hi}; bf16x2_t r = __builtin_convertvector(v, bf16x2_t); return __builtin_bit_cast(unsigned, r); }
__device__ __forceinline__ size_t pl_off(int row, int k, int K) { return (size_t)(row >> 1) * (size_t)(2 * K) + (size_t)((k >> 5) * 64 + (row & 1) * 32 + (k & 31)); }
__device__ __forceinline__ unsigned ld_u32_agent(const unsigned* p) { return __hip_atomic_load(p, __ATOMIC_RELAXED, __HIP_MEMORY_SCOPE_AGENT); }
__device__ __forceinline__ float ld_f32_agent(const float* p) { return __uint_as_float(__hip_atomic_load((const unsigned*)p, __ATOMIC_RELAXED, __HIP_MEMORY_SCOPE_AGENT)); }
__device__ __forceinline__ float bf2f(bf16_t v) { return __uint_as_float((unsigned)v << 16); }
__device__ __forceinline__ float bflo(unsigned v) { return __uint_as_float(v << 16); }
__device__ __forceinline__ float bfhi(unsigned v) { return __uint_as_float(v & 0xffff0000u); }

#define XB_TMO      128
#define XB_XCNT(j)  (256  + 64 * (j))
#define XB_XSUB(j)  (1280 + 64 * (j))
#define XB_XGEN(j)  (2304 + 64 * (j))
#define XB_TOP      3328
#define XB_TOPGEN   3392
#define XCD_BAR_WORDS 3456
#define XB_SPIN_CAP (1u << 22)
#define LAS __attribute__((address_space(3)))
__device__ __forceinline__ unsigned xb_ld(unsigned* p)              { return __hip_atomic_load(p, __ATOMIC_RELAXED, __HIP_MEMORY_SCOPE_AGENT); }
__device__ __forceinline__ unsigned xb_add(unsigned* p, unsigned v) { return __hip_atomic_fetch_add(p, v, __ATOMIC_RELAXED, __HIP_MEMORY_SCOPE_AGENT); }
__device__ __forceinline__ unsigned xb_xcc_id() { return (unsigned)__builtin_amdgcn_s_getreg((3 << 11) | 20) & 0xFu; }
#define XB_SPIN(cond, bar) do { unsigned _sp = 0; while (cond) { if (_sp < 16u) __builtin_amdgcn_s_sleep(2); else __builtin_amdgcn_s_sleep(20);     \
    if ((++_sp & 255u) == 0u) { if (xb_ld(&(bar)[XB_TMO])) break; if (_sp > XB_SPIN_CAP) { atomicAdd(&(bar)[XB_TMO], 1u); break; } } } } while (0)
struct XcdBarrier { unsigned* bar; unsigned x; volatile LAS unsigned* st; };
__device__ __forceinline__ XcdBarrier xcd_barrier_post(unsigned* bar, volatile LAS unsigned* st) {
    XcdBarrier b; b.bar = bar; b.x = xb_xcc_id(); b.st = st;
    if (threadIdx.x == 0) (void)xb_add(&bar[XB_XCNT(b.x)], 1u);
    return b;
}
__device__ __forceinline__ void xcd_barrier_complete(unsigned* bar, unsigned x, unsigned& nloc, unsigned& nx) {
    const unsigned G = gridDim.x * gridDim.y * gridDim.z;
    unsigned sum, cnt, mine, sp = 0u;
    for (;;) {
        sum = 0u; cnt = 0u; mine = 0u;
#pragma unroll
        for (unsigned j = 0; j < 16; ++j) { const unsigned c = xb_ld(&bar[XB_XCNT(j)]); sum += c; cnt += (c > 0u) ? 1u : 0u; mine = (j == x) ? c : mine; }
        if (sum == G) break;
        __builtin_amdgcn_s_sleep(1);
        if ((++sp & 255u) == 0u) { if (xb_ld(&bar[XB_TMO])) break; if (sp > XB_SPIN_CAP) { atomicAdd(&bar[XB_TMO], 1u); break; } }
    }
    nloc = mine > 0u ? mine : 1u; nx = cnt > 0u ? cnt : 1u;
}
__device__ __forceinline__ void xcd_barrier(const XcdBarrier& b) {
    asm volatile("s_waitcnt vmcnt(0)" ::: "memory");
    __syncthreads();
    if (threadIdx.x == 0) {
        unsigned* bar = b.bar;
        __builtin_amdgcn_s_waitcnt(0);
        unsigned nloc = b.st[0], nx = b.st[1];
        if (nloc == 0u) { xcd_barrier_complete(bar, b.x, nloc, nx); b.st[0] = nloc; b.st[1] = nx; }
        const unsigned old = xb_add(&bar[XB_XSUB(b.x)], 1u);
        const unsigned gen = old / nloc;
        if (old + 1u == (gen + 1u) * nloc) {
            __builtin_amdgcn_fence(__ATOMIC_RELEASE, "agent");
            asm volatile("s_waitcnt vmcnt(0)" ::: "memory");
            const unsigned og = xb_add(&bar[XB_TOP], 1u);
            const unsigned tg = og / nx;
            if (og + 1u == (tg + 1u) * nx) xb_add(&bar[XB_TOPGEN], 1u);
            else XB_SPIN(xb_ld(&bar[XB_TOPGEN]) == tg, bar);
            __builtin_amdgcn_fence(__ATOMIC_ACQUIRE, "agent");
            xb_add(&bar[XB_XGEN(b.x)], 1u);
            asm volatile("s_waitcnt vmcnt(0)" ::: "memory");
        } else {
            XB_SPIN(xb_ld(&bar[XB_XGEN(b.x)]) == gen, bar);
            __builtin_amdgcn_fence(__ATOMIC_ACQUIRE, "agent");
            asm volatile("s_waitcnt vmcnt(0)" ::: "memory");
        }
    }
    __syncthreads();
}

#define LDS_BYTES 68096
#define LROW 72

__device__ __forceinline__ int inproj_map(int n) {
    if (n < 1152) return n;
    if (n < 2304) return C_GQ + (n - 1152);
    if (n < 2688) return C_GG + (n - 2304);
    if (n < 3456) return C_LQ + (n - 2688);
    if (n < 3462) return C_FF + (n - 3456);
    if (n < 3468) return C_GA + (n - 3462);
    if (n < 3474) return C_GB + (n - 3468);
    if (n < 3490) return n;
    return -1;
}
#define P0_T_IN   (56 * 16)
#define P0_T_OUT  (16 * 16)
#define P0_T_GU   (32 * 16 * 16)
#define P0_T_D    (32 * 16 * 8)
#define P0_T_R    (16)
#define P0_T_LAYER (P0_T_IN + P0_T_OUT + P0_T_GU + P0_T_D + P0_T_R)
#define P0_T_NORM (NTOK / 4)
struct ConvDesc { const float* src; bf16_t* dst; int ld; int col; };
__device__ __forceinline__ ConvDesc conv_desc(const Params& p, int l, int j, int tid) {
    const int nl = tid & 63, kg = tid >> 6;
    ConvDesc d;
    if (j < P0_T_IN) {
        int tn = j / 16, tk = j % 16; int n = tn * 64 + nl; int k0 = tk * 64 + kg * 16;
        d.ld = N_IN; d.col = inproj_map(n); d.src = p.in[2] + (size_t)l * 1024 * N_IN + (size_t)k0 * N_IN;
        d.dst = (bf16_t*)(p.ws + WS_WIN) + (size_t)l * NINP * 1024 + pl_off(n, k0, 1024);
        return d;
    }
    j -= P0_T_IN;
    if (j < P0_T_OUT) {
        int tn = j / 16, tk = j % 16; int n = tn * 64 + nl; int k0 = tk * 64 + kg * 16;
        d.ld = 1024; d.col = n; d.src = p.in[14] + (size_t)l * 1024 * 1024 + (size_t)k0 * 1024;
        d.dst = (bf16_t*)(p.ws + WS_WOUT) + (size_t)l * 1024 * 1024 + pl_off(n, k0, 1024);
        return d;
    }
    j -= P0_T_OUT;
    if (j < P0_T_GU) {
        int e = j / 256, r = j % 256; int tn = r / 16, tk = r % 16; int n = tn * 64 + nl; int k0 = tk * 64 + kg * 16;
        int t128 = n >> 7, wx = (n >> 6) & 1, half = (n >> 5) & 1, jj = n & 31;
        d.ld = 512; d.col = t128 * 64 + wx * 32 + jj;
        d.src = (half ? p.in[21] : p.in[20]) + ((size_t)l * 32 + e) * 1024 * 512 + (size_t)k0 * 512;
        d.dst = (bf16_t*)(p.ws + WS_WGU) + ((size_t)l * 32 + e) * 1024 * 1024 + pl_off(n, k0, 1024);
        return d;
    }
    j -= P0_T_GU;
    if (j < P0_T_D) {
        int e = j / 128, r = j % 128; int tn = r / 8, tk = r % 8; int n = tn * 64 + nl; int k0 = tk * 64 + kg * 16;
        d.ld = 1024; d.col = n; d.src = p.in[22] + ((size_t)l * 32 + e) * 512 * 1024 + (size_t)k0 * 1024;
        d.dst = (bf16_t*)(p.ws + WS_WD) + ((size_t)l * 32 + e) * 1024 * 512 + pl_off(n, k0, 512);
        return d;
    }
    j -= P0_T_D;
    {
        int tk = j; int n = nl; int k0 = tk * 64 + kg * 16;
        if (n < 4) { d.src = p.in[16] + (size_t)l * 1024 * 4 + (size_t)k0 * 4; d.ld = 4; d.col = n; }
        else if (n < 36) { d.src = p.in[18] + (size_t)l * 1024 * 32 + (size_t)k0 * 32; d.ld = 32; d.col = n - 4; }
        else { d.src = p.in[16]; d.ld = 4; d.col = -1; }
        d.dst = (bf16_t*)(p.ws + WS_WR) + ((size_t)l * 64 + n) * 1024 + k0;
        return d;
    }
}
__device__ __forceinline__ void conv_load(const ConvDesc& d, float (&v)[16]) {
    if (d.col >= 0) {
#pragma unroll
        for (int i = 0; i < 16; ++i) v[i] = d.src[(size_t)i * d.ld + d.col];
    } else {
#pragma unroll
        for (int i = 0; i < 16; ++i) v[i] = 0.f;
    }
}
__device__ __forceinline__ void conv_store(const ConvDesc& d, const float (&v)[16]) {
    uint4 o0, o1;
    o0.x = pk_bf16(v[0], v[1]); o0.y = pk_bf16(v[2], v[3]); o0.z = pk_bf16(v[4], v[5]); o0.w = pk_bf16(v[6], v[7]);
    o1.x = pk_bf16(v[8], v[9]); o1.y = pk_bf16(v[10], v[11]); o1.z = pk_bf16(v[12], v[13]); o1.w = pk_bf16(v[14], v[15]);
    *(uint4*)(d.dst) = o0;
    *(uint4*)(d.dst + 8) = o1;
}
__device__ __forceinline__ void conv_job(const Params& p, int l, int j, int tid) {
    ConvDesc d = conv_desc(p, l, j, tid); float v[16]; conv_load(d, v); conv_store(d, v);
}
#define CONV_REST (P0_T_LAYER - P0_T_IN)
__device__ __forceinline__ bool conv_fold_desc(const Params& p, int l, int idx, int tid, ConvDesc& d) {
    if (idx < CONV_REST) { d = conv_desc(p, l, P0_T_IN + idx, tid); return true; }
    if (l == 0 && idx < CONV_REST + P0_T_IN) { d = conv_desc(p, 1, idx - CONV_REST, tid); return true; }
    return false;
}
__device__ __forceinline__ void conv_fold4(const Params& p, int l, int idx0, int tid) {
    ConvDesc d0, d1, d2, d3; float v0[16], v1[16], v2[16], v3[16];
    const bool b0 = conv_fold_desc(p, l, idx0, tid, d0), b1 = conv_fold_desc(p, l, idx0 + 1, tid, d1), b2 = conv_fold_desc(p, l, idx0 + 2, tid, d2), b3 = conv_fold_desc(p, l, idx0 + 3, tid, d3);
    if (b0) conv_load(d0, v0); if (b1) conv_load(d1, v1); if (b2) conv_load(d2, v2); if (b3) conv_load(d3, v3);
    if (b0) conv_store(d0, v0); if (b1) conv_store(d1, v1); if (b2) conv_store(d2, v2); if (b3) conv_store(d3, v3);
}
__device__ void phase0(const Params& p) {
    const int tid = ltid(), nl = tid & 63, kg = tid >> 6;
    const int total = P0_T_IN + P0_T_NORM;
    for (int it = blockIdx.x; it < total; it += gridDim.x) {
        if (it >= P0_T_IN) {
            int row = (it - P0_T_IN) * 4 + kg;
            const float* xr = p.in[0] + (size_t)row * D_MODEL + nl * 16;
            const float* gr = p.in[1] + nl * 16;
            float v[16]; float ss = 0.f;
#pragma unroll
            for (int i = 0; i < 4; ++i) { float4 t = *(const float4*)(xr + 4 * i); v[4 * i] = t.x; v[4 * i + 1] = t.y; v[4 * i + 2] = t.z; v[4 * i + 3] = t.w; }
#pragma unroll
            for (int i = 0; i < 16; ++i) ss += v[i] * v[i];
            ss = wave_sum(ss);
            float r = rsqrtf(ss / D_MODEL + 1e-6f);
#pragma unroll
            for (int i = 0; i < 16; ++i) v[i] = v[i] * r * gr[i];
            uint4 o0, o1;
            o0.x = pk_bf16(v[0], v[1]); o0.y = pk_bf16(v[2], v[3]); o0.z = pk_bf16(v[4], v[5]); o0.w = pk_bf16(v[6], v[7]);
            o1.x = pk_bf16(v[8], v[9]); o1.y = pk_bf16(v[10], v[11]); o1.z = pk_bf16(v[12], v[13]); o1.w = pk_bf16(v[14], v[15]);
            bf16_t* hr = (bf16_t*)(p.ws + WS_HN) + pl_off(row, nl * 16, 1024);
            *(uint4*)hr = o0; *(uint4*)(hr + 8) = o1;
            continue;
        }
        conv_job(p, 0, it, tid);
    }
}

#define GSTAGE 8192
#define RAW_BARRIER() do { asm volatile("s_waitcnt lgkmcnt(0)" ::: "memory"); __builtin_amdgcn_s_barrier(); } while (0)
__device__ __forceinline__ int gswz(int row) { return (0x1320 >> (((row >> 2) & 3) * 4)) & 3; }
__device__ __forceinline__ void gemm_issue(const bf16_t* const (&px)[2], const bf16_t* const (&py)[2], int k0, bf16_t* stage, int w) {
    __builtin_amdgcn_global_load_lds((const unsigned*)(px[0] + 2 * k0), (unsigned*)(stage + (w * 16) * 32), 16, 0, 0);
    __builtin_amdgcn_global_load_lds((const unsigned*)(px[1] + 2 * k0), (unsigned*)(stage + (64 + w * 16) * 32), 16, 0, 0);
    __builtin_amdgcn_global_load_lds((const unsigned*)(py[0] + 2 * k0), (unsigned*)(stage + 4096 + (w * 16) * 32), 16, 0, 0);
    __builtin_amdgcn_global_load_lds((const unsigned*)(py[1] + 2 * k0), (unsigned*)(stage + 4096 + (64 + w * 16) * 32), 16, 0, 0);
}
__device__ __forceinline__ void gemm_compute(const bf16_t* stage, int wx, int wy, int fr, int fg, f32x4 (&acc)[4][4]) {
    const int co = (fg ^ gswz(fr)) * 8;
    bf16x8 xa[4], yb[4];
#pragma unroll
    for (int m = 0; m < 4; ++m) xa[m] = *(const bf16x8*)(stage + (wx * 64 + m * 16 + fr) * 32 + co);
#pragma unroll
    for (int n = 0; n < 4; ++n) yb[n] = *(const bf16x8*)(stage + 4096 + (wy * 64 + n * 16 + fr) * 32 + co);
    __builtin_amdgcn_s_setprio(1);
#pragma unroll
    for (int m = 0; m < 4; ++m)
#pragma unroll
        for (int n = 0; n < 4; ++n) acc[m][n] = __builtin_amdgcn_mfma_f32_16x16x32_bf16(xa[m], yb[n], acc[m][n], 0, 0, 0);
    __builtin_amdgcn_s_setprio(0);
}
template <class FX, class FY>
__device__ __forceinline__ void gemm_core(FX rowx, FY rowy, int K, bf16_t* lds, f32x4 (&acc)[4][4], int gvar = 0) {
    const int tid = ltid(), lane = tid & 63, w = __builtin_amdgcn_readfirstlane(tid >> 6), wx = w >> 1, wy = w & 1, fr = lane & 15, fg = lane >> 4;
#pragma unroll
    for (int a = 0; a < 4; ++a)
#pragma unroll
        for (int b = 0; b < 4; ++b) acc[a][b] = (f32x4){0.f, 0.f, 0.f, 0.f};
    const bf16_t* px[2]; const bf16_t* py[2];
    {
        const int r0 = w * 16 + (lane >> 2), pc = lane & 3;
        const int lc0 = (pc ^ gswz(r0)) * 8;
        px[0] = rowx(r0) + lc0; px[1] = rowx(r0 + 64) + lc0;
        py[0] = rowy(r0) + lc0; py[1] = rowy(r0 + 64) + lc0;
    }
    const int nt = K >> 5;
    RAW_BARRIER();
    if (gvar != 3) {
    gemm_issue(px, py, 0, lds, w);
    gemm_issue(px, py, 32, lds + GSTAGE, w);
    gemm_issue(px, py, 64, lds + 2 * GSTAGE, w);
    }
    for (int j = 0; j < nt; ++j) {
        if (j + 2 < nt) asm volatile("s_waitcnt vmcnt(8)" ::: "memory");
        else if (j + 1 < nt) asm volatile("s_waitcnt vmcnt(4)" ::: "memory");
        else asm volatile("s_waitcnt vmcnt(0)" ::: "memory");
        RAW_BARRIER();
        if (j + 3 < nt && gvar != 3) gemm_issue(px, py, (j + 3) * 32, lds + ((j + 3) & 3) * GSTAGE, w);
        if (gvar != 2) gemm_compute(lds + (j & 3) * GSTAGE, wx, wy, fr, fg, acc);
    }
}
__device__ __forceinline__ void store4_bf16(bf16_t* p, float a, float b, float c, float d) {
    uint2 o; o.x = pk_bf16(a, b); o.y = pk_bf16(c, d); *(uint2*)p = o;
}
template <int NC> __device__ __forceinline__ void ep_put(bf16_t* T, int row, int col, float a, float b, float c, float d) {
    uint2 o; o.x = pk_bf16(a, b); o.y = pk_bf16(c, d); *(uint2*)(T + row * (NC + 8) + col) = o;
}
template <int NC, class FD> __device__ __forceinline__ void ep_flush(const bf16_t* T, int tid, FD dst) {
    constexpr int CPR = NC / 8;
#pragma unroll
    for (int i = 0; i < NC / 16; ++i) {
        const int c = tid + 256 * i; const int row = c / CPR, ch = c % CPR;
        *(u32x4*)(dst(row, ch)) = *(const u32x4*)(T + row * (NC + 8) + ch * 8);
    }
}

__device__ __forceinline__ bool xcd_item(int round, int ntm, int ntn, int& tm, int& tn) {
    const int x = blockIdx.x & 7, loc = blockIdx.x >> 3, nloc = gridDim.x >> 3;
    const int tmx = ntm >> 3;
    const int j = round * nloc + loc;
    if (j >= tmx * ntn) return false;
    tn = j / tmx; tm = (j % tmx) * 8 + x;
    return true;
}

__device__ void phase_inproj(const Params& p, int l, bf16_t* lds, int gvar = 0) {
    const int tid = ltid(), lane = tid & 63, w = tid >> 6, wx = w >> 1, wy = w & 1, fr = lane & 15, fg = lane >> 4;
    const bf16_t* hn = (const bf16_t*)(p.ws + WS_HN);
    const bf16_t* wt = (const bf16_t*)(p.ws + WS_WIN) + (size_t)l * NINP * 1024;
    bf16_t* proj = (bf16_t*)(p.ws + WS_PROJ);
    bf16_t* vtf = (bf16_t*)(p.ws + WS_VTF);
    float* aux = (float*)(p.ws + WS_AUX);
    const float* qg = p.in[3] + l * 64; const float* kg = p.in[4] + l * 64;
    for (int round = 0;; ++round) {
        int tm, tn;
        if (gridDim.x == 512) {
            if (round >= 7) break;
            const int x = blockIdx.x & 7, loc = blockIdx.x >> 3; int tml;
            if (round < 6) { tn = (round >> 1) * 8 + (loc & 7); tml = (round & 1) * 8 + (loc >> 3); }
            else { tn = 24 + (loc & 3); tml = loc >> 2; }
            tm = tml * 8 + x;
        } else if (!xcd_item(round, NTOK / 128, NINP / 128, tm, tn)) break;
        const bool vt = (tn >= 6 && tn < 9) || tn == 23 || tn == 24;
        f32x4 acc[4][4];
        {
            auto rw = [&](int r) { return wt + pl_off(tn * 128 + r, 0, 1024); };
            auto rt_ = [&](int r) { return hn + pl_off(tm * 128 + r, 0, 1024); };
            if (vt) gemm_core(rt_, rw, 1024, lds, acc, gvar); else gemm_core(rw, rt_, 1024, lds, acc, gvar);
        }
        if (gvar != 0 && acc[0][0][0] != 123456.789f) continue;
        if (tn == 27) {
#pragma unroll
            for (int n = 0; n < 4; ++n) {
                int t = tm * 128 + wy * 64 + n * 16 + fr;
#pragma unroll
                for (int m = 0; m < 4; ++m) {
                    int c = wx * 64 + m * 16 + 4 * fg;
                    if (c < 64) *(float4*)(aux + (size_t)t * 64 + c) = make_float4(acc[m][n][0], acc[m][n][1], acc[m][n][2], acc[m][n][3]);
                }
            }
            continue;
        }
        RAW_BARRIER();
        if (vt) {
#pragma unroll
            for (int n = 0; n < 4; ++n)
#pragma unroll
                for (int m = 0; m < 4; ++m) ep_put<128>(lds, wy * 64 + n * 16 + fr, wx * 64 + m * 16 + 4 * fg, acc[m][n][0], acc[m][n][1], acc[m][n][2], acc[m][n][3]);
            RAW_BARRIER();
            const bool fox = tn < 9;
            bf16_t* dstb = fox ? vtf : (bf16_t*)(p.ws + WS_SCR + SCR_LVT); const int nh = fox ? H_FOX : H_GLA;
            const int t0 = tm * 128, b = t0 / SEQ, s0 = t0 % SEQ, chb = tn * 128 - (fox ? NC_FV : NC_LV);
            ep_flush<128>(lds, tid, [&](int row, int c8) { const int ch = chb + row; return dstb + ((size_t)(b * nh + (ch >> 6)) * 64 + (ch & 63)) * SEQ + s0 + c8 * 8; });
        } else {
            if (tn < 6) {
                const float* gn = (tn < 3) ? qg : kg; const float sc = (tn < 3) ? 0.125f * 1.4426950408889634f : 1.f;
                float g[4][4];
#pragma unroll
                for (int m = 0; m < 4; ++m)
#pragma unroll
                    for (int r = 0; r < 4; ++r) g[m][r] = gn[m * 16 + 4 * fg + r] * sc;
#pragma unroll
                for (int n = 0; n < 4; ++n) {
                    float ss = 0.f;
#pragma unroll
                    for (int m = 0; m < 4; ++m)
#pragma unroll
                        for (int r = 0; r < 4; ++r) ss += acc[m][n][r] * acc[m][n][r];
                    ss += __shfl_xor(ss, 16, 64); ss += __shfl_xor(ss, 32, 64);
                    float rs = rsqrtf(ss * (1.f / 64.f) + 1e-6f);
#pragma unroll
                    for (int m = 0; m < 4; ++m)
                        ep_put<128>(lds, wy * 64 + n * 16 + fr, wx * 64 + m * 16 + 4 * fg, acc[m][n][0] * rs * g[m][0], acc[m][n][1] * rs * g[m][1], acc[m][n][2] * rs * g[m][2], acc[m][n][3] * rs * g[m][3]);
                }
            } else {
                const bool do_silu = (tn >= 18 && tn < 21) || (tn >= 25);
                const float sc = (tn == 21) ? 0.17677669529663687f : 1.f;
#pragma unroll
                for (int n = 0; n < 4; ++n)
#pragma unroll
                    for (int m = 0; m < 4; ++m) {
                        float v0 = acc[m][n][0] * sc, v1 = acc[m][n][1] * sc, v2 = acc[m][n][2] * sc, v3 = acc[m][n][3] * sc;
                        if (do_silu) { v0 = siluf_(v0); v1 = siluf_(v1); v2 = siluf_(v2); v3 = siluf_(v3); }
                        ep_put<128>(lds, wy * 64 + n * 16 + fr, wx * 64 + m * 16 + 4 * fg, v0, v1, v2, v3);
                    }
            }
            RAW_BARRIER();
            bf16_t* dstb = proj + (size_t)(tm * 128) * NPROJ + tn * 128;
            ep_flush<128>(lds, tid, [&](int row, int c8) { return dstb + (size_t)row * NPROJ + c8 * 8; });
        }
    }
}

__device__ void phase_outproj(const Params& p, int l, bf16_t* lds) {
    const int tid = ltid(), lane = tid & 63, w = tid >> 6, wx = w >> 1, wy = w & 1, fr = lane & 15, fg = lane >> 4;
    const bf16_t* mix = (const bf16_t*)(p.ws + WS_MIX);
    const bf16_t* wt = (const bf16_t*)(p.ws + WS_WOUT) + (size_t)l * 1024 * 1024;
    const float* xin = (l == 0) ? p.in[0] : p.out;
    float* xo = p.out;
    for (int round = 0;; ++round) {
        int tm, tn;
        if (gridDim.x == 512) {
            if (round >= 2) break;
            const int x = blockIdx.x & 7, loc = blockIdx.x >> 3;
            tn = loc & 7; tm = (round * 8 + (loc >> 3)) * 8 + x;
        } else if (!xcd_item(round, NTOK / 128, 8, tm, tn)) break;
        f32x4 acc[4][4];
        {
            auto rw = [&](int r) { return wt + pl_off(tn * 128 + r, 0, 1024); };
            auto rt_ = [&](int r) { return mix + pl_off(tm * 128 + r, 0, 1024); };
            gemm_core(rw, rt_, 1024, lds, acc);
        }
#pragma unroll
        for (int n = 0; n < 4; ++n) {
            int t = tm * 128 + wy * 64 + n * 16 + fr;
#pragma unroll
            for (int m = 0; m < 4; ++m) {
                int c = tn * 128 + wx * 64 + m * 16 + 4 * fg;
                float4 xv = *(const float4*)(xin + (size_t)t * 1024 + c);
                xv.x += acc[m][n][0]; xv.y += acc[m][n][1]; xv.z += acc[m][n][2]; xv.w += acc[m][n][3];
                *(float4*)(xo + (size_t)t * 1024 + c) = xv;
            }
        }
    }
}

__device__ void phase_route(const Params& p, int l, bf16_t* lds, int dry = 0) {
    const int tid = ltid(), lane = tid & 63, w = tid >> 6, fr = lane & 15, fg = lane >> 4;
    const float* x1 = p.out;
    const float* gain = p.in[15] + l * 1024;
    bf16_t* hn = dry ? (bf16_t*)(p.ws + WS_SCR) : (bf16_t*)(p.ws + WS_HN);
    const bf16_t* wr = (const bf16_t*)(p.ws + WS_WR) + (size_t)l * 64 * 1024;
    const float* brg = p.in[17] + l * 4; const float* bre = p.in[19] + l * 32;
    unsigned* cnt = (unsigned*)(p.ws + WS_CTL) + CW_CNT + l * 32 * NSH * CNT_STRIDE;
    int* rowtok = (int*)(p.ws + WS_ROWTOK);
    int* tslot = (int*)(p.ws + WS_TSLOT);
    float* tgate = (float*)(p.ws + WS_TGATE);
    const int HL = 1032;
    float* red = (float*)(lds + 16 * HL);
    for (int it = blockIdx.x; it < NTOK / 16; it += gridDim.x) {
        __syncthreads();
        f32x4 xin4[4][4];
#pragma unroll
        for (int rr = 0; rr < 4; ++rr) {
            const float* xr = x1 + (size_t)(it * 16 + w * 4 + rr) * 1024 + lane * 16;
#pragma unroll
            for (int i = 0; i < 4; ++i) xin4[rr][i] = *(const f32x4*)(xr + 4 * i);
        }
#pragma unroll
        for (int rr = 0; rr < 4; ++rr) {
            int lr = w * 4 + rr; int t = it * 16 + lr;
            float v[16]; float ss = 0.f;
#pragma unroll
            for (int i = 0; i < 4; ++i) { v[4 * i] = xin4[rr][i][0]; v[4 * i + 1] = xin4[rr][i][1]; v[4 * i + 2] = xin4[rr][i][2]; v[4 * i + 3] = xin4[rr][i][3]; }
#pragma unroll
            for (int i = 0; i < 16; ++i) ss += v[i] * v[i];
            ss = wave_sum(ss);
            float r = rsqrtf(ss / D_MODEL + 1e-6f);
#pragma unroll
            for (int i = 0; i < 16; ++i) v[i] = v[i] * r * gain[lane * 16 + i];
            uint4 o0, o1;
            o0.x = pk_bf16(v[0], v[1]); o0.y = pk_bf16(v[2], v[3]); o0.z = pk_bf16(v[4], v[5]); o0.w = pk_bf16(v[6], v[7]);
            o1.x = pk_bf16(v[8], v[9]); o1.y = pk_bf16(v[10], v[11]); o1.z = pk_bf16(v[12], v[13]); o1.w = pk_bf16(v[14], v[15]);
            bf16_t* hr = hn + pl_off(t, lane * 16, 1024);
            *(uint4*)hr = o0; *(uint4*)(hr + 8) = o1;
            *(uint4*)(lds + lr * HL + lane * 16) = o0; *(uint4*)(lds + lr * HL + lane * 16 + 8) = o1;
        }
        __syncthreads();
        f32x4 acc[3];
#pragma unroll
        for (int n = 0; n < 3; ++n) acc[n] = (f32x4){0.f, 0.f, 0.f, 0.f};
#pragma unroll
        for (int ks = 0; ks < 8; ++ks) {
            int k = w * 256 + ks * 32 + fg * 8;
            bf16x8 a = *(const bf16x8*)(lds + fr * HL + k);
#pragma unroll
            for (int n = 0; n < 3; ++n) {
                bf16x8 b = *(const bf16x8*)(wr + (size_t)(n * 16 + fr) * 1024 + k);
                acc[n] = __builtin_amdgcn_mfma_f32_16x16x32_bf16(a, b, acc[n], 0, 0, 0);
            }
        }
#pragma unroll
        for (int n = 0; n < 3; ++n) *(f32x4*)(red + ((w * 3 + n) * 64 + lane) * 4) = acc[n];
        __syncthreads();
        if (tid < 16) {
            float lg[36];
#pragma unroll
            for (int j = 0; j < 36; ++j) {
                int n = j >> 4, f = j & 15; int ln = (tid >> 2) * 16 + f; float s = 0.f;
#pragma unroll
                for (int ww = 0; ww < 4; ++ww) s += red[((ww * 3 + n) * 64 + ln) * 4 + (tid & 3)];
                lg[j] = s;
            }
            float gl[4]; float gm = -1e30f; int gi = 0;
#pragma unroll
            for (int j = 0; j < 4; ++j) { gl[j] = lg[j] + brg[j]; if (gl[j] > gm) { gm = gl[j]; gi = j; } }
            float gs = 0.f;
#pragma unroll
            for (int j = 0; j < 4; ++j) gs += __expf(gl[j] - gm);
            float gp = 1.f / gs;
            float el[8]; float em = -1e30f;
#pragma unroll
            for (int j = 0; j < 8; ++j) {
                float v = (gi == 0) ? lg[4 + j] : (gi == 1) ? lg[12 + j] : (gi == 2) ? lg[20 + j] : lg[28 + j];
                el[j] = v + bre[gi * 8 + j]; em = fmaxf(em, el[j]);
            }
#pragma unroll
            for (int j = 0; j < 8; ++j) el[j] = __expf(el[j] - em);
            float v0 = -1.f, v1 = -1.f; int i0 = 0, i1 = 0;
#pragma unroll
            for (int j = 0; j < 8; ++j) {
                float v = el[j];
                if (v > v0) { v1 = v0; i1 = i0; v0 = v; i0 = j; }
                else if (v > v1) { v1 = v; i1 = j; }
            }
            int t = it * 16 + tid;
            int e0 = gi * 8 + i0, e1 = gi * 8 + i1;
            if (!dry) {
            const int sh = blockIdx.x & (NSH - 1);
            unsigned s0 = atomicAdd(&cnt[(e0 * NSH + sh) * CNT_STRIDE], 1u), s1 = atomicAdd(&cnt[(e1 * NSH + sh) * CNT_STRIDE], 1u);
            rowtok[(size_t)(e0 * NSH + sh) * SHCAP + s0] = t; rowtok[(size_t)(e1 * NSH + sh) * SHCAP + s1] = t;
            tslot[t * 2] = (e0 << 16) | (sh << 11) | (int)s0; tslot[t * 2 + 1] = (e1 << 16) | (sh << 11) | (int)s1;
            tgate[t * 2] = gp * v0 / (v0 + v1); tgate[t * 2 + 1] = gp * v1 / (v0 + v1);
            } else if (gp * v0 == 123.456f) tgate[0] = v1;
        }
    }
}

__device__ __forceinline__ void moe_tables(const unsigned* cnt, int* tab) {
    const int t = threadIdx.x;
    int* sc = tab + 80 + 32 * 9;
    sc[t] = (int)ld_u32_agent(cnt + t * CNT_STRIDE);
    __syncthreads();
    if (t < 32) { int a = 0; for (int s = 0; s < NSH; ++s) { tab[80 + t * 9 + s] = a; a += sc[t * NSH + s]; } tab[80 + t * 9 + 8] = a; }
    __syncthreads();
    if (t == 0) {
        int a = 0;
        for (int e = 0; e < 32; ++e) { tab[e] = a; tab[40 + e] = a * 128; a += (tab[80 + e * 9 + 8] + 127) >> 7; }
        tab[32] = a; tab[72] = a * 128;
    }
    __syncthreads();
}
template <int MODE>
__device__ void phase_expert(const Params& p, int l, bf16_t* lds) {
    const int tid = ltid(), lane = tid & 63, w = tid >> 6, wx = w >> 1, wy = w & 1, fr = lane & 15, fg = lane >> 4;
    const unsigned* cnt = (const unsigned*)(p.ws + WS_CTL) + CW_CNT + l * 32 * NSH * CNT_STRIDE;
    int* tab = (int*)(lds + 4 * GSTAGE);
    moe_tables(cnt, tab);
    if (MODE == 0 && blockIdx.x == 0) {
        unsigned* mt = (unsigned*)(p.ws + WS_CTL) + CW_MOETAB + l * 32 * NSH;
        mt[threadIdx.x] = (unsigned)(tab[40 + (threadIdx.x >> 3)] + tab[80 + (threadIdx.x >> 3) * 9 + (threadIdx.x & 7)]);
    }
    const int* rowtok = (const int*)(p.ws + WS_ROWTOK);
    const bf16_t* hn = (const bf16_t*)(p.ws + WS_HN);
    bf16_t* Hb = (bf16_t*)(p.ws + WS_H);
    bf16_t* Yb = (bf16_t*)(p.ws + WS_Y);
    const int x = blockIdx.x & 7, loc = blockIdx.x >> 3, nloc = gridDim.x >> 3;
    for (int j = loc;; j += nloc) {
        int e = -1, rt = 0, tn = 0; int jj = j;
#pragma unroll
        for (int q = 0; q < 4; ++q) {
            int ee = q * 8 + x; int nrt = tab[ee + 1] - tab[ee];
            if (e < 0) { if (jj < nrt * 8) { e = ee; tn = jj / nrt; rt = jj % nrt; } else jj -= nrt * 8; }
        }
        if (e < 0) break;
        const int hrow0 = tab[40 + e] + rt * 128;
        f32x4 acc[4][4];
        if (MODE == 0) {
            const bf16_t* wbase = (const bf16_t*)(p.ws + WS_WGU) + ((size_t)l * 32 + e) * 1024 * 1024;
            const int* spx = tab + 80 + e * 9;
            auto rw = [&](int r) { return wbase + pl_off(tn * 128 + r, 0, 1024); };
            auto rt_ = [&](int r) {
                const int s = rt * 128 + r; int t = 0;
                if (s < spx[8]) {
                    int xs = 0;
#pragma unroll
                    for (int q = 1; q < NSH; ++q) xs += (s >= spx[q]) ? 1 : 0;
                    t = rowtok[(size_t)(e * NSH + xs) * SHCAP + (s - spx[xs])];
                }
                return hn + pl_off(t, 0, 1024); };
            gemm_core(rw, rt_, 1024, lds, acc);
        } else {
            const bf16_t* wbase = (const bf16_t*)(p.ws + WS_WD) + ((size_t)l * 32 + e) * 1024 * 512;
            auto rw = [&](int r) { return wbase + pl_off(tn * 128 + r, 0, 512); };
            auto rt_ = [&](int r) { return Hb + pl_off(hrow0 + r, 0, 512); };
            gemm_core(rw, rt_, 512, lds, acc);
        }
        RAW_BARRIER();
        if (MODE == 0) {
#pragma unroll
            for (int n = 0; n < 4; ++n)
#pragma unroll
                for (int m = 0; m < 2; ++m)
                    ep_put<64>(lds, wy * 64 + n * 16 + fr, wx * 32 + m * 16 + 4 * fg, siluf_(acc[m][n][0]) * acc[m + 2][n][0], siluf_(acc[m][n][1]) * acc[m + 2][n][1],
                               siluf_(acc[m][n][2]) * acc[m + 2][n][2], siluf_(acc[m][n][3]) * acc[m + 2][n][3]);
            RAW_BARRIER();
            ep_flush<64>(lds, tid, [&](int row, int c8) { return Hb + pl_off(hrow0 + row, tn * 64 + c8 * 8, 512); });
        } else {
#pragma unroll
            for (int n = 0; n < 4; ++n)
#pragma unroll
                for (int m = 0; m < 4; ++m) ep_put<128>(lds, wy * 64 + n * 16 + fr, wx * 64 + m * 16 + 4 * fg, acc[m][n][0], acc[m][n][1], acc[m][n][2], acc[m][n][3]);
            RAW_BARRIER();
            bf16_t* dstb = Yb + (size_t)hrow0 * 1024 + tn * 128;
            ep_flush<128>(lds, tid, [&](int row, int c8) { return dstb + (size_t)row * 1024 + c8 * 8; });
        }
    }
}

__device__ void phase_combine(const Params& p, int l, int dry = 0) {
    const int tid = ltid(), lane = tid & 63, w = tid >> 6;
    const unsigned* mt = (const unsigned*)(p.ws + WS_CTL) + CW_MOETAB + l * 32 * NSH;
    const int* tslot = (const int*)(p.ws + WS_TSLOT);
    const float* tgate = (const float*)(p.ws + WS_TGATE);
    const bf16_t* Yb = (const bf16_t*)(p.ws + WS_Y);
    bf16_t* hn = dry ? (bf16_t*)(p.ws + WS_SCR + (size_t)40 * 1024 * 1024) : (bf16_t*)(p.ws + WS_HN);
    float* x = p.out; float* xw = dry ? (float*)(p.ws + WS_SCR) : p.out;
    const float* gain = (l == 0 || dry) ? p.in[1] + 1024 : nullptr;
    for (int it = blockIdx.x; it < NTOK / 4; it += gridDim.x) {
        int t = it * 4 + w;
        int ts0 = tslot[t * 2], ts1 = tslot[t * 2 + 1];
        float g0 = tgate[t * 2], g1 = tgate[t * 2 + 1];
        int r0 = (int)mt[((ts0 >> 16) << 3) | ((ts0 >> 11) & 7)] + (ts0 & 0x7ff);
        int r1 = (int)mt[((ts1 >> 16) << 3) | ((ts1 >> 11) & 7)] + (ts1 & 0x7ff);
        float* xr = x + (size_t)t * 1024 + lane * 16;
        const bf16_t* y0 = Yb + (size_t)r0 * 1024 + lane * 16;
        const bf16_t* y1 = Yb + (size_t)r1 * 1024 + lane * 16;
        float v[16];
#pragma unroll
        for (int i = 0; i < 4; ++i) { float4 q = *(const float4*)(xr + 4 * i); v[4 * i] = q.x; v[4 * i + 1] = q.y; v[4 * i + 2] = q.z; v[4 * i + 3] = q.w; }
        uint4 a0 = *(const uint4*)y0, a1 = *(const uint4*)(y0 + 8), b0 = *(const uint4*)y1, b1 = *(const uint4*)(y1 + 8);
        unsigned ya[8] = {a0.x, a0.y, a0.z, a0.w, a1.x, a1.y, a1.z, a1.w};
        unsigned yb[8] = {b0.x, b0.y, b0.z, b0.w, b1.x, b1.y, b1.z, b1.w};
#pragma unroll
        for (int i = 0; i < 8; ++i) {
            v[2 * i] += g0 * bflo(ya[i]) + g1 * bflo(yb[i]);
            v[2 * i + 1] += g0 * bfhi(ya[i]) + g1 * bfhi(yb[i]);
        }
#ifdef NANMARK
#pragma unroll
        for (int i = 0; i < 16; ++i) if (!(fabsf(v[i]) < 1e30f)) v[i] = 1000.f;
#endif
#pragma unroll
        for (int i = 0; i < 4; ++i) *(float4*)(xw + (size_t)t * 1024 + lane * 16 + 4 * i) = make_float4(v[4 * i], v[4 * i + 1], v[4 * i + 2], v[4 * i + 3]);
        if (gain) {
            float ss = 0.f;
#pragma unroll
            for (int i = 0; i < 16; ++i) ss += v[i] * v[i];
            ss = wave_sum(ss);
            float r = rsqrtf(ss / D_MODEL + 1e-6f);
#pragma unroll
            for (int i = 0; i < 16; ++i) v[i] = v[i] * r * gain[lane * 16 + i];
            uint4 o0, o1;
            o0.x = pk_bf16(v[0], v[1]); o0.y = pk_bf16(v[2], v[3]); o0.z = pk_bf16(v[4], v[5]); o0.w = pk_bf16(v[6], v[7]);
            o1.x = pk_bf16(v[8], v[9]); o1.y = pk_bf16(v[10], v[11]); o1.z = pk_bf16(v[12], v[13]); o1.w = pk_bf16(v[14], v[15]);
            bf16_t* hr = hn + pl_off(t, lane * 16, 1024);
            *(uint4*)hr = o0; *(uint4*)(hr + 8) = o1;
        }
    }
}


__device__ __forceinline__ void mm_row(const bf16_t* RA, const bf16_t* RB, int mw, int fr, int fg, f32x4 (&acc)[4]) {
#pragma unroll
    for (int ks = 0; ks < 2; ++ks) {
        bf16x8 a = *(const bf16x8*)(RA + (16 * mw + fr) * LROW + ks * 32 + fg * 8);
#pragma unroll
        for (int nt = 0; nt < 4; ++nt) {
            bf16x8 b = *(const bf16x8*)(RB + (16 * nt + fr) * LROW + ks * 32 + fg * 8);
            acc[nt] = __builtin_amdgcn_mfma_f32_16x16x32_bf16(a, b, acc[nt], 0, 0, 0);
        }
    }
}
__device__ __forceinline__ void mm_col(const bf16_t* RA, const bf16_t* RB, int nw, int fr, int fg, f32x4 (&acc)[4]) {
#pragma unroll
    for (int ks = 0; ks < 2; ++ks) {
        bf16x8 b = *(const bf16x8*)(RB + (16 * nw + fr) * LROW + ks * 32 + fg * 8);
#pragma unroll
        for (int mt = 0; mt < 4; ++mt) {
            bf16x8 a = *(const bf16x8*)(RA + (16 * mt + fr) * LROW + ks * 32 + fg * 8);
            acc[mt] = __builtin_amdgcn_mfma_f32_16x16x32_bf16(a, b, acc[mt], 0, 0, 0);
        }
    }
}
__device__ __forceinline__ void zero4(f32x4 (&a)[4]) {
#pragma unroll
    for (int i = 0; i < 4; ++i) a[i] = (f32x4){0.f, 0.f, 0.f, 0.f};
}
__device__ __forceinline__ void st4_lds(bf16_t* p, float a, float b, float c, float d) { uint2 o; o.x = pk_bf16(a, b); o.y = pk_bf16(c, d); *(uint2*)p = o; }
__device__ __forceinline__ bf16_t f2bf(float v) { return (bf16_t)(pk_bf16(v, 0.f) & 0xffffu); }

__device__ void gdn_prep_item(const Params& p, int l, int cid, unsigned char* lds_raw) {
    const int tid = ltid(), lane = tid & 63, w = tid >> 6, fr = lane & 15, fg = lane >> 4;
    const int bh = cid >> 6, n = cid & 63, b = bh / H_GDN, h = bh % H_GDN;
    const int t0 = b * SEQ + n * 64;
    bf16_t* L0 = (bf16_t*)lds_raw; bf16_t* L1 = L0 + 64 * LROW; bf16_t* L2 = L1 + 64 * LROW; bf16_t* L3 = L2 + 64 * LROW; bf16_t* L4 = L3 + 64 * LROW; bf16_t* L5 = L4 + 64 * LROW;
    float* dec = (float*)(L5 + 64 * LROW); float* beta = dec + 64;
    const bf16_t* proj = (const bf16_t*)(p.ws + WS_PROJ);
    const float* aux = (const float*)(p.ws + WS_AUX);
    const float* convw = p.in[7] + (size_t)l * 4 * 1152;
    __syncthreads();
    const int i = tid >> 2, c0 = (tid & 3) * 16;
    float qv[16], kv[16], vv[16];
#pragma unroll
    for (int which = 0; which < 3; ++which) {
        float acc[16];
#pragma unroll
        for (int c = 0; c < 16; ++c) acc[c] = 0.f;
#pragma unroll
        for (int tap = 0; tap < 4; ++tap) {
            const int row = i - 3 + tap;
            if (n * 64 + row >= 0) {
                const bf16_t* xp = proj + (size_t)(t0 + row) * NPROJ + NC_GQ + which * 384 + h * 64 + c0;
                u32x4 x0 = *(const u32x4*)xp, x1 = *(const u32x4*)(xp + 8);
                const float* wp = convw + tap * 1152 + which * 384 + h * 64 + c0;
                f32x4 w0 = *(const f32x4*)wp, w1 = *(const f32x4*)(wp + 4), w2 = *(const f32x4*)(wp + 8), w3 = *(const f32x4*)(wp + 12);
                float wv[16] = {w0[0], w0[1], w0[2], w0[3], w1[0], w1[1], w1[2], w1[3], w2[0], w2[1], w2[2], w2[3], w3[0], w3[1], w3[2], w3[3]};
                unsigned xs[8] = {x0[0], x0[1], x0[2], x0[3], x1[0], x1[1], x1[2], x1[3]};
#pragma unroll
                for (int c = 0; c < 8; ++c) { acc[2 * c] += wv[2 * c] * bflo(xs[c]); acc[2 * c + 1] += wv[2 * c + 1] * bfhi(xs[c]); }
            }
        }
        float ss = 0.f;
#pragma unroll
        for (int c = 0; c < 16; ++c) { acc[c] = siluf_(acc[c]); ss += acc[c] * acc[c]; }
        if (which < 2) {
            ss += __shfl_xor(ss, 1, 64); ss += __shfl_xor(ss, 2, 64);
            const float sc = rsqrtf(ss + 1e-6f) * (which == 0 ? 0.125f : 1.f);
#pragma unroll
            for (int c = 0; c < 16; ++c) acc[c] *= sc;
        }
#pragma unroll
        for (int c = 0; c < 16; ++c) { if (which == 0) qv[c] = acc[c]; else if (which == 1) kv[c] = acc[c]; else vv[c] = acc[c]; }
    }
#pragma unroll
    for (int c = 0; c < 16; c += 4) { st4_lds(L2 + i * LROW + c0 + c, kv[c], kv[c + 1], kv[c + 2], kv[c + 3]); st4_lds(L3 + i * LROW + c0 + c, qv[c], qv[c + 1], qv[c + 2], qv[c + 3]); }
    if (w == 0) {
        const float a = aux[(size_t)(t0 + lane) * 64 + AX_GA + h], bl = aux[(size_t)(t0 + lane) * 64 + AX_GB + h];
        const float g = -__expf(p.in[8][l * H_GDN + h]) * softplusf_(a + p.in[9][l * H_GDN + h]);
        float inc = g;
#pragma unroll
        for (int o = 1; o < 64; o <<= 1) { float t = __shfl_up(inc, o, 64); if (lane >= o) inc += t; }
        dec[lane] = inc; beta[lane] = sigmoidf_(bl);
    }
    __syncthreads();
    {
        f32x4 g4[4]; zero4(g4);
        mm_row(L2, L2, w, fr, fg, g4);
#pragma unroll
        for (int nt = 0; nt < 4; ++nt) {
            const int kap = 16 * nt + fr; const float dk_ = dec[kap], bk_ = beta[kap];
            float nT[4], nN[4], tt[4];
#pragma unroll
            for (int r = 0; r < 4; ++r) {
                const int rho = 16 * w + 4 * fg + r; const float dr_ = dec[rho], br_ = beta[rho];
                const float G = g4[nt][r];
                nT[r] = (kap < rho) ? br_ * G * __expf(dr_ - dk_) : 0.f;
                nN[r] = (rho < kap) ? bk_ * G * __expf(dk_ - dr_) : 0.f;
                tt[r] = ((kap == rho) ? 1.f : 0.f) - nN[r];
            }
            st4_lds(L1 + kap * LROW + 16 * w + 4 * fg, nT[0], nT[1], nT[2], nT[3]);
            st4_lds(L0 + kap * LROW + 16 * w + 4 * fg, nN[0], nN[1], nN[2], nN[3]);
            st4_lds(L4 + kap * LROW + 16 * w + 4 * fg, tt[0], tt[1], tt[2], tt[3]);
        }
        f32x4 a4[4]; zero4(a4);
        mm_row(L2, L3, w, fr, fg, a4);
#pragma unroll
        for (int nt = 0; nt < 4; ++nt) {
            const int ii = 16 * nt + fr; const float di_ = dec[ii];
            float v4[4];
#pragma unroll
            for (int r = 0; r < 4; ++r) { const int j = 16 * w + 4 * fg + r; v4[r] = (j <= ii) ? a4[nt][r] * __expf(di_ - dec[j]) : 0.f; }
            st4_lds(L5 + ii * LROW + 16 * w + 4 * fg, v4[0], v4[1], v4[2], v4[3]);
        }
    }
    __syncthreads();
#pragma unroll
    for (int lev = 1; lev <= 5; ++lev) {
        const bf16_t* XA = (lev & 1) ? L0 : L2; const bf16_t* XAt = (lev & 1) ? L1 : L3;
        bf16_t* XB = (lev & 1) ? L2 : L0; bf16_t* XBt = (lev & 1) ? L3 : L1;
        {
            f32x4 x4[4]; zero4(x4);
            mm_row(XA, XAt, w, fr, fg, x4);
#pragma unroll
            for (int nt = 0; nt < 4; ++nt) {
                const int c = 16 * nt + fr;
                st4_lds(XBt + c * LROW + 16 * w + 4 * fg, x4[nt][0], x4[nt][1], x4[nt][2], x4[nt][3]);
                if (lev < 5) {
#pragma unroll
                    for (int r = 0; r < 4; ++r) XB[(16 * w + 4 * fg + r) * LROW + c] = f2bf(x4[nt][r]);
                }
            }
        }
        __syncthreads();
        {
            f32x4 t4[4];
#pragma unroll
            for (int mt = 0; mt < 4; ++mt) {
                uint2 u = *(const uint2*)(L4 + (16 * w + fr) * LROW + 16 * mt + 4 * fg);
                t4[mt] = (f32x4){bflo(u.x), bfhi(u.x), bflo(u.y), bfhi(u.y)};
            }
            mm_col(XBt, L4, w, fr, fg, t4);
#pragma unroll
            for (int mt = 0; mt < 4; ++mt) st4_lds(L4 + (16 * w + fr) * LROW + 16 * mt + 4 * fg, t4[mt][0], t4[mt][1], t4[mt][2], t4[mt][3]);
        }
    }
    {
        const float dj = dec[i], bj = beta[i], dlast = dec[63];
        const float s1 = bj * __expf(dj), s2 = bj, s3 = __expf(dlast - dj);
#pragma unroll
        for (int c = 0; c < 16; ++c) {
            L0[(c0 + c) * LROW + i] = f2bf(kv[c] * s1);
            L1[(c0 + c) * LROW + i] = f2bf(vv[c] * s2);
            L2[(c0 + c) * LROW + i] = f2bf(kv[c] * s3);
        }
    }
    __syncthreads();
    {
        f32x4 w4[4], u4[4]; zero4(w4); zero4(u4);
        mm_row(L4, L0, w, fr, fg, w4);
        mm_row(L4, L1, w, fr, fg, u4);
        __syncthreads();
#pragma unroll
        for (int nt = 0; nt < 4; ++nt) {
            st4_lds(L0 + (16 * nt + fr) * LROW + 16 * w + 4 * fg, w4[nt][0], w4[nt][1], w4[nt][2], w4[nt][3]);
            st4_lds(L1 + (16 * nt + fr) * LROW + 16 * w + 4 * fg, u4[nt][0], u4[nt][1], u4[nt][2], u4[nt][3]);
        }
        const float ed = __expf(dec[i]);
#pragma unroll
        for (int c = 0; c < 16; c += 4) st4_lds(L3 + i * LROW + c0 + c, qv[c] * ed, qv[c + 1] * ed, qv[c + 2] * ed, qv[c + 3] * ed);
    }
    __syncthreads();
    char* scr = p.ws + WS_SCR;
    {
        f32x4 m4[4]; zero4(m4);
        mm_row(L0, L2, w, fr, fg, m4);
        bf16_t* MP = (bf16_t*)(scr + SCR_GDN_MP) + (size_t)cid * 4096;
#pragma unroll
        for (int nt = 0; nt < 4; ++nt) store4_bf16(MP + (16 * nt + fr) * 64 + 16 * w + 4 * fg, -m4[nt][0], -m4[nt][1], -m4[nt][2], -m4[nt][3]);
        f32x4 n4[4]; zero4(n4);
        mm_row(L2, L1, w, fr, fg, n4);
        bf16_t* NN = (bf16_t*)(scr + SCR_GDN_NN) + (size_t)cid * 4096;
#pragma unroll
        for (int nt = 0; nt < 4; ++nt) store4_bf16(NN + ((nt * 4 + w) * 64 + lane) * 4, n4[nt][0], n4[nt][1], n4[nt][2], n4[nt][3]);
        f32x4 p4[4]; zero4(p4);
        mm_row(L0, L5, w, fr, fg, p4);
        bf16_t* PG = (bf16_t*)(scr + SCR_GDN_P) + (size_t)cid * 4096;
#pragma unroll
        for (int nt = 0; nt < 4; ++nt) {
            uint2 u = *(const uint2*)(L3 + (16 * nt + fr) * LROW + 16 * w + 4 * fg);
            store4_bf16(PG + (16 * nt + fr) * 64 + 16 * w + 4 * fg, bflo(u.x) - p4[nt][0], bfhi(u.x) - p4[nt][1], bflo(u.y) - p4[nt][2], bfhi(u.y) - p4[nt][3]);
        }
        f32x4 o4[4]; zero4(o4);
        mm_row(L1, L5, w, fr, fg, o4);
        bf16_t* OL = (bf16_t*)(scr + SCR_GDN_OL) + (size_t)cid * 4096;
#pragma unroll
        for (int nt = 0; nt < 4; ++nt) store4_bf16(OL + (16 * nt + fr) * 64 + 16 * w + 4 * fg, o4[nt][0], o4[nt][1], o4[nt][2], o4[nt][3]);
        if (tid == 0) ((float*)(scr + SCR_GDN_LAST))[cid] = __expf(dec[63]);
    }
}

#define SCAN_SLOT    5120
#define SCAN_SB(k)   ((bf16_t*)lds_raw + (k) * 1024)
#define SCAN_RING(k) ((bf16_t*)lds_raw + 2048 + (k) * SCAN_SLOT)
#define SCAN_LAST    ((float*)(lds_raw + 4096 + 5 * SCAN_SLOT * 2))
__device__ __forceinline__ void scan_issue(const bf16_t* const (&mp)[8], const bf16_t* nn_lane, int n, bf16_t* slot) {
#pragma unroll
    for (int q = 0; q < 8; ++q) __builtin_amdgcn_global_load_lds((const unsigned*)(mp[q] + (size_t)n * 4096), (unsigned*)(slot + q * 512), 16, 0, 0);
    __builtin_amdgcn_global_load_lds((const unsigned*)(nn_lane + (size_t)n * 4096), (unsigned*)(slot + 4096), 16, 0, 0);
    __builtin_amdgcn_global_load_lds((const unsigned*)(nn_lane + (size_t)n * 4096 + 512), (unsigned*)(slot + 4096 + 512), 16, 0, 0);
}
__device__ void gdn_scan_item(const Params& p, int item, unsigned char* lds_raw, int svar = 0) {
    const int tid = ltid(), lane = tid & 63, w = __builtin_amdgcn_readfirstlane(tid >> 6), fr = lane & 15, fg = lane >> 4;
    const int bh = item >> 2, cg = item & 3;
    char* scr = p.ws + WS_SCR;
    const bf16_t* MP = (const bf16_t*)(scr + SCR_GDN_MP) + (size_t)bh * 64 * 4096;
    const bf16_t* NN = (const bf16_t*)(scr + SCR_GDN_NN) + (size_t)bh * 64 * 4096 + cg * 1024;
    const float* LAST = (const float*)(scr + SCR_GDN_LAST) + bh * 64;
    bf16_t* SG = (bf16_t*)(scr + SCR_GDN_SG) + (size_t)bh * 64 * 4096 + cg * 1024;
    const bf16_t* mp[8];
#pragma unroll
    for (int q = 0; q < 8; ++q) { const int row = 8 * q + (lane >> 3); mp[q] = MP + row * 64 + (((lane & 7) ^ ((row >> 1) & 7)) * 8); }
    const bf16_t* nn_lane = NN + lane * 8;
    RAW_BARRIER();
    if (tid < 64) SCAN_LAST[tid] = ld_f32_agent(LAST + tid);
    asm volatile("s_waitcnt vmcnt(0)" ::: "memory");
    f32x4 S = (f32x4){0.f, 0.f, 0.f, 0.f};
    const int swz = (fr >> 1) & 7;
    if (w == 0) {
#pragma unroll
        for (int n = 0; n < 4; ++n) scan_issue(mp, nn_lane, n, SCAN_RING(n));
    }
    for (int n = 0; n < 64; ++n) {
        bf16_t* sb = SCAN_SB(n & 1);
        const bf16_t* ring = SCAN_RING(n % 5);
        {
            const int c = 2 * w + (fg >> 1);
            uint2 o; o.x = pk_bf16(S[0], S[1]); o.y = pk_bf16(S[2], S[3]);
            *(uint2*)(sb + fr * 64 + ((c ^ swz) * 8) + 4 * (fg & 1)) = o;
        }
        if (w == 0) {
            if (n + 3 < 64) asm volatile("s_waitcnt vmcnt(30)" ::: "memory");
            else if (n + 2 < 64) asm volatile("s_waitcnt vmcnt(20)" ::: "memory");
            else if (n + 1 < 64) asm volatile("s_waitcnt vmcnt(10)" ::: "memory");
            else asm volatile("s_waitcnt vmcnt(0)" ::: "memory");
        }
        RAW_BARRIER();
        if (w == 0 && n + 4 < 64 && svar != 2) scan_issue(mp, nn_lane, n + 4, SCAN_RING((n + 4) % 5));
        const float last = SCAN_LAST[n];
        {
            u32x2 nn = *(const u32x2*)(ring + 4096 + (w * 64 + lane) * 4);
            S[0] = last * S[0] + bflo(nn[0]); S[1] = last * S[1] + bfhi(nn[0]);
            S[2] = last * S[2] + bflo(nn[1]); S[3] = last * S[3] + bfhi(nn[1]);
        }
#pragma unroll
        for (int ks = 0; ks < 2; ++ks) {
            const int co = ((ks * 4 + fg) ^ swz) * 8;
            bf16x8 a = *(const bf16x8*)(ring + (16 * w + fr) * 64 + co);
            bf16x8 s = *(const bf16x8*)(sb + fr * 64 + co);
            S = __builtin_amdgcn_mfma_f32_16x16x32_bf16(a, s, S, 0, 0, 0);
        }
        if (w >= 2 && svar != 1) {
            const int c = (w - 2) * 64 + lane; const int row = c >> 3, pc = c & 7;
            u32x4 v = *(const u32x4*)(sb + row * 64 + pc * 8);
            *(u32x4*)(SG + (size_t)n * 4096 + row * 64 + ((pc ^ ((row >> 1) & 7)) * 8)) = v;
        }
    }
}

__device__ void gdn_out_item(const Params& p, int l, int cid) {
    const int tid = ltid(), lane = tid & 63, w = tid >> 6, fr = lane & 15, fg = lane >> 4;
    const int bh = cid >> 6, n = cid & 63, b = bh / H_GDN, h = bh % H_GDN;
    char* scr = p.ws + WS_SCR;
    const bf16_t* SG = (const bf16_t*)(scr + SCR_GDN_SG) + (size_t)cid * 4096;
    const bf16_t* PG = (const bf16_t*)(scr + SCR_GDN_P) + (size_t)cid * 4096;
    const bf16_t* OL = (const bf16_t*)(scr + SCR_GDN_OL) + (size_t)cid * 4096;
    const int i = 16 * w + fr; const int t = b * SEQ + n * 64 + i;
    f32x4 acc[4];
#pragma unroll
    for (int mt = 0; mt < 4; ++mt) { uint2 u = *(const uint2*)(OL + i * 64 + 16 * mt + 4 * fg); acc[mt] = (f32x4){bflo(u.x), bfhi(u.x), bflo(u.y), bfhi(u.y)}; }
#pragma unroll
    for (int ks = 0; ks < 2; ++ks) {
        bf16x8 bq = *(const bf16x8*)(PG + i * 64 + ks * 32 + fg * 8);
#pragma unroll
        for (int mt = 0; mt < 4; ++mt) {
            bf16x8 a = *(const bf16x8*)(SG + (16 * mt + fr) * 64 + ks * 32 + fg * 8);
            acc[mt] = __builtin_amdgcn_mfma_f32_16x16x32_bf16(a, bq, acc[mt], 0, 0, 0);
        }
    }
    float ss = 0.f;
#pragma unroll
    for (int mt = 0; mt < 4; ++mt)
#pragma unroll
        for (int r = 0; r < 4; ++r) ss += acc[mt][r] * acc[mt][r];
    ss += __shfl_xor(ss, 16, 64); ss += __shfl_xor(ss, 32, 64);
    const float rstd = rsqrtf(ss * (1.f / 64.f) + 1e-6f);
    const float* og = p.in[10] + l * 64;
    const bf16_t* gp = (const bf16_t*)(p.ws + WS_PROJ) + (size_t)t * NPROJ + NC_GG + h * 64;
    bf16_t* mp = (bf16_t*)(p.ws + WS_MIX) + pl_off(t, 384 + h * 64, 1024);
#pragma unroll
    for (int mt = 0; mt < 4; ++mt) {
        const int e0 = 16 * mt + 4 * fg;
        uint2 gu = *(const uint2*)(gp + e0); f32x4 g4 = *(const f32x4*)(og + e0);
        store4_bf16(mp + e0 + (e0 & 32), acc[mt][0] * rstd * g4[0] * bflo(gu.x), acc[mt][1] * rstd * g4[1] * bfhi(gu.x), acc[mt][2] * rstd * g4[2] * bflo(gu.y), acc[mt][3] * rstd * g4[3] * bfhi(gu.y));
    }
}

#define GQROW 40
__device__ void gla_prep_item(const Params& p, int l, int cid, unsigned char* lds_raw) {
    const int tid = ltid(), lane = tid & 63, w = tid >> 6, fr = lane & 15, fg = lane >> 4;
    const int bh = cid >> 6, n = cid & 63, b = bh / H_GLA, h = bh % H_GLA;
    const int t0 = b * SEQ + n * 64;
    float* Bf = (float*)lds_raw;
    bf16_t* Qt = (bf16_t*)(lds_raw + 8448);
    bf16_t* Kt = Qt + 64 * GQROW;
    bf16_t* KLt = Kt + 64 * GQROW;
    bf16_t* Vt = KLt + 32 * LROW;
    const bf16_t* proj = (const bf16_t*)(p.ws + WS_PROJ);
    const float* aux = (const float*)(p.ws + WS_AUX);
    char* scr = p.ws + WS_SCR;
    __syncthreads();
    const int i = tid >> 2, d0 = (tid & 3) * 8;
    {
        const float* wa = p.in[11] + (size_t)l * 16 * 128 + h * 32 + d0;
        const float* ba = p.in[12] + l * 128 + h * 32 + d0;
        float acc[8];
#pragma unroll
        for (int j = 0; j < 8; ++j) acc[j] = ba[j];
        float a1v[16];
#pragma unroll
        for (int r = 0; r < 16; r += 2) { float2 t2 = *(const float2*)(aux + (size_t)(t0 + i) * 64 + AX_LA + r); a1v[r] = t2.x; a1v[r + 1] = t2.y; }
#pragma unroll
        for (int r = 0; r < 16; ++r) {
            f32x4 wA = *(const f32x4*)(wa + r * 128), wB = *(const f32x4*)(wa + r * 128 + 4);
#pragma unroll
            for (int j = 0; j < 4; ++j) { acc[j] += a1v[r] * wA[j]; acc[4 + j] += a1v[r] * wB[j]; }
        }
#pragma unroll
        for (int j = 0; j < 8; ++j) Bf[i * 33 + d0 + j] = logsigmoidf_(acc[j]) * (1.f / 16.f);
    }
    {
        const bf16_t* lvt = (const bf16_t*)(scr + SCR_LVT) + (size_t)bh * 64 * SEQ + n * 64;
#pragma unroll
        for (int ii = 0; ii < 2; ++ii) { int c = tid + 256 * ii; int row = c >> 3, kc = c & 7; *(u32x4*)(Vt + row * LROW + kc * 8) = *(const u32x4*)(lvt + (size_t)row * SEQ + kc * 8); }
    }
    __syncthreads();
#pragma unroll
    for (int c = 0; c < 8; ++c) {
        const int d = 8 * w + c;
        float inc = Bf[lane * 33 + d];
#pragma unroll
        for (int o = 1; o < 64; o <<= 1) { float t = __shfl_up(inc, o, 64); if (lane >= o) inc += t; }
        Bf[lane * 33 + d] = inc;
    }
    __syncthreads();
    {
        const bf16_t* qp = proj + (size_t)(t0 + i) * NPROJ + NC_LQ + h * 32 + d0;
        const bf16_t* kp = proj + (size_t)(t0 + i) * NPROJ + NC_LK + h * 32 + d0;
        u32x4 qu = *(const u32x4*)qp, ku = *(const u32x4*)kp;
        float qf[8] = {bflo(qu[0]), bfhi(qu[0]), bflo(qu[1]), bfhi(qu[1]), bflo(qu[2]), bfhi(qu[2]), bflo(qu[3]), bfhi(qu[3])};
        float kf[8] = {bflo(ku[0]), bfhi(ku[0]), bflo(ku[1]), bfhi(ku[1]), bflo(ku[2]), bfhi(ku[2]), bflo(ku[3]), bfhi(ku[3])};
        float qt[8], kt[8], qb[8];
#pragma unroll
        for (int j = 0; j < 8; ++j) {
            const float bi = Bf[i * 33 + d0 + j], bm = Bf[31 * 33 + d0 + j], bl = Bf[63 * 33 + d0 + j];
            qt[j] = qf[j] * __expf(bi - bm); kt[j] = kf[j] * __expf(bm - bi); qb[j] = qf[j] * __expf(bi);
            KLt[(d0 + j) * LROW + i] = f2bf(kf[j] * __expf(bl - bi));
            if (i == 63) ((float*)(scr + SCR_GLA_DL))[cid * 32 + d0 + j] = __expf(bl);
        }
        u32x4 o; o[0] = pk_bf16(qt[0], qt[1]); o[1] = pk_bf16(qt[2], qt[3]); o[2] = pk_bf16(qt[4], qt[5]); o[3] = pk_bf16(qt[6], qt[7]);
        *(u32x4*)(Qt + i * GQROW + d0) = o;
        o[0] = pk_bf16(kt[0], kt[1]); o[1] = pk_bf16(kt[2], kt[3]); o[2] = pk_bf16(kt[4], kt[5]); o[3] = pk_bf16(kt[6], kt[7]);
        *(u32x4*)(Kt + i * GQROW + d0) = o;
        o[0] = pk_bf16(qb[0], qb[1]); o[1] = pk_bf16(qb[2], qb[3]); o[2] = pk_bf16(qb[4], qb[5]); o[3] = pk_bf16(qb[6], qb[7]);
        *(u32x4*)((bf16_t*)(scr + SCR_GLA_QB) + (size_t)cid * 2048 + i * 32 + d0) = o;
    }
    __syncthreads();
    f32x4 sc[4];
    {
        bf16x8 bq = *(const bf16x8*)(Qt + (16 * w + fr) * GQROW + fg * 8);
#pragma unroll
        for (int mt = 0; mt < 4; ++mt) {
            bf16x8 a = *(const bf16x8*)(Kt + (16 * mt + fr) * GQROW + fg * 8);
            sc[mt] = __builtin_amdgcn_mfma_f32_16x16x32_bf16(a, bq, (f32x4){0.f, 0.f, 0.f, 0.f}, 0, 0, 0);
        }
        const int ii = 16 * w + fr;
#pragma unroll
        for (int mt = 0; mt < 4; ++mt)
#pragma unroll
            for (int r = 0; r < 4; ++r) { const int j = 16 * mt + 4 * fg + r; if (j > ii) sc[mt][r] = 0.f; }
    }
    {
        f32x4 o4[4]; zero4(o4);
#pragma unroll
        for (int kk = 0; kk < 2; ++kk) {
            u32x4 pb = {pk_bf16(sc[2 * kk][0], sc[2 * kk][1]), pk_bf16(sc[2 * kk][2], sc[2 * kk][3]), pk_bf16(sc[2 * kk + 1][0], sc[2 * kk + 1][1]), pk_bf16(sc[2 * kk + 1][2], sc[2 * kk + 1][3])};
#pragma unroll
            for (int mt = 0; mt < 4; ++mt) {
                uint2 v0 = *(const uint2*)(Vt + (16 * mt + fr) * LROW + 32 * kk + 4 * fg), v1 = *(const uint2*)(Vt + (16 * mt + fr) * LROW + 32 * kk + 16 + 4 * fg);
                u32x4 va = {v0.x, v0.y, v1.x, v1.y};
                o4[mt] = __builtin_amdgcn_mfma_f32_16x16x32_bf16(__builtin_bit_cast(bf16x8, va), __builtin_bit_cast(bf16x8, pb), o4[mt], 0, 0, 0);
            }
        }
        bf16_t* OL = (bf16_t*)(scr + SCR_GLA_OL) + (size_t)cid * 4096;
#pragma unroll
        for (int mt = 0; mt < 4; ++mt) store4_bf16(OL + (16 * w + fr) * 64 + 16 * mt + 4 * fg, o4[mt][0], o4[mt][1], o4[mt][2], o4[mt][3]);
    }
    {
        f32x4 k4[2] = {(f32x4){0.f, 0.f, 0.f, 0.f}, (f32x4){0.f, 0.f, 0.f, 0.f}};
#pragma unroll
        for (int ks = 0; ks < 2; ++ks) {
            bf16x8 bv = *(const bf16x8*)(Vt + (16 * w + fr) * LROW + ks * 32 + fg * 8);
#pragma unroll
            for (int mt = 0; mt < 2; ++mt) {
                bf16x8 a = *(const bf16x8*)(KLt + (16 * mt + fr) * LROW + ks * 32 + fg * 8);
                k4[mt] = __builtin_amdgcn_mfma_f32_16x16x32_bf16(a, bv, k4[mt], 0, 0, 0);
            }
        }
        float* KV = (float*)(scr + SCR_GLA_KV) + (size_t)cid * 2048;
#pragma unroll
        for (int mt = 0; mt < 2; ++mt) *(f32x4*)(KV + (16 * w + fr) * 32 + 16 * mt + 4 * fg) = k4[mt];
    }
}
__device__ void gla_scan_item(const Params& p, int g) {
    const int tid = ltid();
    const int bh = g >> 3, idx = (g & 7) * 256 + tid, d = idx & 31;
    char* scr = p.ws + WS_SCR;
    const float* __restrict__ KV = (const float*)(scr + SCR_GLA_KV) + (size_t)bh * 64 * 2048 + idx;
    const float* __restrict__ DL = (const float*)(scr + SCR_GLA_DL) + bh * 64 * 32 + d;
    bf16_t* __restrict__ SG = (bf16_t*)(scr + SCR_GLA_SG) + (size_t)bh * 64 * 2048 + idx;
    float S = 0.f;
    for (int n0 = 0; n0 < 64; n0 += 8) {
        float kv[8], dl[8];
#pragma unroll
        for (int u = 0; u < 8; ++u) { kv[u] = KV[(size_t)(n0 + u) * 2048]; dl[u] = DL[(n0 + u) * 32]; }
#pragma unroll
        for (int u = 0; u < 8; ++u) { SG[(size_t)(n0 + u) * 2048] = f2bf(S); S = dl[u] * S + kv[u]; }
    }
}
__device__ void gla_out_item(const Params& p, int l, int cid) {
    const int tid = ltid(), lane = tid & 63, w = tid >> 6, fr = lane & 15, fg = lane >> 4;
    const int bh = cid >> 6, n = cid & 63, b = bh / H_GLA, h = bh % H_GLA;
    char* scr = p.ws + WS_SCR;
    const bf16_t* SG = (const bf16_t*)(scr + SCR_GLA_SG) + (size_t)cid * 2048;
    const bf16_t* QB = (const bf16_t*)(scr + SCR_GLA_QB) + (size_t)cid * 2048;
    const bf16_t* OL = (const bf16_t*)(scr + SCR_GLA_OL) + (size_t)cid * 4096;
    const int i = 16 * w + fr; const int t = b * SEQ + n * 64 + i;
    f32x4 acc[4];
#pragma unroll
    for (int mt = 0; mt < 4; ++mt) { uint2 u = *(const uint2*)(OL + i * 64 + 16 * mt + 4 * fg); acc[mt] = (f32x4){bflo(u.x), bfhi(u.x), bflo(u.y), bfhi(u.y)}; }
    bf16x8 bq = *(const bf16x8*)(QB + i * 32 + fg * 8);
#pragma unroll
    for (int mt = 0; mt < 4; ++mt) {
        bf16x8 a = *(const bf16x8*)(SG + (16 * mt + fr) * 32 + fg * 8);
        acc[mt] = __builtin_amdgcn_mfma_f32_16x16x32_bf16(a, bq, acc[mt], 0, 0, 0);
    }
    float ss = 0.f;
#pragma unroll
    for (int mt = 0; mt < 4; ++mt)
#pragma unroll
        for (int r = 0; r < 4; ++r) ss += acc[mt][r] * acc[mt][r];
    ss += __shfl_xor(ss, 16, 64); ss += __shfl_xor(ss, 32, 64);
    const float rstd = rsqrtf(ss * (1.f / 64.f) + 1e-6f);
    const float* og = p.in[13] + l * 64;
    const bf16_t* rp = (const bf16_t*)(p.ws + WS_PROJ) + (size_t)t * NPROJ + NC_LR + h * 64;
    bf16_t* mp = (bf16_t*)(p.ws + WS_MIX) + pl_off(t, 768 + h * 64, 1024);
#pragma unroll
    for (int mt = 0; mt < 4; ++mt) {
        const int e0 = 16 * mt + 4 * fg;
        uint2 gu = *(const uint2*)(rp + e0); f32x4 g4 = *(const f32x4*)(og + e0);
        store4_bf16(mp + e0 + (e0 & 32), acc[mt][0] * rstd * g4[0] * bflo(gu.x), acc[mt][1] * rstd * g4[1] * bfhi(gu.x), acc[mt][2] * rstd * g4[2] * bflo(gu.y), acc[mt][3] * rstd * g4[3] * bfhi(gu.y));
    }
}
__device__ void phase_mixout(const Params& p, int l) {
    for (int it = blockIdx.x; it < NGDN_CH + NGLA_CH; it += gridDim.x) {
        if (it < NGDN_CH) { if (MIXSEL & 1) gdn_out_item(p, l, it); } else { if (MIXSEL & 2) gla_out_item(p, l, it - NGDN_CH); }
    }
}

__device__ void fox_cumsum_item(const Params& p, int l, int bh, float* ldsf) {
    const int tid = ltid(), lane = tid & 63, w = tid >> 6;
    const int b = bh / H_FOX, h = bh % H_FOX;
    const float* aux = (const float*)(p.ws + WS_AUX);
    float* cum = (float*)(p.ws + WS_CUM) + (size_t)bh * SEQ;
    const float fb = p.in[5][l * H_FOX + h];
    float v[16]; float s = 0.f;
#pragma unroll
    for (int i = 0; i < 16; ++i) { v[i] = logsigmoidf_(aux[(size_t)(b * SEQ + tid * 16 + i) * 64 + AX_FF + h] + fb); s += v[i]; }
    float inc = s;
#pragma unroll
    for (int o = 1; o < 64; o <<= 1) { float t = __shfl_up(inc, o, 64); if (lane >= o) inc += t; }
    __syncthreads();
    if (lane == 63) ldsf[w] = inc;
    __syncthreads();
    float base = inc - s;
    for (int ww = 0; ww < w; ++ww) base += ldsf[ww];
    float c = base;
    u32x4* csx = (u32x4*)(p.ws + WS_SCR + SCR_CSX) + (size_t)bh * SEQ;
#pragma unroll
    for (int i = 0; i < 16; ++i) {
        c += v[i]; cum[tid * 16 + i] = c;
        const float vv = 1.4426950408889634f * c;
        const unsigned hi = pk_bf16(vv, 0.f) & 0xffffu; const float r1 = vv - __uint_as_float(hi << 16);
        const unsigned mid = pk_bf16(r1, 0.f) & 0xffffu; const float r2 = r1 - __uint_as_float(mid << 16);
        const unsigned lo = pk_bf16(r2, 0.f) & 0xffffu;
        u32x4 f; f[0] = 0x3F803F80u; f[1] = 0x3F80u | ((hi ^ 0x8000u) << 16); f[2] = (mid ^ 0x8000u) | ((lo ^ 0x8000u) << 16); f[3] = 0u;
        csx[tid * 16 + i] = f;
    }
}
__device__ void phase_prep(const Params& p, int l, unsigned char* lds_raw) {
    const int n0 = BATCH * H_FOX, n1 = n0 + ((MIXSEL & 1) ? NGDN_CH : 0), n2 = n1 + ((MIXSEL & 2) ? NGLA_CH : 0);
    for (int it = blockIdx.x; it < n2; it += gridDim.x) {
        if (it < n0) { __syncthreads(); fox_cumsum_item(p, l, it, (float*)lds_raw); }
        else if (it < n1) gdn_prep_item(p, l, it - n0, lds_raw);
        else gla_prep_item(p, l, it - n1, lds_raw);
    }
}

typedef float f32x16 __attribute__((ext_vector_type(16)));
#define ATT_BUF 17408
#define ATT_THR 8.0f
#define ATT_NSTAGE 3
__device__ __forceinline__ void attn_issue(const bf16_t* const (&kp)[2], const bf16_t* const (&vp)[2], const bf16_t* cp, int s0, unsigned char* stage, int w) {
    bf16_t* Ks = (bf16_t*)stage; bf16_t* Vs = Ks + 4096; bf16_t* cs = Vs + 4096;
    __builtin_amdgcn_global_load_lds((const unsigned*)(kp[0] + (size_t)s0 * NPROJ), (unsigned*)(Ks + (w * 8) * 64), 16, 0, 0);
    __builtin_amdgcn_global_load_lds((const unsigned*)(kp[1] + (size_t)s0 * NPROJ), (unsigned*)(Ks + (32 + w * 8) * 64), 16, 0, 0);
    __builtin_amdgcn_global_load_lds((const unsigned*)(vp[0] + s0), (unsigned*)(Vs + (w * 8) * 64), 16, 0, 0);
    __builtin_amdgcn_global_load_lds((const unsigned*)(vp[1] + s0), (unsigned*)(Vs + (32 + w * 8) * 64), 16, 0, 0);
    __builtin_amdgcn_global_load_lds((const unsigned*)(cp + (size_t)s0 * 8), (unsigned*)cs, 16, 0, 0);
}
__device__ __forceinline__ bf16x8 attn_qbias(float u, int h) {
    const unsigned hi = pk_bf16(u, 0.f) & 0xffffu; const float r1 = u - __uint_as_float(hi << 16);
    const unsigned mid = pk_bf16(r1, 0.f) & 0xffffu; const float r2 = r1 - __uint_as_float(mid << 16);
    const unsigned lo = pk_bf16(r2, 0.f) & 0xffffu;
    u32x4 f; f[0] = hi | (mid << 16); f[1] = lo | (0x3F80u << 16); f[2] = 0x3F803F80u; f[3] = 0u;
    if (h) { f[0] = 0u; f[1] = 0u; f[2] = 0u; }
    return __builtin_bit_cast(bf16x8, f);
}
__device__ void fox_attn_item(const Params& p, int l, int bh, int qt, unsigned char* lds_raw) {
    const int tid = ltid(), lane = tid & 63, w = __builtin_amdgcn_readfirstlane(tid >> 6), r = lane & 31, h = lane >> 5;
    const int b = bh / H_FOX, hh = bh % H_FOX;
    const bf16_t* proj = (const bf16_t*)(p.ws + WS_PROJ);
    const bf16_t* kbase = proj + (size_t)b * SEQ * NPROJ + NC_FK + hh * 64;
    const bf16_t* vbase = (const bf16_t*)(p.ws + WS_VTF) + (size_t)bh * 64 * SEQ;
    const float* cum = (const float*)(p.ws + WS_CUM) + (size_t)bh * SEQ;
    const int qlo = qt * 128 + w * 32, q = qlo + r;
    bf16x8 qf[4];
    {
        const bf16_t* qrow = proj + (size_t)(b * SEQ + q) * NPROJ + NC_FQ + hh * 64;
#pragma unroll
        for (int kk = 0; kk < 4; ++kk) qf[kk] = *(const bf16x8*)(qrow + kk * 16 + h * 8);
    }
    const float cq2 = cum[q] * 1.4426950408889634f;
    float mref = 0.f;
    bf16x8 qx = attn_qbias(cq2 - mref, h);
    f32x16 o0, o1;
#pragma unroll
    for (int i = 0; i < 16; ++i) { o0[i] = 0.f; o1[i] = 0.f; }
    float lsum = 0.f;
    const int ntiles = 2 * qt + 2;
    const bf16_t* kp[2]; const bf16_t* vp[2];
    {
        const int row0 = w * 8 + (lane >> 3), pc = lane & 7;
        const int lc0 = (pc ^ ((row0 >> 1) & 7)) * 8;
        kp[0] = kbase + (size_t)row0 * NPROJ + lc0; kp[1] = kbase + (size_t)(row0 + 32) * NPROJ + lc0;
        vp[0] = vbase + (size_t)row0 * SEQ + lc0;   vp[1] = vbase + (size_t)(row0 + 32) * SEQ + lc0;
    }
    const bf16_t* cp = (const bf16_t*)(p.ws + WS_SCR + SCR_CSX) + (size_t)bh * SEQ * 8 + lane * 8;
    const int swr = (r >> 1) & 7;
    int jw;
    {
        float gq = fabsf(p.in[3][l * 64 + lane]), gk = fabsf(p.in[4][l * 64 + lane]);
#pragma unroll
        for (int o = 32; o > 0; o >>= 1) { gq = fmaxf(gq, __shfl_xor(gq, o, 64)); gk = fmaxf(gk, __shfl_xor(gk, o, 64)); }
        const float thr = 2.f * (1.4426950408889634f * 8.f * gq * gk) + 30.f;
        const float cw = cum[qlo] * 1.4426950408889634f;
        const float ce = (lane < ntiles) ? cum[64 * lane + 63] * 1.4426950408889634f : 0.f;
        const unsigned long long keep = __ballot((lane < ntiles) && (cw - ce >= -thr));
        jw = keep ? (__ffsll((long long)keep) - 1) : (ntiles - 1);
    }
    volatile int* jshare = (volatile int*)(lds_raw + ATT_NSTAGE * ATT_BUF + 16);
    asm volatile("s_waitcnt vmcnt(0)" ::: "memory");
    RAW_BARRIER();
    if (tid == 0) *jshare = jw;
    RAW_BARRIER();
    const int jstart = *jshare;
    attn_issue(kp, vp, cp, jstart * 64, lds_raw + (jstart % ATT_NSTAGE) * ATT_BUF, w);
    if (jstart + 1 < ntiles) attn_issue(kp, vp, cp, (jstart + 1) * 64, lds_raw + ((jstart + 1) % ATT_NSTAGE) * ATT_BUF, w);
    for (int j = jstart; j < ntiles; ++j) {
        if (j + 1 < ntiles) asm volatile("s_waitcnt vmcnt(5)" ::: "memory"); else asm volatile("s_waitcnt vmcnt(0)" ::: "memory");
        RAW_BARRIER();
        if (j + 2 < ntiles) attn_issue(kp, vp, cp, (j + 2) * 64, lds_raw + ((j + 2) % ATT_NSTAGE) * ATT_BUF, w);
        const int s0 = j * 64;
        if (s0 <= qlo + 31 && j >= jw) {
            const bf16_t* Ks = (const bf16_t*)(lds_raw + (j % ATT_NSTAGE) * ATT_BUF); const bf16_t* Vs = Ks + 4096; const bf16_t* cs = Vs + 4096;
            f32x16 st0, st1;
            {
                u32x4 z4 = {0u, 0u, 0u, 0u};
                u32x4 c0 = *(const u32x4*)(cs + r * 8), c1 = *(const u32x4*)(cs + (32 + r) * 8);
                if (h) { c0 = z4; c1 = z4; }
                f32x16 zz;
#pragma unroll
                for (int i = 0; i < 16; ++i) zz[i] = 0.f;
                st0 = __builtin_amdgcn_mfma_f32_32x32x16_bf16(__builtin_bit_cast(bf16x8, c0), qx, zz, 0, 0, 0);
                st1 = __builtin_amdgcn_mfma_f32_32x32x16_bf16(__builtin_bit_cast(bf16x8, c1), qx, zz, 0, 0, 0);
            }
#pragma unroll
            for (int kk = 0; kk < 4; ++kk) {
                const int co = ((kk * 2 + h) ^ swr) * 8;
                bf16x8 a0 = *(const bf16x8*)(Ks + r * 64 + co);
                bf16x8 a1 = *(const bf16x8*)(Ks + (32 + r) * 64 + co);
                st0 = __builtin_amdgcn_mfma_f32_32x32x16_bf16(a0, qf[kk], st0, 0, 0, 0);
                st1 = __builtin_amdgcn_mfma_f32_32x32x16_bf16(a1, qf[kk], st1, 0, 0, 0);
            }
            if (s0 + 63 > qlo) {
#pragma unroll
                for (int i = 0; i < 16; ++i) {
                    const int key = s0 + (i & 3) + 8 * (i >> 2) + 4 * h;
                    if (key > q) st0[i] = -1e30f;
                    if (key + 32 > q) st1[i] = -1e30f;
                }
            }
            float mx = fmaxf(st0[0], st1[0]);
#pragma unroll
            for (int i = 1; i < 16; ++i) mx = fmaxf(mx, fmaxf(st0[i], st1[i]));
            if (__any(mx > ATT_THR)) {
                const float mo = fmaxf(mx, __shfl_xor(mx, 32, 64));
                const float d = (mo > ATT_THR) ? mo : 0.f;
                const float alpha = __builtin_amdgcn_exp2f(-d);
#pragma unroll
                for (int i = 0; i < 16; ++i) { st0[i] -= d; st1[i] -= d; o0[i] *= alpha; o1[i] *= alpha; }
                lsum *= alpha; mref += d;
                qx = attn_qbias(cq2 - mref, h);
            }
            float rs = 0.f;
#pragma unroll
            for (int i = 0; i < 16; ++i) { st0[i] = __builtin_amdgcn_exp2f(st0[i]); st1[i] = __builtin_amdgcn_exp2f(st1[i]); rs += st0[i] + st1[i]; }
            lsum += rs;
            bf16x8 pf[2][2];
#pragma unroll
            for (int s = 0; s < 2; ++s) {
                u32x4 t0 = {pk_bf16(st0[8 * s], st0[8 * s + 1]), pk_bf16(st0[8 * s + 2], st0[8 * s + 3]), pk_bf16(st0[8 * s + 4], st0[8 * s + 5]), pk_bf16(st0[8 * s + 6], st0[8 * s + 7])};
                u32x4 t1 = {pk_bf16(st1[8 * s], st1[8 * s + 1]), pk_bf16(st1[8 * s + 2], st1[8 * s + 3]), pk_bf16(st1[8 * s + 4], st1[8 * s + 5]), pk_bf16(st1[8 * s + 6], st1[8 * s + 7])};
                pf[0][s] = __builtin_bit_cast(bf16x8, t0); pf[1][s] = __builtin_bit_cast(bf16x8, t1);
            }
#pragma unroll
            for (int mt = 0; mt < 2; ++mt)
#pragma unroll
                for (int s = 0; s < 2; ++s) {
                    const int c0 = 4 * mt + 2 * s;
                    const int oA = ((c0 ^ swr) * 8) + 4 * h, oB = (((c0 + 1) ^ swr) * 8) + 4 * h;
                    uint2 a00 = *(const uint2*)(Vs + r * 64 + oA), a01 = *(const uint2*)(Vs + r * 64 + oB);
                    uint2 a10 = *(const uint2*)(Vs + (32 + r) * 64 + oA), a11 = *(const uint2*)(Vs + (32 + r) * 64 + oB);
                    u32x4 u0 = {a00.x, a00.y, a01.x, a01.y}; u32x4 u1 = {a10.x, a10.y, a11.x, a11.y};
                    o0 = __builtin_amdgcn_mfma_f32_32x32x16_bf16(__builtin_bit_cast(bf16x8, u0), pf[mt][s], o0, 0, 0, 0);
                    o1 = __builtin_amdgcn_mfma_f32_32x32x16_bf16(__builtin_bit_cast(bf16x8, u1), pf[mt][s], o1, 0, 0, 0);
                }
        }
    }
    lsum += __shfl_xor(lsum, 32, 64);
    const float inv = 1.f / lsum;
    float ss = 0.f;
#pragma unroll
    for (int i = 0; i < 16; ++i) { o0[i] *= inv; o1[i] *= inv; ss += o0[i] * o0[i] + o1[i] * o1[i]; }
    ss += __shfl_xor(ss, 32, 64);
    const float rstd = rsqrtf(ss * (1.f / 64.f) + 1e-6f);
    const float* og = p.in[6] + l * 64;
    bf16_t* mrow = (bf16_t*)(p.ws + WS_MIX) + pl_off(b * SEQ + q, hh * 64, 1024);
#pragma unroll
    for (int g = 0; g < 4; ++g) {
        const int e0 = 8 * g + 4 * h;
        f32x4 g0 = *(const f32x4*)(og + e0), g1 = *(const f32x4*)(og + 32 + e0);
        store4_bf16(mrow + e0, o0[4 * g] * rstd * g0[0], o0[4 * g + 1] * rstd * g0[1], o0[4 * g + 2] * rstd * g0[2], o0[4 * g + 3] * rstd * g0[3]);
        store4_bf16(mrow + 64 + e0, o1[4 * g] * rstd * g1[0], o1[4 * g + 1] * rstd * g1[1], o1[4 * g + 2] * rstd * g1[2], o1[4 * g + 3] * rstd * g1[3]);
    }
}
#define ATT_ITEMS (BATCH * H_FOX * (SEQ / 128))
#define CONV_ITEMS ((CONV_REST + P0_T_IN + 3) / 4)
__device__ void phase_scan_attn(const Params& p, int l, unsigned char* lds_raw, int rep = 0, int sel = 7) {
    unsigned* qctr = (unsigned*)(p.ws + WS_CTL) + CW_Q + l + 2 * rep;
    volatile int* slot = (volatile int*)(lds_raw + ATT_NSTAGE * ATT_BUF);
    for (;;) {
        __syncthreads();
        if (threadIdx.x == 0) *slot = (int)atomicAdd(qctr, 1u);
        __syncthreads();
        int it = *slot;
        const int ns0 = (MIXSEL & 1) ? BATCH * H_GDN * 4 : 0, ns1 = ns0 + ((MIXSEL & 2) ? 128 : 0);
        if (it >= ns1 + ATT_ITEMS + CONV_ITEMS) break;
        if (it >= ns1) {
            const int c = it - ns1;
            int conv_idx = -1;
            if (c < 5 * ATT_ITEMS) { if (c % 5 != 0) conv_idx = c - c / 5 - 1; } else conv_idx = c - ATT_ITEMS;
            if (conv_idx >= 0) {
                if (rep == 0 && conv_idx < CONV_ITEMS) conv_fold4(p, l, conv_idx * 4, ltid());
                continue;
            }
            it = ns1 + c / 5;
        }
        if (it < ns0) { if (sel & 1) gdn_scan_item(p, it, lds_raw, rep ? SVAR : 0); continue; }
        if (it < ns1) { if (sel & 2) gla_scan_item(p, it - ns0); continue; }
        it -= ns1;
        if (!(sel & 4)) continue;
        const int qt = (SEQ / 128 - 1) - it / (BATCH * H_FOX), bh = it % (BATCH * H_FOX);
        fox_attn_item(p, l, bh, qt, lds_raw);
    }
}

#define NPHASE 19
__global__ void __launch_bounds__(256, 2) mk(Params p, int lo, int hi, int use_bar) {
    __shared__ __attribute__((aligned(16))) unsigned char lds_raw[LDS_BYTES];
    bf16_t* lds = (bf16_t*)lds_raw;
    volatile LAS unsigned* st = (volatile LAS unsigned*)(lds_raw + LDS_BYTES - 16);
    XcdBarrier bar; bar.bar = (unsigned*)(p.ws + WS_CTL) + CW_BAR; bar.x = 0; bar.st = st;
    if (use_bar) {
        if (threadIdx.x == 0) { st[0] = 0u; st[1] = 0u; }
        __syncthreads();
        bar = xcd_barrier_post((unsigned*)(p.ws + WS_CTL) + CW_BAR, st);
    }
    for (int ph = lo; ph < hi; ++ph) {
#ifndef PSEL
#define PSEL 0xffff
#endif
        int phv = ph; asm volatile("" : "+s"(phv));
        size_t zoff = 0; asm volatile("" : "+s"(zoff));
        Params q = p; q.ws = p.ws + zoff; q.out = p.out + zoff;
        if (phv == 0) { if (PSEL & 1) phase0(q); }
        else {
            int l = (phv - 1) / 9, s = (phv - 1) % 9;
            if (s == 0) { if (PSEL & 2) phase_inproj(q, l, lds); }
            else if (s == 1) { if (PSEL & 128) phase_prep(q, l, lds_raw); }
            else if (s == 2) { if (PSEL & 256) phase_scan_attn(q, l, lds_raw); }
            else if (s == 3) { if (PSEL & 512) phase_mixout(q, l); }
            else if (s == 4) { if (PSEL & 4) phase_outproj(q, l, lds); }
            else if (s == 5) { if (PSEL & 8) phase_route(q, l, lds); }
            else if (s == 6) { if (PSEL & 16) phase_expert<0>(q, l, lds); }
            else if (s == 7) { if (PSEL & 32) phase_expert<1>(q, l, lds); }
            else if (s == 8) { if (PSEL & 64) phase_combine(q, l); }
        }
#ifdef REPEAT_MASK
        {
            const int ty = (phv == 0) ? 9 : (phv - 1) % 9, l = (phv == 0) ? 0 : (phv - 1) / 9;
            const bool idem = !((ty == 4 && l == 1));
            if (((REPEAT_MASK >> ty) & 1) && idem && use_bar) {
                xcd_barrier(bar);
                if (ty == 9) phase0(q);
                else if (ty == 0) phase_inproj(q, l, lds, GVAR);
                else if (ty == 1) phase_prep(q, l, lds_raw);
                else if (ty == 2) phase_scan_attn(q, l, lds_raw, 1, P3SEL);
                else if (ty == 3) phase_mixout(q, l);
                else if (ty == 4) phase_outproj(q, l, lds);
                else if (ty == 5) phase_route(q, l, lds, 1);
                else if (ty == 8) phase_combine(q, l, 1);
                else if (ty == 6) phase_expert<0>(q, l, lds);
                else if (ty == 7) phase_expert<1>(q, l, lds);
            }
        }
#endif
        if (ph + 1 < hi) {
            if (hi > 1000) cg::this_grid().sync();
            xcd_barrier(bar);
        }
    }
}

extern "C" void kernel_launch(void* const* d_in, const int* in_sizes, int n_in,
                              void* d_out, int out_size, void* d_ws, size_t ws_size,
                              hipStream_t stream) {
    static int grid = 0;
    if (grid == 0) {
        if (ws_size < WS_END) { fprintf(stderr, "ws too small: need %zu have %zu\n", (size_t)WS_END, ws_size); grid = -1; return; }
        int dev = 0, cus = 0, per_cu = 0;
        hipGetDevice(&dev);
        hipDeviceGetAttribute(&cus, hipDeviceAttributeMultiprocessorCount, dev);
        hipOccupancyMaxActiveBlocksPerMultiprocessor(&per_cu, mk, 256, 0);
        if (per_cu > 2) per_cu = 2;
        if (per_cu < 1) { fprintf(stderr, "occupancy query failed\n"); grid = -1; return; }
        grid = cus * per_cu;
        grid -= grid % 8;
    }
    if (grid < 0) return;
    Params p{};
    for (int i = 0; i < 23; ++i) p.in[i] = (const float*)d_in[i];
    p.out = (float*)d_out; p.ws = (char*)d_ws;
    hipMemsetAsync((char*)d_ws + WS_CTL, 0, CTL_BYTES, stream);
#ifdef POISON_GLA
    hipMemsetAsync((char*)d_ws + WS_SCR + SCR_GLA_OL, 0xFF, SCR_LVT - SCR_GLA_OL, stream);
#endif

#ifdef MULTI_LAUNCH
    for (int ph = 0; ph < NPHASE; ++ph) mk<<<grid, 256, 0, stream>>>(p, ph, ph + 1, 0);
#else
    int lo = 0, hi = NPHASE, ub = 2;
    void* args[] = {&p, &lo, &hi, &ub};
    hipError_t e = hipLaunchCooperativeKernel((void*)mk, dim3(grid), dim3(256), args, 0, stream);
    if (e != hipSuccess) fprintf(stderr, "cooperative launch failed: %s (grid %d)\n", hipGetErrorString(e), grid);
#endif
}
```

```cpp
#include <hip/hip_runtime.h>
#include <hip/hip_cooperative_groups.h>
#include <cstdint>
#include <cstdio>
namespace cg = cooperative_groups;

#define D_MODEL 1024
#define BATCH 4
#define SEQ 4096
#define NTOK (BATCH * SEQ)
#define H_FOX 6
#define H_GDN 6
#define H_GLA 4
#define N_IN 3490
#define N_EXP 32
#define D_EXP 512
#define NPROJ 3456
#define NINP 3584

#define C_FF 1152
#define C_GQ 1158
#define C_GG 2310
#define C_GA 2694
#define C_GB 2700
#define C_LQ 2706
#define C_LA 3474
#define NC_FQ 0
#define NC_FK 384
#define NC_FV 768
#define NC_GQ 1152
#define NC_GK 1536
#define NC_GV 1920
#define NC_GG 2304
#define NC_LQ 2688
#define NC_LK 2816
#define NC_LV 2944
#define NC_LR 3200
#define AX_FF 0
#define AX_GA 6
#define AX_GB 12
#define AX_LA 18

#ifndef SVAR
#define SVAR 0
#endif
#ifndef P3SEL
#define P3SEL 7
#endif
#ifndef GVAR
#define GVAR 0
#endif
#ifndef MIXSEL
#define MIXSEL 3
#endif
typedef unsigned short bf16_t;
typedef short bf16x8 __attribute__((ext_vector_type(8)));
typedef float f32x4 __attribute__((ext_vector_type(4)));
typedef unsigned u32x4 __attribute__((ext_vector_type(4)));
typedef unsigned u32x2 __attribute__((ext_vector_type(2)));

#define WS_CTL      0
#define CTL_BYTES   262144
#define WS_WIN      (WS_CTL + CTL_BYTES)
#define WS_WOUT     (WS_WIN + (size_t)2 * NINP * 1024 * 2)
#define WS_WGU      (WS_WOUT + (size_t)2 * 1024 * 1024 * 2)
#define WS_WD       (WS_WGU + (size_t)2 * 32 * 1024 * 1024 * 2)
#define WS_WR       (WS_WD + (size_t)2 * 32 * 1024 * 512 * 2)
#define WS_HN       (WS_WR + (size_t)2 * 64 * 1024 * 2)
#define WS_PROJ     (WS_HN + (size_t)NTOK * 1024 * 2)
#define WS_VTF      (WS_PROJ + (size_t)NTOK * NPROJ * 2)
#define WS_AUX      (WS_VTF + (size_t)BATCH * H_FOX * 64 * SEQ * 2)
#define WS_CUM      (WS_AUX + (size_t)NTOK * 64 * 4)
#define WS_MIX      (WS_CUM + (size_t)BATCH * H_FOX * SEQ * 4)
#define WS_ROWTOK   (WS_MIX + (size_t)NTOK * 1024 * 2)
#define WS_TSLOT    (WS_ROWTOK + (size_t)32 * NTOK * 4)
#define WS_TGATE    (WS_TSLOT + (size_t)NTOK * 2 * 4)
#define WS_SCR      (WS_TGATE + (size_t)NTOK * 2 * 4)
#define SCR_BYTES   ((size_t)100 * 1024 * 1024)
#define WS_END      (WS_SCR + SCR_BYTES)
#define HROWS       (2 * NTOK + 32 * 128)
#define WS_H        WS_PROJ
#define WS_Y        (WS_PROJ + (size_t)HROWS * 512 * 2)

#define NGDN_CH 1536
#define NGLA_CH 1024
#define SCR_GDN_MP   ((size_t)0)
#define SCR_GDN_NN   (SCR_GDN_MP + (size_t)NGDN_CH * 8192)
#define SCR_GDN_P    (SCR_GDN_NN + (size_t)NGDN_CH * 8192)
#define SCR_GDN_OL   (SCR_GDN_P  + (size_t)NGDN_CH * 8192)
#define SCR_GDN_SG   (SCR_GDN_OL + (size_t)NGDN_CH * 8192)
#define SCR_GDN_LAST (SCR_GDN_SG + (size_t)NGDN_CH * 8192)
#define SCR_GLA_OL   (SCR_GDN_LAST + (size_t)NGDN_CH * 4)
#define SCR_GLA_KV   (SCR_GLA_OL + (size_t)NGLA_CH * 8192)
#define SCR_GLA_QB   (SCR_GLA_KV + (size_t)NGLA_CH * 8192)
#define SCR_GLA_SG   (SCR_GLA_QB + (size_t)NGLA_CH * 4096)
#define SCR_GLA_DL   (SCR_GLA_SG + (size_t)NGLA_CH * 4096)
#define SCR_LVT      (SCR_GLA_DL + (size_t)NGLA_CH * 128)
#define SCR_USED     (SCR_LVT + (size_t)BATCH * H_GLA * 64 * SEQ * 2)
#define SCR_CSX      SCR_USED
static_assert(SCR_CSX + (size_t)BATCH * H_FOX * SEQ * 16 <= SCR_BYTES, "scratch overflow");
#define CW_BAR      0
#define CW_CNT      4096
#define CNT_STRIDE  64
#define NSH         8
#define SHCAP       2048
#define CW_Q        (CW_CNT + 2 * 32 * NSH * CNT_STRIDE + 64)
#define CW_MOETAB   (CW_Q + 256)

struct Params {
    const float* in[23];
    float* out;
    char* ws;
};

__device__ __forceinline__ float sigmoidf_(float x) { return __builtin_amdgcn_rcpf(1.f + __expf(-x)); }
__device__ __forceinline__ float siluf_(float x) { return x * __builtin_amdgcn_rcpf(1.f + __expf(-x)); }
__device__ __forceinline__ float softplusf_(float x) { return x > 20.f ? x : __logf(1.f + __expf(x)); }
__device__ __forceinline__ float logsigmoidf_(float x) { return -softplusf_(-x); }
__device__ __forceinline__ float wave_sum(float v) {
#pragma unroll
    for (int o = 32; o > 0; o >>= 1) v += __shfl_xor(v, o, 64);
    return v;
}
__device__ __forceinline__ int ltid() { int t = threadIdx.x; asm volatile("" : "+v"(t)); return t; }
typedef __bf16 bf16x2_t __attribute__((ext_vector_type(2)));
typedef float f32x2_t __attribute__((ext_vector_type(2)));
__device__ __forceinline__ unsigned pk_bf16(float lo, float hi) { f32x2_t v = {lo, hi}; bf16x2_t r = __builtin_convertvector(v, bf16x2_t); return __builtin_bit_cast(unsigned, r); }
__device__ __forceinline__ size_t pl_off(int row, int k, int K) { return (size_t)(row >> 1) * (size_t)(2 * K) + (size_t)((k >> 5) * 64 + (row & 1) * 32 + (k & 31)); }
__device__ __forceinline__ unsigned ld_u32_agent(const unsigned* p) { return __hip_atomic_load(p, __ATOMIC_RELAXED, __HIP_MEMORY_SCOPE_AGENT); }
__device__ __forceinline__ float ld_f32_agent(const float* p) { return __uint_as_float(__hip_atomic_load((const unsigned*)p, __ATOMIC_RELAXED, __HIP_MEMORY_SCOPE_AGENT)); }
__device__ __forceinline__ float bf2f(bf16_t v) { return __uint_as_float((unsigned)v << 16); }
__device__ __forceinline__ float bflo(unsigned v) { return __uint_as_float(v << 16); }
__device__ __forceinline__ float bfhi(unsigned v) { return __uint_as_float(v & 0xffff0000u); }

#define XB_TMO      128
#define XB_XCNT(j)  (256  + 64 * (j))
#define XB_XSUB(j)  (1280 + 64 * (j))
#define XB_XGEN(j)  (2304 + 64 * (j))
#define XB_TOP      3328
#define XB_TOPGEN   3392
#define XCD_BAR_WORDS 3456
#define XB_SPIN_CAP (1u << 22)
#define LAS __attribute__((address_space(3)))
__device__ __forceinline__ unsigned xb_ld(unsigned* p)              { return __hip_atomic_load(p, __ATOMIC_RELAXED, __HIP_MEMORY_SCOPE_AGENT); }
__device__ __forceinline__ unsigned xb_add(unsigned* p, unsigned v) { return __hip_atomic_fetch_add(p, v, __ATOMIC_RELAXED, __HIP_MEMORY_SCOPE_AGENT); }
__device__ __forceinline__ unsigned xb_xcc_id() { return (unsigned)__builtin_amdgcn_s_getreg((3 << 11) | 20) & 0xFu; }
#define XB_SPIN(cond, bar) do { unsigned _sp = 0; while (cond) { if (_sp < 16u) __builtin_amdgcn_s_sleep(2); else __builtin_amdgcn_s_sleep(20);     \
    if ((++_sp & 255u) == 0u) { if (xb_ld(&(bar)[XB_TMO])) break; if (_sp > XB_SPIN_CAP) { atomicAdd(&(bar)[XB_TMO], 1u); break; } } } } while (0)
struct XcdBarrier { unsigned* bar; unsigned x; volatile LAS unsigned* st; };
__device__ __forceinline__ XcdBarrier xcd_barrier_post(unsigned* bar, volatile LAS unsigned* st) {
    XcdBarrier b; b.bar = bar; b.x = xb_xcc_id(); b.st = st;
    if (threadIdx.x == 0) (void)xb_add(&bar[XB_XCNT(b.x)], 1u);
    return b;
}
__device__ __forceinline__ void xcd_barrier_complete(unsigned* bar, unsigned x, unsigned& nloc, unsigned& nx) {
    const unsigned G = gridDim.x * gridDim.y * gridDim.z;
    unsigned sum, cnt, mine, sp = 0u;
    for (;;) {
        sum = 0u; cnt = 0u; mine = 0u;
#pragma unroll
        for (unsigned j = 0; j < 16; ++j) { const unsigned c = xb_ld(&bar[XB_XCNT(j)]); sum += c; cnt += (c > 0u) ? 1u : 0u; mine = (j == x) ? c : mine; }
        if (sum == G) break;
        __builtin_amdgcn_s_sleep(1);
        if ((++sp & 255u) == 0u) { if (xb_ld(&bar[XB_TMO])) break; if (sp > XB_SPIN_CAP) { atomicAdd(&bar[XB_TMO], 1u); break; } }
    }
    nloc = mine > 0u ? mine : 1u; nx = cnt > 0u ? cnt : 1u;
}
__device__ __forceinline__ void xcd_barrier(const XcdBarrier& b) {
    asm volatile("s_waitcnt vmcnt(0)" ::: "memory");
    __syncthreads();
    if (threadIdx.x == 0) {
        unsigned* bar = b.bar;
        __builtin_amdgcn_s_waitcnt(0);
        unsigned nloc = b.st[0], nx = b.st[1];
        if (nloc == 0u) { xcd_barrier_complete(bar, b.x, nloc, nx); b.st[0] = nloc; b.st[1] = nx; }
        const unsigned old = xb_add(&bar[XB_XSUB(b.x)], 1u);
        const unsigned gen = old / nloc;
        if (old + 1u == (gen + 1u) * nloc) {
            __builtin_amdgcn_fence(__ATOMIC_RELEASE, "agent");
            asm volatile("s_waitcnt vmcnt(0)" ::: "memory");
            const unsigned og = xb_add(&bar[XB_TOP], 1u);
            const unsigned tg = og / nx;
            if (og + 1u == (tg + 1u) * nx) xb_add(&bar[XB_TOPGEN], 1u);
            else XB_SPIN(xb_ld(&bar[XB_TOPGEN]) == tg, bar);
            __builtin_amdgcn_fence(__ATOMIC_ACQUIRE, "agent");
            xb_add(&bar[XB_XGEN(b.x)], 1u);
            asm volatile("s_waitcnt vmcnt(0)" ::: "memory");
        } else {
            XB_SPIN(xb_ld(&bar[XB_XGEN(b.x)]) == gen, bar);
            __builtin_amdgcn_fence(__ATOMIC_ACQUIRE, "agent");
            asm volatile("s_waitcnt vmcnt(0)" ::: "memory");
        }
    }
    __syncthreads();
}

#define LDS_BYTES 68096
#define LROW 72

__device__ __forceinline__ int inproj_map(int n) {
    if (n < 1152) return n;
    if (n < 2304) return C_GQ + (n - 1152);
    if (n < 2688) return C_GG + (n - 2304);
    if (n < 3456) return C_LQ + (n - 2688);
    if (n < 3462) return C_FF + (n - 3456);
    if (n < 3468) return C_GA + (n - 3462);
    if (n < 3474) return C_GB + (n - 3468);
    if (n < 3490) return n;
    return -1;
}
#define P0_T_IN   (56 * 16)
#define P0_T_OUT  (16 * 16)
#define P0_T_GU   (32 * 16 * 16)
#define P0_T_D    (32 * 16 * 8)
#define P0_T_R    (16)
#define P0_T_LAYER (P0_T_IN + P0_T_OUT + P0_T_GU + P0_T_D + P0_T_R)
#define P0_T_NORM (NTOK / 4)
struct ConvDesc { const float* src; bf16_t* dst; int ld; int col; };
__device__ __forceinline__ ConvDesc conv_desc(const Params& p, int l, int j, int tid) {
    const int nl = tid & 63, kg = tid >> 6;
    ConvDesc d;
    if (j < P0_T_IN) {
        int tn = j / 16, tk = j % 16; int n = tn * 64 + nl; int k0 = tk * 64 + kg * 16;
        d.ld = N_IN; d.col = inproj_map(n); d.src = p.in[2] + (size_t)l * 1024 * N_IN + (size_t)k0 * N_IN;
        d.dst = (bf16_t*)(p.ws + WS_WIN) + (size_t)l * NINP * 1024 + pl_off(n, k0, 1024);
        return d;
    }
    j -= P0_T_IN;
    if (j < P0_T_OUT) {
        int tn = j / 16, tk = j % 16; int n = tn * 64 + nl; int k0 = tk * 64 + kg * 16;
        d.ld = 1024; d.col = n; d.src = p.in[14] + (size_t)l * 1024 * 1024 + (size_t)k0 * 1024;
        d.dst = (bf16_t*)(p.ws + WS_WOUT) + (size_t)l * 1024 * 1024 + pl_off(n, k0, 1024);
        return d;
    }
    j -= P0_T_OUT;
    if (j < P0_T_GU) {
        int e = j / 256, r = j % 256; int tn = r / 16, tk = r % 16; int n = tn * 64 + nl; int k0 = tk * 64 + kg * 16;
        int t128 = n >> 7, wx = (n >> 6) & 1, half = (n >> 5) & 1, jj = n & 31;
        d.ld = 512; d.col = t128 * 64 + wx * 32 + jj;
        d.src = (half ? p.in[21] : p.in[20]) + ((size_t)l * 32 + e) * 1024 * 512 + (size_t)k0 * 512;
        d.dst = (bf16_t*)(p.ws + WS_WGU) + ((size_t)l * 32 + e) * 1024 * 1024 + pl_off(n, k0, 1024);
        return d;
    }
    j -= P0_T_GU;
    if (j < P0_T_D) {
        int e = j / 128, r = j % 128; int tn = r / 8, tk = r % 8; int n = tn * 64 + nl; int k0 = tk * 64 + kg * 16;
        d.ld = 1024; d.col = n; d.src = p.in[22] + ((size_t)l * 32 + e) * 512 * 1024 + (size_t)k0 * 1024;
        d.dst = (bf16_t*)(p.ws + WS_WD) + ((size_t)l * 32 + e) * 1024 * 512 + pl_off(n, k0, 512);
        return d;
    }
    j -= P0_T_D;
    {
        int tk = j; int n = nl; int k0 = tk * 64 + kg * 16;
        if (n < 4) { d.src = p.in[16] + (size_t)l * 1024 * 4 + (size_t)k0 * 4; d.ld = 4; d.col = n; }
        else if (n < 36) { d.src = p.in[18] + (size_t)l * 1024 * 32 + (size_t)k0 * 32; d.ld = 32; d.col = n - 4; }
        else { d.src = p.in[16]; d.ld = 4; d.col = -1; }
        d.dst = (bf16_t*)(p.ws + WS_WR) + ((size_t)l * 64 + n) * 1024 + k0;
        return d;
    }
}
__device__ __forceinline__ void conv_load(const ConvDesc& d, float (&v)[16]) {
    if (d.col >= 0) {
#pragma unroll
        for (int i = 0; i < 16; ++i) v[i] = d.src[(size_t)i * d.ld + d.col];
    } else {
#pragma unroll
        for (int i = 0; i < 16; ++i) v[i] = 0.f;
    }
}
__device__ __forceinline__ void conv_store(const ConvDesc& d, const float (&v)[16]) {
    uint4 o0, o1;
    o0.x = pk_bf16(v[0], v[1]); o0.y = pk_bf16(v[2], v[3]); o0.z = pk_bf16(v[4], v[5]); o0.w = pk_bf16(v[6], v[7]);
    o1.x = pk_bf16(v[8], v[9]); o1.y = pk_bf16(v[10], v[11]); o1.z = pk_bf16(v[12], v[13]); o1.w = pk_bf16(v[14], v[15]);
    *(uint4*)(d.dst) = o0;
    *(uint4*)(d.dst + 8) = o1;
}
__device__ __forceinline__ void conv_job(const Params& p, int l, int j, int tid) {
    ConvDesc d = conv_desc(p, l, j, tid); float v[16]; conv_load(d, v); conv_store(d, v);
}
#define CONV_REST (P0_T_LAYER - P0_T_IN)
__device__ __forceinline__ bool conv_fold_desc(const Params& p, int l, int idx, int tid, ConvDesc& d) {
    if (idx < CONV_REST) { d = conv_desc(p, l, P0_T_IN + idx, tid); return true; }
    if (l == 0 && idx < CONV_REST + P0_T_IN) { d = conv_desc(p, 1, idx - CONV_REST, tid); return true; }
    return false;
}
__device__ __forceinline__ void conv_fold4(const Params& p, int l, int idx0, int tid) {
    ConvDesc d0, d1, d2, d3; float v0[16], v1[16], v2[16], v3[16];
    const bool b0 = conv_fold_desc(p, l, idx0, tid, d0), b1 = conv_fold_desc(p, l, idx0 + 1, tid, d1), b2 = conv_fold_desc(p, l, idx0 + 2, tid, d2), b3 = conv_fold_desc(p, l, idx0 + 3, tid, d3);
    if (b0) conv_load(d0, v0); if (b1) conv_load(d1, v1); if (b2) conv_load(d2, v2); if (b3) conv_load(d3, v3);
    if (b0) conv_store(d0, v0); if (b1) conv_store(d1, v1); if (b2) conv_store(d2, v2); if (b3) conv_store(d3, v3);
}
__device__ void phase0(const Params& p) {
    const int tid = ltid(), nl = tid & 63, kg = tid >> 6;
    const int total = P0_T_IN + P0_T_NORM;
    for (int it = blockIdx.x; it < total; it += gridDim.x) {
        if (it >= P0_T_IN) {
            int row = (it - P0_T_IN) * 4 + kg;
            const float* xr = p.in[0] + (size_t)row * D_MODEL + nl * 16;
            const float* gr = p.in[1] + nl * 16;
            float v[16]; float ss = 0.f;
#pragma unroll
            for (int i = 0; i < 4; ++i) { float4 t = *(const float4*)(xr + 4 * i); v[4 * i] = t.x; v[4 * i + 1] = t.y; v[4 * i + 2] = t.z; v[4 * i + 3] = t.w; }
#pragma unroll
            for (int i = 0; i < 16; ++i) ss += v[i] * v[i];
            ss = wave_sum(ss);
            float r = rsqrtf(ss / D_MODEL + 1e-6f);
#pragma unroll
            for (int i = 0; i < 16; ++i) v[i] = v[i] * r * gr[i];
            uint4 o0, o1;
            o0.x = pk_bf16(v[0], v[1]); o0.y = pk_bf16(v[2], v[3]); o0.z = pk_bf16(v[4], v[5]); o0.w = pk_bf16(v[6], v[7]);
            o1.x = pk_bf16(v[8], v[9]); o1.y = pk_bf16(v[10], v[11]); o1.z = pk_bf16(v[12], v[13]); o1.w = pk_bf16(v[14], v[15]);
            bf16_t* hr = (bf16_t*)(p.ws + WS_HN) + pl_off(row, nl * 16, 1024);
            *(uint4*)hr = o0; *(uint4*)(hr + 8) = o1;
            continue;
        }
        conv_job(p, 0, it, tid);
    }
}

#define GSTAGE 8192
#define RAW_BARRIER() do { asm volatile("s_waitcnt lgkmcnt(0)" ::: "memory"); __builtin_amdgcn_s_barrier(); } while (0)
__device__ __forceinline__ int gswz(int row) { return (0x1320 >> (((row >> 2) & 3) * 4)) & 3; }
__device__ __forceinline__ void gemm_issue(const bf16_t* const (&px)[2], const bf16_t* const (&py)[2], int k0, bf16_t* stage, int w) {
    __builtin_amdgcn_global_load_lds((const unsigned*)(px[0] + 2 * k0), (unsigned*)(stage + (w * 16) * 32), 16, 0, 0);
    __builtin_amdgcn_global_load_lds((const unsigned*)(px[1] + 2 * k0), (unsigned*)(stage + (64 + w * 16) * 32), 16, 0, 0);
    __builtin_amdgcn_global_load_lds((const unsigned*)(py[0] + 2 * k0), (unsigned*)(stage + 4096 + (w * 16) * 32), 16, 0, 0);
    __builtin_amdgcn_global_load_lds((const unsigned*)(py[1] + 2 * k0), (unsigned*)(stage + 4096 + (64 + w * 16) * 32), 16, 0, 0);
}
__device__ __forceinline__ void gemm_compute(const bf16_t* stage, int wx, int wy, int fr, int fg, f32x4 (&acc)[4][4]) {
    const int co = (fg ^ gswz(fr)) * 8;
    bf16x8 xa[4], yb[4];
#pragma unroll
    for (int m = 0; m < 4; ++m) xa[m] = *(const bf16x8*)(stage + (wx * 64 + m * 16 + fr) * 32 + co);
#pragma unroll
    for (int n = 0; n < 4; ++n) yb[n] = *(const bf16x8*)(stage + 4096 + (wy * 64 + n * 16 + fr) * 32 + co);
    __builtin_amdgcn_s_setprio(1);
#pragma unroll
    for (int m = 0; m < 4; ++m)
#pragma unroll
        for (int n = 0; n < 4; ++n) acc[m][n] = __builtin_amdgcn_mfma_f32_16x16x32_bf16(xa[m], yb[n], acc[m][n], 0, 0, 0);
    __builtin_amdgcn_s_setprio(0);
}
template <class FX, class FY>
__device__ __forceinline__ void gemm_core(FX rowx, FY rowy, int K, bf16_t* lds, f32x4 (&acc)[4][4], int gvar = 0) {
    const int tid = ltid(), lane = tid & 63, w = __builtin_amdgcn_readfirstlane(tid >> 6), wx = w >> 1, wy = w & 1, fr = lane & 15, fg = lane >> 4;
#pragma unroll
    for (int a = 0; a < 4; ++a)
#pragma unroll
        for (int b = 0; b < 4; ++b) acc[a][b] = (f32x4){0.f, 0.f, 0.f, 0.f};
    const bf16_t* px[2]; const bf16_t* py[2];
    {
        const int r0 = w * 16 + (lane >> 2), pc = lane & 3;
        const int lc0 = (pc ^ gswz(r0)) * 8;
        px[0] = rowx(r0) + lc0; px[1] = rowx(r0 + 64) + lc0;
        py[0] = rowy(r0) + lc0; py[1] = rowy(r0 + 64) + lc0;
    }
    const int nt = K >> 5;
    RAW_BARRIER();
    if (gvar != 3) {
    gemm_issue(px, py, 0, lds, w);
    gemm_issue(px, py, 32, lds + GSTAGE, w);
    gemm_issue(px, py, 64, lds + 2 * GSTAGE, w);
    }
    for (int j = 0; j < nt; ++j) {
        if (j + 2 < nt) asm volatile("s_waitcnt vmcnt(8)" ::: "memory");
        else if (j + 1 < nt) asm volatile("s_waitcnt vmcnt(4)" ::: "memory");
        else asm volatile("s_waitcnt vmcnt(0)" ::: "memory");
        RAW_BARRIER();
        if (j + 3 < nt && gvar != 3) gemm_issue(px, py, (j + 3) * 32, lds + ((j + 3) & 3) * GSTAGE, w);
        if (gvar != 2) gemm_compute(lds + (j & 3) * GSTAGE, wx, wy, fr, fg, acc);
    }
}
__device__ __forceinline__ void store4_bf16(bf16_t* p, float a, float b, float c, float d) {
    uint2 o; o.x = pk_bf16(a, b); o.y = pk_bf16(c, d); *(uint2*)p = o;
}
template <int NC> __device__ __forceinline__ void ep_put(bf16_t* T, int row, int col, float a, float b, float c, float d) {
    uint2 o; o.x = pk_bf16(a, b); o.y = pk_bf16(c, d); *(uint2*)(T + row * (NC + 8) + col) = o;
}
template <int NC, class FD> __device__ __forceinline__ void ep_flush(const bf16_t* T, int tid, FD dst) {
    constexpr int CPR = NC / 8;
#pragma unroll
    for (int i = 0; i < NC / 16; ++i) {
        const int c = tid + 256 * i; const int row = c / CPR, ch = c % CPR;
        *(u32x4*)(dst(row, ch)) = *(const u32x4*)(T + row * (NC + 8) + ch * 8);
    }
}

__device__ __forceinline__ bool xcd_item(int round, int ntm, int ntn, int& tm, int& tn) {
    const int x = blockIdx.x & 7, loc = blockIdx.x >> 3, nloc = gridDim.x >> 3;
    const int tmx = ntm >> 3;
    const int j = round * nloc + loc;
    if (j >= tmx * ntn) return false;
    tn = j / tmx; tm = (j % tmx) * 8 + x;
    return true;
}

__device__ void phase_inproj(const Params& p, int l, bf16_t* lds, int gvar = 0) {
    const int tid = ltid(), lane = tid & 63, w = tid >> 6, wx = w >> 1, wy = w & 1, fr = lane & 15, fg = lane >> 4;
    const bf16_t* hn = (const bf16_t*)(p.ws + WS_HN);
    const bf16_t* wt = (const bf16_t*)(p.ws + WS_WIN) + (size_t)l * NINP * 1024;
    bf16_t* proj = (bf16_t*)(p.ws + WS_PROJ);
    bf16_t* vtf = (bf16_t*)(p.ws + WS_VTF);
    float* aux = (float*)(p.ws + WS_AUX);
    const float* qg = p.in[3] + l * 64; const float* kg = p.in[4] + l * 64;
    for (int round = 0;; ++round) {
        int tm, tn;
        if (gridDim.x == 512) {
            if (round >= 7) break;
            const int x = blockIdx.x & 7, loc = blockIdx.x >> 3; int tml;
            if (round < 6) { tn = (round >> 1) * 8 + (loc & 7); tml = (round & 1) * 8 + (loc >> 3); }
            else { tn = 24 + (loc & 3); tml = loc >> 2; }
            tm = tml * 8 + x;
        } else if (!xcd_item(round, NTOK / 128, NINP / 128, tm, tn)) break;
        const bool vt = (tn >= 6 && tn < 9) || tn == 23 || tn == 24;
        f32x4 acc[4][4];
        {
            auto rw = [&](int r) { return wt + pl_off(tn * 128 + r, 0, 1024); };
            auto rt_ = [&](int r) { return hn + pl_off(tm * 128 + r, 0, 1024); };
            if (vt) gemm_core(rt_, rw, 1024, lds, acc, gvar); else gemm_core(rw, rt_, 1024, lds, acc, gvar);
        }
        if (gvar != 0 && acc[0][0][0] != 123456.789f) continue;
        if (tn == 27) {
#pragma unroll
            for (int n = 0; n < 4; ++n) {
                int t = tm * 128 + wy * 64 + n * 16 + fr;
#pragma unroll
                for (int m = 0; m < 4; ++m) {
                    int c = wx * 64 + m * 16 + 4 * fg;
                    if (c < 64) *(float4*)(aux + (size_t)t * 64 + c) = make_float4(acc[m][n][0], acc[m][n][1], acc[m][n][2], acc[m][n][3]);
                }
            }
            continue;
        }
        RAW_BARRIER();
        if (vt) {
#pragma unroll
            for (int n = 0; n < 4; ++n)
#pragma unroll
                for (int m = 0; m < 4; ++m) ep_put<128>(lds, wy * 64 + n * 16 + fr, wx * 64 + m * 16 + 4 * fg, acc[m][n][0], acc[m][n][1], acc[m][n][2], acc[m][n][3]);
            RAW_BARRIER();
            const bool fox = tn < 9;
            bf16_t* dstb = fox ? vtf : (bf16_t*)(p.ws + WS_SCR + SCR_LVT); const int nh = fox ? H_FOX : H_GLA;
            const int t0 = tm * 128, b = t0 / SEQ, s0 = t0 % SEQ, chb = tn * 128 - (fox ? NC_FV : NC_LV);
            ep_flush<128>(lds, tid, [&](int row, int c8) { const int ch = chb + row; return dstb + ((size_t)(b * nh + (ch >> 6)) * 64 + (ch & 63)) * SEQ + s0 + c8 * 8; });
        } else {
            if (tn < 6) {
                const float* gn = (tn < 3) ? qg : kg; const float sc = (tn < 3) ? 0.125f * 1.4426950408889634f : 1.f;
                float g[4][4];
#pragma unroll
                for (int m = 0; m < 4; ++m)
#pragma unroll
                    for (int r = 0; r < 4; ++r) g[m][r] = gn[m * 16 + 4 * fg + r] * sc;
#pragma unroll
                for (int n = 0; n < 4; ++n) {
                    float ss = 0.f;
#pragma unroll
                    for (int m = 0; m < 4; ++m)
#pragma unroll
                        for (int r = 0; r < 4; ++r) ss += acc[m][n][r] * acc[m][n][r];
                    ss += __shfl_xor(ss, 16, 64); ss += __shfl_xor(ss, 32, 64);
                    float rs = rsqrtf(ss * (1.f / 64.f) + 1e-6f);
#pragma unroll
                    for (int m = 0; m < 4; ++m)
                        ep_put<128>(lds, wy * 64 + n * 16 + fr, wx * 64 + m * 16 + 4 * fg, acc[m][n][0] * rs * g[m][0], acc[m][n][1] * rs * g[m][1], acc[m][n][2] * rs * g[m][2], acc[m][n][3] * rs * g[m][3]);
                }
            } else {
                const bool do_silu = (tn >= 18 && tn < 21) || (tn >= 25);
                const float sc = (tn == 21) ? 0.17677669529663687f : 1.f;
#pragma unroll
                for (int n = 0; n < 4; ++n)
#pragma unroll
                    for (int m = 0; m < 4; ++m) {
                        float v0 = acc[m][n][0] * sc, v1 = acc[m][n][1] * sc, v2 = acc[m][n][2] * sc, v3 = acc[m][n][3] * sc;
                        if (do_silu) { v0 = siluf_(v0); v1 = siluf_(v1); v2 = siluf_(v2); v3 = siluf_(v3); }
                        ep_put<128>(lds, wy * 64 + n * 16 + fr, wx * 64 + m * 16 + 4 * fg, v0, v1, v2, v3);
                    }
            }
            RAW_BARRIER();
            bf16_t* dstb = proj + (size_t)(tm * 128) * NPROJ + tn * 128;
            ep_flush<128>(lds, tid, [&](int row, int c8) { return dstb + (size_t)row * NPROJ + c8 * 8; });
        }
    }
}

__device__ void phase_outproj(const Params& p, int l, bf16_t* lds) {
    const int tid = ltid(), lane = tid & 63, w = tid >> 6, wx = w >> 1, wy = w & 1, fr = lane & 15, fg = lane >> 4;
    const bf16_t* mix = (const bf16_t*)(p.ws + WS_MIX);
    const bf16_t* wt = (const bf16_t*)(p.ws + WS_WOUT) + (size_t)l * 1024 * 1024;
    const float* xin = (l == 0) ? p.in[0] : p.out;
    float* xo = p.out;
    for (int round = 0;; ++round) {
        int tm, tn;
        if (gridDim.x == 512) {
            if (round >= 2) break;
            const int x = blockIdx.x & 7, loc = blockIdx.x >> 3;
            tn = loc & 7; tm = (round * 8 + (loc >> 3)) * 8 + x;
        } else if (!xcd_item(round, NTOK / 128, 8, tm, tn)) break;
        f32x4 acc[4][4];
        {
            auto rw = [&](int r) { return wt + pl_off(tn * 128 + r, 0, 1024); };
            auto rt_ = [&](int r) { return mix + pl_off(tm * 128 + r, 0, 1024); };
            gemm_core(rw, rt_, 1024, lds, acc);
        }
#pragma unroll
        for (int n = 0; n < 4; ++n) {
            int t = tm * 128 + wy * 64 + n * 16 + fr;
#pragma unroll
            for (int m = 0; m < 4; ++m) {
                int c = tn * 128 + wx * 64 + m * 16 + 4 * fg;
                float4 xv = *(const float4*)(xin + (size_t)t * 1024 + c);
                xv.x += acc[m][n][0]; xv.y += acc[m][n][1]; xv.z += acc[m][n][2]; xv.w += acc[m][n][3];
                *(float4*)(xo + (size_t)t * 1024 + c) = xv;
            }
        }
    }
}

__device__ void phase_route(const Params& p, int l, bf16_t* lds, int dry = 0) {
    const int tid = ltid(), lane = tid & 63, w = tid >> 6, fr = lane & 15, fg = lane >> 4;
    const float* x1 = p.out;
    const float* gain = p.in[15] + l * 1024;
    bf16_t* hn = dry ? (bf16_t*)(p.ws + WS_SCR) : (bf16_t*)(p.ws + WS_HN);
    const bf16_t* wr = (const bf16_t*)(p.ws + WS_WR) + (size_t)l * 64 * 1024;
    const float* brg = p.in[17] + l * 4; const float* bre = p.in[19] + l * 32;
    unsigned* cnt = (unsigned*)(p.ws + WS_CTL) + CW_CNT + l * 32 * NSH * CNT_STRIDE;
    int* rowtok = (int*)(p.ws + WS_ROWTOK);
    int* tslot = (int*)(p.ws + WS_TSLOT);
    float* tgate = (float*)(p.ws + WS_TGATE);
    const int HL = 1032;
    float* red = (float*)(lds + 16 * HL);
    for (int it = blockIdx.x; it < NTOK / 16; it += gridDim.x) {
        __syncthreads();
        f32x4 xin4[4][4];
#pragma unroll
        for (int rr = 0; rr < 4; ++rr) {
            const float* xr = x1 + (size_t)(it * 16 + w * 4 + rr) * 1024 + lane * 16;
#pragma unroll
            for (int i = 0; i < 4; ++i) xin4[rr][i] = *(const f32x4*)(xr + 4 * i);
        }
#pragma unroll
        for (int rr = 0; rr < 4; ++rr) {
            int lr = w * 4 + rr; int t = it * 16 + lr;
            float v[16]; float ss = 0.f;
#pragma unroll
            for (int i = 0; i < 4; ++i) { v[4 * i] = xin4[rr][i][0]; v[4 * i + 1] = xin4[rr][i][1]; v[4 * i + 2] = xin4[rr][i][2]; v[4 * i + 3] = xin4[rr][i][3]; }
#pragma unroll
            for (int i = 0; i < 16; ++i) ss += v[i] * v[i];
            ss = wave_sum(ss);
            float r = rsqrtf(ss / D_MODEL + 1e-6f);
#pragma unroll
            for (int i = 0; i < 16; ++i) v[i] = v[i] * r * gain[lane * 16 + i];
            uint4 o0, o1;
            o0.x = pk_bf16(v[0], v[1]); o0.y = pk_bf16(v[2], v[3]); o0.z = pk_bf16(v[4], v[5]); o0.w = pk_bf16(v[6], v[7]);
            o1.x = pk_bf16(v[8], v[9]); o1.y = pk_bf16(v[10], v[11]); o1.z = pk_bf16(v[12], v[13]); o1.w = pk_bf16(v[14], v[15]);
            bf16_t* hr = hn + pl_off(t, lane * 16, 1024);
            *(uint4*)hr = o0; *(uint4*)(hr + 8) = o1;
            *(uint4*)(lds + lr * HL + lane * 16) = o0; *(uint4*)(lds + lr * HL + lane * 16 + 8) = o1;
        }
        __syncthreads();
        f32x4 acc[3];
#pragma unroll
        for (int n = 0; n < 3; ++n) acc[n] = (f32x4){0.f, 0.f, 0.f, 0.f};
#pragma unroll
        for (int ks = 0; ks < 8; ++ks) {
            int k = w * 256 + ks * 32 + fg * 8;
            bf16x8 a = *(const bf16x8*)(lds + fr * HL + k);
#pragma unroll
            for (int n = 0; n < 3; ++n) {
                bf16x8 b = *(const bf16x8*)(wr + (size_t)(n * 16 + fr) * 1024 + k);
                acc[n] = __builtin_amdgcn_mfma_f32_16x16x32_bf16(a, b, acc[n], 0, 0, 0);
            }
        }
#pragma unroll
        for (int n = 0; n < 3; ++n) *(f32x4*)(red + ((w * 3 + n) * 64 + lane) * 4) = acc[n];
        __syncthreads();
        if (tid < 16) {
            float lg[36];
#pragma unroll
            for (int j = 0; j < 36; ++j) {
                int n = j >> 4, f = j & 15; int ln = (tid >> 2) * 16 + f; float s = 0.f;
#pragma unroll
                for (int ww = 0; ww < 4; ++ww) s += red[((ww * 3 + n) * 64 + ln) * 4 + (tid & 3)];
                lg[j] = s;
            }
            float gl[4]; float gm = -1e30f; int gi = 0;
#pragma unroll
            for (int j = 0; j < 4; ++j) { gl[j] = lg[j] + brg[j]; if (gl[j] > gm) { gm = gl[j]; gi = j; } }
            float gs = 0.f;
#pragma unroll
            for (int j = 0; j < 4; ++j) gs += __expf(gl[j] - gm);
            float gp = 1.f / gs;
            float el[8]; float em = -1e30f;
#pragma unroll
            for (int j = 0; j < 8; ++j) {
                float v = (gi == 0) ? lg[4 + j] : (gi == 1) ? lg[12 + j] : (gi == 2) ? lg[20 + j] : lg[28 + j];
                el[j] = v + bre[gi * 8 + j]; em = fmaxf(em, el[j]);
            }
#pragma unroll
            for (int j = 0; j < 8; ++j) el[j] = __expf(el[j] - em);
            float v0 = -1.f, v1 = -1.f; int i0 = 0, i1 = 0;
#pragma unroll
            for (int j = 0; j < 8; ++j) {
                float v = el[j];
                if (v > v0) { v1 = v0; i1 = i0; v0 = v; i0 = j; }
                else if (v > v1) { v1 = v; i1 = j; }
            }
            int t = it * 16 + tid;
            int e0 = gi * 8 + i0, e1 = gi * 8 + i1;
            if (!dry) {
            const int sh = blockIdx.x & (NSH - 1);
            unsigned s0 = atomicAdd(&cnt[(e0 * NSH + sh) * CNT_STRIDE], 1u), s1 = atomicAdd(&cnt[(e1 * NSH + sh) * CNT_STRIDE], 1u);
            rowtok[(size_t)(e0 * NSH + sh) * SHCAP + s0] = t; rowtok[(size_t)(e1 * NSH + sh) * SHCAP + s1] = t;
            tslot[t * 2] = (e0 << 16) | (sh << 11) | (int)s0; tslot[t * 2 + 1] = (e1 << 16) | (sh << 11) | (int)s1;
            tgate[t * 2] = gp * v0 / (v0 + v1); tgate[t * 2 + 1] = gp * v1 / (v0 + v1);
            } else if (gp * v0 == 123.456f) tgate[0] = v1;
        }
    }
}

__device__ __forceinline__ void moe_tables(const unsigned* cnt, int* tab) {
    const int t = threadIdx.x;
    int* sc = tab + 80 + 32 * 9;
    sc[t] = (int)ld_u32_agent(cnt + t * CNT_STRIDE);
    __syncthreads();
    if (t < 32) { int a = 0; for (int s = 0; s < NSH; ++s) { tab[80 + t * 9 + s] = a; a += sc[t * NSH + s]; } tab[80 + t * 9 + 8] = a; }
    __syncthreads();
    if (t == 0) {
        int a = 0;
        for (int e = 0; e < 32; ++e) { tab[e] = a; tab[40 + e] = a * 128; a += (tab[80 + e * 9 + 8] + 127) >> 7; }
        tab[32] = a; tab[72] = a * 128;
    }
    __syncthreads();
}
template <int MODE>
__device__ void phase_expert(const Params& p, int l, bf16_t* lds) {
    const int tid = ltid(), lane = tid & 63, w = tid >> 6, wx = w >> 1, wy = w & 1, fr = lane & 15, fg = lane >> 4;
    const unsigned* cnt = (const unsigned*)(p.ws + WS_CTL) + CW_CNT + l * 32 * NSH * CNT_STRIDE;
    int* tab = (int*)(lds + 4 * GSTAGE);
    moe_tables(cnt, tab);
    if (MODE == 0 && blockIdx.x == 0) {
        unsigned* mt = (unsigned*)(p.ws + WS_CTL) + CW_MOETAB + l * 32 * NSH;
        mt[threadIdx.x] = (unsigned)(tab[40 + (threadIdx.x >> 3)] + tab[80 + (threadIdx.x >> 3) * 9 + (threadIdx.x & 7)]);
    }
    const int* rowtok = (const int*)(p.ws + WS_ROWTOK);
    const bf16_t* hn = (const bf16_t*)(p.ws + WS_HN);
    bf16_t* Hb = (bf16_t*)(p.ws + WS_H);
    bf16_t* Yb = (bf16_t*)(p.ws + WS_Y);
    const int x = blockIdx.x & 7, loc = blockIdx.x >> 3, nloc = gridDim.x >> 3;
    for (int j = loc;; j += nloc) {
        int e = -1, rt = 0, tn = 0; int jj = j;
#pragma unroll
        for (int q = 0; q < 4; ++q) {
            int ee = q * 8 + x; int nrt = tab[ee + 1] - tab[ee];
            if (e < 0) { if (jj < nrt * 8) { e = ee; tn = jj / nrt; rt = jj % nrt; } else jj -= nrt * 8; }
        }
        if (e < 0) break;
        const int hrow0 = tab[40 + e] + rt * 128;
        f32x4 acc[4][4];
        if (MODE == 0) {
            const bf16_t* wbase = (const bf16_t*)(p.ws + WS_WGU) + ((size_t)l * 32 + e) * 1024 * 1024;
            const int* spx = tab + 80 + e * 9;
            auto rw = [&](int r) { return wbase + pl_off(tn * 128 + r, 0, 1024); };
            auto rt_ = [&](int r) {
                const int s = rt * 128 + r; int t = 0;
                if (s < spx[8]) {
                    int xs = 0;
#pragma unroll
                    for (int q = 1; q < NSH; ++q) xs += (s >= spx[q]) ? 1 : 0;
                    t = rowtok[(size_t)(e * NSH + xs) * SHCAP + (s - spx[xs])];
                }
                return hn + pl_off(t, 0, 1024); };
            gemm_core(rw, rt_, 1024, lds, acc);
        } else {
            const bf16_t* wbase = (const bf16_t*)(p.ws + WS_WD) + ((size_t)l * 32 + e) * 1024 * 512;
            auto rw = [&](int r) { return wbase + pl_off(tn * 128 + r, 0, 512); };
            auto rt_ = [&](int r) { return Hb + pl_off(hrow0 + r, 0, 512); };
            gemm_core(rw, rt_, 512, lds, acc);
        }
        RAW_BARRIER();
        if (MODE == 0) {
#pragma unroll
            for (int n = 0; n < 4; ++n)
#pragma unroll
                for (int m = 0; m < 2; ++m)
                    ep_put<64>(lds, wy * 64 + n * 16 + fr, wx * 32 + m * 16 + 4 * fg, siluf_(acc[m][n][0]) * acc[m + 2][n][0], siluf_(acc[m][n][1]) * acc[m + 2][n][1],
                               siluf_(acc[m][n][2]) * acc[m + 2][n][2], siluf_(acc[m][n][3]) * acc[m + 2][n][3]);
            RAW_BARRIER();
            ep_flush<64>(lds, tid, [&](int row, int c8) { return Hb + pl_off(hrow0 + row, tn * 64 + c8 * 8, 512); });
        } else {
#pragma unroll
            for (int n = 0; n < 4; ++n)
#pragma unroll
                for (int m = 0; m < 4; ++m) ep_put<128>(lds, wy * 64 + n * 16 + fr, wx * 64 + m * 16 + 4 * fg, acc[m][n][0], acc[m][n][1], acc[m][n][2], acc[m][n][3]);
            RAW_BARRIER();
            bf16_t* dstb = Yb + (size_t)hrow0 * 1024 + tn * 128;
            ep_flush<128>(lds, tid, [&](int row, int c8) { return dstb + (size_t)row * 1024 + c8 * 8; });
        }
    }
}

__device__ void phase_combine(const Params& p, int l, int dry = 0) {
    const int tid = ltid(), lane = tid & 63, w = tid >> 6;
    const unsigned* mt = (const unsigned*)(p.ws + WS_CTL) + CW_MOETAB + l * 32 * NSH;
    const int* tslot = (const int*)(p.ws + WS_TSLOT);
    const float* tgate = (const float*)(p.ws + WS_TGATE);
    const bf16_t* Yb = (const bf16_t*)(p.ws + WS_Y);
    bf16_t* hn = dry ? (bf16_t*)(p.ws + WS_SCR + (size_t)40 * 1024 * 1024) : (bf16_t*)(p.ws + WS_HN);
    float* x = p.out; float* xw = dry ? (float*)(p.ws + WS_SCR) : p.out;
    const float* gain = (l == 0 || dry) ? p.in[1] + 1024 : nullptr;
    for (int it = blockIdx.x; it < NTOK / 4; it += gridDim.x) {
        int t = it * 4 + w;
        int ts0 = tslot[t * 2], ts1 = tslot[t * 2 + 1];
        float g0 = tgate[t * 2], g1 = tgate[t * 2 + 1];
        int r0 = (int)mt[((ts0 >> 16) << 3) | ((ts0 >> 11) & 7)] + (ts0 & 0x7ff);
        int r1 = (int)mt[((ts1 >> 16) << 3) | ((ts1 >> 11) & 7)] + (ts1 & 0x7ff);
        float* xr = x + (size_t)t * 1024 + lane * 16;
        const bf16_t* y0 = Yb + (size_t)r0 * 1024 + lane * 16;
        const bf16_t* y1 = Yb + (size_t)r1 * 1024 + lane * 16;
        float v[16];
#pragma unroll
        for (int i = 0; i < 4; ++i) { float4 q = *(const float4*)(xr + 4 * i); v[4 * i] = q.x; v[4 * i + 1] = q.y; v[4 * i + 2] = q.z; v[4 * i + 3] = q.w; }
        uint4 a0 = *(const uint4*)y0, a1 = *(const uint4*)(y0 + 8), b0 = *(const uint4*)y1, b1 = *(const uint4*)(y1 + 8);
        unsigned ya[8] = {a0.x, a0.y, a0.z, a0.w, a1.x, a1.y, a1.z, a1.w};
        unsigned yb[8] = {b0.x, b0.y, b0.z, b0.w, b1.x, b1.y, b1.z, b1.w};
#pragma unroll
        for (int i = 0; i < 8; ++i) {
            v[2 * i] += g0 * bflo(ya[i]) + g1 * bflo(yb[i]);
            v[2 * i + 1] += g0 * bfhi(ya[i]) + g1 * bfhi(yb[i]);
        }
#ifdef NANMARK
#pragma unroll
        for (int i = 0; i < 16; ++i) if (!(fabsf(v[i]) < 1e30f)) v[i] = 1000.f;
#endif
#pragma unroll
        for (int i = 0; i < 4; ++i) *(float4*)(xw + (size_t)t * 1024 + lane * 16 + 4 * i) = make_float4(v[4 * i], v[4 * i + 1], v[4 * i + 2], v[4 * i + 3]);
        if (gain) {
            float ss = 0.f;
#pragma unroll
            for (int i = 0; i < 16; ++i) ss += v[i] * v[i];
            ss = wave_sum(ss);
            float r = rsqrtf(ss / D_MODEL + 1e-6f);
#pragma unroll
            for (int i = 0; i < 16; ++i) v[i] = v[i] * r * gain[lane * 16 + i];
            uint4 o0, o1;
            o0.x = pk_bf16(v[0], v[1]); o0.y = pk_bf16(v[2], v[3]); o0.z = pk_bf16(v[4], v[5]); o0.w = pk_bf16(v[6], v[7]);
            o1.x = pk_bf16(v[8], v[9]); o1.y = pk_bf16(v[10], v[11]); o1.z = pk_bf16(v[12], v[13]); o1.w = pk_bf16(v[14], v[15]);
            bf16_t* hr = hn + pl_off(t, lane * 16, 1024);
            *(uint4*)hr = o0; *(uint4*)(hr + 8) = o1;
        }
    }
}


__device__ __forceinline__ void mm_row(const bf16_t* RA, const bf16_t* RB, int mw, int fr, int fg, f32x4 (&acc)[4]) {
#pragma unroll
    for (int ks = 0; ks < 2; ++ks) {
        bf16x8 a = *(const bf16x8*)(RA + (16 * mw + fr) * LROW + ks * 32 + fg * 8);
#pragma unroll
        for (int nt = 0; nt < 4; ++nt) {
            bf16x8 b = *(const bf16x8*)(RB + (16 * nt + fr) * LROW + ks * 32 + fg * 8);
            acc[nt] = __builtin_amdgcn_mfma_f32_16x16x32_bf16(a, b, acc[nt], 0, 0, 0);
        }
    }
}
__device__ __forceinline__ void mm_col(const bf16_t* RA, const bf16_t* RB, int nw, int fr, int fg, f32x4 (&acc)[4]) {
#pragma unroll
    for (int ks = 0; ks < 2; ++ks) {
        bf16x8 b = *(const bf16x8*)(RB + (16 * nw + fr) * LROW + ks * 32 + fg * 8);
#pragma unroll
        for (int mt = 0; mt < 4; ++mt) {
            bf16x8 a = *(const bf16x8*)(RA + (16 * mt + fr) * LROW + ks * 32 + fg * 8);
            acc[mt] = __builtin_amdgcn_mfma_f32_16x16x32_bf16(a, b, acc[mt], 0, 0, 0);
        }
    }
}
__device__ __forceinline__ void zero4(f32x4 (&a)[4]) {
#pragma unroll
    for (int i = 0; i < 4; ++i) a[i] = (f32x4){0.f, 0.f, 0.f, 0.f};
}
__device__ __forceinline__ void st4_lds(bf16_t* p, float a, float b, float c, float d) { uint2 o; o.x = pk_bf16(a, b); o.y = pk_bf16(c, d); *(uint2*)p = o; }
__device__ __forceinline__ bf16_t f2bf(float v) { return (bf16_t)(pk_bf16(v, 0.f) & 0xffffu); }

__device__ void gdn_prep_item(const Params& p, int l, int cid, unsigned char* lds_raw) {
    const int tid = ltid(), lane = tid & 63, w = tid >> 6, fr = lane & 15, fg = lane >> 4;
    const int bh = cid >> 6, n = cid & 63, b = bh / H_GDN, h = bh % H_GDN;
    const int t0 = b * SEQ + n * 64;
    bf16_t* L0 = (bf16_t*)lds_raw; bf16_t* L1 = L0 + 64 * LROW; bf16_t* L2 = L1 + 64 * LROW; bf16_t* L3 = L2 + 64 * LROW; bf16_t* L4 = L3 + 64 * LROW; bf16_t* L5 = L4 + 64 * LROW;
    float* dec = (float*)(L5 + 64 * LROW); float* beta = dec + 64;
    const bf16_t* proj = (const bf16_t*)(p.ws + WS_PROJ);
    const float* aux = (const float*)(p.ws + WS_AUX);
    const float* convw = p.in[7] + (size_t)l * 4 * 1152;
    __syncthreads();
    const int i = tid >> 2, c0 = (tid & 3) * 16;
    float qv[16], kv[16], vv[16];
#pragma unroll
    for (int which = 0; which < 3; ++which) {
        float acc[16];
#pragma unroll
        for (int c = 0; c < 16; ++c) acc[c] = 0.f;
#pragma unroll
        for (int tap = 0; tap < 4; ++tap) {
            const int row = i - 3 + tap;
            if (n * 64 + row >= 0) {
                const bf16_t* xp = proj + (size_t)(t0 + row) * NPROJ + NC_GQ + which * 384 + h * 64 + c0;
                u32x4 x0 = *(const u32x4*)xp, x1 = *(const u32x4*)(xp + 8);
                const float* wp = convw + tap * 1152 + which * 384 + h * 64 + c0;
                f32x4 w0 = *(const f32x4*)wp, w1 = *(const f32x4*)(wp + 4), w2 = *(const f32x4*)(wp + 8), w3 = *(const f32x4*)(wp + 12);
                float wv[16] = {w0[0], w0[1], w0[2], w0[3], w1[0], w1[1], w1[2], w1[3], w2[0], w2[1], w2[2], w2[3], w3[0], w3[1], w3[2], w3[3]};
                unsigned xs[8] = {x0[0], x0[1], x0[2], x0[3], x1[0], x1[1], x1[2], x1[3]};
#pragma unroll
                for (int c = 0; c < 8; ++c) { acc[2 * c] += wv[2 * c] * bflo(xs[c]); acc[2 * c + 1] += wv[2 * c + 1] * bfhi(xs[c]); }
            }
        }
        float ss = 0.f;
#pragma unroll
        for (int c = 0; c < 16; ++c) { acc[c] = siluf_(acc[c]); ss += acc[c] * acc[c]; }
        if (which < 2) {
            ss += __shfl_xor(ss, 1, 64); ss += __shfl_xor(ss, 2, 64);
            const float sc = rsqrtf(ss + 1e-6f) * (which == 0 ? 0.125f : 1.f);
#pragma unroll
            for (int c = 0; c < 16; ++c) acc[c] *= sc;
        }
#pragma unroll
        for (int c = 0; c < 16; ++c) { if (which == 0) qv[c] = acc[c]; else if (which == 1) kv[c] = acc[c]; else vv[c] = acc[c]; }
    }
#pragma unroll
    for (int c = 0; c < 16; c += 4) { st4_lds(L2 + i * LROW + c0 + c, kv[c], kv[c + 1], kv[c + 2], kv[c + 3]); st4_lds(L3 + i * LROW + c0 + c, qv[c], qv[c + 1], qv[c + 2], qv[c + 3]); }
    if (w == 0) {
        const float a = aux[(size_t)(t0 + lane) * 64 + AX_GA + h], bl = aux[(size_t)(t0 + lane) * 64 + AX_GB + h];
        const float g = -__expf(p.in[8][l * H_GDN + h]) * softplusf_(a + p.in[9][l * H_GDN + h]);
        float inc = g;
#pragma unroll
        for (int o = 1; o < 64; o <<= 1) { float t = __shfl_up(inc, o, 64); if (lane >= o) inc += t; }
        dec[lane] = inc; beta[lane] = sigmoidf_(bl);
    }
    __syncthreads();
    {
        f32x4 g4[4]; zero4(g4);
        mm_row(L2, L2, w, fr, fg, g4);
#pragma unroll
        for (int nt = 0; nt < 4; ++nt) {
            const int kap = 16 * nt + fr; const float dk_ = dec[kap], bk_ = beta[kap];
            float nT[4], nN[4], tt[4];
#pragma unroll
            for (int r = 0; r < 4; ++r) {
                const int rho = 16 * w + 4 * fg + r; const float dr_ = dec[rho], br_ = beta[rho];
                const float G = g4[nt][r];
                nT[r] = (kap < rho) ? br_ * G * __expf(dr_ - dk_) : 0.f;
                nN[r] = (rho < kap) ? bk_ * G * __expf(dk_ - dr_) : 0.f;
                tt[r] = ((kap == rho) ? 1.f : 0.f) - nN[r];
            }
            st4_lds(L1 + kap * LROW + 16 * w + 4 * fg, nT[0], nT[1], nT[2], nT[3]);
            st4_lds(L0 + kap * LROW + 16 * w + 4 * fg, nN[0], nN[1], nN[2], nN[3]);
            st4_lds(L4 + kap * LROW + 16 * w + 4 * fg, tt[0], tt[1], tt[2], tt[3]);
        }
        f32x4 a4[4]; zero4(a4);
        mm_row(L2, L3, w, fr, fg, a4);
#pragma unroll
        for (int nt = 0; nt < 4; ++nt) {
            const int ii = 16 * nt + fr; const float di_ = dec[ii];
            float v4[4];
#pragma unroll
            for (int r = 0; r < 4; ++r) { const int j = 16 * w + 4 * fg + r; v4[r] = (j <= ii) ? a4[nt][r] * __expf(di_ - dec[j]) : 0.f; }
            st4_lds(L5 + ii * LROW + 16 * w + 4 * fg, v4[0], v4[1], v4[2], v4[3]);
        }
    }
    __syncthreads();
#pragma unroll
    for (int lev = 1; lev <= 5; ++lev) {
        const bf16_t* XA = (lev & 1) ? L0 : L2; const bf16_t* XAt = (lev & 1) ? L1 : L3;
        bf16_t* XB = (lev & 1) ? L2 : L0; bf16_t* XBt = (lev & 1) ? L3 : L1;
        {
            f32x4 x4[4]; zero4(x4);
            mm_row(XA, XAt, w, fr, fg, x4);
#pragma unroll
            for (int nt = 0; nt < 4; ++nt) {
                const int c = 16 * nt + fr;
                st4_lds(XBt + c * LROW + 16 * w + 4 * fg, x4[nt][0], x4[nt][1], x4[nt][2], x4[nt][3]);
                if (lev < 5) {
#pragma unroll
                    for (int r = 0; r < 4; ++r) XB[(16 * w + 4 * fg + r) * LROW + c] = f2bf(x4[nt][r]);
                }
            }
        }
        __syncthreads();
        {
            f32x4 t4[4];
#pragma unroll
            for (int mt = 0; mt < 4; ++mt) {
                uint2 u = *(const uint2*)(L4 + (16 * w + fr) * LROW + 16 * mt + 4 * fg);
                t4[mt] = (f32x4){bflo(u.x), bfhi(u.x), bflo(u.y), bfhi(u.y)};
            }
            mm_col(XBt, L4, w, fr, fg, t4);
#pragma unroll
            for (int mt = 0; mt < 4; ++mt) st4_lds(L4 + (16 * w + fr) * LROW + 16 * mt + 4 * fg, t4[mt][0], t4[mt][1], t4[mt][2], t4[mt][3]);
        }
    }
    {
        const float dj = dec[i], bj = beta[i], dlast = dec[63];
        const float s1 = bj * __expf(dj), s2 = bj, s3 = __expf(dlast - dj);
#pragma unroll
        for (int c = 0; c < 16; ++c) {
            L0[(c0 + c) * LROW + i] = f2bf(kv[c] * s1);
            L1[(c0 + c) * LROW + i] = f2bf(vv[c] * s2);
            L2[(c0 + c) * LROW + i] = f2bf(kv[c] * s3);
        }
    }
    __syncthreads();
    {
        f32x4 w4[4], u4[4]; zero4(w4); zero4(u4);
        mm_row(L4, L0, w, fr, fg, w4);
        mm_row(L4, L1, w, fr, fg, u4);
        __syncthreads();
#pragma unroll
        for (int nt = 0; nt < 4; ++nt) {
            st4_lds(L0 + (16 * nt + fr) * LROW + 16 * w + 4 * fg, w4[nt][0], w4[nt][1], w4[nt][2], w4[nt][3]);
            st4_lds(L1 + (16 * nt + fr) * LROW + 16 * w + 4 * fg, u4[nt][0], u4[nt][1], u4[nt][2], u4[nt][3]);
        }
        const float ed = __expf(dec[i]);
#pragma unroll
        for (int c = 0; c < 16; c += 4) st4_lds(L3 + i * LROW + c0 + c, qv[c] * ed, qv[c + 1] * ed, qv[c + 2] * ed, qv[c + 3] * ed);
    }
    __syncthreads();
    char* scr = p.ws + WS_SCR;
    {
        f32x4 m4[4]; zero4(m4);
        mm_row(L0, L2, w, fr, fg, m4);
        bf16_t* MP = (bf16_t*)(scr + SCR_GDN_MP) + (size_t)cid * 4096;
#pragma unroll
        for (int nt = 0; nt < 4; ++nt) store4_bf16(MP + (16 * nt + fr) * 64 + 16 * w + 4 * fg, -m4[nt][0], -m4[nt][1], -m4[nt][2], -m4[nt][3]);
        f32x4 n4[4]; zero4(n4);
        mm_row(L2, L1, w, fr, fg, n4);
        bf16_t* NN = (bf16_t*)(scr + SCR_GDN_NN) + (size_t)cid * 4096;
#pragma unroll
        for (int nt = 0; nt < 4; ++nt) store4_bf16(NN + ((nt * 4 + w) * 64 + lane) * 4, n4[nt][0], n4[nt][1], n4[nt][2], n4[nt][3]);
        f32x4 p4[4]; zero4(p4);
        mm_row(L0, L5, w, fr, fg, p4);
        bf16_t* PG = (bf16_t*)(scr + SCR_GDN_P) + (size_t)cid * 4096;
#pragma unroll
        for (int nt = 0; nt < 4; ++nt) {
            uint2 u = *(const uint2*)(L3 + (16 * nt + fr) * LROW + 16 * w + 4 * fg);
            store4_bf16(PG + (16 * nt + fr) * 64 + 16 * w + 4 * fg, bflo(u.x) - p4[nt][0], bfhi(u.x) - p4[nt][1], bflo(u.y) - p4[nt][2], bfhi(u.y) - p4[nt][3]);
        }
        f32x4 o4[4]; zero4(o4);
        mm_row(L1, L5, w, fr, fg, o4);
        bf16_t* OL = (bf16_t*)(scr + SCR_GDN_OL) + (size_t)cid * 4096;
#pragma unroll
        for (int nt = 0; nt < 4; ++nt) store4_bf16(OL + (16 * nt + fr) * 64 + 16 * w + 4 * fg, o4[nt][0], o4[nt][1], o4[nt][2], o4[nt][3]);
        if (tid == 0) ((float*)(scr + SCR_GDN_LAST))[cid] = __expf(dec[63]);
    }
}

#define SCAN_SLOT    5120
#define SCAN_SB(k)   ((bf16_t*)lds_raw + (k) * 1024)
#define SCAN_RING(k) ((bf16_t*)lds_raw + 2048 + (k) * SCAN_SLOT)
#define SCAN_LAST    ((float*)(lds_raw + 4096 + 5 * SCAN_SLOT * 2))
__device__ __forceinline__ void scan_issue(const bf16_t* const (&mp)[8], const bf16_t* nn_lane, int n, bf16_t* slot) {
#pragma unroll
    for (int q = 0; q < 8; ++q) __builtin_amdgcn_global_load_lds((const unsigned*)(mp[q] + (size_t)n * 4096), (unsigned*)(slot + q * 512), 16, 0, 0);
    __builtin_amdgcn_global_load_lds((const unsigned*)(nn_lane + (size_t)n * 4096), (unsigned*)(slot + 4096), 16, 0, 0);
    __builtin_amdgcn_global_load_lds((const unsigned*)(nn_lane + (size_t)n * 4096 + 512), (unsigned*)(slot + 4096 + 512), 16, 0, 0);
}
__device__ void gdn_scan_item(const Params& p, int item, unsigned char* lds_raw, int svar = 0) {
    const int tid = ltid(), lane = tid & 63, w = __builtin_amdgcn_readfirstlane(tid >> 6), fr = lane & 15, fg = lane >> 4;
    const int bh = item >> 2, cg = item & 3;
    char* scr = p.ws + WS_SCR;
    const bf16_t* MP = (const bf16_t*)(scr + SCR_GDN_MP) + (size_t)bh * 64 * 4096;
    const bf16_t* NN = (const bf16_t*)(scr + SCR_GDN_NN) + (size_t)bh * 64 * 4096 + cg * 1024;
    const float* LAST = (const float*)(scr + SCR_GDN_LAST) + bh * 64;
    bf16_t* SG = (bf16_t*)(scr + SCR_GDN_SG) + (size_t)bh * 64 * 4096 + cg * 1024;
    const bf16_t* mp[8];
#pragma unroll
    for (int q = 0; q < 8; ++q) { const int row = 8 * q + (lane >> 3); mp[q] = MP + row * 64 + (((lane & 7) ^ ((row >> 1) & 7)) * 8); }
    const bf16_t* nn_lane = NN + lane * 8;
    RAW_BARRIER();
    if (tid < 64) SCAN_LAST[tid] = ld_f32_agent(LAST + tid);
    asm volatile("s_waitcnt vmcnt(0)" ::: "memory");
    f32x4 S = (f32x4){0.f, 0.f, 0.f, 0.f};
    const int swz = (fr >> 1) & 7;
    if (w == 0) {
#pragma unroll
        for (int n = 0; n < 4; ++n) scan_issue(mp, nn_lane, n, SCAN_RING(n));
    }
    for (int n = 0; n < 64; ++n) {
        bf16_t* sb = SCAN_SB(n & 1);
        const bf16_t* ring = SCAN_RING(n % 5);
        {
            const int c = 2 * w + (fg >> 1);
            uint2 o; o.x = pk_bf16(S[0], S[1]); o.y = pk_bf16(S[2], S[3]);
            *(uint2*)(sb + fr * 64 + ((c ^ swz) * 8) + 4 * (fg & 1)) = o;
        }
        if (w == 0) {
            if (n + 3 < 64) asm volatile("s_waitcnt vmcnt(30)" ::: "memory");
            else if (n + 2 < 64) asm volatile("s_waitcnt vmcnt(20)" ::: "memory");
            else if (n + 1 < 64) asm volatile("s_waitcnt vmcnt(10)" ::: "memory");
            else asm volatile("s_waitcnt vmcnt(0)" ::: "memory");
        }
        RAW_BARRIER();
        if (w == 0 && n + 4 < 64 && svar != 2) scan_issue(mp, nn_lane, n + 4, SCAN_RING((n + 4) % 5));
        const float last = SCAN_LAST[n];
        {
            u32x2 nn = *(const u32x2*)(ring + 4096 + (w * 64 + lane) * 4);
            S[0] = last * S[0] + bflo(nn[0]); S[1] = last * S[1] + bfhi(nn[0]);
            S[2] = last * S[2] + bflo(nn[1]); S[3] = last * S[3] + bfhi(nn[1]);
        }
#pragma unroll
        for (int ks = 0; ks < 2; ++ks) {
            const int co = ((ks * 4 + fg) ^ swz) * 8;
            bf16x8 a = *(const bf16x8*)(ring + (16 * w + fr) * 64 + co);
            bf16x8 s = *(const bf16x8*)(sb + fr * 64 + co);
            S = __builtin_amdgcn_mfma_f32_16x16x32_bf16(a, s, S, 0, 0, 0);
        }
        if (w >= 2 && svar != 1) {
            const int c = (w - 2) * 64 + lane; const int row = c >> 3, pc = c & 7;
            u32x4 v = *(const u32x4*)(sb + row * 64 + pc * 8);
            *(u32x4*)(SG + (size_t)n * 4096 + row * 64 + ((pc ^ ((row >> 1) & 7)) * 8)) = v;
        }
    }
}

__device__ void gdn_out_item(const Params& p, int l, int cid) {
    const int tid = ltid(), lane = tid & 63, w = tid >> 6, fr = lane & 15, fg = lane >> 4;
    const int bh = cid >> 6, n = cid & 63, b = bh / H_GDN, h = bh % H_GDN;
    char* scr = p.ws + WS_SCR;
    const bf16_t* SG = (const bf16_t*)(scr + SCR_GDN_SG) + (size_t)cid * 4096;
    const bf16_t* PG = (const bf16_t*)(scr + SCR_GDN_P) + (size_t)cid * 4096;
    const bf16_t* OL = (const bf16_t*)(scr + SCR_GDN_OL) + (size_t)cid * 4096;
    const int i = 16 * w + fr; const int t = b * SEQ + n * 64 + i;
    f32x4 acc[4];
#pragma unroll
    for (int mt = 0; mt < 4; ++mt) { uint2 u = *(const uint2*)(OL + i * 64 + 16 * mt + 4 * fg); acc[mt] = (f32x4){bflo(u.x), bfhi(u.x), bflo(u.y), bfhi(u.y)}; }
#pragma unroll
    for (int ks = 0; ks < 2; ++ks) {
        bf16x8 bq = *(const bf16x8*)(PG + i * 64 + ks * 32 + fg * 8);
#pragma unroll
        for (int mt = 0; mt < 4; ++mt) {
            bf16x8 a = *(const bf16x8*)(SG + (16 * mt + fr) * 64 + ks * 32 + fg * 8);
            acc[mt] = __builtin_amdgcn_mfma_f32_16x16x32_bf16(a, bq, acc[mt], 0, 0, 0);
        }
    }
    float ss = 0.f;
#pragma unroll
    for (int mt = 0; mt < 4; ++mt)
#pragma unroll
        for (int r = 0; r < 4; ++r) ss += acc[mt][r] * acc[mt][r];
    ss += __shfl_xor(ss, 16, 64); ss += __shfl_xor(ss, 32, 64);
    const float rstd = rsqrtf(ss * (1.f / 64.f) + 1e-6f);
    const float* og = p.in[10] + l * 64;
    const bf16_t* gp = (const bf16_t*)(p.ws + WS_PROJ) + (size_t)t * NPROJ + NC_GG + h * 64;
    bf16_t* mp = (bf16_t*)(p.ws + WS_MIX) + pl_off(t, 384 + h * 64, 1024);
#pragma unroll
    for (int mt = 0; mt < 4; ++mt) {
        const int e0 = 16 * mt + 4 * fg;
        uint2 gu = *(const uint2*)(gp + e0); f32x4 g4 = *(const f32x4*)(og + e0);
        store4_bf16(mp + e0 + (e0 & 32), acc[mt][0] * rstd * g4[0] * bflo(gu.x), acc[mt][1] * rstd * g4[1] * bfhi(gu.x), acc[mt][2] * rstd * g4[2] * bflo(gu.y), acc[mt][3] * rstd * g4[3] * bfhi(gu.y));
    }
}

#define GQROW 40
__device__ void gla_prep_item(const Params& p, int l, int cid, unsigned char* lds_raw) {
    const int tid = ltid(), lane = tid & 63, w = tid >> 6, fr = lane & 15, fg = lane >> 4;
    const int bh = cid >> 6, n = cid & 63, b = bh / H_GLA, h = bh % H_GLA;
    const int t0 = b * SEQ + n * 64;
    float* Bf = (float*)lds_raw;
    bf16_t* Qt = (bf16_t*)(lds_raw + 8448);
    bf16_t* Kt = Qt + 64 * GQROW;
    bf16_t* KLt = Kt + 64 * GQROW;
    bf16_t* Vt = KLt + 32 * LROW;
    const bf16_t* proj = (const bf16_t*)(p.ws + WS_PROJ);
    const float* aux = (const float*)(p.ws + WS_AUX);
    char* scr = p.ws + WS_SCR;
    __syncthreads();
    const int i = tid >> 2, d0 = (tid & 3) * 8;
    {
        const float* wa = p.in[11] + (size_t)l * 16 * 128 + h * 32 + d0;
        const float* ba = p.in[12] + l * 128 + h * 32 + d0;
        float acc[8];
#pragma unroll
        for (int j = 0; j < 8; ++j) acc[j] = ba[j];
        float a1v[16];
#pragma unroll
        for (int r = 0; r < 16; r += 2) { float2 t2 = *(const float2*)(aux + (size_t)(t0 + i) * 64 + AX_LA + r); a1v[r] = t2.x; a1v[r + 1] = t2.y; }
#pragma unroll
        for (int r = 0; r < 16; ++r) {
            f32x4 wA = *(const f32x4*)(wa + r * 128), wB = *(const f32x4*)(wa + r * 128 + 4);
#pragma unroll
            for (int j = 0; j < 4; ++j) { acc[j] += a1v[r] * wA[j]; acc[4 + j] += a1v[r] * wB[j]; }
        }
#pragma unroll
        for (int j = 0; j < 8; ++j) Bf[i * 33 + d0 + j] = logsigmoidf_(acc[j]) * (1.f / 16.f);
    }
    {
        const bf16_t* lvt = (const bf16_t*)(scr + SCR_LVT) + (size_t)bh * 64 * SEQ + n * 64;
#pragma unroll
        for (int ii = 0; ii < 2; ++ii) { int c = tid + 256 * ii; int row = c >> 3, kc = c & 7; *(u32x4*)(Vt + row * LROW + kc * 8) = *(const u32x4*)(lvt + (size_t)row * SEQ + kc * 8); }
    }
    __syncthreads();
#pragma unroll
    for (int c = 0; c < 8; ++c) {
        const int d = 8 * w + c;
        float inc = Bf[lane * 33 + d];
#pragma unroll
        for (int o = 1; o < 64; o <<= 1) { float t = __shfl_up(inc, o, 64); if (lane >= o) inc += t; }
        Bf[lane * 33 + d] = inc;
    }
    __syncthreads();
    {
        const bf16_t* qp = proj + (size_t)(t0 + i) * NPROJ + NC_LQ + h * 32 + d0;
        const bf16_t* kp = proj + (size_t)(t0 + i) * NPROJ + NC_LK + h * 32 + d0;
        u32x4 qu = *(const u32x4*)qp, ku = *(const u32x4*)kp;
        float qf[8] = {bflo(qu[0]), bfhi(qu[0]), bflo(qu[1]), bfhi(qu[1]), bflo(qu[2]), bfhi(qu[2]), bflo(qu[3]), bfhi(qu[3])};
        float kf[8] = {bflo(ku[0]), bfhi(ku[0]), bflo(ku[1]), bfhi(ku[1]), bflo(ku[2]), bfhi(ku[2]), bflo(ku[3]), bfhi(ku[3])};
        float qt[8], kt[8], qb[8];
#pragma unroll
        for (int j = 0; j < 8; ++j) {
            const float bi = Bf[i * 33 + d0 + j], bm = Bf[31 * 33 + d0 + j], bl = Bf[63 * 33 + d0 + j];
            qt[j] = qf[j] * __expf(bi - bm); kt[j] = kf[j] * __expf(bm - bi); qb[j] = qf[j] * __expf(bi);
            KLt[(d0 + j) * LROW + i] = f2bf(kf[j] * __expf(bl - bi));
            if (i == 63) ((float*)(scr + SCR_GLA_DL))[cid * 32 + d0 + j] = __expf(bl);
        }
        u32x4 o; o[0] = pk_bf16(qt[0], qt[1]); o[1] = pk_bf16(qt[2], qt[3]); o[2] = pk_bf16(qt[4], qt[5]); o[3] = pk_bf16(qt[6], qt[7]);
        *(u32x4*)(Qt + i * GQROW + d0) = o;
        o[0] = pk_bf16(kt[0], kt[1]); o[1] = pk_bf16(kt[2], kt[3]); o[2] = pk_bf16(kt[4], kt[5]); o[3] = pk_bf16(kt[6], kt[7]);
        *(u32x4*)(Kt + i * GQROW + d0) = o;
        o[0] = pk_bf16(qb[0], qb[1]); o[1] = pk_bf16(qb[2], qb[3]); o[2] = pk_bf16(qb[4], qb[5]); o[3] = pk_bf16(qb[6], qb[7]);
        *(u32x4*)((bf16_t*)(scr + SCR_GLA_QB) + (size_t)cid * 2048 + i * 32 + d0) = o;
    }
    __syncthreads();
    f32x4 sc[4];
    {
        bf16x8 bq = *(const bf16x8*)(Qt + (16 * w + fr) * GQROW + fg * 8);
#pragma unroll
        for (int mt = 0; mt < 4; ++mt) {
            bf16x8 a = *(const bf16x8*)(Kt + (16 * mt + fr) * GQROW + fg * 8);
            sc[mt] = __builtin_amdgcn_mfma_f32_16x16x32_bf16(a, bq, (f32x4){0.f, 0.f, 0.f, 0.f}, 0, 0, 0);
        }
        const int ii = 16 * w + fr;
#pragma unroll
        for (int mt = 0; mt < 4; ++mt)
#pragma unroll
            for (int r = 0; r < 4; ++r) { const int j = 16 * mt + 4 * fg + r; if (j > ii) sc[mt][r] = 0.f; }
    }
    {
        f32x4 o4[4]; zero4(o4);
#pragma unroll
        for (int kk = 0; kk < 2; ++kk) {
            u32x4 pb = {pk_bf16(sc[2 * kk][0], sc[2 * kk][1]), pk_bf16(sc[2 * kk][2], sc[2 * kk][3]), pk_bf16(sc[2 * kk + 1][0], sc[2 * kk + 1][1]), pk_bf16(sc[2 * kk + 1][2], sc[2 * kk + 1][3])};
#pragma unroll
            for (int mt = 0; mt < 4; ++mt) {
                uint2 v0 = *(const uint2*)(Vt + (16 * mt + fr) * LROW + 32 * kk + 4 * fg), v1 = *(const uint2*)(Vt + (16 * mt + fr) * LROW + 32 * kk + 16 + 4 * fg);
                u32x4 va = {v0.x, v0.y, v1.x, v1.y};
                o4[mt] = __builtin_amdgcn_mfma_f32_16x16x32_bf16(__builtin_bit_cast(bf16x8, va), __builtin_bit_cast(bf16x8, pb), o4[mt], 0, 0, 0);
            }
        }
        bf16_t* OL = (bf16_t*)(scr + SCR_GLA_OL) + (size_t)cid * 4096;
#pragma unroll
        for (int mt = 0; mt < 4; ++mt) store4_bf16(OL + (16 * w + fr) * 64 + 16 * mt + 4 * fg, o4[mt][0], o4[mt][1], o4[mt][2], o4[mt][3]);
    }
    {
        f32x4 k4[2] = {(f32x4){0.f, 0.f, 0.f, 0.f}, (f32x4){0.f, 0.f, 0.f, 0.f}};
#pragma unroll
        for (int ks = 0; ks < 2; ++ks) {
            bf16x8 bv = *(const bf16x8*)(Vt + (16 * w + fr) * LROW + ks * 32 + fg * 8);
#pragma unroll
            for (int mt = 0; mt < 2; ++mt) {
                bf16x8 a = *(const bf16x8*)(KLt + (16 * mt + fr) * LROW + ks * 32 + fg * 8);
                k4[mt] = __builtin_amdgcn_mfma_f32_16x16x32_bf16(a, bv, k4[mt], 0, 0, 0);
            }
        }
        float* KV = (float*)(scr + SCR_GLA_KV) + (size_t)cid * 2048;
#pragma unroll
        for (int mt = 0; mt < 2; ++mt) *(f32x4*)(KV + (16 * w + fr) * 32 + 16 * mt + 4 * fg) = k4[mt];
    }
}
__device__ void gla_scan_item(const Params& p, int g) {
    const int tid = ltid();
    const int bh = g >> 3, idx = (g & 7) * 256 + tid, d = idx & 31;
    char* scr = p.ws + WS_SCR;
    const float* __restrict__ KV = (const float*)(scr + SCR_GLA_KV) + (size_t)bh * 64 * 2048 + idx;
    const float* __restrict__ DL = (const float*)(scr + SCR_GLA_DL) + bh * 64 * 32 + d;
    bf16_t* __restrict__ SG = (bf16_t*)(scr + SCR_GLA_SG) + (size_t)bh * 64 * 2048 + idx;
    float S = 0.f;
    for (int n0 = 0; n0 < 64; n0 += 8) {
        float kv[8], dl[8];
#pragma unroll
        for (int u = 0; u < 8; ++u) { kv[u] = KV[(size_t)(n0 + u) * 2048]; dl[u] = DL[(n0 + u) * 32]; }
#pragma unroll
        for (int u = 0; u < 8; ++u) { SG[(size_t)(n0 + u) * 2048] = f2bf(S); S = dl[u] * S + kv[u]; }
    }
}
__device__ void gla_out_item(const Params& p, int l, int cid) {
    const int tid = ltid(), lane = tid & 63, w = tid >> 6, fr = lane & 15, fg = lane >> 4;
    const int bh = cid >> 6, n = cid & 63, b = bh / H_GLA, h = bh % H_GLA;
    char* scr = p.ws + WS_SCR;
    const bf16_t* SG = (const bf16_t*)(scr + SCR_GLA_SG) + (size_t)cid * 2048;
    const bf16_t* QB = (const bf16_t*)(scr + SCR_GLA_QB) + (size_t)cid * 2048;
    const bf16_t* OL = (const bf16_t*)(scr + SCR_GLA_OL) + (size_t)cid * 4096;
    const int i = 16 * w + fr; const int t = b * SEQ + n * 64 + i;
    f32x4 acc[4];
#pragma unroll
    for (int mt = 0; mt < 4; ++mt) { uint2 u = *(const uint2*)(OL + i * 64 + 16 * mt + 4 * fg); acc[mt] = (f32x4){bflo(u.x), bfhi(u.x), bflo(u.y), bfhi(u.y)}; }
    bf16x8 bq = *(const bf16x8*)(QB + i * 32 + fg * 8);
#pragma unroll
    for (int mt = 0; mt < 4; ++mt) {
        bf16x8 a = *(const bf16x8*)(SG + (16 * mt + fr) * 32 + fg * 8);
        acc[mt] = __builtin_amdgcn_mfma_f32_16x16x32_bf16(a, bq, acc[mt], 0, 0, 0);
    }
    float ss = 0.f;
#pragma unroll
    for (int mt = 0; mt < 4; ++mt)
#pragma unroll
        for (int r = 0; r < 4; ++r) ss += acc[mt][r] * acc[mt][r];
    ss += __shfl_xor(ss, 16, 64); ss += __shfl_xor(ss, 32, 64);
    const float rstd = rsqrtf(ss * (1.f / 64.f) + 1e-6f);
    const float* og = p.in[13] + l * 64;
    const bf16_t* rp = (const bf16_t*)(p.ws + WS_PROJ) + (size_t)t * NPROJ + NC_LR + h * 64;
    bf16_t* mp = (bf16_t*)(p.ws + WS_MIX) + pl_off(t, 768 + h * 64, 1024);
#pragma unroll
    for (int mt = 0; mt < 4; ++mt) {
        const int e0 = 16 * mt + 4 * fg;
        uint2 gu = *(const uint2*)(rp + e0); f32x4 g4 = *(const f32x4*)(og + e0);
        store4_bf16(mp + e0 + (e0 & 32), acc[mt][0] * rstd * g4[0] * bflo(gu.x), acc[mt][1] * rstd * g4[1] * bfhi(gu.x), acc[mt][2] * rstd * g4[2] * bflo(gu.y), acc[mt][3] * rstd * g4[3] * bfhi(gu.y));
    }
}
__device__ void phase_mixout(const Params& p, int l) {
    for (int it = blockIdx.x; it < NGDN_CH + NGLA_CH; it += gridDim.x) {
        if (it < NGDN_CH) { if (MIXSEL & 1) gdn_out_item(p, l, it); } else { if (MIXSEL & 2) gla_out_item(p, l, it - NGDN_CH); }
    }
}

__device__ void fox_cumsum_item(const Params& p, int l, int bh, float* ldsf) {
    const int tid = ltid(), lane = tid & 63, w = tid >> 6;
    const int b = bh / H_FOX, h = bh % H_FOX;
    const float* aux = (const float*)(p.ws + WS_AUX);
    float* cum = (float*)(p.ws + WS_CUM) + (size_t)bh * SEQ;
    const float fb = p.in[5][l * H_FOX + h];
    float v[16]; float s = 0.f;
#pragma unroll
    for (int i = 0; i < 16; ++i) { v[i] = logsigmoidf_(aux[(size_t)(b * SEQ + tid * 16 + i) * 64 + AX_FF + h] + fb); s += v[i]; }
    float inc = s;
#pragma unroll
    for (int o = 1; o < 64; o <<= 1) { float t = __shfl_up(inc, o, 64); if (lane >= o) inc += t; }
    __syncthreads();
    if (lane == 63) ldsf[w] = inc;
    __syncthreads();
    float base = inc - s;
    for (int ww = 0; ww < w; ++ww) base += ldsf[ww];
    float c = base;
    u32x4* csx = (u32x4*)(p.ws + WS_SCR + SCR_CSX) + (size_t)bh * SEQ;
#pragma unroll
    for (int i = 0; i < 16; ++i) {
        c += v[i]; cum[tid * 16 + i] = c;
        const float vv = 1.4426950408889634f * c;
        const unsigned hi = pk_bf16(vv, 0.f) & 0xffffu; const float r1 = vv - __uint_as_float(hi << 16);
        const unsigned mid = pk_bf16(r1, 0.f) & 0xffffu; const float r2 = r1 - __uint_as_float(mid << 16);
        const unsigned lo = pk_bf16(r2, 0.f) & 0xffffu;
        u32x4 f; f[0] = 0x3F803F80u; f[1] = 0x3F80u | ((hi ^ 0x8000u) << 16); f[2] = (mid ^ 0x8000u) | ((lo ^ 0x8000u) << 16); f[3] = 0u;
        csx[tid * 16 + i] = f;
    }
}
__device__ void phase_prep(const Params& p, int l, unsigned char* lds_raw) {
    const int n0 = BATCH * H_FOX, n1 = n0 + ((MIXSEL & 1) ? NGDN_CH : 0), n2 = n1 + ((MIXSEL & 2) ? NGLA_CH : 0);
    for (int it = blockIdx.x; it < n2; it += gridDim.x) {
        if (it < n0) { __syncthreads(); fox_cumsum_item(p, l, it, (float*)lds_raw); }
        else if (it < n1) gdn_prep_item(p, l, it - n0, lds_raw);
        else gla_prep_item(p, l, it - n1, lds_raw);
    }
}

typedef float f32x16 __attribute__((ext_vector_type(16)));
#define ATT_BUF 17408
#define ATT_THR 8.0f
#define ATT_NSTAGE 3
__device__ __forceinline__ void attn_issue(const bf16_t* const (&kp)[2], const bf16_t* const (&vp)[2], const bf16_t* cp, int s0, unsigned char* stage, int w) {
    bf16_t* Ks = (bf16_t*)stage; bf16_t* Vs = Ks + 4096; bf16_t* cs = Vs + 4096;
    __builtin_amdgcn_global_load_lds((const unsigned*)(kp[0] + (size_t)s0 * NPROJ), (unsigned*)(Ks + (w * 8) * 64), 16, 0, 0);
    __builtin_amdgcn_global_load_lds((const unsigned*)(kp[1] + (size_t)s0 * NPROJ), (unsigned*)(Ks + (32 + w * 8) * 64), 16, 0, 0);
    __builtin_amdgcn_global_load_lds((const unsigned*)(vp[0] + s0), (unsigned*)(Vs + (w * 8) * 64), 16, 0, 0);
    __builtin_amdgcn_global_load_lds((const unsigned*)(vp[1] + s0), (unsigned*)(Vs + (32 + w * 8) * 64), 16, 0, 0);
    __builtin_amdgcn_global_load_lds((const unsigned*)(cp + (size_t)s0 * 8), (unsigned*)cs, 16, 0, 0);
}
__device__ __forceinline__ bf16x8 attn_qbias(float u, int h) {
    const unsigned hi = pk_bf16(u, 0.f) & 0xffffu; const float r1 = u - __uint_as_float(hi << 16);
    const unsigned mid = pk_bf16(r1, 0.f) & 0xffffu; const float r2 = r1 - __uint_as_float(mid << 16);
    const unsigned lo = pk_bf16(r2, 0.f) & 0xffffu;
    u32x4 f; f[0] = hi | (mid << 16); f[1] = lo | (0x3F80u << 16); f[2] = 0x3F803F80u; f[3] = 0u;
    if (h) { f[0] = 0u; f[1] = 0u; f[2] = 0u; }
    return __builtin_bit_cast(bf16x8, f);
}
__device__ void fox_attn_item(const Params& p, int l, int bh, int qt, unsigned char* lds_raw) {
    const int tid = ltid(), lane = tid & 63, w = __builtin_amdgcn_readfirstlane(tid >> 6), r = lane & 31, h = lane >> 5;
    const int b = bh / H_FOX, hh = bh % H_FOX;
    const bf16_t* proj = (const bf16_t*)(p.ws + WS_PROJ);
    const bf16_t* kbase = proj + (size_t)b * SEQ * NPROJ + NC_FK + hh * 64;
    const bf16_t* vbase = (const bf16_t*)(p.ws + WS_VTF) + (size_t)bh * 64 * SEQ;
    const float* cum = (const float*)(p.ws + WS_CUM) + (size_t)bh * SEQ;
    const int qlo = qt * 128 + w * 32, q = qlo + r;
    bf16x8 qf[4];
    {
        const bf16_t* qrow = proj + (size_t)(b * SEQ + q) * NPROJ + NC_FQ + hh * 64;
#pragma unroll
        for (int kk = 0; kk < 4; ++kk) qf[kk] = *(const bf16x8*)(qrow + kk * 16 + h * 8);
    }
    const float cq2 = cum[q] * 1.4426950408889634f;
    float mref = 0.f;
    bf16x8 qx = attn_qbias(cq2 - mref, h);
    f32x16 o0, o1;
#pragma unroll
    for (int i = 0; i < 16; ++i) { o0[i] = 0.f; o1[i] = 0.f; }
    float lsum = 0.f;
    const int ntiles = 2 * qt + 2;
    const bf16_t* kp[2]; const bf16_t* vp[2];
    {
        const int row0 = w * 8 + (lane >> 3), pc = lane & 7;
        const int lc0 = (pc ^ ((row0 >> 1) & 7)) * 8;
        kp[0] = kbase + (size_t)row0 * NPROJ + lc0; kp[1] = kbase + (size_t)(row0 + 32) * NPROJ + lc0;
        vp[0] = vbase + (size_t)row0 * SEQ + lc0;   vp[1] = vbase + (size_t)(row0 + 32) * SEQ + lc0;
    }
    const bf16_t* cp = (const bf16_t*)(p.ws + WS_SCR + SCR_CSX) + (size_t)bh * SEQ * 8 + lane * 8;
    const int swr = (r >> 1) & 7;
    int jw; float zmax_bound;
    {
        float gq = fabsf(p.in[3][l * 64 + lane]), gk = fabsf(p.in[4][l * 64 + lane]);
#pragma unroll
        for (int o = 32; o > 0; o >>= 1) { gq = fmaxf(gq, __shfl_xor(gq, o, 64)); gk = fmaxf(gk, __shfl_xor(gk, o, 64)); }
        const float thr = 2.f * (1.4426950408889634f * 8.f * gq * gk) + 30.f;
        zmax_bound = 1.4426950408889634f * 8.f * gq * gk;
        const float cw = cum[qlo] * 1.4426950408889634f;
        const float ce = (lane < ntiles) ? cum[64 * lane + 63] * 1.4426950408889634f : 0.f;
        const unsigned long long keep = __ballot((lane < ntiles) && (cw - ce >= -thr));
        jw = keep ? (__ffsll((long long)keep) - 1) : (ntiles - 1);
    }
    volatile int* jshare = (volatile int*)(lds_raw + ATT_NSTAGE * ATT_BUF + 16);
    asm volatile("s_waitcnt vmcnt(0)" ::: "memory");
    RAW_BARRIER();
    if (tid == 0) *jshare = jw;
    RAW_BARRIER();
    const int jstart = *jshare;
    const bool no_rescale = (zmax_bound <= 64.f);
    attn_issue(kp, vp, cp, jstart * 64, lds_raw + (jstart % ATT_NSTAGE) * ATT_BUF, w);
    if (jstart + 1 < ntiles) attn_issue(kp, vp, cp, (jstart + 1) * 64, lds_raw + ((jstart + 1) % ATT_NSTAGE) * ATT_BUF, w);
    for (int j = jstart; j < ntiles; ++j) {
        if (j + 1 < ntiles) asm volatile("s_waitcnt vmcnt(5)" ::: "memory"); else asm volatile("s_waitcnt vmcnt(0)" ::: "memory");
        RAW_BARRIER();
        if (j + 2 < ntiles) attn_issue(kp, vp, cp, (j + 2) * 64, lds_raw + ((j + 2) % ATT_NSTAGE) * ATT_BUF, w);
        const int s0 = j * 64;
        if (s0 <= qlo + 31 && j >= jw) {
            const bf16_t* Ks = (const bf16_t*)(lds_raw + (j % ATT_NSTAGE) * ATT_BUF); const bf16_t* Vs = Ks + 4096; const bf16_t* cs = Vs + 4096;
            f32x16 st0, st1;
            {
                u32x4 z4 = {0u, 0u, 0u, 0u};
                u32x4 c0 = *(const u32x4*)(cs + r * 8), c1 = *(const u32x4*)(cs + (32 + r) * 8);
                if (h) { c0 = z4; c1 = z4; }
                f32x16 zz;
#pragma unroll
                for (int i = 0; i < 16; ++i) zz[i] = 0.f;
                st0 = __builtin_amdgcn_mfma_f32_32x32x16_bf16(__builtin_bit_cast(bf16x8, c0), qx, zz, 0, 0, 0);
                st1 = __builtin_amdgcn_mfma_f32_32x32x16_bf16(__builtin_bit_cast(bf16x8, c1), qx, zz, 0, 0, 0);
            }
#pragma unroll
            for (int kk = 0; kk < 4; ++kk) {
                const int co = ((kk * 2 + h) ^ swr) * 8;
                bf16x8 a0 = *(const bf16x8*)(Ks + r * 64 + co);
                bf16x8 a1 = *(const bf16x8*)(Ks + (32 + r) * 64 + co);
                st0 = __builtin_amdgcn_mfma_f32_32x32x16_bf16(a0, qf[kk], st0, 0, 0, 0);
                st1 = __builtin_amdgcn_mfma_f32_32x32x16_bf16(a1, qf[kk], st1, 0, 0, 0);
            }
            if (s0 + 63 > qlo) {
#pragma unroll
                for (int i = 0; i < 16; ++i) {
                    const int key = s0 + (i & 3) + 8 * (i >> 2) + 4 * h;
                    if (key > q) st0[i] = -1e30f;
                    if (key + 32 > q) st1[i] = -1e30f;
                }
            }
            float mx = 0.f;
            if (!no_rescale) {
                mx = fmaxf(st0[0], st1[0]);
#pragma unroll
                for (int i = 1; i < 16; ++i) mx = fmaxf(mx, fmaxf(st0[i], st1[i]));
            }
            if (!no_rescale && __any(mx > ATT_THR)) {
                const float mo = fmaxf(mx, __shfl_xor(mx, 32, 64));
                const float d = (mo > ATT_THR) ? mo : 0.f;
                const float alpha = __builtin_amdgcn_exp2f(-d);
#pragma unroll
                for (int i = 0; i < 16; ++i) { st0[i] -= d; st1[i] -= d; o0[i] *= alpha; o1[i] *= alpha; }
                lsum *= alpha; mref += d;
                qx = attn_qbias(cq2 - mref, h);
            }
            float rs = 0.f;
#pragma unroll
            for (int i = 0; i < 16; ++i) { st0[i] = __builtin_amdgcn_exp2f(st0[i]); st1[i] = __builtin_amdgcn_exp2f(st1[i]); rs += st0[i] + st1[i]; }
            lsum += rs;
            bf16x8 pf[2][2];
#pragma unroll
            for (int s = 0; s < 2; ++s) {
                u32x4 t0 = {pk_bf16(st0[8 * s], st0[8 * s + 1]), pk_bf16(st0[8 * s + 2], st0[8 * s + 3]), pk_bf16(st0[8 * s + 4], st0[8 * s + 5]), pk_bf16(st0[8 * s + 6], st0[8 * s + 7])};
                u32x4 t1 = {pk_bf16(st1[8 * s], st1[8 * s + 1]), pk_bf16(st1[8 * s + 2], st1[8 * s + 3]), pk_bf16(st1[8 * s + 4], st1[8 * s + 5]), pk_bf16(st1[8 * s + 6], st1[8 * s + 7])};
                pf[0][s] = __builtin_bit_cast(bf16x8, t0); pf[1][s] = __builtin_bit_cast(bf16x8, t1);
            }
#pragma unroll
            for (int mt = 0; mt < 2; ++mt)
#pragma unroll
                for (int s = 0; s < 2; ++s) {
                    const int c0 = 4 * mt + 2 * s;
                    const int oA = ((c0 ^ swr) * 8) + 4 * h, oB = (((c0 + 1) ^ swr) * 8) + 4 * h;
                    uint2 a00 = *(const uint2*)(Vs + r * 64 + oA), a01 = *(const uint2*)(Vs + r * 64 + oB);
                    uint2 a10 = *(const uint2*)(Vs + (32 + r) * 64 + oA), a11 = *(const uint2*)(Vs + (32 + r) * 64 + oB);
                    u32x4 u0 = {a00.x, a00.y, a01.x, a01.y}; u32x4 u1 = {a10.x, a10.y, a11.x, a11.y};
                    o0 = __builtin_amdgcn_mfma_f32_32x32x16_bf16(__builtin_bit_cast(bf16x8, u0), pf[mt][s], o0, 0, 0, 0);
                    o1 = __builtin_amdgcn_mfma_f32_32x32x16_bf16(__builtin_bit_cast(bf16x8, u1), pf[mt][s], o1, 0, 0, 0);
                }
        }
    }
    lsum += __shfl_xor(lsum, 32, 64);
    const float inv = 1.f / lsum;
    float ss = 0.f;
#pragma unroll
    for (int i = 0; i < 16; ++i) { o0[i] *= inv; o1[i] *= inv; ss += o0[i] * o0[i] + o1[i] * o1[i]; }
    ss += __shfl_xor(ss, 32, 64);
    const float rstd = rsqrtf(ss * (1.f / 64.f) + 1e-6f);
    const float* og = p.in[6] + l * 64;
    bf16_t* mrow = (bf16_t*)(p.ws + WS_MIX) + pl_off(b * SEQ + q, hh * 64, 1024);
#pragma unroll
    for (int g = 0; g < 4; ++g) {
        const int e0 = 8 * g + 4 * h;
        f32x4 g0 = *(const f32x4*)(og + e0), g1 = *(const f32x4*)(og + 32 + e0);
        store4_bf16(mrow + e0, o0[4 * g] * rstd * g0[0], o0[4 * g + 1] * rstd * g0[1], o0[4 * g + 2] * rstd * g0[2], o0[4 * g + 3] * rstd * g0[3]);
        store4_bf16(mrow + 64 + e0, o1[4 * g] * rstd * g1[0], o1[4 * g + 1] * rstd * g1[1], o1[4 * g + 2] * rstd * g1[2], o1[4 * g + 3] * rstd * g1[3]);
    }
}
#define ATT_ITEMS (BATCH * H_FOX * (SEQ / 128))
#define CONV_ITEMS ((CONV_REST + P0_T_IN + 3) / 4)
__device__ void phase_scan_attn(const Params& p, int l, unsigned char* lds_raw, int rep = 0, int sel = 7) {
    unsigned* qctr = (unsigned*)(p.ws + WS_CTL) + CW_Q + l + 2 * rep;
    volatile int* slot = (volatile int*)(lds_raw + ATT_NSTAGE * ATT_BUF);
    for (;;) {
        __syncthreads();
        if (threadIdx.x == 0) *slot = (int)atomicAdd(qctr, 1u);
        __syncthreads();
        int it = *slot;
        const int ns0 = (MIXSEL & 1) ? BATCH * H_GDN * 4 : 0, ns1 = ns0 + ((MIXSEL & 2) ? 128 : 0);
        if (it >= ns1 + ATT_ITEMS + CONV_ITEMS) break;
        if (it >= ns1) {
            const int c = it - ns1;
            int conv_idx = -1;
            if (c < 5 * ATT_ITEMS) { if (c % 5 != 0) conv_idx = c - c / 5 - 1; } else conv_idx = c - ATT_ITEMS;
            if (conv_idx >= 0) {
                if (rep == 0 && conv_idx < CONV_ITEMS) conv_fold4(p, l, conv_idx * 4, ltid());
                continue;
            }
            it = ns1 + c / 5;
        }
        if (it < ns0) { if (sel & 1) gdn_scan_item(p, it, lds_raw, rep ? SVAR : 0); continue; }
        if (it < ns1) { if (sel & 2) gla_scan_item(p, it - ns0); continue; }
        it -= ns1;
        if (!(sel & 4)) continue;
        const int qt = (SEQ / 128 - 1) - it / (BATCH * H_FOX), bh = it % (BATCH * H_FOX);
        fox_attn_item(p, l, bh, qt, lds_raw);
    }
}

#define NPHASE 19
__global__ void __launch_bounds__(256, 2) mk(Params p, int lo, int hi, int use_bar) {
    __shared__ __attribute__((aligned(16))) unsigned char lds_raw[LDS_BYTES];
    bf16_t* lds = (bf16_t*)lds_raw;
    volatile LAS unsigned* st = (volatile LAS unsigned*)(lds_raw + LDS_BYTES - 16);
    XcdBarrier bar; bar.bar = (unsigned*)(p.ws + WS_CTL) + CW_BAR; bar.x = 0; bar.st = st;
    if (use_bar) {
        if (threadIdx.x == 0) { st[0] = 0u; st[1] = 0u; }
        __syncthreads();
        bar = xcd_barrier_post((unsigned*)(p.ws + WS_CTL) + CW_BAR, st);
    }
    for (int ph = lo; ph < hi; ++ph) {
#ifndef PSEL
#define PSEL 0xffff
#endif
        int phv = ph; asm volatile("" : "+s"(phv));
        size_t zoff = 0; asm volatile("" : "+s"(zoff));
        Params q = p; q.ws = p.ws + zoff; q.out = p.out + zoff;
        if (phv == 0) { if (PSEL & 1) phase0(q); }
        else {
            int l = (phv - 1) / 9, s = (phv - 1) % 9;
            if (s == 0) { if (PSEL & 2) phase_inproj(q, l, lds); }
            else if (s == 1) { if (PSEL & 128) phase_prep(q, l, lds_raw); }
            else if (s == 2) { if (PSEL & 256) phase_scan_attn(q, l, lds_raw); }
            else if (s == 3) { if (PSEL & 512) phase_mixout(q, l); }
            else if (s == 4) { if (PSEL & 4) phase_outproj(q, l, lds); }
            else if (s == 5) { if (PSEL & 8) phase_route(q, l, lds); }
            else if (s == 6) { if (PSEL & 16) phase_expert<0>(q, l, lds); }
            else if (s == 7) { if (PSEL & 32) phase_expert<1>(q, l, lds); }
            else if (s == 8) { if (PSEL & 64) phase_combine(q, l); }
        }
#ifdef REPEAT_MASK
        {
            const int ty = (phv == 0) ? 9 : (phv - 1) % 9, l = (phv == 0) ? 0 : (phv - 1) / 9;
            const bool idem = !((ty == 4 && l == 1));
            if (((REPEAT_MASK >> ty) & 1) && idem && use_bar) {
                xcd_barrier(bar);
                if (ty == 9) phase0(q);
                else if (ty == 0) phase_inproj(q, l, lds, GVAR);
                else if (ty == 1) phase_prep(q, l, lds_raw);
                else if (ty == 2) phase_scan_attn(q, l, lds_raw, 1, P3SEL);
                else if (ty == 3) phase_mixout(q, l);
                else if (ty == 4) phase_outproj(q, l, lds);
                else if (ty == 5) phase_route(q, l, lds, 1);
                else if (ty == 8) phase_combine(q, l, 1);
                else if (ty == 6) phase_expert<0>(q, l, lds);
                else if (ty == 7) phase_expert<1>(q, l, lds);
            }
        }
#endif
        if (ph + 1 < hi) {
            if (hi > 1000) cg::this_grid().sync();
            xcd_barrier(bar);
        }
    }
}

extern "C" void kernel_launch(void* const* d_in, const int* in_sizes, int n_in,
                              void* d_out, int out_size, void* d_ws, size_t ws_size,
                              hipStream_t stream) {
    static int grid = 0;
    if (grid == 0) {
        if (ws_size < WS_END) { fprintf(stderr, "ws too small: need %zu have %zu\n", (size_t)WS_END, ws_size); grid = -1; return; }
        int dev = 0, cus = 0, per_cu = 0;
        hipGetDevice(&dev);
        hipDeviceGetAttribute(&cus, hipDeviceAttributeMultiprocessorCount, dev);
        hipOccupancyMaxActiveBlocksPerMultiprocessor(&per_cu, mk, 256, 0);
        if (per_cu > 2) per_cu = 2;
        if (per_cu < 1) { fprintf(stderr, "occupancy query failed\n"); grid = -1; return; }
        grid = cus * per_cu;
        grid -= grid % 8;
    }
    if (grid < 0) return;
    Params p{};
    for (int i = 0; i < 23; ++i) p.in[i] = (const float*)d_in[i];
    p.out = (float*)d_out; p.ws = (char*)d_ws;
    hipMemsetAsync((char*)d_ws + WS_CTL, 0, CTL_BYTES, stream);
#ifdef POISON_GLA
    hipMemsetAsync((char*)d_ws + WS_SCR + SCR_GLA_OL, 0xFF, SCR_LVT - SCR_GLA_OL, stream);
#endif

#ifdef MULTI_LAUNCH
    for (int ph = 0; ph < NPHASE; ++ph) mk<<<grid, 256, 0, stream>>>(p, ph, ph + 1, 0);
#else
    int lo = 0, hi = NPHASE, ub = 2;
    void* args[] = {&p, &lo, &hi, &ub};
    hipError_t e = hipLaunchCooperativeKernel((void*)mk, dim3(grid), dim3(256), args, 0, stream);
    if (e != hipSuccess) fprintf(stderr, "cooperative launch failed: %s (grid %d)\n", hipGetErrorString(e), grid);
#endif
}
```

```cpp
#include <hip/hip_runtime.h>
#include <hip/hip_cooperative_groups.h>
#include <cstdint>
#include <cstdio>
namespace cg = cooperative_groups;

#define D_MODEL 1024
#define BATCH 4
#define SEQ 4096
#define NTOK (BATCH * SEQ)
#define H_FOX 6
#define H_GDN 6
#define H_GLA 4
#define N_IN 3490
#define N_EXP 32
#define D_EXP 512
#define NPROJ 3456
#define NINP 3584

#define C_FF 1152
#define C_GQ 1158
#define C_GG 2310
#define C_GA 2694
#define C_GB 2700
#define C_LQ 2706
#define C_LA 3474
#define NC_FQ 0
#define NC_FK 384
#define NC_FV 768
#define NC_GQ 1152
#define NC_GK 1536
#define NC_GV 1920
#define NC_GG 2304
#define NC_LQ 2688
#define NC_LK 2816
#define NC_LV 2944
#define NC_LR 3200
#define AX_FF 0
#define AX_GA 6
#define AX_GB 12
#define AX_LA 18

#ifndef SVAR
#define SVAR 0
#endif
#ifndef P3SEL
#define P3SEL 7
#endif
#ifndef GVAR
#define GVAR 0
#endif
#ifndef MIXSEL
#define MIXSEL 3
#endif
typedef unsigned short bf16_t;
typedef short bf16x8 __attribute__((ext_vector_type(8)));
typedef float f32x4 __attribute__((ext_vector_type(4)));
typedef unsigned u32x4 __attribute__((ext_vector_type(4)));
typedef unsigned u32x2 __attribute__((ext_vector_type(2)));

#define WS_CTL      0
#define CTL_BYTES   262144
#define WS_WIN      (WS_CTL + CTL_BYTES)
#define WS_WOUT     (WS_WIN + (size_t)2 * NINP * 1024 * 2)
#define WS_WGU      (WS_WOUT + (size_t)2 * 1024 * 1024 * 2)
#define WS_WD       (WS_WGU + (size_t)2 * 32 * 1024 * 1024 * 2)
#define WS_WR       (WS_WD + (size_t)2 * 32 * 1024 * 512 * 2)
#define WS_HN       (WS_WR + (size_t)2 * 64 * 1024 * 2)
#define WS_PROJ     (WS_HN + (size_t)NTOK * 1024 * 2)
#define WS_VTF      (WS_PROJ + (size_t)NTOK * NPROJ * 2)
#define WS_AUX      (WS_VTF + (size_t)BATCH * H_FOX * 64 * SEQ * 2)
#define WS_CUM      (WS_AUX + (size_t)NTOK * 64 * 4)
#define WS_MIX      (WS_CUM + (size_t)BATCH * H_FOX * SEQ * 4)
#define WS_ROWTOK   (WS_MIX + (size_t)NTOK * 1024 * 2)
#define WS_TSLOT    (WS_ROWTOK + (size_t)32 * NTOK * 4)
#define WS_TGATE    (WS_TSLOT + (size_t)NTOK * 2 * 4)
#define WS_SCR      (WS_TGATE + (size_t)NTOK * 2 * 4)
#define SCR_BYTES   ((size_t)100 * 1024 * 1024)
#define WS_END      (WS_SCR + SCR_BYTES)
#define HROWS       (2 * NTOK + 32 * 128)
#define WS_H        WS_PROJ
#define WS_Y        (WS_PROJ + (size_t)HROWS * 512 * 2)

#define NGDN_CH 1536
#define NGLA_CH 1024
#define SCR_GDN_MP   ((size_t)0)
#define SCR_GDN_NN   (SCR_GDN_MP + (size_t)NGDN_CH * 8192)
#define SCR_GDN_P    (SCR_GDN_NN + (size_t)NGDN_CH * 8192)
#define SCR_GDN_OL   (SCR_GDN_P  + (size_t)NGDN_CH * 8192)
#define SCR_GDN_SG   (SCR_GDN_OL + (size_t)NGDN_CH * 8192)
#define SCR_GDN_LAST (SCR_GDN_SG + (size_t)NGDN_CH * 8192)
#define SCR_GLA_OL   (SCR_GDN_LAST + (size_t)NGDN_CH * 4)
#define SCR_GLA_KV   (SCR_GLA_OL + (size_t)NGLA_CH * 8192)
#define SCR_GLA_QB   (SCR_GLA_KV + (size_t)NGLA_CH * 8192)
#define SCR_GLA_SG   (SCR_GLA_QB + (size_t)NGLA_CH * 4096)
#define SCR_GLA_DL   (SCR_GLA_SG + (size_t)NGLA_CH * 4096)
#define SCR_LVT      (SCR_GLA_DL + (size_t)NGLA_CH * 128)
#define SCR_USED     (SCR_LVT + (size_t)BATCH * H_GLA * 64 * SEQ * 2)
#define SCR_XB       ((size_t)0)
#define SCR_CSX      SCR_USED
static_assert(SCR_CSX + (size_t)BATCH * H_FOX * SEQ * 16 <= SCR_BYTES, "scratch overflow");
#define CW_BAR      0
#define CW_CNT      4096
#define CNT_STRIDE  64
#define NSH         8
#define SHCAP       2048
#define CW_Q        (CW_CNT + 2 * 32 * NSH * CNT_STRIDE + 64)
#define CW_MOETAB   (CW_Q + 256)

struct Params {
    const float* in[23];
    float* out;
    char* ws;
};

__device__ __forceinline__ float sigmoidf_(float x) { return __builtin_amdgcn_rcpf(1.f + __expf(-x)); }
__device__ __forceinline__ float siluf_(float x) { return x * __builtin_amdgcn_rcpf(1.f + __expf(-x)); }
__device__ __forceinline__ float softplusf_(float x) { return x > 20.f ? x : __logf(1.f + __expf(x)); }
__device__ __forceinline__ float logsigmoidf_(float x) { return -softplusf_(-x); }
__device__ __forceinline__ float wave_sum(float v) {
#pragma unroll
    for (int o = 32; o > 0; o >>= 1) v += __shfl_xor(v, o, 64);
    return v;
}
__device__ __forceinline__ int ltid() { int t = threadIdx.x; asm volatile("" : "+v"(t)); return t; }
typedef __bf16 bf16x2_t __attribute__((ext_vector_type(2)));
typedef float f32x2_t __attribute__((ext_vector_type(2)));
__device__ __forceinline__ unsigned pk_bf16(float lo, float hi) { f32x2_t v = {lo, hi}; bf16x2_t r = __builtin_convertvector(v, bf16x2_t); return __builtin_bit_cast(unsigned, r); }
__device__ __forceinline__ size_t pl_off(int row, int k, int K) { return (size_t)(row >> 1) * (size_t)(2 * K) + (size_t)((k >> 5) * 64 + (row & 1) * 32 + (k & 31)); }
__device__ __forceinline__ unsigned ld_u32_agent(const unsigned* p) { return __hip_atomic_load(p, __ATOMIC_RELAXED, __HIP_MEMORY_SCOPE_AGENT); }
__device__ __forceinline__ float ld_f32_agent(const float* p) { return __uint_as_float(__hip_atomic_load((const unsigned*)p, __ATOMIC_RELAXED, __HIP_MEMORY_SCOPE_AGENT)); }
__device__ __forceinline__ float bf2f(bf16_t v) { return __uint_as_float((unsigned)v << 16); }
__device__ __forceinline__ float bflo(unsigned v) { return __uint_as_float(v << 16); }
__device__ __forceinline__ float bfhi(unsigned v) { return __uint_as_float(v & 0xffff0000u); }

#define XB_TMO      128
#define XB_XCNT(j)  (256  + 64 * (j))
#define XB_XSUB(j)  (1280 + 64 * (j))
#define XB_XGEN(j)  (2304 + 64 * (j))
#define XB_TOP      3328
#define XB_TOPGEN   3392
#define XCD_BAR_WORDS 3456
#define XB_SPIN_CAP (1u << 22)
#define LAS __attribute__((address_space(3)))
__device__ __forceinline__ unsigned xb_ld(unsigned* p)              { return __hip_atomic_load(p, __ATOMIC_RELAXED, __HIP_MEMORY_SCOPE_AGENT); }
__device__ __forceinline__ unsigned xb_add(unsigned* p, unsigned v) { return __hip_atomic_fetch_add(p, v, __ATOMIC_RELAXED, __HIP_MEMORY_SCOPE_AGENT); }
__device__ __forceinline__ unsigned xb_xcc_id() { return (unsigned)__builtin_amdgcn_s_getreg((3 << 11) | 20) & 0xFu; }
#define XB_SPIN(cond, bar) do { unsigned _sp = 0; while (cond) { if (_sp < 16u) __builtin_amdgcn_s_sleep(2); else __builtin_amdgcn_s_sleep(20);     \
    if ((++_sp & 255u) == 0u) { if (xb_ld(&(bar)[XB_TMO])) break; if (_sp > XB_SPIN_CAP) { atomicAdd(&(bar)[XB_TMO], 1u); break; } } } } while (0)
struct XcdBarrier { unsigned* bar; unsigned x; volatile LAS unsigned* st; };
__device__ __forceinline__ XcdBarrier xcd_barrier_post(unsigned* bar, volatile LAS unsigned* st) {
    XcdBarrier b; b.bar = bar; b.x = xb_xcc_id(); b.st = st;
    if (threadIdx.x == 0) (void)xb_add(&bar[XB_XCNT(b.x)], 1u);
    return b;
}
__device__ __forceinline__ void xcd_barrier_complete(unsigned* bar, unsigned x, unsigned& nloc, unsigned& nx) {
    const unsigned G = gridDim.x * gridDim.y * gridDim.z;
    unsigned sum, cnt, mine, sp = 0u;
    for (;;) {
        sum = 0u; cnt = 0u; mine = 0u;
#pragma unroll
        for (unsigned j = 0; j < 16; ++j) { const unsigned c = xb_ld(&bar[XB_XCNT(j)]); sum += c; cnt += (c > 0u) ? 1u : 0u; mine = (j == x) ? c : mine; }
        if (sum == G) break;
        __builtin_amdgcn_s_sleep(1);
        if ((++sp & 255u) == 0u) { if (xb_ld(&bar[XB_TMO])) break; if (sp > XB_SPIN_CAP) { atomicAdd(&bar[XB_TMO], 1u); break; } }
    }
    nloc = mine > 0u ? mine : 1u; nx = cnt > 0u ? cnt : 1u;
}
__device__ __forceinline__ void xcd_barrier(const XcdBarrier& b) {
    asm volatile("s_waitcnt vmcnt(0)" ::: "memory");
    __syncthreads();
    if (threadIdx.x == 0) {
        unsigned* bar = b.bar;
        __builtin_amdgcn_s_waitcnt(0);
        unsigned nloc = b.st[0], nx = b.st[1];
        if (nloc == 0u) { xcd_barrier_complete(bar, b.x, nloc, nx); b.st[0] = nloc; b.st[1] = nx; }
        const unsigned old = xb_add(&bar[XB_XSUB(b.x)], 1u);
        const unsigned gen = old / nloc;
        if (old + 1u == (gen + 1u) * nloc) {
            __builtin_amdgcn_fence(__ATOMIC_RELEASE, "agent");
            asm volatile("s_waitcnt vmcnt(0)" ::: "memory");
            const unsigned og = xb_add(&bar[XB_TOP], 1u);
            const unsigned tg = og / nx;
            if (og + 1u == (tg + 1u) * nx) xb_add(&bar[XB_TOPGEN], 1u);
            else XB_SPIN(xb_ld(&bar[XB_TOPGEN]) == tg, bar);
            __builtin_amdgcn_fence(__ATOMIC_ACQUIRE, "agent");
            xb_add(&bar[XB_XGEN(b.x)], 1u);
            asm volatile("s_waitcnt vmcnt(0)" ::: "memory");
        } else {
            XB_SPIN(xb_ld(&bar[XB_XGEN(b.x)]) == gen, bar);
            __builtin_amdgcn_fence(__ATOMIC_ACQUIRE, "agent");
            asm volatile("s_waitcnt vmcnt(0)" ::: "memory");
        }
    }
    __syncthreads();
}

#define LDS_BYTES 68096
#define LROW 72

__device__ __forceinline__ int inproj_map(int n) {
    if (n < 1152) return n;
    if (n < 2304) return C_GQ + (n - 1152);
    if (n < 2688) return C_GG + (n - 2304);
    if (n < 3456) return C_LQ + (n - 2688);
    if (n < 3462) return C_FF + (n - 3456);
    if (n < 3468) return C_GA + (n - 3462);
    if (n < 3474) return C_GB + (n - 3468);
    if (n < 3490) return n;
    return -1;
}
#define P0_T_IN   (56 * 16)
#define P0_T_OUT  (16 * 16)
#define P0_T_GU   (32 * 16 * 16)
#define P0_T_D    (32 * 16 * 8)
#define P0_T_R    (16)
#define P0_T_LAYER (P0_T_IN + P0_T_OUT + P0_T_GU + P0_T_D + P0_T_R)
#define P0_T_NORM (NTOK / 4)
struct ConvDesc { const float* src; bf16_t* dst; int ld; int col; };
__device__ __forceinline__ ConvDesc conv_desc(const Params& p, int l, int j, int tid) {
    const int nl = tid & 63, kg = tid >> 6;
    ConvDesc d;
    if (j < P0_T_IN) {
        int tn = j / 16, tk = j % 16; int n = tn * 64 + nl; int k0 = tk * 64 + kg * 16;
        d.ld = N_IN; d.col = inproj_map(n); d.src = p.in[2] + (size_t)l * 1024 * N_IN + (size_t)k0 * N_IN;
        d.dst = (bf16_t*)(p.ws + WS_WIN) + (size_t)l * NINP * 1024 + pl_off(n, k0, 1024);
        return d;
    }
    j -= P0_T_IN;
    if (j < P0_T_OUT) {
        int tn = j / 16, tk = j % 16; int n = tn * 64 + nl; int k0 = tk * 64 + kg * 16;
        d.ld = 1024; d.col = n; d.src = p.in[14] + (size_t)l * 1024 * 1024 + (size_t)k0 * 1024;
        d.dst = (bf16_t*)(p.ws + WS_WOUT) + (size_t)l * 1024 * 1024 + pl_off(n, k0, 1024);
        return d;
    }
    j -= P0_T_OUT;
    if (j < P0_T_GU) {
        int e = j / 256, r = j % 256; int tn = r / 16, tk = r % 16; int n = tn * 64 + nl; int k0 = tk * 64 + kg * 16;
        int t128 = n >> 7, wx = (n >> 6) & 1, half = (n >> 5) & 1, jj = n & 31;
        d.ld = 512; d.col = t128 * 64 + wx * 32 + jj;
        d.src = (half ? p.in[21] : p.in[20]) + ((size_t)l * 32 + e) * 1024 * 512 + (size_t)k0 * 512;
        d.dst = (bf16_t*)(p.ws + WS_WGU) + ((size_t)l * 32 + e) * 1024 * 1024 + pl_off(n, k0, 1024);
        return d;
    }
    j -= P0_T_GU;
    if (j < P0_T_D) {
        int e = j / 128, r = j % 128; int tn = r / 8, tk = r % 8; int n = tn * 64 + nl; int k0 = tk * 64 + kg * 16;
        d.ld = 1024; d.col = n; d.src = p.in[22] + ((size_t)l * 32 + e) * 512 * 1024 + (size_t)k0 * 1024;
        d.dst = (bf16_t*)(p.ws + WS_WD) + ((size_t)l * 32 + e) * 1024 * 512 + pl_off(n, k0, 512);
        return d;
    }
    j -= P0_T_D;
    {
        int tk = j; int n = nl; int k0 = tk * 64 + kg * 16;
        if (n < 4) { d.src = p.in[16] + (size_t)l * 1024 * 4 + (size_t)k0 * 4; d.ld = 4; d.col = n; }
        else if (n < 36) { d.src = p.in[18] + (size_t)l * 1024 * 32 + (size_t)k0 * 32; d.ld = 32; d.col = n - 4; }
        else { d.src = p.in[16]; d.ld = 4; d.col = -1; }
        d.dst = (bf16_t*)(p.ws + WS_WR) + ((size_t)l * 64 + n) * 1024 + k0;
        return d;
    }
}
__device__ __forceinline__ void conv_load(const ConvDesc& d, float (&v)[16]) {
    if (d.col >= 0) {
#pragma unroll
        for (int i = 0; i < 16; ++i) v[i] = d.src[(size_t)i * d.ld + d.col];
    } else {
#pragma unroll
        for (int i = 0; i < 16; ++i) v[i] = 0.f;
    }
}
__device__ __forceinline__ void conv_store(const ConvDesc& d, const float (&v)[16]) {
    uint4 o0, o1;
    o0.x = pk_bf16(v[0], v[1]); o0.y = pk_bf16(v[2], v[3]); o0.z = pk_bf16(v[4], v[5]); o0.w = pk_bf16(v[6], v[7]);
    o1.x = pk_bf16(v[8], v[9]); o1.y = pk_bf16(v[10], v[11]); o1.z = pk_bf16(v[12], v[13]); o1.w = pk_bf16(v[14], v[15]);
    *(uint4*)(d.dst) = o0;
    *(uint4*)(d.dst + 8) = o1;
}
__device__ __forceinline__ void conv_job(const Params& p, int l, int j, int tid) {
    ConvDesc d = conv_desc(p, l, j, tid); float v[16]; conv_load(d, v); conv_store(d, v);
}
#define CONV_REST (P0_T_LAYER - P0_T_IN)
__device__ __forceinline__ bool conv_fold_desc(const Params& p, int l, int idx, int tid, ConvDesc& d) {
    if (idx < CONV_REST) { d = conv_desc(p, l, P0_T_IN + idx, tid); return true; }
    if (l == 0 && idx < CONV_REST + P0_T_IN) { d = conv_desc(p, 1, idx - CONV_REST, tid); return true; }
    return false;
}
__device__ __forceinline__ void conv_fold4(const Params& p, int l, int idx0, int tid) {
    ConvDesc d0, d1, d2, d3; float v0[16], v1[16], v2[16], v3[16];
    const bool b0 = conv_fold_desc(p, l, idx0, tid, d0), b1 = conv_fold_desc(p, l, idx0 + 1, tid, d1), b2 = conv_fold_desc(p, l, idx0 + 2, tid, d2), b3 = conv_fold_desc(p, l, idx0 + 3, tid, d3);
    if (b0) conv_load(d0, v0); if (b1) conv_load(d1, v1); if (b2) conv_load(d2, v2); if (b3) conv_load(d3, v3);
    if (b0) conv_store(d0, v0); if (b1) conv_store(d1, v1); if (b2) conv_store(d2, v2); if (b3) conv_store(d3, v3);
}
__device__ void phase0(const Params& p) {
    const int tid = ltid(), nl = tid & 63, kg = tid >> 6;
    const int total = P0_T_IN + P0_T_NORM;
    for (int it = blockIdx.x; it < total; it += gridDim.x) {
        if (it >= P0_T_IN) {
            int row = (it - P0_T_IN) * 4 + kg;
            const float* xr = p.in[0] + (size_t)row * D_MODEL + nl * 16;
            const float* gr = p.in[1] + nl * 16;
            float v[16]; float ss = 0.f;
#pragma unroll
            for (int i = 0; i < 4; ++i) { float4 t = *(const float4*)(xr + 4 * i); v[4 * i] = t.x; v[4 * i + 1] = t.y; v[4 * i + 2] = t.z; v[4 * i + 3] = t.w; }
#pragma unroll
            for (int i = 0; i < 16; ++i) ss += v[i] * v[i];
            ss = wave_sum(ss);
            float r = rsqrtf(ss / D_MODEL + 1e-6f);
#pragma unroll
            for (int i = 0; i < 16; ++i) v[i] = v[i] * r * gr[i];
            uint4 o0, o1;
            o0.x = pk_bf16(v[0], v[1]); o0.y = pk_bf16(v[2], v[3]); o0.z = pk_bf16(v[4], v[5]); o0.w = pk_bf16(v[6], v[7]);
            o1.x = pk_bf16(v[8], v[9]); o1.y = pk_bf16(v[10], v[11]); o1.z = pk_bf16(v[12], v[13]); o1.w = pk_bf16(v[14], v[15]);
            bf16_t* hr = (bf16_t*)(p.ws + WS_HN) + pl_off(row, nl * 16, 1024);
            *(uint4*)hr = o0; *(uint4*)(hr + 8) = o1;
            continue;
        }
        conv_job(p, 0, it, tid);
    }
}

#define GSTAGE 8192
#define RAW_BARRIER() do { asm volatile("s_waitcnt lgkmcnt(0)" ::: "memory"); __builtin_amdgcn_s_barrier(); } while (0)
__device__ __forceinline__ int gswz(int row) { return (0x1320 >> (((row >> 2) & 3) * 4)) & 3; }
__device__ __forceinline__ void gemm_issue(const bf16_t* const (&px)[2], const bf16_t* const (&py)[2], int k0, bf16_t* stage, int w) {
    __builtin_amdgcn_global_load_lds((const unsigned*)(px[0] + 2 * k0), (unsigned*)(stage + (w * 16) * 32), 16, 0, 0);
    __builtin_amdgcn_global_load_lds((const unsigned*)(px[1] + 2 * k0), (unsigned*)(stage + (64 + w * 16) * 32), 16, 0, 0);
    __builtin_amdgcn_global_load_lds((const unsigned*)(py[0] + 2 * k0), (unsigned*)(stage + 4096 + (w * 16) * 32), 16, 0, 0);
    __builtin_amdgcn_global_load_lds((const unsigned*)(py[1] + 2 * k0), (unsigned*)(stage + 4096 + (64 + w * 16) * 32), 16, 0, 0);
}
__device__ __forceinline__ void gemm_compute(const bf16_t* stage, int wx, int wy, int fr, int fg, f32x4 (&acc)[4][4]) {
    const int co = (fg ^ gswz(fr)) * 8;
    bf16x8 xa[4], yb[4];
#pragma unroll
    for (int m = 0; m < 4; ++m) xa[m] = *(const bf16x8*)(stage + (wx * 64 + m * 16 + fr) * 32 + co);
#pragma unroll
    for (int n = 0; n < 4; ++n) yb[n] = *(const bf16x8*)(stage + 4096 + (wy * 64 + n * 16 + fr) * 32 + co);
    __builtin_amdgcn_s_setprio(1);
#pragma unroll
    for (int m = 0; m < 4; ++m)
#pragma unroll
        for (int n = 0; n < 4; ++n) acc[m][n] = __builtin_amdgcn_mfma_f32_16x16x32_bf16(xa[m], yb[n], acc[m][n], 0, 0, 0);
    __builtin_amdgcn_s_setprio(0);
}
template <class FX, class FY>
__device__ __forceinline__ void gemm_core(FX rowx, FY rowy, int K, bf16_t* lds, f32x4 (&acc)[4][4], int gvar = 0) {
    const int tid = ltid(), lane = tid & 63, w = __builtin_amdgcn_readfirstlane(tid >> 6), wx = w >> 1, wy = w & 1, fr = lane & 15, fg = lane >> 4;
#pragma unroll
    for (int a = 0; a < 4; ++a)
#pragma unroll
        for (int b = 0; b < 4; ++b) acc[a][b] = (f32x4){0.f, 0.f, 0.f, 0.f};
    const bf16_t* px[2]; const bf16_t* py[2];
    {
        const int r0 = w * 16 + (lane >> 2), pc = lane & 3;
        const int lc0 = (pc ^ gswz(r0)) * 8;
        px[0] = rowx(r0) + lc0; px[1] = rowx(r0 + 64) + lc0;
        py[0] = rowy(r0) + lc0; py[1] = rowy(r0 + 64) + lc0;
    }
    const int nt = K >> 5;
    RAW_BARRIER();
    if (gvar != 3) {
    gemm_issue(px, py, 0, lds, w);
    gemm_issue(px, py, 32, lds + GSTAGE, w);
    gemm_issue(px, py, 64, lds + 2 * GSTAGE, w);
    }
    for (int j = 0; j < nt; ++j) {
        if (j + 2 < nt) asm volatile("s_waitcnt vmcnt(8)" ::: "memory");
        else if (j + 1 < nt) asm volatile("s_waitcnt vmcnt(4)" ::: "memory");
        else asm volatile("s_waitcnt vmcnt(0)" ::: "memory");
        RAW_BARRIER();
        if (j + 3 < nt && gvar != 3) gemm_issue(px, py, (j + 3) * 32, lds + ((j + 3) & 3) * GSTAGE, w);
        if (gvar != 2) gemm_compute(lds + (j & 3) * GSTAGE, wx, wy, fr, fg, acc);
    }
}
__device__ __forceinline__ void store4_bf16(bf16_t* p, float a, float b, float c, float d) {
    uint2 o; o.x = pk_bf16(a, b); o.y = pk_bf16(c, d); *(uint2*)p = o;
}
template <int NC> __device__ __forceinline__ void ep_put(bf16_t* T, int row, int col, float a, float b, float c, float d) {
    uint2 o; o.x = pk_bf16(a, b); o.y = pk_bf16(c, d); *(uint2*)(T + row * (NC + 8) + col) = o;
}
template <int NC, class FD> __device__ __forceinline__ void ep_flush(const bf16_t* T, int tid, FD dst) {
    constexpr int CPR = NC / 8;
#pragma unroll
    for (int i = 0; i < NC / 16; ++i) {
        const int c = tid + 256 * i; const int row = c / CPR, ch = c % CPR;
        *(u32x4*)(dst(row, ch)) = *(const u32x4*)(T + row * (NC + 8) + ch * 8);
    }
}

__device__ __forceinline__ bool xcd_item(int round, int ntm, int ntn, int& tm, int& tn) {
    const int x = blockIdx.x & 7, loc = blockIdx.x >> 3, nloc = gridDim.x >> 3;
    const int tmx = ntm >> 3;
    const int j = round * nloc + loc;
    if (j >= tmx * ntn) return false;
    tn = j / tmx; tm = (j % tmx) * 8 + x;
    return true;
}

__device__ void phase_inproj(const Params& p, int l, bf16_t* lds, int gvar = 0) {
    const int tid = ltid(), lane = tid & 63, w = tid >> 6, wx = w >> 1, wy = w & 1, fr = lane & 15, fg = lane >> 4;
    const bf16_t* hn = (const bf16_t*)(p.ws + WS_HN);
    const bf16_t* wt = (const bf16_t*)(p.ws + WS_WIN) + (size_t)l * NINP * 1024;
    bf16_t* proj = (bf16_t*)(p.ws + WS_PROJ);
    bf16_t* vtf = (bf16_t*)(p.ws + WS_VTF);
    float* aux = (float*)(p.ws + WS_AUX);
    const float* qg = p.in[3] + l * 64; const float* kg = p.in[4] + l * 64;
    for (int round = 0;; ++round) {
        int tm, tn;
        if (gridDim.x == 512) {
            if (round >= 7) break;
            const int x = blockIdx.x & 7, loc = blockIdx.x >> 3; int tml;
            if (round < 6) { tn = (round >> 1) * 8 + (loc & 7); tml = (round & 1) * 8 + (loc >> 3); }
            else { tn = 24 + (loc & 3); tml = loc >> 2; }
            tm = tml * 8 + x;
        } else if (!xcd_item(round, NTOK / 128, NINP / 128, tm, tn)) break;
        const bool vt = (tn >= 6 && tn < 9) || tn == 23 || tn == 24;
        f32x4 acc[4][4];
        {
            auto rw = [&](int r) { return wt + pl_off(tn * 128 + r, 0, 1024); };
            auto rt_ = [&](int r) { return hn + pl_off(tm * 128 + r, 0, 1024); };
            if (vt) gemm_core(rt_, rw, 1024, lds, acc, gvar); else gemm_core(rw, rt_, 1024, lds, acc, gvar);
        }
        if (gvar != 0 && acc[0][0][0] != 123456.789f) continue;
        if (tn == 27) {
#pragma unroll
            for (int n = 0; n < 4; ++n) {
                int t = tm * 128 + wy * 64 + n * 16 + fr;
#pragma unroll
                for (int m = 0; m < 4; ++m) {
                    int c = wx * 64 + m * 16 + 4 * fg;
                    if (c < 64) *(float4*)(aux + (size_t)t * 64 + c) = make_float4(acc[m][n][0], acc[m][n][1], acc[m][n][2], acc[m][n][3]);
                }
            }
            continue;
        }
        RAW_BARRIER();
        if (vt) {
#pragma unroll
            for (int n = 0; n < 4; ++n)
#pragma unroll
                for (int m = 0; m < 4; ++m) ep_put<128>(lds, wy * 64 + n * 16 + fr, wx * 64 + m * 16 + 4 * fg, acc[m][n][0], acc[m][n][1], acc[m][n][2], acc[m][n][3]);
            RAW_BARRIER();
            const bool fox = tn < 9;
            bf16_t* dstb = fox ? vtf : (bf16_t*)(p.ws + WS_SCR + SCR_LVT); const int nh = fox ? H_FOX : H_GLA;
            const int t0 = tm * 128, b = t0 / SEQ, s0 = t0 % SEQ, chb = tn * 128 - (fox ? NC_FV : NC_LV);
            ep_flush<128>(lds, tid, [&](int row, int c8) { const int ch = chb + row; return dstb + ((size_t)(b * nh + (ch >> 6)) * 64 + (ch & 63)) * SEQ + s0 + c8 * 8; });
        } else {
            if (tn < 6) {
                const float* gn = (tn < 3) ? qg : kg; const float sc = (tn < 3) ? 0.125f * 1.4426950408889634f : 1.f;
                float g[4][4];
#pragma unroll
                for (int m = 0; m < 4; ++m)
#pragma unroll
                    for (int r = 0; r < 4; ++r) g[m][r] = gn[m * 16 + 4 * fg + r] * sc;
#pragma unroll
                for (int n = 0; n < 4; ++n) {
                    float ss = 0.f;
#pragma unroll
                    for (int m = 0; m < 4; ++m)
#pragma unroll
                        for (int r = 0; r < 4; ++r) ss += acc[m][n][r] * acc[m][n][r];
                    ss += __shfl_xor(ss, 16, 64); ss += __shfl_xor(ss, 32, 64);
                    float rs = rsqrtf(ss * (1.f / 64.f) + 1e-6f);
#pragma unroll
                    for (int m = 0; m < 4; ++m)
                        ep_put<128>(lds, wy * 64 + n * 16 + fr, wx * 64 + m * 16 + 4 * fg, acc[m][n][0] * rs * g[m][0], acc[m][n][1] * rs * g[m][1], acc[m][n][2] * rs * g[m][2], acc[m][n][3] * rs * g[m][3]);
                }
            } else {
                const bool do_silu = (tn >= 18 && tn < 21) || (tn >= 25);
                const float sc = (tn == 21) ? 0.17677669529663687f : 1.f;
#pragma unroll
                for (int n = 0; n < 4; ++n)
#pragma unroll
                    for (int m = 0; m < 4; ++m) {
                        float v0 = acc[m][n][0] * sc, v1 = acc[m][n][1] * sc, v2 = acc[m][n][2] * sc, v3 = acc[m][n][3] * sc;
                        if (do_silu) { v0 = siluf_(v0); v1 = siluf_(v1); v2 = siluf_(v2); v3 = siluf_(v3); }
                        ep_put<128>(lds, wy * 64 + n * 16 + fr, wx * 64 + m * 16 + 4 * fg, v0, v1, v2, v3);
                    }
            }
            RAW_BARRIER();
            bf16_t* dstb = proj + (size_t)(tm * 128) * NPROJ + tn * 128;
            ep_flush<128>(lds, tid, [&](int row, int c8) { return dstb + (size_t)row * NPROJ + c8 * 8; });
        }
    }
}

__device__ void phase_outproj(const Params& p, int l, bf16_t* lds) {
    const int tid = ltid(), lane = tid & 63, w = tid >> 6, wx = w >> 1, wy = w & 1, fr = lane & 15, fg = lane >> 4;
    const bf16_t* mix = (const bf16_t*)(p.ws + WS_MIX);
    const bf16_t* wt = (const bf16_t*)(p.ws + WS_WOUT) + (size_t)l * 1024 * 1024;
    const float* xin = (l == 0) ? p.in[0] : p.out;
    bf16_t* xb = (bf16_t*)(p.ws + WS_SCR + SCR_XB);
    for (int round = 0;; ++round) {
        int tm, tn;
        if (gridDim.x == 512) {
            if (round >= 2) break;
            const int x = blockIdx.x & 7, loc = blockIdx.x >> 3;
            tn = loc & 7; tm = (round * 8 + (loc >> 3)) * 8 + x;
        } else if (!xcd_item(round, NTOK / 128, 8, tm, tn)) break;
        f32x4 acc[4][4];
        {
            auto rw = [&](int r) { return wt + pl_off(tn * 128 + r, 0, 1024); };
            auto rt_ = [&](int r) { return mix + pl_off(tm * 128 + r, 0, 1024); };
            gemm_core(rw, rt_, 1024, lds, acc);
        }
#pragma unroll
        for (int n = 0; n < 4; ++n) {
            int t = tm * 128 + wy * 64 + n * 16 + fr;
#pragma unroll
            for (int m = 0; m < 4; ++m) {
                int c = tn * 128 + wx * 64 + m * 16 + 4 * fg;
                float4 xv = *(const float4*)(xin + (size_t)t * 1024 + c);
                store4_bf16(xb + (size_t)t * 1024 + c, xv.x + acc[m][n][0], xv.y + acc[m][n][1], xv.z + acc[m][n][2], xv.w + acc[m][n][3]);
            }
        }
    }
}

__device__ void phase_route(const Params& p, int l, bf16_t* lds, int dry = 0) {
    const int tid = ltid(), lane = tid & 63, w = tid >> 6, fr = lane & 15, fg = lane >> 4;
    const bf16_t* x1 = (const bf16_t*)(p.ws + WS_SCR + SCR_XB);
    const float* gain = p.in[15] + l * 1024;
    bf16_t* hn = dry ? (bf16_t*)(p.ws + WS_SCR) : (bf16_t*)(p.ws + WS_HN);
    const bf16_t* wr = (const bf16_t*)(p.ws + WS_WR) + (size_t)l * 64 * 1024;
    const float* brg = p.in[17] + l * 4; const float* bre = p.in[19] + l * 32;
    unsigned* cnt = (unsigned*)(p.ws + WS_CTL) + CW_CNT + l * 32 * NSH * CNT_STRIDE;
    int* rowtok = (int*)(p.ws + WS_ROWTOK);
    int* tslot = (int*)(p.ws + WS_TSLOT);
    float* tgate = (float*)(p.ws + WS_TGATE);
    const int HL = 1032;
    float* red = (float*)(lds + 16 * HL);
    for (int it = blockIdx.x; it < NTOK / 16; it += gridDim.x) {
        __syncthreads();
        u32x4 xin4[4][2];
#pragma unroll
        for (int rr = 0; rr < 4; ++rr) {
            const bf16_t* xr = x1 + (size_t)(it * 16 + w * 4 + rr) * 1024 + lane * 16;
            xin4[rr][0] = *(const u32x4*)xr; xin4[rr][1] = *(const u32x4*)(xr + 8);
        }
#pragma unroll
        for (int rr = 0; rr < 4; ++rr) {
            int lr = w * 4 + rr; int t = it * 16 + lr;
            float v[16]; float ss = 0.f;
#pragma unroll
            for (int i = 0; i < 4; ++i) { v[4 * i] = bflo(xin4[rr][i >> 1][(2 * i) & 3]); v[4 * i + 1] = bfhi(xin4[rr][i >> 1][(2 * i) & 3]); v[4 * i + 2] = bflo(xin4[rr][i >> 1][(2 * i + 1) & 3]); v[4 * i + 3] = bfhi(xin4[rr][i >> 1][(2 * i + 1) & 3]); }
#pragma unroll
            for (int i = 0; i < 16; ++i) ss += v[i] * v[i];
            ss = wave_sum(ss);
            float r = rsqrtf(ss / D_MODEL + 1e-6f);
#pragma unroll
            for (int i = 0; i < 16; ++i) v[i] = v[i] * r * gain[lane * 16 + i];
            uint4 o0, o1;
            o0.x = pk_bf16(v[0], v[1]); o0.y = pk_bf16(v[2], v[3]); o0.z = pk_bf16(v[4], v[5]); o0.w = pk_bf16(v[6], v[7]);
            o1.x = pk_bf16(v[8], v[9]); o1.y = pk_bf16(v[10], v[11]); o1.z = pk_bf16(v[12], v[13]); o1.w = pk_bf16(v[14], v[15]);
            bf16_t* hr = hn + pl_off(t, lane * 16, 1024);
            *(uint4*)hr = o0; *(uint4*)(hr + 8) = o1;
            *(uint4*)(lds + lr * HL + lane * 16) = o0; *(uint4*)(lds + lr * HL + lane * 16 + 8) = o1;
        }
        __syncthreads();
        f32x4 acc[3];
#pragma unroll
        for (int n = 0; n < 3; ++n) acc[n] = (f32x4){0.f, 0.f, 0.f, 0.f};
#pragma unroll
        for (int ks = 0; ks < 8; ++ks) {
            int k = w * 256 + ks * 32 + fg * 8;
            bf16x8 a = *(const bf16x8*)(lds + fr * HL + k);
#pragma unroll
            for (int n = 0; n < 3; ++n) {
                bf16x8 b = *(const bf16x8*)(wr + (size_t)(n * 16 + fr) * 1024 + k);
                acc[n] = __builtin_amdgcn_mfma_f32_16x16x32_bf16(a, b, acc[n], 0, 0, 0);
            }
        }
#pragma unroll
        for (int n = 0; n < 3; ++n) *(f32x4*)(red + ((w * 3 + n) * 64 + lane) * 4) = acc[n];
        __syncthreads();
        if (tid < 16) {
            float lg[36];
#pragma unroll
            for (int j = 0; j < 36; ++j) {
                int n = j >> 4, f = j & 15; int ln = (tid >> 2) * 16 + f; float s = 0.f;
#pragma unroll
                for (int ww = 0; ww < 4; ++ww) s += red[((ww * 3 + n) * 64 + ln) * 4 + (tid & 3)];
                lg[j] = s;
            }
            float gl[4]; float gm = -1e30f; int gi = 0;
#pragma unroll
            for (int j = 0; j < 4; ++j) { gl[j] = lg[j] + brg[j]; if (gl[j] > gm) { gm = gl[j]; gi = j; } }
            float gs = 0.f;
#pragma unroll
            for (int j = 0; j < 4; ++j) gs += __expf(gl[j] - gm);
            float gp = 1.f / gs;
            float el[8]; float em = -1e30f;
#pragma unroll
            for (int j = 0; j < 8; ++j) {
                float v = (gi == 0) ? lg[4 + j] : (gi == 1) ? lg[12 + j] : (gi == 2) ? lg[20 + j] : lg[28 + j];
                el[j] = v + bre[gi * 8 + j]; em = fmaxf(em, el[j]);
            }
#pragma unroll
            for (int j = 0; j < 8; ++j) el[j] = __expf(el[j] - em);
            float v0 = -1.f, v1 = -1.f; int i0 = 0, i1 = 0;
#pragma unroll
            for (int j = 0; j < 8; ++j) {
                float v = el[j];
                if (v > v0) { v1 = v0; i1 = i0; v0 = v; i0 = j; }
                else if (v > v1) { v1 = v; i1 = j; }
            }
            int t = it * 16 + tid;
            int e0 = gi * 8 + i0, e1 = gi * 8 + i1;
            if (!dry) {
            const int sh = blockIdx.x & (NSH - 1);
            unsigned s0 = atomicAdd(&cnt[(e0 * NSH + sh) * CNT_STRIDE], 1u), s1 = atomicAdd(&cnt[(e1 * NSH + sh) * CNT_STRIDE], 1u);
            rowtok[(size_t)(e0 * NSH + sh) * SHCAP + s0] = t; rowtok[(size_t)(e1 * NSH + sh) * SHCAP + s1] = t;
            tslot[t * 2] = (e0 << 16) | (sh << 11) | (int)s0; tslot[t * 2 + 1] = (e1 << 16) | (sh << 11) | (int)s1;
            tgate[t * 2] = gp * v0 / (v0 + v1); tgate[t * 2 + 1] = gp * v1 / (v0 + v1);
            } else if (gp * v0 == 123.456f) tgate[0] = v1;
        }
    }
}

__device__ __forceinline__ void moe_tables(const unsigned* cnt, int* tab) {
    const int t = threadIdx.x;
    int* sc = tab + 80 + 32 * 9;
    sc[t] = (int)ld_u32_agent(cnt + t * CNT_STRIDE);
    __syncthreads();
    if (t < 32) { int a = 0; for (int s = 0; s < NSH; ++s) { tab[80 + t * 9 + s] = a; a += sc[t * NSH + s]; } tab[80 + t * 9 + 8] = a; }
    __syncthreads();
    if (t == 0) {
        int a = 0;
        for (int e = 0; e < 32; ++e) { tab[e] = a; tab[40 + e] = a * 128; a += (tab[80 + e * 9 + 8] + 127) >> 7; }
        tab[32] = a; tab[72] = a * 128;
    }
    __syncthreads();
}
template <int MODE>
__device__ void phase_expert(const Params& p, int l, bf16_t* lds) {
    const int tid = ltid(), lane = tid & 63, w = tid >> 6, wx = w >> 1, wy = w & 1, fr = lane & 15, fg = lane >> 4;
    const unsigned* cnt = (const unsigned*)(p.ws + WS_CTL) + CW_CNT + l * 32 * NSH * CNT_STRIDE;
    int* tab = (int*)(lds + 4 * GSTAGE);
    moe_tables(cnt, tab);
    if (MODE == 0 && blockIdx.x == 0) {
        unsigned* mt = (unsigned*)(p.ws + WS_CTL) + CW_MOETAB + l * 32 * NSH;
        mt[threadIdx.x] = (unsigned)(tab[40 + (threadIdx.x >> 3)] + tab[80 + (threadIdx.x >> 3) * 9 + (threadIdx.x & 7)]);
    }
    const int* rowtok = (const int*)(p.ws + WS_ROWTOK);
    const bf16_t* hn = (const bf16_t*)(p.ws + WS_HN);
    bf16_t* Hb = (bf16_t*)(p.ws + WS_H);
    bf16_t* Yb = (bf16_t*)(p.ws + WS_Y);
    const int x = blockIdx.x & 7, loc = blockIdx.x >> 3, nloc = gridDim.x >> 3;
    for (int j = loc;; j += nloc) {
        int e = -1, rt = 0, tn = 0; int jj = j;
#pragma unroll
        for (int q = 0; q < 4; ++q) {
            int ee = q * 8 + x; int nrt = tab[ee + 1] - tab[ee];
            if (e < 0) { if (jj < nrt * 8) { e = ee; tn = jj / nrt; rt = jj % nrt; } else jj -= nrt * 8; }
        }
        if (e < 0) break;
        const int hrow0 = tab[40 + e] + rt * 128;
        f32x4 acc[4][4];
        if (MODE == 0) {
            const bf16_t* wbase = (const bf16_t*)(p.ws + WS_WGU) + ((size_t)l * 32 + e) * 1024 * 1024;
            const int* spx = tab + 80 + e * 9;
            auto rw = [&](int r) { return wbase + pl_off(tn * 128 + r, 0, 1024); };
            auto rt_ = [&](int r) {
                const int s = rt * 128 + r; int t = 0;
                if (s < spx[8]) {
                    int xs = 0;
#pragma unroll
                    for (int q = 1; q < NSH; ++q) xs += (s >= spx[q]) ? 1 : 0;
                    t = rowtok[(size_t)(e * NSH + xs) * SHCAP + (s - spx[xs])];
                }
                return hn + pl_off(t, 0, 1024); };
            gemm_core(rw, rt_, 1024, lds, acc);
        } else {
            const bf16_t* wbase = (const bf16_t*)(p.ws + WS_WD) + ((size_t)l * 32 + e) * 1024 * 512;
            auto rw = [&](int r) { return wbase + pl_off(tn * 128 + r, 0, 512); };
            auto rt_ = [&](int r) { return Hb + pl_off(hrow0 + r, 0, 512); };
            gemm_core(rw, rt_, 512, lds, acc);
        }
        RAW_BARRIER();
        if (MODE == 0) {
#pragma unroll
            for (int n = 0; n < 4; ++n)
#pragma unroll
                for (int m = 0; m < 2; ++m)
                    ep_put<64>(lds, wy * 64 + n * 16 + fr, wx * 32 + m * 16 + 4 * fg, siluf_(acc[m][n][0]) * acc[m + 2][n][0], siluf_(acc[m][n][1]) * acc[m + 2][n][1],
                               siluf_(acc[m][n][2]) * acc[m + 2][n][2], siluf_(acc[m][n][3]) * acc[m + 2][n][3]);
            RAW_BARRIER();
            ep_flush<64>(lds, tid, [&](int row, int c8) { return Hb + pl_off(hrow0 + row, tn * 64 + c8 * 8, 512); });
        } else {
#pragma unroll
            for (int n = 0; n < 4; ++n)
#pragma unroll
                for (int m = 0; m < 4; ++m) ep_put<128>(lds, wy * 64 + n * 16 + fr, wx * 64 + m * 16 + 4 * fg, acc[m][n][0], acc[m][n][1], acc[m][n][2], acc[m][n][3]);
            RAW_BARRIER();
            bf16_t* dstb = Yb + (size_t)hrow0 * 1024 + tn * 128;
            ep_flush<128>(lds, tid, [&](int row, int c8) { return dstb + (size_t)row * 1024 + c8 * 8; });
        }
    }
}

__device__ void phase_combine(const Params& p, int l, int dry = 0) {
    const int tid = ltid(), lane = tid & 63, w = tid >> 6;
    const unsigned* mt = (const unsigned*)(p.ws + WS_CTL) + CW_MOETAB + l * 32 * NSH;
    const int* tslot = (const int*)(p.ws + WS_TSLOT);
    const float* tgate = (const float*)(p.ws + WS_TGATE);
    const bf16_t* Yb = (const bf16_t*)(p.ws + WS_Y);
    bf16_t* hn = dry ? (bf16_t*)(p.ws + WS_SCR + (size_t)40 * 1024 * 1024) : (bf16_t*)(p.ws + WS_HN);
    float* xw = dry ? (float*)(p.ws + WS_SCR + (size_t)48 * 1024 * 1024) : p.out;
    const float* gain = (l == 0 || dry) ? p.in[1] + 1024 : nullptr;
    for (int it = blockIdx.x; it < NTOK / 4; it += gridDim.x) {
        int t = it * 4 + w;
        int ts0 = tslot[t * 2], ts1 = tslot[t * 2 + 1];
        float g0 = tgate[t * 2], g1 = tgate[t * 2 + 1];
        int r0 = (int)mt[((ts0 >> 16) << 3) | ((ts0 >> 11) & 7)] + (ts0 & 0x7ff);
        int r1 = (int)mt[((ts1 >> 16) << 3) | ((ts1 >> 11) & 7)] + (ts1 & 0x7ff);
        const bf16_t* xr = (const bf16_t*)(p.ws + WS_SCR + SCR_XB) + (size_t)t * 1024 + lane * 16;
        const bf16_t* y0 = Yb + (size_t)r0 * 1024 + lane * 16;
        const bf16_t* y1 = Yb + (size_t)r1 * 1024 + lane * 16;
        float v[16];
#pragma unroll
        for (int i = 0; i < 2; ++i) { u32x4 q = *(const u32x4*)(xr + 8 * i);
#pragma unroll
            for (int k = 0; k < 4; ++k) { v[8 * i + 2 * k] = bflo(q[k]); v[8 * i + 2 * k + 1] = bfhi(q[k]); } }
        uint4 a0 = *(const uint4*)y0, a1 = *(const uint4*)(y0 + 8), b0 = *(const uint4*)y1, b1 = *(const uint4*)(y1 + 8);
        unsigned ya[8] = {a0.x, a0.y, a0.z, a0.w, a1.x, a1.y, a1.z, a1.w};
        unsigned yb[8] = {b0.x, b0.y, b0.z, b0.w, b1.x, b1.y, b1.z, b1.w};
#pragma unroll
        for (int i = 0; i < 8; ++i) {
            v[2 * i] += g0 * bflo(ya[i]) + g1 * bflo(yb[i]);
            v[2 * i + 1] += g0 * bfhi(ya[i]) + g1 * bfhi(yb[i]);
        }
#ifdef NANMARK
#pragma unroll
        for (int i = 0; i < 16; ++i) if (!(fabsf(v[i]) < 1e30f)) v[i] = 1000.f;
#endif
#pragma unroll
        for (int i = 0; i < 4; ++i) *(float4*)(xw + (size_t)t * 1024 + lane * 16 + 4 * i) = make_float4(v[4 * i], v[4 * i + 1], v[4 * i + 2], v[4 * i + 3]);
        if (gain) {
            float ss = 0.f;
#pragma unroll
            for (int i = 0; i < 16; ++i) ss += v[i] * v[i];
            ss = wave_sum(ss);
            float r = rsqrtf(ss / D_MODEL + 1e-6f);
#pragma unroll
            for (int i = 0; i < 16; ++i) v[i] = v[i] * r * gain[lane * 16 + i];
            uint4 o0, o1;
            o0.x = pk_bf16(v[0], v[1]); o0.y = pk_bf16(v[2], v[3]); o0.z = pk_bf16(v[4], v[5]); o0.w = pk_bf16(v[6], v[7]);
            o1.x = pk_bf16(v[8], v[9]); o1.y = pk_bf16(v[10], v[11]); o1.z = pk_bf16(v[12], v[13]); o1.w = pk_bf16(v[14], v[15]);
            bf16_t* hr = hn + pl_off(t, lane * 16, 1024);
            *(uint4*)hr = o0; *(uint4*)(hr + 8) = o1;
        }
    }
}


__device__ __forceinline__ void mm_row(const bf16_t* RA, const bf16_t* RB, int mw, int fr, int fg, f32x4 (&acc)[4]) {
#pragma unroll
    for (int ks = 0; ks < 2; ++ks) {
        bf16x8 a = *(const bf16x8*)(RA + (16 * mw + fr) * LROW + ks * 32 + fg * 8);
#pragma unroll
        for (int nt = 0; nt < 4; ++nt) {
            bf16x8 b = *(const bf16x8*)(RB + (16 * nt + fr) * LROW + ks * 32 + fg * 8);
            acc[nt] = __builtin_amdgcn_mfma_f32_16x16x32_bf16(a, b, acc[nt], 0, 0, 0);
        }
    }
}
__device__ __forceinline__ void mm_col(const bf16_t* RA, const bf16_t* RB, int nw, int fr, int fg, f32x4 (&acc)[4]) {
#pragma unroll
    for (int ks = 0; ks < 2; ++ks) {
        bf16x8 b = *(const bf16x8*)(RB + (16 * nw + fr) * LROW + ks * 32 + fg * 8);
#pragma unroll
        for (int mt = 0; mt < 4; ++mt) {
            bf16x8 a = *(const bf16x8*)(RA + (16 * mt + fr) * LROW + ks * 32 + fg * 8);
            acc[mt] = __builtin_amdgcn_mfma_f32_16x16x32_bf16(a, b, acc[mt], 0, 0, 0);
        }
    }
}
__device__ __forceinline__ void zero4(f32x4 (&a)[4]) {
#pragma unroll
    for (int i = 0; i < 4; ++i) a[i] = (f32x4){0.f, 0.f, 0.f, 0.f};
}
__device__ __forceinline__ void st4_lds(bf16_t* p, float a, float b, float c, float d) { uint2 o; o.x = pk_bf16(a, b); o.y = pk_bf16(c, d); *(uint2*)p = o; }
__device__ __forceinline__ bf16_t f2bf(float v) { return (bf16_t)(pk_bf16(v, 0.f) & 0xffffu); }

__device__ void gdn_prep_item(const Params& p, int l, int cid, unsigned char* lds_raw) {
    const int tid = ltid(), lane = tid & 63, w = tid >> 6, fr = lane & 15, fg = lane >> 4;
    const int bh = cid >> 6, n = cid & 63, b = bh / H_GDN, h = bh % H_GDN;
    const int t0 = b * SEQ + n * 64;
    bf16_t* L0 = (bf16_t*)lds_raw; bf16_t* L1 = L0 + 64 * LROW; bf16_t* L2 = L1 + 64 * LROW; bf16_t* L3 = L2 + 64 * LROW; bf16_t* L4 = L3 + 64 * LROW; bf16_t* L5 = L4 + 64 * LROW;
    float* dec = (float*)(L5 + 64 * LROW); float* beta = dec + 64;
    const bf16_t* proj = (const bf16_t*)(p.ws + WS_PROJ);
    const float* aux = (const float*)(p.ws + WS_AUX);
    const float* convw = p.in[7] + (size_t)l * 4 * 1152;
    __syncthreads();
    const int i = tid >> 2, c0 = (tid & 3) * 16;
    float qv[16], kv[16], vv[16];
#pragma unroll
    for (int which = 0; which < 3; ++which) {
        float acc[16];
#pragma unroll
        for (int c = 0; c < 16; ++c) acc[c] = 0.f;
#pragma unroll
        for (int tap = 0; tap < 4; ++tap) {
            const int row = i - 3 + tap;
            if (n * 64 + row >= 0) {
                const bf16_t* xp = proj + (size_t)(t0 + row) * NPROJ + NC_GQ + which * 384 + h * 64 + c0;
                u32x4 x0 = *(const u32x4*)xp, x1 = *(const u32x4*)(xp + 8);
                const float* wp = convw + tap * 1152 + which * 384 + h * 64 + c0;
                f32x4 w0 = *(const f32x4*)wp, w1 = *(const f32x4*)(wp + 4), w2 = *(const f32x4*)(wp + 8), w3 = *(const f32x4*)(wp + 12);
                float wv[16] = {w0[0], w0[1], w0[2], w0[3], w1[0], w1[1], w1[2], w1[3], w2[0], w2[1], w2[2], w2[3], w3[0], w3[1], w3[2], w3[3]};
                unsigned xs[8] = {x0[0], x0[1], x0[2], x0[3], x1[0], x1[1], x1[2], x1[3]};
#pragma unroll
                for (int c = 0; c < 8; ++c) { acc[2 * c] += wv[2 * c] * bflo(xs[c]); acc[2 * c + 1] += wv[2 * c + 1] * bfhi(xs[c]); }
            }
        }
        float ss = 0.f;
#pragma unroll
        for (int c = 0; c < 16; ++c) { acc[c] = siluf_(acc[c]); ss += acc[c] * acc[c]; }
        if (which < 2) {
            ss += __shfl_xor(ss, 1, 64); ss += __shfl_xor(ss, 2, 64);
            const float sc = rsqrtf(ss + 1e-6f) * (which == 0 ? 0.125f : 1.f);
#pragma unroll
            for (int c = 0; c < 16; ++c) acc[c] *= sc;
        }
#pragma unroll
        for (int c = 0; c < 16; ++c) { if (which == 0) qv[c] = acc[c]; else if (which == 1) kv[c] = acc[c]; else vv[c] = acc[c]; }
    }
#pragma unroll
    for (int c = 0; c < 16; c += 4) { st4_lds(L2 + i * LROW + c0 + c, kv[c], kv[c + 1], kv[c + 2], kv[c + 3]); st4_lds(L3 + i * LROW + c0 + c, qv[c], qv[c + 1], qv[c + 2], qv[c + 3]); }
    if (w == 0) {
        const float a = aux[(size_t)(t0 + lane) * 64 + AX_GA + h], bl = aux[(size_t)(t0 + lane) * 64 + AX_GB + h];
        const float g = -__expf(p.in[8][l * H_GDN + h]) * softplusf_(a + p.in[9][l * H_GDN + h]);
        float inc = g;
#pragma unroll
        for (int o = 1; o < 64; o <<= 1) { float t = __shfl_up(inc, o, 64); if (lane >= o) inc += t; }
        dec[lane] = inc; beta[lane] = sigmoidf_(bl);
    }
    __syncthreads();
    {
        f32x4 g4[4]; zero4(g4);
        mm_row(L2, L2, w, fr, fg, g4);
#pragma unroll
        for (int nt = 0; nt < 4; ++nt) {
            const int kap = 16 * nt + fr; const float dk_ = dec[kap], bk_ = beta[kap];
            float nT[4], nN[4], tt[4];
#pragma unroll
            for (int r = 0; r < 4; ++r) {
                const int rho = 16 * w + 4 * fg + r; const float dr_ = dec[rho], br_ = beta[rho];
                const float G = g4[nt][r];
                nT[r] = (kap < rho) ? br_ * G * __expf(dr_ - dk_) : 0.f;
                nN[r] = (rho < kap) ? bk_ * G * __expf(dk_ - dr_) : 0.f;
                tt[r] = ((kap == rho) ? 1.f : 0.f) - nN[r];
            }
            st4_lds(L1 + kap * LROW + 16 * w + 4 * fg, nT[0], nT[1], nT[2], nT[3]);
            st4_lds(L0 + kap * LROW + 16 * w + 4 * fg, nN[0], nN[1], nN[2], nN[3]);
            st4_lds(L4 + kap * LROW + 16 * w + 4 * fg, tt[0], tt[1], tt[2], tt[3]);
        }
        f32x4 a4[4]; zero4(a4);
        mm_row(L2, L3, w, fr, fg, a4);
#pragma unroll
        for (int nt = 0; nt < 4; ++nt) {
            const int ii = 16 * nt + fr; const float di_ = dec[ii];
            float v4[4];
#pragma unroll
            for (int r = 0; r < 4; ++r) { const int j = 16 * w + 4 * fg + r; v4[r] = (j <= ii) ? a4[nt][r] * __expf(di_ - dec[j]) : 0.f; }
            st4_lds(L5 + ii * LROW + 16 * w + 4 * fg, v4[0], v4[1], v4[2], v4[3]);
        }
    }
    __syncthreads();
#pragma unroll
    for (int lev = 1; lev <= 5; ++lev) {
        const bf16_t* XA = (lev & 1) ? L0 : L2; const bf16_t* XAt = (lev & 1) ? L1 : L3;
        bf16_t* XB = (lev & 1) ? L2 : L0; bf16_t* XBt = (lev & 1) ? L3 : L1;
        {
            f32x4 x4[4]; zero4(x4);
            mm_row(XA, XAt, w, fr, fg, x4);
#pragma unroll
            for (int nt = 0; nt < 4; ++nt) {
                const int c = 16 * nt + fr;
                st4_lds(XBt + c * LROW + 16 * w + 4 * fg, x4[nt][0], x4[nt][1], x4[nt][2], x4[nt][3]);
                if (lev < 5) {
#pragma unroll
                    for (int r = 0; r < 4; ++r) XB[(16 * w + 4 * fg + r) * LROW + c] = f2bf(x4[nt][r]);
                }
            }
        }
        __syncthreads();
        {
            f32x4 t4[4];
#pragma unroll
            for (int mt = 0; mt < 4; ++mt) {
                uint2 u = *(const uint2*)(L4 + (16 * w + fr) * LROW + 16 * mt + 4 * fg);
                t4[mt] = (f32x4){bflo(u.x), bfhi(u.x), bflo(u.y), bfhi(u.y)};
            }
            mm_col(XBt, L4, w, fr, fg, t4);
#pragma unroll
            for (int mt = 0; mt < 4; ++mt) st4_lds(L4 + (16 * w + fr) * LROW + 16 * mt + 4 * fg, t4[mt][0], t4[mt][1], t4[mt][2], t4[mt][3]);
        }
    }
    {
        const float dj = dec[i], bj = beta[i], dlast = dec[63];
        const float s1 = bj * __expf(dj), s2 = bj, s3 = __expf(dlast - dj);
#pragma unroll
        for (int c = 0; c < 16; ++c) {
            L0[(c0 + c) * LROW + i] = f2bf(kv[c] * s1);
            L1[(c0 + c) * LROW + i] = f2bf(vv[c] * s2);
            L2[(c0 + c) * LROW + i] = f2bf(kv[c] * s3);
        }
    }
    __syncthreads();
    {
        f32x4 w4[4], u4[4]; zero4(w4); zero4(u4);
        mm_row(L4, L0, w, fr, fg, w4);
        mm_row(L4, L1, w, fr, fg, u4);
        __syncthreads();
#pragma unroll
        for (int nt = 0; nt < 4; ++nt) {
            st4_lds(L0 + (16 * nt + fr) * LROW + 16 * w + 4 * fg, w4[nt][0], w4[nt][1], w4[nt][2], w4[nt][3]);
            st4_lds(L1 + (16 * nt + fr) * LROW + 16 * w + 4 * fg, u4[nt][0], u4[nt][1], u4[nt][2], u4[nt][3]);
        }
        const float ed = __expf(dec[i]);
#pragma unroll
        for (int c = 0; c < 16; c += 4) st4_lds(L3 + i * LROW + c0 + c, qv[c] * ed, qv[c + 1] * ed, qv[c + 2] * ed, qv[c + 3] * ed);
    }
    __syncthreads();
    char* scr = p.ws + WS_SCR;
    {
        f32x4 m4[4]; zero4(m4);
        mm_row(L0, L2, w, fr, fg, m4);
        bf16_t* MP = (bf16_t*)(scr + SCR_GDN_MP) + (size_t)cid * 4096;
#pragma unroll
        for (int nt = 0; nt < 4; ++nt) store4_bf16(MP + (16 * nt + fr) * 64 + 16 * w + 4 * fg, -m4[nt][0], -m4[nt][1], -m4[nt][2], -m4[nt][3]);
        f32x4 n4[4]; zero4(n4);
        mm_row(L2, L1, w, fr, fg, n4);
        bf16_t* NN = (bf16_t*)(scr + SCR_GDN_NN) + (size_t)cid * 4096;
#pragma unroll
        for (int nt = 0; nt < 4; ++nt) store4_bf16(NN + ((nt * 4 + w) * 64 + lane) * 4, n4[nt][0], n4[nt][1], n4[nt][2], n4[nt][3]);
        f32x4 p4[4]; zero4(p4);
        mm_row(L0, L5, w, fr, fg, p4);
        bf16_t* PG = (bf16_t*)(scr + SCR_GDN_P) + (size_t)cid * 4096;
#pragma unroll
        for (int nt = 0; nt < 4; ++nt) {
            uint2 u = *(const uint2*)(L3 + (16 * nt + fr) * LROW + 16 * w + 4 * fg);
            store4_bf16(PG + (16 * nt + fr) * 64 + 16 * w + 4 * fg, bflo(u.x) - p4[nt][0], bfhi(u.x) - p4[nt][1], bflo(u.y) - p4[nt][2], bfhi(u.y) - p4[nt][3]);
        }
        f32x4 o4[4]; zero4(o4);
        mm_row(L1, L5, w, fr, fg, o4);
        bf16_t* OL = (bf16_t*)(scr + SCR_GDN_OL) + (size_t)cid * 4096;
#pragma unroll
        for (int nt = 0; nt < 4; ++nt) store4_bf16(OL + (16 * nt + fr) * 64 + 16 * w + 4 * fg, o4[nt][0], o4[nt][1], o4[nt][2], o4[nt][3]);
        if (tid == 0) ((float*)(scr + SCR_GDN_LAST))[cid] = __expf(dec[63]);
    }
}

#define SCAN_SLOT    5120
#define SCAN_SB(k)   ((bf16_t*)lds_raw + (k) * 1024)
#define SCAN_RING(k) ((bf16_t*)lds_raw + 2048 + (k) * SCAN_SLOT)
#define SCAN_LAST    ((float*)(lds_raw + 4096 + 5 * SCAN_SLOT * 2))
__device__ __forceinline__ void scan_issue(const bf16_t* const (&mp)[8], const bf16_t* nn_lane, int n, bf16_t* slot) {
#pragma unroll
    for (int q = 0; q < 8; ++q) __builtin_amdgcn_global_load_lds((const unsigned*)(mp[q] + (size_t)n * 4096), (unsigned*)(slot + q * 512), 16, 0, 0);
    __builtin_amdgcn_global_load_lds((const unsigned*)(nn_lane + (size_t)n * 4096), (unsigned*)(slot + 4096), 16, 0, 0);
    __builtin_amdgcn_global_load_lds((const unsigned*)(nn_lane + (size_t)n * 4096 + 512), (unsigned*)(slot + 4096 + 512), 16, 0, 0);
}
__device__ void gdn_scan_item(const Params& p, int item, unsigned char* lds_raw, int svar = 0) {
    const int tid = ltid(), lane = tid & 63, w = __builtin_amdgcn_readfirstlane(tid >> 6), fr = lane & 15, fg = lane >> 4;
    const int bh = item >> 2, cg = item & 3;
    char* scr = p.ws + WS_SCR;
    const bf16_t* MP = (const bf16_t*)(scr + SCR_GDN_MP) + (size_t)bh * 64 * 4096;
    const bf16_t* NN = (const bf16_t*)(scr + SCR_GDN_NN) + (size_t)bh * 64 * 4096 + cg * 1024;
    const float* LAST = (const float*)(scr + SCR_GDN_LAST) + bh * 64;
    bf16_t* SG = (bf16_t*)(scr + SCR_GDN_SG) + (size_t)bh * 64 * 4096 + cg * 1024;
    const bf16_t* mp[8];
#pragma unroll
    for (int q = 0; q < 8; ++q) { const int row = 8 * q + (lane >> 3); mp[q] = MP + row * 64 + (((lane & 7) ^ ((row >> 1) & 7)) * 8); }
    const bf16_t* nn_lane = NN + lane * 8;
    RAW_BARRIER();
    if (tid < 64) SCAN_LAST[tid] = ld_f32_agent(LAST + tid);
    asm volatile("s_waitcnt vmcnt(0)" ::: "memory");
    f32x4 S = (f32x4){0.f, 0.f, 0.f, 0.f};
    const int swz = (fr >> 1) & 7;
    if (w == 0) {
#pragma unroll
        for (int n = 0; n < 4; ++n) scan_issue(mp, nn_lane, n, SCAN_RING(n));
    }
    for (int n = 0; n < 64; ++n) {
        bf16_t* sb = SCAN_SB(n & 1);
        const bf16_t* ring = SCAN_RING(n % 5);
        {
            const int c = 2 * w + (fg >> 1);
            uint2 o; o.x = pk_bf16(S[0], S[1]); o.y = pk_bf16(S[2], S[3]);
            *(uint2*)(sb + fr * 64 + ((c ^ swz) * 8) + 4 * (fg & 1)) = o;
        }
        if (w == 0) {
            if (n + 3 < 64) asm volatile("s_waitcnt vmcnt(30)" ::: "memory");
            else if (n + 2 < 64) asm volatile("s_waitcnt vmcnt(20)" ::: "memory");
            else if (n + 1 < 64) asm volatile("s_waitcnt vmcnt(10)" ::: "memory");
            else asm volatile("s_waitcnt vmcnt(0)" ::: "memory");
        }
        RAW_BARRIER();
        if (w == 0 && n + 4 < 64 && svar != 2) scan_issue(mp, nn_lane, n + 4, SCAN_RING((n + 4) % 5));
        const float last = SCAN_LAST[n];
        {
            u32x2 nn = *(const u32x2*)(ring + 4096 + (w * 64 + lane) * 4);
            S[0] = last * S[0] + bflo(nn[0]); S[1] = last * S[1] + bfhi(nn[0]);
            S[2] = last * S[2] + bflo(nn[1]); S[3] = last * S[3] + bfhi(nn[1]);
        }
#pragma unroll
        for (int ks = 0; ks < 2; ++ks) {
            const int co = ((ks * 4 + fg) ^ swz) * 8;
            bf16x8 a = *(const bf16x8*)(ring + (16 * w + fr) * 64 + co);
            bf16x8 s = *(const bf16x8*)(sb + fr * 64 + co);
            S = __builtin_amdgcn_mfma_f32_16x16x32_bf16(a, s, S, 0, 0, 0);
        }
        if (w >= 2 && svar != 1) {
            const int c = (w - 2) * 64 + lane; const int row = c >> 3, pc = c & 7;
            u32x4 v = *(const u32x4*)(sb + row * 64 + pc * 8);
            *(u32x4*)(SG + (size_t)n * 4096 + row * 64 + ((pc ^ ((row >> 1) & 7)) * 8)) = v;
        }
    }
}

__device__ void gdn_out_item(const Params& p, int l, int cid) {
    const int tid = ltid(), lane = tid & 63, w = tid >> 6, fr = lane & 15, fg = lane >> 4;
    const int bh = cid >> 6, n = cid & 63, b = bh / H_GDN, h = bh % H_GDN;
    char* scr = p.ws + WS_SCR;
    const bf16_t* SG = (const bf16_t*)(scr + SCR_GDN_SG) + (size_t)cid * 4096;
    const bf16_t* PG = (const bf16_t*)(scr + SCR_GDN_P) + (size_t)cid * 4096;
    const bf16_t* OL = (const bf16_t*)(scr + SCR_GDN_OL) + (size_t)cid * 4096;
    const int i = 16 * w + fr; const int t = b * SEQ + n * 64 + i;
    f32x4 acc[4];
#pragma unroll
    for (int mt = 0; mt < 4; ++mt) { uint2 u = *(const uint2*)(OL + i * 64 + 16 * mt + 4 * fg); acc[mt] = (f32x4){bflo(u.x), bfhi(u.x), bflo(u.y), bfhi(u.y)}; }
#pragma unroll
    for (int ks = 0; ks < 2; ++ks) {
        bf16x8 bq = *(const bf16x8*)(PG + i * 64 + ks * 32 + fg * 8);
#pragma unroll
        for (int mt = 0; mt < 4; ++mt) {
            bf16x8 a = *(const bf16x8*)(SG + (16 * mt + fr) * 64 + ks * 32 + fg * 8);
            acc[mt] = __builtin_amdgcn_mfma_f32_16x16x32_bf16(a, bq, acc[mt], 0, 0, 0);
        }
    }
    float ss = 0.f;
#pragma unroll
    for (int mt = 0; mt < 4; ++mt)
#pragma unroll
        for (int r = 0; r < 4; ++r) ss += acc[mt][r] * acc[mt][r];
    ss += __shfl_xor(ss, 16, 64); ss += __shfl_xor(ss, 32, 64);
    const float rstd = rsqrtf(ss * (1.f / 64.f) + 1e-6f);
    const float* og = p.in[10] + l * 64;
    const bf16_t* gp = (const bf16_t*)(p.ws + WS_PROJ) + (size_t)t * NPROJ + NC_GG + h * 64;
    bf16_t* mp = (bf16_t*)(p.ws + WS_MIX) + pl_off(t, 384 + h * 64, 1024);
#pragma unroll
    for (int mt = 0; mt < 4; ++mt) {
        const int e0 = 16 * mt + 4 * fg;
        uint2 gu = *(const uint2*)(gp + e0); f32x4 g4 = *(const f32x4*)(og + e0);
        store4_bf16(mp + e0 + (e0 & 32), acc[mt][0] * rstd * g4[0] * bflo(gu.x), acc[mt][1] * rstd * g4[1] * bfhi(gu.x), acc[mt][2] * rstd * g4[2] * bflo(gu.y), acc[mt][3] * rstd * g4[3] * bfhi(gu.y));
    }
}

#define GQROW 40
__device__ void gla_prep_item(const Params& p, int l, int cid, unsigned char* lds_raw) {
    const int tid = ltid(), lane = tid & 63, w = tid >> 6, fr = lane & 15, fg = lane >> 4;
    const int bh = cid >> 6, n = cid & 63, b = bh / H_GLA, h = bh % H_GLA;
    const int t0 = b * SEQ + n * 64;
    float* Bf = (float*)lds_raw;
    bf16_t* Qt = (bf16_t*)(lds_raw + 8448);
    bf16_t* Kt = Qt + 64 * GQROW;
    bf16_t* KLt = Kt + 64 * GQROW;
    bf16_t* Vt = KLt + 32 * LROW;
    const bf16_t* proj = (const bf16_t*)(p.ws + WS_PROJ);
    const float* aux = (const float*)(p.ws + WS_AUX);
    char* scr = p.ws + WS_SCR;
    __syncthreads();
    const int i = tid >> 2, d0 = (tid & 3) * 8;
    {
        const float* wa = p.in[11] + (size_t)l * 16 * 128 + h * 32 + d0;
        const float* ba = p.in[12] + l * 128 + h * 32 + d0;
        float acc[8];
#pragma unroll
        for (int j = 0; j < 8; ++j) acc[j] = ba[j];
        float a1v[16];
#pragma unroll
        for (int r = 0; r < 16; r += 2) { float2 t2 = *(const float2*)(aux + (size_t)(t0 + i) * 64 + AX_LA + r); a1v[r] = t2.x; a1v[r + 1] = t2.y; }
#pragma unroll
        for (int r = 0; r < 16; ++r) {
            f32x4 wA = *(const f32x4*)(wa + r * 128), wB = *(const f32x4*)(wa + r * 128 + 4);
#pragma unroll
            for (int j = 0; j < 4; ++j) { acc[j] += a1v[r] * wA[j]; acc[4 + j] += a1v[r] * wB[j]; }
        }
#pragma unroll
        for (int j = 0; j < 8; ++j) Bf[i * 33 + d0 + j] = logsigmoidf_(acc[j]) * (1.f / 16.f);
    }
    {
        const bf16_t* lvt = (const bf16_t*)(scr + SCR_LVT) + (size_t)bh * 64 * SEQ + n * 64;
#pragma unroll
        for (int ii = 0; ii < 2; ++ii) { int c = tid + 256 * ii; int row = c >> 3, kc = c & 7; *(u32x4*)(Vt + row * LROW + kc * 8) = *(const u32x4*)(lvt + (size_t)row * SEQ + kc * 8); }
    }
    __syncthreads();
#pragma unroll
    for (int c = 0; c < 8; ++c) {
        const int d = 8 * w + c;
        float inc = Bf[lane * 33 + d];
#pragma unroll
        for (int o = 1; o < 64; o <<= 1) { float t = __shfl_up(inc, o, 64); if (lane >= o) inc += t; }
        Bf[lane * 33 + d] = inc;
    }
    __syncthreads();
    {
        const bf16_t* qp = proj + (size_t)(t0 + i) * NPROJ + NC_LQ + h * 32 + d0;
        const bf16_t* kp = proj + (size_t)(t0 + i) * NPROJ + NC_LK + h * 32 + d0;
        u32x4 qu = *(const u32x4*)qp, ku = *(const u32x4*)kp;
        float qf[8] = {bflo(qu[0]), bfhi(qu[0]), bflo(qu[1]), bfhi(qu[1]), bflo(qu[2]), bfhi(qu[2]), bflo(qu[3]), bfhi(qu[3])};
        float kf[8] = {bflo(ku[0]), bfhi(ku[0]), bflo(ku[1]), bfhi(ku[1]), bflo(ku[2]), bfhi(ku[2]), bflo(ku[3]), bfhi(ku[3])};
        float qt[8], kt[8], qb[8];
#pragma unroll
        for (int j = 0; j < 8; ++j) {
            const float bi = Bf[i * 33 + d0 + j], bm = Bf[31 * 33 + d0 + j], bl = Bf[63 * 33 + d0 + j];
            qt[j] = qf[j] * __expf(bi - bm); kt[j] = kf[j] * __expf(bm - bi); qb[j] = qf[j] * __expf(bi);
            KLt[(d0 + j) * LROW + i] = f2bf(kf[j] * __expf(bl - bi));
            if (i == 63) ((float*)(scr + SCR_GLA_DL))[cid * 32 + d0 + j] = __expf(bl);
        }
        u32x4 o; o[0] = pk_bf16(qt[0], qt[1]); o[1] = pk_bf16(qt[2], qt[3]); o[2] = pk_bf16(qt[4], qt[5]); o[3] = pk_bf16(qt[6], qt[7]);
        *(u32x4*)(Qt + i * GQROW + d0) = o;
        o[0] = pk_bf16(kt[0], kt[1]); o[1] = pk_bf16(kt[2], kt[3]); o[2] = pk_bf16(kt[4], kt[5]); o[3] = pk_bf16(kt[6], kt[7]);
        *(u32x4*)(Kt + i * GQROW + d0) = o;
        o[0] = pk_bf16(qb[0], qb[1]); o[1] = pk_bf16(qb[2], qb[3]); o[2] = pk_bf16(qb[4], qb[5]); o[3] = pk_bf16(qb[6], qb[7]);
        *(u32x4*)((bf16_t*)(scr + SCR_GLA_QB) + (size_t)cid * 2048 + i * 32 + d0) = o;
    }
    __syncthreads();
    f32x4 sc[4];
    {
        bf16x8 bq = *(const bf16x8*)(Qt + (16 * w + fr) * GQROW + fg * 8);
#pragma unroll
        for (int mt = 0; mt < 4; ++mt) {
            bf16x8 a = *(const bf16x8*)(Kt + (16 * mt + fr) * GQROW + fg * 8);
            sc[mt] = __builtin_amdgcn_mfma_f32_16x16x32_bf16(a, bq, (f32x4){0.f, 0.f, 0.f, 0.f}, 0, 0, 0);
        }
        const int ii = 16 * w + fr;
#pragma unroll
        for (int mt = 0; mt < 4; ++mt)
#pragma unroll
            for (int r = 0; r < 4; ++r) { const int j = 16 * mt + 4 * fg + r; if (j > ii) sc[mt][r] = 0.f; }
    }
    {
        f32x4 o4[4]; zero4(o4);
#pragma unroll
        for (int kk = 0; kk < 2; ++kk) {
            u32x4 pb = {pk_bf16(sc[2 * kk][0], sc[2 * kk][1]), pk_bf16(sc[2 * kk][2], sc[2 * kk][3]), pk_bf16(sc[2 * kk + 1][0], sc[2 * kk + 1][1]), pk_bf16(sc[2 * kk + 1][2], sc[2 * kk + 1][3])};
#pragma unroll
            for (int mt = 0; mt < 4; ++mt) {
                uint2 v0 = *(const uint2*)(Vt + (16 * mt + fr) * LROW + 32 * kk + 4 * fg), v1 = *(const uint2*)(Vt + (16 * mt + fr) * LROW + 32 * kk + 16 + 4 * fg);
                u32x4 va = {v0.x, v0.y, v1.x, v1.y};
                o4[mt] = __builtin_amdgcn_mfma_f32_16x16x32_bf16(__builtin_bit_cast(bf16x8, va), __builtin_bit_cast(bf16x8, pb), o4[mt], 0, 0, 0);
            }
        }
        bf16_t* OL = (bf16_t*)(scr + SCR_GLA_OL) + (size_t)cid * 4096;
#pragma unroll
        for (int mt = 0; mt < 4; ++mt) store4_bf16(OL + (16 * w + fr) * 64 + 16 * mt + 4 * fg, o4[mt][0], o4[mt][1], o4[mt][2], o4[mt][3]);
    }
    {
        f32x4 k4[2] = {(f32x4){0.f, 0.f, 0.f, 0.f}, (f32x4){0.f, 0.f, 0.f, 0.f}};
#pragma unroll
        for (int ks = 0; ks < 2; ++ks) {
            bf16x8 bv = *(const bf16x8*)(Vt + (16 * w + fr) * LROW + ks * 32 + fg * 8);
#pragma unroll
            for (int mt = 0; mt < 2; ++mt) {
                bf16x8 a = *(const bf16x8*)(KLt + (16 * mt + fr) * LROW + ks * 32 + fg * 8);
                k4[mt] = __builtin_amdgcn_mfma_f32_16x16x32_bf16(a, bv, k4[mt], 0, 0, 0);
            }
        }
        float* KV = (float*)(scr + SCR_GLA_KV) + (size_t)cid * 2048;
#pragma unroll
        for (int mt = 0; mt < 2; ++mt) *(f32x4*)(KV + (16 * w + fr) * 32 + 16 * mt + 4 * fg) = k4[mt];
    }
}
__device__ void gla_scan_item(const Params& p, int g) {
    const int tid = ltid();
    const int bh = g >> 3, idx = (g & 7) * 256 + tid, d = idx & 31;
    char* scr = p.ws + WS_SCR;
    const float* __restrict__ KV = (const float*)(scr + SCR_GLA_KV) + (size_t)bh * 64 * 2048 + idx;
    const float* __restrict__ DL = (const float*)(scr + SCR_GLA_DL) + bh * 64 * 32 + d;
    bf16_t* __restrict__ SG = (bf16_t*)(scr + SCR_GLA_SG) + (size_t)bh * 64 * 2048 + idx;
    float S = 0.f;
    for (int n0 = 0; n0 < 64; n0 += 8) {
        float kv[8], dl[8];
#pragma unroll
        for (int u = 0; u < 8; ++u) { kv[u] = KV[(size_t)(n0 + u) * 2048]; dl[u] = DL[(n0 + u) * 32]; }
#pragma unroll
        for (int u = 0; u < 8; ++u) { SG[(size_t)(n0 + u) * 2048] = f2bf(S); S = dl[u] * S + kv[u]; }
    }
}
__device__ void gla_out_item(const Params& p, int l, int cid) {
    const int tid = ltid(), lane = tid & 63, w = tid >> 6, fr = lane & 15, fg = lane >> 4;
    const int bh = cid >> 6, n = cid & 63, b = bh / H_GLA, h = bh % H_GLA;
    char* scr = p.ws + WS_SCR;
    const bf16_t* SG = (const bf16_t*)(scr + SCR_GLA_SG) + (size_t)cid * 2048;
    const bf16_t* QB = (const bf16_t*)(scr + SCR_GLA_QB) + (size_t)cid * 2048;
    const bf16_t* OL = (const bf16_t*)(scr + SCR_GLA_OL) + (size_t)cid * 4096;
    const int i = 16 * w + fr; const int t = b * SEQ + n * 64 + i;
    f32x4 acc[4];
#pragma unroll
    for (int mt = 0; mt < 4; ++mt) { uint2 u = *(const uint2*)(OL + i * 64 + 16 * mt + 4 * fg); acc[mt] = (f32x4){bflo(u.x), bfhi(u.x), bflo(u.y), bfhi(u.y)}; }
    bf16x8 bq = *(const bf16x8*)(QB + i * 32 + fg * 8);
#pragma unroll
    for (int mt = 0; mt < 4; ++mt) {
        bf16x8 a = *(const bf16x8*)(SG + (16 * mt + fr) * 32 + fg * 8);
        acc[mt] = __builtin_amdgcn_mfma_f32_16x16x32_bf16(a, bq, acc[mt], 0, 0, 0);
    }
    float ss = 0.f;
#pragma unroll
    for (int mt = 0; mt < 4; ++mt)
#pragma unroll
        for (int r = 0; r < 4; ++r) ss += acc[mt][r] * acc[mt][r];
    ss += __shfl_xor(ss, 16, 64); ss += __shfl_xor(ss, 32, 64);
    const float rstd = rsqrtf(ss * (1.f / 64.f) + 1e-6f);
    const float* og = p.in[13] + l * 64;
    const bf16_t* rp = (const bf16_t*)(p.ws + WS_PROJ) + (size_t)t * NPROJ + NC_LR + h * 64;
    bf16_t* mp = (bf16_t*)(p.ws + WS_MIX) + pl_off(t, 768 + h * 64, 1024);
#pragma unroll
    for (int mt = 0; mt < 4; ++mt) {
        const int e0 = 16 * mt + 4 * fg;
        uint2 gu = *(const uint2*)(rp + e0); f32x4 g4 = *(const f32x4*)(og + e0);
        store4_bf16(mp + e0 + (e0 & 32), acc[mt][0] * rstd * g4[0] * bflo(gu.x), acc[mt][1] * rstd * g4[1] * bfhi(gu.x), acc[mt][2] * rstd * g4[2] * bflo(gu.y), acc[mt][3] * rstd * g4[3] * bfhi(gu.y));
    }
}
__device__ void phase_mixout(const Params& p, int l) {
    for (int it = blockIdx.x; it < NGDN_CH + NGLA_CH; it += gridDim.x) {
        if (it < NGDN_CH) { if (MIXSEL & 1) gdn_out_item(p, l, it); } else { if (MIXSEL & 2) gla_out_item(p, l, it - NGDN_CH); }
    }
}

__device__ void fox_cumsum_item(const Params& p, int l, int bh, float* ldsf) {
    const int tid = ltid(), lane = tid & 63, w = tid >> 6;
    const int b = bh / H_FOX, h = bh % H_FOX;
    const float* aux = (const float*)(p.ws + WS_AUX);
    float* cum = (float*)(p.ws + WS_CUM) + (size_t)bh * SEQ;
    const float fb = p.in[5][l * H_FOX + h];
    float v[16]; float s = 0.f;
#pragma unroll
    for (int i = 0; i < 16; ++i) { v[i] = logsigmoidf_(aux[(size_t)(b * SEQ + tid * 16 + i) * 64 + AX_FF + h] + fb); s += v[i]; }
    float inc = s;
#pragma unroll
    for (int o = 1; o < 64; o <<= 1) { float t = __shfl_up(inc, o, 64); if (lane >= o) inc += t; }
    __syncthreads();
    if (lane == 63) ldsf[w] = inc;
    __syncthreads();
    float base = inc - s;
    for (int ww = 0; ww < w; ++ww) base += ldsf[ww];
    float c = base;
    u32x4* csx = (u32x4*)(p.ws + WS_SCR + SCR_CSX) + (size_t)bh * SEQ;
#pragma unroll
    for (int i = 0; i < 16; ++i) {
        c += v[i]; cum[tid * 16 + i] = c;
        const float vv = 1.4426950408889634f * c;
        const unsigned hi = pk_bf16(vv, 0.f) & 0xffffu; const float r1 = vv - __uint_as_float(hi << 16);
        const unsigned mid = pk_bf16(r1, 0.f) & 0xffffu; const float r2 = r1 - __uint_as_float(mid << 16);
        const unsigned lo = pk_bf16(r2, 0.f) & 0xffffu;
        u32x4 f; f[0] = 0x3F803F80u; f[1] = 0x3F80u | ((hi ^ 0x8000u) << 16); f[2] = (mid ^ 0x8000u) | ((lo ^ 0x8000u) << 16); f[3] = 0u;
        csx[tid * 16 + i] = f;
    }
}
__device__ void phase_prep(const Params& p, int l, unsigned char* lds_raw) {
    const int n0 = BATCH * H_FOX, n1 = n0 + ((MIXSEL & 1) ? NGDN_CH : 0), n2 = n1 + ((MIXSEL & 2) ? NGLA_CH : 0);
    for (int it = blockIdx.x; it < n2; it += gridDim.x) {
        if (it < n0) { __syncthreads(); fox_cumsum_item(p, l, it, (float*)lds_raw); }
        else if (it < n1) gdn_prep_item(p, l, it - n0, lds_raw);
        else gla_prep_item(p, l, it - n1, lds_raw);
    }
}

typedef float f32x16 __attribute__((ext_vector_type(16)));
#define ATT_BUF 17408
#define ATT_THR 8.0f
#define ATT_NSTAGE 3
__device__ __forceinline__ void attn_issue(const bf16_t* const (&kp)[2], const bf16_t* const (&vp)[2], const bf16_t* cp, int s0, unsigned char* stage, int w) {
    bf16_t* Ks = (bf16_t*)stage; bf16_t* Vs = Ks + 4096; bf16_t* cs = Vs + 4096;
    __builtin_amdgcn_global_load_lds((const unsigned*)(kp[0] + (size_t)s0 * NPROJ), (unsigned*)(Ks + (w * 8) * 64), 16, 0, 0);
    __builtin_amdgcn_global_load_lds((const unsigned*)(kp[1] + (size_t)s0 * NPROJ), (unsigned*)(Ks + (32 + w * 8) * 64), 16, 0, 0);
    __builtin_amdgcn_global_load_lds((const unsigned*)(vp[0] + s0), (unsigned*)(Vs + (w * 8) * 64), 16, 0, 0);
    __builtin_amdgcn_global_load_lds((const unsigned*)(vp[1] + s0), (unsigned*)(Vs + (32 + w * 8) * 64), 16, 0, 0);
    __builtin_amdgcn_global_load_lds((const unsigned*)(cp + (size_t)s0 * 8), (unsigned*)cs, 16, 0, 0);
}
__device__ __forceinline__ bf16x8 attn_qbias(float u, int h) {
    const unsigned hi = pk_bf16(u, 0.f) & 0xffffu; const float r1 = u - __uint_as_float(hi << 16);
    const unsigned mid = pk_bf16(r1, 0.f) & 0xffffu; const float r2 = r1 - __uint_as_float(mid << 16);
    const unsigned lo = pk_bf16(r2, 0.f) & 0xffffu;
    u32x4 f; f[0] = hi | (mid << 16); f[1] = lo | (0x3F80u << 16); f[2] = 0x3F803F80u; f[3] = 0u;
    if (h) { f[0] = 0u; f[1] = 0u; f[2] = 0u; }
    return __builtin_bit_cast(bf16x8, f);
}
__device__ void fox_attn_item(const Params& p, int l, int bh, int qt, unsigned char* lds_raw) {
    const int tid = ltid(), lane = tid & 63, w = __builtin_amdgcn_readfirstlane(tid >> 6), r = lane & 31, h = lane >> 5;
    const int b = bh / H_FOX, hh = bh % H_FOX;
    const bf16_t* proj = (const bf16_t*)(p.ws + WS_PROJ);
    const bf16_t* kbase = proj + (size_t)b * SEQ * NPROJ + NC_FK + hh * 64;
    const bf16_t* vbase = (const bf16_t*)(p.ws + WS_VTF) + (size_t)bh * 64 * SEQ;
    const float* cum = (const float*)(p.ws + WS_CUM) + (size_t)bh * SEQ;
    const int qlo = qt * 128 + w * 32, q = qlo + r;
    bf16x8 qf[4];
    {
        const bf16_t* qrow = proj + (size_t)(b * SEQ + q) * NPROJ + NC_FQ + hh * 64;
#pragma unroll
        for (int kk = 0; kk < 4; ++kk) qf[kk] = *(const bf16x8*)(qrow + kk * 16 + h * 8);
    }
    const float cq2 = cum[q] * 1.4426950408889634f;
    float mref = 0.f;
    bf16x8 qx = attn_qbias(cq2 - mref, h);
    f32x16 o0, o1;
#pragma unroll
    for (int i = 0; i < 16; ++i) { o0[i] = 0.f; o1[i] = 0.f; }
    float lsum = 0.f;
    const int ntiles = 2 * qt + 2;
    const bf16_t* kp[2]; const bf16_t* vp[2];
    {
        const int row0 = w * 8 + (lane >> 3), pc = lane & 7;
        const int lc0 = (pc ^ ((row0 >> 1) & 7)) * 8;
        kp[0] = kbase + (size_t)row0 * NPROJ + lc0; kp[1] = kbase + (size_t)(row0 + 32) * NPROJ + lc0;
        vp[0] = vbase + (size_t)row0 * SEQ + lc0;   vp[1] = vbase + (size_t)(row0 + 32) * SEQ + lc0;
    }
    const bf16_t* cp = (const bf16_t*)(p.ws + WS_SCR + SCR_CSX) + (size_t)bh * SEQ * 8 + lane * 8;
    const int swr = (r >> 1) & 7;
    int jw; float zmax_bound;
    {
        float gq = fabsf(p.in[3][l * 64 + lane]), gk = fabsf(p.in[4][l * 64 + lane]);
#pragma unroll
        for (int o = 32; o > 0; o >>= 1) { gq = fmaxf(gq, __shfl_xor(gq, o, 64)); gk = fmaxf(gk, __shfl_xor(gk, o, 64)); }
        const float thr = 2.f * (1.4426950408889634f * 8.f * gq * gk) + 30.f;
        zmax_bound = 1.4426950408889634f * 8.f * gq * gk;
        const float cw = cum[qlo] * 1.4426950408889634f;
        const float ce = (lane < ntiles) ? cum[64 * lane + 63] * 1.4426950408889634f : 0.f;
        const unsigned long long keep = __ballot((lane < ntiles) && (cw - ce >= -thr));
        jw = keep ? (__ffsll((long long)keep) - 1) : (ntiles - 1);
    }
    volatile int* jshare = (volatile int*)(lds_raw + ATT_NSTAGE * ATT_BUF + 16);
    asm volatile("s_waitcnt vmcnt(0)" ::: "memory");
    RAW_BARRIER();
    if (tid == 0) *jshare = jw;
    RAW_BARRIER();
    const int jstart = *jshare;
    const bool no_rescale = (zmax_bound <= 64.f);
    attn_issue(kp, vp, cp, jstart * 64, lds_raw + (jstart % ATT_NSTAGE) * ATT_BUF, w);
    if (jstart + 1 < ntiles) attn_issue(kp, vp, cp, (jstart + 1) * 64, lds_raw + ((jstart + 1) % ATT_NSTAGE) * ATT_BUF, w);
    for (int j = jstart; j < ntiles; ++j) {
        if (j + 1 < ntiles) asm volatile("s_waitcnt vmcnt(5)" ::: "memory"); else asm volatile("s_waitcnt vmcnt(0)" ::: "memory");
        RAW_BARRIER();
        if (j + 2 < ntiles) attn_issue(kp, vp, cp, (j + 2) * 64, lds_raw + ((j + 2) % ATT_NSTAGE) * ATT_BUF, w);
        const int s0 = j * 64;
        if (s0 <= qlo + 31 && j >= jw) {
            const bf16_t* Ks = (const bf16_t*)(lds_raw + (j % ATT_NSTAGE) * ATT_BUF); const bf16_t* Vs = Ks + 4096; const bf16_t* cs = Vs + 4096;
            f32x16 st0, st1;
            {
                u32x4 z4 = {0u, 0u, 0u, 0u};
                u32x4 c0 = *(const u32x4*)(cs + r * 8), c1 = *(const u32x4*)(cs + (32 + r) * 8);
                if (h) { c0 = z4; c1 = z4; }
                f32x16 zz;
#pragma unroll
                for (int i = 0; i < 16; ++i) zz[i] = 0.f;
                st0 = __builtin_amdgcn_mfma_f32_32x32x16_bf16(__builtin_bit_cast(bf16x8, c0), qx, zz, 0, 0, 0);
                st1 = __builtin_amdgcn_mfma_f32_32x32x16_bf16(__builtin_bit_cast(bf16x8, c1), qx, zz, 0, 0, 0);
            }
#pragma unroll
            for (int kk = 0; kk < 4; ++kk) {
                const int co = ((kk * 2 + h) ^ swr) * 8;
                bf16x8 a0 = *(const bf16x8*)(Ks + r * 64 + co);
                bf16x8 a1 = *(const bf16x8*)(Ks + (32 + r) * 64 + co);
                st0 = __builtin_amdgcn_mfma_f32_32x32x16_bf16(a0, qf[kk], st0, 0, 0, 0);
                st1 = __builtin_amdgcn_mfma_f32_32x32x16_bf16(a1, qf[kk], st1, 0, 0, 0);
            }
            if (s0 + 63 > qlo) {
#pragma unroll
                for (int i = 0; i < 16; ++i) {
                    const int key = s0 + (i & 3) + 8 * (i >> 2) + 4 * h;
                    if (key > q) st0[i] = -1e30f;
                    if (key + 32 > q) st1[i] = -1e30f;
                }
            }
            float mx = 0.f;
            if (!no_rescale) {
                mx = fmaxf(st0[0], st1[0]);
#pragma unroll
                for (int i = 1; i < 16; ++i) mx = fmaxf(mx, fmaxf(st0[i], st1[i]));
            }
            if (!no_rescale && __any(mx > ATT_THR)) {
                const float mo = fmaxf(mx, __shfl_xor(mx, 32, 64));
                const float d = (mo > ATT_THR) ? mo : 0.f;
                const float alpha = __builtin_amdgcn_exp2f(-d);
#pragma unroll
                for (int i = 0; i < 16; ++i) { st0[i] -= d; st1[i] -= d; o0[i] *= alpha; o1[i] *= alpha; }
                lsum *= alpha; mref += d;
                qx = attn_qbias(cq2 - mref, h);
            }
            float rs = 0.f;
#pragma unroll
            for (int i = 0; i < 16; ++i) { st0[i] = __builtin_amdgcn_exp2f(st0[i]); st1[i] = __builtin_amdgcn_exp2f(st1[i]); rs += st0[i] + st1[i]; }
            lsum += rs;
            bf16x8 pf[2][2];
#pragma unroll
            for (int s = 0; s < 2; ++s) {
                u32x4 t0 = {pk_bf16(st0[8 * s], st0[8 * s + 1]), pk_bf16(st0[8 * s + 2], st0[8 * s + 3]), pk_bf16(st0[8 * s + 4], st0[8 * s + 5]), pk_bf16(st0[8 * s + 6], st0[8 * s + 7])};
                u32x4 t1 = {pk_bf16(st1[8 * s], st1[8 * s + 1]), pk_bf16(st1[8 * s + 2], st1[8 * s + 3]), pk_bf16(st1[8 * s + 4], st1[8 * s + 5]), pk_bf16(st1[8 * s + 6], st1[8 * s + 7])};
                pf[0][s] = __builtin_bit_cast(bf16x8, t0); pf[1][s] = __builtin_bit_cast(bf16x8, t1);
            }
#pragma unroll
            for (int mt = 0; mt < 2; ++mt)
#pragma unroll
                for (int s = 0; s < 2; ++s) {
                    const int c0 = 4 * mt + 2 * s;
                    const int oA = ((c0 ^ swr) * 8) + 4 * h, oB = (((c0 + 1) ^ swr) * 8) + 4 * h;
                    uint2 a00 = *(const uint2*)(Vs + r * 64 + oA), a01 = *(const uint2*)(Vs + r * 64 + oB);
                    uint2 a10 = *(const uint2*)(Vs + (32 + r) * 64 + oA), a11 = *(const uint2*)(Vs + (32 + r) * 64 + oB);
                    u32x4 u0 = {a00.x, a00.y, a01.x, a01.y}; u32x4 u1 = {a10.x, a10.y, a11.x, a11.y};
                    o0 = __builtin_amdgcn_mfma_f32_32x32x16_bf16(__builtin_bit_cast(bf16x8, u0), pf[mt][s], o0, 0, 0, 0);
                    o1 = __builtin_amdgcn_mfma_f32_32x32x16_bf16(__builtin_bit_cast(bf16x8, u1), pf[mt][s], o1, 0, 0, 0);
                }
        }
    }
    lsum += __shfl_xor(lsum, 32, 64);
    const float inv = 1.f / lsum;
    float ss = 0.f;
#pragma unroll
    for (int i = 0; i < 16; ++i) { o0[i] *= inv; o1[i] *= inv; ss += o0[i] * o0[i] + o1[i] * o1[i]; }
    ss += __shfl_xor(ss, 32, 64);
    const float rstd = rsqrtf(ss * (1.f / 64.f) + 1e-6f);
    const float* og = p.in[6] + l * 64;
    bf16_t* mrow = (bf16_t*)(p.ws + WS_MIX) + pl_off(b * SEQ + q, hh * 64, 1024);
#pragma unroll
    for (int g = 0; g < 4; ++g) {
        const int e0 = 8 * g + 4 * h;
        f32x4 g0 = *(const f32x4*)(og + e0), g1 = *(const f32x4*)(og + 32 + e0);
        store4_bf16(mrow + e0, o0[4 * g] * rstd * g0[0], o0[4 * g + 1] * rstd * g0[1], o0[4 * g + 2] * rstd * g0[2], o0[4 * g + 3] * rstd * g0[3]);
        store4_bf16(mrow + 64 + e0, o1[4 * g] * rstd * g1[0], o1[4 * g + 1] * rstd * g1[1], o1[4 * g + 2] * rstd * g1[2], o1[4 * g + 3] * rstd * g1[3]);
    }
}
#define ATT_ITEMS (BATCH * H_FOX * (SEQ / 128))
#define CONV_ITEMS ((CONV_REST + P0_T_IN + 3) / 4)
__device__ void phase_scan_attn(const Params& p, int l, unsigned char* lds_raw, int rep = 0, int sel = 7) {
    unsigned* qctr = (unsigned*)(p.ws + WS_CTL) + CW_Q + l + 2 * rep;
    volatile int* slot = (volatile int*)(lds_raw + ATT_NSTAGE * ATT_BUF);
    for (;;) {
        __syncthreads();
        if (threadIdx.x == 0) *slot = (int)atomicAdd(qctr, 1u);
        __syncthreads();
        int it = *slot;
        const int ns0 = (MIXSEL & 1) ? BATCH * H_GDN * 4 : 0, ns1 = ns0 + ((MIXSEL & 2) ? 128 : 0);
        if (it >= ns1 + ATT_ITEMS + CONV_ITEMS) break;
        if (it >= ns1) {
            const int c = it - ns1;
            int conv_idx = -1;
            if (c < 5 * ATT_ITEMS) { if (c % 5 != 0) conv_idx = c - c / 5 - 1; } else conv_idx = c - ATT_ITEMS;
            if (conv_idx >= 0) {
                if (rep == 0 && conv_idx < CONV_ITEMS) conv_fold4(p, l, conv_idx * 4, ltid());
                continue;
            }
            it = ns1 + c / 5;
        }
        if (it < ns0) { if (sel & 1) gdn_scan_item(p, it, lds_raw, rep ? SVAR : 0); continue; }
        if (it < ns1) { if (sel & 2) gla_scan_item(p, it - ns0); continue; }
        it -= ns1;
        if (!(sel & 4)) continue;
        const int qt = (SEQ / 128 - 1) - it / (BATCH * H_FOX), bh = it % (BATCH * H_FOX);
        fox_attn_item(p, l, bh, qt, lds_raw);
    }
}

#define NPHASE 19
__global__ void __launch_bounds__(256, 2) mk(Params p, int lo, int hi, int use_bar) {
    __shared__ __attribute__((aligned(16))) unsigned char lds_raw[LDS_BYTES];
    bf16_t* lds = (bf16_t*)lds_raw;
    volatile LAS unsigned* st = (volatile LAS unsigned*)(lds_raw + LDS_BYTES - 16);
    XcdBarrier bar; bar.bar = (unsigned*)(p.ws + WS_CTL) + CW_BAR; bar.x = 0; bar.st = st;
    if (use_bar) {
        if (threadIdx.x == 0) { st[0] = 0u; st[1] = 0u; }
        __syncthreads();
        bar = xcd_barrier_post((unsigned*)(p.ws + WS_CTL) + CW_BAR, st);
    }
    for (int ph = lo; ph < hi; ++ph) {
#ifndef PSEL
#define PSEL 0xffff
#endif
        int phv = ph; asm volatile("" : "+s"(phv));
        size_t zoff = 0; asm volatile("" : "+s"(zoff));
        Params q = p; q.ws = p.ws + zoff; q.out = p.out + zoff;
        if (phv == 0) { if (PSEL & 1) phase0(q); }
        else {
            int l = (phv - 1) / 9, s = (phv - 1) % 9;
            if (s == 0) { if (PSEL & 2) phase_inproj(q, l, lds); }
            else if (s == 1) { if (PSEL & 128) phase_prep(q, l, lds_raw); }
            else if (s == 2) { if (PSEL & 256) phase_scan_attn(q, l, lds_raw); }
            else if (s == 3) { if (PSEL & 512) phase_mixout(q, l); }
            else if (s == 4) { if (PSEL & 4) phase_outproj(q, l, lds); }
            else if (s == 5) { if (PSEL & 8) phase_route(q, l, lds); }
            else if (s == 6) { if (PSEL & 16) phase_expert<0>(q, l, lds); }
            else if (s == 7) { if (PSEL & 32) phase_expert<1>(q, l, lds); }
            else if (s == 8) { if (PSEL & 64) phase_combine(q, l); }
        }
#ifdef REPEAT_MASK
        {
            const int ty = (phv == 0) ? 9 : (phv - 1) % 9, l = (phv == 0) ? 0 : (phv - 1) / 9;
            const bool idem = !((ty == 4 && l == 1));
            if (((REPEAT_MASK >> ty) & 1) && idem && use_bar) {
                xcd_barrier(bar);
                if (ty == 9) phase0(q);
                else if (ty == 0) phase_inproj(q, l, lds, GVAR);
                else if (ty == 1) phase_prep(q, l, lds_raw);
                else if (ty == 2) phase_scan_attn(q, l, lds_raw, 1, P3SEL);
                else if (ty == 3) phase_mixout(q, l);
                else if (ty == 4) phase_outproj(q, l, lds);
                else if (ty == 5) phase_route(q, l, lds, 1);
                else if (ty == 8) phase_combine(q, l, 1);
                else if (ty == 6) phase_expert<0>(q, l, lds);
                else if (ty == 7) phase_expert<1>(q, l, lds);
            }
        }
#endif
        if (ph + 1 < hi) {
            if (hi > 1000) cg::this_grid().sync();
            xcd_barrier(bar);
        }
    }
}

extern "C" void kernel_launch(void* const* d_in, const int* in_sizes, int n_in,
                              void* d_out, int out_size, void* d_ws, size_t ws_size,
                              hipStream_t stream) {
    static int grid = 0;
    if (grid == 0) {
        if (ws_size < WS_END) { fprintf(stderr, "ws too small: need %zu have %zu\n", (size_t)WS_END, ws_size); grid = -1; return; }
        int dev = 0, cus = 0, per_cu = 0;
        hipGetDevice(&dev);
        hipDeviceGetAttribute(&cus, hipDeviceAttributeMultiprocessorCount, dev);
        hipOccupancyMaxActiveBlocksPerMultiprocessor(&per_cu, mk, 256, 0);
        if (per_cu > 2) per_cu = 2;
        if (per_cu < 1) { fprintf(stderr, "occupancy query failed\n"); grid = -1; return; }
        grid = cus * per_cu;
        grid -= grid % 8;
    }
    if (grid < 0) return;
    Params p{};
    for (int i = 0; i < 23; ++i) p.in[i] = (const float*)d_in[i];
    p.out = (float*)d_out; p.ws = (char*)d_ws;
    hipMemsetAsync((char*)d_ws + WS_CTL, 0, CTL_BYTES, stream);
#ifdef POISON_GLA
    hipMemsetAsync((char*)d_ws + WS_SCR + SCR_GLA_OL, 0xFF, SCR_LVT - SCR_GLA_OL, stream);
#endif

#ifdef MULTI_LAUNCH
    for (int ph = 0; ph < NPHASE; ++ph) mk<<<grid, 256, 0, stream>>>(p, ph, ph + 1, 0);
#else
    int lo = 0, hi = NPHASE, ub = 2;
    void* args[] = {&p, &lo, &hi, &ub};
    hipError_t e = hipLaunchCooperativeKernel((void*)mk, dim3(grid), dim3(256), args, 0, stream);
    if (e != hipSuccess) fprintf(stderr, "cooperative launch failed: %s (grid %d)\n", hipGetErrorString(e), grid);
#endif
}
```

```cpp
#include <hip/hip_runtime.h>
#include <hip/hip_cooperative_groups.h>
#include <cstdint>
#include <cstdio>
namespace cg = cooperative_groups;

#define D_MODEL 1024
#define BATCH 4
#define SEQ 4096
#define NTOK (BATCH * SEQ)
#define H_FOX 6
#define H_GDN 6
#define H_GLA 4
#define N_IN 3490
#define N_EXP 32
#define D_EXP 512
#define NPROJ 3456
#define NINP 3584

#define C_FF 1152
#define C_GQ 1158
#define C_GG 2310
#define C_GA 2694
#define C_GB 2700
#define C_LQ 2706
#define C_LA 3474
#define NC_FQ 0
#define NC_FK 384
#define NC_FV 768
#define NC_GQ 1152
#define NC_GK 1536
#define NC_GV 1920
#define NC_GG 2304
#define NC_LQ 2688
#define NC_LK 2816
#define NC_LV 2944
#define NC_LR 3200
#define AX_FF 0
#define AX_GA 6
#define AX_GB 12
#define AX_LA 18

#ifndef SVAR
#define SVAR 0
#endif
#ifndef P3SEL
#define P3SEL 7
#endif
#ifndef GVAR
#define GVAR 0
#endif
#ifndef MIXSEL
#define MIXSEL 3
#endif
typedef unsigned short bf16_t;
typedef short bf16x8 __attribute__((ext_vector_type(8)));
typedef float f32x4 __attribute__((ext_vector_type(4)));
typedef unsigned u32x4 __attribute__((ext_vector_type(4)));
typedef unsigned u32x2 __attribute__((ext_vector_type(2)));

#define WS_CTL      0
#define CTL_BYTES   262144
#define WS_WIN      (WS_CTL + CTL_BYTES)
#define WS_WOUT     (WS_WIN + (size_t)2 * NINP * 1024 * 2)
#define WS_WGU      (WS_WOUT + (size_t)2 * 1024 * 1024 * 2)
#define WS_WD       (WS_WGU + (size_t)2 * 32 * 1024 * 1024 * 2)
#define WS_WR       (WS_WD + (size_t)2 * 32 * 1024 * 512 * 2)
#define WS_HN       (WS_WR + (size_t)2 * 64 * 1024 * 2)
#define WS_PROJ     (WS_HN + (size_t)NTOK * 1024 * 2)
#define WS_VTF      (WS_PROJ + (size_t)NTOK * NPROJ * 2)
#define WS_AUX      (WS_VTF + (size_t)BATCH * H_FOX * 64 * SEQ * 2)
#define WS_CUM      (WS_AUX + (size_t)NTOK * 64 * 4)
#define WS_MIX      (WS_CUM + (size_t)BATCH * H_FOX * SEQ * 4)
#define WS_ROWTOK   (WS_MIX + (size_t)NTOK * 1024 * 2)
#define WS_TSLOT    (WS_ROWTOK + (size_t)32 * NTOK * 4)
#define WS_TGATE    (WS_TSLOT + (size_t)NTOK * 2 * 4)
#define WS_SCR      (WS_TGATE + (size_t)NTOK * 2 * 4)
#define SCR_BYTES   ((size_t)100 * 1024 * 1024)
#define WS_END      (WS_SCR + SCR_BYTES)
#define HROWS       (2 * NTOK + 32 * 128)
#define WS_H        WS_PROJ
#define WS_Y        (WS_PROJ + (size_t)HROWS * 512 * 2)

#define NGDN_CH 1536
#define NGLA_CH 1024
#define SCR_GDN_MP   ((size_t)0)
#define SCR_GDN_NN   (SCR_GDN_MP + (size_t)NGDN_CH * 8192)
#define SCR_GDN_P    (SCR_GDN_NN + (size_t)NGDN_CH * 8192)
#define SCR_GDN_OL   (SCR_GDN_P  + (size_t)NGDN_CH * 8192)
#define SCR_GDN_SG   (SCR_GDN_OL + (size_t)NGDN_CH * 8192)
#define SCR_GDN_LAST (SCR_GDN_SG + (size_t)NGDN_CH * 8192)
#define SCR_GLA_OL   (SCR_GDN_LAST + (size_t)NGDN_CH * 4)
#define SCR_GLA_KV   (SCR_GLA_OL + (size_t)NGLA_CH * 8192)
#define SCR_GLA_QB   (SCR_GLA_KV + (size_t)NGLA_CH * 8192)
#define SCR_GLA_SG   (SCR_GLA_QB + (size_t)NGLA_CH * 4096)
#define SCR_GLA_DL   (SCR_GLA_SG + (size_t)NGLA_CH * 4096)
#define SCR_LVT      (SCR_GLA_DL + (size_t)NGLA_CH * 128)
#define SCR_USED     (SCR_LVT + (size_t)BATCH * H_GLA * 64 * SEQ * 2)
#define SCR_XB       ((size_t)0)
#define SCR_CSX      SCR_USED
static_assert(SCR_CSX + (size_t)BATCH * H_FOX * SEQ * 16 <= SCR_BYTES, "scratch overflow");
#define CW_BAR      0
#define CW_CNT      4096
#define CNT_STRIDE  64
#define NSH         8
#define SHCAP       2048
#define CW_Q        (CW_CNT + 2 * 32 * NSH * CNT_STRIDE + 64)
#define CW_MOETAB   (CW_Q + 256)

struct Params {
    const float* in[23];
    float* out;
    char* ws;
};

__device__ __forceinline__ float sigmoidf_(float x) { return __builtin_amdgcn_rcpf(1.f + __expf(-x)); }
__device__ __forceinline__ float siluf_(float x) { return x * __builtin_amdgcn_rcpf(1.f + __expf(-x)); }
__device__ __forceinline__ float softplusf_(float x) { return x > 20.f ? x : __logf(1.f + __expf(x)); }
__device__ __forceinline__ float logsigmoidf_(float x) { return -softplusf_(-x); }
__device__ __forceinline__ float wave_sum(float v) {
#pragma unroll
    for (int o = 32; o > 0; o >>= 1) v += __shfl_xor(v, o, 64);
    return v;
}
__device__ __forceinline__ int ltid() { int t = threadIdx.x; asm volatile("" : "+v"(t)); return t; }
typedef __bf16 bf16x2_t __attribute__((ext_vector_type(2)));
typedef float f32x2_t __attribute__((ext_vector_type(2)));
__device__ __forceinline__ unsigned pk_bf16(float lo, float hi) { f32x2_t v = {lo, hi}; bf16x2_t r = __builtin_convertvector(v, bf16x2_t); return __builtin_bit_cast(unsigned, r); }
__device__ __forceinline__ size_t pl_off(int row, int k, int K) { return (size_t)(row >> 1) * (size_t)(2 * K) + (size_t)((k >> 5) * 64 + (row & 1) * 32 + (k & 31)); }
__device__ __forceinline__ unsigned ld_u32_agent(const unsigned* p) { return __hip_atomic_load(p, __ATOMIC_RELAXED, __HIP_MEMORY_SCOPE_AGENT); }
__device__ __forceinline__ float ld_f32_agent(const float* p) { return __uint_as_float(__hip_atomic_load((const unsigned*)p, __ATOMIC_RELAXED, __HIP_MEMORY_SCOPE_AGENT)); }
__device__ __forceinline__ float bf2f(bf16_t v) { return __uint_as_float((unsigned)v << 16); }
__device__ __forceinline__ float bflo(unsigned v) { return __uint_as_float(v << 16); }
__device__ __forceinline__ float bfhi(unsigned v) { return __uint_as_float(v & 0xffff0000u); }

#define XB_TMO      128
#define XB_XCNT(j)  (256  + 64 * (j))
#define XB_XSUB(j)  (1280 + 64 * (j))
#define XB_XGEN(j)  (2304 + 64 * (j))
#define XB_TOP      3328
#define XB_TOPGEN   3392
#define XCD_BAR_WORDS 3456
#define XB_SPIN_CAP (1u << 22)
#define LAS __attribute__((address_space(3)))
__device__ __forceinline__ unsigned xb_ld(unsigned* p)              { return __hip_atomic_load(p, __ATOMIC_RELAXED, __HIP_MEMORY_SCOPE_AGENT); }
__device__ __forceinline__ unsigned xb_add(unsigned* p, unsigned v) { return __hip_atomic_fetch_add(p, v, __ATOMIC_RELAXED, __HIP_MEMORY_SCOPE_AGENT); }
__device__ __forceinline__ unsigned xb_xcc_id() { return (unsigned)__builtin_amdgcn_s_getreg((3 << 11) | 20) & 0xFu; }
#define XB_SPIN(cond, bar) do { unsigned _sp = 0; while (cond) { if (_sp < 16u) __builtin_amdgcn_s_sleep(2); else __builtin_amdgcn_s_sleep(20);     \
    if ((++_sp & 255u) == 0u) { if (xb_ld(&(bar)[XB_TMO])) break; if (_sp > XB_SPIN_CAP) { atomicAdd(&(bar)[XB_TMO], 1u); break; } } } } while (0)
struct XcdBarrier { unsigned* bar; unsigned x; volatile LAS unsigned* st; };
__device__ __forceinline__ XcdBarrier xcd_barrier_post(unsigned* bar, volatile LAS unsigned* st) {
    XcdBarrier b; b.bar = bar; b.x = xb_xcc_id(); b.st = st;
    if (threadIdx.x == 0) (void)xb_add(&bar[XB_XCNT(b.x)], 1u);
    return b;
}
__device__ __forceinline__ void xcd_barrier_complete(unsigned* bar, unsigned x, unsigned& nloc, unsigned& nx) {
    const unsigned G = gridDim.x * gridDim.y * gridDim.z;
    unsigned sum, cnt, mine, sp = 0u;
    for (;;) {
        sum = 0u; cnt = 0u; mine = 0u;
#pragma unroll
        for (unsigned j = 0; j < 16; ++j) { const unsigned c = xb_ld(&bar[XB_XCNT(j)]); sum += c; cnt += (c > 0u) ? 1u : 0u; mine = (j == x) ? c : mine; }
        if (sum == G) break;
        __builtin_amdgcn_s_sleep(1);
        if ((++sp & 255u) == 0u) { if (xb_ld(&bar[XB_TMO])) break; if (sp > XB_SPIN_CAP) { atomicAdd(&bar[XB_TMO], 1u); break; } }
    }
    nloc = mine > 0u ? mine : 1u; nx = cnt > 0u ? cnt : 1u;
}
__device__ __forceinline__ void xcd_barrier(const XcdBarrier& b) {
    asm volatile("s_waitcnt vmcnt(0)" ::: "memory");
    __syncthreads();
    if (threadIdx.x == 0) {
        unsigned* bar = b.bar;
        __builtin_amdgcn_s_waitcnt(0);
        unsigned nloc = b.st[0], nx = b.st[1];
        if (nloc == 0u) { xcd_barrier_complete(bar, b.x, nloc, nx); b.st[0] = nloc; b.st[1] = nx; }
        const unsigned old = xb_add(&bar[XB_XSUB(b.x)], 1u);
        const unsigned gen = old / nloc;
        if (old + 1u == (gen + 1u) * nloc) {
            __builtin_amdgcn_fence(__ATOMIC_RELEASE, "agent");
            asm volatile("s_waitcnt vmcnt(0)" ::: "memory");
            const unsigned og = xb_add(&bar[XB_TOP], 1u);
            const unsigned tg = og / nx;
            if (og + 1u == (tg + 1u) * nx) xb_add(&bar[XB_TOPGEN], 1u);
            else XB_SPIN(xb_ld(&bar[XB_TOPGEN]) == tg, bar);
            __builtin_amdgcn_fence(__ATOMIC_ACQUIRE, "agent");
            xb_add(&bar[XB_XGEN(b.x)], 1u);
            asm volatile("s_waitcnt vmcnt(0)" ::: "memory");
        } else {
            XB_SPIN(xb_ld(&bar[XB_XGEN(b.x)]) == gen, bar);
            __builtin_amdgcn_fence(__ATOMIC_ACQUIRE, "agent");
            asm volatile("s_waitcnt vmcnt(0)" ::: "memory");
        }
    }
    __syncthreads();
}

#define LDS_BYTES 68096
#define LROW 72

__device__ __forceinline__ int inproj_map(int n) {
    if (n < 1152) return n;
    if (n < 2304) return C_GQ + (n - 1152);
    if (n < 2688) return C_GG + (n - 2304);
    if (n < 3456) return C_LQ + (n - 2688);
    if (n < 3462) return C_FF + (n - 3456);
    if (n < 3468) return C_GA + (n - 3462);
    if (n < 3474) return C_GB + (n - 3468);
    if (n < 3490) return n;
    return -1;
}
#define P0_T_IN   (56 * 16)
#define P0_T_OUT  (16 * 16)
#define P0_T_GU   (32 * 16 * 16)
#define P0_T_D    (32 * 16 * 8)
#define P0_T_R    (16)
#define P0_T_LAYER (P0_T_IN + P0_T_OUT + P0_T_GU + P0_T_D + P0_T_R)
#define P0_T_NORM (NTOK / 4)
struct ConvDesc { const float* src; bf16_t* dst; int ld; int col; };
__device__ __forceinline__ ConvDesc conv_desc(const Params& p, int l, int j, int tid) {
    const int nl = tid & 63, kg = tid >> 6;
    ConvDesc d;
    if (j < P0_T_IN) {
        int tn = j / 16, tk = j % 16; int n = tn * 64 + nl; int k0 = tk * 64 + kg * 16;
        d.ld = N_IN; d.col = inproj_map(n); d.src = p.in[2] + (size_t)l * 1024 * N_IN + (size_t)k0 * N_IN;
        d.dst = (bf16_t*)(p.ws + WS_WIN) + (size_t)l * NINP * 1024 + pl_off(n, k0, 1024);
        return d;
    }
    j -= P0_T_IN;
    if (j < P0_T_OUT) {
        int tn = j / 16, tk = j % 16; int n = tn * 64 + nl; int k0 = tk * 64 + kg * 16;
        d.ld = 1024; d.col = n; d.src = p.in[14] + (size_t)l * 1024 * 1024 + (size_t)k0 * 1024;
        d.dst = (bf16_t*)(p.ws + WS_WOUT) + (size_t)l * 1024 * 1024 + pl_off(n, k0, 1024);
        return d;
    }
    j -= P0_T_OUT;
    if (j < P0_T_GU) {
        int e = j / 256, r = j % 256; int tn = r / 16, tk = r % 16; int n = tn * 64 + nl; int k0 = tk * 64 + kg * 16;
        int t128 = n >> 7, wx = (n >> 6) & 1, half = (n >> 5) & 1, jj = n & 31;
        d.ld = 512; d.col = t128 * 64 + wx * 32 + jj;
        d.src = (half ? p.in[21] : p.in[20]) + ((size_t)l * 32 + e) * 1024 * 512 + (size_t)k0 * 512;
        d.dst = (bf16_t*)(p.ws + WS_WGU) + ((size_t)l * 32 + e) * 1024 * 1024 + pl_off(n, k0, 1024);
        return d;
    }
    j -= P0_T_GU;
    if (j < P0_T_D) {
        int e = j / 128, r = j % 128; int tn = r / 8, tk = r % 8; int n = tn * 64 + nl; int k0 = tk * 64 + kg * 16;
        d.ld = 1024; d.col = n; d.src = p.in[22] + ((size_t)l * 32 + e) * 512 * 1024 + (size_t)k0 * 1024;
        d.dst = (bf16_t*)(p.ws + WS_WD) + ((size_t)l * 32 + e) * 1024 * 512 + pl_off(n, k0, 512);
        return d;
    }
    j -= P0_T_D;
    {
        int tk = j; int n = nl; int k0 = tk * 64 + kg * 16;
        if (n < 4) { d.src = p.in[16] + (size_t)l * 1024 * 4 + (size_t)k0 * 4; d.ld = 4; d.col = n; }
        else if (n < 36) { d.src = p.in[18] + (size_t)l * 1024 * 32 + (size_t)k0 * 32; d.ld = 32; d.col = n - 4; }
        else { d.src = p.in[16]; d.ld = 4; d.col = -1; }
        d.dst = (bf16_t*)(p.ws + WS_WR) + ((size_t)l * 64 + n) * 1024 + k0;
        return d;
    }
}
__device__ __forceinline__ void conv_load(const ConvDesc& d, float (&v)[16]) {
    if (d.col >= 0) {
#pragma unroll
        for (int i = 0; i < 16; ++i) v[i] = d.src[(size_t)i * d.ld + d.col];
    } else {
#pragma unroll
        for (int i = 0; i < 16; ++i) v[i] = 0.f;
    }
}
__device__ __forceinline__ void conv_store(const ConvDesc& d, const float (&v)[16]) {
    uint4 o0, o1;
    o0.x = pk_bf16(v[0], v[1]); o0.y = pk_bf16(v[2], v[3]); o0.z = pk_bf16(v[4], v[5]); o0.w = pk_bf16(v[6], v[7]);
    o1.x = pk_bf16(v[8], v[9]); o1.y = pk_bf16(v[10], v[11]); o1.z = pk_bf16(v[12], v[13]); o1.w = pk_bf16(v[14], v[15]);
    *(uint4*)(d.dst) = o0;
    *(uint4*)(d.dst + 8) = o1;
}
__device__ __forceinline__ void conv_job(const Params& p, int l, int j, int tid) {
    ConvDesc d = conv_desc(p, l, j, tid); float v[16]; conv_load(d, v); conv_store(d, v);
}
#define CONV_REST (P0_T_LAYER - P0_T_IN)
__device__ __forceinline__ bool conv_fold_desc(const Params& p, int l, int idx, int tid, ConvDesc& d) {
    if (idx < CONV_REST) { d = conv_desc(p, l, P0_T_IN + idx, tid); return true; }
    if (l == 0 && idx < CONV_REST + P0_T_IN) { d = conv_desc(p, 1, idx - CONV_REST, tid); return true; }
    return false;
}
__device__ __forceinline__ void conv_fold4(const Params& p, int l, int idx0, int tid) {
    ConvDesc d0, d1, d2, d3; float v0[16], v1[16], v2[16], v3[16];
    const bool b0 = conv_fold_desc(p, l, idx0, tid, d0), b1 = conv_fold_desc(p, l, idx0 + 1, tid, d1), b2 = conv_fold_desc(p, l, idx0 + 2, tid, d2), b3 = conv_fold_desc(p, l, idx0 + 3, tid, d3);
    if (b0) conv_load(d0, v0); if (b1) conv_load(d1, v1); if (b2) conv_load(d2, v2); if (b3) conv_load(d3, v3);
    if (b0) conv_store(d0, v0); if (b1) conv_store(d1, v1); if (b2) conv_store(d2, v2); if (b3) conv_store(d3, v3);
}
__device__ void phase0(const Params& p) {
    const int tid = ltid(), nl = tid & 63, kg = tid >> 6;
    const int total = P0_T_IN + P0_T_NORM;
    for (int it = blockIdx.x; it < total; it += gridDim.x) {
        if (it >= P0_T_IN) {
            int row = (it - P0_T_IN) * 4 + kg;
            const float* xr = p.in[0] + (size_t)row * D_MODEL + nl * 16;
            const float* gr = p.in[1] + nl * 16;
            float v[16]; float ss = 0.f;
#pragma unroll
            for (int i = 0; i < 4; ++i) { float4 t = *(const float4*)(xr + 4 * i); v[4 * i] = t.x; v[4 * i + 1] = t.y; v[4 * i + 2] = t.z; v[4 * i + 3] = t.w; }
#pragma unroll
            for (int i = 0; i < 16; ++i) ss += v[i] * v[i];
            ss = wave_sum(ss);
            float r = rsqrtf(ss / D_MODEL + 1e-6f);
#pragma unroll
            for (int i = 0; i < 16; ++i) v[i] = v[i] * r * gr[i];
            uint4 o0, o1;
            o0.x = pk_bf16(v[0], v[1]); o0.y = pk_bf16(v[2], v[3]); o0.z = pk_bf16(v[4], v[5]); o0.w = pk_bf16(v[6], v[7]);
            o1.x = pk_bf16(v[8], v[9]); o1.y = pk_bf16(v[10], v[11]); o1.z = pk_bf16(v[12], v[13]); o1.w = pk_bf16(v[14], v[15]);
            bf16_t* hr = (bf16_t*)(p.ws + WS_HN) + pl_off(row, nl * 16, 1024);
            *(uint4*)hr = o0; *(uint4*)(hr + 8) = o1;
            continue;
        }
        conv_job(p, 0, it, tid);
    }
}

#define GSTAGE 8192
#define RAW_BARRIER() do { asm volatile("s_waitcnt lgkmcnt(0)" ::: "memory"); __builtin_amdgcn_s_barrier(); } while (0)
__device__ __forceinline__ int gswz(int row) { return (0x1320 >> (((row >> 2) & 3) * 4)) & 3; }
__device__ __forceinline__ void gemm_issue(const bf16_t* const (&px)[2], const bf16_t* const (&py)[2], int k0, bf16_t* stage, int w) {
    __builtin_amdgcn_global_load_lds((const unsigned*)(px[0] + 2 * k0), (unsigned*)(stage + (w * 16) * 32), 16, 0, 0);
    __builtin_amdgcn_global_load_lds((const unsigned*)(px[1] + 2 * k0), (unsigned*)(stage + (64 + w * 16) * 32), 16, 0, 0);
    __builtin_amdgcn_global_load_lds((const unsigned*)(py[0] + 2 * k0), (unsigned*)(stage + 4096 + (w * 16) * 32), 16, 0, 0);
    __builtin_amdgcn_global_load_lds((const unsigned*)(py[1] + 2 * k0), (unsigned*)(stage + 4096 + (64 + w * 16) * 32), 16, 0, 0);
}
__device__ __forceinline__ void gemm_compute(const bf16_t* stage, int wx, int wy, int fr, int fg, f32x4 (&acc)[4][4]) {
    const int co = (fg ^ gswz(fr)) * 8;
    bf16x8 xa[4], yb[4];
#pragma unroll
    for (int m = 0; m < 4; ++m) xa[m] = *(const bf16x8*)(stage + (wx * 64 + m * 16 + fr) * 32 + co);
#pragma unroll
    for (int n = 0; n < 4; ++n) yb[n] = *(const bf16x8*)(stage + 4096 + (wy * 64 + n * 16 + fr) * 32 + co);
    __builtin_amdgcn_s_setprio(1);
#pragma unroll
    for (int m = 0; m < 4; ++m)
#pragma unroll
        for (int n = 0; n < 4; ++n) acc[m][n] = __builtin_amdgcn_mfma_f32_16x16x32_bf16(xa[m], yb[n], acc[m][n], 0, 0, 0);
    __builtin_amdgcn_s_setprio(0);
}
template <class FX, class FY>
__device__ __forceinline__ void gemm_core(FX rowx, FY rowy, int K, bf16_t* lds, f32x4 (&acc)[4][4], int gvar = 0) {
    const int tid = ltid(), lane = tid & 63, w = __builtin_amdgcn_readfirstlane(tid >> 6), wx = w >> 1, wy = w & 1, fr = lane & 15, fg = lane >> 4;
#pragma unroll
    for (int a = 0; a < 4; ++a)
#pragma unroll
        for (int b = 0; b < 4; ++b) acc[a][b] = (f32x4){0.f, 0.f, 0.f, 0.f};
    const bf16_t* px[2]; const bf16_t* py[2];
    {
        const int r0 = w * 16 + (lane >> 2), pc = lane & 3;
        const int lc0 = (pc ^ gswz(r0)) * 8;
        px[0] = rowx(r0) + lc0; px[1] = rowx(r0 + 64) + lc0;
        py[0] = rowy(r0) + lc0; py[1] = rowy(r0 + 64) + lc0;
    }
    const int nt = K >> 5;
    RAW_BARRIER();
    if (gvar != 3) {
    gemm_issue(px, py, 0, lds, w);
    gemm_issue(px, py, 32, lds + GSTAGE, w);
    gemm_issue(px, py, 64, lds + 2 * GSTAGE, w);
    }
    for (int j = 0; j < nt; ++j) {
        if (j + 2 < nt) asm volatile("s_waitcnt vmcnt(8)" ::: "memory");
        else if (j + 1 < nt) asm volatile("s_waitcnt vmcnt(4)" ::: "memory");
        else asm volatile("s_waitcnt vmcnt(0)" ::: "memory");
        RAW_BARRIER();
        if (j + 3 < nt && gvar != 3) gemm_issue(px, py, (j + 3) * 32, lds + ((j + 3) & 3) * GSTAGE, w);
        if (gvar != 2) gemm_compute(lds + (j & 3) * GSTAGE, wx, wy, fr, fg, acc);
    }
}
__device__ __forceinline__ void store4_bf16(bf16_t* p, float a, float b, float c, float d) {
    uint2 o; o.x = pk_bf16(a, b); o.y = pk_bf16(c, d); *(uint2*)p = o;
}
template <int NC> __device__ __forceinline__ void ep_put(bf16_t* T, int row, int col, float a, float b, float c, float d) {
    uint2 o; o.x = pk_bf16(a, b); o.y = pk_bf16(c, d); *(uint2*)(T + row * (NC + 8) + col) = o;
}
template <int NC, class FD> __device__ __forceinline__ void ep_flush(const bf16_t* T, int tid, FD dst) {
    constexpr int CPR = NC / 8;
#pragma unroll
    for (int i = 0; i < NC / 16; ++i) {
        const int c = tid + 256 * i; const int row = c / CPR, ch = c % CPR;
        *(u32x4*)(dst(row, ch)) = *(const u32x4*)(T + row * (NC + 8) + ch * 8);
    }
}

__device__ __forceinline__ bool xcd_item(int round, int ntm, int ntn, int& tm, int& tn) {
    const int x = blockIdx.x & 7, loc = blockIdx.x >> 3, nloc = gridDim.x >> 3;
    const int tmx = ntm >> 3;
    const int j = round * nloc + loc;
    if (j >= tmx * ntn) return false;
    tn = j / tmx; tm = (j % tmx) * 8 + x;
    return true;
}

__device__ void phase_inproj(const Params& p, int l, bf16_t* lds, int gvar = 0) {
    const int tid = ltid(), lane = tid & 63, w = tid >> 6, wx = w >> 1, wy = w & 1, fr = lane & 15, fg = lane >> 4;
    const bf16_t* hn = (const bf16_t*)(p.ws + WS_HN);
    const bf16_t* wt = (const bf16_t*)(p.ws + WS_WIN) + (size_t)l * NINP * 1024;
    bf16_t* proj = (bf16_t*)(p.ws + WS_PROJ);
    bf16_t* vtf = (bf16_t*)(p.ws + WS_VTF);
    float* aux = (float*)(p.ws + WS_AUX);
    const float* qg = p.in[3] + l * 64; const float* kg = p.in[4] + l * 64;
    for (int round = 0;; ++round) {
        int tm, tn;
        if (gridDim.x == 512) {
            if (round >= 7) break;
            const int x = blockIdx.x & 7, loc = blockIdx.x >> 3; int tml;
            if (round < 6) { tn = (round >> 1) * 8 + (loc & 7); tml = (round & 1) * 8 + (loc >> 3); }
            else { tn = 24 + (loc & 3); tml = loc >> 2; }
            tm = tml * 8 + x;
        } else if (!xcd_item(round, NTOK / 128, NINP / 128, tm, tn)) break;
        const bool vt = (tn >= 6 && tn < 9) || tn == 23 || tn == 24;
        f32x4 acc[4][4];
        {
            auto rw = [&](int r) { return wt + pl_off(tn * 128 + r, 0, 1024); };
            auto rt_ = [&](int r) { return hn + pl_off(tm * 128 + r, 0, 1024); };
            if (vt) gemm_core(rt_, rw, 1024, lds, acc, gvar); else gemm_core(rw, rt_, 1024, lds, acc, gvar);
        }
        if (gvar != 0 && acc[0][0][0] != 123456.789f) continue;
        if (tn == 27) {
#pragma unroll
            for (int n = 0; n < 4; ++n) {
                int t = tm * 128 + wy * 64 + n * 16 + fr;
#pragma unroll
                for (int m = 0; m < 4; ++m) {
                    int c = wx * 64 + m * 16 + 4 * fg;
                    if (c < 64) *(float4*)(aux + (size_t)t * 64 + c) = make_float4(acc[m][n][0], acc[m][n][1], acc[m][n][2], acc[m][n][3]);
                }
            }
            continue;
        }
        RAW_BARRIER();
        if (vt) {
#pragma unroll
            for (int n = 0; n < 4; ++n)
#pragma unroll
                for (int m = 0; m < 4; ++m) ep_put<128>(lds, wy * 64 + n * 16 + fr, wx * 64 + m * 16 + 4 * fg, acc[m][n][0], acc[m][n][1], acc[m][n][2], acc[m][n][3]);
            RAW_BARRIER();
            const bool fox = tn < 9;
            bf16_t* dstb = fox ? vtf : (bf16_t*)(p.ws + WS_SCR + SCR_LVT); const int nh = fox ? H_FOX : H_GLA;
            const int t0 = tm * 128, b = t0 / SEQ, s0 = t0 % SEQ, chb = tn * 128 - (fox ? NC_FV : NC_LV);
            ep_flush<128>(lds, tid, [&](int row, int c8) { const int ch = chb + row; return dstb + ((size_t)(b * nh + (ch >> 6)) * 64 + (ch & 63)) * SEQ + s0 + c8 * 8; });
        } else {
            if (tn < 6) {
                const float* gn = (tn < 3) ? qg : kg; const float sc = (tn < 3) ? 0.125f * 1.4426950408889634f : 1.f;
                float g[4][4];
#pragma unroll
                for (int m = 0; m < 4; ++m)
#pragma unroll
                    for (int r = 0; r < 4; ++r) g[m][r] = gn[m * 16 + 4 * fg + r] * sc;
#pragma unroll
                for (int n = 0; n < 4; ++n) {
                    float ss = 0.f;
#pragma unroll
                    for (int m = 0; m < 4; ++m)
#pragma unroll
                        for (int r = 0; r < 4; ++r) ss += acc[m][n][r] * acc[m][n][r];
                    ss += __shfl_xor(ss, 16, 64); ss += __shfl_xor(ss, 32, 64);
                    float rs = rsqrtf(ss * (1.f / 64.f) + 1e-6f);
#pragma unroll
                    for (int m = 0; m < 4; ++m)
                        ep_put<128>(lds, wy * 64 + n * 16 + fr, wx * 64 + m * 16 + 4 * fg, acc[m][n][0] * rs * g[m][0], acc[m][n][1] * rs * g[m][1], acc[m][n][2] * rs * g[m][2], acc[m][n][3] * rs * g[m][3]);
                }
            } else {
                const bool do_silu = (tn >= 18 && tn < 21) || (tn >= 25);
                const float sc = (tn == 21) ? 0.17677669529663687f : 1.f;
#pragma unroll
                for (int n = 0; n < 4; ++n)
#pragma unroll
                    for (int m = 0; m < 4; ++m) {
                        float v0 = acc[m][n][0] * sc, v1 = acc[m][n][1] * sc, v2 = acc[m][n][2] * sc, v3 = acc[m][n][3] * sc;
                        if (do_silu) { v0 = siluf_(v0); v1 = siluf_(v1); v2 = siluf_(v2); v3 = siluf_(v3); }
                        ep_put<128>(lds, wy * 64 + n * 16 + fr, wx * 64 + m * 16 + 4 * fg, v0, v1, v2, v3);
                    }
            }
            RAW_BARRIER();
            bf16_t* dstb = proj + (size_t)(tm * 128) * NPROJ + tn * 128;
            ep_flush<128>(lds, tid, [&](int row, int c8) { return dstb + (size_t)row * NPROJ + c8 * 8; });
        }
    }
}

__device__ void phase_outproj(const Params& p, int l, bf16_t* lds) {
    const int tid = ltid(), lane = tid & 63, w = tid >> 6, wx = w >> 1, wy = w & 1, fr = lane & 15, fg = lane >> 4;
    const bf16_t* mix = (const bf16_t*)(p.ws + WS_MIX);
    const bf16_t* wt = (const bf16_t*)(p.ws + WS_WOUT) + (size_t)l * 1024 * 1024;
    const float* xin = (l == 0) ? p.in[0] : p.out;
    bf16_t* xb = (bf16_t*)(p.ws + WS_SCR + SCR_XB);
    for (int round = 0;; ++round) {
        int tm, tn;
        if (gridDim.x == 512) {
            if (round >= 2) break;
            const int x = blockIdx.x & 7, loc = blockIdx.x >> 3;
            tn = loc & 7; tm = (round * 8 + (loc >> 3)) * 8 + x;
        } else if (!xcd_item(round, NTOK / 128, 8, tm, tn)) break;
        f32x4 acc[4][4];
        {
            auto rw = [&](int r) { return wt + pl_off(tn * 128 + r, 0, 1024); };
            auto rt_ = [&](int r) { return mix + pl_off(tm * 128 + r, 0, 1024); };
            gemm_core(rw, rt_, 1024, lds, acc);
        }
#pragma unroll
        for (int n = 0; n < 4; ++n) {
            int t = tm * 128 + wy * 64 + n * 16 + fr;
#pragma unroll
            for (int m = 0; m < 4; ++m) {
                int c = tn * 128 + wx * 64 + m * 16 + 4 * fg;
                float4 xv;
                if (l == 0) xv = *(const float4*)(xin + (size_t)t * 1024 + c);
                else { const u32x2 u = *(const u32x2*)((const bf16_t*)p.out + (size_t)t * 1024 + c); xv = make_float4(bflo(u[0]), bfhi(u[0]), bflo(u[1]), bfhi(u[1])); }
                store4_bf16(xb + (size_t)t * 1024 + c, xv.x + acc[m][n][0], xv.y + acc[m][n][1], xv.z + acc[m][n][2], xv.w + acc[m][n][3]);
            }
        }
    }
}

__device__ void phase_route(const Params& p, int l, bf16_t* lds, int dry = 0) {
    const int tid = ltid(), lane = tid & 63, w = tid >> 6, fr = lane & 15, fg = lane >> 4;
    const bf16_t* x1 = (const bf16_t*)(p.ws + WS_SCR + SCR_XB);
    const float* gain = p.in[15] + l * 1024;
    bf16_t* hn = dry ? (bf16_t*)(p.ws + WS_SCR) : (bf16_t*)(p.ws + WS_HN);
    const bf16_t* wr = (const bf16_t*)(p.ws + WS_WR) + (size_t)l * 64 * 1024;
    const float* brg = p.in[17] + l * 4; const float* bre = p.in[19] + l * 32;
    unsigned* cnt = (unsigned*)(p.ws + WS_CTL) + CW_CNT + l * 32 * NSH * CNT_STRIDE;
    int* rowtok = (int*)(p.ws + WS_ROWTOK);
    int* tslot = (int*)(p.ws + WS_TSLOT);
    float* tgate = (float*)(p.ws + WS_TGATE);
    const int HL = 1032;
    float* red = (float*)(lds + 16 * HL);
    for (int it = blockIdx.x; it < NTOK / 16; it += gridDim.x) {
        __syncthreads();
        u32x4 xin4[4][2];
#pragma unroll
        for (int rr = 0; rr < 4; ++rr) {
            const bf16_t* xr = x1 + (size_t)(it * 16 + w * 4 + rr) * 1024 + lane * 16;
            xin4[rr][0] = *(const u32x4*)xr; xin4[rr][1] = *(const u32x4*)(xr + 8);
        }
#pragma unroll
        for (int rr = 0; rr < 4; ++rr) {
            int lr = w * 4 + rr; int t = it * 16 + lr;
            float v[16]; float ss = 0.f;
#pragma unroll
            for (int i = 0; i < 4; ++i) { v[4 * i] = bflo(xin4[rr][i >> 1][(2 * i) & 3]); v[4 * i + 1] = bfhi(xin4[rr][i >> 1][(2 * i) & 3]); v[4 * i + 2] = bflo(xin4[rr][i >> 1][(2 * i + 1) & 3]); v[4 * i + 3] = bfhi(xin4[rr][i >> 1][(2 * i + 1) & 3]); }
#pragma unroll
            for (int i = 0; i < 16; ++i) ss += v[i] * v[i];
            ss = wave_sum(ss);
            float r = rsqrtf(ss / D_MODEL + 1e-6f);
#pragma unroll
            for (int i = 0; i < 16; ++i) v[i] = v[i] * r * gain[lane * 16 + i];
            uint4 o0, o1;
            o0.x = pk_bf16(v[0], v[1]); o0.y = pk_bf16(v[2], v[3]); o0.z = pk_bf16(v[4], v[5]); o0.w = pk_bf16(v[6], v[7]);
            o1.x = pk_bf16(v[8], v[9]); o1.y = pk_bf16(v[10], v[11]); o1.z = pk_bf16(v[12], v[13]); o1.w = pk_bf16(v[14], v[15]);
            bf16_t* hr = hn + pl_off(t, lane * 16, 1024);
            *(uint4*)hr = o0; *(uint4*)(hr + 8) = o1;
            *(uint4*)(lds + lr * HL + lane * 16) = o0; *(uint4*)(lds + lr * HL + lane * 16 + 8) = o1;
        }
        __syncthreads();
        f32x4 acc[3];
#pragma unroll
        for (int n = 0; n < 3; ++n) acc[n] = (f32x4){0.f, 0.f, 0.f, 0.f};
#pragma unroll
        for (int ks = 0; ks < 8; ++ks) {
            int k = w * 256 + ks * 32 + fg * 8;
            bf16x8 a = *(const bf16x8*)(lds + fr * HL + k);
#pragma unroll
            for (int n = 0; n < 3; ++n) {
                bf16x8 b = *(const bf16x8*)(wr + (size_t)(n * 16 + fr) * 1024 + k);
                acc[n] = __builtin_amdgcn_mfma_f32_16x16x32_bf16(a, b, acc[n], 0, 0, 0);
            }
        }
#pragma unroll
        for (int n = 0; n < 3; ++n) *(f32x4*)(red + ((w * 3 + n) * 64 + lane) * 4) = acc[n];
        __syncthreads();
        if (tid < 16) {
            float lg[36];
#pragma unroll
            for (int j = 0; j < 36; ++j) {
                int n = j >> 4, f = j & 15; int ln = (tid >> 2) * 16 + f; float s = 0.f;
#pragma unroll
                for (int ww = 0; ww < 4; ++ww) s += red[((ww * 3 + n) * 64 + ln) * 4 + (tid & 3)];
                lg[j] = s;
            }
            float gl[4]; float gm = -1e30f; int gi = 0;
#pragma unroll
            for (int j = 0; j < 4; ++j) { gl[j] = lg[j] + brg[j]; if (gl[j] > gm) { gm = gl[j]; gi = j; } }
            float gs = 0.f;
#pragma unroll
            for (int j = 0; j < 4; ++j) gs += __expf(gl[j] - gm);
            float gp = 1.f / gs;
            float el[8]; float em = -1e30f;
#pragma unroll
            for (int j = 0; j < 8; ++j) {
                float v = (gi == 0) ? lg[4 + j] : (gi == 1) ? lg[12 + j] : (gi == 2) ? lg[20 + j] : lg[28 + j];
                el[j] = v + bre[gi * 8 + j]; em = fmaxf(em, el[j]);
            }
#pragma unroll
            for (int j = 0; j < 8; ++j) el[j] = __expf(el[j] - em);
            float v0 = -1.f, v1 = -1.f; int i0 = 0, i1 = 0;
#pragma unroll
            for (int j = 0; j < 8; ++j) {
                float v = el[j];
                if (v > v0) { v1 = v0; i1 = i0; v0 = v; i0 = j; }
                else if (v > v1) { v1 = v; i1 = j; }
            }
            int t = it * 16 + tid;
            int e0 = gi * 8 + i0, e1 = gi * 8 + i1;
            if (!dry) {
            const int sh = blockIdx.x & (NSH - 1);
            unsigned s0 = atomicAdd(&cnt[(e0 * NSH + sh) * CNT_STRIDE], 1u), s1 = atomicAdd(&cnt[(e1 * NSH + sh) * CNT_STRIDE], 1u);
            rowtok[(size_t)(e0 * NSH + sh) * SHCAP + s0] = t; rowtok[(size_t)(e1 * NSH + sh) * SHCAP + s1] = t;
            tslot[t * 2] = (e0 << 16) | (sh << 11) | (int)s0; tslot[t * 2 + 1] = (e1 << 16) | (sh << 11) | (int)s1;
            tgate[t * 2] = gp * v0 / (v0 + v1); tgate[t * 2 + 1] = gp * v1 / (v0 + v1);
            } else if (gp * v0 == 123.456f) tgate[0] = v1;
        }
    }
}

__device__ __forceinline__ void moe_tables(const unsigned* cnt, int* tab) {
    const int t = threadIdx.x;
    int* sc = tab + 80 + 32 * 9;
    sc[t] = (int)ld_u32_agent(cnt + t * CNT_STRIDE);
    __syncthreads();
    if (t < 32) { int a = 0; for (int s = 0; s < NSH; ++s) { tab[80 + t * 9 + s] = a; a += sc[t * NSH + s]; } tab[80 + t * 9 + 8] = a; }
    __syncthreads();
    if (t == 0) {
        int a = 0;
        for (int e = 0; e < 32; ++e) { tab[e] = a; tab[40 + e] = a * 128; a += (tab[80 + e * 9 + 8] + 127) >> 7; }
        tab[32] = a; tab[72] = a * 128;
    }
    __syncthreads();
}
template <int MODE>
__device__ void phase_expert(const Params& p, int l, bf16_t* lds) {
    const int tid = ltid(), lane = tid & 63, w = tid >> 6, wx = w >> 1, wy = w & 1, fr = lane & 15, fg = lane >> 4;
    const unsigned* cnt = (const unsigned*)(p.ws + WS_CTL) + CW_CNT + l * 32 * NSH * CNT_STRIDE;
    int* tab = (int*)(lds + 4 * GSTAGE);
    moe_tables(cnt, tab);
    if (MODE == 0 && blockIdx.x == 0) {
        unsigned* mt = (unsigned*)(p.ws + WS_CTL) + CW_MOETAB + l * 32 * NSH;
        mt[threadIdx.x] = (unsigned)(tab[40 + (threadIdx.x >> 3)] + tab[80 + (threadIdx.x >> 3) * 9 + (threadIdx.x & 7)]);
    }
    const int* rowtok = (const int*)(p.ws + WS_ROWTOK);
    const bf16_t* hn = (const bf16_t*)(p.ws + WS_HN);
    bf16_t* Hb = (bf16_t*)(p.ws + WS_H);
    bf16_t* Yb = (bf16_t*)(p.ws + WS_Y);
    const int x = blockIdx.x & 7, loc = blockIdx.x >> 3, nloc = gridDim.x >> 3;
    for (int j = loc;; j += nloc) {
        int e = -1, rt = 0, tn = 0; int jj = j;
#pragma unroll
        for (int q = 0; q < 4; ++q) {
            int ee = q * 8 + x; int nrt = tab[ee + 1] - tab[ee];
            if (e < 0) { if (jj < nrt * 8) { e = ee; tn = jj / nrt; rt = jj % nrt; } else jj -= nrt * 8; }
        }
        if (e < 0) break;
        const int hrow0 = tab[40 + e] + rt * 128;
        f32x4 acc[4][4];
        if (MODE == 0) {
            const bf16_t* wbase = (const bf16_t*)(p.ws + WS_WGU) + ((size_t)l * 32 + e) * 1024 * 1024;
            const int* spx = tab + 80 + e * 9;
            auto rw = [&](int r) { return wbase + pl_off(tn * 128 + r, 0, 1024); };
            auto rt_ = [&](int r) {
                const int s = rt * 128 + r; int t = 0;
                if (s < spx[8]) {
                    int xs = 0;
#pragma unroll
                    for (int q = 1; q < NSH; ++q) xs += (s >= spx[q]) ? 1 : 0;
                    t = rowtok[(size_t)(e * NSH + xs) * SHCAP + (s - spx[xs])];
                }
                return hn + pl_off(t, 0, 1024); };
            gemm_core(rw, rt_, 1024, lds, acc);
        } else {
            const bf16_t* wbase = (const bf16_t*)(p.ws + WS_WD) + ((size_t)l * 32 + e) * 1024 * 512;
            auto rw = [&](int r) { return wbase + pl_off(tn * 128 + r, 0, 512); };
            auto rt_ = [&](int r) { return Hb + pl_off(hrow0 + r, 0, 512); };
            gemm_core(rw, rt_, 512, lds, acc);
        }
        RAW_BARRIER();
        if (MODE == 0) {
#pragma unroll
            for (int n = 0; n < 4; ++n)
#pragma unroll
                for (int m = 0; m < 2; ++m)
                    ep_put<64>(lds, wy * 64 + n * 16 + fr, wx * 32 + m * 16 + 4 * fg, siluf_(acc[m][n][0]) * acc[m + 2][n][0], siluf_(acc[m][n][1]) * acc[m + 2][n][1],
                               siluf_(acc[m][n][2]) * acc[m + 2][n][2], siluf_(acc[m][n][3]) * acc[m + 2][n][3]);
            RAW_BARRIER();
            ep_flush<64>(lds, tid, [&](int row, int c8) { return Hb + pl_off(hrow0 + row, tn * 64 + c8 * 8, 512); });
        } else {
#pragma unroll
            for (int n = 0; n < 4; ++n)
#pragma unroll
                for (int m = 0; m < 4; ++m) ep_put<128>(lds, wy * 64 + n * 16 + fr, wx * 64 + m * 16 + 4 * fg, acc[m][n][0], acc[m][n][1], acc[m][n][2], acc[m][n][3]);
            RAW_BARRIER();
            bf16_t* dstb = Yb + (size_t)hrow0 * 1024 + tn * 128;
            ep_flush<128>(lds, tid, [&](int row, int c8) { return dstb + (size_t)row * 1024 + c8 * 8; });
        }
    }
}

__device__ void phase_combine(const Params& p, int l, int dry = 0) {
    const int tid = ltid(), lane = tid & 63, w = tid >> 6;
    const unsigned* mt = (const unsigned*)(p.ws + WS_CTL) + CW_MOETAB + l * 32 * NSH;
    const int* tslot = (const int*)(p.ws + WS_TSLOT);
    const float* tgate = (const float*)(p.ws + WS_TGATE);
    const bf16_t* Yb = (const bf16_t*)(p.ws + WS_Y);
    bf16_t* hn = dry ? (bf16_t*)(p.ws + WS_SCR + (size_t)40 * 1024 * 1024) : (bf16_t*)(p.ws + WS_HN);
    float* xw = dry ? (float*)(p.ws + WS_SCR + (size_t)48 * 1024 * 1024) : p.out;
    const float* gain = (l == 0 || dry) ? p.in[1] + 1024 : nullptr;
    for (int it = blockIdx.x; it < NTOK / 4; it += gridDim.x) {
        int t = it * 4 + w;
        int ts0 = tslot[t * 2], ts1 = tslot[t * 2 + 1];
        float g0 = tgate[t * 2], g1 = tgate[t * 2 + 1];
        int r0 = (int)mt[((ts0 >> 16) << 3) | ((ts0 >> 11) & 7)] + (ts0 & 0x7ff);
        int r1 = (int)mt[((ts1 >> 16) << 3) | ((ts1 >> 11) & 7)] + (ts1 & 0x7ff);
        const bf16_t* xr = (const bf16_t*)(p.ws + WS_SCR + SCR_XB) + (size_t)t * 1024 + lane * 16;
        const bf16_t* y0 = Yb + (size_t)r0 * 1024 + lane * 16;
        const bf16_t* y1 = Yb + (size_t)r1 * 1024 + lane * 16;
        float v[16];
#pragma unroll
        for (int i = 0; i < 2; ++i) { u32x4 q = *(const u32x4*)(xr + 8 * i);
#pragma unroll
            for (int k = 0; k < 4; ++k) { v[8 * i + 2 * k] = bflo(q[k]); v[8 * i + 2 * k + 1] = bfhi(q[k]); } }
        uint4 a0 = *(const uint4*)y0, a1 = *(const uint4*)(y0 + 8), b0 = *(const uint4*)y1, b1 = *(const uint4*)(y1 + 8);
        unsigned ya[8] = {a0.x, a0.y, a0.z, a0.w, a1.x, a1.y, a1.z, a1.w};
        unsigned yb[8] = {b0.x, b0.y, b0.z, b0.w, b1.x, b1.y, b1.z, b1.w};
#pragma unroll
        for (int i = 0; i < 8; ++i) {
            v[2 * i] += g0 * bflo(ya[i]) + g1 * bflo(yb[i]);
            v[2 * i + 1] += g0 * bfhi(ya[i]) + g1 * bfhi(yb[i]);
        }
#ifdef NANMARK
#pragma unroll
        for (int i = 0; i < 16; ++i) if (!(fabsf(v[i]) < 1e30f)) v[i] = 1000.f;
#endif
        if (l == 0 && !dry) {
            uint4 o0, o1;
            o0.x = pk_bf16(v[0], v[1]); o0.y = pk_bf16(v[2], v[3]); o0.z = pk_bf16(v[4], v[5]); o0.w = pk_bf16(v[6], v[7]);
            o1.x = pk_bf16(v[8], v[9]); o1.y = pk_bf16(v[10], v[11]); o1.z = pk_bf16(v[12], v[13]); o1.w = pk_bf16(v[14], v[15]);
            bf16_t* xo2 = (bf16_t*)p.out + (size_t)t * 1024 + lane * 16;
            *(uint4*)xo2 = o0; *(uint4*)(xo2 + 8) = o1;
        } else {
#pragma unroll
            for (int i = 0; i < 4; ++i) *(float4*)(xw + (size_t)t * 1024 + lane * 16 + 4 * i) = make_float4(v[4 * i], v[4 * i + 1], v[4 * i + 2], v[4 * i + 3]);
        }
        if (gain) {
            float ss = 0.f;
#pragma unroll
            for (int i = 0; i < 16; ++i) ss += v[i] * v[i];
            ss = wave_sum(ss);
            float r = rsqrtf(ss / D_MODEL + 1e-6f);
#pragma unroll
            for (int i = 0; i < 16; ++i) v[i] = v[i] * r * gain[lane * 16 + i];
            uint4 o0, o1;
            o0.x = pk_bf16(v[0], v[1]); o0.y = pk_bf16(v[2], v[3]); o0.z = pk_bf16(v[4], v[5]); o0.w = pk_bf16(v[6], v[7]);
            o1.x = pk_bf16(v[8], v[9]); o1.y = pk_bf16(v[10], v[11]); o1.z = pk_bf16(v[12], v[13]); o1.w = pk_bf16(v[14], v[15]);
            bf16_t* hr = hn + pl_off(t, lane * 16, 1024);
            *(uint4*)hr = o0; *(uint4*)(hr + 8) = o1;
        }
    }
}


__device__ __forceinline__ void mm_row(const bf16_t* RA, const bf16_t* RB, int mw, int fr, int fg, f32x4 (&acc)[4]) {
#pragma unroll
    for (int ks = 0; ks < 2; ++ks) {
        bf16x8 a = *(const bf16x8*)(RA + (16 * mw + fr) * LROW + ks * 32 + fg * 8);
#pragma unroll
        for (int nt = 0; nt < 4; ++nt) {
            bf16x8 b = *(const bf16x8*)(RB + (16 * nt + fr) * LROW + ks * 32 + fg * 8);
            acc[nt] = __builtin_amdgcn_mfma_f32_16x16x32_bf16(a, b, acc[nt], 0, 0, 0);
        }
    }
}
__device__ __forceinline__ void mm_col(const bf16_t* RA, const bf16_t* RB, int nw, int fr, int fg, f32x4 (&acc)[4]) {
#pragma unroll
    for (int ks = 0; ks < 2; ++ks) {
        bf16x8 b = *(const bf16x8*)(RB + (16 * nw + fr) * LROW + ks * 32 + fg * 8);
#pragma unroll
        for (int mt = 0; mt < 4; ++mt) {
            bf16x8 a = *(const bf16x8*)(RA + (16 * mt + fr) * LROW + ks * 32 + fg * 8);
            acc[mt] = __builtin_amdgcn_mfma_f32_16x16x32_bf16(a, b, acc[mt], 0, 0, 0);
        }
    }
}
__device__ __forceinline__ void zero4(f32x4 (&a)[4]) {
#pragma unroll
    for (int i = 0; i < 4; ++i) a[i] = (f32x4){0.f, 0.f, 0.f, 0.f};
}
__device__ __forceinline__ void st4_lds(bf16_t* p, float a, float b, float c, float d) { uint2 o; o.x = pk_bf16(a, b); o.y = pk_bf16(c, d); *(uint2*)p = o; }
__device__ __forceinline__ bf16_t f2bf(float v) { return (bf16_t)(pk_bf16(v, 0.f) & 0xffffu); }

__device__ void gdn_prep_item(const Params& p, int l, int cid, unsigned char* lds_raw) {
    const int tid = ltid(), lane = tid & 63, w = tid >> 6, fr = lane & 15, fg = lane >> 4;
    const int bh = cid >> 6, n = cid & 63, b = bh / H_GDN, h = bh % H_GDN;
    const int t0 = b * SEQ + n * 64;
    bf16_t* L0 = (bf16_t*)lds_raw; bf16_t* L1 = L0 + 64 * LROW; bf16_t* L2 = L1 + 64 * LROW; bf16_t* L3 = L2 + 64 * LROW; bf16_t* L4 = L3 + 64 * LROW; bf16_t* L5 = L4 + 64 * LROW;
    float* dec = (float*)(L5 + 64 * LROW); float* beta = dec + 64;
    const bf16_t* proj = (const bf16_t*)(p.ws + WS_PROJ);
    const float* aux = (const float*)(p.ws + WS_AUX);
    const float* convw = p.in[7] + (size_t)l * 4 * 1152;
    __syncthreads();
    const int i = tid >> 2, c0 = (tid & 3) * 16;
    float qv[16], kv[16], vv[16];
#pragma unroll
    for (int which = 0; which < 3; ++which) {
        float acc[16];
#pragma unroll
        for (int c = 0; c < 16; ++c) acc[c] = 0.f;
#pragma unroll
        for (int tap = 0; tap < 4; ++tap) {
            const int row = i - 3 + tap;
            if (n * 64 + row >= 0) {
                const bf16_t* xp = proj + (size_t)(t0 + row) * NPROJ + NC_GQ + which * 384 + h * 64 + c0;
                u32x4 x0 = *(const u32x4*)xp, x1 = *(const u32x4*)(xp + 8);
                const float* wp = convw + tap * 1152 + which * 384 + h * 64 + c0;
                f32x4 w0 = *(const f32x4*)wp, w1 = *(const f32x4*)(wp + 4), w2 = *(const f32x4*)(wp + 8), w3 = *(const f32x4*)(wp + 12);
                float wv[16] = {w0[0], w0[1], w0[2], w0[3], w1[0], w1[1], w1[2], w1[3], w2[0], w2[1], w2[2], w2[3], w3[0], w3[1], w3[2], w3[3]};
                unsigned xs[8] = {x0[0], x0[1], x0[2], x0[3], x1[0], x1[1], x1[2], x1[3]};
#pragma unroll
                for (int c = 0; c < 8; ++c) { acc[2 * c] += wv[2 * c] * bflo(xs[c]); acc[2 * c + 1] += wv[2 * c + 1] * bfhi(xs[c]); }
            }
        }
        float ss = 0.f;
#pragma unroll
        for (int c = 0; c < 16; ++c) { acc[c] = siluf_(acc[c]); ss += acc[c] * acc[c]; }
        if (which < 2) {
            ss += __shfl_xor(ss, 1, 64); ss += __shfl_xor(ss, 2, 64);
            const float sc = rsqrtf(ss + 1e-6f) * (which == 0 ? 0.125f : 1.f);
#pragma unroll
            for (int c = 0; c < 16; ++c) acc[c] *= sc;
        }
#pragma unroll
        for (int c = 0; c < 16; ++c) { if (which == 0) qv[c] = acc[c]; else if (which == 1) kv[c] = acc[c]; else vv[c] = acc[c]; }
    }
#pragma unroll
    for (int c = 0; c < 16; c += 4) { st4_lds(L2 + i * LROW + c0 + c, kv[c], kv[c + 1], kv[c + 2], kv[c + 3]); st4_lds(L3 + i * LROW + c0 + c, qv[c], qv[c + 1], qv[c + 2], qv[c + 3]); }
    if (w == 0) {
        const float a = aux[(size_t)(t0 + lane) * 64 + AX_GA + h], bl = aux[(size_t)(t0 + lane) * 64 + AX_GB + h];
        const float g = -__expf(p.in[8][l * H_GDN + h]) * softplusf_(a + p.in[9][l * H_GDN + h]);
        float inc = g;
#pragma unroll
        for (int o = 1; o < 64; o <<= 1) { float t = __shfl_up(inc, o, 64); if (lane >= o) inc += t; }
        dec[lane] = inc; beta[lane] = sigmoidf_(bl);
    }
    __syncthreads();
    {
        f32x4 g4[4]; zero4(g4);
        mm_row(L2, L2, w, fr, fg, g4);
#pragma unroll
        for (int nt = 0; nt < 4; ++nt) {
            const int kap = 16 * nt + fr; const float dk_ = dec[kap], bk_ = beta[kap];
            float nT[4], nN[4], tt[4];
#pragma unroll
            for (int r = 0; r < 4; ++r) {
                const int rho = 16 * w + 4 * fg + r; const float dr_ = dec[rho], br_ = beta[rho];
                const float G = g4[nt][r];
                nT[r] = (kap < rho) ? br_ * G * __expf(dr_ - dk_) : 0.f;
                nN[r] = (rho < kap) ? bk_ * G * __expf(dk_ - dr_) : 0.f;
                tt[r] = ((kap == rho) ? 1.f : 0.f) - nN[r];
            }
            st4_lds(L1 + kap * LROW + 16 * w + 4 * fg, nT[0], nT[1], nT[2], nT[3]);
            st4_lds(L0 + kap * LROW + 16 * w + 4 * fg, nN[0], nN[1], nN[2], nN[3]);
            st4_lds(L4 + kap * LROW + 16 * w + 4 * fg, tt[0], tt[1], tt[2], tt[3]);
        }
        f32x4 a4[4]; zero4(a4);
        mm_row(L2, L3, w, fr, fg, a4);
#pragma unroll
        for (int nt = 0; nt < 4; ++nt) {
            const int ii = 16 * nt + fr; const float di_ = dec[ii];
            float v4[4];
#pragma unroll
            for (int r = 0; r < 4; ++r) { const int j = 16 * w + 4 * fg + r; v4[r] = (j <= ii) ? a4[nt][r] * __expf(di_ - dec[j]) : 0.f; }
            st4_lds(L5 + ii * LROW + 16 * w + 4 * fg, v4[0], v4[1], v4[2], v4[3]);
        }
    }
    __syncthreads();
#pragma unroll
    for (int lev = 1; lev <= 5; ++lev) {
        const bf16_t* XA = (lev & 1) ? L0 : L2; const bf16_t* XAt = (lev & 1) ? L1 : L3;
        bf16_t* XB = (lev & 1) ? L2 : L0; bf16_t* XBt = (lev & 1) ? L3 : L1;
        {
            f32x4 x4[4]; zero4(x4);
            mm_row(XA, XAt, w, fr, fg, x4);
#pragma unroll
            for (int nt = 0; nt < 4; ++nt) {
                const int c = 16 * nt + fr;
                st4_lds(XBt + c * LROW + 16 * w + 4 * fg, x4[nt][0], x4[nt][1], x4[nt][2], x4[nt][3]);
                if (lev < 5) {
#pragma unroll
                    for (int r = 0; r < 4; ++r) XB[(16 * w + 4 * fg + r) * LROW + c] = f2bf(x4[nt][r]);
                }
            }
        }
        __syncthreads();
        {
            f32x4 t4[4];
#pragma unroll
            for (int mt = 0; mt < 4; ++mt) {
                uint2 u = *(const uint2*)(L4 + (16 * w + fr) * LROW + 16 * mt + 4 * fg);
                t4[mt] = (f32x4){bflo(u.x), bfhi(u.x), bflo(u.y), bfhi(u.y)};
            }
            mm_col(XBt, L4, w, fr, fg, t4);
#pragma unroll
            for (int mt = 0; mt < 4; ++mt) st4_lds(L4 + (16 * w + fr) * LROW + 16 * mt + 4 * fg, t4[mt][0], t4[mt][1], t4[mt][2], t4[mt][3]);
        }
    }
    {
        const float dj = dec[i], bj = beta[i], dlast = dec[63];
        const float s1 = bj * __expf(dj), s2 = bj, s3 = __expf(dlast - dj);
#pragma unroll
        for (int c = 0; c < 16; ++c) {
            L0[(c0 + c) * LROW + i] = f2bf(kv[c] * s1);
            L1[(c0 + c) * LROW + i] = f2bf(vv[c] * s2);
            L2[(c0 + c) * LROW + i] = f2bf(kv[c] * s3);
        }
    }
    __syncthreads();
    {
        f32x4 w4[4], u4[4]; zero4(w4); zero4(u4);
        mm_row(L4, L0, w, fr, fg, w4);
        mm_row(L4, L1, w, fr, fg, u4);
        __syncthreads();
#pragma unroll
        for (int nt = 0; nt < 4; ++nt) {
            st4_lds(L0 + (16 * nt + fr) * LROW + 16 * w + 4 * fg, w4[nt][0], w4[nt][1], w4[nt][2], w4[nt][3]);
            st4_lds(L1 + (16 * nt + fr) * LROW + 16 * w + 4 * fg, u4[nt][0], u4[nt][1], u4[nt][2], u4[nt][3]);
        }
        const float ed = __expf(dec[i]);
#pragma unroll
        for (int c = 0; c < 16; c += 4) st4_lds(L3 + i * LROW + c0 + c, qv[c] * ed, qv[c + 1] * ed, qv[c + 2] * ed, qv[c + 3] * ed);
    }
    __syncthreads();
    char* scr = p.ws + WS_SCR;
    {
        f32x4 m4[4]; zero4(m4);
        mm_row(L0, L2, w, fr, fg, m4);
        bf16_t* MP = (bf16_t*)(scr + SCR_GDN_MP) + (size_t)cid * 4096;
#pragma unroll
        for (int nt = 0; nt < 4; ++nt) store4_bf16(MP + (16 * nt + fr) * 64 + 16 * w + 4 * fg, -m4[nt][0], -m4[nt][1], -m4[nt][2], -m4[nt][3]);
        f32x4 n4[4]; zero4(n4);
        mm_row(L2, L1, w, fr, fg, n4);
        bf16_t* NN = (bf16_t*)(scr + SCR_GDN_NN) + (size_t)cid * 4096;
#pragma unroll
        for (int nt = 0; nt < 4; ++nt) store4_bf16(NN + ((nt * 4 + w) * 64 + lane) * 4, n4[nt][0], n4[nt][1], n4[nt][2], n4[nt][3]);
        f32x4 p4[4]; zero4(p4);
        mm_row(L0, L5, w, fr, fg, p4);
        bf16_t* PG = (bf16_t*)(scr + SCR_GDN_P) + (size_t)cid * 4096;
#pragma unroll
        for (int nt = 0; nt < 4; ++nt) {
            uint2 u = *(const uint2*)(L3 + (16 * nt + fr) * LROW + 16 * w + 4 * fg);
            store4_bf16(PG + (16 * nt + fr) * 64 + 16 * w + 4 * fg, bflo(u.x) - p4[nt][0], bfhi(u.x) - p4[nt][1], bflo(u.y) - p4[nt][2], bfhi(u.y) - p4[nt][3]);
        }
        f32x4 o4[4]; zero4(o4);
        mm_row(L1, L5, w, fr, fg, o4);
        bf16_t* OL = (bf16_t*)(scr + SCR_GDN_OL) + (size_t)cid * 4096;
#pragma unroll
        for (int nt = 0; nt < 4; ++nt) store4_bf16(OL + (16 * nt + fr) * 64 + 16 * w + 4 * fg, o4[nt][0], o4[nt][1], o4[nt][2], o4[nt][3]);
        if (tid == 0) ((float*)(scr + SCR_GDN_LAST))[cid] = __expf(dec[63]);
    }
}

#define SCAN_SLOT    5120
#define SCAN_SB(k)   ((bf16_t*)lds_raw + (k) * 1024)
#define SCAN_RING(k) ((bf16_t*)lds_raw + 2048 + (k) * SCAN_SLOT)
#define SCAN_LAST    ((float*)(lds_raw + 4096 + 5 * SCAN_SLOT * 2))
__device__ __forceinline__ void scan_issue(const bf16_t* const (&mp)[8], const bf16_t* nn_lane, int n, bf16_t* slot) {
#pragma unroll
    for (int q = 0; q < 8; ++q) __builtin_amdgcn_global_load_lds((const unsigned*)(mp[q] + (size_t)n * 4096), (unsigned*)(slot + q * 512), 16, 0, 0);
    __builtin_amdgcn_global_load_lds((const unsigned*)(nn_lane + (size_t)n * 4096), (unsigned*)(slot + 4096), 16, 0, 0);
    __builtin_amdgcn_global_load_lds((const unsigned*)(nn_lane + (size_t)n * 4096 + 512), (unsigned*)(slot + 4096 + 512), 16, 0, 0);
}
__device__ void gdn_scan_item(const Params& p, int item, unsigned char* lds_raw, int svar = 0) {
    const int tid = ltid(), lane = tid & 63, w = __builtin_amdgcn_readfirstlane(tid >> 6), fr = lane & 15, fg = lane >> 4;
    const int bh = item >> 2, cg = item & 3;
    char* scr = p.ws + WS_SCR;
    const bf16_t* MP = (const bf16_t*)(scr + SCR_GDN_MP) + (size_t)bh * 64 * 4096;
    const bf16_t* NN = (const bf16_t*)(scr + SCR_GDN_NN) + (size_t)bh * 64 * 4096 + cg * 1024;
    const float* LAST = (const float*)(scr + SCR_GDN_LAST) + bh * 64;
    bf16_t* SG = (bf16_t*)(scr + SCR_GDN_SG) + (size_t)bh * 64 * 4096 + cg * 1024;
    const bf16_t* mp[8];
#pragma unroll
    for (int q = 0; q < 8; ++q) { const int row = 8 * q + (lane >> 3); mp[q] = MP + row * 64 + (((lane & 7) ^ ((row >> 1) & 7)) * 8); }
    const bf16_t* nn_lane = NN + lane * 8;
    RAW_BARRIER();
    if (tid < 64) SCAN_LAST[tid] = ld_f32_agent(LAST + tid);
    asm volatile("s_waitcnt vmcnt(0)" ::: "memory");
    f32x4 S = (f32x4){0.f, 0.f, 0.f, 0.f};
    const int swz = (fr >> 1) & 7;
    if (w == 0) {
#pragma unroll
        for (int n = 0; n < 4; ++n) scan_issue(mp, nn_lane, n, SCAN_RING(n));
    }
    for (int n = 0; n < 64; ++n) {
        bf16_t* sb = SCAN_SB(n & 1);
        const bf16_t* ring = SCAN_RING(n % 5);
        {
            const int c = 2 * w + (fg >> 1);
            uint2 o; o.x = pk_bf16(S[0], S[1]); o.y = pk_bf16(S[2], S[3]);
            *(uint2*)(sb + fr * 64 + ((c ^ swz) * 8) + 4 * (fg & 1)) = o;
        }
        if (w == 0) {
            if (n + 3 < 64) asm volatile("s_waitcnt vmcnt(30)" ::: "memory");
            else if (n + 2 < 64) asm volatile("s_waitcnt vmcnt(20)" ::: "memory");
            else if (n + 1 < 64) asm volatile("s_waitcnt vmcnt(10)" ::: "memory");
            else asm volatile("s_waitcnt vmcnt(0)" ::: "memory");
        }
        RAW_BARRIER();
        if (w == 0 && n + 4 < 64 && svar != 2) scan_issue(mp, nn_lane, n + 4, SCAN_RING((n + 4) % 5));
        const float last = SCAN_LAST[n];
        {
            u32x2 nn = *(const u32x2*)(ring + 4096 + (w * 64 + lane) * 4);
            S[0] = last * S[0] + bflo(nn[0]); S[1] = last * S[1] + bfhi(nn[0]);
            S[2] = last * S[2] + bflo(nn[1]); S[3] = last * S[3] + bfhi(nn[1]);
        }
#pragma unroll
        for (int ks = 0; ks < 2; ++ks) {
            const int co = ((ks * 4 + fg) ^ swz) * 8;
            bf16x8 a = *(const bf16x8*)(ring + (16 * w + fr) * 64 + co);
            bf16x8 s = *(const bf16x8*)(sb + fr * 64 + co);
            S = __builtin_amdgcn_mfma_f32_16x16x32_bf16(a, s, S, 0, 0, 0);
        }
        if (w >= 2 && svar != 1) {
            const int c = (w - 2) * 64 + lane; const int row = c >> 3, pc = c & 7;
            u32x4 v = *(const u32x4*)(sb + row * 64 + pc * 8);
            *(u32x4*)(SG + (size_t)n * 4096 + row * 64 + ((pc ^ ((row >> 1) & 7)) * 8)) = v;
        }
    }
}

__device__ void gdn_out_item(const Params& p, int l, int cid) {
    const int tid = ltid(), lane = tid & 63, w = tid >> 6, fr = lane & 15, fg = lane >> 4;
    const int bh = cid >> 6, n = cid & 63, b = bh / H_GDN, h = bh % H_GDN;
    char* scr = p.ws + WS_SCR;
    const bf16_t* SG = (const bf16_t*)(scr + SCR_GDN_SG) + (size_t)cid * 4096;
    const bf16_t* PG = (const bf16_t*)(scr + SCR_GDN_P) + (size_t)cid * 4096;
    const bf16_t* OL = (const bf16_t*)(scr + SCR_GDN_OL) + (size_t)cid * 4096;
    const int i = 16 * w + fr; const int t = b * SEQ + n * 64 + i;
    f32x4 acc[4];
#pragma unroll
    for (int mt = 0; mt < 4; ++mt) { uint2 u = *(const uint2*)(OL + i * 64 + 16 * mt + 4 * fg); acc[mt] = (f32x4){bflo(u.x), bfhi(u.x), bflo(u.y), bfhi(u.y)}; }
#pragma unroll
    for (int ks = 0; ks < 2; ++ks) {
        bf16x8 bq = *(const bf16x8*)(PG + i * 64 + ks * 32 + fg * 8);
#pragma unroll
        for (int mt = 0; mt < 4; ++mt) {
            bf16x8 a = *(const bf16x8*)(SG + (16 * mt + fr) * 64 + ks * 32 + fg * 8);
            acc[mt] = __builtin_amdgcn_mfma_f32_16x16x32_bf16(a, bq, acc[mt], 0, 0, 0);
        }
    }
    float ss = 0.f;
#pragma unroll
    for (int mt = 0; mt < 4; ++mt)
#pragma unroll
        for (int r = 0; r < 4; ++r) ss += acc[mt][r] * acc[mt][r];
    ss += __shfl_xor(ss, 16, 64); ss += __shfl_xor(ss, 32, 64);
    const float rstd = rsqrtf(ss * (1.f / 64.f) + 1e-6f);
    const float* og = p.in[10] + l * 64;
    const bf16_t* gp = (const bf16_t*)(p.ws + WS_PROJ) + (size_t)t * NPROJ + NC_GG + h * 64;
    bf16_t* mp = (bf16_t*)(p.ws + WS_MIX) + pl_off(t, 384 + h * 64, 1024);
#pragma unroll
    for (int mt = 0; mt < 4; ++mt) {
        const int e0 = 16 * mt + 4 * fg;
        uint2 gu = *(const uint2*)(gp + e0); f32x4 g4 = *(const f32x4*)(og + e0);
        store4_bf16(mp + e0 + (e0 & 32), acc[mt][0] * rstd * g4[0] * bflo(gu.x), acc[mt][1] * rstd * g4[1] * bfhi(gu.x), acc[mt][2] * rstd * g4[2] * bflo(gu.y), acc[mt][3] * rstd * g4[3] * bfhi(gu.y));
    }
}

#define GQROW 40
__device__ void gla_prep_item(const Params& p, int l, int cid, unsigned char* lds_raw) {
    const int tid = ltid(), lane = tid & 63, w = tid >> 6, fr = lane & 15, fg = lane >> 4;
    const int bh = cid >> 6, n = cid & 63, b = bh / H_GLA, h = bh % H_GLA;
    const int t0 = b * SEQ + n * 64;
    float* Bf = (float*)lds_raw;
    bf16_t* Qt = (bf16_t*)(lds_raw + 8448);
    bf16_t* Kt = Qt + 64 * GQROW;
    bf16_t* KLt = Kt + 64 * GQROW;
    bf16_t* Vt = KLt + 32 * LROW;
    const bf16_t* proj = (const bf16_t*)(p.ws + WS_PROJ);
    const float* aux = (const float*)(p.ws + WS_AUX);
    char* scr = p.ws + WS_SCR;
    __syncthreads();
    const int i = tid >> 2, d0 = (tid & 3) * 8;
    {
        const float* wa = p.in[11] + (size_t)l * 16 * 128 + h * 32 + d0;
        const float* ba = p.in[12] + l * 128 + h * 32 + d0;
        float acc[8];
#pragma unroll
        for (int j = 0; j < 8; ++j) acc[j] = ba[j];
        float a1v[16];
#pragma unroll
        for (int r = 0; r < 16; r += 2) { float2 t2 = *(const float2*)(aux + (size_t)(t0 + i) * 64 + AX_LA + r); a1v[r] = t2.x; a1v[r + 1] = t2.y; }
#pragma unroll
        for (int r = 0; r < 16; ++r) {
            f32x4 wA = *(const f32x4*)(wa + r * 128), wB = *(const f32x4*)(wa + r * 128 + 4);
#pragma unroll
            for (int j = 0; j < 4; ++j) { acc[j] += a1v[r] * wA[j]; acc[4 + j] += a1v[r] * wB[j]; }
        }
#pragma unroll
        for (int j = 0; j < 8; ++j) Bf[i * 33 + d0 + j] = logsigmoidf_(acc[j]) * (1.f / 16.f);
    }
    {
        const bf16_t* lvt = (const bf16_t*)(scr + SCR_LVT) + (size_t)bh * 64 * SEQ + n * 64;
#pragma unroll
        for (int ii = 0; ii < 2; ++ii) { int c = tid + 256 * ii; int row = c >> 3, kc = c & 7; *(u32x4*)(Vt + row * LROW + kc * 8) = *(const u32x4*)(lvt + (size_t)row * SEQ + kc * 8); }
    }
    __syncthreads();
#pragma unroll
    for (int c = 0; c < 8; ++c) {
        const int d = 8 * w + c;
        float inc = Bf[lane * 33 + d];
#pragma unroll
        for (int o = 1; o < 64; o <<= 1) { float t = __shfl_up(inc, o, 64); if (lane >= o) inc += t; }
        Bf[lane * 33 + d] = inc;
    }
    __syncthreads();
    {
        const bf16_t* qp = proj + (size_t)(t0 + i) * NPROJ + NC_LQ + h * 32 + d0;
        const bf16_t* kp = proj + (size_t)(t0 + i) * NPROJ + NC_LK + h * 32 + d0;
        u32x4 qu = *(const u32x4*)qp, ku = *(const u32x4*)kp;
        float qf[8] = {bflo(qu[0]), bfhi(qu[0]), bflo(qu[1]), bfhi(qu[1]), bflo(qu[2]), bfhi(qu[2]), bflo(qu[3]), bfhi(qu[3])};
        float kf[8] = {bflo(ku[0]), bfhi(ku[0]), bflo(ku[1]), bfhi(ku[1]), bflo(ku[2]), bfhi(ku[2]), bflo(ku[3]), bfhi(ku[3])};
        float qt[8], kt[8], qb[8];
#pragma unroll
        for (int j = 0; j < 8; ++j) {
            const float bi = Bf[i * 33 + d0 + j], bm = Bf[31 * 33 + d0 + j], bl = Bf[63 * 33 + d0 + j];
            qt[j] = qf[j] * __expf(bi - bm); kt[j] = kf[j] * __expf(bm - bi); qb[j] = qf[j] * __expf(bi);
            KLt[(d0 + j) * LROW + i] = f2bf(kf[j] * __expf(bl - bi));
            if (i == 63) ((float*)(scr + SCR_GLA_DL))[cid * 32 + d0 + j] = __expf(bl);
        }
        u32x4 o; o[0] = pk_bf16(qt[0], qt[1]); o[1] = pk_bf16(qt[2], qt[3]); o[2] = pk_bf16(qt[4], qt[5]); o[3] = pk_bf16(qt[6], qt[7]);
        *(u32x4*)(Qt + i * GQROW + d0) = o;
        o[0] = pk_bf16(kt[0], kt[1]); o[1] = pk_bf16(kt[2], kt[3]); o[2] = pk_bf16(kt[4], kt[5]); o[3] = pk_bf16(kt[6], kt[7]);
        *(u32x4*)(Kt + i * GQROW + d0) = o;
        o[0] = pk_bf16(qb[0], qb[1]); o[1] = pk_bf16(qb[2], qb[3]); o[2] = pk_bf16(qb[4], qb[5]); o[3] = pk_bf16(qb[6], qb[7]);
        *(u32x4*)((bf16_t*)(scr + SCR_GLA_QB) + (size_t)cid * 2048 + i * 32 + d0) = o;
    }
    __syncthreads();
    f32x4 sc[4];
    {
        bf16x8 bq = *(const bf16x8*)(Qt + (16 * w + fr) * GQROW + fg * 8);
#pragma unroll
        for (int mt = 0; mt < 4; ++mt) {
            bf16x8 a = *(const bf16x8*)(Kt + (16 * mt + fr) * GQROW + fg * 8);
            sc[mt] = __builtin_amdgcn_mfma_f32_16x16x32_bf16(a, bq, (f32x4){0.f, 0.f, 0.f, 0.f}, 0, 0, 0);
        }
        const int ii = 16 * w + fr;
#pragma unroll
        for (int mt = 0; mt < 4; ++mt)
#pragma unroll
            for (int r = 0; r < 4; ++r) { const int j = 16 * mt + 4 * fg + r; if (j > ii) sc[mt][r] = 0.f; }
    }
    {
        f32x4 o4[4]; zero4(o4);
#pragma unroll
        for (int kk = 0; kk < 2; ++kk) {
            u32x4 pb = {pk_bf16(sc[2 * kk][0], sc[2 * kk][1]), pk_bf16(sc[2 * kk][2], sc[2 * kk][3]), pk_bf16(sc[2 * kk + 1][0], sc[2 * kk + 1][1]), pk_bf16(sc[2 * kk + 1][2], sc[2 * kk + 1][3])};
#pragma unroll
            for (int mt = 0; mt < 4; ++mt) {
                uint2 v0 = *(const uint2*)(Vt + (16 * mt + fr) * LROW + 32 * kk + 4 * fg), v1 = *(const uint2*)(Vt + (16 * mt + fr) * LROW + 32 * kk + 16 + 4 * fg);
                u32x4 va = {v0.x, v0.y, v1.x, v1.y};
                o4[mt] = __builtin_amdgcn_mfma_f32_16x16x32_bf16(__builtin_bit_cast(bf16x8, va), __builtin_bit_cast(bf16x8, pb), o4[mt], 0, 0, 0);
            }
        }
        bf16_t* OL = (bf16_t*)(scr + SCR_GLA_OL) + (size_t)cid * 4096;
#pragma unroll
        for (int mt = 0; mt < 4; ++mt) store4_bf16(OL + (16 * w + fr) * 64 + 16 * mt + 4 * fg, o4[mt][0], o4[mt][1], o4[mt][2], o4[mt][3]);
    }
    {
        f32x4 k4[2] = {(f32x4){0.f, 0.f, 0.f, 0.f}, (f32x4){0.f, 0.f, 0.f, 0.f}};
#pragma unroll
        for (int ks = 0; ks < 2; ++ks) {
            bf16x8 bv = *(const bf16x8*)(Vt + (16 * w + fr) * LROW + ks * 32 + fg * 8);
#pragma unroll
            for (int mt = 0; mt < 2; ++mt) {
                bf16x8 a = *(const bf16x8*)(KLt + (16 * mt + fr) * LROW + ks * 32 + fg * 8);
                k4[mt] = __builtin_amdgcn_mfma_f32_16x16x32_bf16(a, bv, k4[mt], 0, 0, 0);
            }
        }
        float* KV = (float*)(scr + SCR_GLA_KV) + (size_t)cid * 2048;
#pragma unroll
        for (int mt = 0; mt < 2; ++mt) *(f32x4*)(KV + (16 * w + fr) * 32 + 16 * mt + 4 * fg) = k4[mt];
    }
}
__device__ void gla_scan_item(const Params& p, int g) {
    const int tid = ltid();
    const int bh = g >> 3, idx = (g & 7) * 256 + tid, d = idx & 31;
    char* scr = p.ws + WS_SCR;
    const float* __restrict__ KV = (const float*)(scr + SCR_GLA_KV) + (size_t)bh * 64 * 2048 + idx;
    const float* __restrict__ DL = (const float*)(scr + SCR_GLA_DL) + bh * 64 * 32 + d;
    bf16_t* __restrict__ SG = (bf16_t*)(scr + SCR_GLA_SG) + (size_t)bh * 64 * 2048 + idx;
    float S = 0.f;
    for (int n0 = 0; n0 < 64; n0 += 8) {
        float kv[8], dl[8];
#pragma unroll
        for (int u = 0; u < 8; ++u) { kv[u] = KV[(size_t)(n0 + u) * 2048]; dl[u] = DL[(n0 + u) * 32]; }
#pragma unroll
        for (int u = 0; u < 8; ++u) { SG[(size_t)(n0 + u) * 2048] = f2bf(S); S = dl[u] * S + kv[u]; }
    }
}
__device__ void gla_out_item(const Params& p, int l, int cid) {
    const int tid = ltid(), lane = tid & 63, w = tid >> 6, fr = lane & 15, fg = lane >> 4;
    const int bh = cid >> 6, n = cid & 63, b = bh / H_GLA, h = bh % H_GLA;
    char* scr = p.ws + WS_SCR;
    const bf16_t* SG = (const bf16_t*)(scr + SCR_GLA_SG) + (size_t)cid * 2048;
    const bf16_t* QB = (const bf16_t*)(scr + SCR_GLA_QB) + (size_t)cid * 2048;
    const bf16_t* OL = (const bf16_t*)(scr + SCR_GLA_OL) + (size_t)cid * 4096;
    const int i = 16 * w + fr; const int t = b * SEQ + n * 64 + i;
    f32x4 acc[4];
#pragma unroll
    for (int mt = 0; mt < 4; ++mt) { uint2 u = *(const uint2*)(OL + i * 64 + 16 * mt + 4 * fg); acc[mt] = (f32x4){bflo(u.x), bfhi(u.x), bflo(u.y), bfhi(u.y)}; }
    bf16x8 bq = *(const bf16x8*)(QB + i * 32 + fg * 8);
#pragma unroll
    for (int mt = 0; mt < 4; ++mt) {
        bf16x8 a = *(const bf16x8*)(SG + (16 * mt + fr) * 32 + fg * 8);
        acc[mt] = __builtin_amdgcn_mfma_f32_16x16x32_bf16(a, bq, acc[mt], 0, 0, 0);
    }
    float ss = 0.f;
#pragma unroll
    for (int mt = 0; mt < 4; ++mt)
#pragma unroll
        for (int r = 0; r < 4; ++r) ss += acc[mt][r] * acc[mt][r];
    ss += __shfl_xor(ss, 16, 64); ss += __shfl_xor(ss, 32, 64);
    const float rstd = rsqrtf(ss * (1.f / 64.f) + 1e-6f);
    const float* og = p.in[13] + l * 64;
    const bf16_t* rp = (const bf16_t*)(p.ws + WS_PROJ) + (size_t)t * NPROJ + NC_LR + h * 64;
    bf16_t* mp = (bf16_t*)(p.ws + WS_MIX) + pl_off(t, 768 + h * 64, 1024);
#pragma unroll
    for (int mt = 0; mt < 4; ++mt) {
        const int e0 = 16 * mt + 4 * fg;
        uint2 gu = *(const uint2*)(rp + e0); f32x4 g4 = *(const f32x4*)(og + e0);
        store4_bf16(mp + e0 + (e0 & 32), acc[mt][0] * rstd * g4[0] * bflo(gu.x), acc[mt][1] * rstd * g4[1] * bfhi(gu.x), acc[mt][2] * rstd * g4[2] * bflo(gu.y), acc[mt][3] * rstd * g4[3] * bfhi(gu.y));
    }
}
__device__ void phase_mixout(const Params& p, int l) {
    for (int it = blockIdx.x; it < NGDN_CH + NGLA_CH; it += gridDim.x) {
        if (it < NGDN_CH) { if (MIXSEL & 1) gdn_out_item(p, l, it); } else { if (MIXSEL & 2) gla_out_item(p, l, it - NGDN_CH); }
    }
}

__device__ void fox_cumsum_item(const Params& p, int l, int bh, float* ldsf) {
    const int tid = ltid(), lane = tid & 63, w = tid >> 6;
    const int b = bh / H_FOX, h = bh % H_FOX;
    const float* aux = (const float*)(p.ws + WS_AUX);
    float* cum = (float*)(p.ws + WS_CUM) + (size_t)bh * SEQ;
    const float fb = p.in[5][l * H_FOX + h];
    float v[16]; float s = 0.f;
#pragma unroll
    for (int i = 0; i < 16; ++i) { v[i] = logsigmoidf_(aux[(size_t)(b * SEQ + tid * 16 + i) * 64 + AX_FF + h] + fb); s += v[i]; }
    float inc = s;
#pragma unroll
    for (int o = 1; o < 64; o <<= 1) { float t = __shfl_up(inc, o, 64); if (lane >= o) inc += t; }
    __syncthreads();
    if (lane == 63) ldsf[w] = inc;
    __syncthreads();
    float base = inc - s;
    for (int ww = 0; ww < w; ++ww) base += ldsf[ww];
    float c = base;
    u32x4* csx = (u32x4*)(p.ws + WS_SCR + SCR_CSX) + (size_t)bh * SEQ;
#pragma unroll
    for (int i = 0; i < 16; ++i) {
        c += v[i]; cum[tid * 16 + i] = c;
        const float vv = 1.4426950408889634f * c;
        const unsigned hi = pk_bf16(vv, 0.f) & 0xffffu; const float r1 = vv - __uint_as_float(hi << 16);
        const unsigned mid = pk_bf16(r1, 0.f) & 0xffffu; const float r2 = r1 - __uint_as_float(mid << 16);
        const unsigned lo = pk_bf16(r2, 0.f) & 0xffffu;
        u32x4 f; f[0] = 0x3F803F80u; f[1] = 0x3F80u | ((hi ^ 0x8000u) << 16); f[2] = (mid ^ 0x8000u) | ((lo ^ 0x8000u) << 16); f[3] = 0u;
        csx[tid * 16 + i] = f;
    }
}
__device__ void phase_prep(const Params& p, int l, unsigned char* lds_raw) {
    const int n0 = BATCH * H_FOX, n1 = n0 + ((MIXSEL & 1) ? NGDN_CH : 0), n2 = n1 + ((MIXSEL & 2) ? NGLA_CH : 0);
    for (int it = blockIdx.x; it < n2; it += gridDim.x) {
        if (it < n0) { __syncthreads(); fox_cumsum_item(p, l, it, (float*)lds_raw); }
        else if (it < n1) gdn_prep_item(p, l, it - n0, lds_raw);
        else gla_prep_item(p, l, it - n1, lds_raw);
    }
}

typedef float f32x16 __attribute__((ext_vector_type(16)));
#define ATT_BUF 17408
#define ATT_THR 8.0f
#define ATT_NSTAGE 3
__device__ __forceinline__ void attn_issue(const bf16_t* const (&kp)[2], const bf16_t* const (&vp)[2], const bf16_t* cp, int s0, unsigned char* stage, int w) {
    bf16_t* Ks = (bf16_t*)stage; bf16_t* Vs = Ks + 4096; bf16_t* cs = Vs + 4096;
    __builtin_amdgcn_global_load_lds((const unsigned*)(kp[0] + (size_t)s0 * NPROJ), (unsigned*)(Ks + (w * 8) * 64), 16, 0, 0);
    __builtin_amdgcn_global_load_lds((const unsigned*)(kp[1] + (size_t)s0 * NPROJ), (unsigned*)(Ks + (32 + w * 8) * 64), 16, 0, 0);
    __builtin_amdgcn_global_load_lds((const unsigned*)(vp[0] + s0), (unsigned*)(Vs + (w * 8) * 64), 16, 0, 0);
    __builtin_amdgcn_global_load_lds((const unsigned*)(vp[1] + s0), (unsigned*)(Vs + (32 + w * 8) * 64), 16, 0, 0);
    __builtin_amdgcn_global_load_lds((const unsigned*)(cp + (size_t)s0 * 8), (unsigned*)cs, 16, 0, 0);
}
__device__ __forceinline__ bf16x8 attn_qbias(float u, int h) {
    const unsigned hi = pk_bf16(u, 0.f) & 0xffffu; const float r1 = u - __uint_as_float(hi << 16);
    const unsigned mid = pk_bf16(r1, 0.f) & 0xffffu; const float r2 = r1 - __uint_as_float(mid << 16);
    const unsigned lo = pk_bf16(r2, 0.f) & 0xffffu;
    u32x4 f; f[0] = hi | (mid << 16); f[1] = lo | (0x3F80u << 16); f[2] = 0x3F803F80u; f[3] = 0u;
    if (h) { f[0] = 0u; f[1] = 0u; f[2] = 0u; }
    return __builtin_bit_cast(bf16x8, f);
}
__device__ void fox_attn_item(const Params& p, int l, int bh, int qt, unsigned char* lds_raw) {
    const int tid = ltid(), lane = tid & 63, w = __builtin_amdgcn_readfirstlane(tid >> 6), r = lane & 31, h = lane >> 5;
    const int b = bh / H_FOX, hh = bh % H_FOX;
    const bf16_t* proj = (const bf16_t*)(p.ws + WS_PROJ);
    const bf16_t* kbase = proj + (size_t)b * SEQ * NPROJ + NC_FK + hh * 64;
    const bf16_t* vbase = (const bf16_t*)(p.ws + WS_VTF) + (size_t)bh * 64 * SEQ;
    const float* cum = (const float*)(p.ws + WS_CUM) + (size_t)bh * SEQ;
    const int qlo = qt * 128 + w * 32, q = qlo + r;
    bf16x8 qf[4];
    {
        const bf16_t* qrow = proj + (size_t)(b * SEQ + q) * NPROJ + NC_FQ + hh * 64;
#pragma unroll
        for (int kk = 0; kk < 4; ++kk) qf[kk] = *(const bf16x8*)(qrow + kk * 16 + h * 8);
    }
    const float cq2 = cum[q] * 1.4426950408889634f;
    float mref = 0.f;
    bf16x8 qx = attn_qbias(cq2 - mref, h);
    f32x16 o0, o1;
#pragma unroll
    for (int i = 0; i < 16; ++i) { o0[i] = 0.f; o1[i] = 0.f; }
    float lsum = 0.f;
    const int ntiles = 2 * qt + 2;
    const bf16_t* kp[2]; const bf16_t* vp[2];
    {
        const int row0 = w * 8 + (lane >> 3), pc = lane & 7;
        const int lc0 = (pc ^ ((row0 >> 1) & 7)) * 8;
        kp[0] = kbase + (size_t)row0 * NPROJ + lc0; kp[1] = kbase + (size_t)(row0 + 32) * NPROJ + lc0;
        vp[0] = vbase + (size_t)row0 * SEQ + lc0;   vp[1] = vbase + (size_t)(row0 + 32) * SEQ + lc0;
    }
    const bf16_t* cp = (const bf16_t*)(p.ws + WS_SCR + SCR_CSX) + (size_t)bh * SEQ * 8 + lane * 8;
    const int swr = (r >> 1) & 7;
    int jw; float zmax_bound;
    {
        float gq = fabsf(p.in[3][l * 64 + lane]), gk = fabsf(p.in[4][l * 64 + lane]);
#pragma unroll
        for (int o = 32; o > 0; o >>= 1) { gq = fmaxf(gq, __shfl_xor(gq, o, 64)); gk = fmaxf(gk, __shfl_xor(gk, o, 64)); }
        const float thr = 2.f * (1.4426950408889634f * 8.f * gq * gk) + 30.f;
        zmax_bound = 1.4426950408889634f * 8.f * gq * gk;
        const float cw = cum[qlo] * 1.4426950408889634f;
        const float ce = (lane < ntiles) ? cum[64 * lane + 63] * 1.4426950408889634f : 0.f;
        const unsigned long long keep = __ballot((lane < ntiles) && (cw - ce >= -thr));
        jw = keep ? (__ffsll((long long)keep) - 1) : (ntiles - 1);
    }
    volatile int* jshare = (volatile int*)(lds_raw + ATT_NSTAGE * ATT_BUF + 16);
    asm volatile("s_waitcnt vmcnt(0)" ::: "memory");
    RAW_BARRIER();
    if (tid == 0) *jshare = jw;
    RAW_BARRIER();
    const int jstart = *jshare;
    const bool no_rescale = (zmax_bound <= 64.f);
    attn_issue(kp, vp, cp, jstart * 64, lds_raw + (jstart % ATT_NSTAGE) * ATT_BUF, w);
    if (jstart + 1 < ntiles) attn_issue(kp, vp, cp, (jstart + 1) * 64, lds_raw + ((jstart + 1) % ATT_NSTAGE) * ATT_BUF, w);
    for (int j = jstart; j < ntiles; ++j) {
        if (j + 1 < ntiles) asm volatile("s_waitcnt vmcnt(5)" ::: "memory"); else asm volatile("s_waitcnt vmcnt(0)" ::: "memory");
        RAW_BARRIER();
        if (j + 2 < ntiles) attn_issue(kp, vp, cp, (j + 2) * 64, lds_raw + ((j + 2) % ATT_NSTAGE) * ATT_BUF, w);
        const int s0 = j * 64;
        if (s0 <= qlo + 31 && j >= jw) {
            const bf16_t* Ks = (const bf16_t*)(lds_raw + (j % ATT_NSTAGE) * ATT_BUF); const bf16_t* Vs = Ks + 4096; const bf16_t* cs = Vs + 4096;
            f32x16 st0, st1;
            {
                u32x4 z4 = {0u, 0u, 0u, 0u};
                u32x4 c0 = *(const u32x4*)(cs + r * 8), c1 = *(const u32x4*)(cs + (32 + r) * 8);
                if (h) { c0 = z4; c1 = z4; }
                f32x16 zz;
#pragma unroll
                for (int i = 0; i < 16; ++i) zz[i] = 0.f;
                st0 = __builtin_amdgcn_mfma_f32_32x32x16_bf16(__builtin_bit_cast(bf16x8, c0), qx, zz, 0, 0, 0);
                st1 = __builtin_amdgcn_mfma_f32_32x32x16_bf16(__builtin_bit_cast(bf16x8, c1), qx, zz, 0, 0, 0);
            }
#pragma unroll
            for (int kk = 0; kk < 4; ++kk) {
                const int co = ((kk * 2 + h) ^ swr) * 8;
                bf16x8 a0 = *(const bf16x8*)(Ks + r * 64 + co);
                bf16x8 a1 = *(const bf16x8*)(Ks + (32 + r) * 64 + co);
                st0 = __builtin_amdgcn_mfma_f32_32x32x16_bf16(a0, qf[kk], st0, 0, 0, 0);
                st1 = __builtin_amdgcn_mfma_f32_32x32x16_bf16(a1, qf[kk], st1, 0, 0, 0);
            }
            if (s0 + 63 > qlo) {
#pragma unroll
                for (int i = 0; i < 16; ++i) {
                    const int key = s0 + (i & 3) + 8 * (i >> 2) + 4 * h;
                    if (key > q) st0[i] = -1e30f;
                    if (key + 32 > q) st1[i] = -1e30f;
                }
            }
            float mx = 0.f;
            if (!no_rescale) {
                mx = fmaxf(st0[0], st1[0]);
#pragma unroll
                for (int i = 1; i < 16; ++i) mx = fmaxf(mx, fmaxf(st0[i], st1[i]));
            }
            if (!no_rescale && __any(mx > ATT_THR)) {
                const float mo = fmaxf(mx, __shfl_xor(mx, 32, 64));
                const float d = (mo > ATT_THR) ? mo : 0.f;
                const float alpha = __builtin_amdgcn_exp2f(-d);
#pragma unroll
                for (int i = 0; i < 16; ++i) { st0[i] -= d; st1[i] -= d; o0[i] *= alpha; o1[i] *= alpha; }
                lsum *= alpha; mref += d;
                qx = attn_qbias(cq2 - mref, h);
            }
            float rs = 0.f;
#pragma unroll
            for (int i = 0; i < 16; ++i) { st0[i] = __builtin_amdgcn_exp2f(st0[i]); st1[i] = __builtin_amdgcn_exp2f(st1[i]); rs += st0[i] + st1[i]; }
            lsum += rs;
            bf16x8 pf[2][2];
#pragma unroll
            for (int s = 0; s < 2; ++s) {
                u32x4 t0 = {pk_bf16(st0[8 * s], st0[8 * s + 1]), pk_bf16(st0[8 * s + 2], st0[8 * s + 3]), pk_bf16(st0[8 * s + 4], st0[8 * s + 5]), pk_bf16(st0[8 * s + 6], st0[8 * s + 7])};
                u32x4 t1 = {pk_bf16(st1[8 * s], st1[8 * s + 1]), pk_bf16(st1[8 * s + 2], st1[8 * s + 3]), pk_bf16(st1[8 * s + 4], st1[8 * s + 5]), pk_bf16(st1[8 * s + 6], st1[8 * s + 7])};
                pf[0][s] = __builtin_bit_cast(bf16x8, t0); pf[1][s] = __builtin_bit_cast(bf16x8, t1);
            }
#pragma unroll
            for (int mt = 0; mt < 2; ++mt)
#pragma unroll
                for (int s = 0; s < 2; ++s) {
                    const int c0 = 4 * mt + 2 * s;
                    const int oA = ((c0 ^ swr) * 8) + 4 * h, oB = (((c0 + 1) ^ swr) * 8) + 4 * h;
                    uint2 a00 = *(const uint2*)(Vs + r * 64 + oA), a01 = *(const uint2*)(Vs + r * 64 + oB);
                    uint2 a10 = *(const uint2*)(Vs + (32 + r) * 64 + oA), a11 = *(const uint2*)(Vs + (32 + r) * 64 + oB);
                    u32x4 u0 = {a00.x, a00.y, a01.x, a01.y}; u32x4 u1 = {a10.x, a10.y, a11.x, a11.y};
                    o0 = __builtin_amdgcn_mfma_f32_32x32x16_bf16(__builtin_bit_cast(bf16x8, u0), pf[mt][s], o0, 0, 0, 0);
                    o1 = __builtin_amdgcn_mfma_f32_32x32x16_bf16(__builtin_bit_cast(bf16x8, u1), pf[mt][s], o1, 0, 0, 0);
                }
        }
    }
    lsum += __shfl_xor(lsum, 32, 64);
    const float inv = 1.f / lsum;
    float ss = 0.f;
#pragma unroll
    for (int i = 0; i < 16; ++i) { o0[i] *= inv; o1[i] *= inv; ss += o0[i] * o0[i] + o1[i] * o1[i]; }
    ss += __shfl_xor(ss, 32, 64);
    const float rstd = rsqrtf(ss * (1.f / 64.f) + 1e-6f);
    const float* og = p.in[6] + l * 64;
    bf16_t* mrow = (bf16_t*)(p.ws + WS_MIX) + pl_off(b * SEQ + q, hh * 64, 1024);
#pragma unroll
    for (int g = 0; g < 4; ++g) {
        const int e0 = 8 * g + 4 * h;
        f32x4 g0 = *(const f32x4*)(og + e0), g1 = *(const f32x4*)(og + 32 + e0);
        store4_bf16(mrow + e0, o0[4 * g] * rstd * g0[0], o0[4 * g + 1] * rstd * g0[1], o0[4 * g + 2] * rstd * g0[2], o0[4 * g + 3] * rstd * g0[3]);
        store4_bf16(mrow + 64 + e0, o1[4 * g] * rstd * g1[0], o1[4 * g + 1] * rstd * g1[1], o1[4 * g + 2] * rstd * g1[2], o1[4 * g + 3] * rstd * g1[3]);
    }
}
#define ATT_ITEMS (BATCH * H_FOX * (SEQ / 128))
#define CONV_ITEMS ((CONV_REST + P0_T_IN + 3) / 4)
__device__ void phase_scan_attn(const Params& p, int l, unsigned char* lds_raw, int rep = 0, int sel = 7) {
    unsigned* qctr = (unsigned*)(p.ws + WS_CTL) + CW_Q + l + 2 * rep;
    volatile int* slot = (volatile int*)(lds_raw + ATT_NSTAGE * ATT_BUF);
    for (;;) {
        __syncthreads();
        if (threadIdx.x == 0) *slot = (int)atomicAdd(qctr, 1u);
        __syncthreads();
        int it = *slot;
        const int ns0 = (MIXSEL & 1) ? BATCH * H_GDN * 4 : 0, ns1 = ns0 + ((MIXSEL & 2) ? 128 : 0);
        if (it >= ns1 + ATT_ITEMS + CONV_ITEMS) break;
        if (it >= ns1) {
            const int c = it - ns1;
            int conv_idx = -1;
            if (c < 5 * ATT_ITEMS) { if (c % 5 != 0) conv_idx = c - c / 5 - 1; } else conv_idx = c - ATT_ITEMS;
            if (conv_idx >= 0) {
                if (rep == 0 && conv_idx < CONV_ITEMS) conv_fold4(p, l, conv_idx * 4, ltid());
                continue;
            }
            it = ns1 + c / 5;
        }
        if (it < ns0) { if (sel & 1) gdn_scan_item(p, it, lds_raw, rep ? SVAR : 0); continue; }
        if (it < ns1) { if (sel & 2) gla_scan_item(p, it - ns0); continue; }
        it -= ns1;
        if (!(sel & 4)) continue;
        const int qt = (SEQ / 128 - 1) - it / (BATCH * H_FOX), bh = it % (BATCH * H_FOX);
        fox_attn_item(p, l, bh, qt, lds_raw);
    }
}

#define NPHASE 19
__global__ void __launch_bounds__(256, 2) mk(Params p, int lo, int hi, int use_bar) {
    __shared__ __attribute__((aligned(16))) unsigned char lds_raw[LDS_BYTES];
    bf16_t* lds = (bf16_t*)lds_raw;
    volatile LAS unsigned* st = (volatile LAS unsigned*)(lds_raw + LDS_BYTES - 16);
    XcdBarrier bar; bar.bar = (unsigned*)(p.ws + WS_CTL) + CW_BAR; bar.x = 0; bar.st = st;
    if (use_bar) {
        if (threadIdx.x == 0) { st[0] = 0u; st[1] = 0u; }
        __syncthreads();
        bar = xcd_barrier_post((unsigned*)(p.ws + WS_CTL) + CW_BAR, st);
    }
    for (int ph = lo; ph < hi; ++ph) {
#ifndef PSEL
#define PSEL 0xffff
#endif
        int phv = ph; asm volatile("" : "+s"(phv));
        size_t zoff = 0; asm volatile("" : "+s"(zoff));
        Params q = p; q.ws = p.ws + zoff; q.out = p.out + zoff;
        if (phv == 0) { if (PSEL & 1) phase0(q); }
        else {
            int l = (phv - 1) / 9, s = (phv - 1) % 9;
            if (s == 0) { if (PSEL & 2) phase_inproj(q, l, lds); }
            else if (s == 1) { if (PSEL & 128) phase_prep(q, l, lds_raw); }
            else if (s == 2) { if (PSEL & 256) phase_scan_attn(q, l, lds_raw); }
            else if (s == 3) { if (PSEL & 512) phase_mixout(q, l); }
            else if (s == 4) { if (PSEL & 4) phase_outproj(q, l, lds); }
            else if (s == 5) { if (PSEL & 8) phase_route(q, l, lds); }
            else if (s == 6) { if (PSEL & 16) phase_expert<0>(q, l, lds); }
            else if (s == 7) { if (PSEL & 32) phase_expert<1>(q, l, lds); }
            else if (s == 8) { if (PSEL & 64) phase_combine(q, l); }
        }
#ifdef REPEAT_MASK
        {
            const int ty = (phv == 0) ? 9 : (phv - 1) % 9, l = (phv == 0) ? 0 : (phv - 1) / 9;
            const bool idem = !((ty == 4 && l == 1));
            if (((REPEAT_MASK >> ty) & 1) && idem && use_bar) {
                xcd_barrier(bar);
                if (ty == 9) phase0(q);
                else if (ty == 0) phase_inproj(q, l, lds, GVAR);
                else if (ty == 1) phase_prep(q, l, lds_raw);
                else if (ty == 2) phase_scan_attn(q, l, lds_raw, 1, P3SEL);
                else if (ty == 3) phase_mixout(q, l);
                else if (ty == 4) phase_outproj(q, l, lds);
                else if (ty == 5) phase_route(q, l, lds, 1);
                else if (ty == 8) phase_combine(q, l, 1);
                else if (ty == 6) phase_expert<0>(q, l, lds);
                else if (ty == 7) phase_expert<1>(q, l, lds);
            }
        }
#endif
        if (ph + 1 < hi) {
            if (hi > 1000) cg::this_grid().sync();
            xcd_barrier(bar);
        }
    }
}

extern "C" void kernel_launch(void* const* d_in, const int* in_sizes, int n_in,
                              void* d_out, int out_size, void* d_ws, size_t ws_size,
                              hipStream_t stream) {
    static int grid = 0;
    if (grid == 0) {
        if (ws_size < WS_END) { fprintf(stderr, "ws too small: need %zu have %zu\n", (size_t)WS_END, ws_size); grid = -1; return; }
        int dev = 0, cus = 0, per_cu = 0;
        hipGetDevice(&dev);
        hipDeviceGetAttribute(&cus, hipDeviceAttributeMultiprocessorCount, dev);
        hipOccupancyMaxActiveBlocksPerMultiprocessor(&per_cu, mk, 256, 0);
        if (per_cu > 2) per_cu = 2;
        if (per_cu < 1) { fprintf(stderr, "occupancy query failed\n"); grid = -1; return; }
        grid = cus * per_cu;
        grid -= grid % 8;
    }
    if (grid < 0) return;
    Params p{};
    for (int i = 0; i < 23; ++i) p.in[i] = (const float*)d_in[i];
    p.out = (float*)d_out; p.ws = (char*)d_ws;
    hipMemsetAsync((char*)d_ws + WS_CTL, 0, CTL_BYTES, stream);
#ifdef POISON_GLA
    hipMemsetAsync((char*)d_ws + WS_SCR + SCR_GLA_OL, 0xFF, SCR_LVT - SCR_GLA_OL, stream);
#endif

#ifdef MULTI_LAUNCH
    for (int ph = 0; ph < NPHASE; ++ph) mk<<<grid, 256, 0, stream>>>(p, ph, ph + 1, 0);
#else
    int lo = 0, hi = NPHASE, ub = 2;
    void* args[] = {&p, &lo, &hi, &ub};
    hipError_t e = hipLaunchCooperativeKernel((void*)mk, dim3(grid), dim3(256), args, 0, stream);
    if (e != hipSuccess) fprintf(stderr, "cooperative launch failed: %s (grid %d)\n", hipGetErrorString(e), grid);
#endif
}
```

```cpp
#include <hip/hip_runtime.h>
#include <hip/hip_cooperative_groups.h>
#include <cstdint>
#include <cstdio>
namespace cg = cooperative_groups;

#define D_MODEL 1024
#define BATCH 4
#define SEQ 4096
#define NTOK (BATCH * SEQ)
#define H_FOX 6
#define H_GDN 6
#define H_GLA 4
#define N_IN 3490
#define N_EXP 32
#define D_EXP 512
#define NPROJ 3456
#define NINP 3584

#define C_FF 1152
#define C_GQ 1158
#define C_GG 2310
#define C_GA 2694
#define C_GB 2700
#define C_LQ 2706
#define C_LA 3474
#define NC_FQ 0
#define NC_FK 384
#define NC_FV 768
#define NC_GQ 1152
#define NC_GK 1536
#define NC_GV 1920
#define NC_GG 2304
#define NC_LQ 2688
#define NC_LK 2816
#define NC_LV 2944
#define NC_LR 3200
#define AX_FF 0
#define AX_GA 6
#define AX_GB 12
#define AX_LA 18

#ifndef SVAR
#define SVAR 0
#endif
#ifndef P3SEL
#define P3SEL 7
#endif
#ifndef GVAR
#define GVAR 0
#endif
#ifndef MIXSEL
#define MIXSEL 3
#endif
typedef unsigned short bf16_t;
typedef short bf16x8 __attribute__((ext_vector_type(8)));
typedef float f32x4 __attribute__((ext_vector_type(4)));
typedef unsigned u32x4 __attribute__((ext_vector_type(4)));
typedef unsigned u32x2 __attribute__((ext_vector_type(2)));

#define WS_CTL      0
#define CTL_BYTES   262144
#define WS_WIN      (WS_CTL + CTL_BYTES)
#define WS_WOUT     (WS_WIN + (size_t)2 * NINP * 1024 * 2)
#define WS_WGU      (WS_WOUT + (size_t)2 * 1024 * 1024 * 2)
#define WS_WD       (WS_WGU + (size_t)2 * 32 * 1024 * 1024 * 2)
#define WS_WR       (WS_WD + (size_t)2 * 32 * 1024 * 512 * 2)
#define WS_HN       (WS_WR + (size_t)2 * 64 * 1024 * 2)
#define WS_PROJ     (WS_HN + (size_t)NTOK * 1024 * 2)
#define WS_VTF      (WS_PROJ + (size_t)NTOK * NPROJ * 2)
#define WS_AUX      (WS_VTF + (size_t)BATCH * H_FOX * 64 * SEQ * 2)
#define WS_CUM      (WS_AUX + (size_t)NTOK * 64 * 4)
#define WS_MIX      (WS_CUM + (size_t)BATCH * H_FOX * SEQ * 4)
#define WS_ROWTOK   (WS_MIX + (size_t)NTOK * 1024 * 2)
#define WS_TSLOT    (WS_ROWTOK + (size_t)32 * NTOK * 4)
#define WS_TGATE    (WS_TSLOT + (size_t)NTOK * 2 * 4)
#define WS_SCR      (WS_TGATE + (size_t)NTOK * 2 * 4)
#define SCR_BYTES   ((size_t)100 * 1024 * 1024)
#define WS_END      (WS_SCR + SCR_BYTES)
#define HROWS       (2 * NTOK + 32 * 128)
#define WS_H        WS_PROJ
#define WS_Y        (WS_PROJ + (size_t)HROWS * 512 * 2)

#define NGDN_CH 1536
#define NGLA_CH 1024
#define SCR_GDN_MP   ((size_t)0)
#define SCR_GDN_NN   (SCR_GDN_MP + (size_t)NGDN_CH * 8192)
#define SCR_GDN_P    (SCR_GDN_NN + (size_t)NGDN_CH * 8192)
#define SCR_GDN_OL   (SCR_GDN_P  + (size_t)NGDN_CH * 8192)
#define SCR_GDN_SG   (SCR_GDN_OL + (size_t)NGDN_CH * 8192)
#define SCR_GDN_LAST (SCR_GDN_SG + (size_t)NGDN_CH * 8192)
#define SCR_GLA_OL   (SCR_GDN_LAST + (size_t)NGDN_CH * 4)
#define SCR_GLA_KV   (SCR_GLA_OL + (size_t)NGLA_CH * 8192)
#define SCR_GLA_QB   (SCR_GLA_KV + (size_t)NGLA_CH * 8192)
#define SCR_GLA_SG   (SCR_GLA_QB + (size_t)NGLA_CH * 4096)
#define SCR_GLA_DL   (SCR_GLA_SG + (size_t)NGLA_CH * 4096)
#define SCR_LVT      (SCR_GLA_DL + (size_t)NGLA_CH * 128)
#define SCR_USED     (SCR_LVT + (size_t)BATCH * H_GLA * 64 * SEQ * 2)
#define SCR_XB       ((size_t)0)
#define SCR_CSX      SCR_USED
static_assert(SCR_CSX + (size_t)BATCH * H_FOX * SEQ * 16 <= SCR_BYTES, "scratch overflow");
#define CW_BAR      0
#define CW_CNT      4096
#define CNT_STRIDE  64
#define NSH         8
#define SHCAP       2048
#define CW_Q        (CW_CNT + 2 * 32 * NSH * CNT_STRIDE + 64)
#define CW_MOETAB   (CW_Q + 256)

struct Params {
    const float* in[23];
    float* out;
    char* ws;
};

__device__ __forceinline__ float sigmoidf_(float x) { return __builtin_amdgcn_rcpf(1.f + __expf(-x)); }
__device__ __forceinline__ float siluf_(float x) { return x * __builtin_amdgcn_rcpf(1.f + __expf(-x)); }
__device__ __forceinline__ float softplusf_(float x) { return x > 20.f ? x : __logf(1.f + __expf(x)); }
__device__ __forceinline__ float logsigmoidf_(float x) { return -softplusf_(-x); }
__device__ __forceinline__ float wave_sum(float v) {
#pragma unroll
    for (int o = 32; o > 0; o >>= 1) v += __shfl_xor(v, o, 64);
    return v;
}
__device__ __forceinline__ int ltid() { int t = threadIdx.x; asm volatile("" : "+v"(t)); return t; }
typedef __bf16 bf16x2_t __attribute__((ext_vector_type(2)));
typedef float f32x2_t __attribute__((ext_vector_type(2)));
__device__ __forceinline__ unsigned pk_bf16(float lo, float hi) { f32x2_t v = {lo, hi}; bf16x2_t r = __builtin_convertvector(v, bf16x2_t); return __builtin_bit_cast(unsigned, r); }
__device__ __forceinline__ size_t pl_off(int row, int k, int K) { return (size_t)(row >> 1) * (size_t)(2 * K) + (size_t)((k >> 5) * 64 + (row & 1) * 32 + (k & 31)); }
__device__ __forceinline__ unsigned ld_u32_agent(const unsigned* p) { return __hip_atomic_load(p, __ATOMIC_RELAXED, __HIP_MEMORY_SCOPE_AGENT); }
__device__ __forceinline__ float ld_f32_agent(const float* p) { return __uint_as_float(__hip_atomic_load((const unsigned*)p, __ATOMIC_RELAXED, __HIP_MEMORY_SCOPE_AGENT)); }
__device__ __forceinline__ float bf2f(bf16_t v) { return __uint_as_float((unsigned)v << 16); }
__device__ __forceinline__ float bflo(unsigned v) { return __uint_as_float(v << 16); }
__device__ __forceinline__ float bfhi(unsigned v) { return __uint_as_float(v & 0xffff0000u); }

#define XB_TMO      128
#define XB_XCNT(j)  (256  + 64 * (j))
#define XB_XSUB(j)  (1280 + 64 * (j))
#define XB_XGEN(j)  (2304 + 64 * (j))
#define XB_TOP      3328
#define XB_TOPGEN   3392
#define XCD_BAR_WORDS 3456
#define XB_SPIN_CAP (1u << 22)
#define LAS __attribute__((address_space(3)))
__device__ __forceinline__ unsigned xb_ld(unsigned* p)              { return __hip_atomic_load(p, __ATOMIC_RELAXED, __HIP_MEMORY_SCOPE_AGENT); }
__device__ __forceinline__ unsigned xb_add(unsigned* p, unsigned v) { return __hip_atomic_fetch_add(p, v, __ATOMIC_RELAXED, __HIP_MEMORY_SCOPE_AGENT); }
__device__ __forceinline__ unsigned xb_xcc_id() { return (unsigned)__builtin_amdgcn_s_getreg((3 << 11) | 20) & 0xFu; }
#define XB_SPIN(cond, bar) do { unsigned _sp = 0; while (cond) { if (_sp < 16u) __builtin_amdgcn_s_sleep(2); else __builtin_amdgcn_s_sleep(20);     \
    if ((++_sp & 255u) == 0u) { if (xb_ld(&(bar)[XB_TMO])) break; if (_sp > XB_SPIN_CAP) { atomicAdd(&(bar)[XB_TMO], 1u); break; } } } } while (0)
struct XcdBarrier { unsigned* bar; unsigned x; volatile LAS unsigned* st; };
__device__ __forceinline__ XcdBarrier xcd_barrier_post(unsigned* bar, volatile LAS unsigned* st) {
    XcdBarrier b; b.bar = bar; b.x = xb_xcc_id(); b.st = st;
    if (threadIdx.x == 0) (void)xb_add(&bar[XB_XCNT(b.x)], 1u);
    return b;
}
__device__ __forceinline__ void xcd_barrier_complete(unsigned* bar, unsigned x, unsigned& nloc, unsigned& nx) {
    const unsigned G = gridDim.x * gridDim.y * gridDim.z;
    unsigned sum, cnt, mine, sp = 0u;
    for (;;) {
        sum = 0u; cnt = 0u; mine = 0u;
#pragma unroll
        for (unsigned j = 0; j < 16; ++j) { const unsigned c = xb_ld(&bar[XB_XCNT(j)]); sum += c; cnt += (c > 0u) ? 1u : 0u; mine = (j == x) ? c : mine; }
        if (sum == G) break;
        __builtin_amdgcn_s_sleep(1);
        if ((++sp & 255u) == 0u) { if (xb_ld(&bar[XB_TMO])) break; if (sp > XB_SPIN_CAP) { atomicAdd(&bar[XB_TMO], 1u); break; } }
    }
    nloc = mine > 0u ? mine : 1u; nx = cnt > 0u ? cnt : 1u;
}
__device__ __forceinline__ void xcd_barrier(const XcdBarrier& b) {
    asm volatile("s_waitcnt vmcnt(0)" ::: "memory");
    __syncthreads();
    if (threadIdx.x == 0) {
        unsigned* bar = b.bar;
        __builtin_amdgcn_s_waitcnt(0);
        unsigned nloc = b.st[0], nx = b.st[1];
        if (nloc == 0u) { xcd_barrier_complete(bar, b.x, nloc, nx); b.st[0] = nloc; b.st[1] = nx; }
        const unsigned old = xb_add(&bar[XB_XSUB(b.x)], 1u);
        const unsigned gen = old / nloc;
        if (old + 1u == (gen + 1u) * nloc) {
            __builtin_amdgcn_fence(__ATOMIC_RELEASE, "agent");
            asm volatile("s_waitcnt vmcnt(0)" ::: "memory");
            const unsigned og = xb_add(&bar[XB_TOP], 1u);
            const unsigned tg = og / nx;
            if (og + 1u == (tg + 1u) * nx) xb_add(&bar[XB_TOPGEN], 1u);
            else XB_SPIN(xb_ld(&bar[XB_TOPGEN]) == tg, bar);
            __builtin_amdgcn_fence(__ATOMIC_ACQUIRE, "agent");
            xb_add(&bar[XB_XGEN(b.x)], 1u);
            asm volatile("s_waitcnt vmcnt(0)" ::: "memory");
        } else {
            XB_SPIN(xb_ld(&bar[XB_XGEN(b.x)]) == gen, bar);
            __builtin_amdgcn_fence(__ATOMIC_ACQUIRE, "agent");
            asm volatile("s_waitcnt vmcnt(0)" ::: "memory");
        }
    }
    __syncthreads();
}

#define LDS_BYTES 68096
#define LROW 72

__device__ __forceinline__ int inproj_map(int n) {
    if (n < 1152) return n;
    if (n < 2304) return C_GQ + (n - 1152);
    if (n < 2688) return C_GG + (n - 2304);
    if (n < 3456) return C_LQ + (n - 2688);
    if (n < 3462) return C_FF + (n - 3456);
    if (n < 3468) return C_GA + (n - 3462);
    if (n < 3474) return C_GB + (n - 3468);
    if (n < 3490) return n;
    return -1;
}
#define P0_T_IN   (56 * 16)
#define P0_T_OUT  (16 * 16)
#define P0_T_GU   (32 * 16 * 16)
#define P0_T_D    (32 * 16 * 8)
#define P0_T_R    (16)
#define P0_T_LAYER (P0_T_IN + P0_T_OUT + P0_T_GU + P0_T_D + P0_T_R)
#define P0_T_NORM (NTOK / 4)
struct ConvDesc { const float* src; bf16_t* dst; int ld; int col; };
__device__ __forceinline__ ConvDesc conv_desc(const Params& p, int l, int j, int tid) {
    const int nl = tid & 63, kg = tid >> 6;
    ConvDesc d;
    if (j < P0_T_IN) {
        int tn = j / 16, tk = j % 16; int n = tn * 64 + nl; int k0 = tk * 64 + kg * 16;
        d.ld = N_IN; d.col = inproj_map(n); d.src = p.in[2] + (size_t)l * 1024 * N_IN + (size_t)k0 * N_IN;
        d.dst = (bf16_t*)(p.ws + WS_WIN) + (size_t)l * NINP * 1024 + pl_off(n, k0, 1024);
        return d;
    }
    j -= P0_T_IN;
    if (j < P0_T_OUT) {
        int tn = j / 16, tk = j % 16; int n = tn * 64 + nl; int k0 = tk * 64 + kg * 16;
        d.ld = 1024; d.col = n; d.src = p.in[14] + (size_t)l * 1024 * 1024 + (size_t)k0 * 1024;
        d.dst = (bf16_t*)(p.ws + WS_WOUT) + (size_t)l * 1024 * 1024 + pl_off(n, k0, 1024);
        return d;
    }
    j -= P0_T_OUT;
    if (j < P0_T_GU) {
        int e = j / 256, r = j % 256; int tn = r / 16, tk = r % 16; int n = tn * 64 + nl; int k0 = tk * 64 + kg * 16;
        int t128 = n >> 7, wx = (n >> 6) & 1, half = (n >> 5) & 1, jj = n & 31;
        d.ld = 512; d.col = t128 * 64 + wx * 32 + jj;
        d.src = (half ? p.in[21] : p.in[20]) + ((size_t)l * 32 + e) * 1024 * 512 + (size_t)k0 * 512;
        d.dst = (bf16_t*)(p.ws + WS_WGU) + ((size_t)l * 32 + e) * 1024 * 1024 + pl_off(n, k0, 1024);
        return d;
    }
    j -= P0_T_GU;
    if (j < P0_T_D) {
        int e = j / 128, r = j % 128; int tn = r / 8, tk = r % 8; int n = tn * 64 + nl; int k0 = tk * 64 + kg * 16;
        d.ld = 1024; d.col = n; d.src = p.in[22] + ((size_t)l * 32 + e) * 512 * 1024 + (size_t)k0 * 1024;
        d.dst = (bf16_t*)(p.ws + WS_WD) + ((size_t)l * 32 + e) * 1024 * 512 + pl_off(n, k0, 512);
        return d;
    }
    j -= P0_T_D;
    {
        int tk = j; int n = nl; int k0 = tk * 64 + kg * 16;
        if (n < 4) { d.src = p.in[16] + (size_t)l * 1024 * 4 + (size_t)k0 * 4; d.ld = 4; d.col = n; }
        else if (n < 36) { d.src = p.in[18] + (size_t)l * 1024 * 32 + (size_t)k0 * 32; d.ld = 32; d.col = n - 4; }
        else { d.src = p.in[16]; d.ld = 4; d.col = -1; }
        d.dst = (bf16_t*)(p.ws + WS_WR) + ((size_t)l * 64 + n) * 1024 + k0;
        return d;
    }
}
__device__ __forceinline__ void conv_load(const ConvDesc& d, float (&v)[16]) {
    if (d.col >= 0) {
#pragma unroll
        for (int i = 0; i < 16; ++i) v[i] = d.src[(size_t)i * d.ld + d.col];
    } else {
#pragma unroll
        for (int i = 0; i < 16; ++i) v[i] = 0.f;
    }
}
__device__ __forceinline__ void conv_store(const ConvDesc& d, const float (&v)[16]) {
    uint4 o0, o1;
    o0.x = pk_bf16(v[0], v[1]); o0.y = pk_bf16(v[2], v[3]); o0.z = pk_bf16(v[4], v[5]); o0.w = pk_bf16(v[6], v[7]);
    o1.x = pk_bf16(v[8], v[9]); o1.y = pk_bf16(v[10], v[11]); o1.z = pk_bf16(v[12], v[13]); o1.w = pk_bf16(v[14], v[15]);
    *(uint4*)(d.dst) = o0;
    *(uint4*)(d.dst + 8) = o1;
}
__device__ __forceinline__ void conv_job(const Params& p, int l, int j, int tid) {
    ConvDesc d = conv_desc(p, l, j, tid); float v[16]; conv_load(d, v); conv_store(d, v);
}
#define CONV_REST (P0_T_LAYER - P0_T_IN)
__device__ __forceinline__ bool conv_fold_desc(const Params& p, int l, int idx, int tid, ConvDesc& d) {
    if (idx < CONV_REST) { d = conv_desc(p, l, P0_T_IN + idx, tid); return true; }
    if (l == 0 && idx < CONV_REST + P0_T_IN) { d = conv_desc(p, 1, idx - CONV_REST, tid); return true; }
    return false;
}
__device__ __forceinline__ void conv_fold4(const Params& p, int l, int idx0, int tid) {
    ConvDesc d0, d1, d2, d3; float v0[16], v1[16], v2[16], v3[16];
    const bool b0 = conv_fold_desc(p, l, idx0, tid, d0), b1 = conv_fold_desc(p, l, idx0 + 1, tid, d1), b2 = conv_fold_desc(p, l, idx0 + 2, tid, d2), b3 = conv_fold_desc(p, l, idx0 + 3, tid, d3);
    if (b0) conv_load(d0, v0); if (b1) conv_load(d1, v1); if (b2) conv_load(d2, v2); if (b3) conv_load(d3, v3);
    if (b0) conv_store(d0, v0); if (b1) conv_store(d1, v1); if (b2) conv_store(d2, v2); if (b3) conv_store(d3, v3);
}
__device__ void phase0(const Params& p) {
    const int tid = ltid(), nl = tid & 63, kg = tid >> 6;
    const int total = P0_T_IN + P0_T_NORM;
    for (int it = blockIdx.x; it < total; it += gridDim.x) {
        if (it >= P0_T_IN) {
            int row = (it - P0_T_IN) * 4 + kg;
            const float* xr = p.in[0] + (size_t)row * D_MODEL + nl * 16;
            const float* gr = p.in[1] + nl * 16;
            float v[16]; float ss = 0.f;
#pragma unroll
            for (int i = 0; i < 4; ++i) { float4 t = *(const float4*)(xr + 4 * i); v[4 * i] = t.x; v[4 * i + 1] = t.y; v[4 * i + 2] = t.z; v[4 * i + 3] = t.w; }
#pragma unroll
            for (int i = 0; i < 16; ++i) ss += v[i] * v[i];
            ss = wave_sum(ss);
            float r = rsqrtf(ss / D_MODEL + 1e-6f);
#pragma unroll
            for (int i = 0; i < 16; ++i) v[i] = v[i] * r * gr[i];
            uint4 o0, o1;
            o0.x = pk_bf16(v[0], v[1]); o0.y = pk_bf16(v[2], v[3]); o0.z = pk_bf16(v[4], v[5]); o0.w = pk_bf16(v[6], v[7]);
            o1.x = pk_bf16(v[8], v[9]); o1.y = pk_bf16(v[10], v[11]); o1.z = pk_bf16(v[12], v[13]); o1.w = pk_bf16(v[14], v[15]);
            bf16_t* hr = (bf16_t*)(p.ws + WS_HN) + pl_off(row, nl * 16, 1024);
            *(uint4*)hr = o0; *(uint4*)(hr + 8) = o1;
            continue;
        }
        conv_job(p, 0, it, tid);
    }
}

#define GSTAGE 8192
#define RAW_BARRIER() do { asm volatile("s_waitcnt lgkmcnt(0)" ::: "memory"); __builtin_amdgcn_s_barrier(); } while (0)
__device__ __forceinline__ int gswz(int row) { return (0x1320 >> (((row >> 2) & 3) * 4)) & 3; }
__device__ __forceinline__ void gemm_issue(const bf16_t* const (&px)[2], const bf16_t* const (&py)[2], int k0, bf16_t* stage, int w) {
    __builtin_amdgcn_global_load_lds((const unsigned*)(px[0] + 2 * k0), (unsigned*)(stage + (w * 16) * 32), 16, 0, 0);
    __builtin_amdgcn_global_load_lds((const unsigned*)(px[1] + 2 * k0), (unsigned*)(stage + (64 + w * 16) * 32), 16, 0, 0);
    __builtin_amdgcn_global_load_lds((const unsigned*)(py[0] + 2 * k0), (unsigned*)(stage + 4096 + (w * 16) * 32), 16, 0, 0);
    __builtin_amdgcn_global_load_lds((const unsigned*)(py[1] + 2 * k0), (unsigned*)(stage + 4096 + (64 + w * 16) * 32), 16, 0, 0);
}
__device__ __forceinline__ void gemm_compute(const bf16_t* stage, int wx, int wy, int fr, int fg, f32x4 (&acc)[4][4]) {
    const int co = (fg ^ gswz(fr)) * 8;
    bf16x8 xa[4], yb[4];
#pragma unroll
    for (int m = 0; m < 4; ++m) xa[m] = *(const bf16x8*)(stage + (wx * 64 + m * 16 + fr) * 32 + co);
#pragma unroll
    for (int n = 0; n < 4; ++n) yb[n] = *(const bf16x8*)(stage + 4096 + (wy * 64 + n * 16 + fr) * 32 + co);
    __builtin_amdgcn_s_setprio(1);
#pragma unroll
    for (int m = 0; m < 4; ++m)
#pragma unroll
        for (int n = 0; n < 4; ++n) acc[m][n] = __builtin_amdgcn_mfma_f32_16x16x32_bf16(xa[m], yb[n], acc[m][n], 0, 0, 0);
    __builtin_amdgcn_s_setprio(0);
}
template <class FX, class FY>
__device__ __forceinline__ void gemm_core(FX rowx, FY rowy, int K, bf16_t* lds, f32x4 (&acc)[4][4], int gvar = 0) {
    const int tid = ltid(), lane = tid & 63, w = __builtin_amdgcn_readfirstlane(tid >> 6), wx = w >> 1, wy = w & 1, fr = lane & 15, fg = lane >> 4;
#pragma unroll
    for (int a = 0; a < 4; ++a)
#pragma unroll
        for (int b = 0; b < 4; ++b) acc[a][b] = (f32x4){0.f, 0.f, 0.f, 0.f};
    const bf16_t* px[2]; const bf16_t* py[2];
    {
        const int r0 = w * 16 + (lane >> 2), pc = lane & 3;
        const int lc0 = (pc ^ gswz(r0)) * 8;
        px[0] = rowx(r0) + lc0; px[1] = rowx(r0 + 64) + lc0;
        py[0] = rowy(r0) + lc0; py[1] = rowy(r0 + 64) + lc0;
    }
    const int nt = K >> 5;
    RAW_BARRIER();
    if (gvar != 3) {
    gemm_issue(px, py, 0, lds, w);
    gemm_issue(px, py, 32, lds + GSTAGE, w);
    gemm_issue(px, py, 64, lds + 2 * GSTAGE, w);
    }
    for (int j = 0; j < nt; ++j) {
        if (j + 2 < nt) asm volatile("s_waitcnt vmcnt(8)" ::: "memory");
        else if (j + 1 < nt) asm volatile("s_waitcnt vmcnt(4)" ::: "memory");
        else asm volatile("s_waitcnt vmcnt(0)" ::: "memory");
        RAW_BARRIER();
        if (j + 3 < nt && gvar != 3) gemm_issue(px, py, (j + 3) * 32, lds + ((j + 3) & 3) * GSTAGE, w);
        if (gvar != 2) gemm_compute(lds + (j & 3) * GSTAGE, wx, wy, fr, fg, acc);
    }
}
__device__ __forceinline__ void store4_bf16(bf16_t* p, float a, float b, float c, float d) {
    uint2 o; o.x = pk_bf16(a, b); o.y = pk_bf16(c, d); *(uint2*)p = o;
}
template <int NC> __device__ __forceinline__ void ep_put(bf16_t* T, int row, int col, float a, float b, float c, float d) {
    uint2 o; o.x = pk_bf16(a, b); o.y = pk_bf16(c, d); *(uint2*)(T + row * (NC + 8) + col) = o;
}
template <int NC, class FD> __device__ __forceinline__ void ep_flush(const bf16_t* T, int tid, FD dst) {
    constexpr int CPR = NC / 8;
#pragma unroll
    for (int i = 0; i < NC / 16; ++i) {
        const int c = tid + 256 * i; const int row = c / CPR, ch = c % CPR;
        *(u32x4*)(dst(row, ch)) = *(const u32x4*)(T + row * (NC + 8) + ch * 8);
    }
}

__device__ __forceinline__ bool xcd_item(int round, int ntm, int ntn, int& tm, int& tn) {
    const int x = blockIdx.x & 7, loc = blockIdx.x >> 3, nloc = gridDim.x >> 3;
    const int tmx = ntm >> 3;
    const int j = round * nloc + loc;
    if (j >= tmx * ntn) return false;
    tn = j / tmx; tm = (j % tmx) * 8 + x;
    return true;
}

__device__ void phase_inproj(const Params& p, int l, bf16_t* lds, int gvar = 0) {
    const int tid = ltid(), lane = tid & 63, w = tid >> 6, wx = w >> 1, wy = w & 1, fr = lane & 15, fg = lane >> 4;
    const bf16_t* hn = (const bf16_t*)(p.ws + WS_HN);
    const bf16_t* wt = (const bf16_t*)(p.ws + WS_WIN) + (size_t)l * NINP * 1024;
    bf16_t* proj = (bf16_t*)(p.ws + WS_PROJ);
    bf16_t* vtf = (bf16_t*)(p.ws + WS_VTF);
    float* aux = (float*)(p.ws + WS_AUX);
    const float* qg = p.in[3] + l * 64; const float* kg = p.in[4] + l * 64;
    for (int round = 0;; ++round) {
        int tm, tn;
        if (gridDim.x == 512) {
            if (round >= 7) break;
            const int x = blockIdx.x & 7, loc = blockIdx.x >> 3; int tml;
            if (round < 6) { tn = (round >> 1) * 8 + (loc & 7); tml = (round & 1) * 8 + (loc >> 3); }
            else { tn = 24 + (loc & 3); tml = loc >> 2; }
            tm = tml * 8 + x;
        } else if (!xcd_item(round, NTOK / 128, NINP / 128, tm, tn)) break;
        const bool vt = (tn >= 6 && tn < 9) || tn == 23 || tn == 24;
        f32x4 acc[4][4];
        {
            auto rw = [&](int r) { return wt + pl_off(tn * 128 + r, 0, 1024); };
            auto rt_ = [&](int r) { return hn + pl_off(tm * 128 + r, 0, 1024); };
            if (vt) gemm_core(rt_, rw, 1024, lds, acc, gvar); else gemm_core(rw, rt_, 1024, lds, acc, gvar);
        }
        if (gvar != 0 && acc[0][0][0] != 123456.789f) continue;
        if (tn == 27) {
#pragma unroll
            for (int n = 0; n < 4; ++n) {
                int t = tm * 128 + wy * 64 + n * 16 + fr;
#pragma unroll
                for (int m = 0; m < 4; ++m) {
                    int c = wx * 64 + m * 16 + 4 * fg;
                    if (c < 64) *(float4*)(aux + (size_t)t * 64 + c) = make_float4(acc[m][n][0], acc[m][n][1], acc[m][n][2], acc[m][n][3]);
                }
            }
            continue;
        }
        RAW_BARRIER();
        if (vt) {
#pragma unroll
            for (int n = 0; n < 4; ++n)
#pragma unroll
                for (int m = 0; m < 4; ++m) ep_put<128>(lds, wy * 64 + n * 16 + fr, wx * 64 + m * 16 + 4 * fg, acc[m][n][0], acc[m][n][1], acc[m][n][2], acc[m][n][3]);
            RAW_BARRIER();
            const bool fox = tn < 9;
            bf16_t* dstb = fox ? vtf : (bf16_t*)(p.ws + WS_SCR + SCR_LVT); const int nh = fox ? H_FOX : H_GLA;
            const int t0 = tm * 128, b = t0 / SEQ, s0 = t0 % SEQ, chb = tn * 128 - (fox ? NC_FV : NC_LV);
            ep_flush<128>(lds, tid, [&](int row, int c8) { const int ch = chb + row; return dstb + ((size_t)(b * nh + (ch >> 6)) * 64 + (ch & 63)) * SEQ + s0 + c8 * 8; });
        } else {
            if (tn < 6) {
                const float* gn = (tn < 3) ? qg : kg; const float sc = (tn < 3) ? 0.125f * 1.4426950408889634f : 1.f;
                float g[4][4];
#pragma unroll
                for (int m = 0; m < 4; ++m)
#pragma unroll
                    for (int r = 0; r < 4; ++r) g[m][r] = gn[m * 16 + 4 * fg + r] * sc;
#pragma unroll
                for (int n = 0; n < 4; ++n) {
                    float ss = 0.f;
#pragma unroll
                    for (int m = 0; m < 4; ++m)
#pragma unroll
                        for (int r = 0; r < 4; ++r) ss += acc[m][n][r] * acc[m][n][r];
                    ss += __shfl_xor(ss, 16, 64); ss += __shfl_xor(ss, 32, 64);
                    float rs = rsqrtf(ss * (1.f / 64.f) + 1e-6f);
#pragma unroll
                    for (int m = 0; m < 4; ++m)
                        ep_put<128>(lds, wy * 64 + n * 16 + fr, wx * 64 + m * 16 + 4 * fg, acc[m][n][0] * rs * g[m][0], acc[m][n][1] * rs * g[m][1], acc[m][n][2] * rs * g[m][2], acc[m][n][3] * rs * g[m][3]);
                }
            } else {
                const bool do_silu = (tn >= 18 && tn < 21) || (tn >= 25);
                const float sc = (tn == 21) ? 0.17677669529663687f : 1.f;
#pragma unroll
                for (int n = 0; n < 4; ++n)
#pragma unroll
                    for (int m = 0; m < 4; ++m) {
                        float v0 = acc[m][n][0] * sc, v1 = acc[m][n][1] * sc, v2 = acc[m][n][2] * sc, v3 = acc[m][n][3] * sc;
                        if (do_silu) { v0 = siluf_(v0); v1 = siluf_(v1); v2 = siluf_(v2); v3 = siluf_(v3); }
                        ep_put<128>(lds, wy * 64 + n * 16 + fr, wx * 64 + m * 16 + 4 * fg, v0, v1, v2, v3);
                    }
            }
            RAW_BARRIER();
            bf16_t* dstb = proj + (size_t)(tm * 128) * NPROJ + tn * 128;
            ep_flush<128>(lds, tid, [&](int row, int c8) { return dstb + (size_t)row * NPROJ + c8 * 8; });
        }
    }
}

__device__ void phase_outproj(const Params& p, int l, bf16_t* lds) {
    const int tid = ltid(), lane = tid & 63, w = tid >> 6, wx = w >> 1, wy = w & 1, fr = lane & 15, fg = lane >> 4;
    const bf16_t* mix = (const bf16_t*)(p.ws + WS_MIX);
    const bf16_t* wt = (const bf16_t*)(p.ws + WS_WOUT) + (size_t)l * 1024 * 1024;
    const float* xin = (l == 0) ? p.in[0] : p.out;
    bf16_t* xb = (bf16_t*)(p.ws + WS_SCR + SCR_XB);
    for (int round = 0;; ++round) {
        int tm, tn;
        if (gridDim.x == 512) {
            if (round >= 2) break;
            const int x = blockIdx.x & 7, loc = blockIdx.x >> 3;
            tn = loc & 7; tm = (round * 8 + (loc >> 3)) * 8 + x;
        } else if (!xcd_item(round, NTOK / 128, 8, tm, tn)) break;
        f32x4 acc[4][4];
        {
            auto rw = [&](int r) { return wt + pl_off(tn * 128 + r, 0, 1024); };
            auto rt_ = [&](int r) { return mix + pl_off(tm * 128 + r, 0, 1024); };
            gemm_core(rw, rt_, 1024, lds, acc);
        }
#pragma unroll
        for (int n = 0; n < 4; ++n) {
            int t = tm * 128 + wy * 64 + n * 16 + fr;
#pragma unroll
            for (int m = 0; m < 4; ++m) {
                int c = tn * 128 + wx * 64 + m * 16 + 4 * fg;
                float4 xv;
                if (l == 0) xv = *(const float4*)(xin + (size_t)t * 1024 + c);
                else { const u32x2 u = *(const u32x2*)((const bf16_t*)p.out + (size_t)t * 1024 + c); xv = make_float4(bflo(u[0]), bfhi(u[0]), bflo(u[1]), bfhi(u[1])); }
                store4_bf16(xb + (size_t)t * 1024 + c, xv.x + acc[m][n][0], xv.y + acc[m][n][1], xv.z + acc[m][n][2], xv.w + acc[m][n][3]);
            }
        }
    }
}

__device__ void phase_route(const Params& p, int l, bf16_t* lds, int dry = 0) {
    const int tid = ltid(), lane = tid & 63, w = tid >> 6, fr = lane & 15, fg = lane >> 4;
    const bf16_t* x1 = (const bf16_t*)(p.ws + WS_SCR + SCR_XB);
    const float* gain = p.in[15] + l * 1024;
    bf16_t* hn = dry ? (bf16_t*)(p.ws + WS_SCR) : (bf16_t*)(p.ws + WS_HN);
    const bf16_t* wr = (const bf16_t*)(p.ws + WS_WR) + (size_t)l * 64 * 1024;
    const float* brg = p.in[17] + l * 4; const float* bre = p.in[19] + l * 32;
    unsigned* cnt = (unsigned*)(p.ws + WS_CTL) + CW_CNT + l * 32 * NSH * CNT_STRIDE;
    int* rowtok = (int*)(p.ws + WS_ROWTOK);
    int* tslot = (int*)(p.ws + WS_TSLOT);
    float* tgate = (float*)(p.ws + WS_TGATE);
    const int HL = 1032;
    float* red = (float*)(lds + 16 * HL);
    for (int it = blockIdx.x; it < NTOK / 16; it += gridDim.x) {
        __syncthreads();
        u32x4 xin4[4][2];
#pragma unroll
        for (int rr = 0; rr < 4; ++rr) {
            const bf16_t* xr = x1 + (size_t)(it * 16 + w * 4 + rr) * 1024 + lane * 16;
            xin4[rr][0] = *(const u32x4*)xr; xin4[rr][1] = *(const u32x4*)(xr + 8);
        }
#pragma unroll
        for (int rr = 0; rr < 4; ++rr) {
            int lr = w * 4 + rr; int t = it * 16 + lr;
            float v[16]; float ss = 0.f;
#pragma unroll
            for (int i = 0; i < 4; ++i) { v[4 * i] = bflo(xin4[rr][i >> 1][(2 * i) & 3]); v[4 * i + 1] = bfhi(xin4[rr][i >> 1][(2 * i) & 3]); v[4 * i + 2] = bflo(xin4[rr][i >> 1][(2 * i + 1) & 3]); v[4 * i + 3] = bfhi(xin4[rr][i >> 1][(2 * i + 1) & 3]); }
#pragma unroll
            for (int i = 0; i < 16; ++i) ss += v[i] * v[i];
            ss = wave_sum(ss);
            float r = rsqrtf(ss / D_MODEL + 1e-6f);
#pragma unroll
            for (int i = 0; i < 16; ++i) v[i] = v[i] * r * gain[lane * 16 + i];
            uint4 o0, o1;
            o0.x = pk_bf16(v[0], v[1]); o0.y = pk_bf16(v[2], v[3]); o0.z = pk_bf16(v[4], v[5]); o0.w = pk_bf16(v[6], v[7]);
            o1.x = pk_bf16(v[8], v[9]); o1.y = pk_bf16(v[10], v[11]); o1.z = pk_bf16(v[12], v[13]); o1.w = pk_bf16(v[14], v[15]);
            bf16_t* hr = hn + pl_off(t, lane * 16, 1024);
            *(uint4*)hr = o0; *(uint4*)(hr + 8) = o1;
            *(uint4*)(lds + lr * HL + lane * 16) = o0; *(uint4*)(lds + lr * HL + lane * 16 + 8) = o1;
        }
        __syncthreads();
        f32x4 acc[3];
#pragma unroll
        for (int n = 0; n < 3; ++n) acc[n] = (f32x4){0.f, 0.f, 0.f, 0.f};
#pragma unroll
        for (int ks = 0; ks < 8; ++ks) {
            int k = w * 256 + ks * 32 + fg * 8;
            bf16x8 a = *(const bf16x8*)(lds + fr * HL + k);
#pragma unroll
            for (int n = 0; n < 3; ++n) {
                bf16x8 b = *(const bf16x8*)(wr + (size_t)(n * 16 + fr) * 1024 + k);
                acc[n] = __builtin_amdgcn_mfma_f32_16x16x32_bf16(a, b, acc[n], 0, 0, 0);
            }
        }
#pragma unroll
        for (int n = 0; n < 3; ++n) *(f32x4*)(red + ((w * 3 + n) * 64 + lane) * 4) = acc[n];
        __syncthreads();
        if (tid < 16) {
            float lg[36];
#pragma unroll
            for (int j = 0; j < 36; ++j) {
                int n = j >> 4, f = j & 15; int ln = (tid >> 2) * 16 + f; float s = 0.f;
#pragma unroll
                for (int ww = 0; ww < 4; ++ww) s += red[((ww * 3 + n) * 64 + ln) * 4 + (tid & 3)];
                lg[j] = s;
            }
            float gl[4]; float gm = -1e30f; int gi = 0;
#pragma unroll
            for (int j = 0; j < 4; ++j) { gl[j] = lg[j] + brg[j]; if (gl[j] > gm) { gm = gl[j]; gi = j; } }
            float gs = 0.f;
#pragma unroll
            for (int j = 0; j < 4; ++j) gs += __expf(gl[j] - gm);
            float gp = 1.f / gs;
            float el[8]; float em = -1e30f;
#pragma unroll
            for (int j = 0; j < 8; ++j) {
                float v = (gi == 0) ? lg[4 + j] : (gi == 1) ? lg[12 + j] : (gi == 2) ? lg[20 + j] : lg[28 + j];
                el[j] = v + bre[gi * 8 + j]; em = fmaxf(em, el[j]);
            }
#pragma unroll
            for (int j = 0; j < 8; ++j) el[j] = __expf(el[j] - em);
            float v0 = -1.f, v1 = -1.f; int i0 = 0, i1 = 0;
#pragma unroll
            for (int j = 0; j < 8; ++j) {
                float v = el[j];
                if (v > v0) { v1 = v0; i1 = i0; v0 = v; i0 = j; }
                else if (v > v1) { v1 = v; i1 = j; }
            }
            int t = it * 16 + tid;
            int e0 = gi * 8 + i0, e1 = gi * 8 + i1;
            if (!dry) {
            const int sh = blockIdx.x & (NSH - 1);
            unsigned s0 = atomicAdd(&cnt[(e0 * NSH + sh) * CNT_STRIDE], 1u), s1 = atomicAdd(&cnt[(e1 * NSH + sh) * CNT_STRIDE], 1u);
            rowtok[(size_t)(e0 * NSH + sh) * SHCAP + s0] = t; rowtok[(size_t)(e1 * NSH + sh) * SHCAP + s1] = t;
            tslot[t * 2] = (e0 << 16) | (sh << 11) | (int)s0; tslot[t * 2 + 1] = (e1 << 16) | (sh << 11) | (int)s1;
            tgate[t * 2] = gp * v0 / (v0 + v1); tgate[t * 2 + 1] = gp * v1 / (v0 + v1);
            } else if (gp * v0 == 123.456f) tgate[0] = v1;
        }
    }
}

__device__ __forceinline__ void moe_tables(const unsigned* cnt, int* tab) {
    const int t = threadIdx.x;
    int* sc = tab + 80 + 32 * 9;
    sc[t] = (int)ld_u32_agent(cnt + t * CNT_STRIDE);
    __syncthreads();
    if (t < 32) { int a = 0; for (int s = 0; s < NSH; ++s) { tab[80 + t * 9 + s] = a; a += sc[t * NSH + s]; } tab[80 + t * 9 + 8] = a; }
    __syncthreads();
    if (t == 0) {
        int a = 0;
        for (int e = 0; e < 32; ++e) { tab[e] = a; tab[40 + e] = a * 128; a += (tab[80 + e * 9 + 8] + 127) >> 7; }
        tab[32] = a; tab[72] = a * 128;
    }
    __syncthreads();
}
template <int MODE>
__device__ void phase_expert(const Params& p, int l, bf16_t* lds) {
    const int tid = ltid(), lane = tid & 63, w = tid >> 6, wx = w >> 1, wy = w & 1, fr = lane & 15, fg = lane >> 4;
    const unsigned* cnt = (const unsigned*)(p.ws + WS_CTL) + CW_CNT + l * 32 * NSH * CNT_STRIDE;
    int* tab = (int*)(lds + 4 * GSTAGE);
    moe_tables(cnt, tab);
    if (MODE == 0 && blockIdx.x == 0) {
        unsigned* mt = (unsigned*)(p.ws + WS_CTL) + CW_MOETAB + l * 32 * NSH;
        mt[threadIdx.x] = (unsigned)(tab[40 + (threadIdx.x >> 3)] + tab[80 + (threadIdx.x >> 3) * 9 + (threadIdx.x & 7)]);
    }
    const int* rowtok = (const int*)(p.ws + WS_ROWTOK);
    const bf16_t* hn = (const bf16_t*)(p.ws + WS_HN);
    bf16_t* Hb = (bf16_t*)(p.ws + WS_H);
    bf16_t* Yb = (bf16_t*)(p.ws + WS_Y);
    const int x = blockIdx.x & 7, loc = blockIdx.x >> 3, nloc = gridDim.x >> 3;
    for (int j = loc;; j += nloc) {
        int e = -1, rt = 0, tn = 0; int jj = j;
#pragma unroll
        for (int q = 0; q < 4; ++q) {
            int ee = q * 8 + x; int nrt = tab[ee + 1] - tab[ee];
            if (e < 0) { if (jj < nrt * 8) { e = ee; tn = jj / nrt; rt = jj % nrt; } else jj -= nrt * 8; }
        }
        if (e < 0) break;
        const int hrow0 = tab[40 + e] + rt * 128;
        f32x4 acc[4][4];
        if (MODE == 0) {
            const bf16_t* wbase = (const bf16_t*)(p.ws + WS_WGU) + ((size_t)l * 32 + e) * 1024 * 1024;
            const int* spx = tab + 80 + e * 9;
            auto rw = [&](int r) { return wbase + pl_off(tn * 128 + r, 0, 1024); };
            auto rt_ = [&](int r) {
                const int s = rt * 128 + r; int t = 0;
                if (s < spx[8]) {
                    int xs = 0;
#pragma unroll
                    for (int q = 1; q < NSH; ++q) xs += (s >= spx[q]) ? 1 : 0;
                    t = rowtok[(size_t)(e * NSH + xs) * SHCAP + (s - spx[xs])];
                }
                return hn + pl_off(t, 0, 1024); };
            gemm_core(rw, rt_, 1024, lds, acc);
        } else {
            const bf16_t* wbase = (const bf16_t*)(p.ws + WS_WD) + ((size_t)l * 32 + e) * 1024 * 512;
            auto rw = [&](int r) { return wbase + pl_off(tn * 128 + r, 0, 512); };
            auto rt_ = [&](int r) { return Hb + pl_off(hrow0 + r, 0, 512); };
            gemm_core(rw, rt_, 512, lds, acc);
        }
        RAW_BARRIER();
        if (MODE == 0) {
#pragma unroll
            for (int n = 0; n < 4; ++n)
#pragma unroll
                for (int m = 0; m < 2; ++m)
                    ep_put<64>(lds, wy * 64 + n * 16 + fr, wx * 32 + m * 16 + 4 * fg, siluf_(acc[m][n][0]) * acc[m + 2][n][0], siluf_(acc[m][n][1]) * acc[m + 2][n][1],
                               siluf_(acc[m][n][2]) * acc[m + 2][n][2], siluf_(acc[m][n][3]) * acc[m + 2][n][3]);
            RAW_BARRIER();
            ep_flush<64>(lds, tid, [&](int row, int c8) { return Hb + pl_off(hrow0 + row, tn * 64 + c8 * 8, 512); });
        } else {
#pragma unroll
            for (int n = 0; n < 4; ++n)
#pragma unroll
                for (int m = 0; m < 4; ++m) ep_put<128>(lds, wy * 64 + n * 16 + fr, wx * 64 + m * 16 + 4 * fg, acc[m][n][0], acc[m][n][1], acc[m][n][2], acc[m][n][3]);
            RAW_BARRIER();
            bf16_t* dstb = Yb + (size_t)hrow0 * 1024 + tn * 128;
            ep_flush<128>(lds, tid, [&](int row, int c8) { return dstb + (size_t)row * 1024 + c8 * 8; });
        }
    }
}

__device__ void phase_combine(const Params& p, int l, int dry = 0) {
    const int tid = ltid(), lane = tid & 63, w = tid >> 6;
    const unsigned* mt = (const unsigned*)(p.ws + WS_CTL) + CW_MOETAB + l * 32 * NSH;
    const int* tslot = (const int*)(p.ws + WS_TSLOT);
    const float* tgate = (const float*)(p.ws + WS_TGATE);
    const bf16_t* Yb = (const bf16_t*)(p.ws + WS_Y);
    bf16_t* hn = dry ? (bf16_t*)(p.ws + WS_SCR + (size_t)40 * 1024 * 1024) : (bf16_t*)(p.ws + WS_HN);
    float* xw = dry ? (float*)(p.ws + WS_SCR + (size_t)48 * 1024 * 1024) : p.out;
    const float* gain = (l == 0 || dry) ? p.in[1] + 1024 : nullptr;
    for (int it = blockIdx.x; it < NTOK / 4; it += gridDim.x) {
        int t = it * 4 + w;
        int ts0 = tslot[t * 2], ts1 = tslot[t * 2 + 1];
        float g0 = tgate[t * 2], g1 = tgate[t * 2 + 1];
        int r0 = (int)mt[((ts0 >> 16) << 3) | ((ts0 >> 11) & 7)] + (ts0 & 0x7ff);
        int r1 = (int)mt[((ts1 >> 16) << 3) | ((ts1 >> 11) & 7)] + (ts1 & 0x7ff);
        const bf16_t* xr = (const bf16_t*)(p.ws + WS_SCR + SCR_XB) + (size_t)t * 1024 + lane * 16;
        const bf16_t* y0 = Yb + (size_t)r0 * 1024 + lane * 16;
        const bf16_t* y1 = Yb + (size_t)r1 * 1024 + lane * 16;
        float v[16];
#pragma unroll
        for (int i = 0; i < 2; ++i) { u32x4 q = *(const u32x4*)(xr + 8 * i);
#pragma unroll
            for (int k = 0; k < 4; ++k) { v[8 * i + 2 * k] = bflo(q[k]); v[8 * i + 2 * k + 1] = bfhi(q[k]); } }
        uint4 a0 = *(const uint4*)y0, a1 = *(const uint4*)(y0 + 8), b0 = *(const uint4*)y1, b1 = *(const uint4*)(y1 + 8);
        unsigned ya[8] = {a0.x, a0.y, a0.z, a0.w, a1.x, a1.y, a1.z, a1.w};
        unsigned yb[8] = {b0.x, b0.y, b0.z, b0.w, b1.x, b1.y, b1.z, b1.w};
#pragma unroll
        for (int i = 0; i < 8; ++i) {
            v[2 * i] += g0 * bflo(ya[i]) + g1 * bflo(yb[i]);
            v[2 * i + 1] += g0 * bfhi(ya[i]) + g1 * bfhi(yb[i]);
        }
#ifdef NANMARK
#pragma unroll
        for (int i = 0; i < 16; ++i) if (!(fabsf(v[i]) < 1e30f)) v[i] = 1000.f;
#endif
        if (l == 0 && !dry) {
            uint4 o0, o1;
            o0.x = pk_bf16(v[0], v[1]); o0.y = pk_bf16(v[2], v[3]); o0.z = pk_bf16(v[4], v[5]); o0.w = pk_bf16(v[6], v[7]);
            o1.x = pk_bf16(v[8], v[9]); o1.y = pk_bf16(v[10], v[11]); o1.z = pk_bf16(v[12], v[13]); o1.w = pk_bf16(v[14], v[15]);
            bf16_t* xo2 = (bf16_t*)p.out + (size_t)t * 1024 + lane * 16;
            *(uint4*)xo2 = o0; *(uint4*)(xo2 + 8) = o1;
        } else {
#pragma unroll
            for (int i = 0; i < 4; ++i) *(float4*)(xw + (size_t)t * 1024 + lane * 16 + 4 * i) = make_float4(v[4 * i], v[4 * i + 1], v[4 * i + 2], v[4 * i + 3]);
        }
        if (gain) {
            float ss = 0.f;
#pragma unroll
            for (int i = 0; i < 16; ++i) ss += v[i] * v[i];
            ss = wave_sum(ss);
            float r = rsqrtf(ss / D_MODEL + 1e-6f);
#pragma unroll
            for (int i = 0; i < 16; ++i) v[i] = v[i] * r * gain[lane * 16 + i];
            uint4 o0, o1;
            o0.x = pk_bf16(v[0], v[1]); o0.y = pk_bf16(v[2], v[3]); o0.z = pk_bf16(v[4], v[5]); o0.w = pk_bf16(v[6], v[7]);
            o1.x = pk_bf16(v[8], v[9]); o1.y = pk_bf16(v[10], v[11]); o1.z = pk_bf16(v[12], v[13]); o1.w = pk_bf16(v[14], v[15]);
            bf16_t* hr = hn + pl_off(t, lane * 16, 1024);
            *(uint4*)hr = o0; *(uint4*)(hr + 8) = o1;
        }
    }
}


__device__ __forceinline__ void mm_row(const bf16_t* RA, const bf16_t* RB, int mw, int fr, int fg, f32x4 (&acc)[4]) {
#pragma unroll
    for (int ks = 0; ks < 2; ++ks) {
        bf16x8 a = *(const bf16x8*)(RA + (16 * mw + fr) * LROW + ks * 32 + fg * 8);
#pragma unroll
        for (int nt = 0; nt < 4; ++nt) {
            bf16x8 b = *(const bf16x8*)(RB + (16 * nt + fr) * LROW + ks * 32 + fg * 8);
            acc[nt] = __builtin_amdgcn_mfma_f32_16x16x32_bf16(a, b, acc[nt], 0, 0, 0);
        }
    }
}
__device__ __forceinline__ void mm_col(const bf16_t* RA, const bf16_t* RB, int nw, int fr, int fg, f32x4 (&acc)[4]) {
#pragma unroll
    for (int ks = 0; ks < 2; ++ks) {
        bf16x8 b = *(const bf16x8*)(RB + (16 * nw + fr) * LROW + ks * 32 + fg * 8);
#pragma unroll
        for (int mt = 0; mt < 4; ++mt) {
            bf16x8 a = *(const bf16x8*)(RA + (16 * mt + fr) * LROW + ks * 32 + fg * 8);
            acc[mt] = __builtin_amdgcn_mfma_f32_16x16x32_bf16(a, b, acc[mt], 0, 0, 0);
        }
    }
}
__device__ __forceinline__ void zero4(f32x4 (&a)[4]) {
#pragma unroll
    for (int i = 0; i < 4; ++i) a[i] = (f32x4){0.f, 0.f, 0.f, 0.f};
}
__device__ __forceinline__ void st4_lds(bf16_t* p, float a, float b, float c, float d) { uint2 o; o.x = pk_bf16(a, b); o.y = pk_bf16(c, d); *(uint2*)p = o; }
__device__ __forceinline__ bf16_t f2bf(float v) { return (bf16_t)(pk_bf16(v, 0.f) & 0xffffu); }

__device__ void gdn_prep_item(const Params& p, int l, int cid, unsigned char* lds_raw) {
    const int tid = ltid(), lane = tid & 63, w = tid >> 6, fr = lane & 15, fg = lane >> 4;
    const int bh = cid >> 6, n = cid & 63, b = bh / H_GDN, h = bh % H_GDN;
    const int t0 = b * SEQ + n * 64;
    bf16_t* L0 = (bf16_t*)lds_raw; bf16_t* L1 = L0 + 64 * LROW; bf16_t* L2 = L1 + 64 * LROW; bf16_t* L3 = L2 + 64 * LROW; bf16_t* L4 = L3 + 64 * LROW; bf16_t* L5 = L4 + 64 * LROW;
    float* dec = (float*)(L5 + 64 * LROW); float* beta = dec + 64;
    const bf16_t* proj = (const bf16_t*)(p.ws + WS_PROJ);
    const float* aux = (const float*)(p.ws + WS_AUX);
    const float* convw = p.in[7] + (size_t)l * 4 * 1152;
    __syncthreads();
    const int i = tid >> 2, c0 = (tid & 3) * 16;
    float qv[16], kv[16], vv[16];
#pragma unroll
    for (int which = 0; which < 3; ++which) {
        float acc[16];
#pragma unroll
        for (int c = 0; c < 16; ++c) acc[c] = 0.f;
#pragma unroll
        for (int tap = 0; tap < 4; ++tap) {
            const int row = i - 3 + tap;
            if (n * 64 + row >= 0) {
                const bf16_t* xp = proj + (size_t)(t0 + row) * NPROJ + NC_GQ + which * 384 + h * 64 + c0;
                u32x4 x0 = *(const u32x4*)xp, x1 = *(const u32x4*)(xp + 8);
                const float* wp = convw + tap * 1152 + which * 384 + h * 64 + c0;
                f32x4 w0 = *(const f32x4*)wp, w1 = *(const f32x4*)(wp + 4), w2 = *(const f32x4*)(wp + 8), w3 = *(const f32x4*)(wp + 12);
                float wv[16] = {w0[0], w0[1], w0[2], w0[3], w1[0], w1[1], w1[2], w1[3], w2[0], w2[1], w2[2], w2[3], w3[0], w3[1], w3[2], w3[3]};
                unsigned xs[8] = {x0[0], x0[1], x0[2], x0[3], x1[0], x1[1], x1[2], x1[3]};
#pragma unroll
                for (int c = 0; c < 8; ++c) { acc[2 * c] += wv[2 * c] * bflo(xs[c]); acc[2 * c + 1] += wv[2 * c + 1] * bfhi(xs[c]); }
            }
        }
        float ss = 0.f;
#pragma unroll
        for (int c = 0; c < 16; ++c) { acc[c] = siluf_(acc[c]); ss += acc[c] * acc[c]; }
        if (which < 2) {
            ss += __shfl_xor(ss, 1, 64); ss += __shfl_xor(ss, 2, 64);
            const float sc = rsqrtf(ss + 1e-6f) * (which == 0 ? 0.125f : 1.f);
#pragma unroll
            for (int c = 0; c < 16; ++c) acc[c] *= sc;
        }
#pragma unroll
        for (int c = 0; c < 16; ++c) { if (which == 0) qv[c] = acc[c]; else if (which == 1) kv[c] = acc[c]; else vv[c] = acc[c]; }
    }
#pragma unroll
    for (int c = 0; c < 16; c += 4) { st4_lds(L2 + i * LROW + c0 + c, kv[c], kv[c + 1], kv[c + 2], kv[c + 3]); st4_lds(L3 + i * LROW + c0 + c, qv[c], qv[c + 1], qv[c + 2], qv[c + 3]); }
    if (w == 0) {
        const float a = aux[(size_t)(t0 + lane) * 64 + AX_GA + h], bl = aux[(size_t)(t0 + lane) * 64 + AX_GB + h];
        const float g = -__expf(p.in[8][l * H_GDN + h]) * softplusf_(a + p.in[9][l * H_GDN + h]);
        float inc = g;
#pragma unroll
        for (int o = 1; o < 64; o <<= 1) { float t = __shfl_up(inc, o, 64); if (lane >= o) inc += t; }
        dec[lane] = inc; beta[lane] = sigmoidf_(bl);
    }
    __syncthreads();
    {
        f32x4 g4[4]; zero4(g4);
        mm_row(L2, L2, w, fr, fg, g4);
#pragma unroll
        for (int nt = 0; nt < 4; ++nt) {
            const int kap = 16 * nt + fr; const float dk_ = dec[kap], bk_ = beta[kap];
            float nT[4], nN[4], tt[4];
#pragma unroll
            for (int r = 0; r < 4; ++r) {
                const int rho = 16 * w + 4 * fg + r; const float dr_ = dec[rho], br_ = beta[rho];
                const float G = g4[nt][r];
                nT[r] = (kap < rho) ? br_ * G * __expf(dr_ - dk_) : 0.f;
                nN[r] = (rho < kap) ? bk_ * G * __expf(dk_ - dr_) : 0.f;
                tt[r] = ((kap == rho) ? 1.f : 0.f) - nN[r];
            }
            st4_lds(L1 + kap * LROW + 16 * w + 4 * fg, nT[0], nT[1], nT[2], nT[3]);
            st4_lds(L0 + kap * LROW + 16 * w + 4 * fg, nN[0], nN[1], nN[2], nN[3]);
            st4_lds(L4 + kap * LROW + 16 * w + 4 * fg, tt[0], tt[1], tt[2], tt[3]);
        }
        f32x4 a4[4]; zero4(a4);
        mm_row(L2, L3, w, fr, fg, a4);
#pragma unroll
        for (int nt = 0; nt < 4; ++nt) {
            const int ii = 16 * nt + fr; const float di_ = dec[ii];
            float v4[4];
#pragma unroll
            for (int r = 0; r < 4; ++r) { const int j = 16 * w + 4 * fg + r; v4[r] = (j <= ii) ? a4[nt][r] * __expf(di_ - dec[j]) : 0.f; }
            st4_lds(L5 + ii * LROW + 16 * w + 4 * fg, v4[0], v4[1], v4[2], v4[3]);
        }
    }
    __syncthreads();
#pragma unroll
    for (int lev = 1; lev <= 5; ++lev) {
        const bf16_t* XA = (lev & 1) ? L0 : L2; const bf16_t* XAt = (lev & 1) ? L1 : L3;
        bf16_t* XB = (lev & 1) ? L2 : L0; bf16_t* XBt = (lev & 1) ? L3 : L1;
        {
            f32x4 x4[4]; zero4(x4);
            mm_row(XA, XAt, w, fr, fg, x4);
#pragma unroll
            for (int nt = 0; nt < 4; ++nt) {
                const int c = 16 * nt + fr;
                st4_lds(XBt + c * LROW + 16 * w + 4 * fg, x4[nt][0], x4[nt][1], x4[nt][2], x4[nt][3]);
                if (lev < 5) {
#pragma unroll
                    for (int r = 0; r < 4; ++r) XB[(16 * w + 4 * fg + r) * LROW + c] = f2bf(x4[nt][r]);
                }
            }
        }
        __syncthreads();
        {
            f32x4 t4[4];
#pragma unroll
            for (int mt = 0; mt < 4; ++mt) {
                uint2 u = *(const uint2*)(L4 + (16 * w + fr) * LROW + 16 * mt + 4 * fg);
                t4[mt] = (f32x4){bflo(u.x), bfhi(u.x), bflo(u.y), bfhi(u.y)};
            }
            mm_col(XBt, L4, w, fr, fg, t4);
#pragma unroll
            for (int mt = 0; mt < 4; ++mt) st4_lds(L4 + (16 * w + fr) * LROW + 16 * mt + 4 * fg, t4[mt][0], t4[mt][1], t4[mt][2], t4[mt][3]);
        }
    }
    {
        const float dj = dec[i], bj = beta[i], dlast = dec[63];
        const float s1 = bj * __expf(dj), s2 = bj, s3 = __expf(dlast - dj);
#pragma unroll
        for (int c = 0; c < 16; ++c) {
            L0[(c0 + c) * LROW + i] = f2bf(kv[c] * s1);
            L1[(c0 + c) * LROW + i] = f2bf(vv[c] * s2);
            L2[(c0 + c) * LROW + i] = f2bf(kv[c] * s3);
        }
    }
    __syncthreads();
    {
        f32x4 w4[4], u4[4]; zero4(w4); zero4(u4);
        mm_row(L4, L0, w, fr, fg, w4);
        mm_row(L4, L1, w, fr, fg, u4);
        __syncthreads();
#pragma unroll
        for (int nt = 0; nt < 4; ++nt) {
            st4_lds(L0 + (16 * nt + fr) * LROW + 16 * w + 4 * fg, w4[nt][0], w4[nt][1], w4[nt][2], w4[nt][3]);
            st4_lds(L1 + (16 * nt + fr) * LROW + 16 * w + 4 * fg, u4[nt][0], u4[nt][1], u4[nt][2], u4[nt][3]);
        }
        const float ed = __expf(dec[i]);
#pragma unroll
        for (int c = 0; c < 16; c += 4) st4_lds(L3 + i * LROW + c0 + c, qv[c] * ed, qv[c + 1] * ed, qv[c + 2] * ed, qv[c + 3] * ed);
    }
    __syncthreads();
    char* scr = p.ws + WS_SCR;
    {
        f32x4 m4[4]; zero4(m4);
        mm_row(L0, L2, w, fr, fg, m4);
        bf16_t* MP = (bf16_t*)(scr + SCR_GDN_MP) + (size_t)cid * 4096;
#pragma unroll
        for (int nt = 0; nt < 4; ++nt) store4_bf16(MP + (16 * nt + fr) * 64 + 16 * w + 4 * fg, -m4[nt][0], -m4[nt][1], -m4[nt][2], -m4[nt][3]);
        f32x4 n4[4]; zero4(n4);
        mm_row(L2, L1, w, fr, fg, n4);
        bf16_t* NN = (bf16_t*)(scr + SCR_GDN_NN) + (size_t)cid * 4096;
#pragma unroll
        for (int nt = 0; nt < 4; ++nt) store4_bf16(NN + ((nt * 4 + w) * 64 + lane) * 4, n4[nt][0], n4[nt][1], n4[nt][2], n4[nt][3]);
        f32x4 p4[4]; zero4(p4);
        mm_row(L0, L5, w, fr, fg, p4);
        bf16_t* PG = (bf16_t*)(scr + SCR_GDN_P) + (size_t)cid * 4096;
#pragma unroll
        for (int nt = 0; nt < 4; ++nt) {
            uint2 u = *(const uint2*)(L3 + (16 * nt + fr) * LROW + 16 * w + 4 * fg);
            store4_bf16(PG + (16 * nt + fr) * 64 + 16 * w + 4 * fg, bflo(u.x) - p4[nt][0], bfhi(u.x) - p4[nt][1], bflo(u.y) - p4[nt][2], bfhi(u.y) - p4[nt][3]);
        }
        f32x4 o4[4]; zero4(o4);
        mm_row(L1, L5, w, fr, fg, o4);
        bf16_t* OL = (bf16_t*)(scr + SCR_GDN_OL) + (size_t)cid * 4096;
#pragma unroll
        for (int nt = 0; nt < 4; ++nt) store4_bf16(OL + (16 * nt + fr) * 64 + 16 * w + 4 * fg, o4[nt][0], o4[nt][1], o4[nt][2], o4[nt][3]);
        if (tid == 0) ((float*)(scr + SCR_GDN_LAST))[cid] = __expf(dec[63]);
    }
}

#define SCAN_SLOT    5120
#define SCAN_SB(k)   ((bf16_t*)lds_raw + (k) * 1024)
#define SCAN_RING(k) ((bf16_t*)lds_raw + 2048 + (k) * SCAN_SLOT)
#define SCAN_LAST    ((float*)(lds_raw + 4096 + 5 * SCAN_SLOT * 2))
__device__ __forceinline__ void scan_issue(const bf16_t* const (&mp)[8], const bf16_t* nn_lane, int n, bf16_t* slot, int h) {
    if (h == 0) {
#pragma unroll
        for (int q = 0; q < 4; ++q) __builtin_amdgcn_global_load_lds((const unsigned*)(mp[q] + (size_t)n * 4096), (unsigned*)(slot + q * 512), 16, 0, 0);
        __builtin_amdgcn_global_load_lds((const unsigned*)(nn_lane + (size_t)n * 4096), (unsigned*)(slot + 4096), 16, 0, 0);
    } else {
#pragma unroll
        for (int q = 4; q < 8; ++q) __builtin_amdgcn_global_load_lds((const unsigned*)(mp[q] + (size_t)n * 4096), (unsigned*)(slot + q * 512), 16, 0, 0);
        __builtin_amdgcn_global_load_lds((const unsigned*)(nn_lane + (size_t)n * 4096 + 512), (unsigned*)(slot + 4096 + 512), 16, 0, 0);
    }
}
__device__ void gdn_scan_item(const Params& p, int item, unsigned char* lds_raw, int svar = 0) {
    const int tid = ltid(), lane = tid & 63, w = __builtin_amdgcn_readfirstlane(tid >> 6), fr = lane & 15, fg = lane >> 4;
    const int bh = item >> 2, cg = item & 3;
    char* scr = p.ws + WS_SCR;
    const bf16_t* MP = (const bf16_t*)(scr + SCR_GDN_MP) + (size_t)bh * 64 * 4096;
    const bf16_t* NN = (const bf16_t*)(scr + SCR_GDN_NN) + (size_t)bh * 64 * 4096 + cg * 1024;
    const float* LAST = (const float*)(scr + SCR_GDN_LAST) + bh * 64;
    bf16_t* SG = (bf16_t*)(scr + SCR_GDN_SG) + (size_t)bh * 64 * 4096 + cg * 1024;
    const bf16_t* mp[8];
#pragma unroll
    for (int q = 0; q < 8; ++q) { const int row = 8 * q + (lane >> 3); mp[q] = MP + row * 64 + (((lane & 7) ^ ((row >> 1) & 7)) * 8); }
    const bf16_t* nn_lane = NN + lane * 8;
    RAW_BARRIER();
    if (tid < 64) SCAN_LAST[tid] = ld_f32_agent(LAST + tid);
    asm volatile("s_waitcnt vmcnt(0)" ::: "memory");
    f32x4 S = (f32x4){0.f, 0.f, 0.f, 0.f};
    const int swz = (fr >> 1) & 7;
    if (w < 2) {
#pragma unroll
        for (int n = 0; n < 4; ++n) scan_issue(mp, nn_lane, n, SCAN_RING(n), w);
    }
    for (int n = 0; n < 64; ++n) {
        bf16_t* sb = SCAN_SB(n & 1);
        const bf16_t* ring = SCAN_RING(n % 5);
        {
            const int c = 2 * w + (fg >> 1);
            uint2 o; o.x = pk_bf16(S[0], S[1]); o.y = pk_bf16(S[2], S[3]);
            *(uint2*)(sb + fr * 64 + ((c ^ swz) * 8) + 4 * (fg & 1)) = o;
        }
        if (w < 2) {
            if (n + 3 < 64) asm volatile("s_waitcnt vmcnt(15)" ::: "memory");
            else if (n + 2 < 64) asm volatile("s_waitcnt vmcnt(10)" ::: "memory");
            else if (n + 1 < 64) asm volatile("s_waitcnt vmcnt(5)" ::: "memory");
            else asm volatile("s_waitcnt vmcnt(0)" ::: "memory");
        }
        RAW_BARRIER();
        if (w < 2 && n + 4 < 64 && svar != 2) scan_issue(mp, nn_lane, n + 4, SCAN_RING((n + 4) % 5), w);
        const float last = SCAN_LAST[n];
        {
            u32x2 nn = *(const u32x2*)(ring + 4096 + (w * 64 + lane) * 4);
            S[0] = last * S[0] + bflo(nn[0]); S[1] = last * S[1] + bfhi(nn[0]);
            S[2] = last * S[2] + bflo(nn[1]); S[3] = last * S[3] + bfhi(nn[1]);
        }
#pragma unroll
        for (int ks = 0; ks < 2; ++ks) {
            const int co = ((ks * 4 + fg) ^ swz) * 8;
            bf16x8 a = *(const bf16x8*)(ring + (16 * w + fr) * 64 + co);
            bf16x8 s = *(const bf16x8*)(sb + fr * 64 + co);
            S = __builtin_amdgcn_mfma_f32_16x16x32_bf16(a, s, S, 0, 0, 0);
        }
        if (w >= 2 && svar != 1) {
            const int c = (w - 2) * 64 + lane; const int row = c >> 3, pc = c & 7;
            u32x4 v = *(const u32x4*)(sb + row * 64 + pc * 8);
            *(u32x4*)(SG + (size_t)n * 4096 + row * 64 + ((pc ^ ((row >> 1) & 7)) * 8)) = v;
        }
    }
}

__device__ void gdn_out_item(const Params& p, int l, int cid) {
    const int tid = ltid(), lane = tid & 63, w = tid >> 6, fr = lane & 15, fg = lane >> 4;
    const int bh = cid >> 6, n = cid & 63, b = bh / H_GDN, h = bh % H_GDN;
    char* scr = p.ws + WS_SCR;
    const bf16_t* SG = (const bf16_t*)(scr + SCR_GDN_SG) + (size_t)cid * 4096;
    const bf16_t* PG = (const bf16_t*)(scr + SCR_GDN_P) + (size_t)cid * 4096;
    const bf16_t* OL = (const bf16_t*)(scr + SCR_GDN_OL) + (size_t)cid * 4096;
    const int i = 16 * w + fr; const int t = b * SEQ + n * 64 + i;
    f32x4 acc[4];
#pragma unroll
    for (int mt = 0; mt < 4; ++mt) { uint2 u = *(const uint2*)(OL + i * 64 + 16 * mt + 4 * fg); acc[mt] = (f32x4){bflo(u.x), bfhi(u.x), bflo(u.y), bfhi(u.y)}; }
#pragma unroll
    for (int ks = 0; ks < 2; ++ks) {
        bf16x8 bq = *(const bf16x8*)(PG + i * 64 + ks * 32 + fg * 8);
#pragma unroll
        for (int mt = 0; mt < 4; ++mt) {
            bf16x8 a = *(const bf16x8*)(SG + (16 * mt + fr) * 64 + ks * 32 + fg * 8);
            acc[mt] = __builtin_amdgcn_mfma_f32_16x16x32_bf16(a, bq, acc[mt], 0, 0, 0);
        }
    }
    float ss = 0.f;
#pragma unroll
    for (int mt = 0; mt < 4; ++mt)
#pragma unroll
        for (int r = 0; r < 4; ++r) ss += acc[mt][r] * acc[mt][r];
    ss += __shfl_xor(ss, 16, 64); ss += __shfl_xor(ss, 32, 64);
    const float rstd = rsqrtf(ss * (1.f / 64.f) + 1e-6f);
    const float* og = p.in[10] + l * 64;
    const bf16_t* gp = (const bf16_t*)(p.ws + WS_PROJ) + (size_t)t * NPROJ + NC_GG + h * 64;
    bf16_t* mp = (bf16_t*)(p.ws + WS_MIX) + pl_off(t, 384 + h * 64, 1024);
#pragma unroll
    for (int mt = 0; mt < 4; ++mt) {
        const int e0 = 16 * mt + 4 * fg;
        uint2 gu = *(const uint2*)(gp + e0); f32x4 g4 = *(const f32x4*)(og + e0);
        store4_bf16(mp + e0 + (e0 & 32), acc[mt][0] * rstd * g4[0] * bflo(gu.x), acc[mt][1] * rstd * g4[1] * bfhi(gu.x), acc[mt][2] * rstd * g4[2] * bflo(gu.y), acc[mt][3] * rstd * g4[3] * bfhi(gu.y));
    }
}

#define GQROW 40
__device__ void gla_prep_item(const Params& p, int l, int cid, unsigned char* lds_raw) {
    const int tid = ltid(), lane = tid & 63, w = tid >> 6, fr = lane & 15, fg = lane >> 4;
    const int bh = cid >> 6, n = cid & 63, b = bh / H_GLA, h = bh % H_GLA;
    const int t0 = b * SEQ + n * 64;
    float* Bf = (float*)lds_raw;
    bf16_t* Qt = (bf16_t*)(lds_raw + 8448);
    bf16_t* Kt = Qt + 64 * GQROW;
    bf16_t* KLt = Kt + 64 * GQROW;
    bf16_t* Vt = KLt + 32 * LROW;
    const bf16_t* proj = (const bf16_t*)(p.ws + WS_PROJ);
    const float* aux = (const float*)(p.ws + WS_AUX);
    char* scr = p.ws + WS_SCR;
    __syncthreads();
    const int i = tid >> 2, d0 = (tid & 3) * 8;
    {
        const float* wa = p.in[11] + (size_t)l * 16 * 128 + h * 32 + d0;
        const float* ba = p.in[12] + l * 128 + h * 32 + d0;
        float acc[8];
#pragma unroll
        for (int j = 0; j < 8; ++j) acc[j] = ba[j];
        float a1v[16];
#pragma unroll
        for (int r = 0; r < 16; r += 2) { float2 t2 = *(const float2*)(aux + (size_t)(t0 + i) * 64 + AX_LA + r); a1v[r] = t2.x; a1v[r + 1] = t2.y; }
#pragma unroll
        for (int r = 0; r < 16; ++r) {
            f32x4 wA = *(const f32x4*)(wa + r * 128), wB = *(const f32x4*)(wa + r * 128 + 4);
#pragma unroll
            for (int j = 0; j < 4; ++j) { acc[j] += a1v[r] * wA[j]; acc[4 + j] += a1v[r] * wB[j]; }
        }
#pragma unroll
        for (int j = 0; j < 8; ++j) Bf[i * 33 + d0 + j] = logsigmoidf_(acc[j]) * (1.f / 16.f);
    }
    {
        const bf16_t* lvt = (const bf16_t*)(scr + SCR_LVT) + (size_t)bh * 64 * SEQ + n * 64;
#pragma unroll
        for (int ii = 0; ii < 2; ++ii) { int c = tid + 256 * ii; int row = c >> 3, kc = c & 7; *(u32x4*)(Vt + row * LROW + kc * 8) = *(const u32x4*)(lvt + (size_t)row * SEQ + kc * 8); }
    }
    __syncthreads();
#pragma unroll
    for (int c = 0; c < 8; ++c) {
        const int d = 8 * w + c;
        float inc = Bf[lane * 33 + d];
#pragma unroll
        for (int o = 1; o < 64; o <<= 1) { float t = __shfl_up(inc, o, 64); if (lane >= o) inc += t; }
        Bf[lane * 33 + d] = inc;
    }
    __syncthreads();
    {
        const bf16_t* qp = proj + (size_t)(t0 + i) * NPROJ + NC_LQ + h * 32 + d0;
        const bf16_t* kp = proj + (size_t)(t0 + i) * NPROJ + NC_LK + h * 32 + d0;
        u32x4 qu = *(const u32x4*)qp, ku = *(const u32x4*)kp;
        float qf[8] = {bflo(qu[0]), bfhi(qu[0]), bflo(qu[1]), bfhi(qu[1]), bflo(qu[2]), bfhi(qu[2]), bflo(qu[3]), bfhi(qu[3])};
        float kf[8] = {bflo(ku[0]), bfhi(ku[0]), bflo(ku[1]), bfhi(ku[1]), bflo(ku[2]), bfhi(ku[2]), bflo(ku[3]), bfhi(ku[3])};
        float qt[8], kt[8], qb[8];
#pragma unroll
        for (int j = 0; j < 8; ++j) {
            const float bi = Bf[i * 33 + d0 + j], bm = Bf[31 * 33 + d0 + j], bl = Bf[63 * 33 + d0 + j];
            qt[j] = qf[j] * __expf(bi - bm); kt[j] = kf[j] * __expf(bm - bi); qb[j] = qf[j] * __expf(bi);
            KLt[(d0 + j) * LROW + i] = f2bf(kf[j] * __expf(bl - bi));
            if (i == 63) ((float*)(scr + SCR_GLA_DL))[cid * 32 + d0 + j] = __expf(bl);
        }
        u32x4 o; o[0] = pk_bf16(qt[0], qt[1]); o[1] = pk_bf16(qt[2], qt[3]); o[2] = pk_bf16(qt[4], qt[5]); o[3] = pk_bf16(qt[6], qt[7]);
        *(u32x4*)(Qt + i * GQROW + d0) = o;
        o[0] = pk_bf16(kt[0], kt[1]); o[1] = pk_bf16(kt[2], kt[3]); o[2] = pk_bf16(kt[4], kt[5]); o[3] = pk_bf16(kt[6], kt[7]);
        *(u32x4*)(Kt + i * GQROW + d0) = o;
        o[0] = pk_bf16(qb[0], qb[1]); o[1] = pk_bf16(qb[2], qb[3]); o[2] = pk_bf16(qb[4], qb[5]); o[3] = pk_bf16(qb[6], qb[7]);
        *(u32x4*)((bf16_t*)(scr + SCR_GLA_QB) + (size_t)cid * 2048 + i * 32 + d0) = o;
    }
    __syncthreads();
    f32x4 sc[4];
    {
        bf16x8 bq = *(const bf16x8*)(Qt + (16 * w + fr) * GQROW + fg * 8);
#pragma unroll
        for (int mt = 0; mt < 4; ++mt) {
            bf16x8 a = *(const bf16x8*)(Kt + (16 * mt + fr) * GQROW + fg * 8);
            sc[mt] = __builtin_amdgcn_mfma_f32_16x16x32_bf16(a, bq, (f32x4){0.f, 0.f, 0.f, 0.f}, 0, 0, 0);
        }
        const int ii = 16 * w + fr;
#pragma unroll
        for (int mt = 0; mt < 4; ++mt)
#pragma unroll
            for (int r = 0; r < 4; ++r) { const int j = 16 * mt + 4 * fg + r; if (j > ii) sc[mt][r] = 0.f; }
    }
    {
        f32x4 o4[4]; zero4(o4);
#pragma unroll
        for (int kk = 0; kk < 2; ++kk) {
            u32x4 pb = {pk_bf16(sc[2 * kk][0], sc[2 * kk][1]), pk_bf16(sc[2 * kk][2], sc[2 * kk][3]), pk_bf16(sc[2 * kk + 1][0], sc[2 * kk + 1][1]), pk_bf16(sc[2 * kk + 1][2], sc[2 * kk + 1][3])};
#pragma unroll
            for (int mt = 0; mt < 4; ++mt) {
                uint2 v0 = *(const uint2*)(Vt + (16 * mt + fr) * LROW + 32 * kk + 4 * fg), v1 = *(const uint2*)(Vt + (16 * mt + fr) * LROW + 32 * kk + 16 + 4 * fg);
                u32x4 va = {v0.x, v0.y, v1.x, v1.y};
                o4[mt] = __builtin_amdgcn_mfma_f32_16x16x32_bf16(__builtin_bit_cast(bf16x8, va), __builtin_bit_cast(bf16x8, pb), o4[mt], 0, 0, 0);
            }
        }
        bf16_t* OL = (bf16_t*)(scr + SCR_GLA_OL) + (size_t)cid * 4096;
#pragma unroll
        for (int mt = 0; mt < 4; ++mt) store4_bf16(OL + (16 * w + fr) * 64 + 16 * mt + 4 * fg, o4[mt][0], o4[mt][1], o4[mt][2], o4[mt][3]);
    }
    {
        f32x4 k4[2] = {(f32x4){0.f, 0.f, 0.f, 0.f}, (f32x4){0.f, 0.f, 0.f, 0.f}};
#pragma unroll
        for (int ks = 0; ks < 2; ++ks) {
            bf16x8 bv = *(const bf16x8*)(Vt + (16 * w + fr) * LROW + ks * 32 + fg * 8);
#pragma unroll
            for (int mt = 0; mt < 2; ++mt) {
                bf16x8 a = *(const bf16x8*)(KLt + (16 * mt + fr) * LROW + ks * 32 + fg * 8);
                k4[mt] = __builtin_amdgcn_mfma_f32_16x16x32_bf16(a, bv, k4[mt], 0, 0, 0);
            }
        }
        float* KV = (float*)(scr + SCR_GLA_KV) + (size_t)cid * 2048;
#pragma unroll
        for (int mt = 0; mt < 2; ++mt) *(f32x4*)(KV + (16 * w + fr) * 32 + 16 * mt + 4 * fg) = k4[mt];
    }
}
__device__ void gla_scan_item(const Params& p, int g) {
    const int tid = ltid();
    const int bh = g >> 3, idx = (g & 7) * 256 + tid, d = idx & 31;
    char* scr = p.ws + WS_SCR;
    const float* __restrict__ KV = (const float*)(scr + SCR_GLA_KV) + (size_t)bh * 64 * 2048 + idx;
    const float* __restrict__ DL = (const float*)(scr + SCR_GLA_DL) + bh * 64 * 32 + d;
    bf16_t* __restrict__ SG = (bf16_t*)(scr + SCR_GLA_SG) + (size_t)bh * 64 * 2048 + idx;
    float S = 0.f;
    for (int n0 = 0; n0 < 64; n0 += 8) {
        float kv[8], dl[8];
#pragma unroll
        for (int u = 0; u < 8; ++u) { kv[u] = KV[(size_t)(n0 + u) * 2048]; dl[u] = DL[(n0 + u) * 32]; }
#pragma unroll
        for (int u = 0; u < 8; ++u) { SG[(size_t)(n0 + u) * 2048] = f2bf(S); S = dl[u] * S + kv[u]; }
    }
}
__device__ void gla_out_item(const Params& p, int l, int cid) {
    const int tid = ltid(), lane = tid & 63, w = tid >> 6, fr = lane & 15, fg = lane >> 4;
    const int bh = cid >> 6, n = cid & 63, b = bh / H_GLA, h = bh % H_GLA;
    char* scr = p.ws + WS_SCR;
    const bf16_t* SG = (const bf16_t*)(scr + SCR_GLA_SG) + (size_t)cid * 2048;
    const bf16_t* QB = (const bf16_t*)(scr + SCR_GLA_QB) + (size_t)cid * 2048;
    const bf16_t* OL = (const bf16_t*)(scr + SCR_GLA_OL) + (size_t)cid * 4096;
    const int i = 16 * w + fr; const int t = b * SEQ + n * 64 + i;
    f32x4 acc[4];
#pragma unroll
    for (int mt = 0; mt < 4; ++mt) { uint2 u = *(const uint2*)(OL + i * 64 + 16 * mt + 4 * fg); acc[mt] = (f32x4){bflo(u.x), bfhi(u.x), bflo(u.y), bfhi(u.y)}; }
    bf16x8 bq = *(const bf16x8*)(QB + i * 32 + fg * 8);
#pragma unroll
    for (int mt = 0; mt < 4; ++mt) {
        bf16x8 a = *(const bf16x8*)(SG + (16 * mt + fr) * 32 + fg * 8);
        acc[mt] = __builtin_amdgcn_mfma_f32_16x16x32_bf16(a, bq, acc[mt], 0, 0, 0);
    }
    float ss = 0.f;
#pragma unroll
    for (int mt = 0; mt < 4; ++mt)
#pragma unroll
        for (int r = 0; r < 4; ++r) ss += acc[mt][r] * acc[mt][r];
    ss += __shfl_xor(ss, 16, 64); ss += __shfl_xor(ss, 32, 64);
    const float rstd = rsqrtf(ss * (1.f / 64.f) + 1e-6f);
    const float* og = p.in[13] + l * 64;
    const bf16_t* rp = (const bf16_t*)(p.ws + WS_PROJ) + (size_t)t * NPROJ + NC_LR + h * 64;
    bf16_t* mp = (bf16_t*)(p.ws + WS_MIX) + pl_off(t, 768 + h * 64, 1024);
#pragma unroll
    for (int mt = 0; mt < 4; ++mt) {
        const int e0 = 16 * mt + 4 * fg;
        uint2 gu = *(const uint2*)(rp + e0); f32x4 g4 = *(const f32x4*)(og + e0);
        store4_bf16(mp + e0 + (e0 & 32), acc[mt][0] * rstd * g4[0] * bflo(gu.x), acc[mt][1] * rstd * g4[1] * bfhi(gu.x), acc[mt][2] * rstd * g4[2] * bflo(gu.y), acc[mt][3] * rstd * g4[3] * bfhi(gu.y));
    }
}
__device__ void phase_mixout(const Params& p, int l) {
    for (int it = blockIdx.x; it < NGDN_CH + NGLA_CH; it += gridDim.x) {
        if (it < NGDN_CH) { if (MIXSEL & 1) gdn_out_item(p, l, it); } else { if (MIXSEL & 2) gla_out_item(p, l, it - NGDN_CH); }
    }
}

__device__ void fox_cumsum_item(const Params& p, int l, int bh, float* ldsf) {
    const int tid = ltid(), lane = tid & 63, w = tid >> 6;
    const int b = bh / H_FOX, h = bh % H_FOX;
    const float* aux = (const float*)(p.ws + WS_AUX);
    float* cum = (float*)(p.ws + WS_CUM) + (size_t)bh * SEQ;
    const float fb = p.in[5][l * H_FOX + h];
    float v[16]; float s = 0.f;
#pragma unroll
    for (int i = 0; i < 16; ++i) { v[i] = logsigmoidf_(aux[(size_t)(b * SEQ + tid * 16 + i) * 64 + AX_FF + h] + fb); s += v[i]; }
    float inc = s;
#pragma unroll
    for (int o = 1; o < 64; o <<= 1) { float t = __shfl_up(inc, o, 64); if (lane >= o) inc += t; }
    __syncthreads();
    if (lane == 63) ldsf[w] = inc;
    __syncthreads();
    float base = inc - s;
    for (int ww = 0; ww < w; ++ww) base += ldsf[ww];
    float c = base;
    u32x4* csx = (u32x4*)(p.ws + WS_SCR + SCR_CSX) + (size_t)bh * SEQ;
#pragma unroll
    for (int i = 0; i < 16; ++i) {
        c += v[i]; cum[tid * 16 + i] = c;
        const float vv = 1.4426950408889634f * c;
        const unsigned hi = pk_bf16(vv, 0.f) & 0xffffu; const float r1 = vv - __uint_as_float(hi << 16);
        const unsigned mid = pk_bf16(r1, 0.f) & 0xffffu; const float r2 = r1 - __uint_as_float(mid << 16);
        const unsigned lo = pk_bf16(r2, 0.f) & 0xffffu;
        u32x4 f; f[0] = 0x3F803F80u; f[1] = 0x3F80u | ((hi ^ 0x8000u) << 16); f[2] = (mid ^ 0x8000u) | ((lo ^ 0x8000u) << 16); f[3] = 0u;
        csx[tid * 16 + i] = f;
    }
}
__device__ void phase_prep(const Params& p, int l, unsigned char* lds_raw) {
    const int n0 = BATCH * H_FOX, n1 = n0 + ((MIXSEL & 1) ? NGDN_CH : 0), n2 = n1 + ((MIXSEL & 2) ? NGLA_CH : 0);
    for (int it = blockIdx.x; it < n2; it += gridDim.x) {
        if (it < n0) { __syncthreads(); fox_cumsum_item(p, l, it, (float*)lds_raw); }
        else if (it < n1) gdn_prep_item(p, l, it - n0, lds_raw);
        else gla_prep_item(p, l, it - n1, lds_raw);
    }
}

typedef float f32x16 __attribute__((ext_vector_type(16)));
#define ATT_BUF 17408
#define ATT_THR 8.0f
#define ATT_NSTAGE 3
__device__ __forceinline__ void attn_issue(const bf16_t* const (&kp)[2], const bf16_t* const (&vp)[2], const bf16_t* cp, int s0, unsigned char* stage, int w) {
    bf16_t* Ks = (bf16_t*)stage; bf16_t* Vs = Ks + 4096; bf16_t* cs = Vs + 4096;
    __builtin_amdgcn_global_load_lds((const unsigned*)(kp[0] + (size_t)s0 * NPROJ), (unsigned*)(Ks + (w * 8) * 64), 16, 0, 0);
    __builtin_amdgcn_global_load_lds((const unsigned*)(kp[1] + (size_t)s0 * NPROJ), (unsigned*)(Ks + (32 + w * 8) * 64), 16, 0, 0);
    __builtin_amdgcn_global_load_lds((const unsigned*)(vp[0] + s0), (unsigned*)(Vs + (w * 8) * 64), 16, 0, 0);
    __builtin_amdgcn_global_load_lds((const unsigned*)(vp[1] + s0), (unsigned*)(Vs + (32 + w * 8) * 64), 16, 0, 0);
    __builtin_amdgcn_global_load_lds((const unsigned*)(cp + (size_t)s0 * 8), (unsigned*)cs, 16, 0, 0);
}
__device__ __forceinline__ bf16x8 attn_qbias(float u, int h) {
    const unsigned hi = pk_bf16(u, 0.f) & 0xffffu; const float r1 = u - __uint_as_float(hi << 16);
    const unsigned mid = pk_bf16(r1, 0.f) & 0xffffu; const float r2 = r1 - __uint_as_float(mid << 16);
    const unsigned lo = pk_bf16(r2, 0.f) & 0xffffu;
    u32x4 f; f[0] = hi | (mid << 16); f[1] = lo | (0x3F80u << 16); f[2] = 0x3F803F80u; f[3] = 0u;
    if (h) { f[0] = 0u; f[1] = 0u; f[2] = 0u; }
    return __builtin_bit_cast(bf16x8, f);
}
__device__ void fox_attn_item(const Params& p, int l, int bh, int qt, unsigned char* lds_raw) {
    const int tid = ltid(), lane = tid & 63, w = __builtin_amdgcn_readfirstlane(tid >> 6), r = lane & 31, h = lane >> 5;
    const int b = bh / H_FOX, hh = bh % H_FOX;
    const bf16_t* proj = (const bf16_t*)(p.ws + WS_PROJ);
    const bf16_t* kbase = proj + (size_t)b * SEQ * NPROJ + NC_FK + hh * 64;
    const bf16_t* vbase = (const bf16_t*)(p.ws + WS_VTF) + (size_t)bh * 64 * SEQ;
    const float* cum = (const float*)(p.ws + WS_CUM) + (size_t)bh * SEQ;
    const int qlo = qt * 128 + w * 32, q = qlo + r;
    bf16x8 qf[4];
    {
        const bf16_t* qrow = proj + (size_t)(b * SEQ + q) * NPROJ + NC_FQ + hh * 64;
#pragma unroll
        for (int kk = 0; kk < 4; ++kk) qf[kk] = *(const bf16x8*)(qrow + kk * 16 + h * 8);
    }
    const float cq2 = cum[q] * 1.4426950408889634f;
    float mref = 0.f;
    bf16x8 qx = attn_qbias(cq2 - mref, h);
    f32x16 o0, o1;
#pragma unroll
    for (int i = 0; i < 16; ++i) { o0[i] = 0.f; o1[i] = 0.f; }
    float lsum = 0.f;
    const int ntiles = 2 * qt + 2;
    const bf16_t* kp[2]; const bf16_t* vp[2];
    {
        const int row0 = w * 8 + (lane >> 3), pc = lane & 7;
        const int lc0 = (pc ^ ((row0 >> 1) & 7)) * 8;
        kp[0] = kbase + (size_t)row0 * NPROJ + lc0; kp[1] = kbase + (size_t)(row0 + 32) * NPROJ + lc0;
        vp[0] = vbase + (size_t)row0 * SEQ + lc0;   vp[1] = vbase + (size_t)(row0 + 32) * SEQ + lc0;
    }
    const bf16_t* cp = (const bf16_t*)(p.ws + WS_SCR + SCR_CSX) + (size_t)bh * SEQ * 8 + lane * 8;
    const int swr = (r >> 1) & 7;
    int jw; float zmax_bound;
    {
        float gq = fabsf(p.in[3][l * 64 + lane]), gk = fabsf(p.in[4][l * 64 + lane]);
#pragma unroll
        for (int o = 32; o > 0; o >>= 1) { gq = fmaxf(gq, __shfl_xor(gq, o, 64)); gk = fmaxf(gk, __shfl_xor(gk, o, 64)); }
        const float thr = 2.f * (1.4426950408889634f * 8.f * gq * gk) + 30.f;
        zmax_bound = 1.4426950408889634f * 8.f * gq * gk;
        const float cw = cum[qlo] * 1.4426950408889634f;
        const float ce = (lane < ntiles) ? cum[64 * lane + 63] * 1.4426950408889634f : 0.f;
        const unsigned long long keep = __ballot((lane < ntiles) && (cw - ce >= -thr));
        jw = keep ? (__ffsll((long long)keep) - 1) : (ntiles - 1);
    }
    volatile int* jshare = (volatile int*)(lds_raw + ATT_NSTAGE * ATT_BUF + 16);
    asm volatile("s_waitcnt vmcnt(0)" ::: "memory");
    RAW_BARRIER();
    if (tid == 0) *jshare = jw;
    RAW_BARRIER();
    const int jstart = *jshare;
    const bool no_rescale = (zmax_bound <= 64.f);
    attn_issue(kp, vp, cp, jstart * 64, lds_raw + (jstart % ATT_NSTAGE) * ATT_BUF, w);
    if (jstart + 1 < ntiles) attn_issue(kp, vp, cp, (jstart + 1) * 64, lds_raw + ((jstart + 1) % ATT_NSTAGE) * ATT_BUF, w);
    for (int j = jstart; j < ntiles; ++j) {
        if (j + 1 < ntiles) asm volatile("s_waitcnt vmcnt(5)" ::: "memory"); else asm volatile("s_waitcnt vmcnt(0)" ::: "memory");
        RAW_BARRIER();
        if (j + 2 < ntiles) attn_issue(kp, vp, cp, (j + 2) * 64, lds_raw + ((j + 2) % ATT_NSTAGE) * ATT_BUF, w);
        const int s0 = j * 64;
        if (s0 <= qlo + 31 && j >= jw) {
            const bf16_t* Ks = (const bf16_t*)(lds_raw + (j % ATT_NSTAGE) * ATT_BUF); const bf16_t* Vs = Ks + 4096; const bf16_t* cs = Vs + 4096;
            f32x16 st0, st1;
            {
                u32x4 z4 = {0u, 0u, 0u, 0u};
                u32x4 c0 = *(const u32x4*)(cs + r * 8), c1 = *(const u32x4*)(cs + (32 + r) * 8);
                if (h) { c0 = z4; c1 = z4; }
                f32x16 zz;
#pragma unroll
                for (int i = 0; i < 16; ++i) zz[i] = 0.f;
                st0 = __builtin_amdgcn_mfma_f32_32x32x16_bf16(__builtin_bit_cast(bf16x8, c0), qx, zz, 0, 0, 0);
                st1 = __builtin_amdgcn_mfma_f32_32x32x16_bf16(__builtin_bit_cast(bf16x8, c1), qx, zz, 0, 0, 0);
            }
#pragma unroll
            for (int kk = 0; kk < 4; ++kk) {
                const int co = ((kk * 2 + h) ^ swr) * 8;
                bf16x8 a0 = *(const bf16x8*)(Ks + r * 64 + co);
                bf16x8 a1 = *(const bf16x8*)(Ks + (32 + r) * 64 + co);
                st0 = __builtin_amdgcn_mfma_f32_32x32x16_bf16(a0, qf[kk], st0, 0, 0, 0);
                st1 = __builtin_amdgcn_mfma_f32_32x32x16_bf16(a1, qf[kk], st1, 0, 0, 0);
            }
            if (s0 + 63 > qlo) {
#pragma unroll
                for (int i = 0; i < 16; ++i) {
                    const int key = s0 + (i & 3) + 8 * (i >> 2) + 4 * h;
                    if (key > q) st0[i] = -1e30f;
                    if (key + 32 > q) st1[i] = -1e30f;
                }
            }
            float mx = 0.f;
            if (!no_rescale) {
                mx = fmaxf(st0[0], st1[0]);
#pragma unroll
                for (int i = 1; i < 16; ++i) mx = fmaxf(mx, fmaxf(st0[i], st1[i]));
            }
            if (!no_rescale && __any(mx > ATT_THR)) {
                const float mo = fmaxf(mx, __shfl_xor(mx, 32, 64));
                const float d = (mo > ATT_THR) ? mo : 0.f;
                const float alpha = __builtin_amdgcn_exp2f(-d);
#pragma unroll
                for (int i = 0; i < 16; ++i) { st0[i] -= d; st1[i] -= d; o0[i] *= alpha; o1[i] *= alpha; }
                lsum *= alpha; mref += d;
                qx = attn_qbias(cq2 - mref, h);
            }
            float rs = 0.f;
#pragma unroll
            for (int i = 0; i < 16; ++i) { st0[i] = __builtin_amdgcn_exp2f(st0[i]); st1[i] = __builtin_amdgcn_exp2f(st1[i]); rs += st0[i] + st1[i]; }
            lsum += rs;
            bf16x8 pf[2][2];
#pragma unroll
            for (int s = 0; s < 2; ++s) {
                u32x4 t0 = {pk_bf16(st0[8 * s], st0[8 * s + 1]), pk_bf16(st0[8 * s + 2], st0[8 * s + 3]), pk_bf16(st0[8 * s + 4], st0[8 * s + 5]), pk_bf16(st0[8 * s + 6], st0[8 * s + 7])};
                u32x4 t1 = {pk_bf16(st1[8 * s], st1[8 * s + 1]), pk_bf16(st1[8 * s + 2], st1[8 * s + 3]), pk_bf16(st1[8 * s + 4], st1[8 * s + 5]), pk_bf16(st1[8 * s + 6], st1[8 * s + 7])};
                pf[0][s] = __builtin_bit_cast(bf16x8, t0); pf[1][s] = __builtin_bit_cast(bf16x8, t1);
            }
#pragma unroll
            for (int mt = 0; mt < 2; ++mt)
#pragma unroll
                for (int s = 0; s < 2; ++s) {
                    const int c0 = 4 * mt + 2 * s;
                    const int oA = ((c0 ^ swr) * 8) + 4 * h, oB = (((c0 + 1) ^ swr) * 8) + 4 * h;
                    uint2 a00 = *(const uint2*)(Vs + r * 64 + oA), a01 = *(const uint2*)(Vs + r * 64 + oB);
                    uint2 a10 = *(const uint2*)(Vs + (32 + r) * 64 + oA), a11 = *(const uint2*)(Vs + (32 + r) * 64 + oB);
                    u32x4 u0 = {a00.x, a00.y, a01.x, a01.y}; u32x4 u1 = {a10.x, a10.y, a11.x, a11.y};
                    o0 = __builtin_amdgcn_mfma_f32_32x32x16_bf16(__builtin_bit_cast(bf16x8, u0), pf[mt][s], o0, 0, 0, 0);
                    o1 = __builtin_amdgcn_mfma_f32_32x32x16_bf16(__builtin_bit_cast(bf16x8, u1), pf[mt][s], o1, 0, 0, 0);
                }
        }
    }
    lsum += __shfl_xor(lsum, 32, 64);
    const float inv = 1.f / lsum;
    float ss = 0.f;
#pragma unroll
    for (int i = 0; i < 16; ++i) { o0[i] *= inv; o1[i] *= inv; ss += o0[i] * o0[i] + o1[i] * o1[i]; }
    ss += __shfl_xor(ss, 32, 64);
    const float rstd = rsqrtf(ss * (1.f / 64.f) + 1e-6f);
    const float* og = p.in[6] + l * 64;
    bf16_t* mrow = (bf16_t*)(p.ws + WS_MIX) + pl_off(b * SEQ + q, hh * 64, 1024);
#pragma unroll
    for (int g = 0; g < 4; ++g) {
        const int e0 = 8 * g + 4 * h;
        f32x4 g0 = *(const f32x4*)(og + e0), g1 = *(const f32x4*)(og + 32 + e0);
        store4_bf16(mrow + e0, o0[4 * g] * rstd * g0[0], o0[4 * g + 1] * rstd * g0[1], o0[4 * g + 2] * rstd * g0[2], o0[4 * g + 3] * rstd * g0[3]);
        store4_bf16(mrow + 64 + e0, o1[4 * g] * rstd * g1[0], o1[4 * g + 1] * rstd * g1[1], o1[4 * g + 2] * rstd * g1[2], o1[4 * g + 3] * rstd * g1[3]);
    }
}
#define ATT_ITEMS (BATCH * H_FOX * (SEQ / 128))
#define CONV_ITEMS ((CONV_REST + P0_T_IN + 3) / 4)
__device__ void phase_scan_attn(const Params& p, int l, unsigned char* lds_raw, int rep = 0, int sel = 7) {
    unsigned* qctr = (unsigned*)(p.ws + WS_CTL) + CW_Q + l + 2 * rep;
    volatile int* slot = (volatile int*)(lds_raw + ATT_NSTAGE * ATT_BUF);
    for (;;) {
        __syncthreads();
        if (threadIdx.x == 0) *slot = (int)atomicAdd(qctr, 1u);
        __syncthreads();
        int it = *slot;
        const int ns0 = (MIXSEL & 1) ? BATCH * H_GDN * 4 : 0, ns1 = ns0 + ((MIXSEL & 2) ? 128 : 0);
        if (it >= ns1 + ATT_ITEMS + CONV_ITEMS) break;
        if (it >= ns1) {
            const int c = it - ns1;
            int conv_idx = -1;
            if (c < 5 * ATT_ITEMS) { if (c % 5 != 0) conv_idx = c - c / 5 - 1; } else conv_idx = c - ATT_ITEMS;
            if (conv_idx >= 0) {
                if (rep == 0 && conv_idx < CONV_ITEMS) conv_fold4(p, l, conv_idx * 4, ltid());
                continue;
            }
            it = ns1 + c / 5;
        }
        if (it < ns0) { if (sel & 1) gdn_scan_item(p, it, lds_raw, rep ? SVAR : 0); continue; }
        if (it < ns1) { if (sel & 2) gla_scan_item(p, it - ns0); continue; }
        it -= ns1;
        if (!(sel & 4)) continue;
        const int qt = (SEQ / 128 - 1) - it / (BATCH * H_FOX), bh = it % (BATCH * H_FOX);
        fox_attn_item(p, l, bh, qt, lds_raw);
    }
}

#define NPHASE 19
__global__ void __launch_bounds__(256, 2) mk(Params p, int lo, int hi, int use_bar) {
    __shared__ __attribute__((aligned(16))) unsigned char lds_raw[LDS_BYTES];
    bf16_t* lds = (bf16_t*)lds_raw;
    volatile LAS unsigned* st = (volatile LAS unsigned*)(lds_raw + LDS_BYTES - 16);
    XcdBarrier bar; bar.bar = (unsigned*)(p.ws + WS_CTL) + CW_BAR; bar.x = 0; bar.st = st;
    if (use_bar) {
        if (threadIdx.x == 0) { st[0] = 0u; st[1] = 0u; }
        __syncthreads();
        bar = xcd_barrier_post((unsigned*)(p.ws + WS_CTL) + CW_BAR, st);
    }
    for (int ph = lo; ph < hi; ++ph) {
#ifndef PSEL
#define PSEL 0xffff
#endif
        int phv = ph; asm volatile("" : "+s"(phv));
        size_t zoff = 0; asm volatile("" : "+s"(zoff));
        Params q = p; q.ws = p.ws + zoff; q.out = p.out + zoff;
        if (phv == 0) { if (PSEL & 1) phase0(q); }
        else {
            int l = (phv - 1) / 9, s = (phv - 1) % 9;
            if (s == 0) { if (PSEL & 2) phase_inproj(q, l, lds); }
            else if (s == 1) { if (PSEL & 128) phase_prep(q, l, lds_raw); }
            else if (s == 2) { if (PSEL & 256) phase_scan_attn(q, l, lds_raw); }
            else if (s == 3) { if (PSEL & 512) phase_mixout(q, l); }
            else if (s == 4) { if (PSEL & 4) phase_outproj(q, l, lds); }
            else if (s == 5) { if (PSEL & 8) phase_route(q, l, lds); }
            else if (s == 6) { if (PSEL & 16) phase_expert<0>(q, l, lds); }
            else if (s == 7) { if (PSEL & 32) phase_expert<1>(q, l, lds); }
            else if (s == 8) { if (PSEL & 64) phase_combine(q, l); }
        }
#ifdef REPEAT_MASK
        {
            const int ty = (phv == 0) ? 9 : (phv - 1) % 9, l = (phv == 0) ? 0 : (phv - 1) / 9;
            const bool idem = !((ty == 4 && l == 1));
            if (((REPEAT_MASK >> ty) & 1) && idem && use_bar) {
                xcd_barrier(bar);
                if (ty == 9) phase0(q);
                else if (ty == 0) phase_inproj(q, l, lds, GVAR);
                else if (ty == 1) phase_prep(q, l, lds_raw);
                else if (ty == 2) phase_scan_attn(q, l, lds_raw, 1, P3SEL);
                else if (ty == 3) phase_mixout(q, l);
                else if (ty == 4) phase_outproj(q, l, lds);
                else if (ty == 5) phase_route(q, l, lds, 1);
                else if (ty == 8) phase_combine(q, l, 1);
                else if (ty == 6) phase_expert<0>(q, l, lds);
                else if (ty == 7) phase_expert<1>(q, l, lds);
            }
        }
#endif
        if (ph + 1 < hi) {
            if (hi > 1000) cg::this_grid().sync();
            xcd_barrier(bar);
        }
    }
}

extern "C" void kernel_launch(void* const* d_in, const int* in_sizes, int n_in,
                              void* d_out, int out_size, void* d_ws, size_t ws_size,
                              hipStream_t stream) {
    static int grid = 0;
    if (grid == 0) {
        if (ws_size < WS_END) { fprintf(stderr, "ws too small: need %zu have %zu\n", (size_t)WS_END, ws_size); grid = -1; return; }
        int dev = 0, cus = 0, per_cu = 0;
        hipGetDevice(&dev);
        hipDeviceGetAttribute(&cus, hipDeviceAttributeMultiprocessorCount, dev);
        hipOccupancyMaxActiveBlocksPerMultiprocessor(&per_cu, mk, 256, 0);
        if (per_cu > 2) per_cu = 2;
        if (per_cu < 1) { fprintf(stderr, "occupancy query failed\n"); grid = -1; return; }
        grid = cus * per_cu;
        grid -= grid % 8;
    }
    if (grid < 0) return;
    Params p{};
    for (int i = 0; i < 23; ++i) p.in[i] = (const float*)d_in[i];
    p.out = (float*)d_out; p.ws = (char*)d_ws;
    hipMemsetAsync((char*)d_ws + WS_CTL, 0, CTL_BYTES, stream);
#ifdef POISON_GLA
    hipMemsetAsync((char*)d_ws + WS_SCR + SCR_GLA_OL, 0xFF, SCR_LVT - SCR_GLA_OL, stream);
#endif

#ifdef MULTI_LAUNCH
    for (int ph = 0; ph < NPHASE; ++ph) mk<<<grid, 256, 0, stream>>>(p, ph, ph + 1, 0);
#else
    int lo = 0, hi = NPHASE, ub = 2;
    void* args[] = {&p, &lo, &hi, &ub};
    hipError_t e = hipLaunchCooperativeKernel((void*)mk, dim3(grid), dim3(256), args, 0, stream);
    if (e != hipSuccess) fprintf(stderr, "cooperative launch failed: %s (grid %d)\n", hipGetErrorString(e), grid);
#endif
}
```

```cpp
#include <hip/hip_runtime.h>
#include <hip/hip_cooperative_groups.h>
#include <cstdint>
#include <cstdio>
namespace cg = cooperative_groups;

#define D_MODEL 1024
#define BATCH 4
#define SEQ 4096
#define NTOK (BATCH * SEQ)
#define H_FOX 6
#define H_GDN 6
#define H_GLA 4
#define N_IN 3490
#define N_EXP 32
#define D_EXP 512
#define NPROJ 3456
#define NINP 3584

#define C_FF 1152
#define C_GQ 1158
#define C_GG 2310
#define C_GA 2694
#define C_GB 2700
#define C_LQ 2706
#define C_LA 3474
#define NC_FQ 0
#define NC_FK 384
#define NC_FV 768
#define NC_GQ 1152
#define NC_GK 1536
#define NC_GV 1920
#define NC_GG 2304
#define NC_LQ 2688
#define NC_LK 2816
#define NC_LV 2944
#define NC_LR 3200
#define AX_FF 0
#define AX_GA 6
#define AX_GB 12
#define AX_LA 18

#ifndef SVAR
#define SVAR 0
#endif
#ifndef P3SEL
#define P3SEL 7
#endif
#ifndef GVAR
#define GVAR 0
#endif
#ifndef MIXSEL
#define MIXSEL 3
#endif
typedef unsigned short bf16_t;
typedef short bf16x8 __attribute__((ext_vector_type(8)));
typedef float f32x4 __attribute__((ext_vector_type(4)));
typedef unsigned u32x4 __attribute__((ext_vector_type(4)));
typedef unsigned u32x2 __attribute__((ext_vector_type(2)));
typedef int i32x8 __attribute__((ext_vector_type(8)));
typedef float f32x16 __attribute__((ext_vector_type(16)));

#define WS_CTL      0
#define CTL_BYTES   262144
#define WS_WIN      (WS_CTL + CTL_BYTES)
#define WS_WOUT     (WS_WIN + (size_t)2 * NINP * 1024 * 2)
#define WS_WGU      (WS_WOUT + (size_t)2 * 1024 * 1024 * 2)
#define WS_WD       (WS_WGU + (size_t)2 * 32 * 1024 * 1024 * 2)
#define WS_WR       (WS_WD + (size_t)2 * 32 * 1024 * 512 * 2)
#define WS_HN       (WS_WR + (size_t)2 * 64 * 1024 * 2)
#define WS_PROJ     (WS_HN + (size_t)NTOK * 1024 * 2)
#define WS_VTF      (WS_PROJ + (size_t)NTOK * NPROJ * 2)
#define WS_AUX      (WS_VTF + (size_t)BATCH * H_FOX * 64 * SEQ * 2)
#define WS_CUM      (WS_AUX + (size_t)NTOK * 64 * 4)
#define WS_MIX      (WS_CUM + (size_t)BATCH * H_FOX * SEQ * 4)
#define WS_ROWTOK   (WS_MIX + (size_t)NTOK * 1024 * 2)
#define WS_TSLOT    (WS_ROWTOK + (size_t)32 * NTOK * 4)
#define WS_TGATE    (WS_TSLOT + (size_t)NTOK * 2 * 4)
#define WS_SCR      (WS_TGATE + (size_t)NTOK * 2 * 4)
#define SCR_BYTES   ((size_t)100 * 1024 * 1024)
#define WS_END      (WS_SCR + SCR_BYTES)
#define HROWS       (2 * NTOK + 32 * 128)
#define WS_H        WS_PROJ
#define WS_Y        (WS_PROJ + (size_t)HROWS * 512 * 2)

#define NGDN_CH 1536
#define NGLA_CH 1024
#define SCR_GDN_MP   ((size_t)0)
#define SCR_GDN_NN   (SCR_GDN_MP + (size_t)NGDN_CH * 8192)
#define SCR_GDN_P    (SCR_GDN_NN + (size_t)NGDN_CH * 8192)
#define SCR_GDN_OL   (SCR_GDN_P  + (size_t)NGDN_CH * 8192)
#define SCR_GDN_SG   (SCR_GDN_OL + (size_t)NGDN_CH * 8192)
#define SCR_GDN_LAST (SCR_GDN_SG + (size_t)NGDN_CH * 8192)
#define SCR_GLA_OL   (SCR_GDN_LAST + (size_t)NGDN_CH * 4)
#define SCR_GLA_KV   (SCR_GLA_OL + (size_t)NGLA_CH * 8192)
#define SCR_GLA_QB   (SCR_GLA_KV + (size_t)NGLA_CH * 8192)
#define SCR_GLA_SG   (SCR_GLA_QB + (size_t)NGLA_CH * 4096)
#define SCR_GLA_DL   (SCR_GLA_SG + (size_t)NGLA_CH * 4096)
#define SCR_LVT      (SCR_GLA_DL + (size_t)NGLA_CH * 128)
#define SCR_USED     (SCR_LVT + (size_t)BATCH * H_GLA * 64 * SEQ * 2)
#define SCR_XB       ((size_t)0)
#define SCR_CSX      SCR_USED
static_assert(SCR_CSX + (size_t)BATCH * H_FOX * SEQ * 16 <= SCR_BYTES, "scratch overflow");
#define CW_BAR      0
#define CW_CNT      4096
#define CNT_STRIDE  64
#define NSH         8
#define SHCAP       2048
#define CW_Q        (CW_CNT + 2 * 32 * NSH * CNT_STRIDE + 64)
#define CW_MOETAB   (CW_Q + 256)
#define CW_CQ       (CW_MOETAB + 576)

struct Params {
    const float* in[23];
    float* out;
    char* ws;
};

__device__ __forceinline__ float sigmoidf_(float x) { return __builtin_amdgcn_rcpf(1.f + __expf(-x)); }
__device__ __forceinline__ float siluf_(float x) { return x * __builtin_amdgcn_rcpf(1.f + __expf(-x)); }
__device__ __forceinline__ float softplusf_(float x) { return x > 20.f ? x : __logf(1.f + __expf(x)); }
__device__ __forceinline__ float logsigmoidf_(float x) { return -softplusf_(-x); }
__device__ __forceinline__ float wave_sum(float v) {
#pragma unroll
    for (int o = 32; o > 0; o >>= 1) v += __shfl_xor(v, o, 64);
    return v;
}
__device__ __forceinline__ int ltid() { int t = threadIdx.x; asm volatile("" : "+v"(t)); return t; }
typedef __bf16 bf16x2_t __attribute__((ext_vector_type(2)));
typedef float f32x2_t __attribute__((ext_vector_type(2)));
__device__ __forceinline__ unsigned pk_bf16(float lo, float hi) { f32x2_t v = {lo, hi}; bf16x2_t r = __builtin_convertvector(v, bf16x2_t); return __builtin_bit_cast(unsigned, r); }
#define F8_WSCALE 256.f
#define F8_ASCALE 8.f
#define F8_YSCALE 16.f
__device__ __forceinline__ unsigned pk_fp8x4(float a, float b, float c, float d) {
    int w = __builtin_amdgcn_cvt_pk_fp8_f32(a, b, 0, false);
    w = __builtin_amdgcn_cvt_pk_fp8_f32(c, d, w, true);
    return (unsigned)w;
}
__device__ __forceinline__ size_t pl8_off(int row, int k, int K) { return (size_t)(row >> 1) * (size_t)(2 * K) + (size_t)((k >> 6) * 128 + (row & 1) * 64 + (k & 63)); }
__device__ __forceinline__ float f8clamp(float v) { return __builtin_amdgcn_fmed3f(v, -448.f, 448.f); }
__device__ __forceinline__ size_t pl_off(int row, int k, int K) { return (size_t)(row >> 1) * (size_t)(2 * K) + (size_t)((k >> 5) * 64 + (row & 1) * 32 + (k & 31)); }
__device__ __forceinline__ unsigned ld_u32_agent(const unsigned* p) { return __hip_atomic_load(p, __ATOMIC_RELAXED, __HIP_MEMORY_SCOPE_AGENT); }
__device__ __forceinline__ float ld_f32_agent(const float* p) { return __uint_as_float(__hip_atomic_load((const unsigned*)p, __ATOMIC_RELAXED, __HIP_MEMORY_SCOPE_AGENT)); }
__device__ __forceinline__ float bf2f(bf16_t v) { return __uint_as_float((unsigned)v << 16); }
__device__ __forceinline__ float bflo(unsigned v) { return __uint_as_float(v << 16); }
__device__ __forceinline__ float bfhi(unsigned v) { return __uint_as_float(v & 0xffff0000u); }

#define XB_TMO      128
#define XB_XCNT(j)  (256  + 64 * (j))
#define XB_XSUB(j)  (1280 + 64 * (j))
#define XB_XGEN(j)  (2304 + 64 * (j))
#define XB_TOP      3328
#define XB_TOPGEN   3392
#define XCD_BAR_WORDS 3456
#define XB_SPIN_CAP (1u << 22)
#define LAS __attribute__((address_space(3)))
__device__ __forceinline__ unsigned xb_ld(unsigned* p)              { return __hip_atomic_load(p, __ATOMIC_RELAXED, __HIP_MEMORY_SCOPE_AGENT); }
__device__ __forceinline__ unsigned xb_add(unsigned* p, unsigned v) { return __hip_atomic_fetch_add(p, v, __ATOMIC_RELAXED, __HIP_MEMORY_SCOPE_AGENT); }
__device__ __forceinline__ unsigned xb_xcc_id() { return (unsigned)__builtin_amdgcn_s_getreg((3 << 11) | 20) & 0xFu; }
#define XB_SPIN(cond, bar) do { unsigned _sp = 0; while (cond) { if (_sp < 16u) __builtin_amdgcn_s_sleep(2); else __builtin_amdgcn_s_sleep(20);     \
    if ((++_sp & 255u) == 0u) { if (xb_ld(&(bar)[XB_TMO])) break; if (_sp > XB_SPIN_CAP) { atomicAdd(&(bar)[XB_TMO], 1u); break; } } } } while (0)
struct XcdBarrier { unsigned* bar; unsigned x; volatile LAS unsigned* st; };
__device__ __forceinline__ XcdBarrier xcd_barrier_post(unsigned* bar, volatile LAS unsigned* st) {
    XcdBarrier b; b.bar = bar; b.x = xb_xcc_id(); b.st = st;
    if (threadIdx.x == 0) (void)xb_add(&bar[XB_XCNT(b.x)], 1u);
    return b;
}
__device__ __forceinline__ void xcd_barrier_complete(unsigned* bar, unsigned x, unsigned& nloc, unsigned& nx) {
    const unsigned G = gridDim.x * gridDim.y * gridDim.z;
    unsigned sum, cnt, mine, sp = 0u;
    for (;;) {
        sum = 0u; cnt = 0u; mine = 0u;
#pragma unroll
        for (unsigned j = 0; j < 16; ++j) { const unsigned c = xb_ld(&bar[XB_XCNT(j)]); sum += c; cnt += (c > 0u) ? 1u : 0u; mine = (j == x) ? c : mine; }
        if (sum == G) break;
        __builtin_amdgcn_s_sleep(1);
        if ((++sp & 255u) == 0u) { if (xb_ld(&bar[XB_TMO])) break; if (sp > XB_SPIN_CAP) { atomicAdd(&bar[XB_TMO], 1u); break; } }
    }
    nloc = mine > 0u ? mine : 1u; nx = cnt > 0u ? cnt : 1u;
}
template <class WORK>
__device__ __forceinline__ void xcd_barrier(const XcdBarrier& b, unsigned* cq, unsigned lim, bool drain, WORK work) {
    asm volatile("s_waitcnt vmcnt(0)" ::: "memory");
    __syncthreads();
    unsigned old = 0u, gen = 0u, nloc = 1u, nx = 1u; bool last = false;
    if (threadIdx.x == 0) {
        unsigned* bar = b.bar;
        __builtin_amdgcn_s_waitcnt(0);
        nloc = b.st[0]; nx = b.st[1];
        if (nloc == 0u) { xcd_barrier_complete(bar, b.x, nloc, nx); b.st[0] = nloc; b.st[1] = nx; }
        old = xb_add(&bar[XB_XSUB(b.x)], 1u);
        gen = old / nloc;
        last = (old + 1u == (gen + 1u) * nloc);
        if (cq) { unsigned ci = 0xffffffffu; if (!last) { ci = xb_add(cq, 1u); if (ci >= lim) ci = 0xffffffffu; } b.st[2] = ci; }
    }
    if (cq) {
        for (;;) {
            __syncthreads();
            const unsigned ci = b.st[2];
            if (ci == 0xffffffffu) break;
            work((int)ci);
            if (!drain) break;
            __syncthreads();
            if (threadIdx.x == 0) { unsigned cn = xb_add(cq, 1u); if (cn >= lim) cn = 0xffffffffu; b.st[2] = cn; }
        }
    }
    if (threadIdx.x == 0) {
        unsigned* bar = b.bar;
        if (last) {
            __builtin_amdgcn_fence(__ATOMIC_RELEASE, "agent");
            asm volatile("s_waitcnt vmcnt(0)" ::: "memory");
            const unsigned og = xb_add(&bar[XB_TOP], 1u);
            const unsigned tg = og / nx;
            if (og + 1u == (tg + 1u) * nx) xb_add(&bar[XB_TOPGEN], 1u);
            else XB_SPIN(xb_ld(&bar[XB_TOPGEN]) == tg, bar);
            __builtin_amdgcn_fence(__ATOMIC_ACQUIRE, "agent");
            xb_add(&bar[XB_XGEN(b.x)], 1u);
            asm volatile("s_waitcnt vmcnt(0)" ::: "memory");
        } else {
            XB_SPIN(xb_ld(&bar[XB_XGEN(b.x)]) == gen, bar);
            __builtin_amdgcn_fence(__ATOMIC_ACQUIRE, "agent");
            asm volatile("s_waitcnt vmcnt(0)" ::: "memory");
        }
    }
    __syncthreads();
}

__device__ __forceinline__ void xcd_barrier(const XcdBarrier& b) { xcd_barrier(b, (unsigned*)nullptr, 0u, false, [](int) {}); }

#define LDS_BYTES 68096
#define LROW 72

__device__ __forceinline__ int inproj_map(int n) {
    if (n < 1152) return n;
    if (n < 2304) return C_GQ + (n - 1152);
    if (n < 2688) return C_GG + (n - 2304);
    if (n < 3456) return C_LQ + (n - 2688);
    if (n < 3462) return C_FF + (n - 3456);
    if (n < 3468) return C_GA + (n - 3462);
    if (n < 3474) return C_GB + (n - 3468);
    if (n < 3490) return n;
    return -1;
}
#define P0_T_IN   (56 * 16)
#define P0_T_OUT  (16 * 16)
#define P0_T_GU   (32 * 16 * 16)
#define P0_T_D    (32 * 16 * 8)
#define P0_T_R    (16)
#define P0_T_LAYER (P0_T_IN + P0_T_OUT + P0_T_GU + P0_T_D + P0_T_R)
#define P0_T_NORM (NTOK / 4)
struct ConvDesc { const float* src; bf16_t* dst; int ld; int col; int q8; };
__device__ __forceinline__ ConvDesc conv_desc(const Params& p, int l, int j, int tid) {
    const int nl = tid & 63, kg = tid >> 6;
    ConvDesc d; d.q8 = 0;
    if (j < P0_T_IN) {
        int tn = j / 16, tk = j % 16; int n = tn * 64 + nl; int k0 = tk * 64 + kg * 16;
        d.ld = N_IN; d.col = inproj_map(n); d.src = p.in[2] + (size_t)l * 1024 * N_IN + (size_t)k0 * N_IN;
        d.dst = (bf16_t*)(p.ws + WS_WIN) + (size_t)l * NINP * 1024 + pl_off(n, k0, 1024);
        return d;
    }
    j -= P0_T_IN;
    if (j < P0_T_OUT) {
        int tn = j / 16, tk = j % 16; int n = tn * 64 + nl; int k0 = tk * 64 + kg * 16;
        d.ld = 1024; d.col = n; d.src = p.in[14] + (size_t)l * 1024 * 1024 + (size_t)k0 * 1024;
        d.dst = (bf16_t*)(p.ws + WS_WOUT) + (size_t)l * 1024 * 512 + pl_off(n, k0 >> 1, 512); d.q8 = 1;
        return d;
    }
    j -= P0_T_OUT;
    if (j < P0_T_GU) {
        int e = j / 256, r = j % 256; int tn = r / 16, tk = r % 16; int n = tn * 64 + nl; int k0 = tk * 64 + kg * 16;
        int t128 = n >> 7, wx = (n >> 6) & 1, half = (n >> 5) & 1, jj = n & 31;
        d.ld = 512; d.col = t128 * 64 + wx * 32 + jj;
        d.src = (half ? p.in[21] : p.in[20]) + ((size_t)l * 32 + e) * 1024 * 512 + (size_t)k0 * 512;
        d.dst = (bf16_t*)(p.ws + WS_WGU) + ((size_t)l * 32 + e) * 1024 * 512 + pl_off(n, k0 >> 1, 512); d.q8 = 1;
        return d;
    }
    j -= P0_T_GU;
    if (j < P0_T_D) {
        int e = j / 128, r = j % 128; int tn = r / 8, tk = r % 8; int n = tn * 64 + nl; int k0 = tk * 64 + kg * 16;
        d.ld = 1024; d.col = n; d.src = p.in[22] + ((size_t)l * 32 + e) * 512 * 1024 + (size_t)k0 * 1024;
        d.dst = (bf16_t*)(p.ws + WS_WD) + ((size_t)l * 32 + e) * 1024 * 256 + pl_off(n, k0 >> 1, 256); d.q8 = 1;
        return d;
    }
    j -= P0_T_D;
    {
        int tk = j; int n = nl; int k0 = tk * 64 + kg * 16;
        if (n < 4) { d.src = p.in[16] + (size_t)l * 1024 * 4 + (size_t)k0 * 4; d.ld = 4; d.col = n; }
        else if (n < 36) { d.src = p.in[18] + (size_t)l * 1024 * 32 + (size_t)k0 * 32; d.ld = 32; d.col = n - 4; }
        else { d.src = p.in[16]; d.ld = 4; d.col = -1; }
        d.dst = (bf16_t*)(p.ws + WS_WR) + ((size_t)l * 64 + n) * 1024 + k0;
        return d;
    }
}
__device__ __forceinline__ void conv_load(const ConvDesc& d, float (&v)[16]) {
    if (d.col >= 0) {
#pragma unroll
        for (int i = 0; i < 16; ++i) v[i] = __builtin_nontemporal_load(d.src + (size_t)i * d.ld + d.col);
    } else {
#pragma unroll
        for (int i = 0; i < 16; ++i) v[i] = 0.f;
    }
}
__device__ __forceinline__ void conv_store(const ConvDesc& d, const float (&v)[16]) {
    if (d.q8) {
        u32x4 o;
#pragma unroll
        for (int c = 0; c < 4; ++c) o[c] = pk_fp8x4(v[4 * c] * F8_WSCALE, v[4 * c + 1] * F8_WSCALE, v[4 * c + 2] * F8_WSCALE, v[4 * c + 3] * F8_WSCALE);
        *(u32x4*)(d.dst) = o;
        return;
    }
    uint4 o0, o1;
    o0.x = pk_bf16(v[0], v[1]); o0.y = pk_bf16(v[2], v[3]); o0.z = pk_bf16(v[4], v[5]); o0.w = pk_bf16(v[6], v[7]);
    o1.x = pk_bf16(v[8], v[9]); o1.y = pk_bf16(v[10], v[11]); o1.z = pk_bf16(v[12], v[13]); o1.w = pk_bf16(v[14], v[15]);
    *(uint4*)(d.dst) = o0;
    *(uint4*)(d.dst + 8) = o1;
}
__device__ __forceinline__ void conv_job(const Params& p, int l, int j, int tid) {
    ConvDesc d = conv_desc(p, l, j, tid); float v[16]; conv_load(d, v); conv_store(d, v);
}
#define CONV_REST (P0_T_LAYER - P0_T_IN)
#define CONV_N0 (CONV_REST / 4)
#define CONV_N1 (P0_T_LAYER / 4)
#define CONV_BASE0 1350
#define CONV_TAIL0 2140
__device__ __forceinline__ bool conv_fold_desc(const Params& p, int l, int idx, int tid, ConvDesc& d) {
    if (l == 0) { if (idx < CONV_REST) { d = conv_desc(p, 0, P0_T_IN + idx, tid); return true; } }
    else if (idx < P0_T_LAYER) { d = conv_desc(p, 1, idx, tid); return true; }
    return false;
}
__device__ __forceinline__ void conv_fold4(const Params& p, int l, int idx0, int tid) {
    ConvDesc d0, d1, d2, d3; float v0[16], v1[16], v2[16], v3[16];
    const bool b0 = conv_fold_desc(p, l, idx0, tid, d0), b1 = conv_fold_desc(p, l, idx0 + 1, tid, d1), b2 = conv_fold_desc(p, l, idx0 + 2, tid, d2), b3 = conv_fold_desc(p, l, idx0 + 3, tid, d3);
    if (b0) conv_load(d0, v0); if (b1) conv_load(d1, v1); if (b2) conv_load(d2, v2); if (b3) conv_load(d3, v3);
    if (b0) conv_store(d0, v0); if (b1) conv_store(d1, v1); if (b2) conv_store(d2, v2); if (b3) conv_store(d3, v3);
}
__device__ __forceinline__ void conv_fold2(const Params& p, int l, int idx0, int tid) {
    ConvDesc d0, d1; float v0[16], v1[16];
    const bool b0 = conv_fold_desc(p, l, idx0, tid, d0), b1 = conv_fold_desc(p, l, idx0 + 1, tid, d1);
    if (b0) conv_load(d0, v0); if (b1) conv_load(d1, v1);
    if (b0) conv_store(d0, v0); if (b1) conv_store(d1, v1);
}
__device__ void phase0(const Params& p) {
    const int tid = ltid(), nl = tid & 63, kg = tid >> 6;
    const int total = P0_T_IN + P0_T_NORM;
    for (int it = blockIdx.x; it < total; it += gridDim.x) {
        if (it >= P0_T_IN) {
            int row = (it - P0_T_IN) * 4 + kg;
            const float* xr = p.in[0] + (size_t)row * D_MODEL + nl * 16;
            const float* gr = p.in[1] + nl * 16;
            float v[16]; float ss = 0.f;
#pragma unroll
            for (int i = 0; i < 4; ++i) { float4 t = *(const float4*)(xr + 4 * i); v[4 * i] = t.x; v[4 * i + 1] = t.y; v[4 * i + 2] = t.z; v[4 * i + 3] = t.w; }
#pragma unroll
            for (int i = 0; i < 16; ++i) ss += v[i] * v[i];
            ss = wave_sum(ss);
            float r = rsqrtf(ss / D_MODEL + 1e-6f);
#pragma unroll
            for (int i = 0; i < 16; ++i) v[i] = v[i] * r * gr[i];
            uint4 o0, o1;
            o0.x = pk_bf16(v[0], v[1]); o0.y = pk_bf16(v[2], v[3]); o0.z = pk_bf16(v[4], v[5]); o0.w = pk_bf16(v[6], v[7]);
            o1.x = pk_bf16(v[8], v[9]); o1.y = pk_bf16(v[10], v[11]); o1.z = pk_bf16(v[12], v[13]); o1.w = pk_bf16(v[14], v[15]);
            bf16_t* hr = (bf16_t*)(p.ws + WS_HN) + pl_off(row, nl * 16, 1024);
            *(uint4*)hr = o0; *(uint4*)(hr + 8) = o1;
            continue;
        }
        conv_job(p, 0, it, tid);
    }
}

#define GSTAGE 8192
#define RAW_BARRIER() do { asm volatile("s_waitcnt lgkmcnt(0)" ::: "memory"); __builtin_amdgcn_s_barrier(); } while (0)
__device__ __forceinline__ int gswz(int row) { return (0x1320 >> (((row >> 2) & 3) * 4)) & 3; }
__device__ __forceinline__ void gemm_issue(const bf16_t* const (&px)[2], const bf16_t* const (&py)[2], int k0, bf16_t* stage, int w) {
    __builtin_amdgcn_global_load_lds((const unsigned*)(px[0] + 2 * k0), (unsigned*)(stage + (w * 16) * 32), 16, 0, 0);
    __builtin_amdgcn_global_load_lds((const unsigned*)(px[1] + 2 * k0), (unsigned*)(stage + (64 + w * 16) * 32), 16, 0, 0);
    __builtin_amdgcn_global_load_lds((const unsigned*)(py[0] + 2 * k0), (unsigned*)(stage + 4096 + (w * 16) * 32), 16, 0, 0);
    __builtin_amdgcn_global_load_lds((const unsigned*)(py[1] + 2 * k0), (unsigned*)(stage + 4096 + (64 + w * 16) * 32), 16, 0, 0);
}
__device__ __forceinline__ void gemm_compute(const bf16_t* stage, int wx, int wy, int fr, int fg, f32x4 (&acc)[4][4]) {
    const int co = (fg ^ gswz(fr)) * 8;
    bf16x8 xa[4], yb[4];
#pragma unroll
    for (int m = 0; m < 4; ++m) xa[m] = *(const bf16x8*)(stage + (wx * 64 + m * 16 + fr) * 32 + co);
#pragma unroll
    for (int n = 0; n < 4; ++n) yb[n] = *(const bf16x8*)(stage + 4096 + (wy * 64 + n * 16 + fr) * 32 + co);
    __builtin_amdgcn_s_setprio(1);
#pragma unroll
    for (int m = 0; m < 4; ++m)
#pragma unroll
        for (int n = 0; n < 4; ++n) acc[m][n] = __builtin_amdgcn_mfma_f32_16x16x32_bf16(xa[m], yb[n], acc[m][n], 0, 0, 0);
    __builtin_amdgcn_s_setprio(0);
}
template <class FX, class FY>
__device__ __forceinline__ void gemm_core(FX rowx, FY rowy, int K, bf16_t* lds, f32x4 (&acc)[4][4], int gvar = 0) {
    const int tid = ltid(), lane = tid & 63, w = __builtin_amdgcn_readfirstlane(tid >> 6), wx = w >> 1, wy = w & 1, fr = lane & 15, fg = lane >> 4;
#pragma unroll
    for (int a = 0; a < 4; ++a)
#pragma unroll
        for (int b = 0; b < 4; ++b) acc[a][b] = (f32x4){0.f, 0.f, 0.f, 0.f};
    const bf16_t* px[2]; const bf16_t* py[2];
    {
        const int r0 = w * 16 + (lane >> 2), pc = lane & 3;
        const int lc0 = (pc ^ gswz(r0)) * 8;
        px[0] = rowx(r0) + lc0; px[1] = rowx(r0 + 64) + lc0;
        py[0] = rowy(r0) + lc0; py[1] = rowy(r0 + 64) + lc0;
    }
    const int nt = K >> 5;
    RAW_BARRIER();
    if (gvar != 3) {
    gemm_issue(px, py, 0, lds, w);
    gemm_issue(px, py, 32, lds + GSTAGE, w);
    gemm_issue(px, py, 64, lds + 2 * GSTAGE, w);
    }
    for (int j = 0; j < nt; ++j) {
        if (j + 2 < nt) asm volatile("s_waitcnt vmcnt(8)" ::: "memory");
        else if (j + 1 < nt) asm volatile("s_waitcnt vmcnt(4)" ::: "memory");
        else asm volatile("s_waitcnt vmcnt(0)" ::: "memory");
        RAW_BARRIER();
        if (j + 3 < nt && gvar != 3) gemm_issue(px, py, (j + 3) * 32, lds + ((j + 3) & 3) * GSTAGE, w);
        if (gvar != 2) gemm_compute(lds + (j & 3) * GSTAGE, wx, wy, fr, fg, acc);
    }
}
__device__ __forceinline__ void gemm_compute8(const bf16_t* stage, int wx, int wy, int lane, f32x16 (&acc)[2][2]) {
    const int r = lane & 31, h = lane >> 5, g = gswz(r);
    const int c0 = ((2 * h) ^ g) * 8, c1 = ((2 * h + 1) ^ g) * 8;
    i32x8 xa[2], yb[2];
#pragma unroll
    for (int m = 0; m < 2; ++m) {
        const bf16_t* rp = stage + (wx * 64 + m * 32 + r) * 32;
        const u32x4 lo = *(const u32x4*)(rp + c0), hi = *(const u32x4*)(rp + c1);
        xa[m] = (i32x8){(int)lo[0], (int)lo[1], (int)lo[2], (int)lo[3], (int)hi[0], (int)hi[1], (int)hi[2], (int)hi[3]};
    }
#pragma unroll
    for (int n = 0; n < 2; ++n) {
        const bf16_t* rp = stage + 4096 + (wy * 64 + n * 32 + r) * 32;
        const u32x4 lo = *(const u32x4*)(rp + c0), hi = *(const u32x4*)(rp + c1);
        yb[n] = (i32x8){(int)lo[0], (int)lo[1], (int)lo[2], (int)lo[3], (int)hi[0], (int)hi[1], (int)hi[2], (int)hi[3]};
    }
    __builtin_amdgcn_s_setprio(1);
#pragma unroll
    for (int m = 0; m < 2; ++m)
#pragma unroll
        for (int n = 0; n < 2; ++n) acc[m][n] = __builtin_amdgcn_mfma_scale_f32_32x32x64_f8f6f4(xa[m], yb[n], acc[m][n], 0, 0, 0, 0, 0, 0);
    __builtin_amdgcn_s_setprio(0);
}
template <class FX, class FY>
__device__ __forceinline__ void gemm_core8(FX rowx, FY rowy, int K2, bf16_t* lds, f32x16 (&acc)[2][2]) {
    const int tid = ltid(), lane = tid & 63, w = __builtin_amdgcn_readfirstlane(tid >> 6), wx = w >> 1, wy = w & 1;
#pragma unroll
    for (int a = 0; a < 2; ++a)
#pragma unroll
        for (int b = 0; b < 2; ++b)
#pragma unroll
            for (int i = 0; i < 16; ++i) acc[a][b][i] = 0.f;
    const bf16_t* px[2]; const bf16_t* py[2];
    {
        const int r0 = w * 16 + (lane >> 2), pc = lane & 3;
        const int lc0 = (pc ^ gswz(r0)) * 8;
        px[0] = rowx(r0) + lc0; px[1] = rowx(r0 + 64) + lc0;
        py[0] = rowy(r0) + lc0; py[1] = rowy(r0 + 64) + lc0;
    }
    const int nt = K2 >> 5;
    RAW_BARRIER();
    gemm_issue(px, py, 0, lds, w);
    gemm_issue(px, py, 32, lds + GSTAGE, w);
    gemm_issue(px, py, 64, lds + 2 * GSTAGE, w);
    for (int j = 0; j < nt; ++j) {
        if (j + 2 < nt) asm volatile("s_waitcnt vmcnt(8)" ::: "memory");
        else if (j + 1 < nt) asm volatile("s_waitcnt vmcnt(4)" ::: "memory");
        else asm volatile("s_waitcnt vmcnt(0)" ::: "memory");
        RAW_BARRIER();
        if (j + 3 < nt) gemm_issue(px, py, (j + 3) * 32, lds + ((j + 3) & 3) * GSTAGE, w);
        gemm_compute8(lds + (j & 3) * GSTAGE, wx, wy, lane, acc);
    }
}
__device__ __forceinline__ void store4_bf16(bf16_t* p, float a, float b, float c, float d) {
    uint2 o; o.x = pk_bf16(a, b); o.y = pk_bf16(c, d); *(uint2*)p = o;
}
template <int NC> __device__ __forceinline__ void ep_put(bf16_t* T, int row, int col, float a, float b, float c, float d) {
    uint2 o; o.x = pk_bf16(a, b); o.y = pk_bf16(c, d); *(uint2*)(T + row * (NC + 8) + col) = o;
}
template <int NC, class FD> __device__ __forceinline__ void ep_flush(const bf16_t* T, int tid, FD dst) {
    constexpr int CPR = NC / 8;
#pragma unroll
    for (int i = 0; i < NC / 16; ++i) {
        const int c = tid + 256 * i; const int row = c / CPR, ch = c % CPR;
        *(u32x4*)(dst(row, ch)) = *(const u32x4*)(T + row * (NC + 8) + ch * 8);
    }
}

__device__ __forceinline__ bool xcd_item(int round, int ntm, int ntn, int& tm, int& tn) {
    const int x = blockIdx.x & 7, loc = blockIdx.x >> 3, nloc = gridDim.x >> 3;
    const int tmx = ntm >> 3;
    const int j = round * nloc + loc;
    if (j >= tmx * ntn) return false;
    tn = j / tmx; tm = (j % tmx) * 8 + x;
    return true;
}

__device__ void phase_inproj(const Params& p, int l, bf16_t* lds, int gvar = 0) {
    const int tid = ltid(), lane = tid & 63, w = tid >> 6, wx = w >> 1, wy = w & 1, fr = lane & 15, fg = lane >> 4;
    const bf16_t* hn = (const bf16_t*)(p.ws + WS_HN);
    const bf16_t* wt = (const bf16_t*)(p.ws + WS_WIN) + (size_t)l * NINP * 1024;
    bf16_t* proj = (bf16_t*)(p.ws + WS_PROJ);
    bf16_t* vtf = (bf16_t*)(p.ws + WS_VTF);
    float* aux = (float*)(p.ws + WS_AUX);
    const float* qg = p.in[3] + l * 64; const float* kg = p.in[4] + l * 64;
    for (int round = 0;; ++round) {
        int tm, tn;
        if (gridDim.x == 512) {
            if (round >= 7) break;
            const int x = blockIdx.x & 7, loc = blockIdx.x >> 3; int tml;
            if (round < 6) { tn = (round >> 1) * 8 + (loc & 7); tml = (round & 1) * 8 + (loc >> 3); }
            else { tn = 24 + (loc & 3); tml = loc >> 2; }
            tm = tml * 8 + x;
        } else if (!xcd_item(round, NTOK / 128, NINP / 128, tm, tn)) break;
        const bool vt = (tn >= 6 && tn < 9) || tn == 23 || tn == 24;
        f32x4 acc[4][4];
        {
            auto rw = [&](int r) { return wt + pl_off(tn * 128 + r, 0, 1024); };
            auto rt_ = [&](int r) { return hn + pl_off(tm * 128 + r, 0, 1024); };
            if (vt) gemm_core(rt_, rw, 1024, lds, acc, gvar); else gemm_core(rw, rt_, 1024, lds, acc, gvar);
        }
        if (gvar != 0 && acc[0][0][0] != 123456.789f) continue;
        if (tn == 27) {
#pragma unroll
            for (int n = 0; n < 4; ++n) {
                int t = tm * 128 + wy * 64 + n * 16 + fr;
#pragma unroll
                for (int m = 0; m < 4; ++m) {
                    int c = wx * 64 + m * 16 + 4 * fg;
                    if (c < 64) *(float4*)(aux + (size_t)t * 64 + c) = make_float4(acc[m][n][0], acc[m][n][1], acc[m][n][2], acc[m][n][3]);
                }
            }
            continue;
        }
        RAW_BARRIER();
        if (vt) {
#pragma unroll
            for (int n = 0; n < 4; ++n)
#pragma unroll
                for (int m = 0; m < 4; ++m) ep_put<128>(lds, wy * 64 + n * 16 + fr, wx * 64 + m * 16 + 4 * fg, acc[m][n][0], acc[m][n][1], acc[m][n][2], acc[m][n][3]);
            RAW_BARRIER();
            const bool fox = tn < 9;
            bf16_t* dstb = fox ? vtf : (bf16_t*)(p.ws + WS_SCR + SCR_LVT); const int nh = fox ? H_FOX : H_GLA;
            const int t0 = tm * 128, b = t0 / SEQ, s0 = t0 % SEQ, chb = tn * 128 - (fox ? NC_FV : NC_LV);
            ep_flush<128>(lds, tid, [&](int row, int c8) { const int ch = chb + row; return dstb + ((size_t)(b * nh + (ch >> 6)) * 64 + (ch & 63)) * SEQ + s0 + c8 * 8; });
        } else {
            if (tn < 6) {
                const float* gn = (tn < 3) ? qg : kg; const float sc = (tn < 3) ? 0.125f * 1.4426950408889634f : 1.f;
                float g[4][4];
#pragma unroll
                for (int m = 0; m < 4; ++m)
#pragma unroll
                    for (int r = 0; r < 4; ++r) g[m][r] = gn[m * 16 + 4 * fg + r] * sc;
#pragma unroll
                for (int n = 0; n < 4; ++n) {
                    float ss = 0.f;
#pragma unroll
                    for (int m = 0; m < 4; ++m)
#pragma unroll
                        for (int r = 0; r < 4; ++r) ss += acc[m][n][r] * acc[m][n][r];
                    ss += __shfl_xor(ss, 16, 64); ss += __shfl_xor(ss, 32, 64);
                    float rs = rsqrtf(ss * (1.f / 64.f) + 1e-6f);
#pragma unroll
                    for (int m = 0; m < 4; ++m)
                        ep_put<128>(lds, wy * 64 + n * 16 + fr, wx * 64 + m * 16 + 4 * fg, acc[m][n][0] * rs * g[m][0], acc[m][n][1] * rs * g[m][1], acc[m][n][2] * rs * g[m][2], acc[m][n][3] * rs * g[m][3]);
                }
            } else {
                const bool do_silu = (tn >= 18 && tn < 21) || (tn >= 25);
                const float sc = (tn == 21) ? 0.17677669529663687f : 1.f;
#pragma unroll
                for (int n = 0; n < 4; ++n)
#pragma unroll
                    for (int m = 0; m < 4; ++m) {
                        float v0 = acc[m][n][0] * sc, v1 = acc[m][n][1] * sc, v2 = acc[m][n][2] * sc, v3 = acc[m][n][3] * sc;
                        if (do_silu) { v0 = siluf_(v0); v1 = siluf_(v1); v2 = siluf_(v2); v3 = siluf_(v3); }
                        ep_put<128>(lds, wy * 64 + n * 16 + fr, wx * 64 + m * 16 + 4 * fg, v0, v1, v2, v3);
                    }
            }
            RAW_BARRIER();
            bf16_t* dstb = proj + (size_t)(tm * 128) * NPROJ + tn * 128;
            ep_flush<128>(lds, tid, [&](int row, int c8) { return dstb + (size_t)row * NPROJ + c8 * 8; });
        }
    }
}

__device__ void phase_outproj(const Params& p, int l, bf16_t* lds) {
    const int tid = ltid(), lane = tid & 63, w = tid >> 6, wx = w >> 1, wy = w & 1, fr = lane & 15, fg = lane >> 4;
    const bf16_t* mix = (const bf16_t*)(p.ws + WS_MIX);
    const bf16_t* wt = (const bf16_t*)(p.ws + WS_WOUT) + (size_t)l * 1024 * 512;
    const float* xin = (l == 0) ? p.in[0] : p.out;
    bf16_t* xb = (bf16_t*)(p.ws + WS_SCR + SCR_XB);
    for (int round = 0;; ++round) {
        int tm, tn;
        if (gridDim.x == 512) {
            if (round >= 2) break;
            const int x = blockIdx.x & 7, loc = blockIdx.x >> 3;
            tn = loc & 7; tm = (round * 8 + (loc >> 3)) * 8 + x;
        } else if (!xcd_item(round, NTOK / 128, 8, tm, tn)) break;
        f32x16 acc[2][2];
        {
            auto rw = [&](int r) { return wt + pl_off(tn * 128 + r, 0, 512); };
            auto rt_ = [&](int r) { return mix + pl_off(tm * 128 + r, 0, 512); };
            gemm_core8(rw, rt_, 512, lds, acc);
        }
        constexpr float dq = 1.f / (F8_WSCALE * F8_ASCALE);
#pragma unroll
        for (int n = 0; n < 2; ++n) {
            int t = tm * 128 + wy * 64 + n * 32 + (lane & 31);
#pragma unroll
            for (int m = 0; m < 2; ++m)
#pragma unroll
                for (int g = 0; g < 4; ++g) {
                    int c = tn * 128 + wx * 64 + m * 32 + 8 * g + 4 * (lane >> 5);
                    float4 xv;
                    if (l == 0) xv = *(const float4*)(xin + (size_t)t * 1024 + c);
                    else { const u32x2 u = *(const u32x2*)((const bf16_t*)p.out + (size_t)t * 1024 + c); xv = make_float4(bflo(u[0]), bfhi(u[0]), bflo(u[1]), bfhi(u[1])); }
                    store4_bf16(xb + (size_t)t * 1024 + c, xv.x + acc[m][n][4 * g] * dq, xv.y + acc[m][n][4 * g + 1] * dq, xv.z + acc[m][n][4 * g + 2] * dq, xv.w + acc[m][n][4 * g + 3] * dq);
                }
        }
    }
}

__device__ void phase_route(const Params& p, int l, bf16_t* lds, int dry = 0) {
    const int tid = ltid(), lane = tid & 63, w = tid >> 6, fr = lane & 15, fg = lane >> 4;
    const bf16_t* x1 = (const bf16_t*)(p.ws + WS_SCR + SCR_XB);
    const float* gain = p.in[15] + l * 1024;
    bf16_t* hn = dry ? (bf16_t*)(p.ws + WS_SCR) : (bf16_t*)(p.ws + WS_HN);
    const bf16_t* wr = (const bf16_t*)(p.ws + WS_WR) + (size_t)l * 64 * 1024;
    const float* brg = p.in[17] + l * 4; const float* bre = p.in[19] + l * 32;
    unsigned* cnt = (unsigned*)(p.ws + WS_CTL) + CW_CNT + l * 32 * NSH * CNT_STRIDE;
    int* rowtok = (int*)(p.ws + WS_ROWTOK);
    int* tslot = (int*)(p.ws + WS_TSLOT);
    float* tgate = (float*)(p.ws + WS_TGATE);
    const int HL = 1032;
    float* red = (float*)(lds + 16 * HL);
    bf16x8 wrf[8][2];
#pragma unroll
    for (int ks = 0; ks < 8; ++ks)
#pragma unroll
        for (int n = 0; n < 2; ++n) wrf[ks][n] = *(const bf16x8*)(wr + (size_t)(n * 16 + fr) * 1024 + w * 256 + ks * 32 + fg * 8);
    for (int it = blockIdx.x; it < NTOK / 16; it += gridDim.x) {
        __syncthreads();
        u32x4 xin4[4][2];
#pragma unroll
        for (int rr = 0; rr < 4; ++rr) {
            const bf16_t* xr = x1 + (size_t)(it * 16 + w * 4 + rr) * 1024 + lane * 16;
            xin4[rr][0] = *(const u32x4*)xr; xin4[rr][1] = *(const u32x4*)(xr + 8);
        }
#pragma unroll
        for (int rr = 0; rr < 4; ++rr) {
            int lr = w * 4 + rr; int t = it * 16 + lr;
            float v[16]; float ss = 0.f;
#pragma unroll
            for (int i = 0; i < 4; ++i) { v[4 * i] = bflo(xin4[rr][i >> 1][(2 * i) & 3]); v[4 * i + 1] = bfhi(xin4[rr][i >> 1][(2 * i) & 3]); v[4 * i + 2] = bflo(xin4[rr][i >> 1][(2 * i + 1) & 3]); v[4 * i + 3] = bfhi(xin4[rr][i >> 1][(2 * i + 1) & 3]); }
#pragma unroll
            for (int i = 0; i < 16; ++i) ss += v[i] * v[i];
            ss = wave_sum(ss);
            float r = rsqrtf(ss / D_MODEL + 1e-6f);
#pragma unroll
            for (int i = 0; i < 16; ++i) v[i] = v[i] * r * gain[lane * 16 + i];
            uint4 o0, o1;
            o0.x = pk_bf16(v[0], v[1]); o0.y = pk_bf16(v[2], v[3]); o0.z = pk_bf16(v[4], v[5]); o0.w = pk_bf16(v[6], v[7]);
            o1.x = pk_bf16(v[8], v[9]); o1.y = pk_bf16(v[10], v[11]); o1.z = pk_bf16(v[12], v[13]); o1.w = pk_bf16(v[14], v[15]);
            *(uint4*)(lds + lr * HL + lane * 16) = o0; *(uint4*)(lds + lr * HL + lane * 16 + 8) = o1;
            u32x4 q8;
#pragma unroll
            for (int c = 0; c < 4; ++c) q8[c] = pk_fp8x4(f8clamp(v[4 * c] * F8_ASCALE), f8clamp(v[4 * c + 1] * F8_ASCALE), f8clamp(v[4 * c + 2] * F8_ASCALE), f8clamp(v[4 * c + 3] * F8_ASCALE));
            *(u32x4*)(hn + pl_off(t, lane * 8, 512)) = q8;
        }
        __syncthreads();
        f32x4 acc[3];
#pragma unroll
        for (int n = 0; n < 3; ++n) acc[n] = (f32x4){0.f, 0.f, 0.f, 0.f};
#pragma unroll
        for (int ks = 0; ks < 8; ++ks) {
            int k = w * 256 + ks * 32 + fg * 8;
            bf16x8 a = *(const bf16x8*)(lds + fr * HL + k);
#pragma unroll
            for (int n = 0; n < 2; ++n) acc[n] = __builtin_amdgcn_mfma_f32_16x16x32_bf16(a, wrf[ks][n], acc[n], 0, 0, 0);
            acc[2] = __builtin_amdgcn_mfma_f32_16x16x32_bf16(a, *(const bf16x8*)(wr + (size_t)(32 + fr) * 1024 + k), acc[2], 0, 0, 0);
        }
#pragma unroll
        for (int n = 0; n < 3; ++n) *(f32x4*)(red + ((w * 3 + n) * 64 + lane) * 4) = acc[n];
        __syncthreads();
        if (tid < 16) {
            float lg[36];
#pragma unroll
            for (int j = 0; j < 36; ++j) {
                int n = j >> 4, f = j & 15; int ln = (tid >> 2) * 16 + f; float s = 0.f;
#pragma unroll
                for (int ww = 0; ww < 4; ++ww) s += red[((ww * 3 + n) * 64 + ln) * 4 + (tid & 3)];
                lg[j] = s;
            }
            float gl[4]; float gm = -1e30f; int gi = 0;
#pragma unroll
            for (int j = 0; j < 4; ++j) { gl[j] = lg[j] + brg[j]; if (gl[j] > gm) { gm = gl[j]; gi = j; } }
            float gs = 0.f;
#pragma unroll
            for (int j = 0; j < 4; ++j) gs += __expf(gl[j] - gm);
            float gp = 1.f / gs;
            float el[8]; float em = -1e30f;
#pragma unroll
            for (int j = 0; j < 8; ++j) {
                float v = (gi == 0) ? lg[4 + j] : (gi == 1) ? lg[12 + j] : (gi == 2) ? lg[20 + j] : lg[28 + j];
                el[j] = v + bre[gi * 8 + j]; em = fmaxf(em, el[j]);
            }
#pragma unroll
            for (int j = 0; j < 8; ++j) el[j] = __expf(el[j] - em);
            float v0 = -1.f, v1 = -1.f; int i0 = 0, i1 = 0;
#pragma unroll
            for (int j = 0; j < 8; ++j) {
                float v = el[j];
                if (v > v0) { v1 = v0; i1 = i0; v0 = v; i0 = j; }
                else if (v > v1) { v1 = v; i1 = j; }
            }
            int t = it * 16 + tid;
            int e0 = gi * 8 + i0, e1 = gi * 8 + i1;
            if (!dry) {
            const int sh = blockIdx.x & (NSH - 1);
            unsigned s0 = atomicAdd(&cnt[(e0 * NSH + sh) * CNT_STRIDE], 1u), s1 = atomicAdd(&cnt[(e1 * NSH + sh) * CNT_STRIDE], 1u);
            rowtok[(size_t)(e0 * NSH + sh) * SHCAP + s0] = t; rowtok[(size_t)(e1 * NSH + sh) * SHCAP + s1] = t;
            tslot[t * 2] = (e0 << 16) | (sh << 11) | (int)s0; tslot[t * 2 + 1] = (e1 << 16) | (sh << 11) | (int)s1;
            tgate[t * 2] = gp * v0 / (v0 + v1); tgate[t * 2 + 1] = gp * v1 / (v0 + v1);
            } else if (gp * v0 == 123.456f) tgate[0] = v1;
        }
    }
}

__device__ __forceinline__ void moe_tables(const unsigned* cnt, int* tab) {
    const int t = threadIdx.x;
    int* sc = tab + 80 + 32 * 9;
    sc[t] = (int)ld_u32_agent(cnt + t * CNT_STRIDE);
    __syncthreads();
    if (t < 32) { int a = 0; for (int s = 0; s < NSH; ++s) { tab[80 + t * 9 + s] = a; a += sc[t * NSH + s]; } tab[80 + t * 9 + 8] = a; }
    __syncthreads();
    if (t == 0) {
        int a = 0;
        for (int e = 0; e < 32; ++e) { tab[e] = a; tab[40 + e] = a * 128; a += (tab[80 + e * 9 + 8] + 127) >> 7; }
        tab[32] = a; tab[72] = a * 128;
    }
    __syncthreads();
}
template <int MODE>
__device__ void phase_expert(const Params& p, int l, bf16_t* lds) {
    const int tid = ltid(), lane = tid & 63, w = tid >> 6, wx = w >> 1, wy = w & 1, fr = lane & 15, fg = lane >> 4;
    const unsigned* cnt = (const unsigned*)(p.ws + WS_CTL) + CW_CNT + l * 32 * NSH * CNT_STRIDE;
    int* tab = (int*)(lds + 4 * GSTAGE);
    moe_tables(cnt, tab);
    if (MODE == 0 && blockIdx.x == 0) {
        unsigned* mt = (unsigned*)(p.ws + WS_CTL) + CW_MOETAB + l * 32 * NSH;
        mt[threadIdx.x] = (unsigned)(tab[40 + (threadIdx.x >> 3)] + tab[80 + (threadIdx.x >> 3) * 9 + (threadIdx.x & 7)]);
    }
    const int* rowtok = (const int*)(p.ws + WS_ROWTOK);
    const bf16_t* hn = (const bf16_t*)(p.ws + WS_HN);
    bf16_t* Hb = (bf16_t*)(p.ws + WS_H);
    bf16_t* Yb = (bf16_t*)(p.ws + WS_Y);
    const int x = blockIdx.x & 7, loc = blockIdx.x >> 3, nloc = gridDim.x >> 3;
    auto decode = [&](int j, int& e, int& rt, int& tn) {
        e = -1; rt = 0; tn = 0; int jj = j;
#pragma unroll
        for (int q = 0; q < 4; ++q) {
            int ee = q * 8 + x; int nrt = tab[ee + 1] - tab[ee];
            if (e < 0) { if (jj < nrt * 8) { e = ee; tn = jj / nrt; rt = jj % nrt; } else jj -= nrt * 8; }
        }
        return e >= 0;
    };
    if (MODE == 1) {
        constexpr int NT = 8;
        const int r0 = w * 16 + (lane >> 2), lc0 = ((lane & 3) ^ gswz(r0)) * 8;
        auto setup = [&](int e, int rt, int tn, const bf16_t* (&px)[2], const bf16_t* (&py)[2]) {
            const bf16_t* wbase = (const bf16_t*)(p.ws + WS_WD) + ((size_t)l * 32 + e) * 1024 * 256;
            const int hrow0 = tab[40 + e] + rt * 128;
            px[0] = wbase + pl_off(tn * 128 + r0, 0, 256) + lc0; px[1] = wbase + pl_off(tn * 128 + r0 + 64, 0, 256) + lc0;
            py[0] = Hb + pl_off(hrow0 + r0, 0, 256) + lc0; py[1] = Hb + pl_off(hrow0 + r0 + 64, 0, 256) + lc0;
        };
        int e, rt, tn;
        if (!decode(loc, e, rt, tn)) return;
        const bf16_t* px[2]; const bf16_t* py[2];
        setup(e, rt, tn, px, py);
        RAW_BARRIER();
        gemm_issue(px, py, 0, lds, w); gemm_issue(px, py, 32, lds + GSTAGE, w); gemm_issue(px, py, 64, lds + 2 * GSTAGE, w);
        unsigned char* Y8 = (unsigned char*)(p.ws + WS_Y);
        const int lr = lane & 31, lh = lane >> 5;
        for (int j = loc;; j += nloc) {
            int en, rtn, tnn;
            const bool more = decode(j + nloc, en, rtn, tnn);
            const bf16_t* pxn[2]; const bf16_t* pyn[2];
            setup(more ? en : e, rtn, tnn, pxn, pyn);
            f32x16 acc[2][2];
#pragma unroll
            for (int a = 0; a < 2; ++a)
#pragma unroll
                for (int b = 0; b < 2; ++b)
#pragma unroll
                    for (int q = 0; q < 16; ++q) acc[a][b][q] = 0.f;
#pragma unroll
            for (int s = 0; s < NT; ++s) {
                if (more || s + 2 < NT) asm volatile("s_waitcnt vmcnt(8)" ::: "memory");
                else if (s + 1 < NT) asm volatile("s_waitcnt vmcnt(4)" ::: "memory");
                else asm volatile("s_waitcnt vmcnt(0)" ::: "memory");
                RAW_BARRIER();
                if (s + 3 < NT) gemm_issue(px, py, (s + 3) * 32, lds + ((s + 3) & 3) * GSTAGE, w);
                else if (more) gemm_issue(pxn, pyn, (s + 3 - NT) * 32, lds + ((s + 3) & 3) * GSTAGE, w);
                gemm_compute8(lds + (s & 3) * GSTAGE, wx, wy, lane, acc);
            }
            RAW_BARRIER();
            unsigned char* T8 = (unsigned char*)(lds + 3 * GSTAGE);
            constexpr float dq = F8_YSCALE / (F8_WSCALE * F8_ASCALE);
#pragma unroll
            for (int n = 0; n < 2; ++n)
#pragma unroll
                for (int m = 0; m < 2; ++m)
#pragma unroll
                    for (int g = 0; g < 4; ++g) {
                        const int row = wy * 64 + n * 32 + lr, col = wx * 64 + m * 32 + 8 * g + 4 * lh;
                        *(unsigned*)(T8 + row * 128 + (((col >> 4) ^ (row & 7)) << 4) + (col & 15)) =
                            pk_fp8x4(f8clamp(acc[m][n][4 * g] * dq), f8clamp(acc[m][n][4 * g + 1] * dq), f8clamp(acc[m][n][4 * g + 2] * dq), f8clamp(acc[m][n][4 * g + 3] * dq));
                    }
            RAW_BARRIER();
            {
                const int hrow0 = tab[40 + e] + rt * 128;
#pragma unroll
                for (int i = 0; i < 4; ++i) {
                    const int c = tid + 256 * i; const int row = c >> 3, ch = c & 7;
                    *(u32x4*)(Y8 + (size_t)(hrow0 + row) * 1024 + tn * 128 + ch * 16) = *(const u32x4*)(T8 + row * 128 + ((ch ^ (row & 7)) << 4));
                }
            }
            if (!more) break;
            e = en; rt = rtn; tn = tnn; px[0] = pxn[0]; px[1] = pxn[1]; py[0] = pyn[0]; py[1] = pyn[1];
        }
        return;
    }
    for (int j = loc;; j += nloc) {
        int e = -1, rt = 0, tn = 0; int jj = j;
#pragma unroll
        for (int q = 0; q < 4; ++q) {
            int ee = q * 8 + x; int nrt = tab[ee + 1] - tab[ee];
            if (e < 0) { if (jj < nrt * 8) { e = ee; tn = jj / nrt; rt = jj % nrt; } else jj -= nrt * 8; }
        }
        if (e < 0) break;
        const int hrow0 = tab[40 + e] + rt * 128;
        f32x16 acc[2][2];
        const int lr = lane & 31, lh = lane >> 5;
        if (MODE == 0) {
            const bf16_t* wbase = (const bf16_t*)(p.ws + WS_WGU) + ((size_t)l * 32 + e) * 1024 * 512;
            const int* spx = tab + 80 + e * 9;
            auto rw = [&](int r) { return wbase + pl_off(tn * 128 + r, 0, 512); };
            auto rt_ = [&](int r) {
                const int s = rt * 128 + r; int t = 0;
                if (s < spx[8]) {
                    int xs = 0;
#pragma unroll
                    for (int q = 1; q < NSH; ++q) xs += (s >= spx[q]) ? 1 : 0;
                    t = rowtok[(size_t)(e * NSH + xs) * SHCAP + (s - spx[xs])];
                }
                return hn + pl_off(t, 0, 512); };
            gemm_core8(rw, rt_, 512, lds, acc);
        } else {
            const bf16_t* wbase = (const bf16_t*)(p.ws + WS_WD) + ((size_t)l * 32 + e) * 1024 * 256;
            auto rw = [&](int r) { return wbase + pl_off(tn * 128 + r, 0, 256); };
            auto rt_ = [&](int r) { return Hb + pl_off(hrow0 + r, 0, 256); };
            gemm_core8(rw, rt_, 256, lds, acc);
        }
        RAW_BARRIER();
        if (MODE == 0) {
            unsigned char* T8 = (unsigned char*)lds;
            constexpr float dq = 1.f / (F8_WSCALE * F8_ASCALE);
#pragma unroll
            for (int n = 0; n < 2; ++n)
#pragma unroll
                for (int g = 0; g < 4; ++g) {
                    float hv[4];
#pragma unroll
                    for (int r = 0; r < 4; ++r) hv[r] = f8clamp(siluf_(acc[0][n][4 * g + r] * dq) * (acc[1][n][4 * g + r] * dq) * F8_ASCALE);
                    *(unsigned*)(T8 + (wy * 64 + n * 32 + lr) * 80 + wx * 32 + 8 * g + 4 * lh) = pk_fp8x4(hv[0], hv[1], hv[2], hv[3]);
                }
            RAW_BARRIER();
#pragma unroll
            for (int i = 0; i < 2; ++i) {
                const int c = tid + 256 * i; const int row = c >> 2, ch = c & 3;
                *(u32x4*)(Hb + pl_off(hrow0 + row, tn * 32 + ch * 8, 256)) = *(const u32x4*)(T8 + row * 80 + ch * 16);
            }
        } else {
            constexpr float dq = 1.f / (F8_WSCALE * F8_ASCALE);
#pragma unroll
            for (int n = 0; n < 2; ++n)
#pragma unroll
                for (int m = 0; m < 2; ++m)
#pragma unroll
                    for (int g = 0; g < 4; ++g)
                        ep_put<128>(lds, wy * 64 + n * 32 + lr, wx * 64 + m * 32 + 8 * g + 4 * lh, acc[m][n][4 * g] * dq, acc[m][n][4 * g + 1] * dq, acc[m][n][4 * g + 2] * dq, acc[m][n][4 * g + 3] * dq);
            RAW_BARRIER();
            bf16_t* dstb = Yb + (size_t)hrow0 * 1024 + tn * 128;
            ep_flush<128>(lds, tid, [&](int row, int c8) { return dstb + (size_t)row * 1024 + c8 * 8; });
        }
    }
}

__device__ void phase_combine(const Params& p, int l, int dry = 0) {
    const int tid = ltid(), lane = tid & 63, w = tid >> 6;
    const unsigned* mt = (const unsigned*)(p.ws + WS_CTL) + CW_MOETAB + l * 32 * NSH;
    const int* tslot = (const int*)(p.ws + WS_TSLOT);
    const float* tgate = (const float*)(p.ws + WS_TGATE);
    const bf16_t* Yb = (const bf16_t*)(p.ws + WS_Y);
    bf16_t* hn = dry ? (bf16_t*)(p.ws + WS_SCR + (size_t)40 * 1024 * 1024) : (bf16_t*)(p.ws + WS_HN);
    float* xw = dry ? (float*)(p.ws + WS_SCR + (size_t)48 * 1024 * 1024) : p.out;
    const float* gain = (l == 0 || dry) ? p.in[1] + 1024 : nullptr;
    for (int it = blockIdx.x; it < NTOK / 4; it += gridDim.x) {
        int t = it * 4 + w;
        int ts0 = tslot[t * 2], ts1 = tslot[t * 2 + 1];
        float g0 = tgate[t * 2], g1 = tgate[t * 2 + 1];
        int r0 = (int)mt[((ts0 >> 16) << 3) | ((ts0 >> 11) & 7)] + (ts0 & 0x7ff);
        int r1 = (int)mt[((ts1 >> 16) << 3) | ((ts1 >> 11) & 7)] + (ts1 & 0x7ff);
        const bf16_t* xr = (const bf16_t*)(p.ws + WS_SCR + SCR_XB) + (size_t)t * 1024 + lane * 16;
        const unsigned char* y0 = (const unsigned char*)Yb + (size_t)r0 * 1024 + lane * 16;
        const unsigned char* y1 = (const unsigned char*)Yb + (size_t)r1 * 1024 + lane * 16;
        float v[16];
#pragma unroll
        for (int i = 0; i < 2; ++i) { u32x4 q = *(const u32x4*)(xr + 8 * i);
#pragma unroll
            for (int k = 0; k < 4; ++k) { v[8 * i + 2 * k] = bflo(q[k]); v[8 * i + 2 * k + 1] = bfhi(q[k]); } }
        const u32x4 ya = *(const u32x4*)y0, yb = *(const u32x4*)y1;
        const float g0s = g0 * (1.f / F8_YSCALE), g1s = g1 * (1.f / F8_YSCALE);
#pragma unroll
        for (int i = 0; i < 4; ++i) {
            v[4 * i]     += g0s * __builtin_amdgcn_cvt_f32_fp8((int)ya[i], 0) + g1s * __builtin_amdgcn_cvt_f32_fp8((int)yb[i], 0);
            v[4 * i + 1] += g0s * __builtin_amdgcn_cvt_f32_fp8((int)ya[i], 1) + g1s * __builtin_amdgcn_cvt_f32_fp8((int)yb[i], 1);
            v[4 * i + 2] += g0s * __builtin_amdgcn_cvt_f32_fp8((int)ya[i], 2) + g1s * __builtin_amdgcn_cvt_f32_fp8((int)yb[i], 2);
            v[4 * i + 3] += g0s * __builtin_amdgcn_cvt_f32_fp8((int)ya[i], 3) + g1s * __builtin_amdgcn_cvt_f32_fp8((int)yb[i], 3);
        }
#ifdef NANMARK
#pragma unroll
        for (int i = 0; i < 16; ++i) if (!(fabsf(v[i]) < 1e30f)) v[i] = 1000.f;
#endif
        if (l == 0 && !dry) {
            uint4 o0, o1;
            o0.x = pk_bf16(v[0], v[1]); o0.y = pk_bf16(v[2], v[3]); o0.z = pk_bf16(v[4], v[5]); o0.w = pk_bf16(v[6], v[7]);
            o1.x = pk_bf16(v[8], v[9]); o1.y = pk_bf16(v[10], v[11]); o1.z = pk_bf16(v[12], v[13]); o1.w = pk_bf16(v[14], v[15]);
            bf16_t* xo2 = (bf16_t*)p.out + (size_t)t * 1024 + lane * 16;
            *(uint4*)xo2 = o0; *(uint4*)(xo2 + 8) = o1;
        } else {
#pragma unroll
            for (int i = 0; i < 4; ++i) *(float4*)(xw + (size_t)t * 1024 + lane * 16 + 4 * i) = make_float4(v[4 * i], v[4 * i + 1], v[4 * i + 2], v[4 * i + 3]);
        }
        if (gain) {
            float ss = 0.f;
#pragma unroll
            for (int i = 0; i < 16; ++i) ss += v[i] * v[i];
            ss = wave_sum(ss);
            float r = rsqrtf(ss / D_MODEL + 1e-6f);
#pragma unroll
            for (int i = 0; i < 16; ++i) v[i] = v[i] * r * gain[lane * 16 + i];
            uint4 o0, o1;
            o0.x = pk_bf16(v[0], v[1]); o0.y = pk_bf16(v[2], v[3]); o0.z = pk_bf16(v[4], v[5]); o0.w = pk_bf16(v[6], v[7]);
            o1.x = pk_bf16(v[8], v[9]); o1.y = pk_bf16(v[10], v[11]); o1.z = pk_bf16(v[12], v[13]); o1.w = pk_bf16(v[14], v[15]);
            bf16_t* hr = hn + pl_off(t, lane * 16, 1024);
            *(uint4*)hr = o0; *(uint4*)(hr + 8) = o1;
        }
    }
}


__device__ __forceinline__ void mm_row(const bf16_t* RA, const bf16_t* RB, int mw, int fr, int fg, f32x4 (&acc)[4]) {
#pragma unroll
    for (int ks = 0; ks < 2; ++ks) {
        bf16x8 a = *(const bf16x8*)(RA + (16 * mw + fr) * LROW + ks * 32 + fg * 8);
#pragma unroll
        for (int nt = 0; nt < 4; ++nt) {
            bf16x8 b = *(const bf16x8*)(RB + (16 * nt + fr) * LROW + ks * 32 + fg * 8);
            acc[nt] = __builtin_amdgcn_mfma_f32_16x16x32_bf16(a, b, acc[nt], 0, 0, 0);
        }
    }
}
__device__ __forceinline__ void mm_col(const bf16_t* RA, const bf16_t* RB, int nw, int fr, int fg, f32x4 (&acc)[4]) {
#pragma unroll
    for (int ks = 0; ks < 2; ++ks) {
        bf16x8 b = *(const bf16x8*)(RB + (16 * nw + fr) * LROW + ks * 32 + fg * 8);
#pragma unroll
        for (int mt = 0; mt < 4; ++mt) {
            bf16x8 a = *(const bf16x8*)(RA + (16 * mt + fr) * LROW + ks * 32 + fg * 8);
            acc[mt] = __builtin_amdgcn_mfma_f32_16x16x32_bf16(a, b, acc[mt], 0, 0, 0);
        }
    }
}
__device__ __forceinline__ void zero4(f32x4 (&a)[4]) {
#pragma unroll
    for (int i = 0; i < 4; ++i) a[i] = (f32x4){0.f, 0.f, 0.f, 0.f};
}
__device__ __forceinline__ void st4_lds(bf16_t* p, float a, float b, float c, float d) { uint2 o; o.x = pk_bf16(a, b); o.y = pk_bf16(c, d); *(uint2*)p = o; }
__device__ __forceinline__ bf16_t f2bf(float v) { return (bf16_t)(pk_bf16(v, 0.f) & 0xffffu); }

__device__ void gdn_prep_item(const Params& p, int l, int cid, unsigned char* lds_raw) {
    const int tid = ltid(), lane = tid & 63, w = tid >> 6, fr = lane & 15, fg = lane >> 4;
    const int bh = cid >> 6, n = cid & 63, b = bh / H_GDN, h = bh % H_GDN;
    const int t0 = b * SEQ + n * 64;
    bf16_t* L0 = (bf16_t*)lds_raw; bf16_t* L1 = L0 + 64 * LROW; bf16_t* L2 = L1 + 64 * LROW; bf16_t* L3 = L2 + 64 * LROW; bf16_t* L4 = L3 + 64 * LROW; bf16_t* L5 = L4 + 64 * LROW;
    float* dec = (float*)(L5 + 64 * LROW); float* beta = dec + 64;
    const bf16_t* proj = (const bf16_t*)(p.ws + WS_PROJ);
    const float* aux = (const float*)(p.ws + WS_AUX);
    const float* convw = p.in[7] + (size_t)l * 4 * 1152;
    float aux_a = 0.f, aux_b = 0.f;
    if (w == 0) { aux_a = aux[(size_t)(t0 + lane) * 64 + AX_GA + h]; aux_b = aux[(size_t)(t0 + lane) * 64 + AX_GB + h]; }
    __syncthreads();
    const int i = tid >> 2, c0 = (tid & 3) * 16;
    float qv[16], kv[16], vv[16];
#pragma unroll
    for (int which = 0; which < 3; ++which) {
        float acc[16];
#pragma unroll
        for (int c = 0; c < 16; ++c) acc[c] = 0.f;
#pragma unroll
        for (int tap = 0; tap < 4; ++tap) {
            const int row = i - 3 + tap;
            if (n * 64 + row >= 0) {
                const bf16_t* xp = proj + (size_t)(t0 + row) * NPROJ + NC_GQ + which * 384 + h * 64 + c0;
                u32x4 x0 = *(const u32x4*)xp, x1 = *(const u32x4*)(xp + 8);
                const float* wp = convw + tap * 1152 + which * 384 + h * 64 + c0;
                f32x4 w0 = *(const f32x4*)wp, w1 = *(const f32x4*)(wp + 4), w2 = *(const f32x4*)(wp + 8), w3 = *(const f32x4*)(wp + 12);
                float wv[16] = {w0[0], w0[1], w0[2], w0[3], w1[0], w1[1], w1[2], w1[3], w2[0], w2[1], w2[2], w2[3], w3[0], w3[1], w3[2], w3[3]};
                unsigned xs[8] = {x0[0], x0[1], x0[2], x0[3], x1[0], x1[1], x1[2], x1[3]};
#pragma unroll
                for (int c = 0; c < 8; ++c) { acc[2 * c] += wv[2 * c] * bflo(xs[c]); acc[2 * c + 1] += wv[2 * c + 1] * bfhi(xs[c]); }
            }
        }
        float ss = 0.f;
#pragma unroll
        for (int c = 0; c < 16; ++c) { acc[c] = siluf_(acc[c]); ss += acc[c] * acc[c]; }
        if (which < 2) {
            ss += __shfl_xor(ss, 1, 64); ss += __shfl_xor(ss, 2, 64);
            const float sc = rsqrtf(ss + 1e-6f) * (which == 0 ? 0.125f : 1.f);
#pragma unroll
            for (int c = 0; c < 16; ++c) acc[c] *= sc;
        }
#pragma unroll
        for (int c = 0; c < 16; ++c) { if (which == 0) qv[c] = acc[c]; else if (which == 1) kv[c] = acc[c]; else vv[c] = acc[c]; }
    }
#pragma unroll
    for (int c = 0; c < 16; c += 4) { st4_lds(L2 + i * LROW + c0 + c, kv[c], kv[c + 1], kv[c + 2], kv[c + 3]); st4_lds(L3 + i * LROW + c0 + c, qv[c], qv[c + 1], qv[c + 2], qv[c + 3]); }
    if (w == 0) {
        const float a = aux_a, bl = aux_b;
        const float g = -__expf(p.in[8][l * H_GDN + h]) * softplusf_(a + p.in[9][l * H_GDN + h]);
        float inc = g;
#pragma unroll
        for (int o = 1; o < 64; o <<= 1) { float t = __shfl_up(inc, o, 64); if (lane >= o) inc += t; }
        dec[lane] = inc; beta[lane] = sigmoidf_(bl);
    }
    __syncthreads();
    {
        f32x4 g4[4]; zero4(g4);
        mm_row(L2, L2, w, fr, fg, g4);
#pragma unroll
        for (int nt = 0; nt < 4; ++nt) {
            const int kap = 16 * nt + fr; const float dk_ = dec[kap], bk_ = beta[kap];
            float nT[4], nN[4], tt[4];
#pragma unroll
            for (int r = 0; r < 4; ++r) {
                const int rho = 16 * w + 4 * fg + r; const float dr_ = dec[rho], br_ = beta[rho];
                const float G = g4[nt][r];
                nT[r] = (kap < rho) ? br_ * G * __expf(dr_ - dk_) : 0.f;
                nN[r] = (rho < kap) ? bk_ * G * __expf(dk_ - dr_) : 0.f;
                tt[r] = ((kap == rho) ? 1.f : 0.f) - nN[r];
            }
            st4_lds(L1 + kap * LROW + 16 * w + 4 * fg, nT[0], nT[1], nT[2], nT[3]);
            st4_lds(L0 + kap * LROW + 16 * w + 4 * fg, nN[0], nN[1], nN[2], nN[3]);
            st4_lds(L4 + kap * LROW + 16 * w + 4 * fg, tt[0], tt[1], tt[2], tt[3]);
        }
        f32x4 a4[4]; zero4(a4);
        mm_row(L2, L3, w, fr, fg, a4);
#pragma unroll
        for (int nt = 0; nt < 4; ++nt) {
            const int ii = 16 * nt + fr; const float di_ = dec[ii];
            float v4[4];
#pragma unroll
            for (int r = 0; r < 4; ++r) { const int j = 16 * w + 4 * fg + r; v4[r] = (j <= ii) ? a4[nt][r] * __expf(di_ - dec[j]) : 0.f; }
            st4_lds(L5 + ii * LROW + 16 * w + 4 * fg, v4[0], v4[1], v4[2], v4[3]);
        }
    }
    __syncthreads();
#pragma unroll
    for (int lev = 1; lev <= 5; ++lev) {
        const bf16_t* XA = (lev & 1) ? L0 : L2; const bf16_t* XAt = (lev & 1) ? L1 : L3;
        bf16_t* XB = (lev & 1) ? L2 : L0; bf16_t* XBt = (lev & 1) ? L3 : L1;
        {
            f32x4 x4[4]; zero4(x4);
            mm_row(XA, XAt, w, fr, fg, x4);
#pragma unroll
            for (int nt = 0; nt < 4; ++nt) {
                const int c = 16 * nt + fr;
                st4_lds(XBt + c * LROW + 16 * w + 4 * fg, x4[nt][0], x4[nt][1], x4[nt][2], x4[nt][3]);
                if (lev < 5) {
#pragma unroll
                    for (int r = 0; r < 4; ++r) XB[(16 * w + 4 * fg + r) * LROW + c] = f2bf(x4[nt][r]);
                }
            }
        }
        __syncthreads();
        {
            f32x4 t4[4];
#pragma unroll
            for (int mt = 0; mt < 4; ++mt) {
                uint2 u = *(const uint2*)(L4 + (16 * w + fr) * LROW + 16 * mt + 4 * fg);
                t4[mt] = (f32x4){bflo(u.x), bfhi(u.x), bflo(u.y), bfhi(u.y)};
            }
            mm_col(XBt, L4, w, fr, fg, t4);
#pragma unroll
            for (int mt = 0; mt < 4; ++mt) st4_lds(L4 + (16 * w + fr) * LROW + 16 * mt + 4 * fg, t4[mt][0], t4[mt][1], t4[mt][2], t4[mt][3]);
        }
    }
    {
        const float dj = dec[i], bj = beta[i], dlast = dec[63];
        const float s1 = bj * __expf(dj), s2 = bj, s3 = __expf(dlast - dj);
#pragma unroll
        for (int c = 0; c < 16; ++c) {
            L0[(c0 + c) * LROW + i] = f2bf(kv[c] * s1);
            L1[(c0 + c) * LROW + i] = f2bf(vv[c] * s2);
            L2[(c0 + c) * LROW + i] = f2bf(kv[c] * s3);
        }
    }
    __syncthreads();
    {
        f32x4 w4[4], u4[4]; zero4(w4); zero4(u4);
        mm_row(L4, L0, w, fr, fg, w4);
        mm_row(L4, L1, w, fr, fg, u4);
        __syncthreads();
#pragma unroll
        for (int nt = 0; nt < 4; ++nt) {
            st4_lds(L0 + (16 * nt + fr) * LROW + 16 * w + 4 * fg, w4[nt][0], w4[nt][1], w4[nt][2], w4[nt][3]);
            st4_lds(L1 + (16 * nt + fr) * LROW + 16 * w + 4 * fg, u4[nt][0], u4[nt][1], u4[nt][2], u4[nt][3]);
        }
        const float ed = __expf(dec[i]);
#pragma unroll
        for (int c = 0; c < 16; c += 4) st4_lds(L3 + i * LROW + c0 + c, qv[c] * ed, qv[c + 1] * ed, qv[c + 2] * ed, qv[c + 3] * ed);
    }
    __syncthreads();
    char* scr = p.ws + WS_SCR;
    {
        f32x4 m4[4]; zero4(m4);
        mm_row(L0, L2, w, fr, fg, m4);
        bf16_t* MP = (bf16_t*)(scr + SCR_GDN_MP) + (size_t)cid * 4096;
#pragma unroll
        for (int nt = 0; nt < 4; ++nt) store4_bf16(MP + (16 * nt + fr) * 64 + 16 * w + 4 * fg, -m4[nt][0], -m4[nt][1], -m4[nt][2], -m4[nt][3]);
        f32x4 n4[4]; zero4(n4);
        mm_row(L2, L1, w, fr, fg, n4);
        bf16_t* NN = (bf16_t*)(scr + SCR_GDN_NN) + (size_t)cid * 4096;
#pragma unroll
        for (int nt = 0; nt < 4; ++nt) store4_bf16(NN + ((nt * 4 + w) * 64 + lane) * 4, n4[nt][0], n4[nt][1], n4[nt][2], n4[nt][3]);
        f32x4 p4[4]; zero4(p4);
        mm_row(L0, L5, w, fr, fg, p4);
        bf16_t* PG = (bf16_t*)(scr + SCR_GDN_P) + (size_t)cid * 4096;
#pragma unroll
        for (int nt = 0; nt < 4; ++nt) {
            uint2 u = *(const uint2*)(L3 + (16 * nt + fr) * LROW + 16 * w + 4 * fg);
            store4_bf16(PG + (16 * nt + fr) * 64 + 16 * w + 4 * fg, bflo(u.x) - p4[nt][0], bfhi(u.x) - p4[nt][1], bflo(u.y) - p4[nt][2], bfhi(u.y) - p4[nt][3]);
        }
        f32x4 o4[4]; zero4(o4);
        mm_row(L1, L5, w, fr, fg, o4);
        bf16_t* OL = (bf16_t*)(scr + SCR_GDN_OL) + (size_t)cid * 4096;
#pragma unroll
        for (int nt = 0; nt < 4; ++nt) store4_bf16(OL + (16 * nt + fr) * 64 + 16 * w + 4 * fg, o4[nt][0], o4[nt][1], o4[nt][2], o4[nt][3]);
        if (tid == 0) ((float*)(scr + SCR_GDN_LAST))[cid] = __expf(dec[63]);
    }
}

#define SCAN_SLOT    5120
#define SCAN_SB(k)   ((bf16_t*)lds_raw + (k) * 1024)
#define SCAN_RING(k) ((bf16_t*)lds_raw + 2048 + (k) * SCAN_SLOT)
#define SCAN_LAST    ((float*)(lds_raw + 4096 + 5 * SCAN_SLOT * 2))
__device__ __forceinline__ void scan_issue(const bf16_t* const (&mp)[8], const bf16_t* nn_lane, int n, bf16_t* slot, int h) {
    if (h == 0) {
#pragma unroll
        for (int q = 0; q < 4; ++q) __builtin_amdgcn_global_load_lds((const unsigned*)(mp[q] + (size_t)n * 4096), (unsigned*)(slot + q * 512), 16, 0, 0);
        __builtin_amdgcn_global_load_lds((const unsigned*)(nn_lane + (size_t)n * 4096), (unsigned*)(slot + 4096), 16, 0, 0);
    } else {
#pragma unroll
        for (int q = 4; q < 8; ++q) __builtin_amdgcn_global_load_lds((const unsigned*)(mp[q] + (size_t)n * 4096), (unsigned*)(slot + q * 512), 16, 0, 0);
        __builtin_amdgcn_global_load_lds((const unsigned*)(nn_lane + (size_t)n * 4096 + 512), (unsigned*)(slot + 4096 + 512), 16, 0, 0);
    }
}
__device__ void gdn_scan_item(const Params& p, int item, unsigned char* lds_raw, int svar = 0) {
    const int tid = ltid(), lane = tid & 63, w = __builtin_amdgcn_readfirstlane(tid >> 6), fr = lane & 15, fg = lane >> 4;
    const int bh = item >> 2, cg = item & 3;
    char* scr = p.ws + WS_SCR;
    const bf16_t* MP = (const bf16_t*)(scr + SCR_GDN_MP) + (size_t)bh * 64 * 4096;
    const bf16_t* NN = (const bf16_t*)(scr + SCR_GDN_NN) + (size_t)bh * 64 * 4096 + cg * 1024;
    const float* LAST = (const float*)(scr + SCR_GDN_LAST) + bh * 64;
    bf16_t* SG = (bf16_t*)(scr + SCR_GDN_SG) + (size_t)bh * 64 * 4096 + cg * 1024;
    const bf16_t* mp[8];
#pragma unroll
    for (int q = 0; q < 8; ++q) { const int row = 8 * q + (lane >> 3); mp[q] = MP + row * 64 + (((lane & 7) ^ ((row >> 1) & 7)) * 8); }
    const bf16_t* nn_lane = NN + lane * 8;
    __builtin_amdgcn_s_setprio(2);
    RAW_BARRIER();
    if (tid < 64) SCAN_LAST[tid] = ld_f32_agent(LAST + tid);
    asm volatile("s_waitcnt vmcnt(0)" ::: "memory");
    f32x4 S = (f32x4){0.f, 0.f, 0.f, 0.f};
    const int swz = (fr >> 1) & 7;
    if (w < 2) {
#pragma unroll
        for (int n = 0; n < 4; ++n) scan_issue(mp, nn_lane, n, SCAN_RING(n), w);
    }
    for (int n = 0; n < 64; ++n) {
        bf16_t* sb = SCAN_SB(n & 1);
        const bf16_t* ring = SCAN_RING(n % 5);
        {
            const int c = 2 * w + (fg >> 1);
            uint2 o; o.x = pk_bf16(S[0], S[1]); o.y = pk_bf16(S[2], S[3]);
            *(uint2*)(sb + fr * 64 + ((c ^ swz) * 8) + 4 * (fg & 1)) = o;
        }
        if (w < 2) {
            if (n + 3 < 64) asm volatile("s_waitcnt vmcnt(15)" ::: "memory");
            else if (n + 2 < 64) asm volatile("s_waitcnt vmcnt(10)" ::: "memory");
            else if (n + 1 < 64) asm volatile("s_waitcnt vmcnt(5)" ::: "memory");
            else asm volatile("s_waitcnt vmcnt(0)" ::: "memory");
        }
        RAW_BARRIER();
        if (w < 2 && n + 4 < 64 && svar != 2) scan_issue(mp, nn_lane, n + 4, SCAN_RING((n + 4) % 5), w);
        const float last = SCAN_LAST[n];
        {
            u32x2 nn = *(const u32x2*)(ring + 4096 + (w * 64 + lane) * 4);
            S[0] = last * S[0] + bflo(nn[0]); S[1] = last * S[1] + bfhi(nn[0]);
            S[2] = last * S[2] + bflo(nn[1]); S[3] = last * S[3] + bfhi(nn[1]);
        }
#pragma unroll
        for (int ks = 0; ks < 2; ++ks) {
            const int co = ((ks * 4 + fg) ^ swz) * 8;
            bf16x8 a = *(const bf16x8*)(ring + (16 * w + fr) * 64 + co);
            bf16x8 s = *(const bf16x8*)(sb + fr * 64 + co);
            S = __builtin_amdgcn_mfma_f32_16x16x32_bf16(a, s, S, 0, 0, 0);
        }
        if (w >= 2 && svar != 1) {
            const int c = (w - 2) * 64 + lane; const int row = c >> 3, pc = c & 7;
            u32x4 v = *(const u32x4*)(sb + row * 64 + pc * 8);
            *(u32x4*)(SG + (size_t)n * 4096 + row * 64 + ((pc ^ ((row >> 1) & 7)) * 8)) = v;
        }
    }
    __builtin_amdgcn_s_setprio(0);
}

__device__ void gdn_out_item(const Params& p, int l, int cid) {
    const int tid = ltid(), lane = tid & 63, w = tid >> 6, fr = lane & 15, fg = lane >> 4;
    const int bh = cid >> 6, n = cid & 63, b = bh / H_GDN, h = bh % H_GDN;
    char* scr = p.ws + WS_SCR;
    const bf16_t* SG = (const bf16_t*)(scr + SCR_GDN_SG) + (size_t)cid * 4096;
    const bf16_t* PG = (const bf16_t*)(scr + SCR_GDN_P) + (size_t)cid * 4096;
    const bf16_t* OL = (const bf16_t*)(scr + SCR_GDN_OL) + (size_t)cid * 4096;
    const int i = 16 * w + fr; const int t = b * SEQ + n * 64 + i;
    f32x4 acc[4];
#pragma unroll
    for (int mt = 0; mt < 4; ++mt) { uint2 u = *(const uint2*)(OL + i * 64 + 16 * mt + 4 * fg); acc[mt] = (f32x4){bflo(u.x), bfhi(u.x), bflo(u.y), bfhi(u.y)}; }
#pragma unroll
    for (int ks = 0; ks < 2; ++ks) {
        bf16x8 bq = *(const bf16x8*)(PG + i * 64 + ks * 32 + fg * 8);
#pragma unroll
        for (int mt = 0; mt < 4; ++mt) {
            bf16x8 a = *(const bf16x8*)(SG + (16 * mt + fr) * 64 + ks * 32 + fg * 8);
            acc[mt] = __builtin_amdgcn_mfma_f32_16x16x32_bf16(a, bq, acc[mt], 0, 0, 0);
        }
    }
    float ss = 0.f;
#pragma unroll
    for (int mt = 0; mt < 4; ++mt)
#pragma unroll
        for (int r = 0; r < 4; ++r) ss += acc[mt][r] * acc[mt][r];
    ss += __shfl_xor(ss, 16, 64); ss += __shfl_xor(ss, 32, 64);
    const float rstd = rsqrtf(ss * (1.f / 64.f) + 1e-6f);
    const float* og = p.in[10] + l * 64;
    const bf16_t* gp = (const bf16_t*)(p.ws + WS_PROJ) + (size_t)t * NPROJ + NC_GG + h * 64;
    unsigned char* mp = (unsigned char*)(p.ws + WS_MIX) + pl8_off(t, 384 + h * 64, 1024);
#pragma unroll
    for (int mt = 0; mt < 4; ++mt) {
        const int e0 = 16 * mt + 4 * fg;
        uint2 gu = *(const uint2*)(gp + e0); f32x4 g4 = *(const f32x4*)(og + e0);
        *(unsigned*)(mp + e0) = pk_fp8x4(f8clamp(acc[mt][0] * rstd * g4[0] * bflo(gu.x) * F8_ASCALE), f8clamp(acc[mt][1] * rstd * g4[1] * bfhi(gu.x) * F8_ASCALE), f8clamp(acc[mt][2] * rstd * g4[2] * bflo(gu.y) * F8_ASCALE), f8clamp(acc[mt][3] * rstd * g4[3] * bfhi(gu.y) * F8_ASCALE));
    }
}

#define GQROW 40
__device__ void gla_prep_item(const Params& p, int l, int cid, unsigned char* lds_raw) {
    const int tid = ltid(), lane = tid & 63, w = tid >> 6, fr = lane & 15, fg = lane >> 4;
    const int bh = cid >> 6, n = cid & 63, b = bh / H_GLA, h = bh % H_GLA;
    const int t0 = b * SEQ + n * 64;
    float* Bf = (float*)lds_raw;
    bf16_t* Qt = (bf16_t*)(lds_raw + 8448);
    bf16_t* Kt = Qt + 64 * GQROW;
    bf16_t* KLt = Kt + 64 * GQROW;
    bf16_t* Vt = KLt + 32 * LROW;
    const bf16_t* proj = (const bf16_t*)(p.ws + WS_PROJ);
    const float* aux = (const float*)(p.ws + WS_AUX);
    char* scr = p.ws + WS_SCR;
    __syncthreads();
    const int i = tid >> 2, d0 = (tid & 3) * 8;
    const u32x4 qu = *(const u32x4*)(proj + (size_t)(t0 + i) * NPROJ + NC_LQ + h * 32 + d0), ku = *(const u32x4*)(proj + (size_t)(t0 + i) * NPROJ + NC_LK + h * 32 + d0);
    {
        const float* wa = p.in[11] + (size_t)l * 16 * 128 + h * 32 + d0;
        const float* ba = p.in[12] + l * 128 + h * 32 + d0;
        float acc[8];
#pragma unroll
        for (int j = 0; j < 8; ++j) acc[j] = ba[j];
        float a1v[16];
#pragma unroll
        for (int r = 0; r < 16; r += 2) { float2 t2 = *(const float2*)(aux + (size_t)(t0 + i) * 64 + AX_LA + r); a1v[r] = t2.x; a1v[r + 1] = t2.y; }
#pragma unroll
        for (int r = 0; r < 16; ++r) {
            f32x4 wA = *(const f32x4*)(wa + r * 128), wB = *(const f32x4*)(wa + r * 128 + 4);
#pragma unroll
            for (int j = 0; j < 4; ++j) { acc[j] += a1v[r] * wA[j]; acc[4 + j] += a1v[r] * wB[j]; }
        }
#pragma unroll
        for (int j = 0; j < 8; ++j) Bf[i * 33 + d0 + j] = logsigmoidf_(acc[j]) * (1.f / 16.f);
    }
    {
        const bf16_t* lvt = (const bf16_t*)(scr + SCR_LVT) + (size_t)bh * 64 * SEQ + n * 64;
#pragma unroll
        for (int ii = 0; ii < 2; ++ii) { int c = tid + 256 * ii; int row = c >> 3, kc = c & 7; *(u32x4*)(Vt + row * LROW + kc * 8) = *(const u32x4*)(lvt + (size_t)row * SEQ + kc * 8); }
    }
    __syncthreads();
#pragma unroll
    for (int c = 0; c < 8; ++c) {
        const int d = 8 * w + c;
        float inc = Bf[lane * 33 + d];
#pragma unroll
        for (int o = 1; o < 64; o <<= 1) { float t = __shfl_up(inc, o, 64); if (lane >= o) inc += t; }
        Bf[lane * 33 + d] = inc;
    }
    __syncthreads();
    {
        float qf[8] = {bflo(qu[0]), bfhi(qu[0]), bflo(qu[1]), bfhi(qu[1]), bflo(qu[2]), bfhi(qu[2]), bflo(qu[3]), bfhi(qu[3])};
        float kf[8] = {bflo(ku[0]), bfhi(ku[0]), bflo(ku[1]), bfhi(ku[1]), bflo(ku[2]), bfhi(ku[2]), bflo(ku[3]), bfhi(ku[3])};
        float qt[8], kt[8], qb[8];
#pragma unroll
        for (int j = 0; j < 8; ++j) {
            const float bi = Bf[i * 33 + d0 + j], bm = Bf[31 * 33 + d0 + j], bl = Bf[63 * 33 + d0 + j];
            qt[j] = qf[j] * __expf(bi - bm); kt[j] = kf[j] * __expf(bm - bi); qb[j] = qf[j] * __expf(bi);
            KLt[(d0 + j) * LROW + i] = f2bf(kf[j] * __expf(bl - bi));
            if (i == 63) ((float*)(scr + SCR_GLA_DL))[cid * 32 + d0 + j] = __expf(bl);
        }
        u32x4 o; o[0] = pk_bf16(qt[0], qt[1]); o[1] = pk_bf16(qt[2], qt[3]); o[2] = pk_bf16(qt[4], qt[5]); o[3] = pk_bf16(qt[6], qt[7]);
        *(u32x4*)(Qt + i * GQROW + d0) = o;
        o[0] = pk_bf16(kt[0], kt[1]); o[1] = pk_bf16(kt[2], kt[3]); o[2] = pk_bf16(kt[4], kt[5]); o[3] = pk_bf16(kt[6], kt[7]);
        *(u32x4*)(Kt + i * GQROW + d0) = o;
        o[0] = pk_bf16(qb[0], qb[1]); o[1] = pk_bf16(qb[2], qb[3]); o[2] = pk_bf16(qb[4], qb[5]); o[3] = pk_bf16(qb[6], qb[7]);
        *(u32x4*)((bf16_t*)(scr + SCR_GLA_QB) + (size_t)cid * 2048 + i * 32 + d0) = o;
    }
    __syncthreads();
    f32x4 sc[4];
    {
        bf16x8 bq = *(const bf16x8*)(Qt + (16 * w + fr) * GQROW + fg * 8);
#pragma unroll
        for (int mt = 0; mt < 4; ++mt) {
            bf16x8 a = *(const bf16x8*)(Kt + (16 * mt + fr) * GQROW + fg * 8);
            sc[mt] = __builtin_amdgcn_mfma_f32_16x16x32_bf16(a, bq, (f32x4){0.f, 0.f, 0.f, 0.f}, 0, 0, 0);
        }
        const int ii = 16 * w + fr;
#pragma unroll
        for (int mt = 0; mt < 4; ++mt)
#pragma unroll
            for (int r = 0; r < 4; ++r) { const int j = 16 * mt + 4 * fg + r; if (j > ii) sc[mt][r] = 0.f; }
    }
    {
        f32x4 o4[4]; zero4(o4);
#pragma unroll
        for (int kk = 0; kk < 2; ++kk) {
            u32x4 pb = {pk_bf16(sc[2 * kk][0], sc[2 * kk][1]), pk_bf16(sc[2 * kk][2], sc[2 * kk][3]), pk_bf16(sc[2 * kk + 1][0], sc[2 * kk + 1][1]), pk_bf16(sc[2 * kk + 1][2], sc[2 * kk + 1][3])};
#pragma unroll
            for (int mt = 0; mt < 4; ++mt) {
                uint2 v0 = *(const uint2*)(Vt + (16 * mt + fr) * LROW + 32 * kk + 4 * fg), v1 = *(const uint2*)(Vt + (16 * mt + fr) * LROW + 32 * kk + 16 + 4 * fg);
                u32x4 va = {v0.x, v0.y, v1.x, v1.y};
                o4[mt] = __builtin_amdgcn_mfma_f32_16x16x32_bf16(__builtin_bit_cast(bf16x8, va), __builtin_bit_cast(bf16x8, pb), o4[mt], 0, 0, 0);
            }
        }
        bf16_t* OL = (bf16_t*)(scr + SCR_GLA_OL) + (size_t)cid * 4096;
#pragma unroll
        for (int mt = 0; mt < 4; ++mt) store4_bf16(OL + (16 * w + fr) * 64 + 16 * mt + 4 * fg, o4[mt][0], o4[mt][1], o4[mt][2], o4[mt][3]);
    }
    {
        f32x4 k4[2] = {(f32x4){0.f, 0.f, 0.f, 0.f}, (f32x4){0.f, 0.f, 0.f, 0.f}};
#pragma unroll
        for (int ks = 0; ks < 2; ++ks) {
            bf16x8 bv = *(const bf16x8*)(Vt + (16 * w + fr) * LROW + ks * 32 + fg * 8);
#pragma unroll
            for (int mt = 0; mt < 2; ++mt) {
                bf16x8 a = *(const bf16x8*)(KLt + (16 * mt + fr) * LROW + ks * 32 + fg * 8);
                k4[mt] = __builtin_amdgcn_mfma_f32_16x16x32_bf16(a, bv, k4[mt], 0, 0, 0);
            }
        }
        float* KV = (float*)(scr + SCR_GLA_KV) + (size_t)cid * 2048;
#pragma unroll
        for (int mt = 0; mt < 2; ++mt) *(f32x4*)(KV + (16 * w + fr) * 32 + 16 * mt + 4 * fg) = k4[mt];
    }
}
__device__ void gla_scan_item(const Params& p, int g) {
    const int tid = ltid();
    const int bh = g >> 3, idx = (g & 7) * 256 + tid, d = idx & 31;
    char* scr = p.ws + WS_SCR;
    const float* __restrict__ KV = (const float*)(scr + SCR_GLA_KV) + (size_t)bh * 64 * 2048 + idx;
    const float* __restrict__ DL = (const float*)(scr + SCR_GLA_DL) + bh * 64 * 32 + d;
    bf16_t* __restrict__ SG = (bf16_t*)(scr + SCR_GLA_SG) + (size_t)bh * 64 * 2048 + idx;
    float S = 0.f;
    for (int n0 = 0; n0 < 64; n0 += 8) {
        float kv[8], dl[8];
#pragma unroll
        for (int u = 0; u < 8; ++u) { kv[u] = KV[(size_t)(n0 + u) * 2048]; dl[u] = DL[(n0 + u) * 32]; }
#pragma unroll
        for (int u = 0; u < 8; ++u) { SG[(size_t)(n0 + u) * 2048] = f2bf(S); S = dl[u] * S + kv[u]; }
    }
}
__device__ void gla_out_item(const Params& p, int l, int cid) {
    const int tid = ltid(), lane = tid & 63, w = tid >> 6, fr = lane & 15, fg = lane >> 4;
    const int bh = cid >> 6, n = cid & 63, b = bh / H_GLA, h = bh % H_GLA;
    char* scr = p.ws + WS_SCR;
    const bf16_t* SG = (const bf16_t*)(scr + SCR_GLA_SG) + (size_t)cid * 2048;
    const bf16_t* QB = (const bf16_t*)(scr + SCR_GLA_QB) + (size_t)cid * 2048;
    const bf16_t* OL = (const bf16_t*)(scr + SCR_GLA_OL) + (size_t)cid * 4096;
    const int i = 16 * w + fr; const int t = b * SEQ + n * 64 + i;
    f32x4 acc[4];
#pragma unroll
    for (int mt = 0; mt < 4; ++mt) { uint2 u = *(const uint2*)(OL + i * 64 + 16 * mt + 4 * fg); acc[mt] = (f32x4){bflo(u.x), bfhi(u.x), bflo(u.y), bfhi(u.y)}; }
    bf16x8 bq = *(const bf16x8*)(QB + i * 32 + fg * 8);
#pragma unroll
    for (int mt = 0; mt < 4; ++mt) {
        bf16x8 a = *(const bf16x8*)(SG + (16 * mt + fr) * 32 + fg * 8);
        acc[mt] = __builtin_amdgcn_mfma_f32_16x16x32_bf16(a, bq, acc[mt], 0, 0, 0);
    }
    float ss = 0.f;
#pragma unroll
    for (int mt = 0; mt < 4; ++mt)
#pragma unroll
        for (int r = 0; r < 4; ++r) ss += acc[mt][r] * acc[mt][r];
    ss += __shfl_xor(ss, 16, 64); ss += __shfl_xor(ss, 32, 64);
    const float rstd = rsqrtf(ss * (1.f / 64.f) + 1e-6f);
    const float* og = p.in[13] + l * 64;
    const bf16_t* rp = (const bf16_t*)(p.ws + WS_PROJ) + (size_t)t * NPROJ + NC_LR + h * 64;
    unsigned char* mp = (unsigned char*)(p.ws + WS_MIX) + pl8_off(t, 768 + h * 64, 1024);
#pragma unroll
    for (int mt = 0; mt < 4; ++mt) {
        const int e0 = 16 * mt + 4 * fg;
        uint2 gu = *(const uint2*)(rp + e0); f32x4 g4 = *(const f32x4*)(og + e0);
        *(unsigned*)(mp + e0) = pk_fp8x4(f8clamp(acc[mt][0] * rstd * g4[0] * bflo(gu.x) * F8_ASCALE), f8clamp(acc[mt][1] * rstd * g4[1] * bfhi(gu.x) * F8_ASCALE), f8clamp(acc[mt][2] * rstd * g4[2] * bflo(gu.y) * F8_ASCALE), f8clamp(acc[mt][3] * rstd * g4[3] * bfhi(gu.y) * F8_ASCALE));
    }
}
__device__ void phase_mixout(const Params& p, int l) {
    for (int it = blockIdx.x; it < NGDN_CH + NGLA_CH; it += gridDim.x) {
        if (it < NGDN_CH) { if (MIXSEL & 1) gdn_out_item(p, l, it); } else { if (MIXSEL & 2) gla_out_item(p, l, it - NGDN_CH); }
    }
}

__device__ void fox_cumsum_item(const Params& p, int l, int bh, float* ldsf) {
    const int tid = ltid(), lane = tid & 63, w = tid >> 6;
    const int b = bh / H_FOX, h = bh % H_FOX;
    const float* aux = (const float*)(p.ws + WS_AUX);
    float* cum = (float*)(p.ws + WS_CUM) + (size_t)bh * SEQ;
    const float fb = p.in[5][l * H_FOX + h];
    float v[16]; float s = 0.f;
#pragma unroll
    for (int i = 0; i < 16; ++i) { v[i] = logsigmoidf_(aux[(size_t)(b * SEQ + tid * 16 + i) * 64 + AX_FF + h] + fb); s += v[i]; }
    float inc = s;
#pragma unroll
    for (int o = 1; o < 64; o <<= 1) { float t = __shfl_up(inc, o, 64); if (lane >= o) inc += t; }
    __syncthreads();
    if (lane == 63) ldsf[w] = inc;
    __syncthreads();
    float base = inc - s;
    for (int ww = 0; ww < w; ++ww) base += ldsf[ww];
    float c = base;
    u32x4* csx = (u32x4*)(p.ws + WS_SCR + SCR_CSX) + (size_t)bh * SEQ;
#pragma unroll
    for (int i = 0; i < 16; ++i) {
        c += v[i]; cum[tid * 16 + i] = c;
        const float vv = 1.4426950408889634f * c;
        const unsigned hi = pk_bf16(vv, 0.f) & 0xffffu; const float r1 = vv - __uint_as_float(hi << 16);
        const unsigned mid = pk_bf16(r1, 0.f) & 0xffffu; const float r2 = r1 - __uint_as_float(mid << 16);
        const unsigned lo = pk_bf16(r2, 0.f) & 0xffffu;
        u32x4 f; f[0] = 0x3F803F80u; f[1] = 0x3F80u | ((hi ^ 0x8000u) << 16); f[2] = (mid ^ 0x8000u) | ((lo ^ 0x8000u) << 16); f[3] = 0u;
        csx[tid * 16 + i] = f;
    }
}
__device__ void phase_prep(const Params& p, int l, unsigned char* lds_raw) {
    const int n0 = BATCH * H_FOX, n1 = n0 + ((MIXSEL & 1) ? NGDN_CH : 0), n2 = n1 + ((MIXSEL & 2) ? NGLA_CH : 0);
    for (int it = blockIdx.x; it < n2; it += gridDim.x) {
        if (it < n0) { __syncthreads(); fox_cumsum_item(p, l, it, (float*)lds_raw); }
        else if (it < n1) gdn_prep_item(p, l, it - n0, lds_raw);
        else gla_prep_item(p, l, it - n1, lds_raw);
    }
}

#define ATT_BUF 17408
#define ATT_THR 8.0f
#define ATT_NSTAGE 3
__device__ __forceinline__ void attn_issue(const bf16_t* const (&kp)[2], const bf16_t* const (&vp)[2], const bf16_t* cp, int s0, unsigned char* stage, int w) {
    bf16_t* Ks = (bf16_t*)stage; bf16_t* Vs = Ks + 4096; bf16_t* cs = Vs + 4096;
    __builtin_amdgcn_global_load_lds((const unsigned*)(kp[0] + (size_t)s0 * NPROJ), (unsigned*)(Ks + (w * 8) * 64), 16, 0, 0);
    __builtin_amdgcn_global_load_lds((const unsigned*)(kp[1] + (size_t)s0 * NPROJ), (unsigned*)(Ks + (32 + w * 8) * 64), 16, 0, 0);
    __builtin_amdgcn_global_load_lds((const unsigned*)(vp[0] + s0), (unsigned*)(Vs + (w * 8) * 64), 16, 0, 0);
    __builtin_amdgcn_global_load_lds((const unsigned*)(vp[1] + s0), (unsigned*)(Vs + (32 + w * 8) * 64), 16, 0, 0);
    __builtin_amdgcn_global_load_lds((const unsigned*)(cp + (size_t)s0 * 8), (unsigned*)cs, 16, 0, 0);
}
__device__ __forceinline__ bf16x8 attn_qbias(float u, int h) {
    const unsigned hi = pk_bf16(u, 0.f) & 0xffffu; const float r1 = u - __uint_as_float(hi << 16);
    const unsigned mid = pk_bf16(r1, 0.f) & 0xffffu; const float r2 = r1 - __uint_as_float(mid << 16);
    const unsigned lo = pk_bf16(r2, 0.f) & 0xffffu;
    u32x4 f; f[0] = hi | (mid << 16); f[1] = lo | (0x3F80u << 16); f[2] = 0x3F803F80u; f[3] = 0u;
    if (h) { f[0] = 0u; f[1] = 0u; f[2] = 0u; }
    return __builtin_bit_cast(bf16x8, f);
}
__device__ void fox_attn_item(const Params& p, int l, int bh, int qt, unsigned char* lds_raw) {
    const int tid = ltid(), lane = tid & 63, w = __builtin_amdgcn_readfirstlane(tid >> 6), r = lane & 31, h = lane >> 5;
    const int b = bh / H_FOX, hh = bh % H_FOX;
    const bf16_t* proj = (const bf16_t*)(p.ws + WS_PROJ);
    const bf16_t* kbase = proj + (size_t)b * SEQ * NPROJ + NC_FK + hh * 64;
    const bf16_t* vbase = (const bf16_t*)(p.ws + WS_VTF) + (size_t)bh * 64 * SEQ;
    const float* cum = (const float*)(p.ws + WS_CUM) + (size_t)bh * SEQ;
    const int qlo = qt * 128 + w * 32, q = qlo + r;
    bf16x8 qf[4];
    {
        const bf16_t* qrow = proj + (size_t)(b * SEQ + q) * NPROJ + NC_FQ + hh * 64;
#pragma unroll
        for (int kk = 0; kk < 4; ++kk) qf[kk] = *(const bf16x8*)(qrow + kk * 16 + h * 8);
    }
    const float cq2 = cum[q] * 1.4426950408889634f;
    float mref = 0.f;
    bf16x8 qx = attn_qbias(cq2 - mref, h);
    f32x16 o0, o1;
#pragma unroll
    for (int i = 0; i < 16; ++i) { o0[i] = 0.f; o1[i] = 0.f; }
    float lsum = 0.f;
    const int ntiles = 2 * qt + 2;
    const bf16_t* kp[2]; const bf16_t* vp[2];
    {
        const int row0 = w * 8 + (lane >> 3), pc = lane & 7;
        const int lc0 = (pc ^ ((row0 >> 1) & 7)) * 8;
        kp[0] = kbase + (size_t)row0 * NPROJ + lc0; kp[1] = kbase + (size_t)(row0 + 32) * NPROJ + lc0;
        vp[0] = vbase + (size_t)row0 * SEQ + lc0;   vp[1] = vbase + (size_t)(row0 + 32) * SEQ + lc0;
    }
    const bf16_t* cp = (const bf16_t*)(p.ws + WS_SCR + SCR_CSX) + (size_t)bh * SEQ * 8 + lane * 8;
    const int swr = (r >> 1) & 7;
    int jw; float zmax_bound;
    {
        float gq = fabsf(p.in[3][l * 64 + lane]), gk = fabsf(p.in[4][l * 64 + lane]);
#pragma unroll
        for (int o = 32; o > 0; o >>= 1) { gq = fmaxf(gq, __shfl_xor(gq, o, 64)); gk = fmaxf(gk, __shfl_xor(gk, o, 64)); }
        const float thr = 2.f * (1.4426950408889634f * 8.f * gq * gk) + 30.f;
        zmax_bound = 1.4426950408889634f * 8.f * gq * gk;
        const float cw = cum[qlo] * 1.4426950408889634f;
        const float ce = (lane < ntiles) ? cum[64 * lane + 63] * 1.4426950408889634f : 0.f;
        const unsigned long long keep = __ballot((lane < ntiles) && (cw - ce >= -thr));
        jw = keep ? (__ffsll((long long)keep) - 1) : (ntiles - 1);
    }
    volatile int* jshare = (volatile int*)(lds_raw + ATT_NSTAGE * ATT_BUF + 16);
    asm volatile("s_waitcnt vmcnt(0)" ::: "memory");
    RAW_BARRIER();
    if (tid == 0) *jshare = jw;
    RAW_BARRIER();
    const int jstart = *jshare;
    const bool no_rescale = (zmax_bound <= 64.f);
    attn_issue(kp, vp, cp, jstart * 64, lds_raw + (jstart % ATT_NSTAGE) * ATT_BUF, w);
    if (jstart + 1 < ntiles) attn_issue(kp, vp, cp, (jstart + 1) * 64, lds_raw + ((jstart + 1) % ATT_NSTAGE) * ATT_BUF, w);
    for (int j = jstart; j < ntiles; ++j) {
        if (j + 1 < ntiles) asm volatile("s_waitcnt vmcnt(5)" ::: "memory"); else asm volatile("s_waitcnt vmcnt(0)" ::: "memory");
        RAW_BARRIER();
        if (j + 2 < ntiles) attn_issue(kp, vp, cp, (j + 2) * 64, lds_raw + ((j + 2) % ATT_NSTAGE) * ATT_BUF, w);
        const int s0 = j * 64;
        if (s0 <= qlo + 31 && j >= jw) {
            const bf16_t* Ks = (const bf16_t*)(lds_raw + (j % ATT_NSTAGE) * ATT_BUF); const bf16_t* Vs = Ks + 4096; const bf16_t* cs = Vs + 4096;
            f32x16 st0, st1;
            {
                u32x4 z4 = {0u, 0u, 0u, 0u};
                u32x4 c0 = *(const u32x4*)(cs + r * 8), c1 = *(const u32x4*)(cs + (32 + r) * 8);
                if (h) { c0 = z4; c1 = z4; }
                f32x16 zz;
#pragma unroll
                for (int i = 0; i < 16; ++i) zz[i] = 0.f;
                st0 = __builtin_amdgcn_mfma_f32_32x32x16_bf16(__builtin_bit_cast(bf16x8, c0), qx, zz, 0, 0, 0);
                st1 = __builtin_amdgcn_mfma_f32_32x32x16_bf16(__builtin_bit_cast(bf16x8, c1), qx, zz, 0, 0, 0);
            }
#pragma unroll
            for (int kk = 0; kk < 4; ++kk) {
                const int co = ((kk * 2 + h) ^ swr) * 8;
                bf16x8 a0 = *(const bf16x8*)(Ks + r * 64 + co);
                bf16x8 a1 = *(const bf16x8*)(Ks + (32 + r) * 64 + co);
                st0 = __builtin_amdgcn_mfma_f32_32x32x16_bf16(a0, qf[kk], st0, 0, 0, 0);
                st1 = __builtin_amdgcn_mfma_f32_32x32x16_bf16(a1, qf[kk], st1, 0, 0, 0);
            }
            if (s0 + 63 > qlo) {
#pragma unroll
                for (int i = 0; i < 16; ++i) {
                    const int key = s0 + (i & 3) + 8 * (i >> 2) + 4 * h;
                    if (key > q) st0[i] = -1e30f;
                    if (key + 32 > q) st1[i] = -1e30f;
                }
            }
            float mx = 0.f;
            if (!no_rescale) {
                mx = fmaxf(st0[0], st1[0]);
#pragma unroll
                for (int i = 1; i < 16; ++i) mx = fmaxf(mx, fmaxf(st0[i], st1[i]));
            }
            if (!no_rescale && __any(mx > ATT_THR)) {
                const float mo = fmaxf(mx, __shfl_xor(mx, 32, 64));
                const float d = (mo > ATT_THR) ? mo : 0.f;
                const float alpha = __builtin_amdgcn_exp2f(-d);
#pragma unroll
                for (int i = 0; i < 16; ++i) { st0[i] -= d; st1[i] -= d; o0[i] *= alpha; o1[i] *= alpha; }
                lsum *= alpha; mref += d;
                qx = attn_qbias(cq2 - mref, h);
            }
            float rs = 0.f;
#pragma unroll
            for (int i = 0; i < 16; ++i) { st0[i] = __builtin_amdgcn_exp2f(st0[i]); st1[i] = __builtin_amdgcn_exp2f(st1[i]); rs += st0[i] + st1[i]; }
            lsum += rs;
            bf16x8 pf[2][2];
#pragma unroll
            for (int s = 0; s < 2; ++s) {
                u32x4 t0 = {pk_bf16(st0[8 * s], st0[8 * s + 1]), pk_bf16(st0[8 * s + 2], st0[8 * s + 3]), pk_bf16(st0[8 * s + 4], st0[8 * s + 5]), pk_bf16(st0[8 * s + 6], st0[8 * s + 7])};
                u32x4 t1 = {pk_bf16(st1[8 * s], st1[8 * s + 1]), pk_bf16(st1[8 * s + 2], st1[8 * s + 3]), pk_bf16(st1[8 * s + 4], st1[8 * s + 5]), pk_bf16(st1[8 * s + 6], st1[8 * s + 7])};
                pf[0][s] = __builtin_bit_cast(bf16x8, t0); pf[1][s] = __builtin_bit_cast(bf16x8, t1);
            }
#pragma unroll
            for (int mt = 0; mt < 2; ++mt)
#pragma unroll
                for (int s = 0; s < 2; ++s) {
                    const int c0 = 4 * mt + 2 * s;
                    const int oA = ((c0 ^ swr) * 8) + 4 * h, oB = (((c0 + 1) ^ swr) * 8) + 4 * h;
                    uint2 a00 = *(const uint2*)(Vs + r * 64 + oA), a01 = *(const uint2*)(Vs + r * 64 + oB);
                    uint2 a10 = *(const uint2*)(Vs + (32 + r) * 64 + oA), a11 = *(const uint2*)(Vs + (32 + r) * 64 + oB);
                    u32x4 u0 = {a00.x, a00.y, a01.x, a01.y}; u32x4 u1 = {a10.x, a10.y, a11.x, a11.y};
                    o0 = __builtin_amdgcn_mfma_f32_32x32x16_bf16(__builtin_bit_cast(bf16x8, u0), pf[mt][s], o0, 0, 0, 0);
                    o1 = __builtin_amdgcn_mfma_f32_32x32x16_bf16(__builtin_bit_cast(bf16x8, u1), pf[mt][s], o1, 0, 0, 0);
                }
        }
    }
    lsum += __shfl_xor(lsum, 32, 64);
    const float inv = 1.f / lsum;
    float ss = 0.f;
#pragma unroll
    for (int i = 0; i < 16; ++i) { o0[i] *= inv; o1[i] *= inv; ss += o0[i] * o0[i] + o1[i] * o1[i]; }
    ss += __shfl_xor(ss, 32, 64);
    const float rstd = rsqrtf(ss * (1.f / 64.f) + 1e-6f);
    const float* og = p.in[6] + l * 64;
    unsigned char* mrow = (unsigned char*)(p.ws + WS_MIX) + pl8_off(b * SEQ + q, hh * 64, 1024);
#pragma unroll
    for (int g = 0; g < 4; ++g) {
        const int e0 = 8 * g + 4 * h;
        f32x4 g0 = *(const f32x4*)(og + e0), g1 = *(const f32x4*)(og + 32 + e0);
        const float r8 = rstd * F8_ASCALE;
        *(unsigned*)(mrow + e0) = pk_fp8x4(f8clamp(o0[4 * g] * r8 * g0[0]), f8clamp(o0[4 * g + 1] * r8 * g0[1]), f8clamp(o0[4 * g + 2] * r8 * g0[2]), f8clamp(o0[4 * g + 3] * r8 * g0[3]));
        *(unsigned*)(mrow + 32 + e0) = pk_fp8x4(f8clamp(o1[4 * g] * r8 * g1[0]), f8clamp(o1[4 * g + 1] * r8 * g1[1]), f8clamp(o1[4 * g + 2] * r8 * g1[2]), f8clamp(o1[4 * g + 3] * r8 * g1[3]));
    }
}
#define ATT_ITEMS (BATCH * H_FOX * (SEQ / 128))
#define CONV_ITEMS ((CONV_REST + P0_T_IN + 3) / 4)
__device__ void phase_scan_attn(const Params& p, int l, unsigned char* lds_raw, int rep = 0, int sel = 7) {
    unsigned* qctr = (unsigned*)(p.ws + WS_CTL) + CW_Q + l + 2 * rep;
    volatile int* slot = (volatile int*)(lds_raw + ATT_NSTAGE * ATT_BUF);
    const int cbase = (l == 0) ? CONV_BASE0 : CONV_N1, ctot = (l == 0) ? CONV_TAIL0 : CONV_N1, cvn = ctot - cbase;
    const int QR = (l == 0) ? 1 : 0;
    for (;;) {
        __syncthreads();
        if (threadIdx.x == 0) *slot = (int)atomicAdd(qctr, 1u);
        __syncthreads();
        int it = *slot;
        const int ns0 = (MIXSEL & 1) ? BATCH * H_GDN * 4 : 0, ns1 = ns0 + ((MIXSEL & 2) ? 128 : 0);
        if (it >= ns1 + ATT_ITEMS + cvn) break;
        if (it >= ns1) {
            const int c = it - ns1;
            int conv_idx = -1;
            if (c < (QR + 1) * ATT_ITEMS) { if (c % (QR + 1) != 0) conv_idx = c - c / (QR + 1) - 1; } else conv_idx = c - ATT_ITEMS;
            if (conv_idx >= 0) {
                if (rep == 0 && conv_idx < cvn) conv_fold4(p, l, (cbase + conv_idx) * 4, ltid());
                continue;
            }
            it = ns1 + c / (QR + 1);
        }
        if (it < ns0) { if (sel & 1) gdn_scan_item(p, it, lds_raw, rep ? SVAR : 0); continue; }
        if (it < ns1) { if (sel & 2) gla_scan_item(p, it - ns0); continue; }
        it -= ns1;
        if (!(sel & 4)) continue;
        const int qt = (SEQ / 128 - 1) - it / (BATCH * H_FOX), bh = it % (BATCH * H_FOX);
        fox_attn_item(p, l, bh, qt, lds_raw);
    }
}

#define NPHASE 19
__global__ void __launch_bounds__(256, 2) mk(Params p, int lo, int hi, int use_bar) {
    __shared__ __attribute__((aligned(16))) unsigned char lds_raw[LDS_BYTES];
    bf16_t* lds = (bf16_t*)lds_raw;
    volatile LAS unsigned* st = (volatile LAS unsigned*)(lds_raw + LDS_BYTES - 16);
    XcdBarrier bar; bar.bar = (unsigned*)(p.ws + WS_CTL) + CW_BAR; bar.x = 0; bar.st = st;
    if (use_bar) {
        if (threadIdx.x == 0) { st[0] = 0u; st[1] = 0u; }
        __syncthreads();
        bar = xcd_barrier_post((unsigned*)(p.ws + WS_CTL) + CW_BAR, st);
    }
    for (int ph = lo; ph < hi; ++ph) {
#ifndef PSEL
#define PSEL 0xffff
#endif
        int phv = ph; asm volatile("" : "+s"(phv));
        size_t zoff = 0; asm volatile("" : "+s"(zoff));
        Params q = p; q.ws = p.ws + zoff; q.out = p.out + zoff;
        if (phv == 0) { if (PSEL & 1) phase0(q); }
        else {
            int l = (phv - 1) / 9, s = (phv - 1) % 9;
            if (s == 0) { if (PSEL & 2) phase_inproj(q, l, lds); }
            else if (s == 1) { if (PSEL & 128) phase_prep(q, l, lds_raw); }
            else if (s == 2) { if (PSEL & 256) phase_scan_attn(q, l, lds_raw); }
            else if (s == 3) { if (PSEL & 512) phase_mixout(q, l); }
            else if (s == 4) { if (PSEL & 4) phase_outproj(q, l, lds); }
            else if (s == 5) { if (PSEL & 8) phase_route(q, l, lds); }
            else if (s == 6) { if (PSEL & 16) phase_expert<0>(q, l, lds); }
            else if (s == 7) { if (PSEL & 32) phase_expert<1>(q, l, lds); }
            else if (s == 8) { if (PSEL & 64) phase_combine(q, l); }
        }
#ifdef REPEAT_MASK
        {
            const int ty = (phv == 0) ? 9 : (phv - 1) % 9, l = (phv == 0) ? 0 : (phv - 1) / 9;
            const bool idem = !((ty == 4 && l == 1));
            if (((REPEAT_MASK >> ty) & 1) && idem && use_bar) {
                xcd_barrier(bar);
                if (ty == 9) phase0(q);
                else if (ty == 0) phase_inproj(q, l, lds, GVAR);
                else if (ty == 1) phase_prep(q, l, lds_raw);
                else if (ty == 2) phase_scan_attn(q, l, lds_raw, 1, P3SEL);
                else if (ty == 3) phase_mixout(q, l);
                else if (ty == 4) phase_outproj(q, l, lds);
                else if (ty == 5) phase_route(q, l, lds, 1);
                else if (ty == 8) phase_combine(q, l, 1);
                else if (ty == 6) phase_expert<0>(q, l, lds);
                else if (ty == 7) phase_expert<1>(q, l, lds);
            }
        }
#endif
        if (ph + 1 < hi) {
            if (hi > 1000) cg::this_grid().sync();
            const int cs = (ph <= 2) ? 0 : (ph <= 4) ? 2 : (ph <= 11) ? 1 : -1;
            if (cs >= 0 && use_bar == 2) {
                unsigned* cq = (unsigned*)(q.ws + WS_CTL) + CW_CQ + cs * 64;
                const int cl = (cs == 1) ? 1 : 0, coff = (cs == 2) ? CONV_TAIL0 : 0;
                const unsigned clim = (cs == 0) ? (unsigned)CONV_BASE0 : (cs == 2) ? (unsigned)(CONV_N0 - CONV_TAIL0) : (unsigned)CONV_N1;
                xcd_barrier(bar, cq, clim, ph == 2 || ph == 4 || ph == 11,
                            [&](int ci) { conv_fold2(q, cl, (coff + ci) * 4, ltid()); conv_fold2(q, cl, (coff + ci) * 4 + 2, ltid()); });
            } else xcd_barrier(bar);
        }
    }
}

extern "C" void kernel_launch(void* const* d_in, const int* in_sizes, int n_in,
                              void* d_out, int out_size, void* d_ws, size_t ws_size,
                              hipStream_t stream) {
    static int grid = 0;
    if (grid == 0) {
        if (ws_size < WS_END) { fprintf(stderr, "ws too small: need %zu have %zu\n", (size_t)WS_END, ws_size); grid = -1; return; }
        int dev = 0, cus = 0, per_cu = 0;
        hipGetDevice(&dev);
        hipDeviceGetAttribute(&cus, hipDeviceAttributeMultiprocessorCount, dev);
        hipOccupancyMaxActiveBlocksPerMultiprocessor(&per_cu, mk, 256, 0);
        if (per_cu > 2) per_cu = 2;
        if (per_cu < 1) { fprintf(stderr, "occupancy query failed\n"); grid = -1; return; }
        grid = cus * per_cu;
        grid -= grid % 8;
    }
    if (grid < 0) return;
    Params p{};
    for (int i = 0; i < 23; ++i) p.in[i] = (const float*)d_in[i];
    p.out = (float*)d_out; p.ws = (char*)d_ws;
    hipMemsetAsync((char*)d_ws + WS_CTL, 0, CTL_BYTES, stream);
#ifdef POISON_GLA
    hipMemsetAsync((char*)d_ws + WS_SCR + SCR_GLA_OL, 0xFF, SCR_LVT - SCR_GLA_OL, stream);
#endif

#ifdef MULTI_LAUNCH
    for (int ph = 0; ph < NPHASE; ++ph) mk<<<grid, 256, 0, stream>>>(p, ph, ph + 1, 0);
#else
    int lo = 0, hi = NPHASE, ub = 2;
    void* args[] = {&p, &lo, &hi, &ub};
    hipError_t e = hipLaunchCooperativeKernel((void*)mk, dim3(grid), dim3(256), args, 0, stream);
    if (e != hipSuccess) fprintf(stderr, "cooperative launch failed: %s (grid %d)\n", hipGetErrorString(e), grid);
#endif
}
```
